# Optimizing an MI355X kernel written in HIP

```python
import math
import jax, jax.numpy as jnp
from jax import lax
import numpy as np

D_MODEL = 1024
BATCH = 8
SEQ = 2048
DEPTH = 1

GRID_W = 64
CTX_LEN = 256

MLA_HEADS = 8
MLA_NOPE = 64
MLA_ROPE = 32
MLA_QK = MLA_NOPE + MLA_ROPE
MLA_V = 64
MLA_Q_LORA = 384
MLA_KV_LORA = 256
MLA_WIDTH = MLA_HEADS * MLA_V
ROPE_AXIS = MLA_ROPE // 2
ROPE_THETA = 10000.0
Q_BLOCK = 128

DN_HEADS = 8
DN_DK = 64
DN_DV = 64
DN_WIDTH_K = DN_HEADS * DN_DK
DN_WIDTH = DN_HEADS * DN_DV
CONV_W = 5
CHUNK = 64
N_DIR = 2

EPS = 1e-6

IN_SPLITS = (MLA_Q_LORA, MLA_KV_LORA, MLA_ROPE, MLA_WIDTH,
             DN_WIDTH_K, DN_WIDTH_K, DN_WIDTH, DN_WIDTH,
             N_DIR * DN_HEADS, N_DIR * DN_HEADS, 2 * D_MODEL)
IN_DIM = (MLA_Q_LORA + MLA_KV_LORA + MLA_ROPE + MLA_WIDTH + 2 * DN_WIDTH_K + 2 * DN_WIDTH
          + 2 * N_DIR * DN_HEADS + 2 * D_MODEL)

kernel_name = "hybrid_mla_gated_deltanet_ctx_prefix"


def rms_norm(x, w):
    x32 = x.astype(jnp.float32)
    y = x32 * lax.rsqrt(jnp.mean(x32 * x32, axis=-1, keepdims=True) + EPS)
    return y.astype(x.dtype) * w


def l2_normalize(x):
    x32 = x.astype(jnp.float32)
    return (x32 * lax.rsqrt(jnp.sum(x32 * x32, axis=-1, keepdims=True) + EPS)).astype(x.dtype)


def split_in(p):
    offsets = np.cumsum(np.array(IN_SPLITS))[:-1].tolist()
    return jnp.split(p, offsets, axis=-1)


def axial_rope_tables(n_tokens, dtype):
    rows = n_tokens // GRID_W
    row = jnp.repeat(jnp.arange(rows, dtype=jnp.float32), GRID_W)
    col = jnp.tile(jnp.arange(GRID_W, dtype=jnp.float32), rows)
    inv_freq = ROPE_THETA ** (-jnp.arange(0, ROPE_AXIS, 2, dtype=jnp.float32) / ROPE_AXIS)
    ang = jnp.concatenate([row[:, None] * inv_freq, col[:, None] * inv_freq], axis=-1)
    return jnp.cos(ang).astype(dtype), jnp.sin(ang).astype(dtype)


def apply_axial_rope(t, cos, sin):
    half = ROPE_AXIS // 2
    tr = t.reshape(t.shape[:-1] + (2, 2, half))
    t1, t2 = tr[..., 0, :], tr[..., 1, :]
    c = cos.reshape(-1, 2, half)
    s = sin.reshape(-1, 2, half)
    out = jnp.stack([t1 * c - t2 * s, t1 * s + t2 * c], axis=-2)
    return out.reshape(t.shape)


def rope_tail(t, cos, sin):
    return jnp.concatenate([t[..., :MLA_NOPE], apply_axial_rope(t[..., MLA_NOPE:], cos, sin)], axis=-1)


def mla_queries(cq, q_norm_w, w_uq, q_head_norm_w):
    B, T, _ = cq.shape
    q = (rms_norm(cq, q_norm_w) @ w_uq).reshape(B, T, MLA_HEADS, MLA_QK)
    return rms_norm(q, q_head_norm_w).transpose(0, 2, 1, 3)


def mla_keys_values(ckv, krope, kv_norm_w, w_ukv, k_head_norm_w):
    B, T, _ = ckv.shape
    kv = (rms_norm(ckv, kv_norm_w) @ w_ukv).reshape(B, T, MLA_HEADS, MLA_NOPE + MLA_V)
    k_nope, v = kv[..., :MLA_NOPE], kv[..., MLA_NOPE:]
    k_rope = jnp.broadcast_to(krope[:, :, None, :], (B, T, MLA_HEADS, MLA_ROPE))
    k = rms_norm(jnp.concatenate([k_nope, k_rope], axis=-1), k_head_norm_w)
    return k.transpose(0, 2, 1, 3), v.transpose(0, 2, 1, 3)


def block_softmax_attention(q, k, v):
    B, H, T, dq = q.shape
    nb = T // Q_BLOCK
    scale = MLA_QK ** -0.5
    qb = q.reshape(B, H, nb, Q_BLOCK, dq).transpose(2, 0, 1, 3, 4)

    def attend(q_blk):
        s = jnp.einsum('bhqd,bhkd->bhqk', q_blk, k).astype(jnp.float32) * scale
        p = jax.nn.softmax(s, axis=-1).astype(v.dtype)
        return jnp.einsum('bhqk,bhkd->bhqd', p, v)

    o = lax.map(attend, qb)
    return o.transpose(1, 2, 0, 3, 4).reshape(B, H, T, v.shape[-1])


def centred_depthwise_conv(x, w):
    y = lax.conv_general_dilated(x, w[:, None, :].astype(x.dtype), window_strides=(1,),
                                 padding=[(CONV_W // 2, CONV_W // 2)],
                                 dimension_numbers=('NWC', 'WIO', 'NWC'),
                                 feature_group_count=x.shape[-1])
    return jax.nn.silu(y)


def deltanet_inputs(dq, dk, dv, db, da, conv_w, a_log, dt_bias):
    B, T, _ = dq.shape
    qkv = centred_depthwise_conv(jnp.concatenate([dq, dk, dv], axis=-1), conv_w)
    q, k, v = jnp.split(qkv, [DN_WIDTH_K, 2 * DN_WIDTH_K], axis=-1)
    heads = lambda t, d: t.reshape(B, T, DN_HEADS, d).transpose(0, 2, 1, 3)
    q = l2_normalize(heads(q, DN_DK)) * (DN_DK ** -0.5)
    k = l2_normalize(heads(k, DN_DK))
    v = heads(v, DN_DV)
    db = db.reshape(B, T, N_DIR, DN_HEADS).astype(jnp.float32)
    da = da.reshape(B, T, N_DIR, DN_HEADS).astype(jnp.float32)
    beta = jax.nn.sigmoid(db).transpose(2, 0, 3, 1)
    g = -jnp.exp(a_log.astype(jnp.float32))[:, None, :, None] * \
        jax.nn.softplus(da + dt_bias.astype(jnp.float32)).transpose(2, 0, 3, 1)
    return q, k, v, beta, g


def chunk_gated_delta(q, k, v, beta, g, s0):
    out_dtype = v.dtype
    f32 = jnp.float32
    B, H, T, dk = q.shape
    dv = v.shape[-1]
    n = T // CHUNK
    q = q.astype(f32).reshape(B, H, n, CHUNK, dk)
    k = k.astype(f32).reshape(B, H, n, CHUNK, dk)
    v = v.astype(f32).reshape(B, H, n, CHUNK, dv)
    beta = beta.astype(f32).reshape(B, H, n, CHUNK)
    gc = jnp.cumsum(g.astype(f32).reshape(B, H, n, CHUNK), axis=-1)
    incl = jnp.tril(jnp.ones((CHUNK, CHUNK), dtype=bool))
    strict = jnp.tril(jnp.ones((CHUNK, CHUNK), dtype=bool), -1)
    diff = gc[..., :, None] - gc[..., None, :]
    decay = jnp.where(incl, jnp.exp(jnp.where(incl, diff, 0.0)), 0.0)
    kb = k * beta[..., None]
    lower = jnp.where(strict, jnp.einsum('bhnid,bhnjd->bhnij', kb, k) * decay, 0.0)
    a_mat = lower + jnp.eye(CHUNK, dtype=f32)
    rhs = jnp.concatenate([v * beta[..., None], kb * jnp.exp(gc)[..., None]], axis=-1)
    sol = lax.linalg.triangular_solve(a_mat, rhs, left_side=True, lower=True, unit_diagonal=True)
    u, w = sol[..., :dv], sol[..., dv:]
    qk = jnp.where(incl, jnp.einsum('bhnid,bhnjd->bhnij', q, k) * decay, 0.0)
    g_last = gc[..., -1]
    q_dec = q * jnp.exp(gc)[..., None]
    k_dec = k * jnp.exp(g_last[..., None] - gc)[..., None]
    xs = tuple(jnp.moveaxis(t, 2, 0) for t in (q_dec, qk, u, w, k_dec, g_last))

    def step(state, inp):
        qd, a, u_c, w_c, kd, gl = inp
        v_new = u_c - jnp.einsum('bhcd,bhde->bhce', w_c, state)
        o = jnp.einsum('bhcd,bhde->bhce', qd, state) + jnp.einsum('bhcj,bhje->bhce', a, v_new)
        state = state * jnp.exp(gl)[..., None, None] + jnp.einsum('bhcd,bhce->bhde', kd, v_new)
        return state, o

    s_final, o = lax.scan(step, s0, xs)
    o = jnp.moveaxis(o, 0, 2).reshape(B, H, T, dv).astype(out_dtype)
    return o, s_final


def bidirectional_gated_delta(ctx_in, lat_in):
    qc, kc, vc, bc, gc = ctx_in
    ql, kl, vl, bl, gl = lat_in
    B, H = qc.shape[0], qc.shape[1]
    o_ctx, o_lat = 0.0, 0.0
    for d in range(N_DIR):
        flip = (lambda t: jnp.flip(t, axis=2)) if d == 1 else (lambda t: t)
        s0 = jnp.zeros((B, H, DN_DK, DN_DV), jnp.float32)
        oc, s_ctx = chunk_gated_delta(flip(qc), flip(kc), flip(vc), flip(bc[d]), flip(gc[d]), s0)
        ol, _ = chunk_gated_delta(flip(ql), flip(kl), flip(vl), flip(bl[d]), flip(gl[d]), s_ctx)
        o_ctx = o_ctx + flip(oc)
        o_lat = o_lat + flip(ol)
    return o_ctx, o_lat


def merge_branches(o_mla, z_mla, o_dn, z_dn, gates, mla_w_o, dn_out_norm_w, dn_w_o, w_out):
    B, _, T, _ = o_mla.shape
    y_mla = (o_mla.transpose(0, 2, 1, 3).reshape(B, T, MLA_WIDTH) * jax.nn.silu(z_mla)) @ mla_w_o
    o_dn = rms_norm(o_dn.transpose(0, 2, 1, 3), dn_out_norm_w).reshape(B, T, DN_WIDTH)
    y_dn = (o_dn * jax.nn.silu(z_dn)) @ dn_w_o
    g_mla, g_dn = jnp.split(gates, 2, axis=-1)
    return (jax.nn.sigmoid(g_mla) * y_mla + jax.nn.sigmoid(g_dn) * y_dn) @ w_out


def hybrid_layer(x, ctx, c, c_ctx, rope_cos, rope_sin, w_mod, b_mod, norm_w, w_in,
                 mla_q_norm_w, mla_w_uq, mla_kv_norm_w, mla_w_ukv, mla_q_head_norm_w, mla_k_head_norm_w, mla_w_o,
                 dn_conv_w, dn_a_log, dn_dt_bias, dn_out_norm_w, dn_w_o, w_out, update_ctx):
    shift, scale, gate = jnp.split(jax.nn.silu(c) @ w_mod + b_mod, 3, axis=-1)
    shift_c, scale_c, gate_c = jnp.split(jax.nn.silu(c_ctx) @ w_mod + b_mod, 3, axis=-1)
    h = rms_norm(x, norm_w) * (1.0 + scale[:, None]) + shift[:, None]
    hc = rms_norm(ctx, norm_w) * (1.0 + scale_c) + shift_c
    cq_l, ckv_l, kr_l, zm_l, dq_l, dk_l, dv_l, zd_l, db_l, da_l, gates_l = split_in(h @ w_in)
    cq_c, ckv_c, kr_c, zm_c, dq_c, dk_c, dv_c, zd_c, db_c, da_c, gates_c = split_in(hc @ w_in)

    k_ctx, v_ctx = mla_keys_values(ckv_c, kr_c, mla_kv_norm_w, mla_w_ukv, mla_k_head_norm_w)
    k_lat, v_lat = mla_keys_values(ckv_l, kr_l, mla_kv_norm_w, mla_w_ukv, mla_k_head_norm_w)
    k_lat = rope_tail(k_lat, rope_cos, rope_sin)
    q_lat = rope_tail(mla_queries(cq_l, mla_q_norm_w, mla_w_uq, mla_q_head_norm_w), rope_cos, rope_sin)
    o_mla_lat = block_softmax_attention(q_lat, jnp.concatenate([k_ctx, k_lat], axis=2),
                                        jnp.concatenate([v_ctx, v_lat], axis=2))

    dn_ctx = deltanet_inputs(dq_c, dk_c, dv_c, db_c, da_c, dn_conv_w, dn_a_log, dn_dt_bias)
    dn_lat = deltanet_inputs(dq_l, dk_l, dv_l, db_l, da_l, dn_conv_w, dn_a_log, dn_dt_bias)
    o_dn_ctx, o_dn_lat = bidirectional_gated_delta(dn_ctx, dn_lat)

    y_lat = merge_branches(o_mla_lat, zm_l, o_dn_lat, zd_l, gates_l, mla_w_o, dn_out_norm_w, dn_w_o, w_out)
    x = x + gate[:, None] * y_lat
    if update_ctx:
        q_ctx = mla_queries(cq_c, mla_q_norm_w, mla_w_uq, mla_q_head_norm_w)
        o_mla_ctx = block_softmax_attention(q_ctx, k_ctx, v_ctx)
        y_ctx = merge_branches(o_mla_ctx, zm_c, o_dn_ctx, zd_c, gates_c, mla_w_o, dn_out_norm_w, dn_w_o, w_out)
        ctx = ctx + gate_c * y_ctx
    return x, ctx


def setup_inputs(seed: int = 0) -> dict:
    key = jax.random.key(seed)
    ks = jax.random.split(key, 21)
    f32 = jnp.float32
    L = DEPTH
    nrm = lambda k, shape, fan_in: jax.random.normal(k, shape, f32) * (fan_in ** -0.5)
    gain = lambda k, shape: 1.0 + 0.01 * jax.random.normal(k, shape, f32)
    dt = jnp.exp(jax.random.uniform(ks[17], (L, N_DIR, DN_HEADS), f32, minval=math.log(1e-3), maxval=math.log(1e-1)))
    return {
        "x": jax.random.normal(ks[0], (BATCH, SEQ, D_MODEL), f32),
        "c": jax.random.normal(ks[1], (BATCH, D_MODEL), f32),
        "ctx": jax.random.normal(ks[2], (BATCH, CTX_LEN, D_MODEL), f32),
        "c_ctx": jax.random.normal(ks[3], (D_MODEL,), f32),
        "w_mod": nrm(ks[4], (L, D_MODEL, 3 * D_MODEL), D_MODEL),
        "b_mod": 0.02 * jax.random.normal(ks[5], (L, 3 * D_MODEL), f32),
        "norm_w": gain(ks[6], (L, D_MODEL)),
        "w_in": nrm(ks[7], (L, D_MODEL, IN_DIM), D_MODEL),
        "mla_q_norm_w": gain(ks[8], (L, MLA_Q_LORA)),
        "mla_w_uq": nrm(ks[9], (L, MLA_Q_LORA, MLA_HEADS * MLA_QK), MLA_Q_LORA),
        "mla_kv_norm_w": gain(ks[10], (L, MLA_KV_LORA)),
        "mla_w_ukv": nrm(ks[11], (L, MLA_KV_LORA, MLA_HEADS * (MLA_NOPE + MLA_V)), MLA_KV_LORA),
        "mla_q_head_norm_w": gain(ks[12], (L, MLA_QK)),
        "mla_k_head_norm_w": gain(ks[13], (L, MLA_QK)),
        "mla_w_o": nrm(ks[14], (L, MLA_WIDTH, D_MODEL), MLA_WIDTH),
        "dn_conv_w": nrm(ks[15], (L, CONV_W, 2 * DN_WIDTH_K + DN_WIDTH), CONV_W),
        "dn_a_log": jnp.log(jax.random.uniform(ks[16], (L, N_DIR, DN_HEADS), f32, minval=1.0, maxval=16.0)),
        "dn_dt_bias": dt + jnp.log(-jnp.expm1(-dt)),
        "dn_out_norm_w": gain(ks[18], (L, DN_DV)),
        "dn_w_o": nrm(ks[19], (L, DN_WIDTH, D_MODEL), DN_WIDTH),
        "w_out": nrm(ks[20], (L, D_MODEL, D_MODEL), D_MODEL),
    }


def reference(x, c, ctx, c_ctx, w_mod, b_mod, norm_w, w_in, mla_q_norm_w, mla_w_uq, mla_kv_norm_w, mla_w_ukv,
              mla_q_head_norm_w, mla_k_head_norm_w, mla_w_o, dn_conv_w, dn_a_log, dn_dt_bias, dn_out_norm_w, dn_w_o,
              w_out):
    rope_cos, rope_sin = axial_rope_tables(x.shape[1], x.dtype)
    for layer in range(DEPTH):
        x, ctx = hybrid_layer(x, ctx, c, c_ctx, rope_cos, rope_sin, w_mod[layer], b_mod[layer], norm_w[layer],
                              w_in[layer], mla_q_norm_w[layer], mla_w_uq[layer], mla_kv_norm_w[layer],
                              mla_w_ukv[layer], mla_q_head_norm_w[layer], mla_k_head_norm_w[layer], mla_w_o[layer],
                              dn_conv_w[layer], dn_a_log[layer], dn_dt_bias[layer], dn_out_norm_w[layer],
                              dn_w_o[layer], w_out[layer], update_ctx=(layer < DEPTH - 1))
    return x
```

```cpp
#include <hip/hip_runtime.h>
#include <stdint.h>
#include <cstdio>

typedef uint16_t bf16_t;

#define NB 8
#define SEQ 2048
#define CTXL 256
#define TPB 2304
#define NCTX 2048
#define NL 16384
#define NT 18432
#define DM 1024
#define IN_DIM 5312
#define PA_W 2240
#define PB_W 3072
#define PA_CQ 0
#define PA_CKV 384
#define PA_KR 640
#define PA_DQ 672
#define PA_DK 1184
#define PA_DV 1696
#define PA_DB 2208
#define PA_DA 2224
#define EPSF 1e-6f

__device__ __forceinline__ float bf2f(bf16_t v) { return __uint_as_float(((uint32_t)v) << 16); }
__device__ __forceinline__ bf16_t f2bf(float f) {
    uint32_t u = __float_as_uint(f);
    u += 0x7fffu + ((u >> 16) & 1u);
    return (bf16_t)(u >> 16);
}
__device__ __forceinline__ float silu_f(float v) { return v / (1.f + expf(-v)); }
__device__ __forceinline__ float sigmoid_f(float v) { return 1.f / (1.f + expf(-v)); }
__device__ __forceinline__ float wave_sum(float v) {
#pragma unroll
    for (int o = 32; o > 0; o >>= 1) v += __shfl_xor(v, o);
    return v;
}
__device__ __forceinline__ float wave_max(float v) {
#pragma unroll
    for (int o = 32; o > 0; o >>= 1) v = fmaxf(v, __shfl_xor(v, o));
    return v;
}
__device__ __forceinline__ float block_sum256(float v, float* sh) {
    v = wave_sum(v);
    __syncthreads();
    if ((threadIdx.x & 63) == 0) sh[threadIdx.x >> 6] = v;
    __syncthreads();
    return sh[0] + sh[1] + sh[2] + sh[3];
}

__global__ void __launch_bounds__(256) mod_kernel(const float* __restrict__ c, const float* __restrict__ c_ctx,
                                                  const float* __restrict__ w_mod, const float* __restrict__ b_mod,
                                                  float* __restrict__ mod) {
    __shared__ float sc[9 * 1024];
    for (int i = threadIdx.x; i < 9 * 1024; i += 256) {
        int r = i >> 10, k = i & 1023;
        float v = (r < 8) ? c[r * 1024 + k] : c_ctx[k];
        sc[i] = silu_f(v);
    }
    __syncthreads();
    const int j = blockIdx.x * 256 + threadIdx.x;
    float acc[9];
#pragma unroll
    for (int r = 0; r < 9; ++r) acc[r] = 0.f;
    for (int k = 0; k < 1024; ++k) {
        const float w = w_mod[(size_t)k * 3072 + j];
#pragma unroll
        for (int r = 0; r < 9; ++r) acc[r] += sc[r * 1024 + k] * w;
    }
    const float bb = b_mod[j];
#pragma unroll
    for (int r = 0; r < 9; ++r) mod[r * 3072 + j] = acc[r] + bb;
}

__global__ void __launch_bounds__(256) norm_kernel(const float* __restrict__ x, const float* __restrict__ ctx,
                                                   const float* __restrict__ norm_w, const float* __restrict__ mod,
                                                   bf16_t* __restrict__ h) {
    __shared__ float sh[4];
    const int r = blockIdx.x;
    const float* src; int mrow;
    if (r < NCTX) { src = ctx + (size_t)r * DM; mrow = 8; }
    else { const int rl = r - NCTX; src = x + (size_t)rl * DM; mrow = rl / SEQ; }
    const float4 v = ((const float4*)src)[threadIdx.x];
    float ss = v.x * v.x + v.y * v.y + v.z * v.z + v.w * v.w;
    ss = block_sum256(ss, sh);
    const float rstd = rsqrtf(ss * (1.f / 1024.f) + EPSF);
    const float* shift = mod + mrow * 3072;
    const float* scale = shift + 1024;
    const int k = threadIdx.x * 4;
    float vv[4] = {v.x, v.y, v.z, v.w};
#pragma unroll
    for (int i = 0; i < 4; ++i) {
        float y = vv[i] * rstd * norm_w[k + i];
        y = y * (1.f + scale[k + i]) + shift[k + i];
        h[(size_t)r * DM + k + i] = f2bf(y);
    }
}

struct EpiArgs {
    void* C; int ldc;
    const bf16_t* Pb;
    const float* M1;
    const float* x;
    const float* mod;
};
template <int EPI>
__global__ void __launch_bounds__(256) gemm_naive(const bf16_t* __restrict__ A, int lda, const float* __restrict__ W, int ldw,
                                                  int M, int N, int K, EpiArgs e) {
    __shared__ float As[16][68];
    __shared__ float Ws[16][68];
    const int tid = threadIdx.x, tx = tid & 15, ty = tid >> 4;
    const int row0 = blockIdx.y * 64, col0 = blockIdx.x * 64;
    float acc[4][4];
#pragma unroll
    for (int i = 0; i < 4; ++i)
#pragma unroll
        for (int j = 0; j < 4; ++j) acc[i][j] = 0.f;
    const int ar = tid >> 2, ak = (tid & 3) * 4;
    const int wk = tid >> 4, wn = (tid & 15) * 4;
    for (int k0 = 0; k0 < K; k0 += 16) {
        {
            const bf16_t* ap = A + (size_t)(row0 + ar) * lda + k0 + ak;
            const uint2 raw = *(const uint2*)ap;
            As[ak + 0][ar] = __uint_as_float(raw.x << 16);
            As[ak + 1][ar] = __uint_as_float(raw.x & 0xffff0000u);
            As[ak + 2][ar] = __uint_as_float(raw.y << 16);
            As[ak + 3][ar] = __uint_as_float(raw.y & 0xffff0000u);
            float4 w4 = make_float4(0.f, 0.f, 0.f, 0.f);
            if (col0 + wn < N) w4 = *(const float4*)(W + (size_t)(k0 + wk) * ldw + col0 + wn);
            Ws[wk][wn + 0] = w4.x; Ws[wk][wn + 1] = w4.y; Ws[wk][wn + 2] = w4.z; Ws[wk][wn + 3] = w4.w;
        }
        __syncthreads();
#pragma unroll
        for (int kk = 0; kk < 16; ++kk) {
            float a[4], b[4];
#pragma unroll
            for (int i = 0; i < 4; ++i) a[i] = As[kk][ty * 4 + i];
#pragma unroll
            for (int j = 0; j < 4; ++j) b[j] = Ws[kk][tx * 4 + j];
#pragma unroll
            for (int i = 0; i < 4; ++i)
#pragma unroll
                for (int j = 0; j < 4; ++j) acc[i][j] += a[i] * b[j];
        }
        __syncthreads();
    }
#pragma unroll
    for (int i = 0; i < 4; ++i) {
        const int row = row0 + ty * 4 + i;
#pragma unroll
        for (int j = 0; j < 4; ++j) {
            const int col = col0 + tx * 4 + j;
            if (col >= N) continue;
            const float v = acc[i][j];
            if (EPI == 0) {
                ((bf16_t*)e.C)[(size_t)row * e.ldc + col] = f2bf(v);
            } else if (EPI == 1) {
                const float g = sigmoid_f(bf2f(e.Pb[(size_t)row * PB_W + 1024 + col]));
                ((float*)e.C)[(size_t)row * e.ldc + col] = g * v;
            } else if (EPI == 2) {
                const float g = sigmoid_f(bf2f(e.Pb[(size_t)row * PB_W + 2048 + col]));
                ((bf16_t*)e.C)[(size_t)row * e.ldc + col] = f2bf(e.M1[(size_t)row * 1024 + col] + g * v);
            } else {
                const float gate = e.mod[(row / SEQ) * 3072 + 2048 + col];
                ((float*)e.C)[(size_t)row * e.ldc + col] = e.x[(size_t)row * DM + col] + gate * v;
            }
        }
    }
}

__global__ void __launch_bounds__(256) prenorm_kernel(const bf16_t* __restrict__ Pa, const float* __restrict__ q_norm_w,
                                                      const float* __restrict__ kv_norm_w, bf16_t* __restrict__ qn,
                                                      bf16_t* __restrict__ kvn) {
    __shared__ float sh[4];
    const int r = blockIdx.x, tid = threadIdx.x;
    const bf16_t* row = Pa + (size_t)r * PA_W;
    {
        const float v = bf2f(row[PA_CKV + tid]);
        const float ss = block_sum256(v * v, sh);
        const float rstd = rsqrtf(ss * (1.f / 256.f) + EPSF);
        kvn[(size_t)r * 256 + tid] = f2bf(v * rstd * kv_norm_w[tid]);
    }
    if (r >= NCTX) {
        const float v0 = bf2f(row[PA_CQ + tid]);
        const float v1 = (tid < 128) ? bf2f(row[PA_CQ + 256 + tid]) : 0.f;
        const float ss = block_sum256(v0 * v0 + v1 * v1, sh);
        const float rstd = rsqrtf(ss * (1.f / 384.f) + EPSF);
        bf16_t* o = qn + (size_t)(r - NCTX) * 384;
        o[tid] = f2bf(v0 * rstd * q_norm_w[tid]);
        if (tid < 128) o[256 + tid] = f2bf(v1 * rstd * q_norm_w[256 + tid]);
    }
}

__global__ void __launch_bounds__(256) mla_post_kernel(const bf16_t* __restrict__ Pa, const bf16_t* __restrict__ Qraw,
                                                       const bf16_t* __restrict__ KVraw, const float* __restrict__ qhn_w,
                                                       const float* __restrict__ khn_w, bf16_t* __restrict__ Q,
                                                       bf16_t* __restrict__ Kb, bf16_t* __restrict__ Vb) {
    const int r = blockIdx.x, tid = threadIdx.x, w = tid >> 6, lane = tid & 63;
    int b, pos, t = 0; bool lat = (r >= NCTX);
    if (!lat) { b = r / CTXL; pos = r % CTXL; }
    else { const int rl = r - NCTX; b = rl / SEQ; t = rl % SEQ; pos = CTXL + t; }
    float cs = 1.f, sn = 0.f;
    const int j = lane & 31, ax = j >> 4, ph = (j >> 3) & 1, f = j & 7;
    if (lat) {
        const float inv_freq = powf(10000.f, -(float)f / 8.f);
        const float p = (ax == 0) ? (float)(t / 64) : (float)(t % 64);
        const float ang = p * inv_freq;
        cs = cosf(ang); sn = sinf(ang);
    }
    const float kr = (lane < 32) ? bf2f(Pa[(size_t)r * PA_W + PA_KR + lane]) : 0.f;
#pragma unroll
    for (int hi = 0; hi < 2; ++hi) {
        const int hh = w * 2 + hi;
        const float k0 = bf2f(KVraw[(size_t)r * 1024 + hh * 128 + lane]);
        const float k1 = kr;
        const float ss = wave_sum(k0 * k0 + k1 * k1);
        const float rstd = rsqrtf(ss * (1.f / 96.f) + EPSF);
        const float kn0 = k0 * rstd * khn_w[lane];
        float kn1 = (lane < 32) ? k1 * rstd * khn_w[64 + lane] : 0.f;
        {
            const float partner = __shfl_xor(kn1, 8);
            const float t1 = ph ? partner : kn1, t2 = ph ? kn1 : partner;
            kn1 = ph ? (t1 * sn + t2 * cs) : (t1 * cs - t2 * sn);
        }
        bf16_t* kd = Kb + ((size_t)(b * 8 + hh) * TPB + pos) * 96;
        kd[lane] = f2bf(kn0);
        if (lane < 32) kd[64 + lane] = f2bf(kn1);
        Vb[((size_t)(b * 8 + hh) * TPB + pos) * 64 + lane] = KVraw[(size_t)r * 1024 + hh * 128 + 64 + lane];
        if (lat) {
            const int rl = r - NCTX;
            const float q0 = bf2f(Qraw[(size_t)rl * 768 + hh * 96 + lane]);
            const float q1 = (lane < 32) ? bf2f(Qraw[(size_t)rl * 768 + hh * 96 + 64 + lane]) : 0.f;
            const float qs = wave_sum(q0 * q0 + q1 * q1);
            const float qr = rsqrtf(qs * (1.f / 96.f) + EPSF);
            const float qn0 = q0 * qr * qhn_w[lane];
            float qn1 = (lane < 32) ? q1 * qr * qhn_w[64 + lane] : 0.f;
            {
                const float partner = __shfl_xor(qn1, 8);
                const float t1 = ph ? partner : qn1, t2 = ph ? qn1 : partner;
                qn1 = ph ? (t1 * sn + t2 * cs) : (t1 * cs - t2 * sn);
            }
            const float qsc = 0.10206207261596575f * 1.4426950408889634f;
            bf16_t* qd = Q + ((size_t)(b * 8 + hh) * SEQ + t) * 96;
            qd[lane] = f2bf(qn0 * qsc);
            if (lane < 32) qd[64 + lane] = f2bf(qn1 * qsc);
        }
    }
}

__global__ void __launch_bounds__(256) dn_prep_kernel(const bf16_t* __restrict__ Pa, const float* __restrict__ conv_w,
                                                      const float* __restrict__ a_log, const float* __restrict__ dt_bias,
                                                      bf16_t* __restrict__ dnq, bf16_t* __restrict__ dnk, bf16_t* __restrict__ dnv,
                                                      float* __restrict__ beta, float* __restrict__ gbuf) {
    const int r = blockIdx.x, tid = threadIdx.x, w = tid >> 6, lane = tid & 63;
    int b, pp, seglen, base, pos;
    if (r < NCTX) { b = r / CTXL; pp = r % CTXL; seglen = CTXL; base = b * CTXL; pos = pp; }
    else { const int rl = r - NCTX; b = rl / SEQ; pp = rl % SEQ; seglen = SEQ; base = NCTX + b * SEQ; pos = CTXL + pp; }
#pragma unroll
    for (int m = 0; m < 6; ++m) {
        const int ch = tid + 256 * m;
        float y = 0.f;
#pragma unroll
        for (int jj = 0; jj < 5; ++jj) {
            const int q = pp + jj - 2;
            if (q >= 0 && q < seglen) y += bf2f(Pa[(size_t)(base + q) * PA_W + PA_DQ + ch]) * conv_w[jj * 1536 + ch];
        }
        y = silu_f(y);
        const int grp = m >> 1, hh = w + 4 * (m & 1);
        const size_t o = ((size_t)(b * 8 + hh) * TPB + pos) * 64 + lane;
        if (grp == 2) { dnv[o] = f2bf(y); }
        else {
            const float ss = wave_sum(y * y);
            const float rn = rsqrtf(ss + EPSF);
            if (grp == 0) dnq[o] = f2bf(y * rn * 0.125f);
            else dnk[o] = f2bf(y * rn);
        }
    }
    if (tid < 16) {
        const int d = tid >> 3, hh = tid & 7;
        const float db = bf2f(Pa[(size_t)r * PA_W + PA_DB + tid]);
        const float da = bf2f(Pa[(size_t)r * PA_W + PA_DA + tid]);
        const float xx = da + dt_bias[tid];
        const float sp = (xx > 20.f) ? xx : log1pf(expf(xx));
        const size_t o = ((size_t)((d * 8 + b) * 8 + hh)) * TPB + pos;
        beta[o] = sigmoid_f(db);
        gbuf[o] = -expf(a_log[tid]) * sp;
    }
}

__global__ void __launch_bounds__(256) attn_naive_kernel(const bf16_t* __restrict__ Q, const bf16_t* __restrict__ Kb,
                                                         const bf16_t* __restrict__ Vb, bf16_t* __restrict__ o_mla) {
    __shared__ float sc[4][TPB];
    __shared__ float sq[4][96];
    const int tid = threadIdx.x, w = tid >> 6, lane = tid & 63;
    const int bh = blockIdx.y;
    const int t = blockIdx.x * 4 + w;
    const bf16_t* qp = Q + ((size_t)bh * SEQ + t) * 96;
    sq[w][lane] = bf2f(qp[lane]);
    if (lane < 32) sq[w][64 + lane] = bf2f(qp[64 + lane]);
    __syncthreads();
    const bf16_t* kb = Kb + (size_t)bh * TPB * 96;
    float mx = -3.0e38f;
    for (int key = lane; key < TPB; key += 64) {
        const uint4* kp = (const uint4*)(kb + (size_t)key * 96);
        float s = 0.f;
#pragma unroll
        for (int c = 0; c < 12; ++c) {
            const uint4 u = kp[c];
            const uint32_t uu[4] = {u.x, u.y, u.z, u.w};
#pragma unroll
            for (int e = 0; e < 4; ++e) {
                s += sq[w][c * 8 + e * 2] * __uint_as_float(uu[e] << 16);
                s += sq[w][c * 8 + e * 2 + 1] * __uint_as_float(uu[e] & 0xffff0000u);
            }
        }
        sc[w][key] = s;
        mx = fmaxf(mx, s);
    }
    mx = wave_max(mx);
    float l = 0.f;
    for (int key = lane; key < TPB; key += 64) {
        const float p = exp2f(sc[w][key] - mx);
        sc[w][key] = p;
        l += p;
    }
    l = wave_sum(l);
    __syncthreads();
    const bf16_t* vb = Vb + (size_t)bh * TPB * 64;
    float o = 0.f;
    for (int key = 0; key < TPB; ++key) o += sc[w][key] * bf2f(vb[(size_t)key * 64 + lane]);
    o /= l;
    const int b = bh >> 3, hh = bh & 7;
    o_mla[((size_t)(b * SEQ + t)) * 512 + hh * 64 + lane] = f2bf(o);
}

__global__ void __launch_bounds__(64) dn_scan_naive(const bf16_t* __restrict__ dnq, const bf16_t* __restrict__ dnk,
                                                    const bf16_t* __restrict__ dnv, const float* __restrict__ beta,
                                                    const float* __restrict__ gbuf, bf16_t* __restrict__ Of, bf16_t* __restrict__ Ob) {
    const int idx = blockIdx.x, lane = threadIdx.x;
    const int d = idx >> 6, b = (idx >> 3) & 7, hh = idx & 7;
    const size_t cb = (size_t)(b * 8 + hh) * TPB;
    const float* bt = beta + (size_t)((d * 8 + b) * 8 + hh) * TPB;
    const float* gg = gbuf + (size_t)((d * 8 + b) * 8 + hh) * TPB;
    bf16_t* O = d ? Ob : Of;
    float S[64];
#pragma unroll
    for (int i = 0; i < 64; ++i) S[i] = 0.f;
    for (int s = 0; s < TPB; ++s) {
        int pos;
        if (d == 0) pos = s; else pos = (s < CTXL) ? (CTXL - 1 - s) : (TPB - 1 - (s - CTXL));
        const float kk = bf2f(dnk[(cb + pos) * 64 + lane]);
        const float qq = bf2f(dnq[(cb + pos) * 64 + lane]);
        const float vv = bf2f(dnv[(cb + pos) * 64 + lane]);
        const float a = expf(gg[pos]);
        const float be = bt[pos];
        float pred = 0.f;
#pragma unroll
        for (int i = 0; i < 64; ++i) pred += __shfl(kk, i) * S[i];
        pred *= a;
        const float vn = be * (vv - pred);
        float o = 0.f;
#pragma unroll
        for (int i = 0; i < 64; ++i) {
            S[i] = a * S[i] + __shfl(kk, i) * vn;
            o += __shfl(qq, i) * S[i];
        }
        if (pos >= CTXL) O[((size_t)(b * SEQ + pos - CTXL)) * 512 + hh * 64 + lane] = f2bf(o);
    }
}

__global__ void __launch_bounds__(256) merge_prep_kernel(const bf16_t* __restrict__ o_mla, const bf16_t* __restrict__ Of,
                                                         const bf16_t* __restrict__ Ob, const bf16_t* __restrict__ Pb,
                                                         const float* __restrict__ dn_norm_w, bf16_t* __restrict__ A_mla,
                                                         bf16_t* __restrict__ A_dn) {
    const int rl = blockIdx.x, tid = threadIdx.x, lane = tid & 63;
#pragma unroll
    for (int m = 0; m < 2; ++m) {
        const int c = tid + 256 * m;
        const size_t o = (size_t)rl * 512 + c;
        const float zm = bf2f(Pb[(size_t)rl * PB_W + c]);
        const float zd = bf2f(Pb[(size_t)rl * PB_W + 512 + c]);
        A_mla[o] = f2bf(bf2f(o_mla[o]) * silu_f(zm));
        const float v = bf2f(Of[o]) + bf2f(Ob[o]);
        const float ss = wave_sum(v * v);
        const float rstd = rsqrtf(ss * (1.f / 64.f) + EPSF);
        A_dn[o] = f2bf(v * rstd * dn_norm_w[lane] * silu_f(zd));
    }
}

template <int EPI>
static void launch_gemm(const bf16_t* A, int lda, const float* W, int ldw, int M, int N, int K, EpiArgs e, hipStream_t s) {
    dim3 grid((N + 63) / 64, M / 64);
    gemm_naive<EPI><<<grid, 256, 0, s>>>(A, lda, W, ldw, M, N, K, e);
}

extern "C" void kernel_launch(void* const* d_in, const int* in_sizes, int n_in,
                              void* d_out, int out_size, void* d_ws, size_t ws_size,
                              hipStream_t stream) {
    const float* x = (const float*)d_in[0];
    const float* c = (const float*)d_in[1];
    const float* ctx = (const float*)d_in[2];
    const float* c_ctx = (const float*)d_in[3];
    const float* w_mod = (const float*)d_in[4];
    const float* b_mod = (const float*)d_in[5];
    const float* norm_w = (const float*)d_in[6];
    const float* w_in = (const float*)d_in[7];
    const float* q_norm_w = (const float*)d_in[8];
    const float* w_uq = (const float*)d_in[9];
    const float* kv_norm_w = (const float*)d_in[10];
    const float* w_ukv = (const float*)d_in[11];
    const float* qhn_w = (const float*)d_in[12];
    const float* khn_w = (const float*)d_in[13];
    const float* mla_w_o = (const float*)d_in[14];
    const float* conv_w = (const float*)d_in[15];
    const float* a_log = (const float*)d_in[16];
    const float* dt_bias = (const float*)d_in[17];
    const float* dn_norm_w = (const float*)d_in[18];
    const float* dn_w_o = (const float*)d_in[19];
    const float* w_out = (const float*)d_in[20];
    float* out = (float*)d_out;
    char* ws = (char*)d_ws;
    char* ob = (char*)d_out;

    const size_t R_H = 0;
    const size_t R_PA = 37748736;
    const size_t R_PB = R_PA + 82575360;
    const size_t R_F = R_PB + 100663296;
    bf16_t* h = (bf16_t*)(ws + R_H);
    bf16_t* Pa = (bf16_t*)(ws + R_PA);
    bf16_t* Pb = (bf16_t*)(ws + R_PB);
    bf16_t* Qb = (bf16_t*)(ws + R_F);
    bf16_t* Vb = (bf16_t*)(ws + R_F + 25165824);
    float* mod = (float*)(ws + R_F + 25165824 + 18874368);
    bf16_t* qn = (bf16_t*)(ws + R_H);
    bf16_t* kvn = (bf16_t*)(ws + R_H + 12582912);
    bf16_t* Qraw = (bf16_t*)(ob);
    bf16_t* KVraw = (bf16_t*)(ob + 25165824);
    bf16_t* Kb = (bf16_t*)(ws + R_H);
    bf16_t* dnq = (bf16_t*)(ob);
    bf16_t* dnk = (bf16_t*)(ob + 18874368);
    bf16_t* dnv = (bf16_t*)(ob + 2 * 18874368);
    float* beta = (float*)(ob + 3 * 18874368);
    float* gbuf = (float*)(ob + 3 * 18874368 + 1179648);
    bf16_t* o_mla = (bf16_t*)(ws + R_PA);
    bf16_t* Of = (bf16_t*)(ws + R_PA + 16777216);
    bf16_t* Ob = (bf16_t*)(ws + R_PA + 2 * 16777216);
    bf16_t* A_mla = (bf16_t*)(ws + R_F);
    bf16_t* A_dn = (bf16_t*)(ws + R_F + 16777216);
    float* M1 = (float*)(ob);
    bf16_t* Mb = (bf16_t*)(ws + R_H);

    EpiArgs e{};
    mod_kernel<<<12, 256, 0, stream>>>(c, c_ctx, w_mod, b_mod, mod);
    norm_kernel<<<NT, 256, 0, stream>>>(x, ctx, norm_w, mod, h);
    e.C = Pa; e.ldc = PA_W;
    launch_gemm<0>(h, DM, w_in + 0, IN_DIM, NT, 672, DM, e, stream);
    e.C = Pa + PA_DQ;
    launch_gemm<0>(h, DM, w_in + 1184, IN_DIM, NT, 1536, DM, e, stream);
    e.C = Pa + PA_DB;
    launch_gemm<0>(h, DM, w_in + 3232, IN_DIM, NT, 32, DM, e, stream);
    const bf16_t* hl = h + (size_t)NCTX * DM;
    e.C = Pb; e.ldc = PB_W;
    launch_gemm<0>(hl, DM, w_in + 672, IN_DIM, NL, 512, DM, e, stream);
    e.C = Pb + 512;
    launch_gemm<0>(hl, DM, w_in + 2720, IN_DIM, NL, 512, DM, e, stream);
    e.C = Pb + 1024;
    launch_gemm<0>(hl, DM, w_in + 3264, IN_DIM, NL, 2048, DM, e, stream);
    prenorm_kernel<<<NT, 256, 0, stream>>>(Pa, q_norm_w, kv_norm_w, qn, kvn);
    e.C = Qraw; e.ldc = 768;
    launch_gemm<0>(qn, 384, w_uq, 768, NL, 768, 384, e, stream);
    e.C = KVraw; e.ldc = 1024;
    launch_gemm<0>(kvn, 256, w_ukv, 1024, NT, 1024, 256, e, stream);
    mla_post_kernel<<<NT, 256, 0, stream>>>(Pa, Qraw, KVraw, qhn_w, khn_w, Qb, Kb, Vb);
    dn_prep_kernel<<<NT, 256, 0, stream>>>(Pa, conv_w, a_log, dt_bias, dnq, dnk, dnv, beta, gbuf);
    attn_naive_kernel<<<dim3(SEQ / 4, 64), 256, 0, stream>>>(Qb, Kb, Vb, o_mla);
    dn_scan_naive<<<128, 64, 0, stream>>>(dnq, dnk, dnv, beta, gbuf, Of, Ob);
    merge_prep_kernel<<<NL, 256, 0, stream>>>(o_mla, Of, Ob, Pb, dn_norm_w, A_mla, A_dn);
    e.C = M1; e.ldc = 1024; e.Pb = Pb;
    launch_gemm<1>(A_mla, 512, mla_w_o, 1024, NL, 1024, 512, e, stream);
    e.C = Mb; e.ldc = 1024; e.M1 = M1;
    launch_gemm<2>(A_dn, 512, dn_w_o, 1024, NL, 1024, 512, e, stream);
    e.C = out; e.ldc = 1024; e.x = x; e.mod = mod;
    launch_gemm<3>(Mb, 1024, w_out, 1024, NL, 1024, 1024, e, stream);
}
```

```cpp
#include <hip/hip_runtime.h>
#include <hip/hip_cooperative_groups.h>
#include <stdint.h>
#include <cstdio>
namespace cg = cooperative_groups;

typedef uint16_t bf16_t;

#define NB 8
#define SEQ 2048
#define CTXL 256
#define TPB 2304
#define NCTX 2048
#define NL 16384
#define NT 18432
#define DM 1024
#define IN_DIM 5312
#define PA_W 2240
#define PB_W 3072
#define PA_CQ 0
#define PA_CKV 384
#define PA_KR 640
#define PA_DQ 672
#define PA_DK 1184
#define PA_DV 1696
#define PA_DB 2208
#define PA_DA 2224
#define EPSF 1e-6f
#define NTHR 256
#define SMEM_BYTES 40960

struct Params {
    const float *x, *c, *ctx, *c_ctx, *w_mod, *b_mod, *norm_w, *w_in, *q_norm_w, *w_uq, *kv_norm_w, *w_ukv, *qhn_w, *khn_w,
        *mla_w_o, *conv_w, *a_log, *dt_bias, *dn_norm_w, *dn_w_o, *w_out;
    float* out;
    bf16_t *h, *Pa, *Pb, *Qb, *Vb, *qn, *kvn, *Qraw, *KVraw, *Kb, *dnq, *dnk, *dnv, *o_mla, *Of, *Ob, *A_mla, *A_dn, *Mb;
    float *mod, *beta, *gbuf, *M1;
};

__device__ __forceinline__ float bf2f(bf16_t v) { return __uint_as_float(((uint32_t)v) << 16); }
__device__ __forceinline__ bf16_t f2bf(float f) {
    uint32_t u = __float_as_uint(f);
    u += 0x7fffu + ((u >> 16) & 1u);
    return (bf16_t)(u >> 16);
}
__device__ __forceinline__ float silu_f(float v) { return v / (1.f + expf(-v)); }
__device__ __forceinline__ float sigmoid_f(float v) { return 1.f / (1.f + expf(-v)); }
__device__ __forceinline__ float wave_sum(float v) {
#pragma unroll
    for (int o = 32; o > 0; o >>= 1) v += __shfl_xor(v, o);
    return v;
}
__device__ __forceinline__ float wave_max(float v) {
#pragma unroll
    for (int o = 32; o > 0; o >>= 1) v = fmaxf(v, __shfl_xor(v, o));
    return v;
}
__device__ __forceinline__ float block_sum256(float v, float* sh) {
    v = wave_sum(v);
    __syncthreads();
    if ((threadIdx.x & 63) == 0) sh[threadIdx.x >> 6] = v;
    __syncthreads();
    return sh[0] + sh[1] + sh[2] + sh[3];
}

__device__ void ph_mod(const Params& p, int bid, int nb, char* smem) {
    float* sc = (float*)smem;
    if (bid >= 12) return;
    for (int i = threadIdx.x; i < 9 * 1024; i += NTHR) {
        int r = i >> 10, k = i & 1023;
        float v = (r < 8) ? p.c[r * 1024 + k] : p.c_ctx[k];
        sc[i] = silu_f(v);
    }
    __syncthreads();
    const int j = bid * 256 + threadIdx.x;
    float acc[9];
#pragma unroll
    for (int r = 0; r < 9; ++r) acc[r] = 0.f;
    for (int k = 0; k < 1024; ++k) {
        const float w = p.w_mod[(size_t)k * 3072 + j];
#pragma unroll
        for (int r = 0; r < 9; ++r) acc[r] += sc[r * 1024 + k] * w;
    }
    const float bb = p.b_mod[j];
#pragma unroll
    for (int r = 0; r < 9; ++r) p.mod[r * 3072 + j] = acc[r] + bb;
    __syncthreads();
}

__device__ void ph_norm(const Params& p, int bid, int nb, char* smem) {
    float* sh = (float*)smem;
    for (int r = bid; r < NT; r += nb) {
        const float* src; int mrow;
        if (r < NCTX) { src = p.ctx + (size_t)r * DM; mrow = 8; }
        else { const int rl = r - NCTX; src = p.x + (size_t)rl * DM; mrow = rl / SEQ; }
        const float4 v = ((const float4*)src)[threadIdx.x];
        float ss = v.x * v.x + v.y * v.y + v.z * v.z + v.w * v.w;
        ss = block_sum256(ss, sh);
        const float rstd = rsqrtf(ss * (1.f / 1024.f) + EPSF);
        const float* shift = p.mod + mrow * 3072;
        const float* scale = shift + 1024;
        const int k = threadIdx.x * 4;
        float vv[4] = {v.x, v.y, v.z, v.w};
#pragma unroll
        for (int i = 0; i < 4; ++i) {
            float y = vv[i] * rstd * p.norm_w[k + i];
            y = y * (1.f + scale[k + i]) + shift[k + i];
            p.h[(size_t)r * DM + k + i] = f2bf(y);
        }
    }
}

struct EpiArgs {
    void* C; int ldc;
    const bf16_t* Pb;
    const float* M1;
    const float* x;
    const float* mod;
};
template <int EPI>
__device__ void ph_gemm_naive(const bf16_t* __restrict__ A, int lda, const float* __restrict__ W, int ldw,
                              int M, int N, int K, EpiArgs e, int bid, int nb, char* smem) {
    float (*As)[68] = (float (*)[68])smem;
    float (*Ws)[68] = (float (*)[68])(smem + 16 * 68 * 4);
    const int tid = threadIdx.x, tx = tid & 15, ty = tid >> 4;
    const int ntn = (N + 63) / 64, ntm = M / 64;
    for (int u = bid; u < ntn * ntm; u += nb) {
        const int row0 = (u / ntn) * 64, col0 = (u % ntn) * 64;
        float acc[4][4];
#pragma unroll
        for (int i = 0; i < 4; ++i)
#pragma unroll
            for (int j = 0; j < 4; ++j) acc[i][j] = 0.f;
        const int ar = tid >> 2, ak = (tid & 3) * 4;
        const int wk = tid >> 4, wn = (tid & 15) * 4;
        for (int k0 = 0; k0 < K; k0 += 16) {
            {
                const bf16_t* ap = A + (size_t)(row0 + ar) * lda + k0 + ak;
                const uint2 raw = *(const uint2*)ap;
                As[ak + 0][ar] = __uint_as_float(raw.x << 16);
                As[ak + 1][ar] = __uint_as_float(raw.x & 0xffff0000u);
                As[ak + 2][ar] = __uint_as_float(raw.y << 16);
                As[ak + 3][ar] = __uint_as_float(raw.y & 0xffff0000u);
                float4 w4 = make_float4(0.f, 0.f, 0.f, 0.f);
                if (col0 + wn < N) w4 = *(const float4*)(W + (size_t)(k0 + wk) * ldw + col0 + wn);
                Ws[wk][wn + 0] = w4.x; Ws[wk][wn + 1] = w4.y; Ws[wk][wn + 2] = w4.z; Ws[wk][wn + 3] = w4.w;
            }
            __syncthreads();
#pragma unroll
            for (int kk = 0; kk < 16; ++kk) {
                float a[4], b[4];
#pragma unroll
                for (int i = 0; i < 4; ++i) a[i] = As[kk][ty * 4 + i];
#pragma unroll
                for (int j = 0; j < 4; ++j) b[j] = Ws[kk][tx * 4 + j];
#pragma unroll
                for (int i = 0; i < 4; ++i)
#pragma unroll
                    for (int j = 0; j < 4; ++j) acc[i][j] += a[i] * b[j];
            }
            __syncthreads();
        }
#pragma unroll
        for (int i = 0; i < 4; ++i) {
            const int row = row0 + ty * 4 + i;
#pragma unroll
            for (int j = 0; j < 4; ++j) {
                const int col = col0 + tx * 4 + j;
                if (col >= N) continue;
                const float v = acc[i][j];
                if (EPI == 0) {
                    ((bf16_t*)e.C)[(size_t)row * e.ldc + col] = f2bf(v);
                } else if (EPI == 1) {
                    const float g = sigmoid_f(bf2f(e.Pb[(size_t)row * PB_W + 1024 + col]));
                    ((float*)e.C)[(size_t)row * e.ldc + col] = g * v;
                } else if (EPI == 2) {
                    const float g = sigmoid_f(bf2f(e.Pb[(size_t)row * PB_W + 2048 + col]));
                    ((bf16_t*)e.C)[(size_t)row * e.ldc + col] = f2bf(e.M1[(size_t)row * 1024 + col] + g * v);
                } else {
                    const float gate = e.mod[(row / SEQ) * 3072 + 2048 + col];
                    ((float*)e.C)[(size_t)row * e.ldc + col] = e.x[(size_t)row * DM + col] + gate * v;
                }
            }
        }
    }
}

__device__ void ph_prenorm(const Params& p, int bid, int nb, char* smem) {
    float* sh = (float*)smem;
    const int tid = threadIdx.x;
    for (int r = bid; r < NT; r += nb) {
        const bf16_t* row = p.Pa + (size_t)r * PA_W;
        {
            const float v = bf2f(row[PA_CKV + tid]);
            const float ss = block_sum256(v * v, sh);
            const float rstd = rsqrtf(ss * (1.f / 256.f) + EPSF);
            p.kvn[(size_t)r * 256 + tid] = f2bf(v * rstd * p.kv_norm_w[tid]);
        }
        if (r >= NCTX) {
            const float v0 = bf2f(row[PA_CQ + tid]);
            const float v1 = (tid < 128) ? bf2f(row[PA_CQ + 256 + tid]) : 0.f;
            const float ss = block_sum256(v0 * v0 + v1 * v1, sh);
            const float rstd = rsqrtf(ss * (1.f / 384.f) + EPSF);
            bf16_t* o = p.qn + (size_t)(r - NCTX) * 384;
            o[tid] = f2bf(v0 * rstd * p.q_norm_w[tid]);
            if (tid < 128) o[256 + tid] = f2bf(v1 * rstd * p.q_norm_w[256 + tid]);
        }
    }
}

__device__ void ph_mla_post(const Params& p, int bid, int nb, char* smem) {
    const int tid = threadIdx.x, w = tid >> 6, lane = tid & 63;
    for (int r = bid; r < NT; r += nb) {
        int b, pos, t = 0; bool lat = (r >= NCTX);
        if (!lat) { b = r / CTXL; pos = r % CTXL; }
        else { const int rl = r - NCTX; b = rl / SEQ; t = rl % SEQ; pos = CTXL + t; }
        float cs = 1.f, sn = 0.f;
        const int j = lane & 31, ax = j >> 4, ph = (j >> 3) & 1, f = j & 7;
        if (lat) {
            const float inv_freq = powf(10000.f, -(float)f / 8.f);
            const float pp = (ax == 0) ? (float)(t / 64) : (float)(t % 64);
            const float ang = pp * inv_freq;
            cs = cosf(ang); sn = sinf(ang);
        }
        const float kr = (lane < 32) ? bf2f(p.Pa[(size_t)r * PA_W + PA_KR + lane]) : 0.f;
#pragma unroll
        for (int hi = 0; hi < 2; ++hi) {
            const int hh = w * 2 + hi;
            const float k0 = bf2f(p.KVraw[(size_t)r * 1024 + hh * 128 + lane]);
            const float k1 = kr;
            const float ss = wave_sum(k0 * k0 + k1 * k1);
            const float rstd = rsqrtf(ss * (1.f / 96.f) + EPSF);
            const float kn0 = k0 * rstd * p.khn_w[lane];
            float kn1 = (lane < 32) ? k1 * rstd * p.khn_w[64 + lane] : 0.f;
            {
                const float partner = __shfl_xor(kn1, 8);
                const float t1 = ph ? partner : kn1, t2 = ph ? kn1 : partner;
                kn1 = ph ? (t1 * sn + t2 * cs) : (t1 * cs - t2 * sn);
            }
            bf16_t* kd = p.Kb + ((size_t)(b * 8 + hh) * TPB + pos) * 96;
            kd[lane] = f2bf(kn0);
            if (lane < 32) kd[64 + lane] = f2bf(kn1);
            p.Vb[((size_t)(b * 8 + hh) * TPB + pos) * 64 + lane] = p.KVraw[(size_t)r * 1024 + hh * 128 + 64 + lane];
            if (lat) {
                const int rl = r - NCTX;
                const float q0 = bf2f(p.Qraw[(size_t)rl * 768 + hh * 96 + lane]);
                const float q1 = (lane < 32) ? bf2f(p.Qraw[(size_t)rl * 768 + hh * 96 + 64 + lane]) : 0.f;
                const float qs = wave_sum(q0 * q0 + q1 * q1);
                const float qr = rsqrtf(qs * (1.f / 96.f) + EPSF);
                const float qn0 = q0 * qr * p.qhn_w[lane];
                float qn1 = (lane < 32) ? q1 * qr * p.qhn_w[64 + lane] : 0.f;
                {
                    const float partner = __shfl_xor(qn1, 8);
                    const float t1 = ph ? partner : qn1, t2 = ph ? qn1 : partner;
                    qn1 = ph ? (t1 * sn + t2 * cs) : (t1 * cs - t2 * sn);
                }
                const float qsc = 0.10206207261596575f * 1.4426950408889634f;
                bf16_t* qd = p.Qb + ((size_t)(b * 8 + hh) * SEQ + t) * 96;
                qd[lane] = f2bf(qn0 * qsc);
                if (lane < 32) qd[64 + lane] = f2bf(qn1 * qsc);
            }
        }
    }
}

__device__ void ph_dn_prep(const Params& p, int bid, int nb, char* smem) {
    const int tid = threadIdx.x, w = tid >> 6, lane = tid & 63;
    for (int r = bid; r < NT; r += nb) {
        int b, pp, seglen, base, pos;
        if (r < NCTX) { b = r / CTXL; pp = r % CTXL; seglen = CTXL; base = b * CTXL; pos = pp; }
        else { const int rl = r - NCTX; b = rl / SEQ; pp = rl % SEQ; seglen = SEQ; base = NCTX + b * SEQ; pos = CTXL + pp; }
#pragma unroll
        for (int m = 0; m < 6; ++m) {
            const int ch = tid + 256 * m;
            float y = 0.f;
#pragma unroll
            for (int jj = 0; jj < 5; ++jj) {
                const int q = pp + jj - 2;
                if (q >= 0 && q < seglen) y += bf2f(p.Pa[(size_t)(base + q) * PA_W + PA_DQ + ch]) * p.conv_w[jj * 1536 + ch];
            }
            y = silu_f(y);
            const int grp = m >> 1, hh = w + 4 * (m & 1);
            const size_t o = ((size_t)(b * 8 + hh) * TPB + pos) * 64 + lane;
            if (grp == 2) { p.dnv[o] = f2bf(y); }
            else {
                const float ss = wave_sum(y * y);
                const float rn = rsqrtf(ss + EPSF);
                if (grp == 0) p.dnq[o] = f2bf(y * rn * 0.125f);
                else p.dnk[o] = f2bf(y * rn);
            }
        }
        if (tid < 16) {
            const int d = tid >> 3, hh = tid & 7;
            const float db = bf2f(p.Pa[(size_t)r * PA_W + PA_DB + tid]);
            const float da = bf2f(p.Pa[(size_t)r * PA_W + PA_DA + tid]);
            const float xx = da + p.dt_bias[tid];
            const float sp = (xx > 20.f) ? xx : log1pf(expf(xx));
            const size_t o = ((size_t)((d * 8 + b) * 8 + hh)) * TPB + pos;
            p.beta[o] = sigmoid_f(db);
            p.gbuf[o] = -expf(p.a_log[tid]) * sp;
        }
    }
}

__device__ void ph_attn_naive(const Params& p, int bid, int nb, char* smem) {
    float (*sc)[TPB] = (float (*)[TPB])smem;
    float (*sq)[96] = (float (*)[96])(smem + 4 * TPB * 4);
    const int tid = threadIdx.x, w = tid >> 6, lane = tid & 63;
    for (int u = bid; u < 64 * (SEQ / 4); u += nb) {
        const int bh = u / (SEQ / 4);
        const int t = (u % (SEQ / 4)) * 4 + w;
        const bf16_t* qp = p.Qb + ((size_t)bh * SEQ + t) * 96;
        __syncthreads();
        sq[w][lane] = bf2f(qp[lane]);
        if (lane < 32) sq[w][64 + lane] = bf2f(qp[64 + lane]);
        __syncthreads();
        const bf16_t* kb = p.Kb + (size_t)bh * TPB * 96;
        float mx = -3.0e38f;
        for (int key = lane; key < TPB; key += 64) {
            const uint4* kp = (const uint4*)(kb + (size_t)key * 96);
            float s = 0.f;
#pragma unroll
            for (int c = 0; c < 12; ++c) {
                const uint4 uq = kp[c];
                const uint32_t uu[4] = {uq.x, uq.y, uq.z, uq.w};
#pragma unroll
                for (int e = 0; e < 4; ++e) {
                    s += sq[w][c * 8 + e * 2] * __uint_as_float(uu[e] << 16);
                    s += sq[w][c * 8 + e * 2 + 1] * __uint_as_float(uu[e] & 0xffff0000u);
                }
            }
            sc[w][key] = s;
            mx = fmaxf(mx, s);
        }
        mx = wave_max(mx);
        float l = 0.f;
        for (int key = lane; key < TPB; key += 64) {
            const float pr = exp2f(sc[w][key] - mx);
            sc[w][key] = pr;
            l += pr;
        }
        l = wave_sum(l);
        __syncthreads();
        const bf16_t* vb = p.Vb + (size_t)bh * TPB * 64;
        float o = 0.f;
        for (int key = 0; key < TPB; ++key) o += sc[w][key] * bf2f(vb[(size_t)key * 64 + lane]);
        o /= l;
        const int b = bh >> 3, hh = bh & 7;
        p.o_mla[((size_t)(b * SEQ + t)) * 512 + hh * 64 + lane] = f2bf(o);
    }
}

__device__ void ph_dn_scan_naive(const Params& p, int idx, int lane) {
    const int d = idx >> 6, b = (idx >> 3) & 7, hh = idx & 7;
    const size_t cb = (size_t)(b * 8 + hh) * TPB;
    const float* bt = p.beta + (size_t)((d * 8 + b) * 8 + hh) * TPB;
    const float* gg = p.gbuf + (size_t)((d * 8 + b) * 8 + hh) * TPB;
    bf16_t* O = d ? p.Ob : p.Of;
    float S[64];
#pragma unroll
    for (int i = 0; i < 64; ++i) S[i] = 0.f;
    for (int s = 0; s < TPB; ++s) {
        int pos;
        if (d == 0) pos = s; else pos = (s < CTXL) ? (CTXL - 1 - s) : (TPB - 1 - (s - CTXL));
        const float kk = bf2f(p.dnk[(cb + pos) * 64 + lane]);
        const float qq = bf2f(p.dnq[(cb + pos) * 64 + lane]);
        const float vv = bf2f(p.dnv[(cb + pos) * 64 + lane]);
        const float a = expf(gg[pos]);
        const float be = bt[pos];
        float pred = 0.f;
#pragma unroll
        for (int i = 0; i < 64; ++i) pred += __shfl(kk, i) * S[i];
        pred *= a;
        const float vn = be * (vv - pred);
        float o = 0.f;
#pragma unroll
        for (int i = 0; i < 64; ++i) {
            S[i] = a * S[i] + __shfl(kk, i) * vn;
            o += __shfl(qq, i) * S[i];
        }
        if (pos >= CTXL) O[((size_t)(b * SEQ + pos - CTXL)) * 512 + hh * 64 + lane] = f2bf(o);
    }
}

__device__ void ph_merge_prep(const Params& p, int bid, int nb, char* smem) {
    const int tid = threadIdx.x, lane = tid & 63;
    for (int rl = bid; rl < NL; rl += nb) {
#pragma unroll
        for (int m = 0; m < 2; ++m) {
            const int c = tid + 256 * m;
            const size_t o = (size_t)rl * 512 + c;
            const float zm = bf2f(p.Pb[(size_t)rl * PB_W + c]);
            const float zd = bf2f(p.Pb[(size_t)rl * PB_W + 512 + c]);
            p.A_mla[o] = f2bf(bf2f(p.o_mla[o]) * silu_f(zm));
            const float v = bf2f(p.Of[o]) + bf2f(p.Ob[o]);
            const float ss = wave_sum(v * v);
            const float rstd = rsqrtf(ss * (1.f / 64.f) + EPSF);
            p.A_dn[o] = f2bf(v * rstd * p.dn_norm_w[lane] * silu_f(zd));
        }
    }
}

__global__ void __launch_bounds__(NTHR) fwd_megakernel(Params p) {
    __shared__ __attribute__((aligned(16))) char smem[SMEM_BYTES];
    cg::grid_group grid = cg::this_grid();
    const int bid = blockIdx.x, nb = gridDim.x;
    EpiArgs e{};

    ph_mod(p, bid, nb, smem);
    grid.sync();
    ph_norm(p, bid, nb, smem);
    grid.sync();
    e.C = p.Pa; e.ldc = PA_W;
    ph_gemm_naive<0>(p.h, DM, p.w_in + 0, IN_DIM, NT, 672, DM, e, bid, nb, smem);
    e.C = p.Pa + PA_DQ;
    ph_gemm_naive<0>(p.h, DM, p.w_in + 1184, IN_DIM, NT, 1536, DM, e, bid, nb, smem);
    e.C = p.Pa + PA_DB;
    ph_gemm_naive<0>(p.h, DM, p.w_in + 3232, IN_DIM, NT, 32, DM, e, bid, nb, smem);
    const bf16_t* hl = p.h + (size_t)NCTX * DM;
    e.C = p.Pb; e.ldc = PB_W;
    ph_gemm_naive<0>(hl, DM, p.w_in + 672, IN_DIM, NL, 512, DM, e, bid, nb, smem);
    e.C = p.Pb + 512;
    ph_gemm_naive<0>(hl, DM, p.w_in + 2720, IN_DIM, NL, 512, DM, e, bid, nb, smem);
    e.C = p.Pb + 1024;
    ph_gemm_naive<0>(hl, DM, p.w_in + 3264, IN_DIM, NL, 2048, DM, e, bid, nb, smem);
    grid.sync();
    ph_prenorm(p, bid, nb, smem);
    grid.sync();
    e.C = p.Qraw; e.ldc = 768;
    ph_gemm_naive<0>(p.qn, 384, p.w_uq, 768, NL, 768, 384, e, bid, nb, smem);
    e.C = p.KVraw; e.ldc = 1024;
    ph_gemm_naive<0>(p.kvn, 256, p.w_ukv, 1024, NT, 1024, 256, e, bid, nb, smem);
    grid.sync();
    ph_mla_post(p, bid, nb, smem);
    ph_dn_prep(p, bid, nb, smem);
    grid.sync();
    if (bid >= nb - 128) {
        if ((threadIdx.x >> 6) == 0) ph_dn_scan_naive(p, bid - (nb - 128), threadIdx.x & 63);
        __syncthreads();
    }
    ph_attn_naive(p, bid, nb, smem);
    grid.sync();
    ph_merge_prep(p, bid, nb, smem);
    grid.sync();
    e.C = p.M1; e.ldc = 1024; e.Pb = p.Pb;
    ph_gemm_naive<1>(p.A_mla, 512, p.mla_w_o, 1024, NL, 1024, 512, e, bid, nb, smem);
    grid.sync();
    e.C = p.Mb; e.ldc = 1024; e.M1 = p.M1;
    ph_gemm_naive<2>(p.A_dn, 512, p.dn_w_o, 1024, NL, 1024, 512, e, bid, nb, smem);
    grid.sync();
    e.C = p.out; e.ldc = 1024; e.x = p.x; e.mod = p.mod;
    ph_gemm_naive<3>(p.Mb, 1024, p.w_out, 1024, NL, 1024, 1024, e, bid, nb, smem);
}

extern "C" void kernel_launch(void* const* d_in, const int* in_sizes, int n_in,
                              void* d_out, int out_size, void* d_ws, size_t ws_size,
                              hipStream_t stream) {
    static int grid_blocks = 0;
    if (!grid_blocks) {
        int dev = 0, cus = 0, per_cu = 0;
        (void)hipGetDevice(&dev);
        (void)hipDeviceGetAttribute(&cus, hipDeviceAttributeMultiprocessorCount, dev);
        (void)hipOccupancyMaxActiveBlocksPerMultiprocessor(&per_cu, fwd_megakernel, NTHR, 0);
        if (per_cu > 2) per_cu = 2;
        if (per_cu < 1) per_cu = 1;
        grid_blocks = cus * per_cu;
    }
    Params p{};
    const float** fp = (const float**)&p;
    for (int i = 0; i < 21; ++i) fp[i] = (const float*)d_in[i];
    p.out = (float*)d_out;
    char* ws = (char*)d_ws;
    char* ob = (char*)d_out;
    const size_t R_H = 0;
    const size_t R_PA = 37748736;
    const size_t R_PB = R_PA + 82575360;
    const size_t R_F = R_PB + 100663296;
    p.h = (bf16_t*)(ws + R_H);
    p.Pa = (bf16_t*)(ws + R_PA);
    p.Pb = (bf16_t*)(ws + R_PB);
    p.Qb = (bf16_t*)(ws + R_F);
    p.Vb = (bf16_t*)(ws + R_F + 25165824);
    p.mod = (float*)(ws + R_F + 25165824 + 18874368);
    p.qn = (bf16_t*)(ws + R_H);
    p.kvn = (bf16_t*)(ws + R_H + 12582912);
    p.Qraw = (bf16_t*)(ob);
    p.KVraw = (bf16_t*)(ob + 25165824);
    p.Kb = (bf16_t*)(ws + R_H);
    p.dnq = (bf16_t*)(ob);
    p.dnk = (bf16_t*)(ob + 18874368);
    p.dnv = (bf16_t*)(ob + 2 * 18874368);
    p.beta = (float*)(ob + 3 * 18874368);
    p.gbuf = (float*)(ob + 3 * 18874368 + 1179648);
    p.o_mla = (bf16_t*)(ws + R_PA);
    p.Of = (bf16_t*)(ws + R_PA + 16777216);
    p.Ob = (bf16_t*)(ws + R_PA + 2 * 16777216);
    p.A_mla = (bf16_t*)(ws + R_F);
    p.A_dn = (bf16_t*)(ws + R_F + 16777216);
    p.M1 = (float*)(ob);
    p.Mb = (bf16_t*)(ws + R_H);
    void* args[] = {&p};
    hipError_t err = hipLaunchCooperativeKernel((void*)fwd_megakernel, dim3(grid_blocks), dim3(NTHR), args, 0, stream);
    if (err != hipSuccess) fprintf(stderr, "cooperative launch failed: %s (grid %d)\n", hipGetErrorString(err), grid_blocks);
}
```

```cpp
#include <hip/hip_runtime.h>
#include <hip/hip_cooperative_groups.h>
#include <stdint.h>
#include <cstdio>
namespace cg = cooperative_groups;

typedef uint16_t bf16_t;

#define NB 8
#define SEQ 2048
#define CTXL 256
#define TPB 2304
#define NCTX 2048
#define NL 16384
#define NT 18432
#define DM 1024
#define IN_DIM 5312
#define PA_W 2304
#define PZ_W 1024
#define PG_W 2048
#define PA_CQ 0
#define PA_CKV 384
#define PA_KR 640
#define PA_DQ 672
#define PA_DK 1184
#define PA_DV 1696
#define PA_DB 2208
#define PA_DA 2224
#define EPSF 1e-6f
#define NTHR 256
#define SMEM_BYTES 77824

struct Params {
    const float *x, *c, *ctx, *c_ctx, *w_mod, *b_mod, *norm_w, *w_in, *q_norm_w, *w_uq, *kv_norm_w, *w_ukv, *qhn_w, *khn_w,
        *mla_w_o, *conv_w, *a_log, *dt_bias, *dn_norm_w, *dn_w_o, *w_out;
    float* out;
    bf16_t *h, *Pa, *Pz, *Pg, *Qb, *Vt, *qn, *kvn, *Qraw, *KVraw, *Kb, *o_mla, *MH, *EF, *ST, *A_mla, *A_dn, *Mb;
    bf16_t *Wt_a, *Wt_z, *Wt_g, *Wt_uq, *Wt_ukv, *Wt_mo, *Wt_do, *Wt_out;
    float *mod;
};

__device__ __forceinline__ float bf2f(bf16_t v) { return __uint_as_float(((uint32_t)v) << 16); }
__device__ __forceinline__ bf16_t f2bf(float f) {
    uint32_t u = __float_as_uint(f);
    u += 0x7fffu + ((u >> 16) & 1u);
    return (bf16_t)(u >> 16);
}
__device__ __forceinline__ float silu_f(float v) { return v / (1.f + expf(-v)); }
__device__ __forceinline__ float sigmoid_f(float v) { return 1.f / (1.f + expf(-v)); }
__device__ __forceinline__ float wave_sum(float v) {
#pragma unroll
    for (int o = 32; o > 0; o >>= 1) v += __shfl_xor(v, o);
    return v;
}
__device__ __forceinline__ float wave_max(float v) {
#pragma unroll
    for (int o = 32; o > 0; o >>= 1) v = fmaxf(v, __shfl_xor(v, o));
    return v;
}
__device__ __forceinline__ float block_sum256(float v, float* sh) {
    v = wave_sum(v);
    __syncthreads();
    if ((threadIdx.x & 63) == 0) sh[threadIdx.x >> 6] = v;
    __syncthreads();
    return sh[0] + sh[1] + sh[2] + sh[3];
}

__device__ __forceinline__ void ph_mod(const Params& p, int bid, int nb, char* smem) {
    float* sc = (float*)smem;
    if (bid >= 12) return;
    for (int i = threadIdx.x; i < 9 * 1024; i += NTHR) {
        int r = i >> 10, k = i & 1023;
        float v = (r < 8) ? p.c[r * 1024 + k] : p.c_ctx[k];
        sc[i] = silu_f(v);
    }
    __syncthreads();
    const int j = bid * 256 + threadIdx.x;
    float acc[9];
#pragma unroll
    for (int r = 0; r < 9; ++r) acc[r] = 0.f;
    for (int k = 0; k < 1024; ++k) {
        const float w = p.w_mod[(size_t)k * 3072 + j];
#pragma unroll
        for (int r = 0; r < 9; ++r) acc[r] += sc[r * 1024 + k] * w;
    }
    const float bb = p.b_mod[j];
#pragma unroll
    for (int r = 0; r < 9; ++r) p.mod[r * 3072 + j] = acc[r] + bb;
    __syncthreads();
}

__device__ __forceinline__ void ph_norm(const Params& p, int bid, int nb, char* smem) {
    float* sh = (float*)smem;
    for (int r = bid; r < NT; r += nb) {
        const float* src; int mrow;
        if (r < NCTX) { src = p.ctx + (size_t)r * DM; mrow = 8; }
        else { const int rl = r - NCTX; src = p.x + (size_t)rl * DM; mrow = rl / SEQ; }
        const float4 v = ((const float4*)src)[threadIdx.x];
        float ss = v.x * v.x + v.y * v.y + v.z * v.z + v.w * v.w;
        ss = block_sum256(ss, sh);
        const float rstd = rsqrtf(ss * (1.f / 1024.f) + EPSF);
        const float* shift = p.mod + mrow * 3072;
        const float* scale = shift + 1024;
        const int k = threadIdx.x * 4;
        float vv[4] = {v.x, v.y, v.z, v.w};
#pragma unroll
        for (int i = 0; i < 4; ++i) {
            float y = vv[i] * rstd * p.norm_w[k + i];
            y = y * (1.f + scale[k + i]) + shift[k + i];
            p.h[(size_t)r * DM + k + i] = f2bf(y);
        }
    }
}

typedef __bf16 bf16v2_t __attribute__((ext_vector_type(2)));
typedef float f32x2 __attribute__((ext_vector_type(2)));
__device__ __forceinline__ uint32_t pack_bf2(float lo, float hi) {
    f32x2 v = {lo, hi};
    bf16v2_t b = __builtin_convertvector(v, bf16v2_t);
    return __builtin_bit_cast(uint32_t, b);
}

__device__ __forceinline__ void wprep_unit(const float* __restrict__ W, int ldw, int K, int n0, int k0, int srcbase, bf16_t* __restrict__ dst, float* tile) {
    const int tid = threadIdx.x;
    {
        const int n4 = (tid & 7) * 4, kk = tid >> 3;
#pragma unroll
        for (int half = 0; half < 2; ++half) {
            const int k = kk + 32 * half;
            float4 v = make_float4(0.f, 0.f, 0.f, 0.f);
            if (srcbase >= 0) v = *(const float4*)(W + (size_t)(k0 + k) * ldw + srcbase + n4);
            float* t = tile + k * 33 + n4;
            t[0] = v.x; t[1] = v.y; t[2] = v.z; t[3] = v.w;
        }
    }
    __syncthreads();
    {
        const int n = tid >> 3, kc = tid & 7;
        const float* t = tile + (kc * 8) * 33 + n;
        uint4 o;
        o.x = pack_bf2(t[0 * 33], t[1 * 33]); o.y = pack_bf2(t[2 * 33], t[3 * 33]);
        o.z = pack_bf2(t[4 * 33], t[5 * 33]); o.w = pack_bf2(t[6 * 33], t[7 * 33]);
        *(uint4*)(dst + (size_t)(n0 + n) * K + k0 + kc * 8) = o;
    }
    __syncthreads();
}

__device__ __forceinline__ void ph_wprep(const Params& p, int bid, int nb, char* smem) {
    float* tile = (float*)smem;
    const int U0 = 72 * 16, U1 = 32 * 16, U2 = 64 * 16, U3 = 24 * 6, U4 = 32 * 4, U5 = 32 * 8, U6 = 32 * 8, U7 = 32 * 16;
    const int UT = U0 + U1 + U2 + U3 + U4 + U5 + U6 + U7;
    for (int u = bid; u < UT; u += nb) {
        int v = u;
        const float* W; int ldw, K; bf16_t* dst; int job;
        if (v < U0) { job = 0; W = p.w_in; ldw = IN_DIM; K = 1024; dst = p.Wt_a; }
        else if ((v -= U0) < U1) { job = 1; W = p.w_in; ldw = IN_DIM; K = 1024; dst = p.Wt_z; }
        else if ((v -= U1) < U2) { job = 2; W = p.w_in; ldw = IN_DIM; K = 1024; dst = p.Wt_g; }
        else if ((v -= U2) < U3) { job = 3; W = p.w_uq; ldw = 768; K = 384; dst = p.Wt_uq; }
        else if ((v -= U3) < U4) { job = 4; W = p.w_ukv; ldw = 1024; K = 256; dst = p.Wt_ukv; }
        else if ((v -= U4) < U5) { job = 5; W = p.mla_w_o; ldw = 1024; K = 512; dst = p.Wt_mo; }
        else if ((v -= U5) < U6) { job = 6; W = p.dn_w_o; ldw = 1024; K = 512; dst = p.Wt_do; }
        else { v -= U6; job = 7; W = p.w_out; ldw = 1024; K = 1024; dst = p.Wt_out; }
        const int nkt = K / 64;
        const int n0 = (v / nkt) * 32, k0 = (v % nkt) * 64;
        int srcbase = n0;
        if (job == 0) srcbase = (n0 < 672) ? n0 : (n0 < 2208) ? n0 + 512 : (n0 < 2240) ? n0 + 1024 : -1;
        else if (job == 1) srcbase = (n0 < 512) ? 672 + n0 : 2208 + n0;
        else if (job == 2) srcbase = 3264 + n0;
        wprep_unit(W, ldw, K, n0, k0, srcbase, dst, tile);
    }
}

typedef short bf16x8 __attribute__((ext_vector_type(8)));
typedef float f32x4 __attribute__((ext_vector_type(4)));
typedef unsigned u32x4 __attribute__((ext_vector_type(4)));

__device__ __forceinline__ int lds_off(int row, int chunk) { return row * 128 + (((chunk ^ (row >> 1)) & 7) << 4); }

template <int NTN>
__device__ __forceinline__ void gemm_tile_acc(f32x4 (&acc)[NTN][4], const bf16_t* __restrict__ A, int lda, const bf16_t* __restrict__ Bt, int ldb,
                                              int K, int m0, int n0, char* smem) {
    const int tid = threadIdx.x, lane = tid & 63, w = tid >> 6, wm = w >> 1, wn = w & 1;
    const int l15 = lane & 15, lq = lane >> 4;
    const int srow = tid >> 3, sch = tid & 7;
    u32x4 ra[4], rb[NTN];
    const bf16_t* ap = A + (size_t)(m0 + srow) * lda + sch * 8;
    const bf16_t* bp = Bt + (size_t)(n0 + srow) * ldb + sch * 8;
    int KT = K >> 6;
    asm volatile("" : "+s"(KT));
#pragma unroll
    for (int i = 0; i < 4; ++i) ra[i] = *(const u32x4*)(ap + (size_t)(32 * i) * lda);
#pragma unroll
    for (int i = 0; i < NTN; ++i) rb[i] = *(const u32x4*)(bp + (size_t)(32 * i) * ldb);
#pragma unroll
    for (int i = 0; i < 4; ++i) *(u32x4*)(smem + lds_off(srow + 32 * i, sch)) = ra[i];
#pragma unroll
    for (int i = 0; i < NTN; ++i) *(u32x4*)(smem + 16384 + lds_off(srow + 32 * i, sch)) = rb[i];
    __syncthreads();
    for (int kt = 0; kt < KT; ++kt) {
        if (kt + 1 < KT) {
#pragma unroll
            for (int i = 0; i < 4; ++i) ra[i] = *(const u32x4*)(ap + (size_t)(32 * i) * lda + (kt + 1) * 64);
#pragma unroll
            for (int i = 0; i < NTN; ++i) rb[i] = *(const u32x4*)(bp + (size_t)(32 * i) * ldb + (kt + 1) * 64);
        }
        const char* sa = smem + (kt & 1) * 32768;
        const char* sb = sa + 16384;
#pragma unroll
        for (int ks = 0; ks < 2; ++ks) {
            bf16x8 af[4], bfr[NTN];
#pragma unroll
            for (int mt = 0; mt < 4; ++mt) af[mt] = *(const bf16x8*)(sa + lds_off(wm * 64 + mt * 16 + l15, ks * 4 + lq));
#pragma unroll
            for (int nt = 0; nt < NTN; ++nt) bfr[nt] = *(const bf16x8*)(sb + lds_off(wn * (16 * NTN) + nt * 16 + l15, ks * 4 + lq));
#pragma unroll
            for (int nt = 0; nt < NTN; ++nt)
#pragma unroll
                for (int mt = 0; mt < 4; ++mt)
                    acc[nt][mt] = __builtin_amdgcn_mfma_f32_16x16x32_bf16(bfr[nt], af[mt], acc[nt][mt], 0, 0, 0);
        }
        if (kt + 1 < KT) {
            char* da = smem + ((kt + 1) & 1) * 32768;
#pragma unroll
            for (int i = 0; i < 4; ++i) *(u32x4*)(da + lds_off(srow + 32 * i, sch)) = ra[i];
#pragma unroll
            for (int i = 0; i < NTN; ++i) *(u32x4*)(da + 16384 + lds_off(srow + 32 * i, sch)) = rb[i];
        }
        __syncthreads();
    }
}

template <int NTN>
__device__ __forceinline__ void acc_zero(f32x4 (&acc)[NTN][4]) {
#pragma unroll
    for (int i = 0; i < NTN; ++i)
#pragma unroll
        for (int j = 0; j < 4; ++j) acc[i][j] = (f32x4){0.f, 0.f, 0.f, 0.f};
}

__device__ __forceinline__ bool next_unit(int it, int U, int bid, int nb, int& u) {
    const int x = bid & 7, li = bid >> 3, per = nb >> 3;
    const int lo = (int)(((long)U * x) >> 3), hi = (int)(((long)U * (x + 1)) >> 3);
    u = lo + li + it * per;
    return u < hi;
}
__device__ __forceinline__ void unit_mn(int u, int ntn, int& tm, int& tn) {
    const int g = u / (8 * ntn), r = u % (8 * ntn);
    tm = g * 8 + (r & 7); tn = r >> 3;
}

__device__ __forceinline__ void st_bf4(bf16_t* p, f32x4 v) {
    uint2 o; o.x = pack_bf2(v[0], v[1]); o.y = pack_bf2(v[2], v[3]);
    *(uint2*)p = o;
}
__device__ __forceinline__ f32x4 ld_bf4(const bf16_t* p) {
    const uint2 r = *(const uint2*)p;
    return (f32x4){__uint_as_float(r.x << 16), __uint_as_float(r.x & 0xffff0000u), __uint_as_float(r.y << 16), __uint_as_float(r.y & 0xffff0000u)};
}
#define EPI_COORDS const int lane_ = threadIdx.x & 63, w_ = threadIdx.x >> 6, wm_ = w_ >> 1, wn_ = w_ & 1, l15_ = lane_ & 15, lq_ = lane_ >> 4;
#define EPI_ROW(mt) (m0 + wm_ * 64 + (mt) * 16 + l15_)
#define EPI_COL(nt) (n0 + wn_ * 64 + (nt) * 16 + lq_ * 4)
#define EPI_COL2(nt) (n0 + wn_ * 32 + (nt) * 16 + lq_ * 4)

__device__ __forceinline__ void gemm_store_bf16(const bf16_t* A, int lda, const bf16_t* Bt, int K, int tm, int tn, bf16_t* C, int ldc, char* smem) {
    f32x4 acc[4][4];
    acc_zero<4>(acc);
    const int m0 = tm * 128, n0 = tn * 128;
    gemm_tile_acc<4>(acc, A, lda, Bt, K, K, m0, n0, smem);
    EPI_COORDS
#pragma unroll
    for (int nt = 0; nt < 4; ++nt)
#pragma unroll
        for (int mt = 0; mt < 4; ++mt) st_bf4(C + (size_t)EPI_ROW(mt) * ldc + EPI_COL(nt), acc[nt][mt]);
}

__device__ __forceinline__ void ph_prenorm(const Params& p, int bid, int nb, char* smem) {
    float* sh = (float*)smem;
    const int tid = threadIdx.x;
    for (int r = bid; r < NT; r += nb) {
        const bf16_t* row = p.Pa + (size_t)r * PA_W;
        {
            const float v = bf2f(row[PA_CKV + tid]);
            const float ss = block_sum256(v * v, sh);
            const float rstd = rsqrtf(ss * (1.f / 256.f) + EPSF);
            p.kvn[(size_t)r * 256 + tid] = f2bf(v * rstd * p.kv_norm_w[tid]);
        }
        if (r >= NCTX) {
            const float v0 = bf2f(row[PA_CQ + tid]);
            const float v1 = (tid < 128) ? bf2f(row[PA_CQ + 256 + tid]) : 0.f;
            const float ss = block_sum256(v0 * v0 + v1 * v1, sh);
            const float rstd = rsqrtf(ss * (1.f / 384.f) + EPSF);
            bf16_t* o = p.qn + (size_t)(r - NCTX) * 384;
            o[tid] = f2bf(v0 * rstd * p.q_norm_w[tid]);
            if (tid < 128) o[256 + tid] = f2bf(v1 * rstd * p.q_norm_w[256 + tid]);
        }
    }
}

__device__ __forceinline__ void ph_mla_post(const Params& p, int bid, int nb, char* smem) {
    const int tid = threadIdx.x, w = tid >> 6, lane = tid & 63;
    for (int r = bid; r < NT; r += nb) {
        int b, pos, t = 0; bool lat = (r >= NCTX);
        if (!lat) { b = r / CTXL; pos = r % CTXL; }
        else { const int rl = r - NCTX; b = rl / SEQ; t = rl % SEQ; pos = CTXL + t; }
        float cs = 1.f, sn = 0.f;
        const int j = lane & 31, ax = j >> 4, ph = (j >> 3) & 1, f = j & 7;
        if (lat) {
            const float inv_freq = powf(10000.f, -(float)f / 8.f);
            const float pp = (ax == 0) ? (float)(t / 64) : (float)(t % 64);
            const float ang = pp * inv_freq;
            cs = cosf(ang); sn = sinf(ang);
        }
        const float kr = (lane < 32) ? bf2f(p.Pa[(size_t)r * PA_W + PA_KR + lane]) : 0.f;
#pragma unroll
        for (int hi = 0; hi < 2; ++hi) {
            const int hh = w * 2 + hi;
            const float k0 = bf2f(p.KVraw[(size_t)r * 1024 + hh * 128 + lane]);
            const float k1 = kr;
            const float ss = wave_sum(k0 * k0 + k1 * k1);
            const float rstd = rsqrtf(ss * (1.f / 96.f) + EPSF);
            const float kn0 = k0 * rstd * p.khn_w[lane];
            float kn1 = (lane < 32) ? k1 * rstd * p.khn_w[64 + lane] : 0.f;
            {
                const float partner = __shfl_xor(kn1, 8);
                const float t1 = ph ? partner : kn1, t2 = ph ? kn1 : partner;
                kn1 = ph ? (t1 * sn + t2 * cs) : (t1 * cs - t2 * sn);
            }
            bf16_t* kd = p.Kb + ((size_t)(b * 8 + hh) * TPB + pos) * 96;
            kd[lane] = f2bf(kn0);
            if (lane < 32) kd[64 + lane] = f2bf(kn1);
            {
                const int kpos = (pos & ~12) | ((pos & 4) << 1) | ((pos & 8) >> 1);
                p.Vt[((size_t)(b * 8 + hh) * 64 + lane) * TPB + kpos] = p.KVraw[(size_t)r * 1024 + hh * 128 + 64 + lane];
            }
            if (lat) {
                const int rl = r - NCTX;
                const float q0 = bf2f(p.Qraw[(size_t)rl * 768 + hh * 96 + lane]);
                const float q1 = (lane < 32) ? bf2f(p.Qraw[(size_t)rl * 768 + hh * 96 + 64 + lane]) : 0.f;
                const float qs = wave_sum(q0 * q0 + q1 * q1);
                const float qr = rsqrtf(qs * (1.f / 96.f) + EPSF);
                const float qn0 = q0 * qr * p.qhn_w[lane];
                float qn1 = (lane < 32) ? q1 * qr * p.qhn_w[64 + lane] : 0.f;
                {
                    const float partner = __shfl_xor(qn1, 8);
                    const float t1 = ph ? partner : qn1, t2 = ph ? qn1 : partner;
                    qn1 = ph ? (t1 * sn + t2 * cs) : (t1 * cs - t2 * sn);
                }
                const float qsc = 0.10206207261596575f * 1.4426950408889634f;
                bf16_t* qd = p.Qb + ((size_t)(b * 8 + hh) * SEQ + t) * 96;
                qd[lane] = f2bf(qn0 * qsc);
                if (lane < 32) qd[64 + lane] = f2bf(qn1 * qsc);
            }
        }
    }
}

typedef float f32x16 __attribute__((ext_vector_type(16)));
#define ATT_KROW 208
#define ATT_VROW 144
#define ATT_KBYTES (64 * ATT_KROW)
#define ATT_STAGE (ATT_KBYTES + 64 * ATT_VROW)
__device__ __forceinline__ void ph_attn(const Params& p, int bid, int nb, char* smem) {
    const int tid = threadIdx.x, lane = tid & 63, w = tid >> 6, r = lane & 31, h = lane >> 5;
    int u;
    for (int it = 0; next_unit(it, 1024, bid, nb, u); ++it) {
        const int bh = u >> 4, qb = u & 15;
        bf16x8 qf[6];
        {
            const bf16_t* Qp = p.Qb + ((size_t)bh * SEQ + qb * 128 + w * 32 + r) * 96 + h * 8;
#pragma unroll
            for (int s = 0; s < 6; ++s) qf[s] = *(const bf16x8*)(Qp + s * 16);
        }
        const bf16_t* Kg = p.Kb + (size_t)bh * TPB * 96 + tid * 8;
        const bf16_t* Vg = p.Vt + (size_t)bh * 64 * TPB + (size_t)(tid >> 3) * TPB + (tid & 7) * 8;
        int koff[3], voff[2];
#pragma unroll
        for (int i = 0; i < 3; ++i) { const int c = tid + 256 * i; koff[i] = (c / 12) * ATT_KROW + (c % 12) * 16; }
#pragma unroll
        for (int i = 0; i < 2; ++i) { const int c = tid + 256 * i; voff[i] = ATT_KBYTES + (c >> 3) * ATT_VROW + (c & 7) * 16; }
        u32x4 rk[3], rv[2];
#pragma unroll
        for (int i = 0; i < 3; ++i) rk[i] = *(const u32x4*)(Kg + i * 2048);
#pragma unroll
        for (int i = 0; i < 2; ++i) rv[i] = *(const u32x4*)(Vg + (size_t)(32 * i) * TPB);
#pragma unroll
        for (int i = 0; i < 3; ++i) *(u32x4*)(smem + koff[i]) = rk[i];
#pragma unroll
        for (int i = 0; i < 2; ++i) *(u32x4*)(smem + voff[i]) = rv[i];
        __syncthreads();
        f32x16 o0, o1;
#pragma unroll
        for (int i = 0; i < 16; ++i) { o0[i] = 0.f; o1[i] = 0.f; }
        float m = -1.0e30f, l = 0.f;
        int NKT = TPB / 64;
        asm volatile("" : "+s"(NKT));
        for (int kt = 0; kt < NKT; ++kt) {
            if (kt + 1 < NKT) {
#pragma unroll
                for (int i = 0; i < 3; ++i) rk[i] = *(const u32x4*)(Kg + (size_t)(kt + 1) * 6144 + i * 2048);
#pragma unroll
                for (int i = 0; i < 2; ++i) rv[i] = *(const u32x4*)(Vg + (size_t)(32 * i) * TPB + (kt + 1) * 64);
            }
            const char* sk = smem + (kt & 1) * ATT_STAGE;
            const char* sv = sk + ATT_KBYTES;
            f32x16 s0, s1;
#pragma unroll
            for (int i = 0; i < 16; ++i) { s0[i] = 0.f; s1[i] = 0.f; }
#pragma unroll
            for (int s = 0; s < 6; ++s) {
                const bf16x8 k0 = *(const bf16x8*)(sk + r * ATT_KROW + (2 * s + h) * 16);
                const bf16x8 k1 = *(const bf16x8*)(sk + (32 + r) * ATT_KROW + (2 * s + h) * 16);
                s0 = __builtin_amdgcn_mfma_f32_32x32x16_bf16(k0, qf[s], s0, 0, 0, 0);
                s1 = __builtin_amdgcn_mfma_f32_32x32x16_bf16(k1, qf[s], s1, 0, 0, 0);
            }
            float mx = fmaxf(s0[0], s1[0]);
#pragma unroll
            for (int i = 1; i < 16; ++i) mx = fmaxf(mx, fmaxf(s0[i], s1[i]));
            mx = fmaxf(mx, __shfl_xor(mx, 32));
            const float mn = fmaxf(m, mx);
            const float alpha = __builtin_amdgcn_exp2f(m - mn);
            m = mn;
            float ls = 0.f;
#pragma unroll
            for (int i = 0; i < 16; ++i) {
                s0[i] = __builtin_amdgcn_exp2f(s0[i] - mn);
                s1[i] = __builtin_amdgcn_exp2f(s1[i] - mn);
                ls += s0[i] + s1[i];
            }
            l = l * alpha + ls;
#pragma unroll
            for (int i = 0; i < 16; ++i) { o0[i] *= alpha; o1[i] *= alpha; }
#pragma unroll
            for (int ks = 0; ks < 4; ++ks) {
                u32x4 pw;
                if (ks < 2) {
                    pw[0] = pack_bf2(s0[8 * (ks & 1) + 0], s0[8 * (ks & 1) + 1]); pw[1] = pack_bf2(s0[8 * (ks & 1) + 2], s0[8 * (ks & 1) + 3]);
                    pw[2] = pack_bf2(s0[8 * (ks & 1) + 4], s0[8 * (ks & 1) + 5]); pw[3] = pack_bf2(s0[8 * (ks & 1) + 6], s0[8 * (ks & 1) + 7]);
                } else {
                    pw[0] = pack_bf2(s1[8 * (ks & 1) + 0], s1[8 * (ks & 1) + 1]); pw[1] = pack_bf2(s1[8 * (ks & 1) + 2], s1[8 * (ks & 1) + 3]);
                    pw[2] = pack_bf2(s1[8 * (ks & 1) + 4], s1[8 * (ks & 1) + 5]); pw[3] = pack_bf2(s1[8 * (ks & 1) + 6], s1[8 * (ks & 1) + 7]);
                }
                const bf16x8 pf = __builtin_bit_cast(bf16x8, pw);
                const bf16x8 v0 = *(const bf16x8*)(sv + r * ATT_VROW + (2 * ks + h) * 16);
                const bf16x8 v1 = *(const bf16x8*)(sv + (32 + r) * ATT_VROW + (2 * ks + h) * 16);
                o0 = __builtin_amdgcn_mfma_f32_32x32x16_bf16(v0, pf, o0, 0, 0, 0);
                o1 = __builtin_amdgcn_mfma_f32_32x32x16_bf16(v1, pf, o1, 0, 0, 0);
            }
            if (kt + 1 < NKT) {
                char* ds = smem + ((kt + 1) & 1) * ATT_STAGE;
#pragma unroll
                for (int i = 0; i < 3; ++i) *(u32x4*)(ds + koff[i]) = rk[i];
#pragma unroll
                for (int i = 0; i < 2; ++i) *(u32x4*)(ds + voff[i]) = rv[i];
            }
            __syncthreads();
        }
        l += __shfl_xor(l, 32);
        const float inv = 1.f / l;
        const int b = bh >> 3, hh = bh & 7;
        bf16_t* op = p.o_mla + ((size_t)(b * SEQ + qb * 128 + w * 32 + r)) * 512 + hh * 64 + 4 * h;
#pragma unroll
        for (int g = 0; g < 4; ++g) {
            uint2 a, c;
            a.x = pack_bf2(o0[4 * g + 0] * inv, o0[4 * g + 1] * inv); a.y = pack_bf2(o0[4 * g + 2] * inv, o0[4 * g + 3] * inv);
            c.x = pack_bf2(o1[4 * g + 0] * inv, o1[4 * g + 1] * inv); c.y = pack_bf2(o1[4 * g + 2] * inv, o1[4 * g + 3] * inv);
            *(uint2*)(op + 8 * g) = a;
            *(uint2*)(op + 32 + 8 * g) = c;
        }
    }
}

__device__ __forceinline__ int el_off(int row, int col) { return lds_off(row, col >> 3) + (col & 7) * 2; }

__device__ __forceinline__ void mm64(f32x4 (&acc)[4], const char* A, int arow0, const char* B, int l15, int lq) {
#pragma unroll
    for (int ks = 0; ks < 2; ++ks) {
        const bf16x8 a = *(const bf16x8*)(A + lds_off(arow0 + l15, ks * 4 + lq));
#pragma unroll
        for (int nt = 0; nt < 4; ++nt) {
            const bf16x8 b = *(const bf16x8*)(B + lds_off(nt * 16 + l15, ks * 4 + lq));
            acc[nt] = __builtin_amdgcn_mfma_f32_16x16x32_bf16(a, b, acc[nt], 0, 0, 0);
        }
    }
}
__device__ __forceinline__ void acc4_zero(f32x4 (&a)[4]) {
#pragma unroll
    for (int i = 0; i < 4; ++i) a[i] = (f32x4){0.f, 0.f, 0.f, 0.f};
}

#define DN_SQ 0
#define DN_SK 8192
#define DN_SV 16384
#define DN_SL 24576
#define DN_SA 57344
#define DN_SKD 65536
#define DN_SS 73728

template <int D>
__device__ __forceinline__ void dn_solve(const float* Ld, const bf16_t* srcm, const float* sc, float (&X)[64]) {
#pragma unroll
    for (int i = 0; i < 64; ++i) {
        asm volatile("" ::: "memory");
        const int pos = D ? 63 - i : i;
        float x = bf2f(srcm[pos * 64]) * sc[i];
#pragma unroll
        for (int j = 0; j < i; ++j) x -= Ld[i * 64 + j] * X[j];
        X[i] = x;
    }
}

__device__ __forceinline__ void ph_dn1(const Params& p, int bid, int nb, char* smem) {
    char* sQ = smem + DN_SQ; char* sK = smem + DN_SK; char* sV = smem + DN_SV;
    char* sL = smem + DN_SL; char* sA = smem + DN_SA; char* sKd = smem + DN_SKD;
    float* sS = (float*)(smem + DN_SS);
    for (int u = bid; u < 64 * 36; u += nb) {
        int tid = threadIdx.x;
        asm volatile("" : "+v"(tid));
        const int lane = tid & 63, w = tid >> 6, l15 = lane & 15, lq = lane >> 4;
        const int bh = u / 36, pb = u % 36, b = bh >> 3, h = bh & 7;
        int rowbase, seglen, lb;
        if (pb < 4) { rowbase = b * CTXL; seglen = CTXL; lb = pb; }
        else { rowbase = NCTX + b * SEQ; seglen = SEQ; lb = pb - 4; }
        const bool lat = (pb >= 4);
        if (tid < 128) {
            const int d = tid >> 6, tp = lane;
            const int pos = d ? 63 - tp : tp;
            const bf16_t* row = p.Pa + (size_t)(rowbase + lb * 64 + pos) * PA_W;
            const float db = bf2f(row[PA_DB + d * 8 + h]);
            const float da = bf2f(row[PA_DA + d * 8 + h]);
            const float xx = da + p.dt_bias[d * 8 + h];
            const float sp = (xx > 20.f) ? xx : log1pf(expf(xx));
            const float g = -expf(p.a_log[d * 8 + h]) * sp;
            float gc = g;
#pragma unroll
            for (int o = 1; o < 64; o <<= 1) { const float t = __shfl_up(gc, o); if (lane >= o) gc += t; }
            const float gl = __shfl(gc, 63);
            const float bt = sigmoid_f(db), eg = expf(gc);
            sS[(d * 5 + 0) * 64 + tp] = bt;
            sS[(d * 5 + 1) * 64 + tp] = gc;
            sS[(d * 5 + 2) * 64 + tp] = eg;
            sS[(d * 5 + 3) * 64 + tp] = expf(gl - gc);
            sS[(d * 5 + 4) * 64 + tp] = bt * eg;
        }
        {
            char* raw = sL;
            for (int c = tid; c < 3 * 68 * 8; c += NTHR) {
                const int g = c / 544, rem = c % 544, rr = rem >> 3, ch = rem & 7;
                const int lp = lb * 64 - 2 + rr;
                u32x4 val = (u32x4){0u, 0u, 0u, 0u};
                if (lp >= 0 && lp < seglen) val = *(const u32x4*)(p.Pa + (size_t)(rowbase + lp) * PA_W + PA_DQ + g * 512 + h * 64 + ch * 8);
                *(u32x4*)(raw + (g * 68 + rr) * 128 + ch * 16) = val;
            }
            __syncthreads();
            float cw[3][5];
#pragma unroll
            for (int g = 0; g < 3; ++g)
#pragma unroll
                for (int j = 0; j < 5; ++j) cw[g][j] = p.conv_w[j * 1536 + g * 512 + h * 64 + lane];
            const bf16_t* rw = (const bf16_t*)raw;
            float win[3][5];
#pragma unroll
            for (int g = 0; g < 3; ++g)
#pragma unroll
                for (int j = 0; j < 4; ++j) win[g][j + 1] = bf2f(rw[(g * 68 + w * 16 + j) * 64 + lane]);
#pragma unroll
            for (int tt = 0; tt < 16; ++tt) {
                const int t = w * 16 + tt;
                float y[3];
#pragma unroll
                for (int g = 0; g < 3; ++g) {
#pragma unroll
                    for (int j = 0; j < 4; ++j) win[g][j] = win[g][j + 1];
                    win[g][4] = bf2f(rw[(g * 68 + t + 4) * 64 + lane]);
                    float a = 0.f;
#pragma unroll
                    for (int j = 0; j < 5; ++j) a += win[g][j] * cw[g][j];
                    y[g] = silu_f(a);
                }
                const float sq = wave_sum(y[0] * y[0]);
                const float sk = wave_sum(y[1] * y[1]);
                const int eo = el_off(t, lane);
                *(bf16_t*)(sQ + eo) = f2bf(y[0] * rsqrtf(sq + EPSF) * 0.125f);
                *(bf16_t*)(sK + eo) = f2bf(y[1] * rsqrtf(sk + EPSF));
                *(bf16_t*)(sV + eo) = f2bf(y[2]);
                ((bf16_t*)sKd)[t * 64 + lane] = f2bf(y[1] * rsqrtf(sk + EPSF));
                ((bf16_t*)sA)[t * 64 + lane] = f2bf(y[2]);
            }
            __syncthreads();
        }
        {
            f32x4 G[4];
            acc4_zero(G);
            mm64(G, sK, 16 * w, sK, l15, lq);
            float* L0 = (float*)sL; float* L1 = L0 + 4096;
            const float* be0 = sS + 0 * 64; const float* gc0 = sS + 1 * 64;
            const float* be1 = sS + 5 * 64; const float* gc1 = sS + 6 * 64;
#pragma unroll
            for (int nt = 0; nt < 4; ++nt)
#pragma unroll
                for (int rg = 0; rg < 4; ++rg) {
                    const int t = 16 * w + 4 * lq + rg, s = 16 * nt + l15;
                    const float gv = G[nt][rg];
                    if (s < t) L0[t * 64 + s] = be0[t] * gv * __expf(gc0[t] - gc0[s]);
                    if (s > t) { const int tp = 63 - t, sp = 63 - s; L1[tp * 64 + sp] = be1[tp] * gv * __expf(gc1[tp] - gc1[sp]); }
                }
            __syncthreads();
        }
        {
            int tid3 = tid;
            asm volatile("" : "+v"(tid3) :: "memory");
            const int d = tid3 >> 7, isw = (tid3 >> 6) & 1, cc = tid3 & 63;
            const float* Ld = (const float*)sL + d * 4096;
            const float* sc = sS + (d * 5 + (isw ? 4 : 0)) * 64;
            const bf16_t* srcm = (const bf16_t*)(isw ? sKd : sA) + cc;
            float X[64];
            if (d == 0) dn_solve<0>(Ld, srcm, sc, X); else dn_solve<1>(Ld, srcm, sc, X);
            __syncthreads();
            char* dst = sL + d * 16384 + isw * 8192;
#pragma unroll
            for (int q = 0; q < 8; ++q) {
                u32x4 o;
                o[0] = pack_bf2(X[8 * q + 0], X[8 * q + 1]); o[1] = pack_bf2(X[8 * q + 2], X[8 * q + 3]);
                o[2] = pack_bf2(X[8 * q + 4], X[8 * q + 5]); o[3] = pack_bf2(X[8 * q + 6], X[8 * q + 7]);
                *(u32x4*)(dst + lds_off(cc, q)) = o;
            }
        }
        int tid5 = tid;
        asm volatile("" : "+v"(tid5) :: "memory");
        const int lane5 = tid5 & 63, w5 = tid5 >> 6, l15_5 = lane5 & 15, lq5 = lane5 >> 4;
        f32x4 QK[4];
        acc4_zero(QK);
        mm64(QK, sQ, 16 * w5, sK, l15_5, lq5);
#pragma unroll 1
        for (int d = 0; d < 2; ++d) {
            const float* gcd = sS + (d * 5 + 1) * 64;
            const float* egd = sS + (d * 5 + 2) * 64;
            const float* ekd = sS + (d * 5 + 3) * 64;
            {
                const int i = lane5, tq = w5;
                float kv[16];
#pragma unroll
                for (int e = 0; e < 16; ++e) {
                    const int tp = tq * 16 + e, pos = d ? 63 - tp : tp;
                    kv[e] = bf2f(*(const bf16_t*)(sK + el_off(pos, i))) * ekd[tp];
                }
#pragma unroll
                for (int q = 0; q < 2; ++q) {
                    u32x4 o;
                    o[0] = pack_bf2(kv[8 * q + 0], kv[8 * q + 1]); o[1] = pack_bf2(kv[8 * q + 2], kv[8 * q + 3]);
                    o[2] = pack_bf2(kv[8 * q + 4], kv[8 * q + 5]); o[3] = pack_bf2(kv[8 * q + 6], kv[8 * q + 7]);
                    *(u32x4*)(sKd + lds_off(i, 2 * tq + q)) = o;
                }
            }
#pragma unroll
            for (int nt = 0; nt < 4; ++nt)
#pragma unroll
                for (int rg = 0; rg < 4; ++rg) {
                    const int t = 16 * w5 + 4 * lq5 + rg, s = 16 * nt + l15_5;
                    const int tp = d ? 63 - t : t, sp = d ? 63 - s : s;
                    const float val = (sp <= tp) ? QK[nt][rg] * __expf(gcd[tp] - gcd[sp]) : 0.f;
                    *(bf16_t*)(sA + el_off(tp, sp)) = f2bf(val);
                }
            __syncthreads();
            const char* uT = sL + d * 16384;
            const char* wT = uT + 8192;
            const int cd = (d == 0) ? pb : (pb < 4 ? 3 - pb : 39 - pb);
            bf16_t* Mg = p.MH + ((size_t)((bh * 2 + d) * 36 + cd) * 2) * 4096;
            bf16_t* Hg = Mg + 4096;
            {
                f32x4 MT[4];
                acc4_zero(MT);
                mm64(MT, wT, 16 * w5, sKd, l15_5, lq5);
                const float egl = egd[63];
                const int j0 = 16 * w5 + 4 * lq5;
#pragma unroll
                for (int nt = 0; nt < 4; ++nt) {
                    const int i = 16 * nt + l15_5;
                    f32x4 o;
#pragma unroll
                    for (int e = 0; e < 4; ++e) o[e] = ((i == j0 + e) ? egl : 0.f) - MT[nt][e];
                    st_bf4(Mg + i * 64 + j0, o);
                }
            }
            {
                f32x4 HH[4];
                acc4_zero(HH);
                mm64(HH, sKd, 16 * w5, uT, l15_5, lq5);
                const int i0 = 16 * w5 + 4 * lq5;
#pragma unroll
                for (int nt = 0; nt < 4; ++nt) st_bf4(Hg + (16 * nt + l15_5) * 64 + i0, HH[nt]);
            }
            if (lat) {
                bf16_t* Eg = p.EF + ((size_t)((bh * 2 + d) * 32 + (pb - 4)) * 2) * 4096;
                bf16_t* Fg = Eg + 4096;
                {
                    f32x4 ET[4];
                    acc4_zero(ET);
                    mm64(ET, wT, 16 * w5, sA, l15_5, lq5);
                    const int j0 = 16 * w5 + 4 * lq5;
#pragma unroll
                    for (int nt = 0; nt < 4; ++nt) {
                        const int sp = 16 * nt + l15_5, spos = d ? 63 - sp : sp;
                        const f32x4 qv = ld_bf4((const bf16_t*)(sQ + el_off(spos, j0)));
                        const float eg = egd[sp];
                        f32x4 o;
#pragma unroll
                        for (int e = 0; e < 4; ++e) o[e] = qv[e] * eg - ET[nt][e];
                        st_bf4(Eg + spos * 64 + j0, o);
                    }
                }
                {
                    f32x4 FF[4];
                    acc4_zero(FF);
                    mm64(FF, sA, 16 * w5, uT, l15_5, lq5);
                    const int s0 = 16 * w5 + 4 * lq5;
#pragma unroll
                    for (int nt = 0; nt < 4; ++nt) {
                        const int c = 16 * nt + l15_5;
                        if (d == 0) st_bf4(Fg + c * 64 + s0, FF[nt]);
                        else st_bf4(Fg + c * 64 + (60 - s0), (f32x4){FF[nt][3], FF[nt][2], FF[nt][1], FF[nt][0]});
                    }
                }
            }
            __syncthreads();
        }
    }
}

__device__ __forceinline__ void ph_dn2(const Params& p, int bid, int nb, char* smem) {
    if (bid >= 128) return;
    const int tid = threadIdx.x, lane = tid & 63, w = tid >> 6, l15 = lane & 15, lq = lane >> 4;
    const int chain = bid, d = chain & 1;
    const bf16_t* MHc = p.MH + (size_t)chain * 36 * 2 * 4096;
    bf16_t* STc = p.ST + (size_t)chain * 32 * 4096;
    for (int i = tid; i < 8192 / 16; i += NTHR) *(u32x4*)(smem + i * 16) = (u32x4){0u, 0u, 0u, 0u};
    __syncthreads();
    const int i0 = 16 * w + 4 * lq;
    bf16x8 am[2]; uint2 hr[4];
    {
        const bf16_t* Mg = MHc;
#pragma unroll
        for (int ks = 0; ks < 2; ++ks) am[ks] = *(const bf16x8*)(Mg + (16 * w + l15) * 64 + ks * 32 + lq * 8);
#pragma unroll
        for (int nt = 0; nt < 4; ++nt) hr[nt] = *(const uint2*)(Mg + 4096 + (16 * nt + l15) * 64 + i0);
    }
    for (int c = 0; c < 36; ++c) {
        bf16x8 amn[2]; uint2 hrn[4];
        if (c + 1 < 36) {
            const bf16_t* Mg = MHc + (size_t)(c + 1) * 2 * 4096;
#pragma unroll
            for (int ks = 0; ks < 2; ++ks) amn[ks] = *(const bf16x8*)(Mg + (16 * w + l15) * 64 + ks * 32 + lq * 8);
#pragma unroll
            for (int nt = 0; nt < 4; ++nt) hrn[nt] = *(const uint2*)(Mg + 4096 + (16 * nt + l15) * 64 + i0);
        }
        const char* sS = smem + (c & 1) * 8192;
        char* sN = smem + ((c + 1) & 1) * 8192;
        f32x4 acc[4];
#pragma unroll
        for (int nt = 0; nt < 4; ++nt)
            acc[nt] = (f32x4){__uint_as_float(hr[nt].x << 16), __uint_as_float(hr[nt].x & 0xffff0000u),
                              __uint_as_float(hr[nt].y << 16), __uint_as_float(hr[nt].y & 0xffff0000u)};
#pragma unroll
        for (int ks = 0; ks < 2; ++ks)
#pragma unroll
            for (int nt = 0; nt < 4; ++nt) {
                const bf16x8 bs = *(const bf16x8*)(sS + lds_off(16 * nt + l15, ks * 4 + lq));
                acc[nt] = __builtin_amdgcn_mfma_f32_16x16x32_bf16(am[ks], bs, acc[nt], 0, 0, 0);
            }
        const int cn = c + 1;
        const bool st = (cn >= 4 && cn <= 35);
        const int pbi = (d == 0 ? cn : 39 - cn) - 4;
#pragma unroll
        for (int nt = 0; nt < 4; ++nt) {
            uint2 o; o.x = pack_bf2(acc[nt][0], acc[nt][1]); o.y = pack_bf2(acc[nt][2], acc[nt][3]);
            const int cc = 16 * nt + l15;
            *(uint2*)(sN + el_off(cc, i0)) = o;
            if (st) *(uint2*)(STc + (size_t)pbi * 4096 + cc * 64 + i0) = o;
        }
        if (c + 1 < 36) {
#pragma unroll
            for (int ks = 0; ks < 2; ++ks) am[ks] = amn[ks];
#pragma unroll
            for (int nt = 0; nt < 4; ++nt) hr[nt] = hrn[nt];
        }
        __syncthreads();
    }
}

__device__ __forceinline__ void ph_dn3(const Params& p, int bid, int nb, char* smem) {
    const int tid = threadIdx.x, lane = tid & 63, w = tid >> 6, l15 = lane & 15, lq = lane >> 4;
    for (int u = bid; u < 64 * 32; u += nb) {
        const int bh = u >> 5, pbi = u & 31, b = bh >> 3, h = bh & 7;
        const int s0 = 16 * w + 4 * lq;
        f32x4 acc[4];
        acc4_zero(acc);
#pragma unroll
        for (int d = 0; d < 2; ++d) {
            const bf16_t* Eg = p.EF + ((size_t)((bh * 2 + d) * 32 + pbi) * 2) * 4096;
            const bf16_t* Fg = Eg + 4096;
            const bf16_t* Sg = p.ST + ((size_t)(bh * 2 + d) * 32 + pbi) * 4096;
#pragma unroll
            for (int nt = 0; nt < 4; ++nt) acc[nt] += ld_bf4(Fg + (16 * nt + l15) * 64 + s0);
#pragma unroll
            for (int ks = 0; ks < 2; ++ks) {
                const bf16x8 ae = *(const bf16x8*)(Eg + (16 * w + l15) * 64 + ks * 32 + lq * 8);
#pragma unroll
                for (int nt = 0; nt < 4; ++nt) {
                    const bf16x8 bs = *(const bf16x8*)(Sg + (16 * nt + l15) * 64 + ks * 32 + lq * 8);
                    acc[nt] = __builtin_amdgcn_mfma_f32_16x16x32_bf16(ae, bs, acc[nt], 0, 0, 0);
                }
            }
        }
        const size_t rl0 = (size_t)b * SEQ + pbi * 64;
#pragma unroll
        for (int rg = 0; rg < 4; ++rg) {
            float ss = 0.f;
#pragma unroll
            for (int nt = 0; nt < 4; ++nt) ss += acc[nt][rg] * acc[nt][rg];
            ss += __shfl_xor(ss, 1); ss += __shfl_xor(ss, 2); ss += __shfl_xor(ss, 4); ss += __shfl_xor(ss, 8);
            const float rstd = rsqrtf(ss * (1.f / 64.f) + EPSF);
            const size_t rl = rl0 + s0 + rg;
#pragma unroll
            for (int nt = 0; nt < 4; ++nt) {
                const int c = 16 * nt + l15;
                const float zd = bf2f(p.Pz[rl * PZ_W + 512 + h * 64 + c]);
                p.A_dn[rl * 512 + h * 64 + c] = f2bf(acc[nt][rg] * rstd * p.dn_norm_w[c] * silu_f(zd));
            }
        }
    }
    for (size_t i = (size_t)bid * NTHR + tid; i < (size_t)NL * 64; i += (size_t)nb * NTHR) {
        const size_t rl = i >> 6; const int c8 = (int)(i & 63) * 8;
        const u32x4 ov = *(const u32x4*)(p.o_mla + rl * 512 + c8);
        const u32x4 zv = *(const u32x4*)(p.Pz + rl * PZ_W + c8);
        u32x4 r;
#pragma unroll
        for (int e = 0; e < 4; ++e) {
            const float o0 = __uint_as_float(ov[e] << 16), o1 = __uint_as_float(ov[e] & 0xffff0000u);
            const float z0 = __uint_as_float(zv[e] << 16), z1 = __uint_as_float(zv[e] & 0xffff0000u);
            r[e] = pack_bf2(o0 * silu_f(z0), o1 * silu_f(z1));
        }
        *(u32x4*)(p.A_mla + rl * 512 + c8) = r;
    }
}


__device__ __forceinline__ void ph_inproj(const Params& p, int bid, int nb, char* smem) {
    const int UA = 144 * 18, UZ = 128 * 8;
    const bf16_t* hl = p.h + (size_t)NCTX * DM;
    int u, tm, tn;
    for (int it = 0; next_unit(it, UA + UZ, bid, nb, u); ++it) {
        if (u < UA) { unit_mn(u, 18, tm, tn); gemm_store_bf16(p.h, DM, p.Wt_a, 1024, tm, tn, p.Pa, PA_W, smem); }
        else { unit_mn(u - UA, 8, tm, tn); gemm_store_bf16(hl, DM, p.Wt_z, 1024, tm, tn, p.Pz, PZ_W, smem); }
    }
}

__device__ __forceinline__ void ph_qkv_raw(const Params& p, int bid, int nb, char* smem) {
    const int UQ = 128 * 6, UK = 144 * 8;
    int u, tm, tn;
    for (int it = 0; next_unit(it, UQ + UK, bid, nb, u); ++it) {
        if (u < UQ) { unit_mn(u, 6, tm, tn); gemm_store_bf16(p.qn, 384, p.Wt_uq, 384, tm, tn, p.Qraw, 768, smem); }
        else { unit_mn(u - UQ, 8, tm, tn); gemm_store_bf16(p.kvn, 256, p.Wt_ukv, 256, tm, tn, p.KVraw, 1024, smem); }
    }
}

__device__ __forceinline__ void ph_gates(const Params& p, int bid, int nb, char* smem) {
    const bf16_t* hl = p.h + (size_t)NCTX * DM;
    int u, tm, tn;
    for (int it = 0; next_unit(it, 128 * 16, bid, nb, u); ++it) {
        unit_mn(u, 16, tm, tn);
        gemm_store_bf16(hl, DM, p.Wt_g, 1024, tm, tn, p.Pg, PG_W, smem);
    }
}

__device__ __forceinline__ void ph_merge(const Params& p, int bid, int nb, char* smem) {
    int u, tm, tn;
    for (int it = 0; next_unit(it, 128 * 16, bid, nb, u); ++it) {
        unit_mn(u, 16, tm, tn);
        const int m0 = tm * 128, n0 = tn * 64;
        f32x4 acc[2][4], mm[2][4];
        EPI_COORDS
        acc_zero<2>(acc);
        gemm_tile_acc<2>(acc, p.A_mla, 512, p.Wt_mo, 512, 512, m0, n0, smem);
#pragma unroll
        for (int nt = 0; nt < 2; ++nt)
#pragma unroll
            for (int mt = 0; mt < 4; ++mt) {
                const f32x4 g = ld_bf4(p.Pg + (size_t)EPI_ROW(mt) * PG_W + EPI_COL2(nt));
#pragma unroll
                for (int e = 0; e < 4; ++e) mm[nt][mt][e] = sigmoid_f(g[e]) * acc[nt][mt][e];
            }
        acc_zero<2>(acc);
        gemm_tile_acc<2>(acc, p.A_dn, 512, p.Wt_do, 512, 512, m0, n0, smem);
#pragma unroll
        for (int nt = 0; nt < 2; ++nt)
#pragma unroll
            for (int mt = 0; mt < 4; ++mt) {
                const f32x4 g = ld_bf4(p.Pg + (size_t)EPI_ROW(mt) * PG_W + 1024 + EPI_COL2(nt));
                f32x4 o;
#pragma unroll
                for (int e = 0; e < 4; ++e) o[e] = mm[nt][mt][e] + sigmoid_f(g[e]) * acc[nt][mt][e];
                st_bf4(p.Mb + (size_t)EPI_ROW(mt) * 1024 + EPI_COL2(nt), o);
            }
    }
}

__device__ __forceinline__ void ph_out(const Params& p, int bid, int nb, char* smem) {
    int u, tm, tn;
    for (int it = 0; next_unit(it, 128 * 8, bid, nb, u); ++it) {
        unit_mn(u, 8, tm, tn);
        const int m0 = tm * 128, n0 = tn * 128;
        f32x4 acc[4][4];
        EPI_COORDS
        acc_zero<4>(acc);
        gemm_tile_acc<4>(acc, p.Mb, 1024, p.Wt_out, 1024, 1024, m0, n0, smem);
#pragma unroll
        for (int nt = 0; nt < 4; ++nt)
#pragma unroll
            for (int mt = 0; mt < 4; ++mt) {
                const int row = EPI_ROW(mt), col = EPI_COL(nt);
                const f32x4 gate = *(const f32x4*)(p.mod + (row / SEQ) * 3072 + 2048 + col);
                const f32x4 xv = *(const f32x4*)(p.x + (size_t)row * DM + col);
                *(f32x4*)(p.out + (size_t)row * DM + col) = xv + gate * acc[nt][mt];
            }
    }
}

__global__ void __launch_bounds__(NTHR, 2) fwd_megakernel(Params p) {
    __shared__ __attribute__((aligned(16))) char smem[SMEM_BYTES];
    cg::grid_group grid = cg::this_grid();
    const int bid = blockIdx.x, nb = gridDim.x;

    ph_mod(p, bid, nb, smem);
    ph_wprep(p, bid, nb, smem);
    grid.sync();
    ph_norm(p, bid, nb, smem);
    grid.sync();
    ph_inproj(p, bid, nb, smem);
    grid.sync();
    ph_prenorm(p, bid, nb, smem);
    grid.sync();
    ph_qkv_raw(p, bid, nb, smem);
    grid.sync();
    ph_mla_post(p, bid, nb, smem);
    grid.sync();
    ph_attn(p, bid, nb, smem);
    grid.sync();
    ph_dn1(p, bid, nb, smem);
    grid.sync();
    ph_dn2(p, bid, nb, smem);
    grid.sync();
    ph_dn3(p, bid, nb, smem);
    ph_gates(p, bid, nb, smem);
    grid.sync();
    ph_merge(p, bid, nb, smem);
    grid.sync();
    ph_out(p, bid, nb, smem);
}

extern "C" void kernel_launch(void* const* d_in, const int* in_sizes, int n_in,
                              void* d_out, int out_size, void* d_ws, size_t ws_size,
                              hipStream_t stream) {
    static int grid_blocks = 0;
    if (!grid_blocks) {
        int dev = 0, cus = 0, per_cu = 0;
        (void)hipGetDevice(&dev);
        (void)hipDeviceGetAttribute(&cus, hipDeviceAttributeMultiprocessorCount, dev);
        (void)hipOccupancyMaxActiveBlocksPerMultiprocessor(&per_cu, fwd_megakernel, NTHR, 0);
        if (per_cu > 2) per_cu = 2;
        if (per_cu < 1) per_cu = 1;
        grid_blocks = cus * per_cu;
    }
    Params p{};
    const float** fp = (const float**)&p;
    for (int i = 0; i < 21; ++i) fp[i] = (const float*)d_in[i];
    p.out = (float*)d_out;
    char* ws = (char*)d_ws;
    char* ob = (char*)d_out;
    const size_t R_W = 0;
    const size_t R_H = 16777216;
    const size_t R_Z = R_H + 37748736;
    const size_t R_A = R_Z + 33554432;
    const size_t R_F = R_A + 84934656;
    {
        size_t o = R_W;
        p.Wt_a = (bf16_t*)(ws + o); o += 4718592;
        p.Wt_z = (bf16_t*)(ws + o); o += 2097152;
        p.Wt_g = (bf16_t*)(ws + o); o += 4194304;
        p.Wt_uq = (bf16_t*)(ws + o); o += 589824;
        p.Wt_ukv = (bf16_t*)(ws + o); o += 524288;
        p.Wt_mo = (bf16_t*)(ws + o); o += 1048576;
        p.Wt_do = (bf16_t*)(ws + o); o += 1048576;
        p.Wt_out = (bf16_t*)(ws + o); o += 2097152;
        p.mod = (float*)(ws + o); o += 110592;
    }
    p.h = (bf16_t*)(ws + R_H);
    p.Pz = (bf16_t*)(ws + R_Z);
    p.Pa = (bf16_t*)(ws + R_A);
    p.qn = (bf16_t*)(ws + R_F);
    p.kvn = (bf16_t*)(ws + R_F + 12582912);
    p.Qb = (bf16_t*)(ws + R_F + 22020096);
    p.Kb = (bf16_t*)(ws + R_F + 47185920);
    p.Vt = (bf16_t*)(ws + R_F + 75497472);
    p.Qraw = (bf16_t*)(ob);
    p.KVraw = (bf16_t*)(ob + 25165824);
    p.o_mla = (bf16_t*)(ws + R_F);
    p.MH = (bf16_t*)(ws + R_F + 16777216);
    p.EF = (bf16_t*)(ob);
    p.ST = (bf16_t*)(ws + R_A);
    p.A_mla = (bf16_t*)(ws + R_A + 33554432);
    p.A_dn = (bf16_t*)(ws + R_A + 50331648);
    p.Pg = (bf16_t*)(ws + R_F + 16777216);
    p.Mb = (bf16_t*)(ws + R_H);
    void* args[] = {&p};
    hipError_t err = hipLaunchCooperativeKernel((void*)fwd_megakernel, dim3(grid_blocks), dim3(NTHR), args, 0, stream);
    if (err != hipSuccess) fprintf(stderr, "cooperative launch failed: %s (grid %d)\n", hipGetErrorString(err), grid_blocks);
}
```

```cpp
#include <hip/hip_runtime.h>
#include <hip/hip_cooperative_groups.h>
#include <stdint.h>
#include <cstdio>
namespace cg = cooperative_groups;

typedef uint16_t bf16_t;
#define LAS __attribute__((address_space(3)))

#define NB 8
#define SEQ 2048
#define CTXL 256
#define TPB 2304
#define NCTX 2048
#define NL 16384
#define NT 18432
#define DM 1024
#define IN_DIM 5312
#define PA_W 2304
#define PZ_W 1024
#define PG_W 2048
#define PA_CQ 0
#define PA_CKV 384
#define PA_KR 640
#define PA_DQ 672
#define PA_DK 1184
#define PA_DV 1696
#define PA_DB 2208
#define PA_DA 2224
#define EPSF 1e-6f
#define NTHR 256
#define SMEM_BYTES 77824

struct Params {
    const float *x, *c, *ctx, *c_ctx, *w_mod, *b_mod, *norm_w, *w_in, *q_norm_w, *w_uq, *kv_norm_w, *w_ukv, *qhn_w, *khn_w,
        *mla_w_o, *conv_w, *a_log, *dt_bias, *dn_norm_w, *dn_w_o, *w_out;
    float* out;
    bf16_t *h, *Pa, *Pz, *Pg, *Qb, *Vt, *qn, *kvn, *Qraw, *KVraw, *Kb, *o_mla, *MH, *EF, *ST, *A_mla, *A_dn, *Mb;
    bf16_t *Wt_a, *Wt_z, *Wt_g, *Wt_uq, *Wt_ukv, *Wt_mo, *Wt_do, *Wt_out;
    float *mod, *rope;
    unsigned* bar;
};

__device__ __forceinline__ float bf2f(bf16_t v) { return __uint_as_float(((uint32_t)v) << 16); }
__device__ __forceinline__ bf16_t f2bf(float f) {
    uint32_t u = __float_as_uint(f);
    u += 0x7fffu + ((u >> 16) & 1u);
    return (bf16_t)(u >> 16);
}
__device__ __forceinline__ float silu_f(float v) { return v * __builtin_amdgcn_rcpf(1.f + __expf(-v)); }
__device__ __forceinline__ float sigmoid_f(float v) { return __builtin_amdgcn_rcpf(1.f + __expf(-v)); }
template <int CTRL> __device__ __forceinline__ float dpp_mov(float v) {
    return __builtin_bit_cast(float, __builtin_amdgcn_update_dpp(0, __builtin_bit_cast(int, v), CTRL, 0xF, 0xF, true));
}
__device__ __forceinline__ float row16_sum(float v) {
    v += dpp_mov<0xB1>(v); v += dpp_mov<0x4E>(v); v += dpp_mov<0x141>(v); v += dpp_mov<0x140>(v); return v;
}
__device__ __forceinline__ float rdlane(float v, int l) { return __builtin_bit_cast(float, __builtin_amdgcn_readlane(__builtin_bit_cast(int, v), l)); }
__device__ __forceinline__ float wave_sum(float v) {
    v += dpp_mov<0xB1>(v);
    v += dpp_mov<0x4E>(v);
    v += dpp_mov<0x141>(v);
    v += dpp_mov<0x140>(v);
    return (rdlane(v, 0) + rdlane(v, 16)) + (rdlane(v, 32) + rdlane(v, 48));
}
__device__ __forceinline__ float xrow_sum(float v) { v += __shfl_xor(v, 16); v += __shfl_xor(v, 32); return v; }
__device__ __forceinline__ float wave_max(float v) {
#pragma unroll
    for (int o = 32; o > 0; o >>= 1) v = fmaxf(v, __shfl_xor(v, o));
    return v;
}
__device__ __forceinline__ float block_sum256(float v, float* sh) {
    v = wave_sum(v);
    __syncthreads();
    if ((threadIdx.x & 63) == 0) sh[threadIdx.x >> 6] = v;
    __syncthreads();
    return sh[0] + sh[1] + sh[2] + sh[3];
}

__device__ __forceinline__ void ph_mod(const Params& p, int bid, int nb, char* smem) {
    float* sc = (float*)smem;
    for (int item = bid; item < 64; item += nb) {
        const int k0 = item * 16, tid = threadIdx.x;
        __syncthreads();
        if (tid < 144) {
            const int r = tid >> 4, kk = tid & 15;
            const float v = (r < 8) ? p.c[r * 1024 + k0 + kk] : p.c_ctx[k0 + kk];
            sc[tid] = silu_f(v);
        }
        __syncthreads();
#pragma unroll 1
        for (int half = 0; half < 2; ++half) {
            float acc[6][9];
#pragma unroll
            for (int q = 0; q < 6; ++q)
#pragma unroll
                for (int r = 0; r < 9; ++r) acc[q][r] = 0.f;
            const float* wp = p.w_mod + (size_t)k0 * 3072 + half * 1536 + tid;
#pragma unroll 4
            for (int kk = 0; kk < 16; ++kk) {
                float wv[6];
#pragma unroll
                for (int q = 0; q < 6; ++q) wv[q] = wp[(size_t)kk * 3072 + q * 256];
#pragma unroll
                for (int r = 0; r < 9; ++r) {
                    const float s = sc[r * 16 + kk];
#pragma unroll
                    for (int q = 0; q < 6; ++q) acc[q][r] += s * wv[q];
                }
            }
#pragma unroll
            for (int q = 0; q < 6; ++q) {
                const int j = half * 1536 + q * 256 + tid;
                const float bb = (item == 0) ? p.b_mod[j] : 0.f;
#pragma unroll
                for (int r = 0; r < 9; ++r) atomicAdd(p.mod + r * 3072 + j, acc[q][r] + bb);
            }
        }
    }
}

__device__ __forceinline__ void ph_norm(const Params& p, int bid, int nb, char* smem) {
    float* sh = (float*)smem;
    for (int r = bid; r < NT; r += nb) {
        const float* src; int mrow;
        if (r < NCTX) { src = p.ctx + (size_t)r * DM; mrow = 8; }
        else { const int rl = r - NCTX; src = p.x + (size_t)rl * DM; mrow = rl / SEQ; }
        const float4 v = ((const float4*)src)[threadIdx.x];
        float ss = v.x * v.x + v.y * v.y + v.z * v.z + v.w * v.w;
        ss = block_sum256(ss, sh);
        const float rstd = rsqrtf(ss * (1.f / 1024.f) + EPSF);
        const float* shift = p.mod + mrow * 3072;
        const float* scale = shift + 1024;
        const int k = threadIdx.x * 4;
        float vv[4] = {v.x, v.y, v.z, v.w};
#pragma unroll
        for (int i = 0; i < 4; ++i) {
            float y = vv[i] * rstd * p.norm_w[k + i];
            y = y * (1.f + scale[k + i]) + shift[k + i];
            p.h[(size_t)r * DM + k + i] = f2bf(y);
        }
    }
}

typedef __bf16 bf16v2_t __attribute__((ext_vector_type(2)));
typedef float f32x2 __attribute__((ext_vector_type(2)));
__device__ __forceinline__ uint32_t pack_bf2(float lo, float hi) {
    f32x2 v = {lo, hi};
    bf16v2_t b = __builtin_convertvector(v, bf16v2_t);
    return __builtin_bit_cast(uint32_t, b);
}

__device__ __forceinline__ void wprep_unit(const float* __restrict__ W, int ldw, int K, int n0, int k0, int srcbase, bf16_t* __restrict__ dst, float* tile,
                                           const float* __restrict__ kscale) {
    const int tid = threadIdx.x;
    {
        const int n4 = (tid & 7) * 4, kk = tid >> 3;
#pragma unroll
        for (int half = 0; half < 2; ++half) {
            const int k = kk + 32 * half;
            float4 v = make_float4(0.f, 0.f, 0.f, 0.f);
            if (srcbase >= 0) v = *(const float4*)(W + (size_t)(k0 + k) * ldw + srcbase + n4);
            if (kscale) { const float s = kscale[k0 + k]; v.x *= s; v.y *= s; v.z *= s; v.w *= s; }
            float* t = tile + k * 33 + n4;
            t[0] = v.x; t[1] = v.y; t[2] = v.z; t[3] = v.w;
        }
    }
    __syncthreads();
    {
        const int n = tid >> 3, kc = tid & 7;
        const float* t = tile + (kc * 8) * 33 + n;
        uint4 o;
        o.x = pack_bf2(t[0 * 33], t[1 * 33]); o.y = pack_bf2(t[2 * 33], t[3 * 33]);
        o.z = pack_bf2(t[4 * 33], t[5 * 33]); o.w = pack_bf2(t[6 * 33], t[7 * 33]);
        *(uint4*)(dst + (size_t)(n0 + n) * K + k0 + kc * 8) = o;
    }
    __syncthreads();
}

__device__ __forceinline__ void ph_wprep(const Params& p, int bid, int nb, char* smem) {
    float* tile = (float*)smem;
    const int U0 = 72 * 16, U1 = 32 * 16, U2 = 64 * 16, U3 = 24 * 6, U4 = 32 * 4, U5 = 32 * 8, U6 = 32 * 8, U7 = 32 * 16;
    const int UT = U0 + U1 + U2 + U3 + U4 + U5 + U6 + U7;
    for (int u = bid; u < UT; u += nb) {
        int v = u;
        const float* W; int ldw, K; bf16_t* dst; int job;
        if (v < U0) { job = 0; W = p.w_in; ldw = IN_DIM; K = 1024; dst = p.Wt_a; }
        else if ((v -= U0) < U1) { job = 1; W = p.w_in; ldw = IN_DIM; K = 1024; dst = p.Wt_z; }
        else if ((v -= U1) < U2) { job = 2; W = p.w_in; ldw = IN_DIM; K = 1024; dst = p.Wt_g; }
        else if ((v -= U2) < U3) { job = 3; W = p.w_uq; ldw = 768; K = 384; dst = p.Wt_uq; }
        else if ((v -= U3) < U4) { job = 4; W = p.w_ukv; ldw = 1024; K = 256; dst = p.Wt_ukv; }
        else if ((v -= U4) < U5) { job = 5; W = p.mla_w_o; ldw = 1024; K = 512; dst = p.Wt_mo; }
        else if ((v -= U5) < U6) { job = 6; W = p.dn_w_o; ldw = 1024; K = 512; dst = p.Wt_do; }
        else { v -= U6; job = 7; W = p.w_out; ldw = 1024; K = 1024; dst = p.Wt_out; }
        const int nkt = K / 64;
        const int n0 = (v / nkt) * 32, k0 = (v % nkt) * 64;
        int srcbase = n0;
        if (job == 0) srcbase = (n0 < 672) ? n0 : (n0 < 2208) ? n0 + 512 : (n0 < 2240) ? n0 + 1024 : -1;
        else if (job == 1) srcbase = (n0 < 512) ? 672 + n0 : 2208 + n0;
        else if (job == 2) srcbase = 3264 + n0;
        const float* ksc = (job == 3) ? p.q_norm_w : (job == 4) ? p.kv_norm_w : nullptr;
        wprep_unit(W, ldw, K, n0, k0, srcbase, dst, tile, ksc);
    }
    if (bid == nb - 1) {
        for (int i = threadIdx.x; i < 512; i += NTHR) {
            const int pos = i >> 3, f = i & 7;
            const float ang = (float)pos * powf(10000.f, -(float)f / 8.f);
            p.rope[2 * i] = cosf(ang); p.rope[2 * i + 1] = sinf(ang);
        }
    }
}

typedef short bf16x8 __attribute__((ext_vector_type(8)));
typedef float f32x4 __attribute__((ext_vector_type(4)));
typedef unsigned u32x4 __attribute__((ext_vector_type(4)));

__device__ __forceinline__ int lds_off(int row, int chunk) { return row * 128 + (((chunk ^ (row >> 1)) & 7) << 4); }

template <int NTN>
__device__ __forceinline__ void gemm_compute_stage(f32x4 (&acc)[NTN][4], const char* sa, int wm, int wn, int l15, int lq) {
    const char* sb = sa + 16384;
#pragma unroll
    for (int ks = 0; ks < 2; ++ks) {
        bf16x8 af[4], bfr[NTN];
#pragma unroll
        for (int mt = 0; mt < 4; ++mt) af[mt] = *(const bf16x8*)(sa + lds_off(wm * 64 + mt * 16 + l15, ks * 4 + lq));
#pragma unroll
        for (int nt = 0; nt < NTN; ++nt) bfr[nt] = *(const bf16x8*)(sb + lds_off(wn * (16 * NTN) + nt * 16 + l15, ks * 4 + lq));
#pragma unroll
        for (int nt = 0; nt < NTN; ++nt)
#pragma unroll
            for (int mt = 0; mt < 4; ++mt)
                acc[nt][mt] = __builtin_amdgcn_mfma_f32_16x16x32_bf16(bfr[nt], af[mt], acc[nt][mt], 0, 0, 0);
    }
}
template <int NTN>
__device__ __forceinline__ void gemm_tile_acc(f32x4 (&acc)[NTN][4], const bf16_t* __restrict__ A, int lda, const bf16_t* __restrict__ Bt, int ldb,
                                              int K, int m0, int n0, char* smem) {
    int tid = threadIdx.x;
    asm volatile("" : "+v"(tid));
    const int lane = tid & 63, w = tid >> 6, wm = w >> 1, wn = w & 1;
    const int l15 = lane & 15, lq = lane >> 4;
    const int srow = tid >> 3, sch = tid & 7;
    u32x4 ra[4], rb[NTN];
    const bf16_t* ap = A + (size_t)(m0 + srow) * lda + sch * 8;
    const bf16_t* bp = Bt + (size_t)(n0 + srow) * ldb + sch * 8;
    int KT = K >> 6;
    asm volatile("" : "+s"(KT));
#define GT_LOAD(KT_) do { _Pragma("unroll") for (int i = 0; i < 4; ++i) ra[i] = *(const u32x4*)(ap + (size_t)(32 * i) * lda + (KT_) * 64); \
                          _Pragma("unroll") for (int i = 0; i < NTN; ++i) rb[i] = *(const u32x4*)(bp + (size_t)(32 * i) * ldb + (KT_) * 64); } while (0)
#define GT_WRITE(ST_) do { char* da_ = smem + (ST_) * 32768; \
                          _Pragma("unroll") for (int i = 0; i < 4; ++i) *(u32x4*)(da_ + lds_off(srow + 32 * i, sch)) = ra[i]; \
                          _Pragma("unroll") for (int i = 0; i < NTN; ++i) *(u32x4*)(da_ + 16384 + lds_off(srow + 32 * i, sch)) = rb[i]; } while (0)
    GT_LOAD(0);
    GT_WRITE(0);
    GT_LOAD(1);
    __syncthreads();
    for (int kt = 0; kt < KT; ++kt) {
        if (kt + 1 < KT) GT_WRITE((kt + 1) & 1);
        if (kt + 2 < KT) GT_LOAD(kt + 2);
        gemm_compute_stage<NTN>(acc, smem + (kt & 1) * 32768, wm, wn, l15, lq);
        __syncthreads();
    }
#undef GT_LOAD
#undef GT_WRITE
}

template <int NTN>
__device__ __forceinline__ void acc_zero(f32x4 (&acc)[NTN][4]) {
#pragma unroll
    for (int i = 0; i < NTN; ++i)
#pragma unroll
        for (int j = 0; j < 4; ++j) acc[i][j] = (f32x4){0.f, 0.f, 0.f, 0.f};
}

__device__ __forceinline__ bool next_unit(int it, int U, int bid, int nb, int& u) {
    const int x = bid & 7, li = bid >> 3, per = nb >> 3;
    const int lo = (int)(((long)U * x) >> 3), hi = (int)(((long)U * (x + 1)) >> 3);
    u = lo + li + it * per;
    return u < hi;
}
__device__ __forceinline__ void unit_mn(int u, int ntn, int& tm, int& tn) {
    const int g = u / (8 * ntn), r = u % (8 * ntn);
    tm = g * 8 + (r & 7); tn = r >> 3;
}

__device__ __forceinline__ void st_bf4(bf16_t* p, f32x4 v) {
    uint2 o; o.x = pack_bf2(v[0], v[1]); o.y = pack_bf2(v[2], v[3]);
    *(uint2*)p = o;
}
__device__ __forceinline__ f32x4 ld_bf4(const bf16_t* p) {
    const uint2 r = *(const uint2*)p;
    return (f32x4){__uint_as_float(r.x << 16), __uint_as_float(r.x & 0xffff0000u), __uint_as_float(r.y << 16), __uint_as_float(r.y & 0xffff0000u)};
}
#define EPI_COORDS_OPAQUE(SFX) int tid##SFX = threadIdx.x; asm volatile("" : "+v"(tid##SFX)); \
    const int lane_ = tid##SFX & 63, w_ = tid##SFX >> 6, wm_ = w_ >> 1, wn_ = w_ & 1, l15_ = lane_ & 15, lq_ = lane_ >> 4;
#define EPI_COORDS const int lane_ = threadIdx.x & 63, w_ = threadIdx.x >> 6, wm_ = w_ >> 1, wn_ = w_ & 1, l15_ = lane_ & 15, lq_ = lane_ >> 4;
#define EPI_ROW(mt) (m0 + wm_ * 64 + (mt) * 16 + l15_)
#define EPI_COL(nt) (n0 + wn_ * 64 + (nt) * 16 + lq_ * 4)
#define EPI_COL2(nt) (n0 + wn_ * 32 + (nt) * 16 + lq_ * 4)

__device__ __forceinline__ void gemm_store_bf16(const bf16_t* A, int lda, const bf16_t* Bt, int K, int tm, int tn, bf16_t* C, int ldc, char* smem) {
    f32x4 acc[4][4];
    acc_zero<4>(acc);
    const int m0 = tm * 128, n0 = tn * 128;
    gemm_tile_acc<4>(acc, A, lda, Bt, K, K, m0, n0, smem);
    EPI_COORDS
#pragma unroll
    for (int nt = 0; nt < 4; ++nt)
#pragma unroll
        for (int mt = 0; mt < 4; ++mt) st_bf4(C + (size_t)EPI_ROW(mt) * ldc + EPI_COL(nt), acc[nt][mt]);
}

template <int NTN>
__device__ __forceinline__ void gemm_rows_acc(f32x4 (&acc)[NTN][2], float (&ssq)[4], const bf16_t* __restrict__ A, int lda,
                                              const bf16_t* __restrict__ Bt, int ldb, int K, int m0, int n0, char* smem) {
    constexpr int NB_ = NTN / 2;
    const int tid = threadIdx.x, lane = tid & 63, w = tid >> 6;
    const int l15 = lane & 15, lq = lane >> 4;
    const int srow = tid >> 3, sch = tid & 7;
    u32x4 ra[4], rb[NB_];
    const bf16_t* ap = A + (size_t)(m0 + srow) * lda + sch * 8;
    const bf16_t* bp = Bt + (size_t)(n0 + srow) * ldb + sch * 8;
    int KT = K >> 6;
    asm volatile("" : "+s"(KT));
#pragma unroll
    for (int i = 0; i < 4; ++i) ra[i] = *(const u32x4*)(ap + (size_t)(32 * i) * lda);
#pragma unroll
    for (int i = 0; i < NB_; ++i) rb[i] = *(const u32x4*)(bp + (size_t)(32 * i) * ldb);
#pragma unroll
    for (int i = 0; i < 4; ++i) *(u32x4*)(smem + lds_off(srow + 32 * i, sch)) = ra[i];
#pragma unroll
    for (int i = 0; i < NB_; ++i) *(u32x4*)(smem + 16384 + lds_off(srow + 32 * i, sch)) = rb[i];
    __syncthreads();
    for (int kt = 0; kt < KT; ++kt) {
#pragma unroll
        for (int i = 0; i < 4; ++i)
#pragma unroll
            for (int e = 0; e < 4; ++e) {
                const float lo = __uint_as_float(ra[i][e] << 16), hi = __uint_as_float(ra[i][e] & 0xffff0000u);
                ssq[i] += lo * lo + hi * hi;
            }
        if (kt + 1 < KT) {
#pragma unroll
            for (int i = 0; i < 4; ++i) ra[i] = *(const u32x4*)(ap + (size_t)(32 * i) * lda + (kt + 1) * 64);
#pragma unroll
            for (int i = 0; i < NB_; ++i) rb[i] = *(const u32x4*)(bp + (size_t)(32 * i) * ldb + (kt + 1) * 64);
        }
        const char* sa = smem + (kt & 1) * 32768;
        const char* sb = sa + 16384;
#pragma unroll
        for (int ks = 0; ks < 2; ++ks) {
            bf16x8 af[2], bfr[NTN];
#pragma unroll
            for (int mt = 0; mt < 2; ++mt) af[mt] = *(const bf16x8*)(sa + lds_off(w * 32 + mt * 16 + l15, ks * 4 + lq));
#pragma unroll
            for (int nt = 0; nt < NTN; ++nt) bfr[nt] = *(const bf16x8*)(sb + lds_off(nt * 16 + l15, ks * 4 + lq));
#pragma unroll
            for (int nt = 0; nt < NTN; ++nt)
#pragma unroll
                for (int mt = 0; mt < 2; ++mt)
                    acc[nt][mt] = __builtin_amdgcn_mfma_f32_16x16x32_bf16(bfr[nt], af[mt], acc[nt][mt], 0, 0, 0);
        }
        if (kt + 1 < KT) {
            char* da = smem + ((kt + 1) & 1) * 32768;
#pragma unroll
            for (int i = 0; i < 4; ++i) *(u32x4*)(da + lds_off(srow + 32 * i, sch)) = ra[i];
#pragma unroll
            for (int i = 0; i < NB_; ++i) *(u32x4*)(da + 16384 + lds_off(srow + 32 * i, sch)) = rb[i];
        }
        __syncthreads();
    }
    float* rssq = (float*)(smem + 65536);
#pragma unroll
    for (int i = 0; i < 4; ++i) {
        float s = ssq[i];
        s += dpp_mov<0xB1>(s); s += dpp_mov<0x4E>(s); s += dpp_mov<0x141>(s);
        if (sch == 0) rssq[srow + 32 * i] = s;
    }
    __syncthreads();
}

__device__ __forceinline__ void ph_mla_proj(const Params& p, int bid, int nb, char* smem) {
    const int tid = threadIdx.x, lane = tid & 63, w = tid >> 6, l15 = lane & 15, lq = lane >> 4;
    const float* rssq = (const float*)(smem + 65536);
    const int UQ = 128 * 8, UK = 144 * 8;
    int u;
    for (int it = 0; next_unit(it, UQ + UK, bid, nb, u); ++it) {
        if (u < UQ) {
            const int tm = u >> 3, hh = u & 7;
            const int m0 = NCTX + tm * 128;
            f32x4 acc[6][2];
            float ssq[4] = {0.f, 0.f, 0.f, 0.f};
#pragma unroll
            for (int i = 0; i < 6; ++i) { acc[i][0] = (f32x4){0.f, 0.f, 0.f, 0.f}; acc[i][1] = (f32x4){0.f, 0.f, 0.f, 0.f}; }
            gemm_rows_acc<6>(acc, ssq, p.Pa + PA_CQ, PA_W, p.Wt_uq, 384, 384, m0, hh * 96, smem);
#pragma unroll
            for (int mt = 0; mt < 2; ++mt) {
                const int ml = 32 * w + 16 * mt + l15;
                const int rl = tm * 128 + ml;
                const int b = rl >> 11, t = rl & 2047;
                const float rs = rsqrtf(rssq[ml] * (1.f / 384.f) + EPSF);
                float hs = 0.f;
#pragma unroll
                for (int nt = 0; nt < 6; ++nt)
#pragma unroll
                    for (int e = 0; e < 4; ++e) { const float v = acc[nt][mt][e] * rs; acc[nt][mt][e] = v; hs += v * v; }
                hs = xrow_sum(hs);
                const float hr = rsqrtf(hs * (1.f / 96.f) + EPSF) * (0.10206207261596575f * 1.4426950408889634f);
                bf16_t* qd = p.Qb + ((size_t)((b * 8 + hh) * SEQ + t)) * 96 + 4 * lq;
#pragma unroll
                for (int nt = 0; nt < 6; ++nt) {
                    const f32x4 wv = *(const f32x4*)(p.qhn_w + 16 * nt + 4 * lq);
                    f32x4 v;
#pragma unroll
                    for (int e = 0; e < 4; ++e) v[e] = acc[nt][mt][e] * hr * wv[e];
                    if (nt >= 4) {
                        const int pos = (nt == 4) ? (t >> 6) : (t & 63);
                        const int ph = lq >> 1;
#pragma unroll
                        for (int e = 0; e < 4; ++e) {
                            const float2 cs = *(const float2*)(p.rope + 2 * (pos * 8 + (lq & 1) * 4 + e));
                            const float partner = __shfl_xor(v[e], 32);
                            const float t1 = ph ? partner : v[e], t2 = ph ? v[e] : partner;
                            v[e] = ph ? (t1 * cs.y + t2 * cs.x) : (t1 * cs.x - t2 * cs.y);
                        }
                    }
                    st_bf4(qd + 16 * nt, v);
                }
            }
        } else {
            const int uu = u - UQ;
            const int tm = uu >> 3, hh = uu & 7;
            const int m0 = tm * 128;
            f32x4 acc[8][2];
            float ssq[4] = {0.f, 0.f, 0.f, 0.f};
#pragma unroll
            for (int i = 0; i < 8; ++i) { acc[i][0] = (f32x4){0.f, 0.f, 0.f, 0.f}; acc[i][1] = (f32x4){0.f, 0.f, 0.f, 0.f}; }
            gemm_rows_acc<8>(acc, ssq, p.Pa + PA_CKV, PA_W, p.Wt_ukv, 256, 256, m0, hh * 128, smem);
#pragma unroll
            for (int mt = 0; mt < 2; ++mt) {
                const int ml = 32 * w + 16 * mt + l15;
                const int r = m0 + ml;
                int b, pos, t = 0; const bool lat = (r >= NCTX);
                if (!lat) { b = r >> 8; pos = r & 255; }
                else { const int rl = r - NCTX; b = rl >> 11; t = rl & 2047; pos = CTXL + t; }
                const float rs = rsqrtf(rssq[ml] * (1.f / 256.f) + EPSF);
                const u32x4 krw = *(const u32x4*)(p.Pa + (size_t)r * PA_W + PA_KR + 8 * lq);
                float kr[8];
#pragma unroll
                for (int e = 0; e < 4; ++e) { kr[2 * e] = __uint_as_float(krw[e] << 16); kr[2 * e + 1] = __uint_as_float(krw[e] & 0xffff0000u); }
                float hs = 0.f;
#pragma unroll
                for (int e = 0; e < 8; ++e) hs += kr[e] * kr[e];
#pragma unroll
                for (int nt = 0; nt < 4; ++nt)
#pragma unroll
                    for (int e = 0; e < 4; ++e) { const float v = acc[nt][mt][e] * rs; acc[nt][mt][e] = v; hs += v * v; }
                hs = xrow_sum(hs);
                const float hr = rsqrtf(hs * (1.f / 96.f) + EPSF);
                bf16_t* kd = p.Kb + ((size_t)((b * 8 + hh) * TPB + pos)) * 96;
#pragma unroll
                for (int nt = 0; nt < 4; ++nt) {
                    const f32x4 wv = *(const f32x4*)(p.khn_w + 16 * nt + 4 * lq);
                    f32x4 v;
#pragma unroll
                    for (int e = 0; e < 4; ++e) v[e] = acc[nt][mt][e] * hr * wv[e];
                    st_bf4(kd + 16 * nt + 4 * lq, v);
                }
                {
                    const int ph = lq & 1;
                    const int rp = (lq >> 1) ? (t & 63) : (t >> 6);
                    float o[8];
#pragma unroll
                    for (int e = 0; e < 8; ++e) {
                        const float v = kr[e] * hr * p.khn_w[64 + 8 * lq + e];
                        const float partner = __shfl_xor(v, 16);
                        float2 cs = make_float2(1.f, 0.f);
                        if (lat) cs = *(const float2*)(p.rope + 2 * (rp * 8 + e));
                        const float t1 = ph ? partner : v, t2 = ph ? v : partner;
                        o[e] = ph ? (t1 * cs.y + t2 * cs.x) : (t1 * cs.x - t2 * cs.y);
                    }
                    u32x4 ov;
                    ov[0] = pack_bf2(o[0], o[1]); ov[1] = pack_bf2(o[2], o[3]); ov[2] = pack_bf2(o[4], o[5]); ov[3] = pack_bf2(o[6], o[7]);
                    *(u32x4*)(kd + 64 + 8 * lq) = ov;
                }
                {
                    const int kpos = (pos & ~12) | ((pos & 4) << 1) | ((pos & 8) >> 1);
                    bf16_t* vd = p.Vt + (size_t)((b * 8 + hh) * 64) * TPB + kpos;
#pragma unroll
                    for (int nt = 4; nt < 8; ++nt)
#pragma unroll
                        for (int e = 0; e < 4; ++e) vd[(size_t)(16 * (nt - 4) + 4 * lq + e) * TPB] = f2bf(acc[nt][mt][e] * rs);
                }
            }
        }
    }
}

typedef float f32x16 __attribute__((ext_vector_type(16)));
#define ATT_KROW 208
#define ATT_VROW 144
#define ATT_KBYTES (64 * ATT_KROW)
#define ATT_STAGE (ATT_KBYTES + 64 * ATT_VROW)
__device__ __forceinline__ void ph_attn(const Params& p, int bid, int nb, char* smem) {
    const int tid = threadIdx.x, lane = tid & 63, w = tid >> 6, r = lane & 31, h = lane >> 5;
    int u;
    for (int it = 0; next_unit(it, 1024, bid, nb, u); ++it) {
        const int bh = u >> 4, qb = u & 15;
        bf16x8 qf[6];
        {
            const bf16_t* Qp = p.Qb + ((size_t)bh * SEQ + qb * 128 + w * 32 + r) * 96 + h * 8;
#pragma unroll
            for (int s = 0; s < 6; ++s) qf[s] = *(const bf16x8*)(Qp + s * 16);
        }
        const bf16_t* Kg = p.Kb + (size_t)bh * TPB * 96 + tid * 8;
        const bf16_t* Vg = p.Vt + (size_t)bh * 64 * TPB + (size_t)(tid >> 3) * TPB + (tid & 7) * 8;
        int koff[3], voff[2];
#pragma unroll
        for (int i = 0; i < 3; ++i) { const int c = tid + 256 * i; koff[i] = (c / 12) * ATT_KROW + (c % 12) * 16; }
#pragma unroll
        for (int i = 0; i < 2; ++i) { const int c = tid + 256 * i; voff[i] = ATT_KBYTES + (c >> 3) * ATT_VROW + (c & 7) * 16; }
        u32x4 rk[3], rv[2];
#pragma unroll
        for (int i = 0; i < 3; ++i) rk[i] = *(const u32x4*)(Kg + i * 2048);
#pragma unroll
        for (int i = 0; i < 2; ++i) rv[i] = *(const u32x4*)(Vg + (size_t)(32 * i) * TPB);
#pragma unroll
        for (int i = 0; i < 3; ++i) *(u32x4*)(smem + koff[i]) = rk[i];
#pragma unroll
        for (int i = 0; i < 2; ++i) *(u32x4*)(smem + voff[i]) = rv[i];
        __syncthreads();
        f32x16 o0, o1;
#pragma unroll
        for (int i = 0; i < 16; ++i) { o0[i] = 0.f; o1[i] = 0.f; }
        float m = -1.0e30f, l = 0.f;
        int NKT = TPB / 64;
        asm volatile("" : "+s"(NKT));
        for (int kt = 0; kt < NKT; ++kt) {
            if (kt + 1 < NKT) {
#pragma unroll
                for (int i = 0; i < 3; ++i) rk[i] = *(const u32x4*)(Kg + (size_t)(kt + 1) * 6144 + i * 2048);
#pragma unroll
                for (int i = 0; i < 2; ++i) rv[i] = *(const u32x4*)(Vg + (size_t)(32 * i) * TPB + (kt + 1) * 64);
            }
            const char* sk = smem + (kt & 1) * ATT_STAGE;
            const char* sv = sk + ATT_KBYTES;
            f32x16 s0, s1;
#pragma unroll
            for (int i = 0; i < 16; ++i) { s0[i] = 0.f; s1[i] = 0.f; }
#pragma unroll
            for (int s = 0; s < 6; ++s) {
                const bf16x8 k0 = *(const bf16x8*)(sk + r * ATT_KROW + (2 * s + h) * 16);
                const bf16x8 k1 = *(const bf16x8*)(sk + (32 + r) * ATT_KROW + (2 * s + h) * 16);
                s0 = __builtin_amdgcn_mfma_f32_32x32x16_bf16(k0, qf[s], s0, 0, 0, 0);
                s1 = __builtin_amdgcn_mfma_f32_32x32x16_bf16(k1, qf[s], s1, 0, 0, 0);
            }
            float mx = fmaxf(s0[0], s1[0]);
#pragma unroll
            for (int i = 1; i < 16; ++i) mx = fmaxf(mx, fmaxf(s0[i], s1[i]));
            mx = fmaxf(mx, __shfl_xor(mx, 32));
            const float mn = fmaxf(m, mx);
            const float alpha = __builtin_amdgcn_exp2f(m - mn);
            m = mn;
            float ls = 0.f;
#pragma unroll
            for (int i = 0; i < 16; ++i) {
                s0[i] = __builtin_amdgcn_exp2f(s0[i] - mn);
                s1[i] = __builtin_amdgcn_exp2f(s1[i] - mn);
                ls += s0[i] + s1[i];
            }
            l = l * alpha + ls;
#pragma unroll
            for (int i = 0; i < 16; ++i) { o0[i] *= alpha; o1[i] *= alpha; }
#pragma unroll
            for (int ks = 0; ks < 4; ++ks) {
                u32x4 pw;
                if (ks < 2) {
                    pw[0] = pack_bf2(s0[8 * (ks & 1) + 0], s0[8 * (ks & 1) + 1]); pw[1] = pack_bf2(s0[8 * (ks & 1) + 2], s0[8 * (ks & 1) + 3]);
                    pw[2] = pack_bf2(s0[8 * (ks & 1) + 4], s0[8 * (ks & 1) + 5]); pw[3] = pack_bf2(s0[8 * (ks & 1) + 6], s0[8 * (ks & 1) + 7]);
                } else {
                    pw[0] = pack_bf2(s1[8 * (ks & 1) + 0], s1[8 * (ks & 1) + 1]); pw[1] = pack_bf2(s1[8 * (ks & 1) + 2], s1[8 * (ks & 1) + 3]);
                    pw[2] = pack_bf2(s1[8 * (ks & 1) + 4], s1[8 * (ks & 1) + 5]); pw[3] = pack_bf2(s1[8 * (ks & 1) + 6], s1[8 * (ks & 1) + 7]);
                }
                const bf16x8 pf = __builtin_bit_cast(bf16x8, pw);
                const bf16x8 v0 = *(const bf16x8*)(sv + r * ATT_VROW + (2 * ks + h) * 16);
                const bf16x8 v1 = *(const bf16x8*)(sv + (32 + r) * ATT_VROW + (2 * ks + h) * 16);
                o0 = __builtin_amdgcn_mfma_f32_32x32x16_bf16(v0, pf, o0, 0, 0, 0);
                o1 = __builtin_amdgcn_mfma_f32_32x32x16_bf16(v1, pf, o1, 0, 0, 0);
            }
            if (kt + 1 < NKT) {
                char* ds = smem + ((kt + 1) & 1) * ATT_STAGE;
#pragma unroll
                for (int i = 0; i < 3; ++i) *(u32x4*)(ds + koff[i]) = rk[i];
#pragma unroll
                for (int i = 0; i < 2; ++i) *(u32x4*)(ds + voff[i]) = rv[i];
            }
            __syncthreads();
        }
        l += __shfl_xor(l, 32);
        const float inv = 1.f / l;
        const int b = bh >> 3, hh = bh & 7;
        bf16_t* op = p.o_mla + ((size_t)(b * SEQ + qb * 128 + w * 32 + r)) * 512 + hh * 64 + 4 * h;
#pragma unroll
        for (int g = 0; g < 4; ++g) {
            uint2 a, c;
            a.x = pack_bf2(o0[4 * g + 0] * inv, o0[4 * g + 1] * inv); a.y = pack_bf2(o0[4 * g + 2] * inv, o0[4 * g + 3] * inv);
            c.x = pack_bf2(o1[4 * g + 0] * inv, o1[4 * g + 1] * inv); c.y = pack_bf2(o1[4 * g + 2] * inv, o1[4 * g + 3] * inv);
            *(uint2*)(op + 8 * g) = a;
            *(uint2*)(op + 32 + 8 * g) = c;
        }
    }
}

__device__ __forceinline__ int el_off(int row, int col) { return lds_off(row, col >> 3) + (col & 7) * 2; }

__device__ __forceinline__ void mm64(f32x4 (&acc)[4], const char* A, int arow0, const char* B, int l15, int lq) {
#pragma unroll
    for (int ks = 0; ks < 2; ++ks) {
        const bf16x8 a = *(const bf16x8*)(A + lds_off(arow0 + l15, ks * 4 + lq));
#pragma unroll
        for (int nt = 0; nt < 4; ++nt) {
            const bf16x8 b = *(const bf16x8*)(B + lds_off(nt * 16 + l15, ks * 4 + lq));
            acc[nt] = __builtin_amdgcn_mfma_f32_16x16x32_bf16(a, b, acc[nt], 0, 0, 0);
        }
    }
}
__device__ __forceinline__ void acc4_zero(f32x4 (&a)[4]) {
#pragma unroll
    for (int i = 0; i < 4; ++i) a[i] = (f32x4){0.f, 0.f, 0.f, 0.f};
}

#define DN_SQ 0
#define DN_SK 8192
#define DN_SV 16384
#define DN_LSTR 65
#define DN_LBYTES (64 * DN_LSTR * 4)
#define DN_SL 24576
#define DN_SA 57856
#define DN_SKD 66048
#define DN_SS 74240

typedef short s16x4 __attribute__((ext_vector_type(4)));
__device__ __forceinline__ s16x4 ds_tr(const char* p) { return __builtin_amdgcn_ds_read_tr16_b64_v4i16((LAS s16x4*)p); }

__device__ __forceinline__ void ph_dn1(const Params& p, int bid, int nb, char* smem) {
    char* sQ = smem + DN_SQ; char* sK = smem + DN_SK; char* sV = smem + DN_SV;
    char* sL = smem + DN_SL; char* sA = smem + DN_SA; char* sKd = smem + DN_SKD;
    float* sS = (float*)(smem + DN_SS);
    for (int u = bid; u < 64 * 36; u += nb) {
        int tid = threadIdx.x;
        asm volatile("" : "+v"(tid));
        const int lane = tid & 63, w = tid >> 6, l15 = lane & 15, lq = lane >> 4;
        const int bh = u / 36, pb = u % 36, b = bh >> 3, h = bh & 7;
        int rowbase, seglen, lb;
        if (pb < 4) { rowbase = b * CTXL; seglen = CTXL; lb = pb; }
        else { rowbase = NCTX + b * SEQ; seglen = SEQ; lb = pb - 4; }
        const bool lat = (pb >= 4);
        if (tid < 128) {
            const int d = tid >> 6, tp = lane;
            const int pos = d ? 63 - tp : tp;
            const bf16_t* row = p.Pa + (size_t)(rowbase + lb * 64 + pos) * PA_W;
            const float db = bf2f(row[PA_DB + d * 8 + h]);
            const float da = bf2f(row[PA_DA + d * 8 + h]);
            const float xx = da + p.dt_bias[d * 8 + h];
            const float sp = (xx > 20.f) ? xx : log1pf(expf(xx));
            const float g = -expf(p.a_log[d * 8 + h]) * sp;
            float gc = g;
#pragma unroll
            for (int o = 1; o < 64; o <<= 1) { const float t = __shfl_up(gc, o); if (lane >= o) gc += t; }
            const float gl = __shfl(gc, 63);
            const float bt = sigmoid_f(db), eg = expf(gc);
            sS[(d * 5 + 0) * 64 + tp] = bt;
            sS[(d * 5 + 1) * 64 + tp] = gc;
            sS[(d * 5 + 2) * 64 + tp] = eg;
            sS[(d * 5 + 3) * 64 + tp] = expf(gl - gc);
            sS[(d * 5 + 4) * 64 + tp] = bt * eg;
        }
        {
            char* raw = sL;
            for (int c = tid; c < 3 * 68 * 8; c += NTHR) {
                const int g = c / 544, rem = c % 544, rr = rem >> 3, ch = rem & 7;
                const int lp = lb * 64 - 2 + rr;
                u32x4 val = (u32x4){0u, 0u, 0u, 0u};
                if (lp >= 0 && lp < seglen) val = *(const u32x4*)(p.Pa + (size_t)(rowbase + lp) * PA_W + PA_DQ + g * 512 + h * 64 + ch * 8);
                *(u32x4*)(raw + (g * 68 + rr) * 128 + ch * 16) = val;
            }
            __syncthreads();
            float cw[3][5];
#pragma unroll
            for (int g = 0; g < 3; ++g)
#pragma unroll
                for (int j = 0; j < 5; ++j) cw[g][j] = p.conv_w[j * 1536 + g * 512 + h * 64 + lane];
            const bf16_t* rw = (const bf16_t*)raw;
            float win[3][5];
#pragma unroll
            for (int g = 0; g < 3; ++g)
#pragma unroll
                for (int j = 0; j < 4; ++j) win[g][j + 1] = bf2f(rw[(g * 68 + w * 16 + j) * 64 + lane]);
#pragma unroll
            for (int tt = 0; tt < 16; ++tt) {
                const int t = w * 16 + tt;
                float y[3];
#pragma unroll
                for (int g = 0; g < 3; ++g) {
#pragma unroll
                    for (int j = 0; j < 4; ++j) win[g][j] = win[g][j + 1];
                    win[g][4] = bf2f(rw[(g * 68 + t + 4) * 64 + lane]);
                    float a = 0.f;
#pragma unroll
                    for (int j = 0; j < 5; ++j) a += win[g][j] * cw[g][j];
                    y[g] = silu_f(a);
                }
                const float sq = wave_sum(y[0] * y[0]);
                const float sk = wave_sum(y[1] * y[1]);
                const int eo = el_off(t, lane);
                *(bf16_t*)(sQ + eo) = f2bf(y[0] * rsqrtf(sq + EPSF) * 0.125f);
                *(bf16_t*)(sK + eo) = f2bf(y[1] * rsqrtf(sk + EPSF));
                *(bf16_t*)(sV + eo) = f2bf(y[2]);
            }
            __syncthreads();
        }
        {
            f32x4 G[4];
            acc4_zero(G);
            mm64(G, sK, 16 * w, sK, l15, lq);
            float* L0 = (float*)sL; float* L1 = (float*)(sL + DN_LBYTES);
            const float* be0 = sS + 0 * 64; const float* gc0 = sS + 1 * 64;
            const float* be1 = sS + 5 * 64; const float* gc1 = sS + 6 * 64;
#pragma unroll
            for (int nt = 0; nt < 4; ++nt)
#pragma unroll
                for (int rg = 0; rg < 4; ++rg) {
                    const int t = 16 * w + 4 * lq + rg, s = 16 * nt + l15;
                    const float gv = G[nt][rg];
                    const int tp = 63 - t, sp = 63 - s;
                    L0[t * DN_LSTR + s] = (s < t) ? be0[t] * gv * __expf(gc0[t] - gc0[s]) : 0.f;
                    L1[tp * DN_LSTR + sp] = (s > t) ? be1[tp] * gv * __expf(gc1[tp] - gc1[sp]) : 0.f;
                }
            __syncthreads();
        }
        {
            int tid3 = tid;
            asm volatile("" : "+v"(tid3) :: "memory");
            const int lane3 = tid3 & 63, w3 = tid3 >> 6, l15c = lane3 & 15, lqc = lane3 >> 4;
            if (tid3 < 128) {
                float* Lb = (float*)(sL + w3 * DN_LBYTES) + (16 * lqc) * DN_LSTR + 16 * lqc;
                float x[16];
#pragma unroll
                for (int i = 0; i < 16; ++i) {
                    float v = (i == l15c) ? 1.f : 0.f;
#pragma unroll
                    for (int j = 0; j < i; ++j) v -= Lb[i * DN_LSTR + j] * x[j];
                    x[i] = v;
                }
#pragma unroll
                for (int i = 0; i < 16; ++i) Lb[i * DN_LSTR + l15c] = x[i];
            }
            __syncthreads();
            {
                const int d = w3 >> 1, pr = w3 & 1, b0 = 2 * pr, b1 = 2 * pr + 1;
                float* Ld = (float*)(sL + d * DN_LBYTES);
                float* scr = (float*)(sA) + w3 * 272;
                f32x4 P = (f32x4){0.f, 0.f, 0.f, 0.f};
#pragma unroll
                for (int kk = 0; kk < 4; ++kk)
                    P = __builtin_amdgcn_mfma_f32_16x16x4f32(Ld[(16 * b1 + l15c) * DN_LSTR + 16 * b0 + 4 * kk + lqc],
                                                            Ld[(16 * b0 + 4 * kk + lqc) * DN_LSTR + 16 * b0 + l15c], P, 0, 0, 0);
#pragma unroll
                for (int rg = 0; rg < 4; ++rg) scr[(4 * lqc + rg) * 17 + l15c] = P[rg];
                f32x4 R = (f32x4){0.f, 0.f, 0.f, 0.f};
#pragma unroll
                for (int kk = 0; kk < 4; ++kk)
                    R = __builtin_amdgcn_mfma_f32_16x16x4f32(Ld[(16 * b1 + l15c) * DN_LSTR + 16 * b1 + 4 * kk + lqc],
                                                            scr[(4 * kk + lqc) * 17 + l15c], R, 0, 0, 0);
#pragma unroll
                for (int rg = 0; rg < 4; ++rg) Ld[(16 * b1 + 4 * lqc + rg) * DN_LSTR + 16 * b0 + l15c] = -R[rg];
            }
            __syncthreads();
            {
                const int d = w3 >> 1, hf = w3 & 1;
                float* Ld = (float*)(sL + d * DN_LBYTES);
                float* scr2 = (float*)(d ? sKd : sA);
                f32x4 P2[2];
                P2[0] = (f32x4){0.f, 0.f, 0.f, 0.f}; P2[1] = (f32x4){0.f, 0.f, 0.f, 0.f};
#pragma unroll
                for (int kk = 0; kk < 8; ++kk) {
                    const float a = Ld[(32 + 16 * hf + l15c) * DN_LSTR + 4 * kk + lqc];
#pragma unroll
                    for (int n2 = 0; n2 < 2; ++n2)
                        P2[n2] = __builtin_amdgcn_mfma_f32_16x16x4f32(a, Ld[(4 * kk + lqc) * DN_LSTR + 16 * n2 + l15c], P2[n2], 0, 0, 0);
                }
#pragma unroll
                for (int n2 = 0; n2 < 2; ++n2)
#pragma unroll
                    for (int rg = 0; rg < 4; ++rg) scr2[(16 * hf + 4 * lqc + rg) * 33 + 16 * n2 + l15c] = P2[n2][rg];
                __syncthreads();
                f32x4 R2[2];
                R2[0] = (f32x4){0.f, 0.f, 0.f, 0.f}; R2[1] = (f32x4){0.f, 0.f, 0.f, 0.f};
#pragma unroll
                for (int kk = 0; kk < 8; ++kk) {
                    const float a = Ld[(32 + 16 * hf + l15c) * DN_LSTR + 32 + 4 * kk + lqc];
#pragma unroll
                    for (int n2 = 0; n2 < 2; ++n2)
                        R2[n2] = __builtin_amdgcn_mfma_f32_16x16x4f32(a, scr2[(4 * kk + lqc) * 33 + 16 * n2 + l15c], R2[n2], 0, 0, 0);
                }
#pragma unroll
                for (int n2 = 0; n2 < 2; ++n2)
#pragma unroll
                    for (int rg = 0; rg < 4; ++rg) Ld[(32 + 16 * hf + 4 * lqc + rg) * DN_LSTR + 16 * n2 + l15c] = -R2[n2][rg];
            }
            __syncthreads();
            f32x4 U0[4];
            acc4_zero(U0);
#pragma unroll 1
            for (int dd = 0; dd < 4; ++dd) {
                const int d = dd >> 1, isw = dd & 1;
                const float* Td = (const float*)(sL + d * DN_LBYTES);
                {
                    const int tr = tid3 >> 2, cq = tid3 & 3;
                    const float* c1 = sS + (d * 5 + (isw ? 4 : 0)) * 64 + 16 * cq;
                    const float* trow = Td + tr * DN_LSTR + 16 * cq;
                    float tv[16];
#pragma unroll
                    for (int e2 = 0; e2 < 16; ++e2) tv[e2] = trow[e2] * c1[e2];
#pragma unroll
                    for (int q = 0; q < 2; ++q) {
                        u32x4 o1, o2;
#pragma unroll
                        for (int e2 = 0; e2 < 4; ++e2) {
                            const int i0 = 8 * q + 2 * e2;
                            const uint32_t hi = pack_bf2(tv[i0], tv[i0 + 1]);
                            const float r0 = tv[i0] - __uint_as_float(hi << 16), r1 = tv[i0 + 1] - __uint_as_float(hi & 0xffff0000u);
                            o1[e2] = hi;
                            o2[e2] = pack_bf2(r0, r1);
                        }
                        *(u32x4*)(sA + lds_off(tr, 2 * cq + q)) = o1;
                        *(u32x4*)(sKd + lds_off(tr, 2 * cq + q)) = o2;
                    }
                }
                __syncthreads();
                f32x4 U[4];
                acc4_zero(U);
                {
                    const char* sX = isw ? sK : sV;
#pragma unroll
                    for (int ks = 0; ks < 2; ++ks) {
                        const bf16x8 a1 = *(const bf16x8*)(sA + lds_off(16 * w3 + l15c, ks * 4 + lqc));
                        const bf16x8 a2 = *(const bf16x8*)(sKd + lds_off(16 * w3 + l15c, ks * 4 + lqc));
                        const int r0 = 32 * ks + 8 * lqc + (l15c >> 2);
                        const int p0 = d ? 63 - r0 : r0, p1 = d ? 63 - (r0 + 4) : (r0 + 4);
#pragma unroll
                        for (int nt = 0; nt < 4; ++nt) {
                            const int col = 16 * nt + 4 * (l15c & 3);
                            const s16x4 v0 = ds_tr(sX + el_off(p0, col)), v1 = ds_tr(sX + el_off(p1, col));
                            const bf16x8 bx = __builtin_shufflevector(v0, v1, 0, 1, 2, 3, 4, 5, 6, 7);
                            U[nt] = __builtin_amdgcn_mfma_f32_16x16x32_bf16(a1, bx, U[nt], 0, 0, 0);
                            U[nt] = __builtin_amdgcn_mfma_f32_16x16x32_bf16(a2, bx, U[nt], 0, 0, 0);
                        }
                    }
                }
                __syncthreads();
                if (isw == 0) {
                    U0[0] = U[0]; U0[1] = U[1]; U0[2] = U[2]; U0[3] = U[3];
                } else {
                    char* uT = sL + d * DN_LBYTES;
                    char* wT = uT + 8192;
                    const int t0 = 16 * w3 + 4 * lqc;
#pragma unroll
                    for (int nt = 0; nt < 4; ++nt) {
                        uint2 ou, ow;
                        ou.x = pack_bf2(U0[nt][0], U0[nt][1]); ou.y = pack_bf2(U0[nt][2], U0[nt][3]);
                        ow.x = pack_bf2(U[nt][0], U[nt][1]); ow.y = pack_bf2(U[nt][2], U[nt][3]);
                        *(uint2*)(uT + el_off(16 * nt + l15c, t0)) = ou;
                        *(uint2*)(wT + el_off(16 * nt + l15c, t0)) = ow;
                    }
                    __syncthreads();
                }
            }
        }
        int tid5 = tid;
        asm volatile("" : "+v"(tid5) :: "memory");
        const int lane5 = tid5 & 63, w5 = tid5 >> 6, l15_5 = lane5 & 15, lq5 = lane5 >> 4;
        f32x4 QK[4];
        acc4_zero(QK);
        mm64(QK, sQ, 16 * w5, sK, l15_5, lq5);
#pragma unroll 1
        for (int d = 0; d < 2; ++d) {
            const float* gcd = sS + (d * 5 + 1) * 64;
            const float* egd = sS + (d * 5 + 2) * 64;
            const float* ekd = sS + (d * 5 + 3) * 64;
            {
                const int i = lane5, tq = w5;
                float kv[16];
#pragma unroll
                for (int e = 0; e < 16; ++e) {
                    const int tp = tq * 16 + e, pos = d ? 63 - tp : tp;
                    kv[e] = bf2f(*(const bf16_t*)(sK + el_off(pos, i))) * ekd[tp];
                }
#pragma unroll
                for (int q = 0; q < 2; ++q) {
                    u32x4 o;
                    o[0] = pack_bf2(kv[8 * q + 0], kv[8 * q + 1]); o[1] = pack_bf2(kv[8 * q + 2], kv[8 * q + 3]);
                    o[2] = pack_bf2(kv[8 * q + 4], kv[8 * q + 5]); o[3] = pack_bf2(kv[8 * q + 6], kv[8 * q + 7]);
                    *(u32x4*)(sKd + lds_off(i, 2 * tq + q)) = o;
                }
            }
#pragma unroll
            for (int nt = 0; nt < 4; ++nt)
#pragma unroll
                for (int rg = 0; rg < 4; ++rg) {
                    const int t = 16 * w5 + 4 * lq5 + rg, s = 16 * nt + l15_5;
                    const int tp = d ? 63 - t : t, sp = d ? 63 - s : s;
                    const float val = (sp <= tp) ? QK[nt][rg] * __expf(gcd[tp] - gcd[sp]) : 0.f;
                    *(bf16_t*)(sA + el_off(tp, sp)) = f2bf(val);
                }
            __syncthreads();
            const char* uT = sL + d * DN_LBYTES;
            const char* wT = uT + 8192;
            const int cd = (d == 0) ? pb : (pb < 4 ? 3 - pb : 39 - pb);
            bf16_t* Mg = p.MH + ((size_t)((bh * 2 + d) * 36 + cd) * 2) * 4096;
            bf16_t* Hg = Mg + 4096;
            {
                f32x4 MT[4];
                acc4_zero(MT);
                mm64(MT, wT, 16 * w5, sKd, l15_5, lq5);
                const float egl = egd[63];
                const int j0 = 16 * w5 + 4 * lq5;
#pragma unroll
                for (int nt = 0; nt < 4; ++nt) {
                    const int i = 16 * nt + l15_5;
                    f32x4 o;
#pragma unroll
                    for (int e = 0; e < 4; ++e) o[e] = ((i == j0 + e) ? egl : 0.f) - MT[nt][e];
                    st_bf4(Mg + i * 64 + j0, o);
                }
            }
            {
                f32x4 HH[4];
                acc4_zero(HH);
                mm64(HH, sKd, 16 * w5, uT, l15_5, lq5);
                const int i0 = 16 * w5 + 4 * lq5;
#pragma unroll
                for (int nt = 0; nt < 4; ++nt) st_bf4(Hg + (16 * nt + l15_5) * 64 + i0, HH[nt]);
            }
            if (lat) {
                bf16_t* Eg = p.EF + ((size_t)((bh * 2 + d) * 32 + (pb - 4)) * 2) * 4096;
                bf16_t* Fg = Eg + 4096;
                {
                    f32x4 ET[4];
                    acc4_zero(ET);
                    mm64(ET, wT, 16 * w5, sA, l15_5, lq5);
                    const int j0 = 16 * w5 + 4 * lq5;
#pragma unroll
                    for (int nt = 0; nt < 4; ++nt) {
                        const int sp = 16 * nt + l15_5, spos = d ? 63 - sp : sp;
                        const f32x4 qv = ld_bf4((const bf16_t*)(sQ + el_off(spos, j0)));
                        const float eg = egd[sp];
                        f32x4 o;
#pragma unroll
                        for (int e = 0; e < 4; ++e) o[e] = qv[e] * eg - ET[nt][e];
                        st_bf4(Eg + spos * 64 + j0, o);
                    }
                }
                {
                    f32x4 FF[4];
                    acc4_zero(FF);
                    mm64(FF, sA, 16 * w5, uT, l15_5, lq5);
                    const int s0 = 16 * w5 + 4 * lq5;
#pragma unroll
                    for (int nt = 0; nt < 4; ++nt) {
                        const int c = 16 * nt + l15_5;
                        if (d == 0) st_bf4(Fg + c * 64 + s0, FF[nt]);
                        else st_bf4(Fg + c * 64 + (60 - s0), (f32x4){FF[nt][3], FF[nt][2], FF[nt][1], FF[nt][0]});
                    }
                }
            }
            __syncthreads();
        }
    }
}

__device__ __forceinline__ void ph_dn2(const Params& p, int bid, int nb, char* smem) {
    if (bid >= 128) return;
    const int tid = threadIdx.x, lane = tid & 63, w = tid >> 6, l15 = lane & 15, lq = lane >> 4;
    const int chain = bid, d = chain & 1;
    const bf16_t* MHc = p.MH + (size_t)chain * 36 * 2 * 4096;
    bf16_t* STc = p.ST + (size_t)chain * 32 * 4096;
    for (int i = tid; i < 8192 / 16; i += NTHR) *(u32x4*)(smem + i * 16) = (u32x4){0u, 0u, 0u, 0u};
    __syncthreads();
    const int i0 = 16 * w + 4 * lq;
    bf16x8 am[2]; uint2 hr[4];
    {
        const bf16_t* Mg = MHc;
#pragma unroll
        for (int ks = 0; ks < 2; ++ks) am[ks] = *(const bf16x8*)(Mg + (16 * w + l15) * 64 + ks * 32 + lq * 8);
#pragma unroll
        for (int nt = 0; nt < 4; ++nt) hr[nt] = *(const uint2*)(Mg + 4096 + (16 * nt + l15) * 64 + i0);
    }
    for (int c = 0; c < 36; ++c) {
        bf16x8 amn[2]; uint2 hrn[4];
        if (c + 1 < 36) {
            const bf16_t* Mg = MHc + (size_t)(c + 1) * 2 * 4096;
#pragma unroll
            for (int ks = 0; ks < 2; ++ks) amn[ks] = *(const bf16x8*)(Mg + (16 * w + l15) * 64 + ks * 32 + lq * 8);
#pragma unroll
            for (int nt = 0; nt < 4; ++nt) hrn[nt] = *(const uint2*)(Mg + 4096 + (16 * nt + l15) * 64 + i0);
        }
        const char* sS = smem + (c & 1) * 8192;
        char* sN = smem + ((c + 1) & 1) * 8192;
        f32x4 acc[4];
#pragma unroll
        for (int nt = 0; nt < 4; ++nt)
            acc[nt] = (f32x4){__uint_as_float(hr[nt].x << 16), __uint_as_float(hr[nt].x & 0xffff0000u),
                              __uint_as_float(hr[nt].y << 16), __uint_as_float(hr[nt].y & 0xffff0000u)};
#pragma unroll
        for (int ks = 0; ks < 2; ++ks)
#pragma unroll
            for (int nt = 0; nt < 4; ++nt) {
                const bf16x8 bs = *(const bf16x8*)(sS + lds_off(16 * nt + l15, ks * 4 + lq));
                acc[nt] = __builtin_amdgcn_mfma_f32_16x16x32_bf16(am[ks], bs, acc[nt], 0, 0, 0);
            }
        const int cn = c + 1;
        const bool st = (cn >= 4 && cn <= 35);
        const int pbi = (d == 0 ? cn : 39 - cn) - 4;
#pragma unroll
        for (int nt = 0; nt < 4; ++nt) {
            uint2 o; o.x = pack_bf2(acc[nt][0], acc[nt][1]); o.y = pack_bf2(acc[nt][2], acc[nt][3]);
            const int cc = 16 * nt + l15;
            *(uint2*)(sN + el_off(cc, i0)) = o;
            if (st) *(uint2*)(STc + (size_t)pbi * 4096 + cc * 64 + i0) = o;
        }
        if (c + 1 < 36) {
#pragma unroll
            for (int ks = 0; ks < 2; ++ks) am[ks] = amn[ks];
#pragma unroll
            for (int nt = 0; nt < 4; ++nt) hr[nt] = hrn[nt];
        }
        __syncthreads();
    }
}

__device__ __forceinline__ void ph_dn3(const Params& p, int bid, int nb, char* smem) {
    const int tid = threadIdx.x, lane = tid & 63, w = tid >> 6, l15 = lane & 15, lq = lane >> 4;
    for (int u = bid; u < 64 * 32; u += nb) {
        const int bh = u >> 5, pbi = u & 31, b = bh >> 3, h = bh & 7;
        const int s0 = 16 * w + 4 * lq;
        f32x4 acc[4];
        acc4_zero(acc);
#pragma unroll
        for (int d = 0; d < 2; ++d) {
            const bf16_t* Eg = p.EF + ((size_t)((bh * 2 + d) * 32 + pbi) * 2) * 4096;
            const bf16_t* Fg = Eg + 4096;
            const bf16_t* Sg = p.ST + ((size_t)(bh * 2 + d) * 32 + pbi) * 4096;
#pragma unroll
            for (int nt = 0; nt < 4; ++nt) acc[nt] += ld_bf4(Fg + (16 * nt + l15) * 64 + s0);
#pragma unroll
            for (int ks = 0; ks < 2; ++ks) {
                const bf16x8 ae = *(const bf16x8*)(Eg + (16 * w + l15) * 64 + ks * 32 + lq * 8);
#pragma unroll
                for (int nt = 0; nt < 4; ++nt) {
                    const bf16x8 bs = *(const bf16x8*)(Sg + (16 * nt + l15) * 64 + ks * 32 + lq * 8);
                    acc[nt] = __builtin_amdgcn_mfma_f32_16x16x32_bf16(ae, bs, acc[nt], 0, 0, 0);
                }
            }
        }
        const size_t rl0 = (size_t)b * SEQ + pbi * 64;
#pragma unroll
        for (int rg = 0; rg < 4; ++rg) {
            float ss = 0.f;
#pragma unroll
            for (int nt = 0; nt < 4; ++nt) ss += acc[nt][rg] * acc[nt][rg];
            ss = row16_sum(ss);
            const float rstd = rsqrtf(ss * (1.f / 64.f) + EPSF);
            const size_t rl = rl0 + s0 + rg;
#pragma unroll
            for (int nt = 0; nt < 4; ++nt) {
                const int c = 16 * nt + l15;
                const float zd = bf2f(p.Pz[rl * PZ_W + 512 + h * 64 + c]);
                p.A_dn[rl * 512 + h * 64 + c] = f2bf(acc[nt][rg] * rstd * p.dn_norm_w[c] * silu_f(zd));
            }
        }
    }
    for (size_t i = (size_t)bid * NTHR + tid; i < (size_t)NL * 64; i += (size_t)nb * NTHR) {
        const size_t rl = i >> 6; const int c8 = (int)(i & 63) * 8;
        const u32x4 ov = *(const u32x4*)(p.o_mla + rl * 512 + c8);
        const u32x4 zv = *(const u32x4*)(p.Pz + rl * PZ_W + c8);
        u32x4 r;
#pragma unroll
        for (int e = 0; e < 4; ++e) {
            const float o0 = __uint_as_float(ov[e] << 16), o1 = __uint_as_float(ov[e] & 0xffff0000u);
            const float z0 = __uint_as_float(zv[e] << 16), z1 = __uint_as_float(zv[e] & 0xffff0000u);
            r[e] = pack_bf2(o0 * silu_f(z0), o1 * silu_f(z1));
        }
        *(u32x4*)(p.A_mla + rl * 512 + c8) = r;
    }
}


__device__ __forceinline__ void ph_inproj(const Params& p, int bid, int nb, char* smem) {
    const int UA = 144 * 18, UZ = 128 * 8;
    const bf16_t* hl = p.h + (size_t)NCTX * DM;
    int u, tm, tn;
    for (int it = 0; next_unit(it, UA + UZ, bid, nb, u); ++it) {
        if (u < UA) { unit_mn(u, 18, tm, tn); gemm_store_bf16(p.h, DM, p.Wt_a, 1024, tm, tn, p.Pa, PA_W, smem); }
        else { unit_mn(u - UA, 8, tm, tn); gemm_store_bf16(hl, DM, p.Wt_z, 1024, tm, tn, p.Pz, PZ_W, smem); }
    }
}

__device__ __forceinline__ void ph_gates(const Params& p, int bid, int nb, char* smem) {
    const bf16_t* hl = p.h + (size_t)NCTX * DM;
    int u, tm, tn;
    for (int it = 0; next_unit(it, 128 * 16, bid, nb, u); ++it) {
        unit_mn(u, 16, tm, tn);
        gemm_store_bf16(hl, DM, p.Wt_g, 1024, tm, tn, p.Pg, PG_W, smem);
    }
}

__device__ __forceinline__ void ph_merge(const Params& p, int bid, int nb, char* smem) {
    int u, tm, tn;
    for (int it = 0; next_unit(it, 128 * 8, bid, nb, u); ++it) {
        unit_mn(u, 8, tm, tn);
        const int m0 = tm * 128, n0 = tn * 128;
        f32x4 acc[4][4];
        uint2 mm[4][4];
        acc_zero<4>(acc);
        gemm_tile_acc<4>(acc, p.A_mla, 512, p.Wt_mo, 512, 512, m0, n0, smem);
        {
        EPI_COORDS_OPAQUE(a)
#pragma unroll
        for (int nt = 0; nt < 4; ++nt)
#pragma unroll
            for (int mt = 0; mt < 4; ++mt) {
                const f32x4 g = ld_bf4(p.Pg + (size_t)EPI_ROW(mt) * PG_W + EPI_COL(nt));
                mm[nt][mt].x = pack_bf2(sigmoid_f(g[0]) * acc[nt][mt][0], sigmoid_f(g[1]) * acc[nt][mt][1]);
                mm[nt][mt].y = pack_bf2(sigmoid_f(g[2]) * acc[nt][mt][2], sigmoid_f(g[3]) * acc[nt][mt][3]);
            }
        }
        acc_zero<4>(acc);
        gemm_tile_acc<4>(acc, p.A_dn, 512, p.Wt_do, 512, 512, m0, n0, smem);
        {
        EPI_COORDS_OPAQUE(b)
#pragma unroll
        for (int nt = 0; nt < 4; ++nt)
#pragma unroll
            for (int mt = 0; mt < 4; ++mt) {
                const f32x4 g = ld_bf4(p.Pg + (size_t)EPI_ROW(mt) * PG_W + 1024 + EPI_COL(nt));
                f32x4 o;
                o[0] = __uint_as_float(mm[nt][mt].x << 16) + sigmoid_f(g[0]) * acc[nt][mt][0];
                o[1] = __uint_as_float(mm[nt][mt].x & 0xffff0000u) + sigmoid_f(g[1]) * acc[nt][mt][1];
                o[2] = __uint_as_float(mm[nt][mt].y << 16) + sigmoid_f(g[2]) * acc[nt][mt][2];
                o[3] = __uint_as_float(mm[nt][mt].y & 0xffff0000u) + sigmoid_f(g[3]) * acc[nt][mt][3];
                st_bf4(p.Mb + (size_t)EPI_ROW(mt) * 1024 + EPI_COL(nt), o);
            }
        }
    }
}

__device__ __forceinline__ void ph_out(const Params& p, int bid, int nb, char* smem) {
    int u, tm, tn;
    for (int it = 0; next_unit(it, 128 * 8, bid, nb, u); ++it) {
        unit_mn(u, 8, tm, tn);
        const int m0 = tm * 128, n0 = tn * 128;
        f32x4 acc[4][4];
        EPI_COORDS
        acc_zero<4>(acc);
        gemm_tile_acc<4>(acc, p.Mb, 1024, p.Wt_out, 1024, 1024, m0, n0, smem);
#pragma unroll
        for (int nt = 0; nt < 4; ++nt)
#pragma unroll
            for (int mt = 0; mt < 4; ++mt) {
                const int row = EPI_ROW(mt), col = EPI_COL(nt);
                const f32x4 gate = *(const f32x4*)(p.mod + (row / SEQ) * 3072 + 2048 + col);
                const f32x4 xv = *(const f32x4*)(p.x + (size_t)row * DM + col);
                *(f32x4*)(p.out + (size_t)row * DM + col) = xv + gate * acc[nt][mt];
            }
    }
}

#define XB_TMO      128
#define XB_XCNT(j)  (256  + 64 * (j))
#define XB_XSUB(j)  (1280 + 64 * (j))
#define XB_XGEN(j)  (2304 + 64 * (j))
#define XB_TOP      3328
#define XB_TOPGEN   3392
#define XCD_BAR_WORDS 3456
#define XB_SPIN_CAP (1u << 20)
__device__ __forceinline__ unsigned xb_ld(unsigned* p)              { return __hip_atomic_load(p, __ATOMIC_RELAXED, __HIP_MEMORY_SCOPE_AGENT); }
__device__ __forceinline__ unsigned xb_add(unsigned* p, unsigned v) { return __hip_atomic_fetch_add(p, v, __ATOMIC_RELAXED, __HIP_MEMORY_SCOPE_AGENT); }
__device__ __forceinline__ unsigned xb_xcc_id() { return (unsigned)__builtin_amdgcn_s_getreg((3 << 11) | 20) & 0xFu; }
#define XB_SPIN(cond, bar) do { unsigned _sp = 0; while (cond) { __builtin_amdgcn_s_sleep(1); \
    if ((++_sp & 255u) == 0u) { if (xb_ld(&(bar)[XB_TMO])) break; if (_sp > XB_SPIN_CAP) { atomicAdd(&(bar)[XB_TMO], 1u); break; } } } } while (0)
struct XcdBarrier { unsigned* bar; unsigned x; volatile LAS unsigned* st; };
__device__ __forceinline__ XcdBarrier xcd_barrier_post(unsigned* bar, volatile LAS unsigned* st) {
    XcdBarrier b; b.bar = bar; b.x = xb_xcc_id(); b.st = st;
    if (threadIdx.x == 0) (void)xb_add(&bar[XB_XCNT(b.x)], 1u);
    return b;
}
__device__ __forceinline__ void xcd_barrier_complete(unsigned* bar, unsigned x, unsigned& nloc, unsigned& nx) {
    const unsigned G = gridDim.x * gridDim.y * gridDim.z;
    unsigned sum, cnt, mine, sp = 0u;
    for (;;) {
        sum = 0u; cnt = 0u; mine = 0u;
#pragma unroll
        for (unsigned j = 0; j < 16; ++j) { const unsigned c = xb_ld(&bar[XB_XCNT(j)]); sum += c; cnt += (c > 0u) ? 1u : 0u; mine = (j == x) ? c : mine; }
        if (sum == G) break;
        __builtin_amdgcn_s_sleep(1);
        if ((++sp & 255u) == 0u) { if (xb_ld(&bar[XB_TMO])) break; if (sp > XB_SPIN_CAP) { atomicAdd(&bar[XB_TMO], 1u); break; } }
    }
    nloc = mine > 0u ? mine : 1u; nx = cnt > 0u ? cnt : 1u;
}
__device__ __forceinline__ void xcd_barrier(const XcdBarrier& b) {
    asm volatile("s_waitcnt vmcnt(0)" ::: "memory");
    __syncthreads();
    if (threadIdx.x == 0) {
        unsigned* bar = b.bar;
        __builtin_amdgcn_s_waitcnt(0);
        unsigned nloc = b.st[0], nx = b.st[1];
        if (nloc == 0u) { xcd_barrier_complete(bar, b.x, nloc, nx); b.st[0] = nloc; b.st[1] = nx; }
        const unsigned old = xb_add(&bar[XB_XSUB(b.x)], 1u);
        const unsigned gen = old / nloc;
        if (old + 1u == (gen + 1u) * nloc) {
            __builtin_amdgcn_fence(__ATOMIC_RELEASE, "agent");
            asm volatile("s_waitcnt vmcnt(0)" ::: "memory");
            const unsigned og = xb_add(&bar[XB_TOP], 1u);
            const unsigned tg = og / nx;
            if (og + 1u == (tg + 1u) * nx) xb_add(&bar[XB_TOPGEN], 1u);
            else XB_SPIN(xb_ld(&bar[XB_TOPGEN]) == tg, bar);
            __builtin_amdgcn_fence(__ATOMIC_ACQUIRE, "agent");
            xb_add(&bar[XB_XGEN(b.x)], 1u);
            asm volatile("s_waitcnt vmcnt(0)" ::: "memory");
        } else {
            XB_SPIN(xb_ld(&bar[XB_XGEN(b.x)]) == gen, bar);
            __builtin_amdgcn_fence(__ATOMIC_ACQUIRE, "agent");
            asm volatile("s_waitcnt vmcnt(0)" ::: "memory");
        }
    }
    __syncthreads();
}

__global__ void __launch_bounds__(NTHR, 2) fwd_megakernel(Params p) {
    __shared__ __attribute__((aligned(16))) char smem[SMEM_BYTES];
    const int bid = blockIdx.x, nb = gridDim.x;
    volatile LAS unsigned* bst = (volatile LAS unsigned*)(smem + SMEM_BYTES - 16);
    if (threadIdx.x == 0) { bst[0] = 0u; bst[1] = 0u; }
    __syncthreads();
    const XcdBarrier xb = xcd_barrier_post(p.bar, bst);

    ph_mod(p, bid, nb, smem);
    ph_wprep(p, bid, nb, smem);
    xcd_barrier(xb);
    ph_norm(p, bid, nb, smem);
    xcd_barrier(xb);
    ph_inproj(p, bid, nb, smem);
    xcd_barrier(xb);
    ph_mla_proj(p, bid, nb, smem);
    xcd_barrier(xb);
    ph_attn(p, bid, nb, smem);
    xcd_barrier(xb);
    ph_dn1(p, bid, nb, smem);
    xcd_barrier(xb);
    ph_dn2(p, bid, nb, smem);
    xcd_barrier(xb);
    ph_dn3(p, bid, nb, smem);
    ph_gates(p, bid, nb, smem);
    xcd_barrier(xb);
    ph_merge(p, bid, nb, smem);
    xcd_barrier(xb);
    ph_out(p, bid, nb, smem);
}

extern "C" void kernel_launch(void* const* d_in, const int* in_sizes, int n_in,
                              void* d_out, int out_size, void* d_ws, size_t ws_size,
                              hipStream_t stream) {
    static int grid_blocks = 0;
    if (!grid_blocks) {
        int dev = 0, cus = 0, per_cu = 0;
        (void)hipGetDevice(&dev);
        (void)hipDeviceGetAttribute(&cus, hipDeviceAttributeMultiprocessorCount, dev);
        (void)hipOccupancyMaxActiveBlocksPerMultiprocessor(&per_cu, fwd_megakernel, NTHR, 0);
        if (per_cu > 2) per_cu = 2;
        if (per_cu < 1) per_cu = 1;
        grid_blocks = cus * per_cu;
    }
    Params p{};
    const float** fp = (const float**)&p;
    for (int i = 0; i < 21; ++i) fp[i] = (const float*)d_in[i];
    p.out = (float*)d_out;
    char* ws = (char*)d_ws;
    char* ob = (char*)d_out;
    const size_t R_W = 0;
    const size_t R_H = 16777216;
    const size_t R_Z = R_H + 37748736;
    const size_t R_A = R_Z + 33554432;
    const size_t R_F = R_A + 84934656;
    {
        size_t o = R_W;
        p.Wt_a = (bf16_t*)(ws + o); o += 4718592;
        p.Wt_z = (bf16_t*)(ws + o); o += 2097152;
        p.Wt_g = (bf16_t*)(ws + o); o += 4194304;
        p.Wt_uq = (bf16_t*)(ws + o); o += 589824;
        p.Wt_ukv = (bf16_t*)(ws + o); o += 524288;
        p.Wt_mo = (bf16_t*)(ws + o); o += 1048576;
        p.Wt_do = (bf16_t*)(ws + o); o += 1048576;
        p.Wt_out = (bf16_t*)(ws + o); o += 2097152;
        p.mod = (float*)(ws + o); o += 110592;
        p.bar = (unsigned*)(ws + o); o += XCD_BAR_WORDS * 4;
        p.rope = (float*)(ws + o); o += 4096;
    }
    p.h = (bf16_t*)(ws + R_H);
    p.Pz = (bf16_t*)(ws + R_Z);
    p.Pa = (bf16_t*)(ws + R_A);
    p.qn = (bf16_t*)(ws + R_F);
    p.kvn = (bf16_t*)(ws + R_F + 12582912);
    p.Qb = (bf16_t*)(ws + R_F + 22020096);
    p.Kb = (bf16_t*)(ws + R_F + 47185920);
    p.Vt = (bf16_t*)(ws + R_F + 75497472);
    p.Qraw = (bf16_t*)(ob);
    p.KVraw = (bf16_t*)(ob + 25165824);
    p.o_mla = (bf16_t*)(ws + R_F);
    p.MH = (bf16_t*)(ws + R_F + 16777216);
    p.EF = (bf16_t*)(ob);
    p.ST = (bf16_t*)(ws + R_A);
    p.A_mla = (bf16_t*)(ws + R_A + 33554432);
    p.A_dn = (bf16_t*)(ws + R_A + 50331648);
    p.Pg = (bf16_t*)(ws + R_F + 16777216);
    p.Mb = (bf16_t*)(ws + R_H);
    (void)hipMemsetAsync(p.mod, 0, 110592 + XCD_BAR_WORDS * 4, stream);
    void* args[] = {&p};
    hipError_t err = hipLaunchCooperativeKernel((void*)fwd_megakernel, dim3(grid_blocks), dim3(NTHR), args, 0, stream);
    if (err != hipSuccess) fprintf(stderr, "cooperative launch failed: %s (grid %d)\n", hipGetErrorString(err), grid_blocks);
}
```

```cpp
#include <hip/hip_runtime.h>
#include <hip/hip_cooperative_groups.h>
#include <stdint.h>
#include <cstdio>
namespace cg = cooperative_groups;

typedef uint16_t bf16_t;
#define LAS __attribute__((address_space(3)))

#define NB 8
#define SEQ 2048
#define CTXL 256
#define TPB 2304
#define NCTX 2048
#define NL 16384
#define NT 18432
#define DM 1024
#define IN_DIM 5312
#define PA_W 2304
#define PZ_W 1024
#define PG_W 2048
#define PA_CQ 0
#define PA_CKV 384
#define PA_KR 640
#define PA_DQ 672
#define PA_DK 1184
#define PA_DV 1696
#define PA_DB 2208
#define PA_DA 2224
#define EPSF 1e-6f
#define NTHR 256
#define SMEM_BYTES 77824

struct Params {
    const float *x, *c, *ctx, *c_ctx, *w_mod, *b_mod, *norm_w, *w_in, *q_norm_w, *w_uq, *kv_norm_w, *w_ukv, *qhn_w, *khn_w,
        *mla_w_o, *conv_w, *a_log, *dt_bias, *dn_norm_w, *dn_w_o, *w_out;
    float* out;
    bf16_t *h, *Pa, *Pz, *Pg, *Qb, *Vt, *qn, *kvn, *Qraw, *KVraw, *Kb, *o_mla, *MH, *EF, *ST, *A_mla, *A_dn, *Mb;
    bf16_t *Wt_a, *Wt_z, *Wt_g, *Wt_uq, *Wt_ukv, *Wt_mo, *Wt_do, *Wt_out;
    float *mod, *rope;
    unsigned* bar;
};

__device__ __forceinline__ float bf2f(bf16_t v) { return __uint_as_float(((uint32_t)v) << 16); }
__device__ __forceinline__ bf16_t f2bf(float f) {
    uint32_t u = __float_as_uint(f);
    u += 0x7fffu + ((u >> 16) & 1u);
    return (bf16_t)(u >> 16);
}
__device__ __forceinline__ float silu_f(float v) { return v * __builtin_amdgcn_rcpf(1.f + __expf(-v)); }
__device__ __forceinline__ float sigmoid_f(float v) { return __builtin_amdgcn_rcpf(1.f + __expf(-v)); }
template <int CTRL> __device__ __forceinline__ float dpp_mov(float v) {
    return __builtin_bit_cast(float, __builtin_amdgcn_update_dpp(0, __builtin_bit_cast(int, v), CTRL, 0xF, 0xF, true));
}
__device__ __forceinline__ float row16_sum(float v) {
    v += dpp_mov<0xB1>(v); v += dpp_mov<0x4E>(v); v += dpp_mov<0x141>(v); v += dpp_mov<0x140>(v); return v;
}
__device__ __forceinline__ float rdlane(float v, int l) { return __builtin_bit_cast(float, __builtin_amdgcn_readlane(__builtin_bit_cast(int, v), l)); }
__device__ __forceinline__ float wave_sum(float v) {
    v += dpp_mov<0xB1>(v);
    v += dpp_mov<0x4E>(v);
    v += dpp_mov<0x141>(v);
    v += dpp_mov<0x140>(v);
    return (rdlane(v, 0) + rdlane(v, 16)) + (rdlane(v, 32) + rdlane(v, 48));
}
__device__ __forceinline__ float xrow_sum(float v) { v += __shfl_xor(v, 16); v += __shfl_xor(v, 32); return v; }
__device__ __forceinline__ float wave_max(float v) {
#pragma unroll
    for (int o = 32; o > 0; o >>= 1) v = fmaxf(v, __shfl_xor(v, o));
    return v;
}
__device__ __forceinline__ float block_sum256(float v, float* sh) {
    v = wave_sum(v);
    __syncthreads();
    if ((threadIdx.x & 63) == 0) sh[threadIdx.x >> 6] = v;
    __syncthreads();
    return sh[0] + sh[1] + sh[2] + sh[3];
}

__device__ __forceinline__ void ph_mod(const Params& p, int bid, int nb, char* smem) {
    float* sc = (float*)smem;
    for (int item = bid; item < 64; item += nb) {
        const int k0 = item * 16, tid = threadIdx.x;
        __syncthreads();
        if (tid < 144) {
            const int r = tid >> 4, kk = tid & 15;
            const float v = (r < 8) ? p.c[r * 1024 + k0 + kk] : p.c_ctx[k0 + kk];
            sc[tid] = silu_f(v);
        }
        __syncthreads();
#pragma unroll 1
        for (int half = 0; half < 2; ++half) {
            float acc[6][9];
#pragma unroll
            for (int q = 0; q < 6; ++q)
#pragma unroll
                for (int r = 0; r < 9; ++r) acc[q][r] = 0.f;
            const float* wp = p.w_mod + (size_t)k0 * 3072 + half * 1536 + tid;
#pragma unroll 4
            for (int kk = 0; kk < 16; ++kk) {
                float wv[6];
#pragma unroll
                for (int q = 0; q < 6; ++q) wv[q] = wp[(size_t)kk * 3072 + q * 256];
#pragma unroll
                for (int r = 0; r < 9; ++r) {
                    const float s = sc[r * 16 + kk];
#pragma unroll
                    for (int q = 0; q < 6; ++q) acc[q][r] += s * wv[q];
                }
            }
#pragma unroll
            for (int q = 0; q < 6; ++q) {
                const int j = half * 1536 + q * 256 + tid;
                const float bb = (item == 0) ? p.b_mod[j] : 0.f;
#pragma unroll
                for (int r = 0; r < 9; ++r) atomicAdd(p.mod + r * 3072 + j, acc[q][r] + bb);
            }
        }
    }
}

__device__ __forceinline__ void ph_norm(const Params& p, int bid, int nb, char* smem) {
    float* sh = (float*)smem;
    for (int r = bid; r < NT; r += nb) {
        const float* src; int mrow;
        if (r < NCTX) { src = p.ctx + (size_t)r * DM; mrow = 8; }
        else { const int rl = r - NCTX; src = p.x + (size_t)rl * DM; mrow = rl / SEQ; }
        const float4 v = ((const float4*)src)[threadIdx.x];
        float ss = v.x * v.x + v.y * v.y + v.z * v.z + v.w * v.w;
        ss = block_sum256(ss, sh);
        const float rstd = rsqrtf(ss * (1.f / 1024.f) + EPSF);
        const float* shift = p.mod + mrow * 3072;
        const float* scale = shift + 1024;
        const int k = threadIdx.x * 4;
        float vv[4] = {v.x, v.y, v.z, v.w};
#pragma unroll
        for (int i = 0; i < 4; ++i) {
            float y = vv[i] * rstd * p.norm_w[k + i];
            y = y * (1.f + scale[k + i]) + shift[k + i];
            p.h[(size_t)r * DM + k + i] = f2bf(y);
        }
    }
}

typedef __bf16 bf16v2_t __attribute__((ext_vector_type(2)));
typedef float f32x2 __attribute__((ext_vector_type(2)));
__device__ __forceinline__ uint32_t pack_bf2(float lo, float hi) {
    f32x2 v = {lo, hi};
    bf16v2_t b = __builtin_convertvector(v, bf16v2_t);
    return __builtin_bit_cast(uint32_t, b);
}

__device__ __forceinline__ void wprep_unit(const float* __restrict__ W, int ldw, int K, int n0, int k0, int srcbase, bf16_t* __restrict__ dst, float* tile,
                                           const float* __restrict__ kscale) {
    const int tid = threadIdx.x;
    {
        const int n4 = (tid & 7) * 4, kk = tid >> 3;
#pragma unroll
        for (int half = 0; half < 2; ++half) {
            const int k = kk + 32 * half;
            float4 v = make_float4(0.f, 0.f, 0.f, 0.f);
            if (srcbase >= 0) v = *(const float4*)(W + (size_t)(k0 + k) * ldw + srcbase + n4);
            if (kscale) { const float s = kscale[k0 + k]; v.x *= s; v.y *= s; v.z *= s; v.w *= s; }
            float* t = tile + k * 33 + n4;
            t[0] = v.x; t[1] = v.y; t[2] = v.z; t[3] = v.w;
        }
    }
    __syncthreads();
    {
        const int n = tid >> 3, kc = tid & 7;
        const float* t = tile + (kc * 8) * 33 + n;
        uint4 o;
        o.x = pack_bf2(t[0 * 33], t[1 * 33]); o.y = pack_bf2(t[2 * 33], t[3 * 33]);
        o.z = pack_bf2(t[4 * 33], t[5 * 33]); o.w = pack_bf2(t[6 * 33], t[7 * 33]);
        *(uint4*)(dst + (size_t)(n0 + n) * K + k0 + kc * 8) = o;
    }
    __syncthreads();
}

__device__ __forceinline__ void ph_wprep(const Params& p, int bid, int nb, char* smem) {
    float* tile = (float*)smem;
    const int U0 = 72 * 16, U1 = 32 * 16, U2 = 64 * 16, U3 = 24 * 6, U4 = 32 * 4, U5 = 32 * 8, U6 = 32 * 8, U7 = 32 * 16;
    const int UT = U0 + U1 + U2 + U3 + U4 + U5 + U6 + U7;
    for (int u = bid; u < UT; u += nb) {
        int v = u;
        const float* W; int ldw, K; bf16_t* dst; int job;
        if (v < U0) { job = 0; W = p.w_in; ldw = IN_DIM; K = 1024; dst = p.Wt_a; }
        else if ((v -= U0) < U1) { job = 1; W = p.w_in; ldw = IN_DIM; K = 1024; dst = p.Wt_z; }
        else if ((v -= U1) < U2) { job = 2; W = p.w_in; ldw = IN_DIM; K = 1024; dst = p.Wt_g; }
        else if ((v -= U2) < U3) { job = 3; W = p.w_uq; ldw = 768; K = 384; dst = p.Wt_uq; }
        else if ((v -= U3) < U4) { job = 4; W = p.w_ukv; ldw = 1024; K = 256; dst = p.Wt_ukv; }
        else if ((v -= U4) < U5) { job = 5; W = p.mla_w_o; ldw = 1024; K = 512; dst = p.Wt_mo; }
        else if ((v -= U5) < U6) { job = 6; W = p.dn_w_o; ldw = 1024; K = 512; dst = p.Wt_do; }
        else { v -= U6; job = 7; W = p.w_out; ldw = 1024; K = 1024; dst = p.Wt_out; }
        const int nkt = K / 64;
        const int n0 = (v / nkt) * 32, k0 = (v % nkt) * 64;
        int srcbase = n0;
        if (job == 0) {
            if (n0 < 672) srcbase = n0;
            else if (n0 < 2208) { const int r = n0 - 672, hh = r / 192, g = (r % 192) >> 6, i0 = r & 63; srcbase = 1184 + g * 512 + hh * 64 + i0; }
            else srcbase = (n0 < 2240) ? n0 + 1024 : -1;
        }
        else if (job == 1) srcbase = (n0 < 512) ? 672 + n0 : 2208 + n0;
        else if (job == 2) srcbase = 3264 + n0;
        const float* ksc = (job == 3) ? p.q_norm_w : (job == 4) ? p.kv_norm_w : nullptr;
        wprep_unit(W, ldw, K, n0, k0, srcbase, dst, tile, ksc);
    }
    if (bid == nb - 1) {
        for (int i = threadIdx.x; i < 512; i += NTHR) {
            const int pos = i >> 3, f = i & 7;
            const float ang = (float)pos * powf(10000.f, -(float)f / 8.f);
            p.rope[2 * i] = cosf(ang); p.rope[2 * i + 1] = sinf(ang);
        }
    }
}

typedef short bf16x8 __attribute__((ext_vector_type(8)));
typedef float f32x4 __attribute__((ext_vector_type(4)));
typedef unsigned u32x4 __attribute__((ext_vector_type(4)));

__device__ __forceinline__ int lds_off(int row, int chunk) { return row * 128 + (((chunk ^ (row >> 1)) & 7) << 4); }

template <int NTN>
__device__ __forceinline__ void gemm_compute_stage(f32x4 (&acc)[NTN][4], const char* sa, int wm, int wn, int l15, int lq) {
    const char* sb = sa + 16384;
#pragma unroll
    for (int ks = 0; ks < 2; ++ks) {
        bf16x8 af[4], bfr[NTN];
#pragma unroll
        for (int mt = 0; mt < 4; ++mt) af[mt] = *(const bf16x8*)(sa + lds_off(wm * 64 + mt * 16 + l15, ks * 4 + lq));
#pragma unroll
        for (int nt = 0; nt < NTN; ++nt) bfr[nt] = *(const bf16x8*)(sb + lds_off(wn * (16 * NTN) + nt * 16 + l15, ks * 4 + lq));
#pragma unroll
        for (int nt = 0; nt < NTN; ++nt)
#pragma unroll
            for (int mt = 0; mt < 4; ++mt)
                acc[nt][mt] = __builtin_amdgcn_mfma_f32_16x16x32_bf16(bfr[nt], af[mt], acc[nt][mt], 0, 0, 0);
    }
}
template <int NTN>
__device__ __forceinline__ void gemm_tile_acc(f32x4 (&acc)[NTN][4], const bf16_t* __restrict__ A, int lda, const bf16_t* __restrict__ Bt, int ldb,
                                              int K, int m0, int n0, char* smem) {
    int tid = threadIdx.x;
    asm volatile("" : "+v"(tid));
    const int lane = tid & 63, w = tid >> 6, wm = w >> 1, wn = w & 1;
    const int l15 = lane & 15, lq = lane >> 4;
    const int srow = tid >> 3, sch = tid & 7;
    u32x4 ra[4], rb[NTN];
    const bf16_t* ap = A + (size_t)(m0 + srow) * lda + sch * 8;
    const bf16_t* bp = Bt + (size_t)(n0 + srow) * ldb + sch * 8;
    int KT = K >> 6;
    asm volatile("" : "+s"(KT));
#define GT_LOAD(KT_) do { _Pragma("unroll") for (int i = 0; i < 4; ++i) ra[i] = *(const u32x4*)(ap + (size_t)(32 * i) * lda + (KT_) * 64); \
                          _Pragma("unroll") for (int i = 0; i < NTN; ++i) rb[i] = *(const u32x4*)(bp + (size_t)(32 * i) * ldb + (KT_) * 64); } while (0)
#define GT_WRITE(ST_) do { char* da_ = smem + (ST_) * 32768; \
                          _Pragma("unroll") for (int i = 0; i < 4; ++i) *(u32x4*)(da_ + lds_off(srow + 32 * i, sch)) = ra[i]; \
                          _Pragma("unroll") for (int i = 0; i < NTN; ++i) *(u32x4*)(da_ + 16384 + lds_off(srow + 32 * i, sch)) = rb[i]; } while (0)
    GT_LOAD(0);
    GT_WRITE(0);
    GT_LOAD(1);
    __syncthreads();
    for (int kt = 0; kt < KT; ++kt) {
        if (kt + 1 < KT) GT_WRITE((kt + 1) & 1);
        if (kt + 2 < KT) GT_LOAD(kt + 2);
        gemm_compute_stage<NTN>(acc, smem + (kt & 1) * 32768, wm, wn, l15, lq);
        __syncthreads();
    }
#undef GT_LOAD
#undef GT_WRITE
}

template <int NTN>
__device__ __forceinline__ void acc_zero(f32x4 (&acc)[NTN][4]) {
#pragma unroll
    for (int i = 0; i < NTN; ++i)
#pragma unroll
        for (int j = 0; j < 4; ++j) acc[i][j] = (f32x4){0.f, 0.f, 0.f, 0.f};
}

__device__ __forceinline__ bool next_unit(int it, int U, int bid, int nb, int& u) {
    const int x = bid & 7, li = bid >> 3, per = nb >> 3;
    const int lo = (int)(((long)U * x) >> 3), hi = (int)(((long)U * (x + 1)) >> 3);
    u = lo + li + it * per;
    return u < hi;
}
__device__ __forceinline__ void unit_mn(int u, int ntn, int& tm, int& tn) {
    const int g = u / (8 * ntn), r = u % (8 * ntn);
    tm = g * 8 + (r & 7); tn = r >> 3;
}

__device__ __forceinline__ void st_bf4(bf16_t* p, f32x4 v) {
    uint2 o; o.x = pack_bf2(v[0], v[1]); o.y = pack_bf2(v[2], v[3]);
    *(uint2*)p = o;
}
__device__ __forceinline__ f32x4 ld_bf4(const bf16_t* p) {
    const uint2 r = *(const uint2*)p;
    return (f32x4){__uint_as_float(r.x << 16), __uint_as_float(r.x & 0xffff0000u), __uint_as_float(r.y << 16), __uint_as_float(r.y & 0xffff0000u)};
}
#define EPI_COORDS_OPAQUE(SFX) int tid##SFX = threadIdx.x; asm volatile("" : "+v"(tid##SFX)); \
    const int lane_ = tid##SFX & 63, w_ = tid##SFX >> 6, wm_ = w_ >> 1, wn_ = w_ & 1, l15_ = lane_ & 15, lq_ = lane_ >> 4;
#define EPI_COORDS const int lane_ = threadIdx.x & 63, w_ = threadIdx.x >> 6, wm_ = w_ >> 1, wn_ = w_ & 1, l15_ = lane_ & 15, lq_ = lane_ >> 4;
#define EPI_ROW(mt) (m0 + wm_ * 64 + (mt) * 16 + l15_)
#define EPI_COL(nt) (n0 + wn_ * 64 + (nt) * 16 + lq_ * 4)
#define EPI_COL2(nt) (n0 + wn_ * 32 + (nt) * 16 + lq_ * 4)

__device__ __forceinline__ void gemm_store_bf16(const bf16_t* A, int lda, const bf16_t* Bt, int K, int tm, int tn, bf16_t* C, int ldc, char* smem) {
    f32x4 acc[4][4];
    acc_zero<4>(acc);
    const int m0 = tm * 128, n0 = tn * 128;
    gemm_tile_acc<4>(acc, A, lda, Bt, K, K, m0, n0, smem);
    EPI_COORDS
#pragma unroll
    for (int nt = 0; nt < 4; ++nt)
#pragma unroll
        for (int mt = 0; mt < 4; ++mt) st_bf4(C + (size_t)EPI_ROW(mt) * ldc + EPI_COL(nt), acc[nt][mt]);
}

template <int NTN>
__device__ __forceinline__ void gemm_rows_acc(f32x4 (&acc)[NTN][2], float (&ssq)[4], const bf16_t* __restrict__ A, int lda,
                                              const bf16_t* __restrict__ Bt, int ldb, int K, int m0, int n0, char* smem) {
    constexpr int NB_ = NTN / 2;
    const int tid = threadIdx.x, lane = tid & 63, w = tid >> 6;
    const int l15 = lane & 15, lq = lane >> 4;
    const int srow = tid >> 3, sch = tid & 7;
    u32x4 ra[4], rb[NB_];
    const bf16_t* ap = A + (size_t)(m0 + srow) * lda + sch * 8;
    const bf16_t* bp = Bt + (size_t)(n0 + srow) * ldb + sch * 8;
    int KT = K >> 6;
    asm volatile("" : "+s"(KT));
#pragma unroll
    for (int i = 0; i < 4; ++i) ra[i] = *(const u32x4*)(ap + (size_t)(32 * i) * lda);
#pragma unroll
    for (int i = 0; i < NB_; ++i) rb[i] = *(const u32x4*)(bp + (size_t)(32 * i) * ldb);
#pragma unroll
    for (int i = 0; i < 4; ++i) *(u32x4*)(smem + lds_off(srow + 32 * i, sch)) = ra[i];
#pragma unroll
    for (int i = 0; i < NB_; ++i) *(u32x4*)(smem + 16384 + lds_off(srow + 32 * i, sch)) = rb[i];
    __syncthreads();
    for (int kt = 0; kt < KT; ++kt) {
#pragma unroll
        for (int i = 0; i < 4; ++i)
#pragma unroll
            for (int e = 0; e < 4; ++e) {
                const float lo = __uint_as_float(ra[i][e] << 16), hi = __uint_as_float(ra[i][e] & 0xffff0000u);
                ssq[i] += lo * lo + hi * hi;
            }
        if (kt + 1 < KT) {
#pragma unroll
            for (int i = 0; i < 4; ++i) ra[i] = *(const u32x4*)(ap + (size_t)(32 * i) * lda + (kt + 1) * 64);
#pragma unroll
            for (int i = 0; i < NB_; ++i) rb[i] = *(const u32x4*)(bp + (size_t)(32 * i) * ldb + (kt + 1) * 64);
        }
        const char* sa = smem + (kt & 1) * 32768;
        const char* sb = sa + 16384;
#pragma unroll
        for (int ks = 0; ks < 2; ++ks) {
            bf16x8 af[2], bfr[NTN];
#pragma unroll
            for (int mt = 0; mt < 2; ++mt) af[mt] = *(const bf16x8*)(sa + lds_off(w * 32 + mt * 16 + l15, ks * 4 + lq));
#pragma unroll
            for (int nt = 0; nt < NTN; ++nt) bfr[nt] = *(const bf16x8*)(sb + lds_off(nt * 16 + l15, ks * 4 + lq));
#pragma unroll
            for (int nt = 0; nt < NTN; ++nt)
#pragma unroll
                for (int mt = 0; mt < 2; ++mt)
                    acc[nt][mt] = __builtin_amdgcn_mfma_f32_16x16x32_bf16(bfr[nt], af[mt], acc[nt][mt], 0, 0, 0);
        }
        if (kt + 1 < KT) {
            char* da = smem + ((kt + 1) & 1) * 32768;
#pragma unroll
            for (int i = 0; i < 4; ++i) *(u32x4*)(da + lds_off(srow + 32 * i, sch)) = ra[i];
#pragma unroll
            for (int i = 0; i < NB_; ++i) *(u32x4*)(da + 16384 + lds_off(srow + 32 * i, sch)) = rb[i];
        }
        __syncthreads();
    }
    float* rssq = (float*)(smem + 65536);
#pragma unroll
    for (int i = 0; i < 4; ++i) {
        float s = ssq[i];
        s += dpp_mov<0xB1>(s); s += dpp_mov<0x4E>(s); s += dpp_mov<0x141>(s);
        if (sch == 0) rssq[srow + 32 * i] = s;
    }
    __syncthreads();
}

__device__ __forceinline__ void ph_mla_proj(const Params& p, int bid, int nb, char* smem) {
    const int tid = threadIdx.x, lane = tid & 63, w = tid >> 6, l15 = lane & 15, lq = lane >> 4;
    const float* rssq = (const float*)(smem + 65536);
    const int UQ = 128 * 8, UK = 144 * 8;
    int u;
    for (int it = 0; next_unit(it, UQ + UK, bid, nb, u); ++it) {
        if (u < UQ) {
            const int tm = u >> 3, hh = u & 7;
            const int m0 = NCTX + tm * 128;
            f32x4 acc[6][2];
            float ssq[4] = {0.f, 0.f, 0.f, 0.f};
#pragma unroll
            for (int i = 0; i < 6; ++i) { acc[i][0] = (f32x4){0.f, 0.f, 0.f, 0.f}; acc[i][1] = (f32x4){0.f, 0.f, 0.f, 0.f}; }
            gemm_rows_acc<6>(acc, ssq, p.Pa + PA_CQ, PA_W, p.Wt_uq, 384, 384, m0, hh * 96, smem);
#pragma unroll
            for (int mt = 0; mt < 2; ++mt) {
                const int ml = 32 * w + 16 * mt + l15;
                const int rl = tm * 128 + ml;
                const int b = rl >> 11, t = rl & 2047;
                const float rs = rsqrtf(rssq[ml] * (1.f / 384.f) + EPSF);
                float hs = 0.f;
#pragma unroll
                for (int nt = 0; nt < 6; ++nt)
#pragma unroll
                    for (int e = 0; e < 4; ++e) { const float v = acc[nt][mt][e] * rs; acc[nt][mt][e] = v; hs += v * v; }
                hs = xrow_sum(hs);
                const float hr = rsqrtf(hs * (1.f / 96.f) + EPSF) * (0.10206207261596575f * 1.4426950408889634f);
                bf16_t* qd = p.Qb + ((size_t)((b * 8 + hh) * SEQ + t)) * 96 + 4 * lq;
#pragma unroll
                for (int nt = 0; nt < 6; ++nt) {
                    const f32x4 wv = *(const f32x4*)(p.qhn_w + 16 * nt + 4 * lq);
                    f32x4 v;
#pragma unroll
                    for (int e = 0; e < 4; ++e) v[e] = acc[nt][mt][e] * hr * wv[e];
                    if (nt >= 4) {
                        const int pos = (nt == 4) ? (t >> 6) : (t & 63);
                        const int ph = lq >> 1;
#pragma unroll
                        for (int e = 0; e < 4; ++e) {
                            const float2 cs = *(const float2*)(p.rope + 2 * (pos * 8 + (lq & 1) * 4 + e));
                            const float partner = __shfl_xor(v[e], 32);
                            const float t1 = ph ? partner : v[e], t2 = ph ? v[e] : partner;
                            v[e] = ph ? (t1 * cs.y + t2 * cs.x) : (t1 * cs.x - t2 * cs.y);
                        }
                    }
                    st_bf4(qd + 16 * nt, v);
                }
            }
        } else {
            const int uu = u - UQ;
            const int tm = uu >> 3, hh = uu & 7;
            const int m0 = tm * 128;
            f32x4 acc[8][2];
            float ssq[4] = {0.f, 0.f, 0.f, 0.f};
#pragma unroll
            for (int i = 0; i < 8; ++i) { acc[i][0] = (f32x4){0.f, 0.f, 0.f, 0.f}; acc[i][1] = (f32x4){0.f, 0.f, 0.f, 0.f}; }
            gemm_rows_acc<8>(acc, ssq, p.Pa + PA_CKV, PA_W, p.Wt_ukv, 256, 256, m0, hh * 128, smem);
#pragma unroll
            for (int mt = 0; mt < 2; ++mt) {
                const int ml = 32 * w + 16 * mt + l15;
                const int r = m0 + ml;
                int b, pos, t = 0; const bool lat = (r >= NCTX);
                if (!lat) { b = r >> 8; pos = r & 255; }
                else { const int rl = r - NCTX; b = rl >> 11; t = rl & 2047; pos = CTXL + t; }
                const float rs = rsqrtf(rssq[ml] * (1.f / 256.f) + EPSF);
                const u32x4 krw = *(const u32x4*)(p.Pa + (size_t)r * PA_W + PA_KR + 8 * lq);
                float kr[8];
#pragma unroll
                for (int e = 0; e < 4; ++e) { kr[2 * e] = __uint_as_float(krw[e] << 16); kr[2 * e + 1] = __uint_as_float(krw[e] & 0xffff0000u); }
                float hs = 0.f;
#pragma unroll
                for (int e = 0; e < 8; ++e) hs += kr[e] * kr[e];
#pragma unroll
                for (int nt = 0; nt < 4; ++nt)
#pragma unroll
                    for (int e = 0; e < 4; ++e) { const float v = acc[nt][mt][e] * rs; acc[nt][mt][e] = v; hs += v * v; }
                hs = xrow_sum(hs);
                const float hr = rsqrtf(hs * (1.f / 96.f) + EPSF);
                bf16_t* kd = p.Kb + ((size_t)((b * 8 + hh) * TPB + pos)) * 96;
#pragma unroll
                for (int nt = 0; nt < 4; ++nt) {
                    const f32x4 wv = *(const f32x4*)(p.khn_w + 16 * nt + 4 * lq);
                    f32x4 v;
#pragma unroll
                    for (int e = 0; e < 4; ++e) v[e] = acc[nt][mt][e] * hr * wv[e];
                    st_bf4(kd + 16 * nt + 4 * lq, v);
                }
                {
                    const int ph = lq & 1;
                    const int rp = (lq >> 1) ? (t & 63) : (t >> 6);
                    float o[8];
#pragma unroll
                    for (int e = 0; e < 8; ++e) {
                        const float v = kr[e] * hr * p.khn_w[64 + 8 * lq + e];
                        const float partner = __shfl_xor(v, 16);
                        float2 cs = make_float2(1.f, 0.f);
                        if (lat) cs = *(const float2*)(p.rope + 2 * (rp * 8 + e));
                        const float t1 = ph ? partner : v, t2 = ph ? v : partner;
                        o[e] = ph ? (t1 * cs.y + t2 * cs.x) : (t1 * cs.x - t2 * cs.y);
                    }
                    u32x4 ov;
                    ov[0] = pack_bf2(o[0], o[1]); ov[1] = pack_bf2(o[2], o[3]); ov[2] = pack_bf2(o[4], o[5]); ov[3] = pack_bf2(o[6], o[7]);
                    *(u32x4*)(kd + 64 + 8 * lq) = ov;
                }
                {
                    const int kpos = (pos & ~12) | ((pos & 4) << 1) | ((pos & 8) >> 1);
                    bf16_t* vd = p.Vt + (size_t)((b * 8 + hh) * 64) * TPB + kpos;
#pragma unroll
                    for (int nt = 4; nt < 8; ++nt)
#pragma unroll
                        for (int e = 0; e < 4; ++e) vd[(size_t)(16 * (nt - 4) + 4 * lq + e) * TPB] = f2bf(acc[nt][mt][e] * rs);
                }
            }
        }
    }
}

typedef float f32x16 __attribute__((ext_vector_type(16)));
#define ATT_THR 6.0f
#define ATT_KROW 208
#define ATT_VROW 144
#define ATT_KBYTES (64 * ATT_KROW)
#define ATT_STAGE (ATT_KBYTES + 64 * ATT_VROW)
__device__ __forceinline__ void ph_attn(const Params& p, int bid, int nb, char* smem) {
    const int tid = threadIdx.x, lane = tid & 63, w = tid >> 6, r = lane & 31, h = lane >> 5;
    int u;
    for (int it = 0; next_unit(it, 1024, bid, nb, u); ++it) {
        const int bh = u >> 4, qb = u & 15;
        bf16x8 qf[6];
        {
            const bf16_t* Qp = p.Qb + ((size_t)bh * SEQ + qb * 128 + w * 32 + r) * 96 + h * 8;
#pragma unroll
            for (int s = 0; s < 6; ++s) qf[s] = *(const bf16x8*)(Qp + s * 16);
        }
        const bf16_t* Kg = p.Kb + (size_t)bh * TPB * 96 + tid * 8;
        const bf16_t* Vg = p.Vt + (size_t)bh * 64 * TPB + (size_t)(tid >> 3) * TPB + (tid & 7) * 8;
        int koff[3], voff[2];
#pragma unroll
        for (int i = 0; i < 3; ++i) { const int c = tid + 256 * i; koff[i] = (c / 12) * ATT_KROW + (c % 12) * 16; }
#pragma unroll
        for (int i = 0; i < 2; ++i) { const int c = tid + 256 * i; voff[i] = ATT_KBYTES + (c >> 3) * ATT_VROW + (c & 7) * 16; }
        u32x4 rk[3], rv[2];
#pragma unroll
        for (int i = 0; i < 3; ++i) rk[i] = *(const u32x4*)(Kg + i * 2048);
#pragma unroll
        for (int i = 0; i < 2; ++i) rv[i] = *(const u32x4*)(Vg + (size_t)(32 * i) * TPB);
#pragma unroll
        for (int i = 0; i < 3; ++i) *(u32x4*)(smem + koff[i]) = rk[i];
#pragma unroll
        for (int i = 0; i < 2; ++i) *(u32x4*)(smem + voff[i]) = rv[i];
        __syncthreads();
        f32x16 o0, o1;
#pragma unroll
        for (int i = 0; i < 16; ++i) { o0[i] = 0.f; o1[i] = 0.f; }
        float m = 0.f, l = 0.f;
        int NKT = TPB / 64;
        asm volatile("" : "+s"(NKT));
        for (int kt = 0; kt < NKT; ++kt) {
            if (kt + 1 < NKT) {
#pragma unroll
                for (int i = 0; i < 3; ++i) rk[i] = *(const u32x4*)(Kg + (size_t)(kt + 1) * 6144 + i * 2048);
#pragma unroll
                for (int i = 0; i < 2; ++i) rv[i] = *(const u32x4*)(Vg + (size_t)(32 * i) * TPB + (kt + 1) * 64);
            }
            const char* sk = smem + (kt & 1) * ATT_STAGE;
            const char* sv = sk + ATT_KBYTES;
            f32x16 s0, s1;
            {
                const float c0 = -m;
#pragma unroll
                for (int i = 0; i < 16; ++i) { s0[i] = c0; s1[i] = c0; }
            }
#pragma unroll
            for (int s = 0; s < 6; ++s) {
                const bf16x8 k0 = *(const bf16x8*)(sk + r * ATT_KROW + (2 * s + h) * 16);
                const bf16x8 k1 = *(const bf16x8*)(sk + (32 + r) * ATT_KROW + (2 * s + h) * 16);
                s0 = __builtin_amdgcn_mfma_f32_32x32x16_bf16(k0, qf[s], s0, 0, 0, 0);
                s1 = __builtin_amdgcn_mfma_f32_32x32x16_bf16(k1, qf[s], s1, 0, 0, 0);
            }
            float mx = fmaxf(s0[0], s1[0]);
#pragma unroll
            for (int i = 1; i < 16; ++i) mx = fmaxf(mx, fmaxf(s0[i], s1[i]));
            mx = fmaxf(mx, __shfl_xor(mx, 32));
            if (kt == 0 || __any(mx > ATT_THR)) {
                const float delta = (kt == 0) ? mx : fmaxf(mx, 0.f);
                const float alpha = (kt == 0) ? 1.f : __builtin_amdgcn_exp2f(-delta);
                m += delta;
                l *= alpha;
#pragma unroll
                for (int i = 0; i < 16; ++i) { o0[i] *= alpha; o1[i] *= alpha; s0[i] -= delta; s1[i] -= delta; }
            }
            float ls = 0.f;
#pragma unroll
            for (int i = 0; i < 16; ++i) {
                s0[i] = __builtin_amdgcn_exp2f(s0[i]);
                s1[i] = __builtin_amdgcn_exp2f(s1[i]);
                ls += s0[i] + s1[i];
            }
            l += ls;
#pragma unroll
            for (int ks = 0; ks < 4; ++ks) {
                u32x4 pw;
                if (ks < 2) {
                    pw[0] = pack_bf2(s0[8 * (ks & 1) + 0], s0[8 * (ks & 1) + 1]); pw[1] = pack_bf2(s0[8 * (ks & 1) + 2], s0[8 * (ks & 1) + 3]);
                    pw[2] = pack_bf2(s0[8 * (ks & 1) + 4], s0[8 * (ks & 1) + 5]); pw[3] = pack_bf2(s0[8 * (ks & 1) + 6], s0[8 * (ks & 1) + 7]);
                } else {
                    pw[0] = pack_bf2(s1[8 * (ks & 1) + 0], s1[8 * (ks & 1) + 1]); pw[1] = pack_bf2(s1[8 * (ks & 1) + 2], s1[8 * (ks & 1) + 3]);
                    pw[2] = pack_bf2(s1[8 * (ks & 1) + 4], s1[8 * (ks & 1) + 5]); pw[3] = pack_bf2(s1[8 * (ks & 1) + 6], s1[8 * (ks & 1) + 7]);
                }
                const bf16x8 pf = __builtin_bit_cast(bf16x8, pw);
                const bf16x8 v0 = *(const bf16x8*)(sv + r * ATT_VROW + (2 * ks + h) * 16);
                const bf16x8 v1 = *(const bf16x8*)(sv + (32 + r) * ATT_VROW + (2 * ks + h) * 16);
                o0 = __builtin_amdgcn_mfma_f32_32x32x16_bf16(v0, pf, o0, 0, 0, 0);
                o1 = __builtin_amdgcn_mfma_f32_32x32x16_bf16(v1, pf, o1, 0, 0, 0);
            }
            if (kt + 1 < NKT) {
                char* ds = smem + ((kt + 1) & 1) * ATT_STAGE;
#pragma unroll
                for (int i = 0; i < 3; ++i) *(u32x4*)(ds + koff[i]) = rk[i];
#pragma unroll
                for (int i = 0; i < 2; ++i) *(u32x4*)(ds + voff[i]) = rv[i];
            }
            __syncthreads();
        }
        l += __shfl_xor(l, 32);
        const float inv = 1.f / l;
        const int b = bh >> 3, hh = bh & 7;
        bf16_t* op = p.o_mla + ((size_t)(b * SEQ + qb * 128 + w * 32 + r)) * 512 + hh * 64 + 4 * h;
#pragma unroll
        for (int g = 0; g < 4; ++g) {
            uint2 a, c;
            a.x = pack_bf2(o0[4 * g + 0] * inv, o0[4 * g + 1] * inv); a.y = pack_bf2(o0[4 * g + 2] * inv, o0[4 * g + 3] * inv);
            c.x = pack_bf2(o1[4 * g + 0] * inv, o1[4 * g + 1] * inv); c.y = pack_bf2(o1[4 * g + 2] * inv, o1[4 * g + 3] * inv);
            *(uint2*)(op + 8 * g) = a;
            *(uint2*)(op + 32 + 8 * g) = c;
        }
    }
}

__device__ __forceinline__ int el_off(int row, int col) { return lds_off(row, col >> 3) + (col & 7) * 2; }

__device__ __forceinline__ void mm64(f32x4 (&acc)[4], const char* A, int arow0, const char* B, int l15, int lq) {
#pragma unroll
    for (int ks = 0; ks < 2; ++ks) {
        const bf16x8 a = *(const bf16x8*)(A + lds_off(arow0 + l15, ks * 4 + lq));
#pragma unroll
        for (int nt = 0; nt < 4; ++nt) {
            const bf16x8 b = *(const bf16x8*)(B + lds_off(nt * 16 + l15, ks * 4 + lq));
            acc[nt] = __builtin_amdgcn_mfma_f32_16x16x32_bf16(a, b, acc[nt], 0, 0, 0);
        }
    }
}
__device__ __forceinline__ void acc4_zero(f32x4 (&a)[4]) {
#pragma unroll
    for (int i = 0; i < 4; ++i) a[i] = (f32x4){0.f, 0.f, 0.f, 0.f};
}

#define DN_SQ 0
#define DN_SK 8192
#define DN_SV 16384
#define DN_LSTR 65
#define DN_LBYTES (64 * DN_LSTR * 4)
#define DN_SL 24576
#define DN_SA 57856
#define DN_SKD 66048
#define DN_SS 74240

typedef short s16x4 __attribute__((ext_vector_type(4)));
__device__ __forceinline__ s16x4 ds_tr(const char* p) { return __builtin_amdgcn_ds_read_tr16_b64_v4i16((LAS s16x4*)p); }

struct Dn1In { u32x4 rp[7]; float db, da; float cw[4]; };
__device__ __forceinline__ void dn1_fetch(Dn1In& in, const Params& p, int u, int tid) {
    const int bh = u / 36, pb = u % 36, b = bh >> 3, h = bh & 7;
    int rowbase, seglen, lb;
    if (pb < 4) { rowbase = b * CTXL; seglen = CTXL; lb = pb; }
    else { rowbase = NCTX + b * SEQ; seglen = SEQ; lb = pb - 4; }
#pragma unroll
    for (int i = 0; i < 7; ++i) {
        const int c = tid + NTHR * i;
        const int g = c / 544, rem = c % 544, rr = rem >> 3, ch = rem & 7;
        const int lp = lb * 64 - 2 + rr;
        u32x4 val = (u32x4){0u, 0u, 0u, 0u};
        if (c < 3 * 68 * 8 && lp >= 0 && lp < seglen) val = *(const u32x4*)(p.Pa + (size_t)(rowbase + lp) * PA_W + PA_DQ + h * 192 + g * 64 + ch * 8);
        in.rp[i] = val;
    }
#pragma unroll
    for (int i = 0; i < 4; ++i) {
        const int idx = tid + NTHR * i, g = idx / 320, j = (idx % 320) >> 6, c = idx & 63;
        in.cw[i] = (idx < 960) ? p.conv_w[j * 1536 + g * 512 + h * 64 + c] : 0.f;
    }
    in.db = 0.f; in.da = 0.f;
    if (tid < 128) {
        const int d = tid >> 6, tp = tid & 63;
        const int pos = d ? 63 - tp : tp;
        const bf16_t* row = p.Pa + (size_t)(rowbase + lb * 64 + pos) * PA_W;
        in.db = bf2f(row[PA_DB + d * 8 + h]);
        in.da = bf2f(row[PA_DA + d * 8 + h]);
    }
}

__device__ __forceinline__ void ph_dn1(const Params& p, int bid, int nb, char* smem) {
    char* sQ = smem + DN_SQ; char* sK = smem + DN_SK; char* sV = smem + DN_SV;
    char* sL = smem + DN_SL; char* sA = smem + DN_SA; char* sKd = smem + DN_SKD;
    float* sS = (float*)(smem + DN_SS);
    const int x_ = bid & 7, li_ = bid >> 3, per_ = nb >> 3;
#define DN1_UNIT(IT, U, VALID) do { const int q_ = li_ + (IT) * per_; const int grp_ = x_ + 8 * (q_ >> 3); VALID = (grp_ < 8 * 36); \
        const int b_ = grp_ / 36, pb_ = grp_ % 36; U = (b_ * 8 + (q_ & 7)) * 36 + pb_; } while (0)
    Dn1In in;
    int u, un; bool valid, validn;
    DN1_UNIT(0, u, valid);
    if (valid) dn1_fetch(in, p, u, threadIdx.x);
    for (int it = 0; valid; ++it, u = un, valid = validn) {
        DN1_UNIT(it + 1, un, validn);
        int tid = threadIdx.x;
        asm volatile("" : "+v"(tid));
        const int lane = tid & 63, w = tid >> 6, l15 = lane & 15, lq = lane >> 4;
        const int bh = u / 36, pb = u % 36, h = bh & 7;
        const bool lat = (pb >= 4);
        if (tid < 128) {
            const int d = tid >> 6, tp = lane;
            const float xx = in.da + p.dt_bias[d * 8 + h];
            const float sp = (xx > 20.f) ? xx : log1pf(__expf(xx));
            const float g = -__expf(p.a_log[d * 8 + h]) * sp;
            float gc = g;
#pragma unroll
            for (int o = 1; o < 64; o <<= 1) { const float t = __shfl_up(gc, o); if (lane >= o) gc += t; }
            const float gl = __shfl(gc, 63);
            const float bt = sigmoid_f(in.db), eg = __expf(gc);
            sS[(d * 5 + 0) * 64 + tp] = bt;
            sS[(d * 5 + 1) * 64 + tp] = gc;
            sS[(d * 5 + 2) * 64 + tp] = eg;
            sS[(d * 5 + 3) * 64 + tp] = __expf(gl - gc);
            sS[(d * 5 + 4) * 64 + tp] = bt * eg;
        }
        {
            char* raw = sL;
#pragma unroll
            for (int i = 0; i < 7; ++i) {
                const int c = tid + NTHR * i;
                const int g = c / 544, rem = c % 544, rr = rem >> 3, ch = rem & 7;
                if (c < 3 * 68 * 8) *(u32x4*)(raw + (g * 68 + rr) * 128 + ch * 16) = in.rp[i];
            }
            float* cwS = (float*)(sL + 26112);
#pragma unroll
            for (int i = 0; i < 4; ++i) { const int idx = tid + NTHR * i; if (idx < 960) cwS[idx] = in.cw[i]; }
            if (validn) dn1_fetch(in, p, un, tid);
            __syncthreads();
            const int o = tid & 7, r0 = tid >> 3;
#pragma unroll
            for (int g = 0; g < 3; ++g) {
                if (g == 0 && !lat) continue;
                float wj[5][8];
#pragma unroll
                for (int j = 0; j < 5; ++j) {
                    const f32x4 w0 = *(const f32x4*)(cwS + (g * 5 + j) * 64 + 8 * o), w1 = *(const f32x4*)(cwS + (g * 5 + j) * 64 + 8 * o + 4);
#pragma unroll
                    for (int e2 = 0; e2 < 4; ++e2) { wj[j][e2] = w0[e2]; wj[j][4 + e2] = w1[e2]; }
                }
#pragma unroll
                for (int hh = 0; hh < 2; ++hh) {
                    const int rr = r0 + 32 * hh;
                    float a[8];
#pragma unroll
                    for (int e2 = 0; e2 < 8; ++e2) a[e2] = 0.f;
#pragma unroll
                    for (int j = 0; j < 5; ++j) {
                        const u32x4 dv = *(const u32x4*)(raw + (g * 68 + rr + j) * 128 + o * 16);
#pragma unroll
                        for (int e2 = 0; e2 < 4; ++e2) {
                            a[2 * e2] += __uint_as_float(dv[e2] << 16) * wj[j][2 * e2];
                            a[2 * e2 + 1] += __uint_as_float(dv[e2] & 0xffff0000u) * wj[j][2 * e2 + 1];
                        }
                    }
                    float ss = 0.f;
#pragma unroll
                    for (int e2 = 0; e2 < 8; ++e2) { a[e2] = silu_f(a[e2]); ss += a[e2] * a[e2]; }
                    float sc = 1.f;
                    if (g < 2) {
                        ss += dpp_mov<0xB1>(ss); ss += dpp_mov<0x4E>(ss); ss += dpp_mov<0x141>(ss);
                        sc = rsqrtf(ss + EPSF) * (g == 0 ? 0.125f : 1.f);
                    }
                    u32x4 ov;
#pragma unroll
                    for (int e2 = 0; e2 < 4; ++e2) ov[e2] = pack_bf2(a[2 * e2] * sc, a[2 * e2 + 1] * sc);
                    *(u32x4*)((g == 0 ? sQ : g == 1 ? sK : sV) + lds_off(rr, o)) = ov;
                }
            }
            __syncthreads();
        }
        {
            f32x4 G[4];
            acc4_zero(G);
            mm64(G, sK, 16 * w, sK, l15, lq);
            float* L0 = (float*)sL; float* L1 = (float*)(sL + DN_LBYTES);
            const float* be0 = sS + 0 * 64; const float* gc0 = sS + 1 * 64;
            const float* be1 = sS + 5 * 64; const float* gc1 = sS + 6 * 64;
#pragma unroll
            for (int nt = 0; nt < 4; ++nt)
#pragma unroll
                for (int rg = 0; rg < 4; ++rg) {
                    const int t = 16 * w + 4 * lq + rg, s = 16 * nt + l15;
                    const float gv = G[nt][rg];
                    const int tp = 63 - t, sp = 63 - s;
                    L0[t * DN_LSTR + s] = (s < t) ? be0[t] * gv * __expf(gc0[t] - gc0[s]) : 0.f;
                    L1[tp * DN_LSTR + sp] = (s > t) ? be1[tp] * gv * __expf(gc1[tp] - gc1[sp]) : 0.f;
                }
            __syncthreads();
        }
        {
            int tid3 = tid;
            asm volatile("" : "+v"(tid3) :: "memory");
            const int lane3 = tid3 & 63, w3 = tid3 >> 6, l15c = lane3 & 15, lqc = lane3 >> 4;
            if (tid3 < 128) {
                float* Lb = (float*)(sL + w3 * DN_LBYTES) + (16 * lqc) * DN_LSTR + 16 * lqc;
                float x[16];
#pragma unroll
                for (int i = 0; i < 16; ++i) {
                    float v = (i == l15c) ? 1.f : 0.f;
#pragma unroll
                    for (int j = 0; j < i; ++j) v -= Lb[i * DN_LSTR + j] * x[j];
                    x[i] = v;
                }
#pragma unroll
                for (int i = 0; i < 16; ++i) Lb[i * DN_LSTR + l15c] = x[i];
            }
            __syncthreads();
            {
                const int d = w3 >> 1, pr = w3 & 1, b0 = 2 * pr, b1 = 2 * pr + 1;
                float* Ld = (float*)(sL + d * DN_LBYTES);
                float* scr = (float*)(sA) + w3 * 272;
                f32x4 P = (f32x4){0.f, 0.f, 0.f, 0.f};
#pragma unroll
                for (int kk = 0; kk < 4; ++kk)
                    P = __builtin_amdgcn_mfma_f32_16x16x4f32(Ld[(16 * b1 + l15c) * DN_LSTR + 16 * b0 + 4 * kk + lqc],
                                                            Ld[(16 * b0 + 4 * kk + lqc) * DN_LSTR + 16 * b0 + l15c], P, 0, 0, 0);
#pragma unroll
                for (int rg = 0; rg < 4; ++rg) scr[(4 * lqc + rg) * 17 + l15c] = P[rg];
                f32x4 R = (f32x4){0.f, 0.f, 0.f, 0.f};
#pragma unroll
                for (int kk = 0; kk < 4; ++kk)
                    R = __builtin_amdgcn_mfma_f32_16x16x4f32(Ld[(16 * b1 + l15c) * DN_LSTR + 16 * b1 + 4 * kk + lqc],
                                                            scr[(4 * kk + lqc) * 17 + l15c], R, 0, 0, 0);
#pragma unroll
                for (int rg = 0; rg < 4; ++rg) Ld[(16 * b1 + 4 * lqc + rg) * DN_LSTR + 16 * b0 + l15c] = -R[rg];
            }
            __syncthreads();
            {
                const int d = w3 >> 1, hf = w3 & 1;
                float* Ld = (float*)(sL + d * DN_LBYTES);
                float* scr2 = (float*)(d ? sKd : sA);
                f32x4 P2[2];
                P2[0] = (f32x4){0.f, 0.f, 0.f, 0.f}; P2[1] = (f32x4){0.f, 0.f, 0.f, 0.f};
#pragma unroll
                for (int kk = 0; kk < 8; ++kk) {
                    const float a = Ld[(32 + 16 * hf + l15c) * DN_LSTR + 4 * kk + lqc];
#pragma unroll
                    for (int n2 = 0; n2 < 2; ++n2)
                        P2[n2] = __builtin_amdgcn_mfma_f32_16x16x4f32(a, Ld[(4 * kk + lqc) * DN_LSTR + 16 * n2 + l15c], P2[n2], 0, 0, 0);
                }
#pragma unroll
                for (int n2 = 0; n2 < 2; ++n2)
#pragma unroll
                    for (int rg = 0; rg < 4; ++rg) scr2[(16 * hf + 4 * lqc + rg) * 33 + 16 * n2 + l15c] = P2[n2][rg];
                __syncthreads();
                f32x4 R2[2];
                R2[0] = (f32x4){0.f, 0.f, 0.f, 0.f}; R2[1] = (f32x4){0.f, 0.f, 0.f, 0.f};
#pragma unroll
                for (int kk = 0; kk < 8; ++kk) {
                    const float a = Ld[(32 + 16 * hf + l15c) * DN_LSTR + 32 + 4 * kk + lqc];
#pragma unroll
                    for (int n2 = 0; n2 < 2; ++n2)
                        R2[n2] = __builtin_amdgcn_mfma_f32_16x16x4f32(a, scr2[(4 * kk + lqc) * 33 + 16 * n2 + l15c], R2[n2], 0, 0, 0);
                }
#pragma unroll
                for (int n2 = 0; n2 < 2; ++n2)
#pragma unroll
                    for (int rg = 0; rg < 4; ++rg) Ld[(32 + 16 * hf + 4 * lqc + rg) * DN_LSTR + 16 * n2 + l15c] = -R2[n2][rg];
            }
            __syncthreads();
            f32x4 U0[4];
            acc4_zero(U0);
#pragma unroll 1
            for (int dd = 0; dd < 4; ++dd) {
                const int d = dd >> 1, isw = dd & 1;
                const float* Td = (const float*)(sL + d * DN_LBYTES);
                {
                    const int tr = tid3 >> 2, cq = tid3 & 3;
                    const float* c1 = sS + (d * 5 + (isw ? 4 : 0)) * 64 + 16 * cq;
                    const float* trow = Td + tr * DN_LSTR + 16 * cq;
                    float tv[16];
#pragma unroll
                    for (int e2 = 0; e2 < 16; ++e2) tv[e2] = trow[e2] * c1[e2];
#pragma unroll
                    for (int q = 0; q < 2; ++q) {
                        u32x4 o1, o2;
#pragma unroll
                        for (int e2 = 0; e2 < 4; ++e2) {
                            const int i0 = 8 * q + 2 * e2;
                            const uint32_t hi = pack_bf2(tv[i0], tv[i0 + 1]);
                            const float r0 = tv[i0] - __uint_as_float(hi << 16), r1 = tv[i0 + 1] - __uint_as_float(hi & 0xffff0000u);
                            o1[e2] = hi;
                            o2[e2] = pack_bf2(r0, r1);
                        }
                        *(u32x4*)(sA + lds_off(tr, 2 * cq + q)) = o1;
                        *(u32x4*)(sKd + lds_off(tr, 2 * cq + q)) = o2;
                    }
                }
                __syncthreads();
                f32x4 U[4];
                acc4_zero(U);
                {
                    const char* sX = isw ? sK : sV;
#pragma unroll
                    for (int ks = 0; ks < 2; ++ks) {
                        const bf16x8 a1 = *(const bf16x8*)(sA + lds_off(16 * w3 + l15c, ks * 4 + lqc));
                        const bf16x8 a2 = *(const bf16x8*)(sKd + lds_off(16 * w3 + l15c, ks * 4 + lqc));
                        const int r0 = 32 * ks + 8 * lqc + (l15c >> 2);
                        const int p0 = d ? 63 - r0 : r0, p1 = d ? 63 - (r0 + 4) : (r0 + 4);
#pragma unroll
                        for (int nt = 0; nt < 4; ++nt) {
                            const int col = 16 * nt + 4 * (l15c & 3);
                            const s16x4 v0 = ds_tr(sX + el_off(p0, col)), v1 = ds_tr(sX + el_off(p1, col));
                            const bf16x8 bx = __builtin_shufflevector(v0, v1, 0, 1, 2, 3, 4, 5, 6, 7);
                            U[nt] = __builtin_amdgcn_mfma_f32_16x16x32_bf16(a1, bx, U[nt], 0, 0, 0);
                            U[nt] = __builtin_amdgcn_mfma_f32_16x16x32_bf16(a2, bx, U[nt], 0, 0, 0);
                        }
                    }
                }
                __syncthreads();
                if (isw == 0) {
                    U0[0] = U[0]; U0[1] = U[1]; U0[2] = U[2]; U0[3] = U[3];
                } else {
                    char* uT = sL + d * DN_LBYTES;
                    char* wT = uT + 8192;
                    const int t0 = 16 * w3 + 4 * lqc;
#pragma unroll
                    for (int nt = 0; nt < 4; ++nt) {
                        uint2 ou, ow;
                        ou.x = pack_bf2(U0[nt][0], U0[nt][1]); ou.y = pack_bf2(U0[nt][2], U0[nt][3]);
                        ow.x = pack_bf2(U[nt][0], U[nt][1]); ow.y = pack_bf2(U[nt][2], U[nt][3]);
                        *(uint2*)(uT + el_off(16 * nt + l15c, t0)) = ou;
                        *(uint2*)(wT + el_off(16 * nt + l15c, t0)) = ow;
                    }
                    __syncthreads();
                }
            }
        }
        int tid5 = tid;
        asm volatile("" : "+v"(tid5) :: "memory");
        const int lane5 = tid5 & 63, w5 = tid5 >> 6, l15_5 = lane5 & 15, lq5 = lane5 >> 4;
        f32x4 QK[4];
        acc4_zero(QK);
        mm64(QK, sQ, 16 * w5, sK, l15_5, lq5);
#pragma unroll 1
        for (int d = 0; d < 2; ++d) {
            const float* gcd = sS + (d * 5 + 1) * 64;
            const float* egd = sS + (d * 5 + 2) * 64;
            const float* ekd = sS + (d * 5 + 3) * 64;
            {
                const int i = lane5, tq = w5;
                float kv[16];
#pragma unroll
                for (int e = 0; e < 16; ++e) {
                    const int tp = tq * 16 + e, pos = d ? 63 - tp : tp;
                    kv[e] = bf2f(*(const bf16_t*)(sK + el_off(pos, i))) * ekd[tp];
                }
#pragma unroll
                for (int q = 0; q < 2; ++q) {
                    u32x4 o;
                    o[0] = pack_bf2(kv[8 * q + 0], kv[8 * q + 1]); o[1] = pack_bf2(kv[8 * q + 2], kv[8 * q + 3]);
                    o[2] = pack_bf2(kv[8 * q + 4], kv[8 * q + 5]); o[3] = pack_bf2(kv[8 * q + 6], kv[8 * q + 7]);
                    *(u32x4*)(sKd + lds_off(i, 2 * tq + q)) = o;
                }
            }
#pragma unroll
            for (int nt = 0; nt < 4; ++nt)
#pragma unroll
                for (int rg = 0; rg < 4; ++rg) {
                    const int t = 16 * w5 + 4 * lq5 + rg, s = 16 * nt + l15_5;
                    const int tp = d ? 63 - t : t, sp = d ? 63 - s : s;
                    const float val = (sp <= tp) ? QK[nt][rg] * __expf(gcd[tp] - gcd[sp]) : 0.f;
                    *(bf16_t*)(sA + el_off(tp, sp)) = f2bf(val);
                }
            __syncthreads();
            const char* uT = sL + d * DN_LBYTES;
            const char* wT = uT + 8192;
            const int cd = (d == 0) ? pb : (pb < 4 ? 3 - pb : 39 - pb);
            bf16_t* Mg = p.MH + ((size_t)((bh * 2 + d) * 36 + cd) * 2) * 4096;
            bf16_t* Hg = Mg + 4096;
            {
                f32x4 MT[4];
                acc4_zero(MT);
                mm64(MT, wT, 16 * w5, sKd, l15_5, lq5);
                const float egl = egd[63];
                const int j0 = 16 * w5 + 4 * lq5;
#pragma unroll
                for (int nt = 0; nt < 4; ++nt) {
                    const int i = 16 * nt + l15_5;
                    f32x4 o;
#pragma unroll
                    for (int e = 0; e < 4; ++e) o[e] = ((i == j0 + e) ? egl : 0.f) - MT[nt][e];
                    st_bf4(Mg + i * 64 + j0, o);
                }
            }
            {
                f32x4 HH[4];
                acc4_zero(HH);
                mm64(HH, sKd, 16 * w5, uT, l15_5, lq5);
                const int i0 = 16 * w5 + 4 * lq5;
#pragma unroll
                for (int nt = 0; nt < 4; ++nt) st_bf4(Hg + (16 * nt + l15_5) * 64 + i0, HH[nt]);
            }
            if (lat) {
                bf16_t* Eg = p.EF + ((size_t)((bh * 2 + d) * 32 + (pb - 4)) * 2) * 4096;
                bf16_t* Fg = Eg + 4096;
                {
                    f32x4 ET[4];
                    acc4_zero(ET);
                    mm64(ET, wT, 16 * w5, sA, l15_5, lq5);
                    const int j0 = 16 * w5 + 4 * lq5;
#pragma unroll
                    for (int nt = 0; nt < 4; ++nt) {
                        const int sp = 16 * nt + l15_5, spos = d ? 63 - sp : sp;
                        const f32x4 qv = ld_bf4((const bf16_t*)(sQ + el_off(spos, j0)));
                        const float eg = egd[sp];
                        f32x4 o;
#pragma unroll
                        for (int e = 0; e < 4; ++e) o[e] = qv[e] * eg - ET[nt][e];
                        st_bf4(Eg + spos * 64 + j0, o);
                    }
                }
                {
                    f32x4 FF[4];
                    acc4_zero(FF);
                    mm64(FF, uT, 16 * w5, sA, l15_5, lq5);
                    const int c0 = 16 * w5 + 4 * lq5;
#pragma unroll
                    for (int nt = 0; nt < 4; ++nt) {
                        const int sp = 16 * nt + l15_5, spos = d ? 63 - sp : sp;
                        st_bf4(Fg + spos * 64 + c0, FF[nt]);
                    }
                }
            }
            __syncthreads();
        }
    }
}

struct Dn2Frag { bf16x8 am[2]; uint2 hr[2]; };
__device__ __forceinline__ void dn2_load(Dn2Frag& f, const bf16_t* Mg, int w, int l15, int lq, int i0, int hf) {
#pragma unroll
    for (int ks = 0; ks < 2; ++ks) f.am[ks] = *(const bf16x8*)(Mg + (16 * w + l15) * 64 + ks * 32 + lq * 8);
#pragma unroll
    for (int n2 = 0; n2 < 2; ++n2) f.hr[n2] = *(const uint2*)(Mg + 4096 + (32 * hf + 16 * n2 + l15) * 64 + i0);
}
__device__ __forceinline__ void dn2_step(const Dn2Frag& f, int c, int d, int hf, bf16_t* STc, char* smem, int l15, int lq, int i0) {
    const char* sS = smem + (c & 1) * 4096;
    char* sN = smem + ((c + 1) & 1) * 4096;
    f32x4 acc[2];
#pragma unroll
    for (int n2 = 0; n2 < 2; ++n2)
        acc[n2] = (f32x4){__uint_as_float(f.hr[n2].x << 16), __uint_as_float(f.hr[n2].x & 0xffff0000u),
                          __uint_as_float(f.hr[n2].y << 16), __uint_as_float(f.hr[n2].y & 0xffff0000u)};
#pragma unroll
    for (int ks = 0; ks < 2; ++ks)
#pragma unroll
        for (int n2 = 0; n2 < 2; ++n2) {
            const bf16x8 bs = *(const bf16x8*)(sS + lds_off(16 * n2 + l15, ks * 4 + lq));
            acc[n2] = __builtin_amdgcn_mfma_f32_16x16x32_bf16(f.am[ks], bs, acc[n2], 0, 0, 0);
        }
    const int cn = c + 1;
    const bool st = (cn >= 4 && cn <= 35);
    const int pbi = (d == 0 ? cn : 39 - cn) - 4;
#pragma unroll
    for (int n2 = 0; n2 < 2; ++n2) {
        uint2 o; o.x = pack_bf2(acc[n2][0], acc[n2][1]); o.y = pack_bf2(acc[n2][2], acc[n2][3]);
        const int cl = 16 * n2 + l15;
        *(uint2*)(sN + el_off(cl, i0)) = o;
        if (st) *(uint2*)(STc + (size_t)pbi * 4096 + (32 * hf + cl) * 64 + i0) = o;
    }
    __syncthreads();
}
__device__ __forceinline__ void ph_dn2(const Params& p, int bid, int nb, char* smem) {
    if (bid >= 256) return;
    const int tid = threadIdx.x, lane = tid & 63, w = tid >> 6, l15 = lane & 15, lq = lane >> 4;
    const int chain = bid >> 1, hf = bid & 1, d = chain & 1;
    const bf16_t* MHc = p.MH + (size_t)chain * 36 * 2 * 4096;
    bf16_t* STc = p.ST + (size_t)chain * 32 * 4096;
    for (int i = tid; i < 4096 / 16; i += NTHR) *(u32x4*)(smem + i * 16) = (u32x4){0u, 0u, 0u, 0u};
    __syncthreads();
    const int i0 = 16 * w + 4 * lq;
    Dn2Frag f0, f1, f2, f3;
    dn2_load(f0, MHc + (size_t)0 * 8192, w, l15, lq, i0, hf);
    dn2_load(f1, MHc + (size_t)1 * 8192, w, l15, lq, i0, hf);
    dn2_load(f2, MHc + (size_t)2 * 8192, w, l15, lq, i0, hf);
    dn2_load(f3, MHc + (size_t)3 * 8192, w, l15, lq, i0, hf);
    for (int c0 = 0; c0 < 36; c0 += 4) {
        const bool more = (c0 + 4 < 36);
        dn2_step(f0, c0 + 0, d, hf, STc, smem, l15, lq, i0);
        if (more) dn2_load(f0, MHc + (size_t)(c0 + 4) * 8192, w, l15, lq, i0, hf);
        dn2_step(f1, c0 + 1, d, hf, STc, smem, l15, lq, i0);
        if (more) dn2_load(f1, MHc + (size_t)(c0 + 5) * 8192, w, l15, lq, i0, hf);
        dn2_step(f2, c0 + 2, d, hf, STc, smem, l15, lq, i0);
        if (more) dn2_load(f2, MHc + (size_t)(c0 + 6) * 8192, w, l15, lq, i0, hf);
        dn2_step(f3, c0 + 3, d, hf, STc, smem, l15, lq, i0);
        if (more) dn2_load(f3, MHc + (size_t)(c0 + 7) * 8192, w, l15, lq, i0, hf);
    }
}

__device__ __forceinline__ void ph_dn3(const Params& p, int bid, int nb, char* smem) {
    const int tid = threadIdx.x, lane = tid & 63, w = tid >> 6, l15 = lane & 15, lq = lane >> 4;
    for (int u = bid; u < 64 * 32; u += nb) {
        const int bh = u >> 5, pbi = u & 31, b = bh >> 3, h = bh & 7;
        const int s = 16 * w + l15;
        const size_t rl = (size_t)b * SEQ + pbi * 64 + s;
        f32x4 zdv[4];
#pragma unroll
        for (int mt = 0; mt < 4; ++mt) zdv[mt] = ld_bf4(p.Pz + rl * PZ_W + 512 + h * 64 + 16 * mt + 4 * lq);
        f32x4 acc[4];
        acc4_zero(acc);
#pragma unroll
        for (int d = 0; d < 2; ++d) {
            const bf16_t* Eg = p.EF + ((size_t)((bh * 2 + d) * 32 + pbi) * 2) * 4096;
            const bf16_t* Fg = Eg + 4096;
            const bf16_t* Sg = p.ST + ((size_t)(bh * 2 + d) * 32 + pbi) * 4096;
#pragma unroll
            for (int mt = 0; mt < 4; ++mt) acc[mt] += ld_bf4(Fg + s * 64 + 16 * mt + 4 * lq);
#pragma unroll
            for (int ks = 0; ks < 2; ++ks) {
                const bf16x8 be = *(const bf16x8*)(Eg + s * 64 + ks * 32 + lq * 8);
#pragma unroll
                for (int mt = 0; mt < 4; ++mt) {
                    const bf16x8 as = *(const bf16x8*)(Sg + (16 * mt + l15) * 64 + ks * 32 + lq * 8);
                    acc[mt] = __builtin_amdgcn_mfma_f32_16x16x32_bf16(as, be, acc[mt], 0, 0, 0);
                }
            }
        }
        float ss = 0.f;
#pragma unroll
        for (int mt = 0; mt < 4; ++mt)
#pragma unroll
            for (int rg = 0; rg < 4; ++rg) ss += acc[mt][rg] * acc[mt][rg];
        ss = xrow_sum(ss);
        const float rstd = rsqrtf(ss * (1.f / 64.f) + EPSF);
#pragma unroll
        for (int mt = 0; mt < 4; ++mt) {
            const f32x4 nw = *(const f32x4*)(p.dn_norm_w + 16 * mt + 4 * lq);
            f32x4 o;
#pragma unroll
            for (int rg = 0; rg < 4; ++rg) o[rg] = acc[mt][rg] * rstd * nw[rg] * silu_f(zdv[mt][rg]);
            st_bf4(p.A_dn + rl * 512 + h * 64 + 16 * mt + 4 * lq, o);
        }
    }
    for (size_t i = (size_t)bid * NTHR + tid; i < (size_t)NL * 64; i += (size_t)nb * NTHR) {
        const size_t rl = i >> 6; const int c8 = (int)(i & 63) * 8;
        const u32x4 ov = *(const u32x4*)(p.o_mla + rl * 512 + c8);
        const u32x4 zv = *(const u32x4*)(p.Pz + rl * PZ_W + c8);
        u32x4 r;
#pragma unroll
        for (int e = 0; e < 4; ++e) {
            const float o0 = __uint_as_float(ov[e] << 16), o1 = __uint_as_float(ov[e] & 0xffff0000u);
            const float z0 = __uint_as_float(zv[e] << 16), z1 = __uint_as_float(zv[e] & 0xffff0000u);
            r[e] = pack_bf2(o0 * silu_f(z0), o1 * silu_f(z1));
        }
        *(u32x4*)(p.A_mla + rl * 512 + c8) = r;
    }
}


__device__ __forceinline__ void ph_inproj(const Params& p, int bid, int nb, char* smem) {
    const int UA = 144 * 18, UZ = 128 * 8;
    const bf16_t* hl = p.h + (size_t)NCTX * DM;
    int u, tm, tn;
    for (int it = 0; next_unit(it, UA + UZ, bid, nb, u); ++it) {
        if (u < UA) { unit_mn(u, 18, tm, tn); gemm_store_bf16(p.h, DM, p.Wt_a, 1024, tm, tn, p.Pa, PA_W, smem); }
        else { unit_mn(u - UA, 8, tm, tn); gemm_store_bf16(hl, DM, p.Wt_z, 1024, tm, tn, p.Pz, PZ_W, smem); }
    }
}

__device__ __forceinline__ void ph_gates(const Params& p, int bid, int nb, char* smem) {
    const bf16_t* hl = p.h + (size_t)NCTX * DM;
    int u, tm, tn;
    for (int it = 0; next_unit(it, 128 * 16, bid, nb, u); ++it) {
        unit_mn(u, 16, tm, tn);
        gemm_store_bf16(hl, DM, p.Wt_g, 1024, tm, tn, p.Pg, PG_W, smem);
    }
}

__device__ __forceinline__ void ph_merge(const Params& p, int bid, int nb, char* smem) {
    int u, tm, tn;
    for (int it = 0; next_unit(it, 128 * 8, bid, nb, u); ++it) {
        unit_mn(u, 8, tm, tn);
        const int m0 = tm * 128, n0 = tn * 128;
        f32x4 acc[4][4];
        uint2 mm[4][4];
        acc_zero<4>(acc);
        gemm_tile_acc<4>(acc, p.A_mla, 512, p.Wt_mo, 512, 512, m0, n0, smem);
        {
        EPI_COORDS_OPAQUE(a)
#pragma unroll
        for (int nt = 0; nt < 4; ++nt)
#pragma unroll
            for (int mt = 0; mt < 4; ++mt) {
                const f32x4 g = ld_bf4(p.Pg + (size_t)EPI_ROW(mt) * PG_W + EPI_COL(nt));
                mm[nt][mt].x = pack_bf2(sigmoid_f(g[0]) * acc[nt][mt][0], sigmoid_f(g[1]) * acc[nt][mt][1]);
                mm[nt][mt].y = pack_bf2(sigmoid_f(g[2]) * acc[nt][mt][2], sigmoid_f(g[3]) * acc[nt][mt][3]);
            }
        }
        acc_zero<4>(acc);
        gemm_tile_acc<4>(acc, p.A_dn, 512, p.Wt_do, 512, 512, m0, n0, smem);
        {
        EPI_COORDS_OPAQUE(b)
#pragma unroll
        for (int nt = 0; nt < 4; ++nt)
#pragma unroll
            for (int mt = 0; mt < 4; ++mt) {
                const f32x4 g = ld_bf4(p.Pg + (size_t)EPI_ROW(mt) * PG_W + 1024 + EPI_COL(nt));
                f32x4 o;
                o[0] = __uint_as_float(mm[nt][mt].x << 16) + sigmoid_f(g[0]) * acc[nt][mt][0];
                o[1] = __uint_as_float(mm[nt][mt].x & 0xffff0000u) + sigmoid_f(g[1]) * acc[nt][mt][1];
                o[2] = __uint_as_float(mm[nt][mt].y << 16) + sigmoid_f(g[2]) * acc[nt][mt][2];
                o[3] = __uint_as_float(mm[nt][mt].y & 0xffff0000u) + sigmoid_f(g[3]) * acc[nt][mt][3];
                st_bf4(p.Mb + (size_t)EPI_ROW(mt) * 1024 + EPI_COL(nt), o);
            }
        }
    }
}

__device__ __forceinline__ void ph_out(const Params& p, int bid, int nb, char* smem) {
    int u, tm, tn;
    for (int it = 0; next_unit(it, 128 * 8, bid, nb, u); ++it) {
        unit_mn(u, 8, tm, tn);
        const int m0 = tm * 128, n0 = tn * 128;
        f32x4 acc[4][4];
        EPI_COORDS
        acc_zero<4>(acc);
        gemm_tile_acc<4>(acc, p.Mb, 1024, p.Wt_out, 1024, 1024, m0, n0, smem);
#pragma unroll
        for (int nt = 0; nt < 4; ++nt)
#pragma unroll
            for (int mt = 0; mt < 4; ++mt) {
                const int row = EPI_ROW(mt), col = EPI_COL(nt);
                const f32x4 gate = *(const f32x4*)(p.mod + (row / SEQ) * 3072 + 2048 + col);
                const f32x4 xv = *(const f32x4*)(p.x + (size_t)row * DM + col);
                *(f32x4*)(p.out + (size_t)row * DM + col) = xv + gate * acc[nt][mt];
            }
    }
}

#define XB_TMO      128
#define XB_XCNT(j)  (256  + 64 * (j))
#define XB_XSUB(j)  (1280 + 64 * (j))
#define XB_XGEN(j)  (2304 + 64 * (j))
#define XB_TOP      3328
#define XB_TOPGEN   3392
#define XCD_BAR_WORDS 3456
#define XB_SPIN_CAP (1u << 20)
__device__ __forceinline__ unsigned xb_ld(unsigned* p)              { return __hip_atomic_load(p, __ATOMIC_RELAXED, __HIP_MEMORY_SCOPE_AGENT); }
__device__ __forceinline__ unsigned xb_add(unsigned* p, unsigned v) { return __hip_atomic_fetch_add(p, v, __ATOMIC_RELAXED, __HIP_MEMORY_SCOPE_AGENT); }
__device__ __forceinline__ unsigned xb_xcc_id() { return (unsigned)__builtin_amdgcn_s_getreg((3 << 11) | 20) & 0xFu; }
#define XB_SPIN(cond, bar) do { unsigned _sp = 0; while (cond) { __builtin_amdgcn_s_sleep(1); \
    if ((++_sp & 255u) == 0u) { if (xb_ld(&(bar)[XB_TMO])) break; if (_sp > XB_SPIN_CAP) { atomicAdd(&(bar)[XB_TMO], 1u); break; } } } } while (0)
struct XcdBarrier { unsigned* bar; unsigned x; volatile LAS unsigned* st; };
__device__ __forceinline__ XcdBarrier xcd_barrier_post(unsigned* bar, volatile LAS unsigned* st) {
    XcdBarrier b; b.bar = bar; b.x = xb_xcc_id(); b.st = st;
    if (threadIdx.x == 0) (void)xb_add(&bar[XB_XCNT(b.x)], 1u);
    return b;
}
__device__ __forceinline__ void xcd_barrier_complete(unsigned* bar, unsigned x, unsigned& nloc, unsigned& nx) {
    const unsigned G = gridDim.x * gridDim.y * gridDim.z;
    unsigned sum, cnt, mine, sp = 0u;
    for (;;) {
        sum = 0u; cnt = 0u; mine = 0u;
#pragma unroll
        for (unsigned j = 0; j < 16; ++j) { const unsigned c = xb_ld(&bar[XB_XCNT(j)]); sum += c; cnt += (c > 0u) ? 1u : 0u; mine = (j == x) ? c : mine; }
        if (sum == G) break;
        __builtin_amdgcn_s_sleep(1);
        if ((++sp & 255u) == 0u) { if (xb_ld(&bar[XB_TMO])) break; if (sp > XB_SPIN_CAP) { atomicAdd(&bar[XB_TMO], 1u); break; } }
    }
    nloc = mine > 0u ? mine : 1u; nx = cnt > 0u ? cnt : 1u;
}
__device__ __forceinline__ void xcd_barrier(const XcdBarrier& b) {
    asm volatile("s_waitcnt vmcnt(0)" ::: "memory");
    __syncthreads();
    if (threadIdx.x == 0) {
        unsigned* bar = b.bar;
        __builtin_amdgcn_s_waitcnt(0);
        unsigned nloc = b.st[0], nx = b.st[1];
        if (nloc == 0u) { xcd_barrier_complete(bar, b.x, nloc, nx); b.st[0] = nloc; b.st[1] = nx; }
        const unsigned old = xb_add(&bar[XB_XSUB(b.x)], 1u);
        const unsigned gen = old / nloc;
        if (old + 1u == (gen + 1u) * nloc) {
            __builtin_amdgcn_fence(__ATOMIC_RELEASE, "agent");
            asm volatile("s_waitcnt vmcnt(0)" ::: "memory");
            const unsigned og = xb_add(&bar[XB_TOP], 1u);
            const unsigned tg = og / nx;
            if (og + 1u == (tg + 1u) * nx) xb_add(&bar[XB_TOPGEN], 1u);
            else XB_SPIN(xb_ld(&bar[XB_TOPGEN]) == tg, bar);
            __builtin_amdgcn_fence(__ATOMIC_ACQUIRE, "agent");
            xb_add(&bar[XB_XGEN(b.x)], 1u);
            asm volatile("s_waitcnt vmcnt(0)" ::: "memory");
        } else {
            XB_SPIN(xb_ld(&bar[XB_XGEN(b.x)]) == gen, bar);
            __builtin_amdgcn_fence(__ATOMIC_ACQUIRE, "agent");
            asm volatile("s_waitcnt vmcnt(0)" ::: "memory");
        }
    }
    __syncthreads();
}

__global__ void __launch_bounds__(NTHR, 2) fwd_megakernel(Params p) {
    __shared__ __attribute__((aligned(16))) char smem[SMEM_BYTES];
    const int bid = blockIdx.x, nb = gridDim.x;
    volatile LAS unsigned* bst = (volatile LAS unsigned*)(smem + SMEM_BYTES - 16);
    if (threadIdx.x == 0) { bst[0] = 0u; bst[1] = 0u; }
    __syncthreads();
    const XcdBarrier xb = xcd_barrier_post(p.bar, bst);

    ph_mod(p, bid, nb, smem);
    ph_wprep(p, bid, nb, smem);
    xcd_barrier(xb);
    ph_norm(p, bid, nb, smem);
    xcd_barrier(xb);
    ph_inproj(p, bid, nb, smem);
    xcd_barrier(xb);
    ph_mla_proj(p, bid, nb, smem);
    xcd_barrier(xb);
    ph_attn(p, bid, nb, smem);
    xcd_barrier(xb);
    ph_dn1(p, bid, nb, smem);
    xcd_barrier(xb);
    ph_dn2(p, bid, nb, smem);
    xcd_barrier(xb);
    ph_dn3(p, bid, nb, smem);
    ph_gates(p, bid, nb, smem);
    xcd_barrier(xb);
    ph_merge(p, bid, nb, smem);
    xcd_barrier(xb);
    ph_out(p, bid, nb, smem);
}

extern "C" void kernel_launch(void* const* d_in, const int* in_sizes, int n_in,
                              void* d_out, int out_size, void* d_ws, size_t ws_size,
                              hipStream_t stream) {
    static int grid_blocks = 0;
    if (!grid_blocks) {
        int dev = 0, cus = 0, per_cu = 0;
        (void)hipGetDevice(&dev);
        (void)hipDeviceGetAttribute(&cus, hipDeviceAttributeMultiprocessorCount, dev);
        (void)hipOccupancyMaxActiveBlocksPerMultiprocessor(&per_cu, fwd_megakernel, NTHR, 0);
        if (per_cu > 2) per_cu = 2;
        if (per_cu < 1) per_cu = 1;
        grid_blocks = cus * per_cu;
    }
    Params p{};
    const float** fp = (const float**)&p;
    for (int i = 0; i < 21; ++i) fp[i] = (const float*)d_in[i];
    p.out = (float*)d_out;
    char* ws = (char*)d_ws;
    char* ob = (char*)d_out;
    const size_t R_W = 0;
    const size_t R_H = 16777216;
    const size_t R_Z = R_H + 37748736;
    const size_t R_A = R_Z + 33554432;
    const size_t R_F = R_A + 84934656;
    {
        size_t o = R_W;
        p.Wt_a = (bf16_t*)(ws + o); o += 4718592;
        p.Wt_z = (bf16_t*)(ws + o); o += 2097152;
        p.Wt_g = (bf16_t*)(ws + o); o += 4194304;
        p.Wt_uq = (bf16_t*)(ws + o); o += 589824;
        p.Wt_ukv = (bf16_t*)(ws + o); o += 524288;
        p.Wt_mo = (bf16_t*)(ws + o); o += 1048576;
        p.Wt_do = (bf16_t*)(ws + o); o += 1048576;
        p.Wt_out = (bf16_t*)(ws + o); o += 2097152;
        p.mod = (float*)(ws + o); o += 110592;
        p.bar = (unsigned*)(ws + o); o += XCD_BAR_WORDS * 4;
        p.rope = (float*)(ws + o); o += 4096;
    }
    p.h = (bf16_t*)(ws + R_H);
    p.Pz = (bf16_t*)(ws + R_Z);
    p.Pa = (bf16_t*)(ws + R_A);
    p.qn = (bf16_t*)(ws + R_F);
    p.kvn = (bf16_t*)(ws + R_F + 12582912);
    p.Qb = (bf16_t*)(ws + R_F + 22020096);
    p.Kb = (bf16_t*)(ws + R_F + 47185920);
    p.Vt = (bf16_t*)(ws + R_F + 75497472);
    p.Qraw = (bf16_t*)(ob);
    p.KVraw = (bf16_t*)(ob + 25165824);
    p.o_mla = (bf16_t*)(ws + R_F);
    p.MH = (bf16_t*)(ws + R_F + 16777216);
    p.EF = (bf16_t*)(ob);
    p.ST = (bf16_t*)(ws + R_A);
    p.A_mla = (bf16_t*)(ws + R_A + 33554432);
    p.A_dn = (bf16_t*)(ws + R_A + 50331648);
    p.Pg = (bf16_t*)(ws + R_F + 16777216);
    p.Mb = (bf16_t*)(ws + R_H);
    (void)hipMemsetAsync(p.mod, 0, 110592 + XCD_BAR_WORDS * 4, stream);
    void* args[] = {&p};
    hipError_t err = hipLaunchCooperativeKernel((void*)fwd_megakernel, dim3(grid_blocks), dim3(NTHR), args, 0, stream);
    if (err != hipSuccess) fprintf(stderr, "cooperative launch failed: %s (grid %d)\n", hipGetErrorString(err), grid_blocks);
}
```

```cpp
#include <hip/hip_runtime.h>
#include <hip/hip_cooperative_groups.h>
#include <stdint.h>
#include <cstdio>
namespace cg = cooperative_groups;

typedef uint16_t bf16_t;
#define LAS __attribute__((address_space(3)))

#define NB 8
#define SEQ 2048
#define CTXL 256
#define TPB 2304
#define NCTX 2048
#define NL 16384
#define NT 18432
#define DM 1024
#define IN_DIM 5312
#define PA_W 2304
#define PZ_W 1024
#define PG_W 2048
#define PA_CQ 0
#define PA_CKV 384
#define PA_KR 640
#define PA_DQ 672
#define PA_DK 1184
#define PA_DV 1696
#define PA_DB 2208
#define PA_DA 2224
#define EPSF 1e-6f
#define NTHR 256
#define SMEM_BYTES 77824

struct Params {
    const float *x, *c, *ctx, *c_ctx, *w_mod, *b_mod, *norm_w, *w_in, *q_norm_w, *w_uq, *kv_norm_w, *w_ukv, *qhn_w, *khn_w,
        *mla_w_o, *conv_w, *a_log, *dt_bias, *dn_norm_w, *dn_w_o, *w_out;
    float* out;
    bf16_t *h, *Pa, *Pz, *Pg, *Qb, *Vt, *qn, *kvn, *Qraw, *KVraw, *Kb, *o_mla, *MH, *EF, *ST, *A_mla, *A_dn, *Mb;
    bf16_t *Wt_a, *Wt_z, *Wt_g, *Wt_uq, *Wt_ukv, *Wt_mo, *Wt_do, *Wt_out;
    float *mod, *rope;
    unsigned* bar;
};

typedef float f32x4 __attribute__((ext_vector_type(4)));
typedef unsigned u32x4 __attribute__((ext_vector_type(4)));
typedef __bf16 bf16v2_t __attribute__((ext_vector_type(2)));
typedef float f32x2 __attribute__((ext_vector_type(2)));
__device__ __forceinline__ uint32_t pack_bf2(float lo, float hi) {
    f32x2 v = {lo, hi};
    bf16v2_t b = __builtin_convertvector(v, bf16v2_t);
    return __builtin_bit_cast(uint32_t, b);
}
__device__ __forceinline__ void st_bf4(bf16_t* p, f32x4 v) {
    uint2 o; o.x = pack_bf2(v[0], v[1]); o.y = pack_bf2(v[2], v[3]);
    *(uint2*)p = o;
}
__device__ __forceinline__ float bf2f(bf16_t v) { return __uint_as_float(((uint32_t)v) << 16); }
__device__ __forceinline__ bf16_t f2bf(float f) {
    uint32_t u = __float_as_uint(f);
    u += 0x7fffu + ((u >> 16) & 1u);
    return (bf16_t)(u >> 16);
}
__device__ __forceinline__ float silu_f(float v) { return v * __builtin_amdgcn_rcpf(1.f + __expf(-v)); }
__device__ __forceinline__ float sigmoid_f(float v) { return __builtin_amdgcn_rcpf(1.f + __expf(-v)); }
template <int CTRL> __device__ __forceinline__ float dpp_mov(float v) {
    return __builtin_bit_cast(float, __builtin_amdgcn_update_dpp(0, __builtin_bit_cast(int, v), CTRL, 0xF, 0xF, true));
}
__device__ __forceinline__ float row16_sum(float v) {
    v += dpp_mov<0xB1>(v); v += dpp_mov<0x4E>(v); v += dpp_mov<0x141>(v); v += dpp_mov<0x140>(v); return v;
}
__device__ __forceinline__ float rdlane(float v, int l) { return __builtin_bit_cast(float, __builtin_amdgcn_readlane(__builtin_bit_cast(int, v), l)); }
__device__ __forceinline__ float wave_sum(float v) {
    v += dpp_mov<0xB1>(v);
    v += dpp_mov<0x4E>(v);
    v += dpp_mov<0x141>(v);
    v += dpp_mov<0x140>(v);
    return (rdlane(v, 0) + rdlane(v, 16)) + (rdlane(v, 32) + rdlane(v, 48));
}
__device__ __forceinline__ float xrow_sum(float v) { v += __shfl_xor(v, 16); v += __shfl_xor(v, 32); return v; }
__device__ __forceinline__ float wave_max(float v) {
#pragma unroll
    for (int o = 32; o > 0; o >>= 1) v = fmaxf(v, __shfl_xor(v, o));
    return v;
}
__device__ __forceinline__ float block_sum256(float v, float* sh) {
    v = wave_sum(v);
    __syncthreads();
    if ((threadIdx.x & 63) == 0) sh[threadIdx.x >> 6] = v;
    __syncthreads();
    return sh[0] + sh[1] + sh[2] + sh[3];
}

__device__ __forceinline__ void ph_mod(const Params& p, int bid, int nb, char* smem) {
    float* sc = (float*)smem;
    for (int item = bid; item < 64; item += nb) {
        const int k0 = item * 16, tid = threadIdx.x;
        __syncthreads();
        if (tid < 144) {
            const int r = tid >> 4, kk = tid & 15;
            const float v = (r < 8) ? p.c[r * 1024 + k0 + kk] : p.c_ctx[k0 + kk];
            sc[tid] = silu_f(v);
        }
        __syncthreads();
#pragma unroll 1
        for (int half = 0; half < 2; ++half) {
            float acc[6][9];
#pragma unroll
            for (int q = 0; q < 6; ++q)
#pragma unroll
                for (int r = 0; r < 9; ++r) acc[q][r] = 0.f;
            const float* wp = p.w_mod + (size_t)k0 * 3072 + half * 1536 + tid;
#pragma unroll 4
            for (int kk = 0; kk < 16; ++kk) {
                float wv[6];
#pragma unroll
                for (int q = 0; q < 6; ++q) wv[q] = wp[(size_t)kk * 3072 + q * 256];
#pragma unroll
                for (int r = 0; r < 9; ++r) {
                    const float s = sc[r * 16 + kk];
#pragma unroll
                    for (int q = 0; q < 6; ++q) acc[q][r] += s * wv[q];
                }
            }
#pragma unroll
            for (int q = 0; q < 6; ++q) {
                const int j = half * 1536 + q * 256 + tid;
                const float bb = (item == 0) ? p.b_mod[j] : 0.f;
#pragma unroll
                for (int r = 0; r < 9; ++r) atomicAdd(p.mod + r * 3072 + j, acc[q][r] + bb);
            }
        }
    }
}

__device__ __forceinline__ void ph_norm(const Params& p, int bid, int nb, char* smem) {
    const int lane = threadIdx.x & 63, gw = bid * 4 + (threadIdx.x >> 6), nw = nb * 4;
    f32x4 v[4], vn[4];
    int r = gw;
    auto rowptr = [&](int rr) -> const float* { return (rr < NCTX) ? p.ctx + (size_t)rr * DM : p.x + (size_t)(rr - NCTX) * DM; };
    if (r < NT) {
        const float* src = rowptr(r);
#pragma unroll
        for (int i = 0; i < 4; ++i) v[i] = *(const f32x4*)(src + i * 256 + lane * 4);
    }
    for (; r < NT; r += nw) {
        const int rn = r + nw;
        if (rn < NT) {
            const float* src = rowptr(rn);
#pragma unroll
            for (int i = 0; i < 4; ++i) vn[i] = *(const f32x4*)(src + i * 256 + lane * 4);
        }
        float ss = 0.f;
#pragma unroll
        for (int i = 0; i < 4; ++i) ss += v[i][0] * v[i][0] + v[i][1] * v[i][1] + v[i][2] * v[i][2] + v[i][3] * v[i][3];
        ss = wave_sum(ss);
        const float rstd = rsqrtf(ss * (1.f / 1024.f) + EPSF);
        const int mrow = (r < NCTX) ? 8 : (r - NCTX) / SEQ;
        const float* shift = p.mod + mrow * 3072;
        const float* scale = shift + 1024;
#pragma unroll
        for (int i = 0; i < 4; ++i) {
            const int k = i * 256 + lane * 4;
            const f32x4 nwv = *(const f32x4*)(p.norm_w + k), sc = *(const f32x4*)(scale + k), sh = *(const f32x4*)(shift + k);
            f32x4 y;
#pragma unroll
            for (int e2 = 0; e2 < 4; ++e2) y[e2] = v[i][e2] * rstd * nwv[e2] * (1.f + sc[e2]) + sh[e2];
            st_bf4(p.h + (size_t)r * DM + k, y);
        }
#pragma unroll
        for (int i = 0; i < 4; ++i) v[i] = vn[i];
    }
}


__device__ __forceinline__ void wprep_unit(const float* __restrict__ W, int ldw, int K, int n0, int k0, int srcbase, bf16_t* __restrict__ dst, float* tile,
                                           const float* __restrict__ kscale) {
    const int tid = threadIdx.x;
    {
        const int n4 = (tid & 7) * 4, kk = tid >> 3;
        float4 v[4];
#pragma unroll
        for (int q = 0; q < 4; ++q) {
            const int k = kk + 32 * q;
            v[q] = make_float4(0.f, 0.f, 0.f, 0.f);
            if (srcbase >= 0) v[q] = *(const float4*)(W + (size_t)(k0 + k) * ldw + srcbase + n4);
        }
#pragma unroll
        for (int q = 0; q < 4; ++q) {
            const int k = kk + 32 * q;
            if (kscale) { const float s = kscale[k0 + k]; v[q].x *= s; v[q].y *= s; v[q].z *= s; v[q].w *= s; }
            float* t = tile + k * 33 + n4;
            t[0] = v[q].x; t[1] = v[q].y; t[2] = v[q].z; t[3] = v[q].w;
        }
    }
    __syncthreads();
    {
        const int n = tid >> 3;
#pragma unroll
        for (int q = 0; q < 2; ++q) {
            const int kc = (tid & 7) + 8 * q;
            const float* t = tile + (kc * 8) * 33 + n;
            uint4 o;
            o.x = pack_bf2(t[0 * 33], t[1 * 33]); o.y = pack_bf2(t[2 * 33], t[3 * 33]);
            o.z = pack_bf2(t[4 * 33], t[5 * 33]); o.w = pack_bf2(t[6 * 33], t[7 * 33]);
            *(uint4*)(dst + (size_t)(n0 + n) * K + k0 + kc * 8) = o;
        }
    }
    __syncthreads();
}

__device__ __forceinline__ void ph_wprep(const Params& p, int bid, int nb, char* smem) {
    float* tile = (float*)smem;
    const int U0 = 72 * 8, U1 = 32 * 8, U2 = 64 * 8, U3 = 24 * 3, U4 = 32 * 2, U5 = 32 * 4, U6 = 32 * 4, U7 = 32 * 8;
    const int UT = U0 + U1 + U2 + U3 + U4 + U5 + U6 + U7;
    for (int u = bid; u < UT; u += nb) {
        int v = u;
        const float* W; int ldw, K; bf16_t* dst; int job;
        if (v < U0) { job = 0; W = p.w_in; ldw = IN_DIM; K = 1024; dst = p.Wt_a; }
        else if ((v -= U0) < U1) { job = 1; W = p.w_in; ldw = IN_DIM; K = 1024; dst = p.Wt_z; }
        else if ((v -= U1) < U2) { job = 2; W = p.w_in; ldw = IN_DIM; K = 1024; dst = p.Wt_g; }
        else if ((v -= U2) < U3) { job = 3; W = p.w_uq; ldw = 768; K = 384; dst = p.Wt_uq; }
        else if ((v -= U3) < U4) { job = 4; W = p.w_ukv; ldw = 1024; K = 256; dst = p.Wt_ukv; }
        else if ((v -= U4) < U5) { job = 5; W = p.mla_w_o; ldw = 1024; K = 512; dst = p.Wt_mo; }
        else if ((v -= U5) < U6) { job = 6; W = p.dn_w_o; ldw = 1024; K = 512; dst = p.Wt_do; }
        else { v -= U6; job = 7; W = p.w_out; ldw = 1024; K = 1024; dst = p.Wt_out; }
        const int nkt = K / 128;
        const int n0 = (v / nkt) * 32, k0 = (v % nkt) * 128;
        int srcbase = n0;
        if (job == 0) {
            if (n0 < 672) srcbase = n0;
            else if (n0 < 2208) { const int r = n0 - 672, hh = r / 192, g = (r % 192) >> 6, i0 = r & 63; srcbase = 1184 + g * 512 + hh * 64 + i0; }
            else srcbase = (n0 < 2240) ? n0 + 1024 : -1;
        }
        else if (job == 1) srcbase = (n0 < 512) ? 672 + n0 : 2208 + n0;
        else if (job == 2) srcbase = 3264 + n0;
        const float* ksc = (job == 3) ? p.q_norm_w : (job == 4) ? p.kv_norm_w : nullptr;
        wprep_unit(W, ldw, K, n0, k0, srcbase, dst, tile, ksc);
    }
    if (bid == nb - 1) {
        for (int i = threadIdx.x; i < 512; i += NTHR) {
            const int pos = i >> 3, f = i & 7;
            const float ang = (float)pos * powf(10000.f, -(float)f / 8.f);
            p.rope[2 * i] = cosf(ang); p.rope[2 * i + 1] = sinf(ang);
        }
    }
}

typedef short bf16x8 __attribute__((ext_vector_type(8)));


__device__ __forceinline__ int lds_off(int row, int chunk) { return row * 128 + (((chunk ^ (row >> 1)) & 7) << 4); }

__device__ __forceinline__ int epi_perm(int rho) { return 8 * ((rho >> 2) & 3) + 4 * (rho >> 4) + (rho & 3); }

template <int NTN>
__device__ __forceinline__ void gemm_compute_stage(f32x4 (&acc)[NTN][4], const char* sa, int wm, int wn, int l15, int lq) {
    const char* sb = sa + 16384;
#pragma unroll
    for (int ks = 0; ks < 2; ++ks) {
        bf16x8 af[4], bfr[NTN];
#pragma unroll
        for (int mt = 0; mt < 4; ++mt) af[mt] = *(const bf16x8*)(sa + lds_off(wm * 64 + mt * 16 + l15, ks * 4 + lq));
#pragma unroll
        for (int nt = 0; nt < NTN; ++nt) bfr[nt] = *(const bf16x8*)(sb + lds_off(wn * (16 * NTN) + nt * 16 + l15, ks * 4 + lq));
#pragma unroll
        for (int nt = 0; nt < NTN; ++nt)
#pragma unroll
            for (int mt = 0; mt < 4; ++mt)
                acc[nt][mt] = __builtin_amdgcn_mfma_f32_16x16x32_bf16(bfr[nt], af[mt], acc[nt][mt], 0, 0, 0);
    }
}
template <int NTN>
__device__ __forceinline__ void gemm_tile_acc(f32x4 (&acc)[NTN][4], const bf16_t* __restrict__ A, int lda, const bf16_t* __restrict__ Bt, int ldb,
                                              int K, int m0, int n0, char* smem) {
    int tid = threadIdx.x;
    asm volatile("" : "+v"(tid));
    const int lane = tid & 63, w = tid >> 6, wm = w >> 1, wn = w & 1;
    const int l15 = lane & 15, lq = lane >> 4;
    const int srow = tid >> 3, sch = (tid & 7) ^ ((srow >> 1) & 7);
    const bf16_t* ap = A + (size_t)(m0 + srow) * lda + sch * 8;
    const int prow = epi_perm(srow & 31);
    const bf16_t* bp = Bt + (size_t)(n0 + prow) * ldb + sch * 8;
    int KT = K >> 6;
    asm volatile("" : "+s"(KT));
    LAS char* lbase = (LAS char*)smem + w * 1024;
#define GT_STAGE(ST_, KT_) do { \
        _Pragma("unroll") for (int i = 0; i < 4; ++i) \
            __builtin_amdgcn_global_load_lds((const void*)(ap + (size_t)(32 * i) * lda + (KT_) * 64), (LAS void*)(lbase + (ST_) * 32768 + i * 4096), 16, 0, 0); \
        _Pragma("unroll") for (int i = 0; i < NTN; ++i) \
            __builtin_amdgcn_global_load_lds((const void*)(bp + (size_t)(32 * i) * ldb + (KT_) * 64), (LAS void*)(lbase + (ST_) * 32768 + 16384 + i * 4096), 16, 0, 0); } while (0)
    GT_STAGE(0, 0);
    __syncthreads();
    for (int kt = 0; kt < KT; ++kt) {
        if (kt + 1 < KT) GT_STAGE((kt + 1) & 1, kt + 1);
        gemm_compute_stage<NTN>(acc, smem + (kt & 1) * 32768, wm, wn, l15, lq);
        __syncthreads();
    }
#undef GT_STAGE
}

template <int NTN>
__device__ __forceinline__ void acc_zero(f32x4 (&acc)[NTN][4]) {
#pragma unroll
    for (int i = 0; i < NTN; ++i)
#pragma unroll
        for (int j = 0; j < 4; ++j) acc[i][j] = (f32x4){0.f, 0.f, 0.f, 0.f};
}

__device__ __forceinline__ bool next_unit(int it, int U, int bid, int nb, int& u) {
    const int x = bid & 7, li = bid >> 3, per = nb >> 3;
    const int lo = (int)(((long)U * x) >> 3), hi = (int)(((long)U * (x + 1)) >> 3);
    u = lo + li + it * per;
    return u < hi;
}
__device__ __forceinline__ void unit_mn(int u, int ntn, int& tm, int& tn) {
    const int g = u / (8 * ntn), r = u % (8 * ntn);
    tm = g * 8 + (r & 7); tn = r >> 3;
}


__device__ __forceinline__ f32x4 ld_bf4(const bf16_t* p) {
    const uint2 r = *(const uint2*)p;
    return (f32x4){__uint_as_float(r.x << 16), __uint_as_float(r.x & 0xffff0000u), __uint_as_float(r.y << 16), __uint_as_float(r.y & 0xffff0000u)};
}
#define EPI_COORDS_OPAQUE(SFX) int tid##SFX = threadIdx.x; asm volatile("" : "+v"(tid##SFX)); \
    const int lane_ = tid##SFX & 63, w_ = tid##SFX >> 6, wm_ = w_ >> 1, wn_ = w_ & 1, l15_ = lane_ & 15, lq_ = lane_ >> 4;
#define EPI_COORDS const int lane_ = threadIdx.x & 63, w_ = threadIdx.x >> 6, wm_ = w_ >> 1, wn_ = w_ & 1, l15_ = lane_ & 15, lq_ = lane_ >> 4;
#define EPI_ROW(mt) (m0 + wm_ * 64 + (mt) * 16 + l15_)
#define EPI_COL(nt) (n0 + wn_ * 64 + 32 * ((nt) >> 1) + 8 * lq_ + 4 * ((nt) & 1))
#define EPI_COL2(nt) (n0 + wn_ * 32 + (nt) * 16 + lq_ * 4)

__device__ __forceinline__ void gemm_store_bf16(const bf16_t* A, int lda, const bf16_t* Bt, int K, int tm, int tn, bf16_t* C, int ldc, char* smem) {
    f32x4 acc[4][4];
    acc_zero<4>(acc);
    const int m0 = tm * 128, n0 = tn * 128;
    gemm_tile_acc<4>(acc, A, lda, Bt, K, K, m0, n0, smem);
    EPI_COORDS
#pragma unroll
    for (int j = 0; j < 2; ++j)
#pragma unroll
        for (int mt = 0; mt < 4; ++mt) {
            u32x4 o;
            o[0] = pack_bf2(acc[2 * j][mt][0], acc[2 * j][mt][1]); o[1] = pack_bf2(acc[2 * j][mt][2], acc[2 * j][mt][3]);
            o[2] = pack_bf2(acc[2 * j + 1][mt][0], acc[2 * j + 1][mt][1]); o[3] = pack_bf2(acc[2 * j + 1][mt][2], acc[2 * j + 1][mt][3]);
            *(u32x4*)(C + (size_t)EPI_ROW(mt) * ldc + EPI_COL(2 * j)) = o;
        }
}

template <int NTN>
__device__ __forceinline__ void gemm_rows_acc(f32x4 (&acc)[NTN][2], float (&ssq)[2], const bf16_t* __restrict__ A, int lda,
                                              const bf16_t* __restrict__ Bt, int ldb, int K, int m0, int n0, char* smem) {
    constexpr int NB_ = NTN / 2;
    int tid = threadIdx.x;
    asm volatile("" : "+v"(tid));
    const int lane = tid & 63, w = tid >> 6;
    const int l15 = lane & 15, lq = lane >> 4;
    const int srow = tid >> 3, sch = (tid & 7) ^ ((srow >> 1) & 7);
    const bf16_t* ap = A + (size_t)(m0 + srow) * lda + sch * 8;
    const bf16_t* bp = Bt + (size_t)(n0 + srow) * ldb + sch * 8;
    int KT = K >> 6;
    asm volatile("" : "+s"(KT));
    LAS char* lbase = (LAS char*)smem + w * 1024;
#define GR_STAGE(ST_, KT_) do { \
        _Pragma("unroll") for (int i = 0; i < 4; ++i) \
            __builtin_amdgcn_global_load_lds((const void*)(ap + (size_t)(32 * i) * lda + (KT_) * 64), (LAS void*)(lbase + (ST_) * 32768 + i * 4096), 16, 0, 0); \
        _Pragma("unroll") for (int i = 0; i < NB_; ++i) \
            __builtin_amdgcn_global_load_lds((const void*)(bp + (size_t)(32 * i) * ldb + (KT_) * 64), (LAS void*)(lbase + (ST_) * 32768 + 16384 + i * 4096), 16, 0, 0); } while (0)
    GR_STAGE(0, 0);
    __syncthreads();
    for (int kt = 0; kt < KT; ++kt) {
        if (kt + 1 < KT) GR_STAGE((kt + 1) & 1, kt + 1);
        const char* sa = smem + (kt & 1) * 32768;
        const char* sb = sa + 16384;
#pragma unroll
        for (int ks = 0; ks < 2; ++ks) {
            bf16x8 af[2], bfr[NTN];
#pragma unroll
            for (int mt = 0; mt < 2; ++mt) af[mt] = *(const bf16x8*)(sa + lds_off(w * 32 + mt * 16 + l15, ks * 4 + lq));
#pragma unroll
            for (int nt = 0; nt < NTN; ++nt) bfr[nt] = *(const bf16x8*)(sb + lds_off(nt * 16 + l15, ks * 4 + lq));
#pragma unroll
            for (int mt = 0; mt < 2; ++mt) {
                const u32x4 aw = __builtin_bit_cast(u32x4, af[mt]);
#pragma unroll
                for (int e2 = 0; e2 < 4; ++e2) {
                    const float lo = __uint_as_float(aw[e2] << 16), hi = __uint_as_float(aw[e2] & 0xffff0000u);
                    ssq[mt] += lo * lo + hi * hi;
                }
            }
#pragma unroll
            for (int nt = 0; nt < NTN; ++nt)
#pragma unroll
                for (int mt = 0; mt < 2; ++mt)
                    acc[nt][mt] = __builtin_amdgcn_mfma_f32_16x16x32_bf16(bfr[nt], af[mt], acc[nt][mt], 0, 0, 0);
        }
        __syncthreads();
    }
#undef GR_STAGE
    ssq[0] = xrow_sum(ssq[0]);
    ssq[1] = xrow_sum(ssq[1]);
}

__device__ __forceinline__ void ph_mla_proj(const Params& p, int bid, int nb, char* smem) {
    const int tid = threadIdx.x, lane = tid & 63, w = tid >> 6, l15 = lane & 15, lq = lane >> 4;
    const int UQ = 128 * 8, UK = 144 * 8;
    int u;
    for (int it = 0; next_unit(it, UQ + UK, bid, nb, u); ++it) {
        if (u < UQ) {
            const int tm = u >> 3, hh = u & 7;
            const int m0 = NCTX + tm * 128;
            f32x4 acc[6][2];
            float ssq[2] = {0.f, 0.f};
#pragma unroll
            for (int i = 0; i < 6; ++i) { acc[i][0] = (f32x4){0.f, 0.f, 0.f, 0.f}; acc[i][1] = (f32x4){0.f, 0.f, 0.f, 0.f}; }
            gemm_rows_acc<6>(acc, ssq, p.Pa + PA_CQ, PA_W, p.Wt_uq, 384, 384, m0, hh * 96, smem);
#pragma unroll
            for (int mt = 0; mt < 2; ++mt) {
                const int ml = 32 * w + 16 * mt + l15;
                const int rl = tm * 128 + ml;
                const int b = rl >> 11, t = rl & 2047;
                const float rs = rsqrtf(ssq[mt] * (1.f / 384.f) + EPSF);
                float hs = 0.f;
#pragma unroll
                for (int nt = 0; nt < 6; ++nt)
#pragma unroll
                    for (int e = 0; e < 4; ++e) { const float v = acc[nt][mt][e] * rs; acc[nt][mt][e] = v; hs += v * v; }
                hs = xrow_sum(hs);
                const float hr = rsqrtf(hs * (1.f / 96.f) + EPSF) * (0.10206207261596575f * 1.4426950408889634f);
                bf16_t* qd = p.Qb + ((size_t)((b * 8 + hh) * SEQ + t)) * 96 + 4 * lq;
#pragma unroll
                for (int nt = 0; nt < 6; ++nt) {
                    const f32x4 wv = *(const f32x4*)(p.qhn_w + 16 * nt + 4 * lq);
                    f32x4 v;
#pragma unroll
                    for (int e = 0; e < 4; ++e) v[e] = acc[nt][mt][e] * hr * wv[e];
                    if (nt >= 4) {
                        const int pos = (nt == 4) ? (t >> 6) : (t & 63);
                        const int ph = lq >> 1;
#pragma unroll
                        for (int e = 0; e < 4; ++e) {
                            const float2 cs = *(const float2*)(p.rope + 2 * (pos * 8 + (lq & 1) * 4 + e));
                            const float partner = __shfl_xor(v[e], 32);
                            const float t1 = ph ? partner : v[e], t2 = ph ? v[e] : partner;
                            v[e] = ph ? (t1 * cs.y + t2 * cs.x) : (t1 * cs.x - t2 * cs.y);
                        }
                    }
                    st_bf4(qd + 16 * nt, v);
                }
            }
        } else {
            const int uu = u - UQ;
            const int tm = uu >> 3, hh = uu & 7;
            const int m0 = tm * 128;
            f32x4 acc[8][2];
            float ssq[2] = {0.f, 0.f};
#pragma unroll
            for (int i = 0; i < 8; ++i) { acc[i][0] = (f32x4){0.f, 0.f, 0.f, 0.f}; acc[i][1] = (f32x4){0.f, 0.f, 0.f, 0.f}; }
            gemm_rows_acc<8>(acc, ssq, p.Pa + PA_CKV, PA_W, p.Wt_ukv, 256, 256, m0, hh * 128, smem);
#pragma unroll
            for (int mt = 0; mt < 2; ++mt) {
                const int ml = 32 * w + 16 * mt + l15;
                const int r = m0 + ml;
                int b, pos, t = 0; const bool lat = (r >= NCTX);
                if (!lat) { b = r >> 8; pos = r & 255; }
                else { const int rl = r - NCTX; b = rl >> 11; t = rl & 2047; pos = CTXL + t; }
                const float rs = rsqrtf(ssq[mt] * (1.f / 256.f) + EPSF);
                const u32x4 krw = *(const u32x4*)(p.Pa + (size_t)r * PA_W + PA_KR + 8 * lq);
                float kr[8];
#pragma unroll
                for (int e = 0; e < 4; ++e) { kr[2 * e] = __uint_as_float(krw[e] << 16); kr[2 * e + 1] = __uint_as_float(krw[e] & 0xffff0000u); }
                float hs = 0.f;
#pragma unroll
                for (int e = 0; e < 8; ++e) hs += kr[e] * kr[e];
#pragma unroll
                for (int nt = 0; nt < 4; ++nt)
#pragma unroll
                    for (int e = 0; e < 4; ++e) { const float v = acc[nt][mt][e] * rs; acc[nt][mt][e] = v; hs += v * v; }
                hs = xrow_sum(hs);
                const float hr = rsqrtf(hs * (1.f / 96.f) + EPSF);
                bf16_t* kd = p.Kb + ((size_t)((b * 8 + hh) * TPB + pos)) * 96;
#pragma unroll
                for (int nt = 0; nt < 4; ++nt) {
                    const f32x4 wv = *(const f32x4*)(p.khn_w + 16 * nt + 4 * lq);
                    f32x4 v;
#pragma unroll
                    for (int e = 0; e < 4; ++e) v[e] = acc[nt][mt][e] * hr * wv[e];
                    st_bf4(kd + 16 * nt + 4 * lq, v);
                }
                {
                    const int ph = lq & 1;
                    const int rp = (lq >> 1) ? (t & 63) : (t >> 6);
                    float o[8];
#pragma unroll
                    for (int e = 0; e < 8; ++e) {
                        const float v = kr[e] * hr * p.khn_w[64 + 8 * lq + e];
                        const float partner = __shfl_xor(v, 16);
                        float2 cs = make_float2(1.f, 0.f);
                        if (lat) cs = *(const float2*)(p.rope + 2 * (rp * 8 + e));
                        const float t1 = ph ? partner : v, t2 = ph ? v : partner;
                        o[e] = ph ? (t1 * cs.y + t2 * cs.x) : (t1 * cs.x - t2 * cs.y);
                    }
                    u32x4 ov;
                    ov[0] = pack_bf2(o[0], o[1]); ov[1] = pack_bf2(o[2], o[3]); ov[2] = pack_bf2(o[4], o[5]); ov[3] = pack_bf2(o[6], o[7]);
                    *(u32x4*)(kd + 64 + 8 * lq) = ov;
                }
                {
                    const int kpos = (pos & ~12) | ((pos & 4) << 1) | ((pos & 8) >> 1);
                    bf16_t* vd = p.Vt + (size_t)((b * 8 + hh) * 64) * TPB + kpos;
#pragma unroll
                    for (int nt = 4; nt < 8; ++nt)
#pragma unroll
                        for (int e = 0; e < 4; ++e) vd[(size_t)(16 * (nt - 4) + 4 * lq + e) * TPB] = f2bf(acc[nt][mt][e] * rs);
                }
            }
        }
    }
}

typedef float f32x16 __attribute__((ext_vector_type(16)));
#define ATT_THR 6.0f
#define ATT_KROW 208
#define ATT_VROW 144
#define ATT_KBYTES (64 * ATT_KROW)
#define ATT_STAGE (ATT_KBYTES + 64 * ATT_VROW)
__device__ __forceinline__ void ph_attn(const Params& p, int bid, int nb, char* smem) {
    const int tid = threadIdx.x, lane = tid & 63, w = tid >> 6, r = lane & 31, h = lane >> 5;
    int u;
    for (int it = 0; next_unit(it, 1024, bid, nb, u); ++it) {
        const int bh = u >> 4, qb = u & 15;
        bf16x8 qf[6];
        {
            const bf16_t* Qp = p.Qb + ((size_t)bh * SEQ + qb * 128 + w * 32 + r) * 96 + h * 8;
#pragma unroll
            for (int s = 0; s < 6; ++s) qf[s] = *(const bf16x8*)(Qp + s * 16);
        }
        const bf16_t* Kg = p.Kb + (size_t)bh * TPB * 96 + tid * 8;
        const bf16_t* Vg = p.Vt + (size_t)bh * 64 * TPB + (size_t)(tid >> 3) * TPB + (tid & 7) * 8;
        int koff[3], voff[2];
#pragma unroll
        for (int i = 0; i < 3; ++i) { const int c = tid + 256 * i; koff[i] = (c / 12) * ATT_KROW + (c % 12) * 16; }
#pragma unroll
        for (int i = 0; i < 2; ++i) { const int c = tid + 256 * i; voff[i] = ATT_KBYTES + (c >> 3) * ATT_VROW + (c & 7) * 16; }
        u32x4 rk[3], rv[2];
#pragma unroll
        for (int i = 0; i < 3; ++i) rk[i] = *(const u32x4*)(Kg + i * 2048);
#pragma unroll
        for (int i = 0; i < 2; ++i) rv[i] = *(const u32x4*)(Vg + (size_t)(32 * i) * TPB);
#pragma unroll
        for (int i = 0; i < 3; ++i) *(u32x4*)(smem + koff[i]) = rk[i];
#pragma unroll
        for (int i = 0; i < 2; ++i) *(u32x4*)(smem + voff[i]) = rv[i];
        __syncthreads();
        f32x16 o0, o1;
#pragma unroll
        for (int i = 0; i < 16; ++i) { o0[i] = 0.f; o1[i] = 0.f; }
        float m = 0.f, l = 0.f;
        int NKT = TPB / 64;
        asm volatile("" : "+s"(NKT));
        for (int kt = 0; kt < NKT; ++kt) {
            if (kt + 1 < NKT) {
#pragma unroll
                for (int i = 0; i < 3; ++i) rk[i] = *(const u32x4*)(Kg + (size_t)(kt + 1) * 6144 + i * 2048);
#pragma unroll
                for (int i = 0; i < 2; ++i) rv[i] = *(const u32x4*)(Vg + (size_t)(32 * i) * TPB + (kt + 1) * 64);
            }
            const char* sk = smem + (kt & 1) * ATT_STAGE;
            const char* sv = sk + ATT_KBYTES;
            f32x16 s0, s1;
            {
                const float c0 = -m;
#pragma unroll
                for (int i = 0; i < 16; ++i) { s0[i] = c0; s1[i] = c0; }
            }
#pragma unroll
            for (int s = 0; s < 6; ++s) {
                const bf16x8 k0 = *(const bf16x8*)(sk + r * ATT_KROW + (2 * s + h) * 16);
                const bf16x8 k1 = *(const bf16x8*)(sk + (32 + r) * ATT_KROW + (2 * s + h) * 16);
                s0 = __builtin_amdgcn_mfma_f32_32x32x16_bf16(k0, qf[s], s0, 0, 0, 0);
                s1 = __builtin_amdgcn_mfma_f32_32x32x16_bf16(k1, qf[s], s1, 0, 0, 0);
            }
            float mx = fmaxf(s0[0], s1[0]);
#pragma unroll
            for (int i = 1; i < 16; ++i) mx = fmaxf(mx, fmaxf(s0[i], s1[i]));
            mx = fmaxf(mx, __shfl_xor(mx, 32));
            if (kt == 0 || __any(mx > ATT_THR)) {
                const float delta = (kt == 0) ? mx : fmaxf(mx, 0.f);
                const float alpha = (kt == 0) ? 1.f : __builtin_amdgcn_exp2f(-delta);
                m += delta;
                l *= alpha;
#pragma unroll
                for (int i = 0; i < 16; ++i) { o0[i] *= alpha; o1[i] *= alpha; s0[i] -= delta; s1[i] -= delta; }
            }
            float ls = 0.f;
#pragma unroll
            for (int i = 0; i < 16; ++i) {
                s0[i] = __builtin_amdgcn_exp2f(s0[i]);
                s1[i] = __builtin_amdgcn_exp2f(s1[i]);
                ls += s0[i] + s1[i];
            }
            l += ls;
#pragma unroll
            for (int ks = 0; ks < 4; ++ks) {
                u32x4 pw;
                if (ks < 2) {
                    pw[0] = pack_bf2(s0[8 * (ks & 1) + 0], s0[8 * (ks & 1) + 1]); pw[1] = pack_bf2(s0[8 * (ks & 1) + 2], s0[8 * (ks & 1) + 3]);
                    pw[2] = pack_bf2(s0[8 * (ks & 1) + 4], s0[8 * (ks & 1) + 5]); pw[3] = pack_bf2(s0[8 * (ks & 1) + 6], s0[8 * (ks & 1) + 7]);
                } else {
                    pw[0] = pack_bf2(s1[8 * (ks & 1) + 0], s1[8 * (ks & 1) + 1]); pw[1] = pack_bf2(s1[8 * (ks & 1) + 2], s1[8 * (ks & 1) + 3]);
                    pw[2] = pack_bf2(s1[8 * (ks & 1) + 4], s1[8 * (ks & 1) + 5]); pw[3] = pack_bf2(s1[8 * (ks & 1) + 6], s1[8 * (ks & 1) + 7]);
                }
                const bf16x8 pf = __builtin_bit_cast(bf16x8, pw);
                const bf16x8 v0 = *(const bf16x8*)(sv + r * ATT_VROW + (2 * ks + h) * 16);
                const bf16x8 v1 = *(const bf16x8*)(sv + (32 + r) * ATT_VROW + (2 * ks + h) * 16);
                o0 = __builtin_amdgcn_mfma_f32_32x32x16_bf16(v0, pf, o0, 0, 0, 0);
                o1 = __builtin_amdgcn_mfma_f32_32x32x16_bf16(v1, pf, o1, 0, 0, 0);
            }
            if (kt + 1 < NKT) {
                char* ds = smem + ((kt + 1) & 1) * ATT_STAGE;
#pragma unroll
                for (int i = 0; i < 3; ++i) *(u32x4*)(ds + koff[i]) = rk[i];
#pragma unroll
                for (int i = 0; i < 2; ++i) *(u32x4*)(ds + voff[i]) = rv[i];
            }
            __syncthreads();
        }
        l += __shfl_xor(l, 32);
        const float inv = 1.f / l;
        const int b = bh >> 3, hh = bh & 7;
        bf16_t* op = p.o_mla + ((size_t)(b * SEQ + qb * 128 + w * 32 + r)) * 512 + hh * 64 + 4 * h;
#pragma unroll
        for (int g = 0; g < 4; ++g) {
            uint2 a, c;
            a.x = pack_bf2(o0[4 * g + 0] * inv, o0[4 * g + 1] * inv); a.y = pack_bf2(o0[4 * g + 2] * inv, o0[4 * g + 3] * inv);
            c.x = pack_bf2(o1[4 * g + 0] * inv, o1[4 * g + 1] * inv); c.y = pack_bf2(o1[4 * g + 2] * inv, o1[4 * g + 3] * inv);
            *(uint2*)(op + 8 * g) = a;
            *(uint2*)(op + 32 + 8 * g) = c;
        }
    }
}

__device__ __forceinline__ int el_off(int row, int col) { return lds_off(row, col >> 3) + (col & 7) * 2; }

__device__ __forceinline__ void mm64(f32x4 (&acc)[4], const char* A, int arow0, const char* B, int l15, int lq) {
#pragma unroll
    for (int ks = 0; ks < 2; ++ks) {
        const bf16x8 a = *(const bf16x8*)(A + lds_off(arow0 + l15, ks * 4 + lq));
#pragma unroll
        for (int nt = 0; nt < 4; ++nt) {
            const bf16x8 b = *(const bf16x8*)(B + lds_off(nt * 16 + l15, ks * 4 + lq));
            acc[nt] = __builtin_amdgcn_mfma_f32_16x16x32_bf16(a, b, acc[nt], 0, 0, 0);
        }
    }
}
__device__ __forceinline__ void acc4_zero(f32x4 (&a)[4]) {
#pragma unroll
    for (int i = 0; i < 4; ++i) a[i] = (f32x4){0.f, 0.f, 0.f, 0.f};
}

#define DN_SQ 0
#define DN_SK 8192
#define DN_SV 16384
#define DN_LSTR 65
#define DN_LBYTES (64 * DN_LSTR * 4)
#define DN_SL 24576
#define DN_SA 57856
#define DN_SKD 66048
#define DN_SS 74240

typedef short s16x4 __attribute__((ext_vector_type(4)));
__device__ __forceinline__ s16x4 ds_tr(const char* p) { return __builtin_amdgcn_ds_read_tr16_b64_v4i16((LAS s16x4*)p); }

struct Dn1In { u32x4 rp[7]; float db, da; float cw[4]; };
__device__ __forceinline__ void dn1_fetch(Dn1In& in, const Params& p, int u, int tid) {
    const int bh = u / 36, pb = u % 36, b = bh >> 3, h = bh & 7;
    int rowbase, seglen, lb;
    if (pb < 4) { rowbase = b * CTXL; seglen = CTXL; lb = pb; }
    else { rowbase = NCTX + b * SEQ; seglen = SEQ; lb = pb - 4; }
#pragma unroll
    for (int i = 0; i < 7; ++i) {
        const int c = tid + NTHR * i;
        const int g = c / 544, rem = c % 544, rr = rem >> 3, ch = rem & 7;
        const int lp = lb * 64 - 2 + rr;
        u32x4 val = (u32x4){0u, 0u, 0u, 0u};
        if (c < 3 * 68 * 8 && lp >= 0 && lp < seglen) val = *(const u32x4*)(p.Pa + (size_t)(rowbase + lp) * PA_W + PA_DQ + h * 192 + g * 64 + ch * 8);
        in.rp[i] = val;
    }
#pragma unroll
    for (int i = 0; i < 4; ++i) {
        const int idx = tid + NTHR * i, g = idx / 320, j = (idx % 320) >> 6, c = idx & 63;
        in.cw[i] = (idx < 960) ? p.conv_w[j * 1536 + g * 512 + h * 64 + c] : 0.f;
    }
    in.db = 0.f; in.da = 0.f;
    if (tid < 128) {
        const int d = tid >> 6, tp = tid & 63;
        const int pos = d ? 63 - tp : tp;
        const bf16_t* row = p.Pa + (size_t)(rowbase + lb * 64 + pos) * PA_W;
        in.db = bf2f(row[PA_DB + d * 8 + h]);
        in.da = bf2f(row[PA_DA + d * 8 + h]);
    }
}

__device__ __forceinline__ void ph_dn1(const Params& p, int bid, int nb, char* smem) {
    char* sQ = smem + DN_SQ; char* sK = smem + DN_SK; char* sV = smem + DN_SV;
    char* sL = smem + DN_SL; char* sA = smem + DN_SA; char* sKd = smem + DN_SKD;
    float* sS = (float*)(smem + DN_SS);
    const int x_ = bid & 7, li_ = bid >> 3, per_ = nb >> 3;
#define DN1_UNIT(IT, U, VALID) do { const int q_ = li_ + (IT) * per_; const int grp_ = x_ + 8 * (q_ >> 3); VALID = (grp_ < 8 * 36); \
        const int b_ = grp_ / 36, pb_ = grp_ % 36; U = (b_ * 8 + (q_ & 7)) * 36 + pb_; } while (0)
    Dn1In in;
    int u, un; bool valid, validn;
    DN1_UNIT(0, u, valid);
    if (valid) dn1_fetch(in, p, u, threadIdx.x);
    for (int it = 0; valid; ++it, u = un, valid = validn) {
        DN1_UNIT(it + 1, un, validn);
        int tid = threadIdx.x;
        asm volatile("" : "+v"(tid));
        const int lane = tid & 63, w = tid >> 6, l15 = lane & 15, lq = lane >> 4;
        const int bh = u / 36, pb = u % 36, h = bh & 7;
        const bool lat = (pb >= 4);
        if (tid < 128) {
            const int d = tid >> 6, tp = lane;
            const float xx = in.da + p.dt_bias[d * 8 + h];
            const float sp = (xx > 20.f) ? xx : log1pf(__expf(xx));
            const float g = -__expf(p.a_log[d * 8 + h]) * sp;
            float gc = g;
#pragma unroll
            for (int o = 1; o < 64; o <<= 1) { const float t = __shfl_up(gc, o); if (lane >= o) gc += t; }
            const float gl = __shfl(gc, 63);
            const float bt = sigmoid_f(in.db), eg = __expf(gc);
            sS[(d * 5 + 0) * 64 + tp] = bt;
            sS[(d * 5 + 1) * 64 + tp] = gc;
            sS[(d * 5 + 2) * 64 + tp] = eg;
            sS[(d * 5 + 3) * 64 + tp] = __expf(gl - gc);
            sS[(d * 5 + 4) * 64 + tp] = bt * eg;
        }
        {
            char* raw = sL;
#pragma unroll
            for (int i = 0; i < 7; ++i) {
                const int c = tid + NTHR * i;
                const int g = c / 544, rem = c % 544, rr = rem >> 3, ch = rem & 7;
                if (c < 3 * 68 * 8) *(u32x4*)(raw + (g * 68 + rr) * 128 + ch * 16) = in.rp[i];
            }
            float* cwS = (float*)(sL + 26112);
#pragma unroll
            for (int i = 0; i < 4; ++i) { const int idx = tid + NTHR * i; if (idx < 960) cwS[idx] = in.cw[i]; }
            if (validn) dn1_fetch(in, p, un, tid);
            __syncthreads();
            const int o = tid & 7, r0 = tid >> 3;
#pragma unroll
            for (int g = 0; g < 3; ++g) {
                if (g == 0 && !lat) continue;
                float wj[5][8];
#pragma unroll
                for (int j = 0; j < 5; ++j) {
                    const f32x4 w0 = *(const f32x4*)(cwS + (g * 5 + j) * 64 + 8 * o), w1 = *(const f32x4*)(cwS + (g * 5 + j) * 64 + 8 * o + 4);
#pragma unroll
                    for (int e2 = 0; e2 < 4; ++e2) { wj[j][e2] = w0[e2]; wj[j][4 + e2] = w1[e2]; }
                }
#pragma unroll
                for (int hh = 0; hh < 2; ++hh) {
                    const int rr = r0 + 32 * hh;
                    float a[8];
#pragma unroll
                    for (int e2 = 0; e2 < 8; ++e2) a[e2] = 0.f;
#pragma unroll
                    for (int j = 0; j < 5; ++j) {
                        const u32x4 dv = *(const u32x4*)(raw + (g * 68 + rr + j) * 128 + o * 16);
#pragma unroll
                        for (int e2 = 0; e2 < 4; ++e2) {
                            a[2 * e2] += __uint_as_float(dv[e2] << 16) * wj[j][2 * e2];
                            a[2 * e2 + 1] += __uint_as_float(dv[e2] & 0xffff0000u) * wj[j][2 * e2 + 1];
                        }
                    }
                    float ss = 0.f;
#pragma unroll
                    for (int e2 = 0; e2 < 8; ++e2) { a[e2] = silu_f(a[e2]); ss += a[e2] * a[e2]; }
                    float sc = 1.f;
                    if (g < 2) {
                        ss += dpp_mov<0xB1>(ss); ss += dpp_mov<0x4E>(ss); ss += dpp_mov<0x141>(ss);
                        sc = rsqrtf(ss + EPSF) * (g == 0 ? 0.125f : 1.f);
                    }
                    u32x4 ov;
#pragma unroll
                    for (int e2 = 0; e2 < 4; ++e2) ov[e2] = pack_bf2(a[2 * e2] * sc, a[2 * e2 + 1] * sc);
                    *(u32x4*)((g == 0 ? sQ : g == 1 ? sK : sV) + lds_off(rr, o)) = ov;
                }
            }
            __syncthreads();
        }
        {
            f32x4 G[4];
            acc4_zero(G);
            mm64(G, sK, 16 * w, sK, l15, lq);
            float* L0 = (float*)sL; float* L1 = (float*)(sL + DN_LBYTES);
            const float* be0 = sS + 0 * 64; const float* gc0 = sS + 1 * 64;
            const float* be1 = sS + 5 * 64; const float* gc1 = sS + 6 * 64;
#pragma unroll
            for (int nt = 0; nt < 4; ++nt)
#pragma unroll
                for (int rg = 0; rg < 4; ++rg) {
                    const int t = 16 * w + 4 * lq + rg, s = 16 * nt + l15;
                    const float gv = G[nt][rg];
                    const int tp = 63 - t, sp = 63 - s;
                    L0[t * DN_LSTR + s] = (s < t) ? be0[t] * gv * __expf(gc0[t] - gc0[s]) : 0.f;
                    L1[tp * DN_LSTR + sp] = (s > t) ? be1[tp] * gv * __expf(gc1[tp] - gc1[sp]) : 0.f;
                }
            __syncthreads();
        }
        {
            int tid3 = tid;
            asm volatile("" : "+v"(tid3) :: "memory");
            const int lane3 = tid3 & 63, w3 = tid3 >> 6, l15c = lane3 & 15, lqc = lane3 >> 4;
            if (tid3 < 128) {
                float* Lb = (float*)(sL + w3 * DN_LBYTES) + (16 * lqc) * DN_LSTR + 16 * lqc;
                float x[16];
#pragma unroll
                for (int i = 0; i < 16; ++i) {
                    float v = (i == l15c) ? 1.f : 0.f;
#pragma unroll
                    for (int j = 0; j < i; ++j) v -= Lb[i * DN_LSTR + j] * x[j];
                    x[i] = v;
                }
#pragma unroll
                for (int i = 0; i < 16; ++i) Lb[i * DN_LSTR + l15c] = x[i];
            }
            __syncthreads();
            {
                const int d = w3 >> 1, pr = w3 & 1, b0 = 2 * pr, b1 = 2 * pr + 1;
                float* Ld = (float*)(sL + d * DN_LBYTES);
                float* scr = (float*)(sA) + w3 * 272;
                f32x4 P = (f32x4){0.f, 0.f, 0.f, 0.f};
#pragma unroll
                for (int kk = 0; kk < 4; ++kk)
                    P = __builtin_amdgcn_mfma_f32_16x16x4f32(Ld[(16 * b1 + l15c) * DN_LSTR + 16 * b0 + 4 * kk + lqc],
                                                            Ld[(16 * b0 + 4 * kk + lqc) * DN_LSTR + 16 * b0 + l15c], P, 0, 0, 0);
#pragma unroll
                for (int rg = 0; rg < 4; ++rg) scr[(4 * lqc + rg) * 17 + l15c] = P[rg];
                f32x4 R = (f32x4){0.f, 0.f, 0.f, 0.f};
#pragma unroll
                for (int kk = 0; kk < 4; ++kk)
                    R = __builtin_amdgcn_mfma_f32_16x16x4f32(Ld[(16 * b1 + l15c) * DN_LSTR + 16 * b1 + 4 * kk + lqc],
                                                            scr[(4 * kk + lqc) * 17 + l15c], R, 0, 0, 0);
#pragma unroll
                for (int rg = 0; rg < 4; ++rg) Ld[(16 * b1 + 4 * lqc + rg) * DN_LSTR + 16 * b0 + l15c] = -R[rg];
            }
            __syncthreads();
            {
                const int d = w3 >> 1, hf = w3 & 1;
                float* Ld = (float*)(sL + d * DN_LBYTES);
                float* scr2 = (float*)(d ? sKd : sA);
                f32x4 P2[2];
                P2[0] = (f32x4){0.f, 0.f, 0.f, 0.f}; P2[1] = (f32x4){0.f, 0.f, 0.f, 0.f};
#pragma unroll
                for (int kk = 0; kk < 8; ++kk) {
                    const float a = Ld[(32 + 16 * hf + l15c) * DN_LSTR + 4 * kk + lqc];
#pragma unroll
                    for (int n2 = 0; n2 < 2; ++n2)
                        P2[n2] = __builtin_amdgcn_mfma_f32_16x16x4f32(a, Ld[(4 * kk + lqc) * DN_LSTR + 16 * n2 + l15c], P2[n2], 0, 0, 0);
                }
#pragma unroll
                for (int n2 = 0; n2 < 2; ++n2)
#pragma unroll
                    for (int rg = 0; rg < 4; ++rg) scr2[(16 * hf + 4 * lqc + rg) * 33 + 16 * n2 + l15c] = P2[n2][rg];
                __syncthreads();
                f32x4 R2[2];
                R2[0] = (f32x4){0.f, 0.f, 0.f, 0.f}; R2[1] = (f32x4){0.f, 0.f, 0.f, 0.f};
#pragma unroll
                for (int kk = 0; kk < 8; ++kk) {
                    const float a = Ld[(32 + 16 * hf + l15c) * DN_LSTR + 32 + 4 * kk + lqc];
#pragma unroll
                    for (int n2 = 0; n2 < 2; ++n2)
                        R2[n2] = __builtin_amdgcn_mfma_f32_16x16x4f32(a, scr2[(4 * kk + lqc) * 33 + 16 * n2 + l15c], R2[n2], 0, 0, 0);
                }
#pragma unroll
                for (int n2 = 0; n2 < 2; ++n2)
#pragma unroll
                    for (int rg = 0; rg < 4; ++rg) Ld[(32 + 16 * hf + 4 * lqc + rg) * DN_LSTR + 16 * n2 + l15c] = -R2[n2][rg];
            }
            __syncthreads();
            f32x4 U0[4];
            acc4_zero(U0);
#pragma unroll 1
            for (int dd = 0; dd < 4; ++dd) {
                const int d = dd >> 1, isw = dd & 1;
                const float* Td = (const float*)(sL + d * DN_LBYTES);
                {
                    const int tr = tid3 >> 2, cq = tid3 & 3;
                    const float* c1 = sS + (d * 5 + (isw ? 4 : 0)) * 64 + 16 * cq;
                    const float* trow = Td + tr * DN_LSTR + 16 * cq;
                    float tv[16];
#pragma unroll
                    for (int e2 = 0; e2 < 16; ++e2) tv[e2] = trow[e2] * c1[e2];
#pragma unroll
                    for (int q = 0; q < 2; ++q) {
                        u32x4 o1, o2;
#pragma unroll
                        for (int e2 = 0; e2 < 4; ++e2) {
                            const int i0 = 8 * q + 2 * e2;
                            const uint32_t hi = pack_bf2(tv[i0], tv[i0 + 1]);
                            const float r0 = tv[i0] - __uint_as_float(hi << 16), r1 = tv[i0 + 1] - __uint_as_float(hi & 0xffff0000u);
                            o1[e2] = hi;
                            o2[e2] = pack_bf2(r0, r1);
                        }
                        *(u32x4*)(sA + lds_off(tr, 2 * cq + q)) = o1;
                        *(u32x4*)(sKd + lds_off(tr, 2 * cq + q)) = o2;
                    }
                }
                __syncthreads();
                f32x4 U[4];
                acc4_zero(U);
                {
                    const char* sX = isw ? sK : sV;
#pragma unroll
                    for (int ks = 0; ks < 2; ++ks) {
                        const bf16x8 a1 = *(const bf16x8*)(sA + lds_off(16 * w3 + l15c, ks * 4 + lqc));
                        const bf16x8 a2 = *(const bf16x8*)(sKd + lds_off(16 * w3 + l15c, ks * 4 + lqc));
                        const int r0 = 32 * ks + 8 * lqc + (l15c >> 2);
                        const int p0 = d ? 63 - r0 : r0, p1 = d ? 63 - (r0 + 4) : (r0 + 4);
#pragma unroll
                        for (int nt = 0; nt < 4; ++nt) {
                            const int col = 16 * nt + 4 * (l15c & 3);
                            const s16x4 v0 = ds_tr(sX + el_off(p0, col)), v1 = ds_tr(sX + el_off(p1, col));
                            const bf16x8 bx = __builtin_shufflevector(v0, v1, 0, 1, 2, 3, 4, 5, 6, 7);
                            U[nt] = __builtin_amdgcn_mfma_f32_16x16x32_bf16(a1, bx, U[nt], 0, 0, 0);
                            U[nt] = __builtin_amdgcn_mfma_f32_16x16x32_bf16(a2, bx, U[nt], 0, 0, 0);
                        }
                    }
                }
                __syncthreads();
                if (isw == 0) {
                    U0[0] = U[0]; U0[1] = U[1]; U0[2] = U[2]; U0[3] = U[3];
                } else {
                    char* uT = sL + d * DN_LBYTES;
                    char* wT = uT + 8192;
                    const int t0 = 16 * w3 + 4 * lqc;
#pragma unroll
                    for (int nt = 0; nt < 4; ++nt) {
                        uint2 ou, ow;
                        ou.x = pack_bf2(U0[nt][0], U0[nt][1]); ou.y = pack_bf2(U0[nt][2], U0[nt][3]);
                        ow.x = pack_bf2(U[nt][0], U[nt][1]); ow.y = pack_bf2(U[nt][2], U[nt][3]);
                        *(uint2*)(uT + el_off(16 * nt + l15c, t0)) = ou;
                        *(uint2*)(wT + el_off(16 * nt + l15c, t0)) = ow;
                    }
                    __syncthreads();
                }
            }
        }
        int tid5 = tid;
        asm volatile("" : "+v"(tid5) :: "memory");
        const int lane5 = tid5 & 63, w5 = tid5 >> 6, l15_5 = lane5 & 15, lq5 = lane5 >> 4;
        f32x4 QK[4];
        acc4_zero(QK);
        mm64(QK, sQ, 16 * w5, sK, l15_5, lq5);
#pragma unroll 1
        for (int d = 0; d < 2; ++d) {
            const float* gcd = sS + (d * 5 + 1) * 64;
            const float* egd = sS + (d * 5 + 2) * 64;
            const float* ekd = sS + (d * 5 + 3) * 64;
            {
                const int i = lane5, tq = w5;
                float kv[16];
#pragma unroll
                for (int e = 0; e < 16; ++e) {
                    const int tp = tq * 16 + e, pos = d ? 63 - tp : tp;
                    kv[e] = bf2f(*(const bf16_t*)(sK + el_off(pos, i))) * ekd[tp];
                }
#pragma unroll
                for (int q = 0; q < 2; ++q) {
                    u32x4 o;
                    o[0] = pack_bf2(kv[8 * q + 0], kv[8 * q + 1]); o[1] = pack_bf2(kv[8 * q + 2], kv[8 * q + 3]);
                    o[2] = pack_bf2(kv[8 * q + 4], kv[8 * q + 5]); o[3] = pack_bf2(kv[8 * q + 6], kv[8 * q + 7]);
                    *(u32x4*)(sKd + lds_off(i, 2 * tq + q)) = o;
                }
            }
#pragma unroll
            for (int nt = 0; nt < 4; ++nt)
#pragma unroll
                for (int rg = 0; rg < 4; ++rg) {
                    const int t = 16 * w5 + 4 * lq5 + rg, s = 16 * nt + l15_5;
                    const int tp = d ? 63 - t : t, sp = d ? 63 - s : s;
                    const float val = (sp <= tp) ? QK[nt][rg] * __expf(gcd[tp] - gcd[sp]) : 0.f;
                    *(bf16_t*)(sA + el_off(tp, sp)) = f2bf(val);
                }
            __syncthreads();
            const char* uT = sL + d * DN_LBYTES;
            const char* wT = uT + 8192;
            const int cd = (d == 0) ? pb : (pb < 4 ? 3 - pb : 39 - pb);
            bf16_t* Mg = p.MH + ((size_t)((bh * 2 + d) * 36 + cd) * 2) * 4096;
            bf16_t* Hg = Mg + 4096;
            {
                f32x4 MT[4];
                acc4_zero(MT);
                mm64(MT, wT, 16 * w5, sKd, l15_5, lq5);
                const float egl = egd[63];
                const int j0 = 16 * w5 + 4 * lq5;
#pragma unroll
                for (int nt = 0; nt < 4; ++nt) {
                    const int i = 16 * nt + l15_5;
                    f32x4 o;
#pragma unroll
                    for (int e = 0; e < 4; ++e) o[e] = ((i == j0 + e) ? egl : 0.f) - MT[nt][e];
                    st_bf4(Mg + i * 64 + j0, o);
                }
            }
            {
                f32x4 HH[4];
                acc4_zero(HH);
                mm64(HH, sKd, 16 * w5, uT, l15_5, lq5);
                const int i0 = 16 * w5 + 4 * lq5;
#pragma unroll
                for (int nt = 0; nt < 4; ++nt) st_bf4(Hg + (16 * nt + l15_5) * 64 + i0, HH[nt]);
            }
            if (lat) {
                bf16_t* Eg = p.EF + ((size_t)((bh * 2 + d) * 32 + (pb - 4)) * 2) * 4096;
                bf16_t* Fg = Eg + 4096;
                {
                    f32x4 ET[4];
                    acc4_zero(ET);
                    mm64(ET, wT, 16 * w5, sA, l15_5, lq5);
                    const int j0 = 16 * w5 + 4 * lq5;
#pragma unroll
                    for (int nt = 0; nt < 4; ++nt) {
                        const int sp = 16 * nt + l15_5, spos = d ? 63 - sp : sp;
                        const f32x4 qv = ld_bf4((const bf16_t*)(sQ + el_off(spos, j0)));
                        const float eg = egd[sp];
                        f32x4 o;
#pragma unroll
                        for (int e = 0; e < 4; ++e) o[e] = qv[e] * eg - ET[nt][e];
                        st_bf4(Eg + spos * 64 + j0, o);
                    }
                }
                {
                    f32x4 FF[4];
                    acc4_zero(FF);
                    mm64(FF, uT, 16 * w5, sA, l15_5, lq5);
                    const int c0 = 16 * w5 + 4 * lq5;
#pragma unroll
                    for (int nt = 0; nt < 4; ++nt) {
                        const int sp = 16 * nt + l15_5, spos = d ? 63 - sp : sp;
                        st_bf4(Fg + spos * 64 + c0, FF[nt]);
                    }
                }
            }
            __syncthreads();
        }
    }
}

struct Dn2Frag { bf16x8 am[2]; uint2 hr[2]; };
__device__ __forceinline__ void dn2_load(Dn2Frag& f, const bf16_t* Mg, int w, int l15, int lq, int i0, int hf) {
#pragma unroll
    for (int ks = 0; ks < 2; ++ks) f.am[ks] = *(const bf16x8*)(Mg + (16 * w + l15) * 64 + ks * 32 + lq * 8);
#pragma unroll
    for (int n2 = 0; n2 < 2; ++n2) f.hr[n2] = *(const uint2*)(Mg + 4096 + (32 * hf + 16 * n2 + l15) * 64 + i0);
}
__device__ __forceinline__ void dn2_step(const Dn2Frag& f, int c, int d, int hf, bf16_t* STc, char* smem, int l15, int lq, int i0) {
    const char* sS = smem + (c & 1) * 4096;
    char* sN = smem + ((c + 1) & 1) * 4096;
    f32x4 acc[2];
#pragma unroll
    for (int n2 = 0; n2 < 2; ++n2)
        acc[n2] = (f32x4){__uint_as_float(f.hr[n2].x << 16), __uint_as_float(f.hr[n2].x & 0xffff0000u),
                          __uint_as_float(f.hr[n2].y << 16), __uint_as_float(f.hr[n2].y & 0xffff0000u)};
#pragma unroll
    for (int ks = 0; ks < 2; ++ks)
#pragma unroll
        for (int n2 = 0; n2 < 2; ++n2) {
            const bf16x8 bs = *(const bf16x8*)(sS + lds_off(16 * n2 + l15, ks * 4 + lq));
            acc[n2] = __builtin_amdgcn_mfma_f32_16x16x32_bf16(f.am[ks], bs, acc[n2], 0, 0, 0);
        }
    const int cn = c + 1;
    const bool st = (cn >= 4 && cn <= 35);
    const int pbi = (d == 0 ? cn : 39 - cn) - 4;
#pragma unroll
    for (int n2 = 0; n2 < 2; ++n2) {
        uint2 o; o.x = pack_bf2(acc[n2][0], acc[n2][1]); o.y = pack_bf2(acc[n2][2], acc[n2][3]);
        const int cl = 16 * n2 + l15;
        *(uint2*)(sN + el_off(cl, i0)) = o;
        if (st) *(uint2*)(STc + (size_t)pbi * 4096 + (32 * hf + cl) * 64 + i0) = o;
    }
    __syncthreads();
}
__device__ __forceinline__ void ph_dn2(const Params& p, int bid, int nb, char* smem) {
    if (bid >= 256) return;
    const int tid = threadIdx.x, lane = tid & 63, w = tid >> 6, l15 = lane & 15, lq = lane >> 4;
    const int chain = bid >> 1, hf = bid & 1, d = chain & 1;
    const bf16_t* MHc = p.MH + (size_t)chain * 36 * 2 * 4096;
    bf16_t* STc = p.ST + (size_t)chain * 32 * 4096;
    for (int i = tid; i < 4096 / 16; i += NTHR) *(u32x4*)(smem + i * 16) = (u32x4){0u, 0u, 0u, 0u};
    __syncthreads();
    const int i0 = 16 * w + 4 * lq;
    Dn2Frag f0, f1, f2, f3;
    dn2_load(f0, MHc + (size_t)0 * 8192, w, l15, lq, i0, hf);
    dn2_load(f1, MHc + (size_t)1 * 8192, w, l15, lq, i0, hf);
    dn2_load(f2, MHc + (size_t)2 * 8192, w, l15, lq, i0, hf);
    dn2_load(f3, MHc + (size_t)3 * 8192, w, l15, lq, i0, hf);
    for (int c0 = 0; c0 < 36; c0 += 4) {
        const bool more = (c0 + 4 < 36);
        dn2_step(f0, c0 + 0, d, hf, STc, smem, l15, lq, i0);
        if (more) dn2_load(f0, MHc + (size_t)(c0 + 4) * 8192, w, l15, lq, i0, hf);
        dn2_step(f1, c0 + 1, d, hf, STc, smem, l15, lq, i0);
        if (more) dn2_load(f1, MHc + (size_t)(c0 + 5) * 8192, w, l15, lq, i0, hf);
        dn2_step(f2, c0 + 2, d, hf, STc, smem, l15, lq, i0);
        if (more) dn2_load(f2, MHc + (size_t)(c0 + 6) * 8192, w, l15, lq, i0, hf);
        dn2_step(f3, c0 + 3, d, hf, STc, smem, l15, lq, i0);
        if (more) dn2_load(f3, MHc + (size_t)(c0 + 7) * 8192, w, l15, lq, i0, hf);
    }
}

__device__ __forceinline__ void ph_dn3(const Params& p, int bid, int nb, char* smem) {
    const int tid = threadIdx.x, lane = tid & 63, w = tid >> 6, l15 = lane & 15, lq = lane >> 4;
    for (int u = bid; u < 64 * 32; u += nb) {
        const int bh = u >> 5, pbi = u & 31, b = bh >> 3, h = bh & 7;
        const int s = 16 * w + l15;
        const size_t rl = (size_t)b * SEQ + pbi * 64 + s;
        f32x4 zdv[4];
#pragma unroll
        for (int mt = 0; mt < 4; ++mt) zdv[mt] = ld_bf4(p.Pz + rl * PZ_W + 512 + h * 64 + 16 * mt + 4 * lq);
        f32x4 acc[4];
        acc4_zero(acc);
#pragma unroll
        for (int d = 0; d < 2; ++d) {
            const bf16_t* Eg = p.EF + ((size_t)((bh * 2 + d) * 32 + pbi) * 2) * 4096;
            const bf16_t* Fg = Eg + 4096;
            const bf16_t* Sg = p.ST + ((size_t)(bh * 2 + d) * 32 + pbi) * 4096;
#pragma unroll
            for (int mt = 0; mt < 4; ++mt) acc[mt] += ld_bf4(Fg + s * 64 + 16 * mt + 4 * lq);
#pragma unroll
            for (int ks = 0; ks < 2; ++ks) {
                const bf16x8 be = *(const bf16x8*)(Eg + s * 64 + ks * 32 + lq * 8);
#pragma unroll
                for (int mt = 0; mt < 4; ++mt) {
                    const bf16x8 as = *(const bf16x8*)(Sg + (16 * mt + l15) * 64 + ks * 32 + lq * 8);
                    acc[mt] = __builtin_amdgcn_mfma_f32_16x16x32_bf16(as, be, acc[mt], 0, 0, 0);
                }
            }
        }
        float ss = 0.f;
#pragma unroll
        for (int mt = 0; mt < 4; ++mt)
#pragma unroll
            for (int rg = 0; rg < 4; ++rg) ss += acc[mt][rg] * acc[mt][rg];
        ss = xrow_sum(ss);
        const float rstd = rsqrtf(ss * (1.f / 64.f) + EPSF);
#pragma unroll
        for (int mt = 0; mt < 4; ++mt) {
            const f32x4 nw = *(const f32x4*)(p.dn_norm_w + 16 * mt + 4 * lq);
            f32x4 o;
#pragma unroll
            for (int rg = 0; rg < 4; ++rg) o[rg] = acc[mt][rg] * rstd * nw[rg] * silu_f(zdv[mt][rg]);
            st_bf4(p.A_dn + rl * 512 + h * 64 + 16 * mt + 4 * lq, o);
        }
    }
    for (size_t i = (size_t)bid * NTHR + tid; i < (size_t)NL * 64; i += (size_t)nb * NTHR) {
        const size_t rl = i >> 6; const int c8 = (int)(i & 63) * 8;
        const u32x4 ov = *(const u32x4*)(p.o_mla + rl * 512 + c8);
        const u32x4 zv = *(const u32x4*)(p.Pz + rl * PZ_W + c8);
        u32x4 r;
#pragma unroll
        for (int e = 0; e < 4; ++e) {
            const float o0 = __uint_as_float(ov[e] << 16), o1 = __uint_as_float(ov[e] & 0xffff0000u);
            const float z0 = __uint_as_float(zv[e] << 16), z1 = __uint_as_float(zv[e] & 0xffff0000u);
            r[e] = pack_bf2(o0 * silu_f(z0), o1 * silu_f(z1));
        }
        *(u32x4*)(p.A_mla + rl * 512 + c8) = r;
    }
}


__device__ __forceinline__ void ph_inproj(const Params& p, int bid, int nb, char* smem) {
    const int UA = 2 * 120 + 16 * 144, UZ = 128 * 8;
    const bf16_t* hl = p.h + (size_t)NCTX * DM;
    int u, tm, tn;
    for (int it = 0; next_unit(it, UA + UZ, bid, nb, u); ++it) {
        if (u < 240) { const int g = u / 120, r = u % 120; tm = g * 8 + (r & 7); tn = 3 + (r >> 3); gemm_store_bf16(p.h, DM, p.Wt_a, 1024, tm, tn, p.Pa, PA_W, smem); }
        else if (u < UA) { unit_mn(u - 240 + 288, 18, tm, tn); gemm_store_bf16(p.h, DM, p.Wt_a, 1024, tm, tn, p.Pa, PA_W, smem); }
        else { unit_mn(u - UA, 8, tm, tn); gemm_store_bf16(hl, DM, p.Wt_z, 1024, tm, tn, p.Pz, PZ_W, smem); }
    }
}

__device__ __forceinline__ void ph_gates(const Params& p, int bid, int nb, char* smem) {
    const bf16_t* hl = p.h + (size_t)NCTX * DM;
    int u, tm, tn;
    for (int it = 0; next_unit(it, 128 * 16, bid, nb, u); ++it) {
        unit_mn(u, 16, tm, tn);
        gemm_store_bf16(hl, DM, p.Wt_g, 1024, tm, tn, p.Pg, PG_W, smem);
    }
}

__device__ __forceinline__ void ph_merge(const Params& p, int bid, int nb, char* smem) {
    int u, tm, tn;
    for (int it = 0; next_unit(it, 128 * 8, bid, nb, u); ++it) {
        unit_mn(u, 8, tm, tn);
        const int m0 = tm * 128, n0 = tn * 128;
        f32x4 acc[4][4];
        uint2 mm[4][4];
        acc_zero<4>(acc);
        gemm_tile_acc<4>(acc, p.A_mla, 512, p.Wt_mo, 512, 512, m0, n0, smem);
        {
        EPI_COORDS_OPAQUE(a)
#pragma unroll
        for (int j = 0; j < 2; ++j)
#pragma unroll
            for (int mt = 0; mt < 4; ++mt) {
                const u32x4 gw = *(const u32x4*)(p.Pg + (size_t)EPI_ROW(mt) * PG_W + EPI_COL(2 * j));
#pragma unroll
                for (int q = 0; q < 2; ++q) {
                    const int nt = 2 * j + q;
                    const float g0 = __uint_as_float(gw[2 * q] << 16), g1 = __uint_as_float(gw[2 * q] & 0xffff0000u);
                    const float g2 = __uint_as_float(gw[2 * q + 1] << 16), g3 = __uint_as_float(gw[2 * q + 1] & 0xffff0000u);
                    mm[nt][mt].x = pack_bf2(sigmoid_f(g0) * acc[nt][mt][0], sigmoid_f(g1) * acc[nt][mt][1]);
                    mm[nt][mt].y = pack_bf2(sigmoid_f(g2) * acc[nt][mt][2], sigmoid_f(g3) * acc[nt][mt][3]);
                }
            }
        }
        acc_zero<4>(acc);
        gemm_tile_acc<4>(acc, p.A_dn, 512, p.Wt_do, 512, 512, m0, n0, smem);
        {
        EPI_COORDS_OPAQUE(b)
#pragma unroll
        for (int j = 0; j < 2; ++j)
#pragma unroll
            for (int mt = 0; mt < 4; ++mt) {
                const u32x4 gw = *(const u32x4*)(p.Pg + (size_t)EPI_ROW(mt) * PG_W + 1024 + EPI_COL(2 * j));
                u32x4 ov;
#pragma unroll
                for (int q = 0; q < 2; ++q) {
                    const int nt = 2 * j + q;
                    const float g0 = __uint_as_float(gw[2 * q] << 16), g1 = __uint_as_float(gw[2 * q] & 0xffff0000u);
                    const float g2 = __uint_as_float(gw[2 * q + 1] << 16), g3 = __uint_as_float(gw[2 * q + 1] & 0xffff0000u);
                    const float o0 = __uint_as_float(mm[nt][mt].x << 16) + sigmoid_f(g0) * acc[nt][mt][0];
                    const float o1 = __uint_as_float(mm[nt][mt].x & 0xffff0000u) + sigmoid_f(g1) * acc[nt][mt][1];
                    const float o2 = __uint_as_float(mm[nt][mt].y << 16) + sigmoid_f(g2) * acc[nt][mt][2];
                    const float o3 = __uint_as_float(mm[nt][mt].y & 0xffff0000u) + sigmoid_f(g3) * acc[nt][mt][3];
                    ov[2 * q] = pack_bf2(o0, o1); ov[2 * q + 1] = pack_bf2(o2, o3);
                }
                *(u32x4*)(p.Mb + (size_t)EPI_ROW(mt) * 1024 + EPI_COL(2 * j)) = ov;
            }
        }
    }
}

__device__ __forceinline__ void ph_out(const Params& p, int bid, int nb, char* smem) {
    int u, tm, tn;
    for (int it = 0; next_unit(it, 128 * 8, bid, nb, u); ++it) {
        unit_mn(u, 8, tm, tn);
        const int m0 = tm * 128, n0 = tn * 128;
        f32x4 acc[4][4], xv[4][4];
        EPI_COORDS
#pragma unroll
        for (int nt = 0; nt < 4; ++nt)
#pragma unroll
            for (int mt = 0; mt < 4; ++mt) xv[nt][mt] = *(const f32x4*)(p.x + (size_t)EPI_ROW(mt) * DM + EPI_COL(nt));
        acc_zero<4>(acc);
        gemm_tile_acc<4>(acc, p.Mb, 1024, p.Wt_out, 1024, 1024, m0, n0, smem);
        const float* gp = p.mod + (m0 / SEQ) * 3072 + 2048;
#pragma unroll
        for (int nt = 0; nt < 4; ++nt) {
            const f32x4 gate = *(const f32x4*)(gp + EPI_COL(nt));
#pragma unroll
            for (int mt = 0; mt < 4; ++mt)
                *(f32x4*)(p.out + (size_t)EPI_ROW(mt) * DM + EPI_COL(nt)) = xv[nt][mt] + gate * acc[nt][mt];
        }
    }
}

#define XB_TMO      128
#define XB_XCNT(j)  (256  + 64 * (j))
#define XB_XSUB(j)  (1280 + 64 * (j))
#define XB_XGEN(j)  (2304 + 64 * (j))
#define XB_TOP      3328
#define XB_TOPGEN   3392
#define XCD_BAR_WORDS 3456
#define XB_SPIN_CAP (1u << 20)
__device__ __forceinline__ unsigned xb_ld(unsigned* p)              { return __hip_atomic_load(p, __ATOMIC_RELAXED, __HIP_MEMORY_SCOPE_AGENT); }
__device__ __forceinline__ unsigned xb_add(unsigned* p, unsigned v) { return __hip_atomic_fetch_add(p, v, __ATOMIC_RELAXED, __HIP_MEMORY_SCOPE_AGENT); }
__device__ __forceinline__ unsigned xb_xcc_id() { return (unsigned)__builtin_amdgcn_s_getreg((3 << 11) | 20) & 0xFu; }
#define XB_SPIN(cond, bar) do { unsigned _sp = 0; while (cond) { __builtin_amdgcn_s_sleep(1); \
    if ((++_sp & 255u) == 0u) { if (xb_ld(&(bar)[XB_TMO])) break; if (_sp > XB_SPIN_CAP) { atomicAdd(&(bar)[XB_TMO], 1u); break; } } } } while (0)
struct XcdBarrier { unsigned* bar; unsigned x; volatile LAS unsigned* st; };
__device__ __forceinline__ XcdBarrier xcd_barrier_post(unsigned* bar, volatile LAS unsigned* st) {
    XcdBarrier b; b.bar = bar; b.x = xb_xcc_id(); b.st = st;
    if (threadIdx.x == 0) (void)xb_add(&bar[XB_XCNT(b.x)], 1u);
    return b;
}
__device__ __forceinline__ void xcd_barrier_complete(unsigned* bar, unsigned x, unsigned& nloc, unsigned& nx) {
    const unsigned G = gridDim.x * gridDim.y * gridDim.z;
    unsigned sum, cnt, mine, sp = 0u;
    for (;;) {
        sum = 0u; cnt = 0u; mine = 0u;
#pragma unroll
        for (unsigned j = 0; j < 16; ++j) { const unsigned c = xb_ld(&bar[XB_XCNT(j)]); sum += c; cnt += (c > 0u) ? 1u : 0u; mine = (j == x) ? c : mine; }
        if (sum == G) break;
        __builtin_amdgcn_s_sleep(1);
        if ((++sp & 255u) == 0u) { if (xb_ld(&bar[XB_TMO])) break; if (sp > XB_SPIN_CAP) { atomicAdd(&bar[XB_TMO], 1u); break; } }
    }
    nloc = mine > 0u ? mine : 1u; nx = cnt > 0u ? cnt : 1u;
}
__device__ __forceinline__ void xcd_barrier(const XcdBarrier& b) {
    asm volatile("s_waitcnt vmcnt(0)" ::: "memory");
    __syncthreads();
    if (threadIdx.x == 0) {
        unsigned* bar = b.bar;
        __builtin_amdgcn_s_waitcnt(0);
        unsigned nloc = b.st[0], nx = b.st[1];
        if (nloc == 0u) { xcd_barrier_complete(bar, b.x, nloc, nx); b.st[0] = nloc; b.st[1] = nx; }
        const unsigned old = xb_add(&bar[XB_XSUB(b.x)], 1u);
        const unsigned gen = old / nloc;
        if (old + 1u == (gen + 1u) * nloc) {
            __builtin_amdgcn_fence(__ATOMIC_RELEASE, "agent");
            asm volatile("s_waitcnt vmcnt(0)" ::: "memory");
            const unsigned og = xb_add(&bar[XB_TOP], 1u);
            const unsigned tg = og / nx;
            if (og + 1u == (tg + 1u) * nx) xb_add(&bar[XB_TOPGEN], 1u);
            else XB_SPIN(xb_ld(&bar[XB_TOPGEN]) == tg, bar);
            __builtin_amdgcn_fence(__ATOMIC_ACQUIRE, "agent");
            xb_add(&bar[XB_XGEN(b.x)], 1u);
            asm volatile("s_waitcnt vmcnt(0)" ::: "memory");
        } else {
            XB_SPIN(xb_ld(&bar[XB_XGEN(b.x)]) == gen, bar);
            __builtin_amdgcn_fence(__ATOMIC_ACQUIRE, "agent");
            asm volatile("s_waitcnt vmcnt(0)" ::: "memory");
        }
    }
    __syncthreads();
}

__global__ void __launch_bounds__(NTHR, 2) fwd_megakernel(Params p) {
    __shared__ __attribute__((aligned(16))) char smem[SMEM_BYTES];
    const int bid = blockIdx.x, nb = gridDim.x;
    volatile LAS unsigned* bst = (volatile LAS unsigned*)(smem + SMEM_BYTES - 16);
    if (threadIdx.x == 0) { bst[0] = 0u; bst[1] = 0u; }
    __syncthreads();
    const XcdBarrier xb = xcd_barrier_post(p.bar, bst);

    ph_mod(p, bid, nb, smem);
    ph_wprep(p, bid, nb, smem);
    xcd_barrier(xb);
    ph_norm(p, bid, nb, smem);
    xcd_barrier(xb);
    ph_inproj(p, bid, nb, smem);
    xcd_barrier(xb);
    ph_mla_proj(p, bid, nb, smem);
    xcd_barrier(xb);
    ph_attn(p, bid, nb, smem);
    xcd_barrier(xb);
    ph_dn1(p, bid, nb, smem);
    xcd_barrier(xb);
    ph_dn2(p, bid, nb, smem);
    xcd_barrier(xb);
    ph_dn3(p, bid, nb, smem);
    ph_gates(p, bid, nb, smem);
    xcd_barrier(xb);
    ph_merge(p, bid, nb, smem);
    xcd_barrier(xb);
    ph_out(p, bid, nb, smem);
}

extern "C" void kernel_launch(void* const* d_in, const int* in_sizes, int n_in,
                              void* d_out, int out_size, void* d_ws, size_t ws_size,
                              hipStream_t stream) {
    static int grid_blocks = 0;
    if (!grid_blocks) {
        int dev = 0, cus = 0, per_cu = 0;
        (void)hipGetDevice(&dev);
        (void)hipDeviceGetAttribute(&cus, hipDeviceAttributeMultiprocessorCount, dev);
        (void)hipOccupancyMaxActiveBlocksPerMultiprocessor(&per_cu, fwd_megakernel, NTHR, 0);
        if (per_cu > 2) per_cu = 2;
        if (per_cu < 1) per_cu = 1;
        grid_blocks = cus * per_cu;
    }
    Params p{};
    const float** fp = (const float**)&p;
    for (int i = 0; i < 21; ++i) fp[i] = (const float*)d_in[i];
    p.out = (float*)d_out;
    char* ws = (char*)d_ws;
    char* ob = (char*)d_out;
    const size_t R_W = 0;
    const size_t R_H = 16777216;
    const size_t R_Z = R_H + 37748736;
    const size_t R_A = R_Z + 33554432;
    const size_t R_F = R_A + 84934656;
    {
        size_t o = R_W;
        p.Wt_a = (bf16_t*)(ws + o); o += 4718592;
        p.Wt_z = (bf16_t*)(ws + o); o += 2097152;
        p.Wt_g = (bf16_t*)(ws + o); o += 4194304;
        p.Wt_uq = (bf16_t*)(ws + o); o += 589824;
        p.Wt_ukv = (bf16_t*)(ws + o); o += 524288;
        p.Wt_mo = (bf16_t*)(ws + o); o += 1048576;
        p.Wt_do = (bf16_t*)(ws + o); o += 1048576;
        p.Wt_out = (bf16_t*)(ws + o); o += 2097152;
        p.mod = (float*)(ws + o); o += 110592;
        p.bar = (unsigned*)(ws + o); o += XCD_BAR_WORDS * 4;
        p.rope = (float*)(ws + o); o += 4096;
    }
    p.h = (bf16_t*)(ws + R_H);
    p.Pz = (bf16_t*)(ws + R_Z);
    p.Pa = (bf16_t*)(ws + R_A);
    p.qn = (bf16_t*)(ws + R_F);
    p.kvn = (bf16_t*)(ws + R_F + 12582912);
    p.Qb = (bf16_t*)(ws + R_F + 22020096);
    p.Kb = (bf16_t*)(ws + R_F + 47185920);
    p.Vt = (bf16_t*)(ws + R_F + 75497472);
    p.Qraw = (bf16_t*)(ob);
    p.KVraw = (bf16_t*)(ob + 25165824);
    p.o_mla = (bf16_t*)(ws + R_F);
    p.MH = (bf16_t*)(ws + R_F + 16777216);
    p.EF = (bf16_t*)(ob);
    p.ST = (bf16_t*)(ws + R_A);
    p.A_mla = (bf16_t*)(ws + R_A + 33554432);
    p.A_dn = (bf16_t*)(ws + R_A + 50331648);
    p.Pg = (bf16_t*)(ws + R_F + 16777216);
    p.Mb = (bf16_t*)(ws + R_H);
    (void)hipMemsetAsync(p.mod, 0, 110592 + XCD_BAR_WORDS * 4, stream);
    void* args[] = {&p};
    hipError_t err = hipLaunchCooperativeKernel((void*)fwd_megakernel, dim3(grid_blocks), dim3(NTHR), args, 0, stream);
    if (err != hipSuccess) fprintf(stderr, "cooperative launch failed: %s (grid %d)\n", hipGetErrorString(err), grid_blocks);
}
```

```cpp
#include <hip/hip_runtime.h>
#include <stdint.h>
#include <cstdio>

typedef uint16_t bf16_t;
#define LAS __attribute__((address_space(3)))

#define NB 8
#define SEQ 2048
#define CTXL 256
#define TPB 2304
#define NCTX 2048
#define NL 16384
#define NT 18432
#define DM 1024
#define IN_DIM 5312
#define PA_W 2304
#define PZ_W 1024
#define PG_W 2048
#define PA_CQ 0
#define PA_CKV 384
#define PA_KR 640
#define PA_DQ 672
#define PA_DK 1184
#define PA_DV 1696
#define PA_DB 2208
#define PA_DA 2224
#define EPSF 1e-6f
#define NTHR 256
#define SMEM_BYTES 77824

struct Params {
    const float *x, *c, *ctx, *c_ctx, *w_mod, *b_mod, *norm_w, *w_in, *q_norm_w, *w_uq, *kv_norm_w, *w_ukv, *qhn_w, *khn_w,
        *mla_w_o, *conv_w, *a_log, *dt_bias, *dn_norm_w, *dn_w_o, *w_out;
    float* out;
    bf16_t *h, *Pa, *Pz, *Pg, *Qb, *Vt, *Kb, *o_mla, *MH, *EF, *ST, *A_mla, *A_dn, *Mb;
    bf16_t *Wt_a, *Wt_z, *Wt_g, *Wt_uq, *Wt_ukv, *Wt_mo, *Wt_do, *Wt_out;
    float *mod, *rope;
    unsigned* bar;
};

typedef float f32x4 __attribute__((ext_vector_type(4)));
typedef unsigned u32x4 __attribute__((ext_vector_type(4)));
typedef __bf16 bf16v2_t __attribute__((ext_vector_type(2)));
typedef float f32x2 __attribute__((ext_vector_type(2)));
__device__ __forceinline__ uint32_t pack_bf2(float lo, float hi) {
    f32x2 v = {lo, hi};
    bf16v2_t b = __builtin_convertvector(v, bf16v2_t);
    return __builtin_bit_cast(uint32_t, b);
}
__device__ __forceinline__ void st_bf4(bf16_t* p, f32x4 v) {
    uint2 o; o.x = pack_bf2(v[0], v[1]); o.y = pack_bf2(v[2], v[3]);
    *(uint2*)p = o;
}
__device__ __forceinline__ float bf2f(bf16_t v) { return __uint_as_float(((uint32_t)v) << 16); }
__device__ __forceinline__ bf16_t f2bf(float f) {
    uint32_t u = __float_as_uint(f);
    u += 0x7fffu + ((u >> 16) & 1u);
    return (bf16_t)(u >> 16);
}
__device__ __forceinline__ float silu_f(float v) { return v * __builtin_amdgcn_rcpf(1.f + __expf(-v)); }
__device__ __forceinline__ float sigmoid_f(float v) { return __builtin_amdgcn_rcpf(1.f + __expf(-v)); }
template <int CTRL> __device__ __forceinline__ float dpp_mov(float v) {
    return __builtin_bit_cast(float, __builtin_amdgcn_update_dpp(0, __builtin_bit_cast(int, v), CTRL, 0xF, 0xF, true));
}
__device__ __forceinline__ float row16_sum(float v) {
    v += dpp_mov<0xB1>(v); v += dpp_mov<0x4E>(v); v += dpp_mov<0x141>(v); v += dpp_mov<0x140>(v); return v;
}
__device__ __forceinline__ float rdlane(float v, int l) { return __builtin_bit_cast(float, __builtin_amdgcn_readlane(__builtin_bit_cast(int, v), l)); }
__device__ __forceinline__ float wave_sum(float v) {
    v += dpp_mov<0xB1>(v);
    v += dpp_mov<0x4E>(v);
    v += dpp_mov<0x141>(v);
    v += dpp_mov<0x140>(v);
    return (rdlane(v, 0) + rdlane(v, 16)) + (rdlane(v, 32) + rdlane(v, 48));
}
__device__ __forceinline__ float xrow_sum(float v) { v += __shfl_xor(v, 16); v += __shfl_xor(v, 32); return v; }
__device__ __forceinline__ void ph_mod(const Params& p, int bid, int nb, char* smem) {
    float* sc = (float*)smem;
    for (int item = bid; item < 64; item += nb) {
        const int k0 = item * 16, tid = threadIdx.x;
        __syncthreads();
        if (tid < 144) {
            const int r = tid >> 4, kk = tid & 15;
            const float v = (r < 8) ? p.c[r * 1024 + k0 + kk] : p.c_ctx[k0 + kk];
            sc[tid] = silu_f(v);
        }
        __syncthreads();
#pragma unroll 1
        for (int half = 0; half < 2; ++half) {
            float acc[6][9];
#pragma unroll
            for (int q = 0; q < 6; ++q)
#pragma unroll
                for (int r = 0; r < 9; ++r) acc[q][r] = 0.f;
            const float* wp = p.w_mod + (size_t)k0 * 3072 + half * 1536 + tid;
#pragma unroll 4
            for (int kk = 0; kk < 16; ++kk) {
                float wv[6];
#pragma unroll
                for (int q = 0; q < 6; ++q) wv[q] = wp[(size_t)kk * 3072 + q * 256];
#pragma unroll
                for (int r = 0; r < 9; ++r) {
                    const float s = sc[r * 16 + kk];
#pragma unroll
                    for (int q = 0; q < 6; ++q) acc[q][r] += s * wv[q];
                }
            }
#pragma unroll
            for (int q = 0; q < 6; ++q) {
                const int j = half * 1536 + q * 256 + tid;
                const float bb = (item == 0) ? p.b_mod[j] : 0.f;
#pragma unroll
                for (int r = 0; r < 9; ++r) atomicAdd(p.mod + r * 3072 + j, acc[q][r] + bb);
            }
        }
    }
}

__device__ __forceinline__ void ph_norm(const Params& p, int bid, int nb, char* smem) {
    const int lane = threadIdx.x & 63, gw = bid * 4 + (threadIdx.x >> 6), nw = nb * 4;
    f32x4 v[4], vn[4];
    int r = gw;
    auto rowptr = [&](int rr) -> const float* { return (rr < NCTX) ? p.ctx + (size_t)rr * DM : p.x + (size_t)(rr - NCTX) * DM; };
    if (r < NT) {
        const float* src = rowptr(r);
#pragma unroll
        for (int i = 0; i < 4; ++i) v[i] = *(const f32x4*)(src + i * 256 + lane * 4);
    }
    for (; r < NT; r += nw) {
        const int rn = r + nw;
        if (rn < NT) {
            const float* src = rowptr(rn);
#pragma unroll
            for (int i = 0; i < 4; ++i) vn[i] = *(const f32x4*)(src + i * 256 + lane * 4);
        }
        float ss = 0.f;
#pragma unroll
        for (int i = 0; i < 4; ++i) ss += v[i][0] * v[i][0] + v[i][1] * v[i][1] + v[i][2] * v[i][2] + v[i][3] * v[i][3];
        ss = wave_sum(ss);
        const float rstd = rsqrtf(ss * (1.f / 1024.f) + EPSF);
        const int mrow = (r < NCTX) ? 8 : (r - NCTX) / SEQ;
        const float* shift = p.mod + mrow * 3072;
        const float* scale = shift + 1024;
#pragma unroll
        for (int i = 0; i < 4; ++i) {
            const int k = i * 256 + lane * 4;
            const f32x4 nwv = *(const f32x4*)(p.norm_w + k), sc = *(const f32x4*)(scale + k), sh = *(const f32x4*)(shift + k);
            f32x4 y;
#pragma unroll
            for (int e2 = 0; e2 < 4; ++e2) y[e2] = v[i][e2] * rstd * nwv[e2] * (1.f + sc[e2]) + sh[e2];
            st_bf4(p.h + (size_t)r * DM + k, y);
        }
#pragma unroll
        for (int i = 0; i < 4; ++i) v[i] = vn[i];
    }
}


__device__ __forceinline__ void wprep_unit(const float* __restrict__ W, int ldw, int K, int n0, int k0, int srcbase, bf16_t* __restrict__ dst, float* tile,
                                           const float* __restrict__ kscale) {
    const int tid = threadIdx.x;
    {
        const int n4 = (tid & 7) * 4, kk = tid >> 3;
        float4 v[4];
#pragma unroll
        for (int q = 0; q < 4; ++q) {
            const int k = kk + 32 * q;
            v[q] = make_float4(0.f, 0.f, 0.f, 0.f);
            if (srcbase >= 0) v[q] = *(const float4*)(W + (size_t)(k0 + k) * ldw + srcbase + n4);
        }
#pragma unroll
        for (int q = 0; q < 4; ++q) {
            const int k = kk + 32 * q;
            if (kscale) { const float s = kscale[k0 + k]; v[q].x *= s; v[q].y *= s; v[q].z *= s; v[q].w *= s; }
            float* t = tile + k * 33 + n4;
            t[0] = v[q].x; t[1] = v[q].y; t[2] = v[q].z; t[3] = v[q].w;
        }
    }
    __syncthreads();
    {
        const int n = tid >> 3;
#pragma unroll
        for (int q = 0; q < 2; ++q) {
            const int kc = (tid & 7) + 8 * q;
            const float* t = tile + (kc * 8) * 33 + n;
            uint4 o;
            o.x = pack_bf2(t[0 * 33], t[1 * 33]); o.y = pack_bf2(t[2 * 33], t[3 * 33]);
            o.z = pack_bf2(t[4 * 33], t[5 * 33]); o.w = pack_bf2(t[6 * 33], t[7 * 33]);
            *(uint4*)(dst + (size_t)(n0 + n) * K + k0 + kc * 8) = o;
        }
    }
    __syncthreads();
}

__device__ __forceinline__ void ph_wprep(const Params& p, int bid, int nb, char* smem) {
    float* tile = (float*)smem;
    const int U0 = 72 * 8, U1 = 32 * 8, U2 = 64 * 8, U3 = 24 * 3, U4 = 32 * 2, U5 = 32 * 4, U6 = 32 * 4, U7 = 32 * 8;
    const int UT = U0 + U1 + U2 + U3 + U4 + U5 + U6 + U7;
    for (int u = bid; u < UT; u += nb) {
        int v = u;
        const float* W; int ldw, K; bf16_t* dst; int job;
        if (v < U0) { job = 0; W = p.w_in; ldw = IN_DIM; K = 1024; dst = p.Wt_a; }
        else if ((v -= U0) < U1) { job = 1; W = p.w_in; ldw = IN_DIM; K = 1024; dst = p.Wt_z; }
        else if ((v -= U1) < U2) { job = 2; W = p.w_in; ldw = IN_DIM; K = 1024; dst = p.Wt_g; }
        else if ((v -= U2) < U3) { job = 3; W = p.w_uq; ldw = 768; K = 384; dst = p.Wt_uq; }
        else if ((v -= U3) < U4) { job = 4; W = p.w_ukv; ldw = 1024; K = 256; dst = p.Wt_ukv; }
        else if ((v -= U4) < U5) { job = 5; W = p.mla_w_o; ldw = 1024; K = 512; dst = p.Wt_mo; }
        else if ((v -= U5) < U6) { job = 6; W = p.dn_w_o; ldw = 1024; K = 512; dst = p.Wt_do; }
        else { v -= U6; job = 7; W = p.w_out; ldw = 1024; K = 1024; dst = p.Wt_out; }
        const int nkt = K / 128;
        const int n0 = (v / nkt) * 32, k0 = (v % nkt) * 128;
        int srcbase = n0;
        if (job == 0) {
            if (n0 < 672) srcbase = n0;
            else if (n0 < 2208) { const int r = n0 - 672, hh = r / 192, g = (r % 192) >> 6, i0 = r & 63; srcbase = 1184 + g * 512 + hh * 64 + i0; }
            else srcbase = (n0 < 2240) ? n0 + 1024 : -1;
        }
        else if (job == 1) srcbase = (n0 < 512) ? 672 + n0 : 2208 + n0;
        else if (job == 2) srcbase = 3264 + n0;
        const float* ksc = (job == 3) ? p.q_norm_w : (job == 4) ? p.kv_norm_w : nullptr;
        wprep_unit(W, ldw, K, n0, k0, srcbase, dst, tile, ksc);
    }
    if (bid == nb - 1) {
        for (int i = threadIdx.x; i < 512; i += NTHR) {
            const int pos = i >> 3, f = i & 7;
            const float ang = (float)pos * powf(10000.f, -(float)f / 8.f);
            p.rope[2 * i] = cosf(ang); p.rope[2 * i + 1] = sinf(ang);
        }
    }
}

typedef short bf16x8 __attribute__((ext_vector_type(8)));


__device__ __forceinline__ int lds_off(int row, int chunk) { return row * 128 + (((chunk ^ (row >> 1)) & 7) << 4); }

__device__ __forceinline__ int epi_perm(int rho) { return 8 * ((rho >> 2) & 3) + 4 * (rho >> 4) + (rho & 3); }

template <int NTN>
__device__ __forceinline__ void gemm_compute_stage(f32x4 (&acc)[NTN][4], const char* sa, int wm, int wn, int l15, int lq) {
    const char* sb = sa + 16384;
#pragma unroll
    for (int ks = 0; ks < 2; ++ks) {
        bf16x8 af[4], bfr[NTN];
#pragma unroll
        for (int mt = 0; mt < 4; ++mt) af[mt] = *(const bf16x8*)(sa + lds_off(wm * 64 + mt * 16 + l15, ks * 4 + lq));
#pragma unroll
        for (int nt = 0; nt < NTN; ++nt) bfr[nt] = *(const bf16x8*)(sb + lds_off(wn * (16 * NTN) + nt * 16 + l15, ks * 4 + lq));
#pragma unroll
        for (int nt = 0; nt < NTN; ++nt)
#pragma unroll
            for (int mt = 0; mt < 4; ++mt)
                acc[nt][mt] = __builtin_amdgcn_mfma_f32_16x16x32_bf16(bfr[nt], af[mt], acc[nt][mt], 0, 0, 0);
    }
}
template <int NTN>
__device__ __forceinline__ void gemm_tile_acc(f32x4 (&acc)[NTN][4], const bf16_t* __restrict__ A, int lda, const bf16_t* __restrict__ Bt, int ldb,
                                              int K, int m0, int n0, char* smem) {
    int tid = threadIdx.x;
    asm volatile("" : "+v"(tid));
    const int lane = tid & 63, w = tid >> 6, wm = w >> 1, wn = w & 1;
    const int l15 = lane & 15, lq = lane >> 4;
    const int srow = tid >> 3, sch = (tid & 7) ^ ((srow >> 1) & 7);
    const bf16_t* ap = A + (size_t)(m0 + srow) * lda + sch * 8;
    const int prow = epi_perm(srow & 31);
    const bf16_t* bp = Bt + (size_t)(n0 + prow) * ldb + sch * 8;
    int KT = K >> 6;
    asm volatile("" : "+s"(KT));
    LAS char* lbase = (LAS char*)smem + w * 1024;
#define GT_STAGE(ST_, KT_) do { \
        _Pragma("unroll") for (int i = 0; i < 4; ++i) \
            __builtin_amdgcn_global_load_lds((const void*)(ap + (size_t)(32 * i) * lda + (KT_) * 64), (LAS void*)(lbase + (ST_) * 32768 + i * 4096), 16, 0, 0); \
        _Pragma("unroll") for (int i = 0; i < NTN; ++i) \
            __builtin_amdgcn_global_load_lds((const void*)(bp + (size_t)(32 * i) * ldb + (KT_) * 64), (LAS void*)(lbase + (ST_) * 32768 + 16384 + i * 4096), 16, 0, 0); } while (0)
    GT_STAGE(0, 0);
    __syncthreads();
    for (int kt = 0; kt < KT; ++kt) {
        if (kt + 1 < KT) GT_STAGE((kt + 1) & 1, kt + 1);
        gemm_compute_stage<NTN>(acc, smem + (kt & 1) * 32768, wm, wn, l15, lq);
        __syncthreads();
    }
#undef GT_STAGE
}

template <int NTN>
__device__ __forceinline__ void acc_zero(f32x4 (&acc)[NTN][4]) {
#pragma unroll
    for (int i = 0; i < NTN; ++i)
#pragma unroll
        for (int j = 0; j < 4; ++j) acc[i][j] = (f32x4){0.f, 0.f, 0.f, 0.f};
}

__device__ __forceinline__ bool next_unit(int it, int U, int bid, int nb, int& u) {
    const int x = bid & 7, li = bid >> 3, per = nb >> 3;
    const int lo = (int)(((long)U * x) >> 3), hi = (int)(((long)U * (x + 1)) >> 3);
    u = lo + li + it * per;
    return u < hi;
}
__device__ __forceinline__ void unit_mn(int u, int ntn, int& tm, int& tn) {
    const int g = u / (8 * ntn), r = u % (8 * ntn);
    tm = g * 8 + (r & 7); tn = r >> 3;
}


__device__ __forceinline__ f32x4 ld_bf4(const bf16_t* p) {
    const uint2 r = *(const uint2*)p;
    return (f32x4){__uint_as_float(r.x << 16), __uint_as_float(r.x & 0xffff0000u), __uint_as_float(r.y << 16), __uint_as_float(r.y & 0xffff0000u)};
}
#define EPI_COORDS_OPAQUE(SFX) int tid##SFX = threadIdx.x; asm volatile("" : "+v"(tid##SFX)); \
    const int lane_ = tid##SFX & 63, w_ = tid##SFX >> 6, wm_ = w_ >> 1, wn_ = w_ & 1, l15_ = lane_ & 15, lq_ = lane_ >> 4;
#define EPI_COORDS const int lane_ = threadIdx.x & 63, w_ = threadIdx.x >> 6, wm_ = w_ >> 1, wn_ = w_ & 1, l15_ = lane_ & 15, lq_ = lane_ >> 4;
#define EPI_ROW(mt) (m0 + wm_ * 64 + (mt) * 16 + l15_)
#define EPI_COL(nt) (n0 + wn_ * 64 + 32 * ((nt) >> 1) + 8 * lq_ + 4 * ((nt) & 1))

__device__ __forceinline__ void gemm_store_bf16(const bf16_t* A, int lda, const bf16_t* Bt, int K, int tm, int tn, bf16_t* C, int ldc, char* smem) {
    f32x4 acc[4][4];
    acc_zero<4>(acc);
    const int m0 = tm * 128, n0 = tn * 128;
    gemm_tile_acc<4>(acc, A, lda, Bt, K, K, m0, n0, smem);
    EPI_COORDS
#pragma unroll
    for (int j = 0; j < 2; ++j)
#pragma unroll
        for (int mt = 0; mt < 4; ++mt) {
            u32x4 o;
            o[0] = pack_bf2(acc[2 * j][mt][0], acc[2 * j][mt][1]); o[1] = pack_bf2(acc[2 * j][mt][2], acc[2 * j][mt][3]);
            o[2] = pack_bf2(acc[2 * j + 1][mt][0], acc[2 * j + 1][mt][1]); o[3] = pack_bf2(acc[2 * j + 1][mt][2], acc[2 * j + 1][mt][3]);
            *(u32x4*)(C + (size_t)EPI_ROW(mt) * ldc + EPI_COL(2 * j)) = o;
        }
}

template <int NTN>
__device__ __forceinline__ void gemm_rows_acc(f32x4 (&acc)[NTN][2], float (&ssq)[2], const bf16_t* __restrict__ A, int lda,
                                              const bf16_t* __restrict__ Bt, int ldb, int K, int m0, int n0, char* smem) {
    constexpr int NB_ = NTN / 2;
    int tid = threadIdx.x;
    asm volatile("" : "+v"(tid));
    const int lane = tid & 63, w = tid >> 6;
    const int l15 = lane & 15, lq = lane >> 4;
    const int srow = tid >> 3, sch = (tid & 7) ^ ((srow >> 1) & 7);
    const bf16_t* ap = A + (size_t)(m0 + srow) * lda + sch * 8;
    const bf16_t* bp = Bt + (size_t)(n0 + srow) * ldb + sch * 8;
    int KT = K >> 6;
    asm volatile("" : "+s"(KT));
    LAS char* lbase = (LAS char*)smem + w * 1024;
#define GR_STAGE(ST_, KT_) do { \
        _Pragma("unroll") for (int i = 0; i < 4; ++i) \
            __builtin_amdgcn_global_load_lds((const void*)(ap + (size_t)(32 * i) * lda + (KT_) * 64), (LAS void*)(lbase + (ST_) * 32768 + i * 4096), 16, 0, 0); \
        _Pragma("unroll") for (int i = 0; i < NB_; ++i) \
            __builtin_amdgcn_global_load_lds((const void*)(bp + (size_t)(32 * i) * ldb + (KT_) * 64), (LAS void*)(lbase + (ST_) * 32768 + 16384 + i * 4096), 16, 0, 0); } while (0)
    GR_STAGE(0, 0);
    __syncthreads();
    for (int kt = 0; kt < KT; ++kt) {
        if (kt + 1 < KT) GR_STAGE((kt + 1) & 1, kt + 1);
        const char* sa = smem + (kt & 1) * 32768;
        const char* sb = sa + 16384;
#pragma unroll
        for (int ks = 0; ks < 2; ++ks) {
            bf16x8 af[2], bfr[NTN];
#pragma unroll
            for (int mt = 0; mt < 2; ++mt) af[mt] = *(const bf16x8*)(sa + lds_off(w * 32 + mt * 16 + l15, ks * 4 + lq));
#pragma unroll
            for (int nt = 0; nt < NTN; ++nt) bfr[nt] = *(const bf16x8*)(sb + lds_off(nt * 16 + l15, ks * 4 + lq));
#pragma unroll
            for (int mt = 0; mt < 2; ++mt) {
                const u32x4 aw = __builtin_bit_cast(u32x4, af[mt]);
#pragma unroll
                for (int e2 = 0; e2 < 4; ++e2) {
                    const float lo = __uint_as_float(aw[e2] << 16), hi = __uint_as_float(aw[e2] & 0xffff0000u);
                    ssq[mt] += lo * lo + hi * hi;
                }
            }
#pragma unroll
            for (int nt = 0; nt < NTN; ++nt)
#pragma unroll
                for (int mt = 0; mt < 2; ++mt)
                    acc[nt][mt] = __builtin_amdgcn_mfma_f32_16x16x32_bf16(bfr[nt], af[mt], acc[nt][mt], 0, 0, 0);
        }
        __syncthreads();
    }
#undef GR_STAGE
    ssq[0] = xrow_sum(ssq[0]);
    ssq[1] = xrow_sum(ssq[1]);
}

__device__ __forceinline__ void ph_mla_proj(const Params& p, int bid, int nb, char* smem) {
    const int tid = threadIdx.x, lane = tid & 63, w = tid >> 6, l15 = lane & 15, lq = lane >> 4;
    float* s_rope = (float*)(smem + 65536);
    float* s_qhn = s_rope + 1024;
    float* s_khn = s_qhn + 96;
    for (int i = tid; i < 1024; i += NTHR) s_rope[i] = p.rope[i];
    if (tid < 96) { s_qhn[tid] = p.qhn_w[tid]; s_khn[tid] = p.khn_w[tid]; }
    __syncthreads();
    const int UQ = 128 * 8, UK = 144 * 8;
    int u;
    for (int it = 0; next_unit(it, UQ + UK, bid, nb, u); ++it) {
        if (u < UQ) {
            const int tm = u >> 3, hh = u & 7;
            const int m0 = NCTX + tm * 128;
            f32x4 acc[6][2];
            float ssq[2] = {0.f, 0.f};
#pragma unroll
            for (int i = 0; i < 6; ++i) { acc[i][0] = (f32x4){0.f, 0.f, 0.f, 0.f}; acc[i][1] = (f32x4){0.f, 0.f, 0.f, 0.f}; }
            gemm_rows_acc<6>(acc, ssq, p.Pa + PA_CQ, PA_W, p.Wt_uq, 384, 384, m0, hh * 96, smem);
#pragma unroll
            for (int mt = 0; mt < 2; ++mt) {
                const int ml = 32 * w + 16 * mt + l15;
                const int rl = tm * 128 + ml;
                const int b = rl >> 11, t = rl & 2047;
                const float rs = rsqrtf(ssq[mt] * (1.f / 384.f) + EPSF);
                float hs = 0.f;
#pragma unroll
                for (int nt = 0; nt < 6; ++nt)
#pragma unroll
                    for (int e = 0; e < 4; ++e) { const float v = acc[nt][mt][e] * rs; acc[nt][mt][e] = v; hs += v * v; }
                hs = xrow_sum(hs);
                const float hr = rsqrtf(hs * (1.f / 96.f) + EPSF) * (0.10206207261596575f * 1.4426950408889634f);
                bf16_t* qd = p.Qb + ((size_t)((b * 8 + hh) * SEQ + t)) * 96 + 4 * lq;
#pragma unroll
                for (int nt = 0; nt < 6; ++nt) {
                    const f32x4 wv = *(const f32x4*)(s_qhn + 16 * nt + 4 * lq);
                    f32x4 v;
#pragma unroll
                    for (int e = 0; e < 4; ++e) v[e] = acc[nt][mt][e] * hr * wv[e];
                    if (nt >= 4) {
                        const int pos = (nt == 4) ? (t >> 6) : (t & 63);
                        const int ph = lq >> 1;
#pragma unroll
                        for (int e = 0; e < 4; ++e) {
                            const float2 cs = *(const float2*)(s_rope + 2 * (pos * 8 + (lq & 1) * 4 + e));
                            const float partner = __shfl_xor(v[e], 32);
                            const float t1 = ph ? partner : v[e], t2 = ph ? v[e] : partner;
                            v[e] = ph ? (t1 * cs.y + t2 * cs.x) : (t1 * cs.x - t2 * cs.y);
                        }
                    }
                    st_bf4(qd + 16 * nt, v);
                }
            }
        } else {
            const int uu = u - UQ;
            const int tm = uu >> 3, hh = uu & 7;
            const int m0 = tm * 128;
            f32x4 acc[8][2];
            float ssq[2] = {0.f, 0.f};
#pragma unroll
            for (int i = 0; i < 8; ++i) { acc[i][0] = (f32x4){0.f, 0.f, 0.f, 0.f}; acc[i][1] = (f32x4){0.f, 0.f, 0.f, 0.f}; }
            gemm_rows_acc<8>(acc, ssq, p.Pa + PA_CKV, PA_W, p.Wt_ukv, 256, 256, m0, hh * 128, smem);
#pragma unroll
            for (int mt = 0; mt < 2; ++mt) {
                const int ml = 32 * w + 16 * mt + l15;
                const int r = m0 + ml;
                int b, pos, t = 0; const bool lat = (r >= NCTX);
                if (!lat) { b = r >> 8; pos = r & 255; }
                else { const int rl = r - NCTX; b = rl >> 11; t = rl & 2047; pos = CTXL + t; }
                const float rs = rsqrtf(ssq[mt] * (1.f / 256.f) + EPSF);
                const u32x4 krw = *(const u32x4*)(p.Pa + (size_t)r * PA_W + PA_KR + 8 * lq);
                float kr[8];
#pragma unroll
                for (int e = 0; e < 4; ++e) { kr[2 * e] = __uint_as_float(krw[e] << 16); kr[2 * e + 1] = __uint_as_float(krw[e] & 0xffff0000u); }
                float hs = 0.f;
#pragma unroll
                for (int e = 0; e < 8; ++e) hs += kr[e] * kr[e];
#pragma unroll
                for (int nt = 0; nt < 4; ++nt)
#pragma unroll
                    for (int e = 0; e < 4; ++e) { const float v = acc[nt][mt][e] * rs; acc[nt][mt][e] = v; hs += v * v; }
                hs = xrow_sum(hs);
                const float hr = rsqrtf(hs * (1.f / 96.f) + EPSF);
                bf16_t* kd = p.Kb + ((size_t)((b * 8 + hh) * TPB + pos)) * 96;
#pragma unroll
                for (int nt = 0; nt < 4; ++nt) {
                    const f32x4 wv = *(const f32x4*)(s_khn + 16 * nt + 4 * lq);
                    f32x4 v;
#pragma unroll
                    for (int e = 0; e < 4; ++e) v[e] = acc[nt][mt][e] * hr * wv[e];
                    st_bf4(kd + 16 * nt + 4 * lq, v);
                }
                {
                    const int ph = lq & 1;
                    const int rp = (lq >> 1) ? (t & 63) : (t >> 6);
                    float o[8];
#pragma unroll
                    for (int e = 0; e < 8; ++e) {
                        const float v = kr[e] * hr * s_khn[64 + 8 * lq + e];
                        const float partner = __shfl_xor(v, 16);
                        float2 cs = make_float2(1.f, 0.f);
                        if (lat) cs = *(const float2*)(s_rope + 2 * (rp * 8 + e));
                        const float t1 = ph ? partner : v, t2 = ph ? v : partner;
                        o[e] = ph ? (t1 * cs.y + t2 * cs.x) : (t1 * cs.x - t2 * cs.y);
                    }
                    u32x4 ov;
                    ov[0] = pack_bf2(o[0], o[1]); ov[1] = pack_bf2(o[2], o[3]); ov[2] = pack_bf2(o[4], o[5]); ov[3] = pack_bf2(o[6], o[7]);
                    *(u32x4*)(kd + 64 + 8 * lq) = ov;
                }
                {
                    const int kpos = (pos & ~12) | ((pos & 4) << 1) | ((pos & 8) >> 1);
                    bf16_t* vd = p.Vt + (size_t)((b * 8 + hh) * 64) * TPB + kpos;
#pragma unroll
                    for (int nt = 4; nt < 8; ++nt)
#pragma unroll
                        for (int e = 0; e < 4; ++e) vd[(size_t)(16 * (nt - 4) + 4 * lq + e) * TPB] = f2bf(acc[nt][mt][e] * rs);
                }
            }
        }
    }
}

typedef float f32x16 __attribute__((ext_vector_type(16)));
#define ATT_THR 6.0f
#define ATT_KROW 208
#define ATT_VROW 144
#define ATT_KBYTES (64 * ATT_KROW)
#define ATT_STAGE (ATT_KBYTES + 64 * ATT_VROW)
__device__ __forceinline__ void ph_attn(const Params& p, int bid, int nb, char* smem) {
    const int tid = threadIdx.x, lane = tid & 63, w = tid >> 6, r = lane & 31, h = lane >> 5;
    int u;
    for (int it = 0; next_unit(it, 1024, bid, nb, u); ++it) {
        const int bh = u >> 4, qb = u & 15;
        bf16x8 qf[6];
        {
            const bf16_t* Qp = p.Qb + ((size_t)bh * SEQ + qb * 128 + w * 32 + r) * 96 + h * 8;
#pragma unroll
            for (int s = 0; s < 6; ++s) qf[s] = *(const bf16x8*)(Qp + s * 16);
        }
        const bf16_t* Kg = p.Kb + (size_t)bh * TPB * 96 + tid * 8;
        const bf16_t* Vg = p.Vt + (size_t)bh * 64 * TPB + (size_t)(tid >> 3) * TPB + (tid & 7) * 8;
        int koff[3], voff[2];
#pragma unroll
        for (int i = 0; i < 3; ++i) { const int c = tid + 256 * i; koff[i] = (c / 12) * ATT_KROW + (c % 12) * 16; }
#pragma unroll
        for (int i = 0; i < 2; ++i) { const int c = tid + 256 * i; voff[i] = ATT_KBYTES + (c >> 3) * ATT_VROW + (c & 7) * 16; }
        u32x4 rk[3], rv[2];
#pragma unroll
        for (int i = 0; i < 3; ++i) rk[i] = *(const u32x4*)(Kg + i * 2048);
#pragma unroll
        for (int i = 0; i < 2; ++i) rv[i] = *(const u32x4*)(Vg + (size_t)(32 * i) * TPB);
#pragma unroll
        for (int i = 0; i < 3; ++i) *(u32x4*)(smem + koff[i]) = rk[i];
#pragma unroll
        for (int i = 0; i < 2; ++i) *(u32x4*)(smem + voff[i]) = rv[i];
        __syncthreads();
        f32x16 o0, o1;
#pragma unroll
        for (int i = 0; i < 16; ++i) { o0[i] = 0.f; o1[i] = 0.f; }
        float m = 0.f, l = 0.f;
        int NKT = TPB / 64;
        asm volatile("" : "+s"(NKT));
        for (int kt = 0; kt < NKT; ++kt) {
            if (kt + 1 < NKT) {
#pragma unroll
                for (int i = 0; i < 3; ++i) rk[i] = *(const u32x4*)(Kg + (size_t)(kt + 1) * 6144 + i * 2048);
#pragma unroll
                for (int i = 0; i < 2; ++i) rv[i] = *(const u32x4*)(Vg + (size_t)(32 * i) * TPB + (kt + 1) * 64);
            }
            const char* sk = smem + (kt & 1) * ATT_STAGE;
            const char* sv = sk + ATT_KBYTES;
            f32x16 s0, s1;
            {
                const float c0 = -m;
#pragma unroll
                for (int i = 0; i < 16; ++i) { s0[i] = c0; s1[i] = c0; }
            }
#pragma unroll
            for (int s = 0; s < 6; ++s) {
                const bf16x8 k0 = *(const bf16x8*)(sk + r * ATT_KROW + (2 * s + h) * 16);
                const bf16x8 k1 = *(const bf16x8*)(sk + (32 + r) * ATT_KROW + (2 * s + h) * 16);
                s0 = __builtin_amdgcn_mfma_f32_32x32x16_bf16(k0, qf[s], s0, 0, 0, 0);
                s1 = __builtin_amdgcn_mfma_f32_32x32x16_bf16(k1, qf[s], s1, 0, 0, 0);
            }
            float mx = fmaxf(s0[0], s1[0]);
#pragma unroll
            for (int i = 1; i < 16; ++i) mx = fmaxf(mx, fmaxf(s0[i], s1[i]));
            mx = fmaxf(mx, __shfl_xor(mx, 32));
            if (kt == 0 || __any(mx > ATT_THR)) {
                const float delta = (kt == 0) ? mx : fmaxf(mx, 0.f);
                const float alpha = (kt == 0) ? 1.f : __builtin_amdgcn_exp2f(-delta);
                m += delta;
                l *= alpha;
#pragma unroll
                for (int i = 0; i < 16; ++i) { o0[i] *= alpha; o1[i] *= alpha; s0[i] -= delta; s1[i] -= delta; }
            }
            float ls = 0.f;
#pragma unroll
            for (int i = 0; i < 16; ++i) {
                s0[i] = __builtin_amdgcn_exp2f(s0[i]);
                s1[i] = __builtin_amdgcn_exp2f(s1[i]);
                ls += s0[i] + s1[i];
            }
            l += ls;
#pragma unroll
            for (int ks = 0; ks < 4; ++ks) {
                u32x4 pw;
                if (ks < 2) {
                    pw[0] = pack_bf2(s0[8 * (ks & 1) + 0], s0[8 * (ks & 1) + 1]); pw[1] = pack_bf2(s0[8 * (ks & 1) + 2], s0[8 * (ks & 1) + 3]);
                    pw[2] = pack_bf2(s0[8 * (ks & 1) + 4], s0[8 * (ks & 1) + 5]); pw[3] = pack_bf2(s0[8 * (ks & 1) + 6], s0[8 * (ks & 1) + 7]);
                } else {
                    pw[0] = pack_bf2(s1[8 * (ks & 1) + 0], s1[8 * (ks & 1) + 1]); pw[1] = pack_bf2(s1[8 * (ks & 1) + 2], s1[8 * (ks & 1) + 3]);
                    pw[2] = pack_bf2(s1[8 * (ks & 1) + 4], s1[8 * (ks & 1) + 5]); pw[3] = pack_bf2(s1[8 * (ks & 1) + 6], s1[8 * (ks & 1) + 7]);
                }
                const bf16x8 pf = __builtin_bit_cast(bf16x8, pw);
                const bf16x8 v0 = *(const bf16x8*)(sv + r * ATT_VROW + (2 * ks + h) * 16);
                const bf16x8 v1 = *(const bf16x8*)(sv + (32 + r) * ATT_VROW + (2 * ks + h) * 16);
                o0 = __builtin_amdgcn_mfma_f32_32x32x16_bf16(v0, pf, o0, 0, 0, 0);
                o1 = __builtin_amdgcn_mfma_f32_32x32x16_bf16(v1, pf, o1, 0, 0, 0);
            }
            if (kt + 1 < NKT) {
                char* ds = smem + ((kt + 1) & 1) * ATT_STAGE;
#pragma unroll
                for (int i = 0; i < 3; ++i) *(u32x4*)(ds + koff[i]) = rk[i];
#pragma unroll
                for (int i = 0; i < 2; ++i) *(u32x4*)(ds + voff[i]) = rv[i];
            }
            __syncthreads();
        }
        l += __shfl_xor(l, 32);
        const float inv = 1.f / l;
        const int b = bh >> 3, hh = bh & 7;
        bf16_t* op = p.o_mla + ((size_t)(b * SEQ + qb * 128 + w * 32 + r)) * 512 + hh * 64 + 4 * h;
#pragma unroll
        for (int g = 0; g < 4; ++g) {
            uint2 a, c;
            a.x = pack_bf2(o0[4 * g + 0] * inv, o0[4 * g + 1] * inv); a.y = pack_bf2(o0[4 * g + 2] * inv, o0[4 * g + 3] * inv);
            c.x = pack_bf2(o1[4 * g + 0] * inv, o1[4 * g + 1] * inv); c.y = pack_bf2(o1[4 * g + 2] * inv, o1[4 * g + 3] * inv);
            *(uint2*)(op + 8 * g) = a;
            *(uint2*)(op + 32 + 8 * g) = c;
        }
    }
}

__device__ __forceinline__ int el_off(int row, int col) { return lds_off(row, col >> 3) + (col & 7) * 2; }

__device__ __forceinline__ void mm64(f32x4 (&acc)[4], const char* A, int arow0, const char* B, int l15, int lq) {
#pragma unroll
    for (int ks = 0; ks < 2; ++ks) {
        const bf16x8 a = *(const bf16x8*)(A + lds_off(arow0 + l15, ks * 4 + lq));
#pragma unroll
        for (int nt = 0; nt < 4; ++nt) {
            const bf16x8 b = *(const bf16x8*)(B + lds_off(nt * 16 + l15, ks * 4 + lq));
            acc[nt] = __builtin_amdgcn_mfma_f32_16x16x32_bf16(a, b, acc[nt], 0, 0, 0);
        }
    }
}
__device__ __forceinline__ void acc4_zero(f32x4 (&a)[4]) {
#pragma unroll
    for (int i = 0; i < 4; ++i) a[i] = (f32x4){0.f, 0.f, 0.f, 0.f};
}

#define DN_SQ 0
#define DN_SK 8192
#define DN_SV 16384
#define DN_LSTR 65
#define DN_LBYTES (64 * DN_LSTR * 4)
#define DN_SL 24576
#define DN_SA 57856
#define DN_SKD 66048
#define DN_SS 74240

typedef short s16x4 __attribute__((ext_vector_type(4)));
__device__ __forceinline__ s16x4 ds_tr(const char* p) { return __builtin_amdgcn_ds_read_tr16_b64_v4i16((LAS s16x4*)p); }

struct Dn1In { u32x4 rp[7]; float db, da, dtb, alog; float cw[4]; };
__device__ __forceinline__ void dn1_fetch(Dn1In& in, const Params& p, int u, int tid) {
    const int bh = u / 36, pb = u % 36, b = bh >> 3, h = bh & 7;
    int rowbase, seglen, lb;
    if (pb < 4) { rowbase = b * CTXL; seglen = CTXL; lb = pb; }
    else { rowbase = NCTX + b * SEQ; seglen = SEQ; lb = pb - 4; }
#pragma unroll
    for (int i = 0; i < 7; ++i) {
        const int c = tid + NTHR * i;
        const int g = c / 544, rem = c % 544, rr = rem >> 3, ch = rem & 7;
        const int lp = lb * 64 - 2 + rr;
        u32x4 val = (u32x4){0u, 0u, 0u, 0u};
        if (c < 3 * 68 * 8 && lp >= 0 && lp < seglen) val = *(const u32x4*)(p.Pa + (size_t)(rowbase + lp) * PA_W + PA_DQ + h * 192 + g * 64 + ch * 8);
        in.rp[i] = val;
    }
#pragma unroll
    for (int i = 0; i < 4; ++i) {
        const int idx = tid + NTHR * i, g = idx / 320, j = (idx % 320) >> 6, c = idx & 63;
        in.cw[i] = (idx < 960) ? p.conv_w[j * 1536 + g * 512 + h * 64 + c] : 0.f;
    }
    in.db = 0.f; in.da = 0.f; in.dtb = 0.f; in.alog = 0.f;
    if (tid < 128) {
        in.dtb = p.dt_bias[(tid >> 6) * 8 + h]; in.alog = p.a_log[(tid >> 6) * 8 + h];
        const int d = tid >> 6, tp = tid & 63;
        const int pos = d ? 63 - tp : tp;
        const bf16_t* row = p.Pa + (size_t)(rowbase + lb * 64 + pos) * PA_W;
        in.db = bf2f(row[PA_DB + d * 8 + h]);
        in.da = bf2f(row[PA_DA + d * 8 + h]);
    }
}

__device__ __forceinline__ void ph_dn1(const Params& p, int bid, int nb, char* smem) {
    char* sQ = smem + DN_SQ; char* sK = smem + DN_SK; char* sV = smem + DN_SV;
    char* sL = smem + DN_SL; char* sA = smem + DN_SA; char* sKd = smem + DN_SKD;
    float* sS = (float*)(smem + DN_SS);
    const int x_ = bid & 7, li_ = bid >> 3, per_ = nb >> 3;
#define DN1_UNIT(IT, U, VALID) do { const int q_ = li_ + (IT) * per_; const int grp_ = x_ + 8 * (q_ >> 3); VALID = (grp_ < 8 * 36); \
        const int b_ = grp_ / 36, pb_ = grp_ % 36; U = (b_ * 8 + (q_ & 7)) * 36 + pb_; } while (0)
    Dn1In in;
    int u, un; bool valid, validn;
    DN1_UNIT(0, u, valid);
    if (valid) dn1_fetch(in, p, u, threadIdx.x);
    for (int it = 0; valid; ++it, u = un, valid = validn) {
        DN1_UNIT(it + 1, un, validn);
        int tid = threadIdx.x;
        asm volatile("" : "+v"(tid));
        const int lane = tid & 63, w = tid >> 6, l15 = lane & 15, lq = lane >> 4;
        const int bh = u / 36, pb = u % 36, h = bh & 7;
        const bool lat = (pb >= 4);
        if (tid < 128) {
            const int d = tid >> 6, tp = lane;
            const float xx = in.da + in.dtb;
            const float sp = (xx > 20.f) ? xx : log1pf(__expf(xx));
            const float g = -__expf(in.alog) * sp;
            float gc = g;
#pragma unroll
            for (int o = 1; o < 64; o <<= 1) { const float t = __shfl_up(gc, o); if (lane >= o) gc += t; }
            const float gl = __shfl(gc, 63);
            const float bt = sigmoid_f(in.db), eg = __expf(gc);
            sS[(d * 5 + 0) * 64 + tp] = bt;
            sS[(d * 5 + 1) * 64 + tp] = gc;
            sS[(d * 5 + 2) * 64 + tp] = eg;
            sS[(d * 5 + 3) * 64 + tp] = __expf(gl - gc);
            sS[(d * 5 + 4) * 64 + tp] = bt * eg;
        }
        {
            char* raw = sL;
#pragma unroll
            for (int i = 0; i < 7; ++i) {
                const int c = tid + NTHR * i;
                const int g = c / 544, rem = c % 544, rr = rem >> 3, ch = rem & 7;
                if (c < 3 * 68 * 8) *(u32x4*)(raw + (g * 68 + rr) * 128 + ch * 16) = in.rp[i];
            }
            float* cwS = (float*)(sL + 26112);
#pragma unroll
            for (int i = 0; i < 4; ++i) { const int idx = tid + NTHR * i; if (idx < 960) cwS[idx] = in.cw[i]; }
            if (validn) dn1_fetch(in, p, un, tid);
            __syncthreads();
            const int o = tid & 7, r0 = tid >> 3;
#pragma unroll
            for (int g = 0; g < 3; ++g) {
                if (g == 0 && !lat) continue;
                float wj[5][8];
#pragma unroll
                for (int j = 0; j < 5; ++j) {
                    const f32x4 w0 = *(const f32x4*)(cwS + (g * 5 + j) * 64 + 8 * o), w1 = *(const f32x4*)(cwS + (g * 5 + j) * 64 + 8 * o + 4);
#pragma unroll
                    for (int e2 = 0; e2 < 4; ++e2) { wj[j][e2] = w0[e2]; wj[j][4 + e2] = w1[e2]; }
                }
#pragma unroll
                for (int hh = 0; hh < 2; ++hh) {
                    const int rr = r0 + 32 * hh;
                    float a[8];
#pragma unroll
                    for (int e2 = 0; e2 < 8; ++e2) a[e2] = 0.f;
#pragma unroll
                    for (int j = 0; j < 5; ++j) {
                        const u32x4 dv = *(const u32x4*)(raw + (g * 68 + rr + j) * 128 + o * 16);
#pragma unroll
                        for (int e2 = 0; e2 < 4; ++e2) {
                            a[2 * e2] += __uint_as_float(dv[e2] << 16) * wj[j][2 * e2];
                            a[2 * e2 + 1] += __uint_as_float(dv[e2] & 0xffff0000u) * wj[j][2 * e2 + 1];
                        }
                    }
                    float ss = 0.f;
#pragma unroll
                    for (int e2 = 0; e2 < 8; ++e2) { a[e2] = silu_f(a[e2]); ss += a[e2] * a[e2]; }
                    float sc = 1.f;
                    if (g < 2) {
                        ss += dpp_mov<0xB1>(ss); ss += dpp_mov<0x4E>(ss); ss += dpp_mov<0x141>(ss);
                        sc = rsqrtf(ss + EPSF) * (g == 0 ? 0.125f : 1.f);
                    }
                    u32x4 ov;
#pragma unroll
                    for (int e2 = 0; e2 < 4; ++e2) ov[e2] = pack_bf2(a[2 * e2] * sc, a[2 * e2 + 1] * sc);
                    *(u32x4*)((g == 0 ? sQ : g == 1 ? sK : sV) + lds_off(rr, o)) = ov;
                }
            }
            __syncthreads();
        }
        {
            f32x4 G[4];
            acc4_zero(G);
            mm64(G, sK, 16 * w, sK, l15, lq);
            float* L0 = (float*)sL; float* L1 = (float*)(sL + DN_LBYTES);
            const float* be0 = sS + 0 * 64; const float* gc0 = sS + 1 * 64;
            const float* be1 = sS + 5 * 64; const float* gc1 = sS + 6 * 64;
#pragma unroll
            for (int nt = 0; nt < 4; ++nt)
#pragma unroll
                for (int rg = 0; rg < 4; ++rg) {
                    const int t = 16 * w + 4 * lq + rg, s = 16 * nt + l15;
                    const float gv = G[nt][rg];
                    const int tp = 63 - t, sp = 63 - s;
                    L0[t * DN_LSTR + s] = (s < t) ? be0[t] * gv * __expf(gc0[t] - gc0[s]) : 0.f;
                    L1[tp * DN_LSTR + sp] = (s > t) ? be1[tp] * gv * __expf(gc1[tp] - gc1[sp]) : 0.f;
                }
            __syncthreads();
        }
        {
            int tid3 = tid;
            asm volatile("" : "+v"(tid3) :: "memory");
            const int lane3 = tid3 & 63, w3 = tid3 >> 6, l15c = lane3 & 15, lqc = lane3 >> 4;
            if (tid3 < 128) {
                float* Lb = (float*)(sL + w3 * DN_LBYTES) + (16 * lqc) * DN_LSTR + 16 * lqc;
                float x[16];
#pragma unroll
                for (int i = 0; i < 16; ++i) {
                    float v = (i == l15c) ? 1.f : 0.f;
#pragma unroll
                    for (int j = 0; j < i; ++j) v -= Lb[i * DN_LSTR + j] * x[j];
                    x[i] = v;
                }
#pragma unroll
                for (int i = 0; i < 16; ++i) Lb[i * DN_LSTR + l15c] = x[i];
            }
            __syncthreads();
            {
                const int d = w3 >> 1, pr = w3 & 1, b0 = 2 * pr, b1 = 2 * pr + 1;
                float* Ld = (float*)(sL + d * DN_LBYTES);
                float* scr = (float*)(sA) + w3 * 272;
                f32x4 P = (f32x4){0.f, 0.f, 0.f, 0.f};
#pragma unroll
                for (int kk = 0; kk < 4; ++kk)
                    P = __builtin_amdgcn_mfma_f32_16x16x4f32(Ld[(16 * b1 + l15c) * DN_LSTR + 16 * b0 + 4 * kk + lqc],
                                                            Ld[(16 * b0 + 4 * kk + lqc) * DN_LSTR + 16 * b0 + l15c], P, 0, 0, 0);
#pragma unroll
                for (int rg = 0; rg < 4; ++rg) scr[(4 * lqc + rg) * 17 + l15c] = P[rg];
                f32x4 R = (f32x4){0.f, 0.f, 0.f, 0.f};
#pragma unroll
                for (int kk = 0; kk < 4; ++kk)
                    R = __builtin_amdgcn_mfma_f32_16x16x4f32(Ld[(16 * b1 + l15c) * DN_LSTR + 16 * b1 + 4 * kk + lqc],
                                                            scr[(4 * kk + lqc) * 17 + l15c], R, 0, 0, 0);
#pragma unroll
                for (int rg = 0; rg < 4; ++rg) Ld[(16 * b1 + 4 * lqc + rg) * DN_LSTR + 16 * b0 + l15c] = -R[rg];
            }
            __syncthreads();
            {
                const int d = w3 >> 1, hf = w3 & 1;
                float* Ld = (float*)(sL + d * DN_LBYTES);
                float* scr2 = (float*)(d ? sKd : sA);
                f32x4 P2[2];
                P2[0] = (f32x4){0.f, 0.f, 0.f, 0.f}; P2[1] = (f32x4){0.f, 0.f, 0.f, 0.f};
#pragma unroll
                for (int kk = 0; kk < 8; ++kk) {
                    const float a = Ld[(32 + 16 * hf + l15c) * DN_LSTR + 4 * kk + lqc];
#pragma unroll
                    for (int n2 = 0; n2 < 2; ++n2)
                        P2[n2] = __builtin_amdgcn_mfma_f32_16x16x4f32(a, Ld[(4 * kk + lqc) * DN_LSTR + 16 * n2 + l15c], P2[n2], 0, 0, 0);
                }
#pragma unroll
                for (int n2 = 0; n2 < 2; ++n2)
#pragma unroll
                    for (int rg = 0; rg < 4; ++rg) scr2[(16 * hf + 4 * lqc + rg) * 33 + 16 * n2 + l15c] = P2[n2][rg];
                __syncthreads();
                f32x4 R2[2];
                R2[0] = (f32x4){0.f, 0.f, 0.f, 0.f}; R2[1] = (f32x4){0.f, 0.f, 0.f, 0.f};
#pragma unroll
                for (int kk = 0; kk < 8; ++kk) {
                    const float a = Ld[(32 + 16 * hf + l15c) * DN_LSTR + 32 + 4 * kk + lqc];
#pragma unroll
                    for (int n2 = 0; n2 < 2; ++n2)
                        R2[n2] = __builtin_amdgcn_mfma_f32_16x16x4f32(a, scr2[(4 * kk + lqc) * 33 + 16 * n2 + l15c], R2[n2], 0, 0, 0);
                }
#pragma unroll
                for (int n2 = 0; n2 < 2; ++n2)
#pragma unroll
                    for (int rg = 0; rg < 4; ++rg) Ld[(32 + 16 * hf + 4 * lqc + rg) * DN_LSTR + 16 * n2 + l15c] = -R2[n2][rg];
            }
            __syncthreads();
#pragma unroll 1
            for (int d = 0; d < 2; ++d) {
                const float* Td = (const float*)(sL + d * DN_LBYTES);
                {
                    const int tr = tid3 >> 2, cq = tid3 & 3;
                    const float* c1 = sS + (d * 5 + 0) * 64 + 16 * cq;
                    const float* c2 = sS + (d * 5 + 4) * 64 + 16 * cq;
                    const float* trow = Td + tr * DN_LSTR + 16 * cq;
                    float tv[16];
#pragma unroll
                    for (int e2 = 0; e2 < 16; ++e2) tv[e2] = trow[e2];
#pragma unroll
                    for (int q = 0; q < 2; ++q) {
                        u32x4 o1, o2;
#pragma unroll
                        for (int e2 = 0; e2 < 4; ++e2) {
                            const int i0 = 8 * q + 2 * e2;
                            o1[e2] = pack_bf2(tv[i0] * c1[i0], tv[i0 + 1] * c1[i0 + 1]);
                            o2[e2] = pack_bf2(tv[i0] * c2[i0], tv[i0 + 1] * c2[i0 + 1]);
                        }
                        *(u32x4*)(sA + lds_off(tr, 2 * cq + q)) = o1;
                        *(u32x4*)(sKd + lds_off(tr, 2 * cq + q)) = o2;
                    }
                }
                __syncthreads();
                f32x4 U[4], W[4];
                acc4_zero(U); acc4_zero(W);
                {
#pragma unroll
                    for (int ks = 0; ks < 2; ++ks) {
                        const bf16x8 a1 = *(const bf16x8*)(sA + lds_off(16 * w3 + l15c, ks * 4 + lqc));
                        const bf16x8 a2 = *(const bf16x8*)(sKd + lds_off(16 * w3 + l15c, ks * 4 + lqc));
                        const int r0 = 32 * ks + 8 * lqc + (l15c >> 2);
                        const int p0 = d ? 63 - r0 : r0, p1 = d ? 63 - (r0 + 4) : (r0 + 4);
#pragma unroll
                        for (int nt = 0; nt < 4; ++nt) {
                            const int col = 16 * nt + 4 * (l15c & 3);
                            const s16x4 v0 = ds_tr(sV + el_off(p0, col)), v1 = ds_tr(sV + el_off(p1, col));
                            const s16x4 k0 = ds_tr(sK + el_off(p0, col)), k1 = ds_tr(sK + el_off(p1, col));
                            U[nt] = __builtin_amdgcn_mfma_f32_16x16x32_bf16(a1, __builtin_shufflevector(v0, v1, 0, 1, 2, 3, 4, 5, 6, 7), U[nt], 0, 0, 0);
                            W[nt] = __builtin_amdgcn_mfma_f32_16x16x32_bf16(a2, __builtin_shufflevector(k0, k1, 0, 1, 2, 3, 4, 5, 6, 7), W[nt], 0, 0, 0);
                        }
                    }
                }
                __syncthreads();
                {
                    char* uT = sL + d * DN_LBYTES;
                    char* wT = uT + 8192;
                    const int t0 = 16 * w3 + 4 * lqc;
#pragma unroll
                    for (int nt = 0; nt < 4; ++nt) {
                        uint2 ou, ow;
                        ou.x = pack_bf2(U[nt][0], U[nt][1]); ou.y = pack_bf2(U[nt][2], U[nt][3]);
                        ow.x = pack_bf2(W[nt][0], W[nt][1]); ow.y = pack_bf2(W[nt][2], W[nt][3]);
                        *(uint2*)(uT + el_off(16 * nt + l15c, t0)) = ou;
                        *(uint2*)(wT + el_off(16 * nt + l15c, t0)) = ow;
                    }
                }
                __syncthreads();
            }
        }
        int tid5 = tid;
        asm volatile("" : "+v"(tid5) :: "memory");
        const int lane5 = tid5 & 63, w5 = tid5 >> 6, l15_5 = lane5 & 15, lq5 = lane5 >> 4;
        f32x4 QK[4];
        acc4_zero(QK);
        mm64(QK, sQ, 16 * w5, sK, l15_5, lq5);
#pragma unroll 1
        for (int d = 0; d < 2; ++d) {
            const float* gcd = sS + (d * 5 + 1) * 64;
            const float* egd = sS + (d * 5 + 2) * 64;
            const float* ekd = sS + (d * 5 + 3) * 64;
            {
                const int i = lane5, tq = w5;
                float kv[16];
#pragma unroll
                for (int e = 0; e < 16; ++e) {
                    const int tp = tq * 16 + e, pos = d ? 63 - tp : tp;
                    kv[e] = bf2f(*(const bf16_t*)(sK + el_off(pos, i))) * ekd[tp];
                }
#pragma unroll
                for (int q = 0; q < 2; ++q) {
                    u32x4 o;
                    o[0] = pack_bf2(kv[8 * q + 0], kv[8 * q + 1]); o[1] = pack_bf2(kv[8 * q + 2], kv[8 * q + 3]);
                    o[2] = pack_bf2(kv[8 * q + 4], kv[8 * q + 5]); o[3] = pack_bf2(kv[8 * q + 6], kv[8 * q + 7]);
                    *(u32x4*)(sKd + lds_off(i, 2 * tq + q)) = o;
                }
            }
#pragma unroll
            for (int nt = 0; nt < 4; ++nt)
#pragma unroll
                for (int rg = 0; rg < 4; ++rg) {
                    const int t = 16 * w5 + 4 * lq5 + rg, s = 16 * nt + l15_5;
                    const int tp = d ? 63 - t : t, sp = d ? 63 - s : s;
                    const float val = (sp <= tp) ? QK[nt][rg] * __expf(gcd[tp] - gcd[sp]) : 0.f;
                    *(bf16_t*)(sA + el_off(tp, sp)) = f2bf(val);
                }
            __syncthreads();
            const char* uT = sL + d * DN_LBYTES;
            const char* wT = uT + 8192;
            const int cd = (d == 0) ? pb : (pb < 4 ? 3 - pb : 39 - pb);
            bf16_t* Mg = p.MH + ((size_t)((bh * 2 + d) * 36 + cd) * 2) * 4096;
            bf16_t* Hg = Mg + 4096;
            {
                f32x4 MT[4];
                acc4_zero(MT);
                mm64(MT, wT, 16 * w5, sKd, l15_5, lq5);
                const float egl = egd[63];
                const int j0 = 16 * w5 + 4 * lq5;
#pragma unroll
                for (int nt = 0; nt < 4; ++nt) {
                    const int i = 16 * nt + l15_5;
                    f32x4 o;
#pragma unroll
                    for (int e = 0; e < 4; ++e) o[e] = ((i == j0 + e) ? egl : 0.f) - MT[nt][e];
                    st_bf4(Mg + i * 64 + j0, o);
                }
            }
            {
                f32x4 HH[4];
                acc4_zero(HH);
                mm64(HH, sKd, 16 * w5, uT, l15_5, lq5);
                const int i0 = 16 * w5 + 4 * lq5;
#pragma unroll
                for (int nt = 0; nt < 4; ++nt) st_bf4(Hg + (16 * nt + l15_5) * 64 + i0, HH[nt]);
            }
            if (lat) {
                bf16_t* Eg = p.EF + ((size_t)((bh * 2 + d) * 32 + (pb - 4)) * 2) * 4096;
                bf16_t* Fg = Eg + 4096;
                {
                    f32x4 ET[4];
                    acc4_zero(ET);
                    mm64(ET, wT, 16 * w5, sA, l15_5, lq5);
                    const int j0 = 16 * w5 + 4 * lq5;
#pragma unroll
                    for (int nt = 0; nt < 4; ++nt) {
                        const int sp = 16 * nt + l15_5, spos = d ? 63 - sp : sp;
                        const f32x4 qv = ld_bf4((const bf16_t*)(sQ + el_off(spos, j0)));
                        const float eg = egd[sp];
                        f32x4 o;
#pragma unroll
                        for (int e = 0; e < 4; ++e) o[e] = qv[e] * eg - ET[nt][e];
                        st_bf4(Eg + spos * 64 + j0, o);
                    }
                }
                {
                    f32x4 FF[4];
                    acc4_zero(FF);
                    mm64(FF, uT, 16 * w5, sA, l15_5, lq5);
                    const int c0 = 16 * w5 + 4 * lq5;
#pragma unroll
                    for (int nt = 0; nt < 4; ++nt) {
                        const int sp = 16 * nt + l15_5, spos = d ? 63 - sp : sp;
                        st_bf4(Fg + spos * 64 + c0, FF[nt]);
                    }
                }
            }
            __syncthreads();
        }
    }
}

struct Dn2Frag { bf16x8 am[2]; uint2 hr[2]; };
__device__ __forceinline__ void dn2_load(Dn2Frag& f, const bf16_t* Mg, int w, int l15, int lq, int i0, int hf) {
#pragma unroll
    for (int ks = 0; ks < 2; ++ks) f.am[ks] = *(const bf16x8*)(Mg + (16 * w + l15) * 64 + ks * 32 + lq * 8);
#pragma unroll
    for (int n2 = 0; n2 < 2; ++n2) f.hr[n2] = *(const uint2*)(Mg + 4096 + (32 * hf + 16 * n2 + l15) * 64 + i0);
}
__device__ __forceinline__ void dn2_step(const Dn2Frag& f, int c, int d, int hf, bf16_t* STc, char* smem, int l15, int lq, int i0) {
    const char* sS = smem + (c & 1) * 4096;
    char* sN = smem + ((c + 1) & 1) * 4096;
    f32x4 acc[2];
#pragma unroll
    for (int n2 = 0; n2 < 2; ++n2)
        acc[n2] = (f32x4){__uint_as_float(f.hr[n2].x << 16), __uint_as_float(f.hr[n2].x & 0xffff0000u),
                          __uint_as_float(f.hr[n2].y << 16), __uint_as_float(f.hr[n2].y & 0xffff0000u)};
#pragma unroll
    for (int ks = 0; ks < 2; ++ks)
#pragma unroll
        for (int n2 = 0; n2 < 2; ++n2) {
            const bf16x8 bs = *(const bf16x8*)(sS + lds_off(16 * n2 + l15, ks * 4 + lq));
            acc[n2] = __builtin_amdgcn_mfma_f32_16x16x32_bf16(f.am[ks], bs, acc[n2], 0, 0, 0);
        }
    const int cn = c + 1;
    const bool st = (cn >= 4 && cn <= 35);
    const int pbi = (d == 0 ? cn : 39 - cn) - 4;
#pragma unroll
    for (int n2 = 0; n2 < 2; ++n2) {
        uint2 o; o.x = pack_bf2(acc[n2][0], acc[n2][1]); o.y = pack_bf2(acc[n2][2], acc[n2][3]);
        const int cl = 16 * n2 + l15;
        *(uint2*)(sN + el_off(cl, i0)) = o;
        if (st) *(uint2*)(STc + (size_t)pbi * 4096 + (32 * hf + cl) * 64 + i0) = o;
    }
    __syncthreads();
}
__device__ __forceinline__ void ph_dn2(const Params& p, int bid, int nb, char* smem) {
    if (bid >= 256) return;
    const int tid = threadIdx.x, lane = tid & 63, w = tid >> 6, l15 = lane & 15, lq = lane >> 4;
    const int chain = bid >> 1, hf = bid & 1, d = chain & 1;
    const bf16_t* MHc = p.MH + (size_t)chain * 36 * 2 * 4096;
    bf16_t* STc = p.ST + (size_t)chain * 32 * 4096;
    for (int i = tid; i < 4096 / 16; i += NTHR) *(u32x4*)(smem + i * 16) = (u32x4){0u, 0u, 0u, 0u};
    __syncthreads();
    const int i0 = 16 * w + 4 * lq;
    Dn2Frag f0, f1, f2, f3;
    dn2_load(f0, MHc + (size_t)0 * 8192, w, l15, lq, i0, hf);
    dn2_load(f1, MHc + (size_t)1 * 8192, w, l15, lq, i0, hf);
    dn2_load(f2, MHc + (size_t)2 * 8192, w, l15, lq, i0, hf);
    dn2_load(f3, MHc + (size_t)3 * 8192, w, l15, lq, i0, hf);
    for (int c0 = 0; c0 < 36; c0 += 4) {
        const bool more = (c0 + 4 < 36);
        dn2_step(f0, c0 + 0, d, hf, STc, smem, l15, lq, i0);
        if (more) dn2_load(f0, MHc + (size_t)(c0 + 4) * 8192, w, l15, lq, i0, hf);
        dn2_step(f1, c0 + 1, d, hf, STc, smem, l15, lq, i0);
        if (more) dn2_load(f1, MHc + (size_t)(c0 + 5) * 8192, w, l15, lq, i0, hf);
        dn2_step(f2, c0 + 2, d, hf, STc, smem, l15, lq, i0);
        if (more) dn2_load(f2, MHc + (size_t)(c0 + 6) * 8192, w, l15, lq, i0, hf);
        dn2_step(f3, c0 + 3, d, hf, STc, smem, l15, lq, i0);
        if (more) dn2_load(f3, MHc + (size_t)(c0 + 7) * 8192, w, l15, lq, i0, hf);
    }
}

__device__ __forceinline__ void ph_dn3(const Params& p, int bid, int nb, char* smem) {
    const int tid = threadIdx.x, lane = tid & 63, w = tid >> 6, l15 = lane & 15, lq = lane >> 4;
    for (int u = bid; u < 64 * 32; u += nb) {
        const int bh = u >> 5, pbi = u & 31, b = bh >> 3, h = bh & 7;
        const int s = 16 * w + l15;
        const size_t rl = (size_t)b * SEQ + pbi * 64 + s;
        f32x4 zdv[4];
#pragma unroll
        for (int mt = 0; mt < 4; ++mt) zdv[mt] = ld_bf4(p.Pz + rl * PZ_W + 512 + h * 64 + 16 * mt + 4 * lq);
        f32x4 acc[4];
        acc4_zero(acc);
#pragma unroll
        for (int d = 0; d < 2; ++d) {
            const bf16_t* Eg = p.EF + ((size_t)((bh * 2 + d) * 32 + pbi) * 2) * 4096;
            const bf16_t* Fg = Eg + 4096;
            const bf16_t* Sg = p.ST + ((size_t)(bh * 2 + d) * 32 + pbi) * 4096;
#pragma unroll
            for (int mt = 0; mt < 4; ++mt) acc[mt] += ld_bf4(Fg + s * 64 + 16 * mt + 4 * lq);
#pragma unroll
            for (int ks = 0; ks < 2; ++ks) {
                const bf16x8 be = *(const bf16x8*)(Eg + s * 64 + ks * 32 + lq * 8);
#pragma unroll
                for (int mt = 0; mt < 4; ++mt) {
                    const bf16x8 as = *(const bf16x8*)(Sg + (16 * mt + l15) * 64 + ks * 32 + lq * 8);
                    acc[mt] = __builtin_amdgcn_mfma_f32_16x16x32_bf16(as, be, acc[mt], 0, 0, 0);
                }
            }
        }
        float ss = 0.f;
#pragma unroll
        for (int mt = 0; mt < 4; ++mt)
#pragma unroll
            for (int rg = 0; rg < 4; ++rg) ss += acc[mt][rg] * acc[mt][rg];
        ss = xrow_sum(ss);
        const float rstd = rsqrtf(ss * (1.f / 64.f) + EPSF);
#pragma unroll
        for (int mt = 0; mt < 4; ++mt) {
            const f32x4 nw = *(const f32x4*)(p.dn_norm_w + 16 * mt + 4 * lq);
            f32x4 o;
#pragma unroll
            for (int rg = 0; rg < 4; ++rg) o[rg] = acc[mt][rg] * rstd * nw[rg] * silu_f(zdv[mt][rg]);
            st_bf4(p.A_dn + rl * 512 + h * 64 + 16 * mt + 4 * lq, o);
        }
    }
    for (size_t i = (size_t)bid * NTHR + tid; i < (size_t)NL * 64; i += (size_t)nb * NTHR) {
        const size_t rl = i >> 6; const int c8 = (int)(i & 63) * 8;
        const u32x4 ov = *(const u32x4*)(p.o_mla + rl * 512 + c8);
        const u32x4 zv = *(const u32x4*)(p.Pz + rl * PZ_W + c8);
        u32x4 r;
#pragma unroll
        for (int e = 0; e < 4; ++e) {
            const float o0 = __uint_as_float(ov[e] << 16), o1 = __uint_as_float(ov[e] & 0xffff0000u);
            const float z0 = __uint_as_float(zv[e] << 16), z1 = __uint_as_float(zv[e] & 0xffff0000u);
            r[e] = pack_bf2(o0 * silu_f(z0), o1 * silu_f(z1));
        }
        *(u32x4*)(p.A_mla + rl * 512 + c8) = r;
    }
}


__device__ __forceinline__ void ph_inproj(const Params& p, int bid, int nb, char* smem) {
    const int UA = 2 * 120 + 16 * 144, UZ = 128 * 8;
    const bf16_t* hl = p.h + (size_t)NCTX * DM;
    int u, tm, tn;
    for (int it = 0; next_unit(it, UA + UZ, bid, nb, u); ++it) {
        if (u < 240) { const int g = u / 120, r = u % 120; tm = g * 8 + (r & 7); tn = 3 + (r >> 3); gemm_store_bf16(p.h, DM, p.Wt_a, 1024, tm, tn, p.Pa, PA_W, smem); }
        else if (u < UA) { unit_mn(u - 240 + 288, 18, tm, tn); gemm_store_bf16(p.h, DM, p.Wt_a, 1024, tm, tn, p.Pa, PA_W, smem); }
        else { unit_mn(u - UA, 8, tm, tn); gemm_store_bf16(hl, DM, p.Wt_z, 1024, tm, tn, p.Pz, PZ_W, smem); }
    }
}

__device__ __forceinline__ void ph_gates(const Params& p, int bid, int nb, char* smem) {
    const bf16_t* hl = p.h + (size_t)NCTX * DM;
    int u, tm, tn;
    for (int it = 0; next_unit(it, 128 * 16, bid, nb, u); ++it) {
        unit_mn(u, 16, tm, tn);
        gemm_store_bf16(hl, DM, p.Wt_g, 1024, tm, tn, p.Pg, PG_W, smem);
    }
}

__device__ __forceinline__ void ph_merge(const Params& p, int bid, int nb, char* smem) {
    int u, tm, tn;
    for (int it = 0; next_unit(it, 128 * 8, bid, nb, u); ++it) {
        unit_mn(u, 8, tm, tn);
        const int m0 = tm * 128, n0 = tn * 128;
        f32x4 acc[4][4];
        uint2 mm[4][4];
        u32x4 gw[2][4];
        {
        EPI_COORDS_OPAQUE(p1)
#pragma unroll
        for (int j = 0; j < 2; ++j)
#pragma unroll
            for (int mt = 0; mt < 4; ++mt) gw[j][mt] = *(const u32x4*)(p.Pg + (size_t)EPI_ROW(mt) * PG_W + EPI_COL(2 * j));
        }
        acc_zero<4>(acc);
        gemm_tile_acc<4>(acc, p.A_mla, 512, p.Wt_mo, 512, 512, m0, n0, smem);
#pragma unroll
        for (int j = 0; j < 2; ++j)
#pragma unroll
            for (int mt = 0; mt < 4; ++mt) {
#pragma unroll
                for (int q = 0; q < 2; ++q) {
                    const int nt = 2 * j + q;
                    const float g0 = __uint_as_float(gw[j][mt][2 * q] << 16), g1 = __uint_as_float(gw[j][mt][2 * q] & 0xffff0000u);
                    const float g2 = __uint_as_float(gw[j][mt][2 * q + 1] << 16), g3 = __uint_as_float(gw[j][mt][2 * q + 1] & 0xffff0000u);
                    mm[nt][mt].x = pack_bf2(sigmoid_f(g0) * acc[nt][mt][0], sigmoid_f(g1) * acc[nt][mt][1]);
                    mm[nt][mt].y = pack_bf2(sigmoid_f(g2) * acc[nt][mt][2], sigmoid_f(g3) * acc[nt][mt][3]);
                }
            }
        {
        EPI_COORDS_OPAQUE(p2)
#pragma unroll
        for (int j = 0; j < 2; ++j)
#pragma unroll
            for (int mt = 0; mt < 4; ++mt) gw[j][mt] = *(const u32x4*)(p.Pg + (size_t)EPI_ROW(mt) * PG_W + 1024 + EPI_COL(2 * j));
        }
        acc_zero<4>(acc);
        gemm_tile_acc<4>(acc, p.A_dn, 512, p.Wt_do, 512, 512, m0, n0, smem);
        {
        EPI_COORDS_OPAQUE(b)
#pragma unroll
        for (int j = 0; j < 2; ++j)
#pragma unroll
            for (int mt = 0; mt < 4; ++mt) {
                u32x4 ov;
#pragma unroll
                for (int q = 0; q < 2; ++q) {
                    const int nt = 2 * j + q;
                    const float g0 = __uint_as_float(gw[j][mt][2 * q] << 16), g1 = __uint_as_float(gw[j][mt][2 * q] & 0xffff0000u);
                    const float g2 = __uint_as_float(gw[j][mt][2 * q + 1] << 16), g3 = __uint_as_float(gw[j][mt][2 * q + 1] & 0xffff0000u);
                    const float o0 = __uint_as_float(mm[nt][mt].x << 16) + sigmoid_f(g0) * acc[nt][mt][0];
                    const float o1 = __uint_as_float(mm[nt][mt].x & 0xffff0000u) + sigmoid_f(g1) * acc[nt][mt][1];
                    const float o2 = __uint_as_float(mm[nt][mt].y << 16) + sigmoid_f(g2) * acc[nt][mt][2];
                    const float o3 = __uint_as_float(mm[nt][mt].y & 0xffff0000u) + sigmoid_f(g3) * acc[nt][mt][3];
                    ov[2 * q] = pack_bf2(o0, o1); ov[2 * q + 1] = pack_bf2(o2, o3);
                }
                *(u32x4*)(p.Mb + (size_t)EPI_ROW(mt) * 1024 + EPI_COL(2 * j)) = ov;
            }
        }
    }
}

__device__ __forceinline__ void ph_out(const Params& p, int bid, int nb, char* smem) {
    int u, tm, tn;
    for (int it = 0; next_unit(it, 128 * 8, bid, nb, u); ++it) {
        unit_mn(u, 8, tm, tn);
        const int m0 = tm * 128, n0 = tn * 128;
        f32x4 acc[4][4], xv[4][4];
        EPI_COORDS
#pragma unroll
        for (int nt = 0; nt < 4; ++nt)
#pragma unroll
            for (int mt = 0; mt < 4; ++mt) xv[nt][mt] = *(const f32x4*)(p.x + (size_t)EPI_ROW(mt) * DM + EPI_COL(nt));
        const float* gp = p.mod + (m0 / SEQ) * 3072 + 2048;
        f32x4 gate[4];
#pragma unroll
        for (int nt = 0; nt < 4; ++nt) gate[nt] = *(const f32x4*)(gp + EPI_COL(nt));
        acc_zero<4>(acc);
        gemm_tile_acc<4>(acc, p.Mb, 1024, p.Wt_out, 1024, 1024, m0, n0, smem);
#pragma unroll
        for (int nt = 0; nt < 4; ++nt)
#pragma unroll
            for (int mt = 0; mt < 4; ++mt)
                *(f32x4*)(p.out + (size_t)EPI_ROW(mt) * DM + EPI_COL(nt)) = xv[nt][mt] + gate[nt] * acc[nt][mt];
    }
}

#define XB_TMO      128
#define XB_XCNT(j)  (256  + 64 * (j))
#define XB_XSUB(j)  (1280 + 64 * (j))
#define XB_XGEN(j)  (2304 + 64 * (j))
#define XB_TOP      3328
#define XB_TOPGEN   3392
#define XCD_BAR_WORDS 3456
#define XB_SPIN_CAP (1u << 20)
__device__ __forceinline__ unsigned xb_ld(unsigned* p)              { return __hip_atomic_load(p, __ATOMIC_RELAXED, __HIP_MEMORY_SCOPE_AGENT); }
__device__ __forceinline__ unsigned xb_add(unsigned* p, unsigned v) { return __hip_atomic_fetch_add(p, v, __ATOMIC_RELAXED, __HIP_MEMORY_SCOPE_AGENT); }
__device__ __forceinline__ unsigned xb_xcc_id() { return (unsigned)__builtin_amdgcn_s_getreg((3 << 11) | 20) & 0xFu; }
#define XB_SPIN(cond, bar) do { unsigned _sp = 0; while (cond) { __builtin_amdgcn_s_sleep(1); \
    if ((++_sp & 255u) == 0u) { if (xb_ld(&(bar)[XB_TMO])) break; if (_sp > XB_SPIN_CAP) { atomicAdd(&(bar)[XB_TMO], 1u); break; } } } } while (0)
struct XcdBarrier { unsigned* bar; unsigned x; volatile LAS unsigned* st; };
__device__ __forceinline__ XcdBarrier xcd_barrier_post(unsigned* bar, volatile LAS unsigned* st) {
    XcdBarrier b; b.bar = bar; b.x = xb_xcc_id(); b.st = st;
    if (threadIdx.x == 0) (void)xb_add(&bar[XB_XCNT(b.x)], 1u);
    return b;
}
__device__ __forceinline__ void xcd_barrier_complete(unsigned* bar, unsigned x, unsigned& nloc, unsigned& nx) {
    const unsigned G = gridDim.x * gridDim.y * gridDim.z;
    unsigned sum, cnt, mine, sp = 0u;
    for (;;) {
        sum = 0u; cnt = 0u; mine = 0u;
#pragma unroll
        for (unsigned j = 0; j < 16; ++j) { const unsigned c = xb_ld(&bar[XB_XCNT(j)]); sum += c; cnt += (c > 0u) ? 1u : 0u; mine = (j == x) ? c : mine; }
        if (sum == G) break;
        __builtin_amdgcn_s_sleep(1);
        if ((++sp & 255u) == 0u) { if (xb_ld(&bar[XB_TMO])) break; if (sp > XB_SPIN_CAP) { atomicAdd(&bar[XB_TMO], 1u); break; } }
    }
    nloc = mine > 0u ? mine : 1u; nx = cnt > 0u ? cnt : 1u;
}
__device__ __forceinline__ void xcd_barrier(const XcdBarrier& b) {
    asm volatile("s_waitcnt vmcnt(0)" ::: "memory");
    __syncthreads();
    if (threadIdx.x == 0) {
        unsigned* bar = b.bar;
        __builtin_amdgcn_s_waitcnt(0);
        unsigned nloc = b.st[0], nx = b.st[1];
        if (nloc == 0u) { xcd_barrier_complete(bar, b.x, nloc, nx); b.st[0] = nloc; b.st[1] = nx; }
        const unsigned old = xb_add(&bar[XB_XSUB(b.x)], 1u);
        const unsigned gen = old / nloc;
        if (old + 1u == (gen + 1u) * nloc) {
            __builtin_amdgcn_fence(__ATOMIC_RELEASE, "agent");
            asm volatile("s_waitcnt vmcnt(0)" ::: "memory");
            const unsigned og = xb_add(&bar[XB_TOP], 1u);
            const unsigned tg = og / nx;
            if (og + 1u == (tg + 1u) * nx) xb_add(&bar[XB_TOPGEN], 1u);
            else XB_SPIN(xb_ld(&bar[XB_TOPGEN]) == tg, bar);
            __builtin_amdgcn_fence(__ATOMIC_ACQUIRE, "agent");
            xb_add(&bar[XB_XGEN(b.x)], 1u);
            asm volatile("s_waitcnt vmcnt(0)" ::: "memory");
        } else {
            XB_SPIN(xb_ld(&bar[XB_XGEN(b.x)]) == gen, bar);
            __builtin_amdgcn_fence(__ATOMIC_ACQUIRE, "agent");
            asm volatile("s_waitcnt vmcnt(0)" ::: "memory");
        }
    }
    __syncthreads();
}

__global__ void __launch_bounds__(NTHR, 2) fwd_megakernel(Params p) {
    __shared__ __attribute__((aligned(16))) char smem[SMEM_BYTES];
    const int bid = blockIdx.x, nb = gridDim.x;
    volatile LAS unsigned* bst = (volatile LAS unsigned*)(smem + SMEM_BYTES - 16);
    if (threadIdx.x == 0) { bst[0] = 0u; bst[1] = 0u; }
    __syncthreads();
    const XcdBarrier xb = xcd_barrier_post(p.bar, bst);

    ph_mod(p, bid, nb, smem);
    ph_wprep(p, bid, nb, smem);
    xcd_barrier(xb);
    ph_norm(p, bid, nb, smem);
    xcd_barrier(xb);
    ph_inproj(p, bid, nb, smem);
    xcd_barrier(xb);
    ph_mla_proj(p, bid, nb, smem);
    xcd_barrier(xb);
    ph_attn(p, bid, nb, smem);
    xcd_barrier(xb);
    ph_dn1(p, bid, nb, smem);
    xcd_barrier(xb);
    ph_dn2(p, bid, nb, smem);
    xcd_barrier(xb);
    ph_dn3(p, bid, nb, smem);
    ph_gates(p, bid, nb, smem);
    xcd_barrier(xb);
    ph_merge(p, bid, nb, smem);
    xcd_barrier(xb);
    ph_out(p, bid, nb, smem);
}

extern "C" void kernel_launch(void* const* d_in, const int* in_sizes, int n_in,
                              void* d_out, int out_size, void* d_ws, size_t ws_size,
                              hipStream_t stream) {
    static int grid_blocks = 0;
    if (!grid_blocks) {
        int dev = 0, cus = 0, per_cu = 0;
        (void)hipGetDevice(&dev);
        (void)hipDeviceGetAttribute(&cus, hipDeviceAttributeMultiprocessorCount, dev);
        (void)hipOccupancyMaxActiveBlocksPerMultiprocessor(&per_cu, fwd_megakernel, NTHR, 0);
        if (per_cu > 2) per_cu = 2;
        if (per_cu < 1) per_cu = 1;
        grid_blocks = cus * per_cu;
    }
    if (n_in != 21 || ws_size < (size_t)268435456 || out_size != NL * DM) {
        fprintf(stderr, "kernel_launch: built for 21 inputs, a %d-float output and >= 256 MiB of workspace (got %d inputs, out %d, ws %zu)\n", NL * DM, n_in, out_size, ws_size);
        return;
    }
    Params p{};
    const float** fp = (const float**)&p;
    for (int i = 0; i < 21; ++i) fp[i] = (const float*)d_in[i];
    p.out = (float*)d_out;
    char* ws = (char*)d_ws;
    char* ob = (char*)d_out;
    const size_t R_W = 0;
    const size_t R_H = 16777216;
    const size_t R_Z = R_H + 37748736;
    const size_t R_A = R_Z + 33554432;
    const size_t R_F = R_A + 84934656;
    {
        size_t o = R_W;
        p.Wt_a = (bf16_t*)(ws + o); o += 4718592;
        p.Wt_z = (bf16_t*)(ws + o); o += 2097152;
        p.Wt_g = (bf16_t*)(ws + o); o += 4194304;
        p.Wt_uq = (bf16_t*)(ws + o); o += 589824;
        p.Wt_ukv = (bf16_t*)(ws + o); o += 524288;
        p.Wt_mo = (bf16_t*)(ws + o); o += 1048576;
        p.Wt_do = (bf16_t*)(ws + o); o += 1048576;
        p.Wt_out = (bf16_t*)(ws + o); o += 2097152;
        p.mod = (float*)(ws + o); o += 110592;
        p.bar = (unsigned*)(ws + o); o += XCD_BAR_WORDS * 4;
        p.rope = (float*)(ws + o); o += 4096;
    }
    p.h = (bf16_t*)(ws + R_H);
    p.Pz = (bf16_t*)(ws + R_Z);
    p.Pa = (bf16_t*)(ws + R_A);
    p.Qb = (bf16_t*)(ws + R_F + 22020096);
    p.Kb = (bf16_t*)(ws + R_F + 47185920);
    p.Vt = (bf16_t*)(ws + R_F + 75497472);
    p.o_mla = (bf16_t*)(ws + R_F);
    p.MH = (bf16_t*)(ws + R_F + 16777216);
    p.EF = (bf16_t*)(ob);
    p.ST = (bf16_t*)(ws + R_A);
    p.A_mla = (bf16_t*)(ws + R_A + 33554432);
    p.A_dn = (bf16_t*)(ws + R_A + 50331648);
    p.Pg = (bf16_t*)(ws + R_F + 16777216);
    p.Mb = (bf16_t*)(ws + R_H);
    (void)hipMemsetAsync(p.mod, 0, 110592 + XCD_BAR_WORDS * 4, stream);
    void* args[] = {&p};
    hipError_t err = hipLaunchCooperativeKernel((void*)fwd_megakernel, dim3(grid_blocks), dim3(NTHR), args, 0, stream);
    if (err != hipSuccess) fprintf(stderr, "cooperative launch failed: %s (grid %d)\n", hipGetErrorString(err), grid_blocks);
}
```

```cpp
#include <hip/hip_runtime.h>
#include <stdint.h>
#include <cstdio>

typedef uint16_t bf16_t;
#define LAS __attribute__((address_space(3)))

#define NB 8
#define SEQ 2048
#define CTXL 256
#define TPB 2304
#define NCTX 2048
#define NL 16384
#define NT 18432
#define DM 1024
#define IN_DIM 5312
#define PA_W 2304
#define PZ_W 1024
#define PG_W 2048
#define PA_CQ 0
#define PA_CKV 384
#define PA_KR 640
#define PA_DQ 672
#define PA_DK 1184
#define PA_DV 1696
#define PA_DB 2208
#define PA_DA 2224
#define EPSF 1e-6f
#define NTHR 256
#define SMEM_BYTES 77824

struct Params {
    const float *x, *c, *ctx, *c_ctx, *w_mod, *b_mod, *norm_w, *w_in, *q_norm_w, *w_uq, *kv_norm_w, *w_ukv, *qhn_w, *khn_w,
        *mla_w_o, *conv_w, *a_log, *dt_bias, *dn_norm_w, *dn_w_o, *w_out;
    float* out;
    bf16_t *h, *Pa, *Pz, *Pg, *Qb, *Vt, *Kb, *o_mla, *MH, *EF, *ST, *A_mla, *A_dn, *Mb;
    bf16_t *Wt_a, *Wt_z, *Wt_g, *Wt_uq, *Wt_ukv, *Wt_mo, *Wt_do, *Wt_out;
    float *mod, *rope;
    unsigned* bar;
};

typedef float f32x4 __attribute__((ext_vector_type(4)));
typedef unsigned u32x4 __attribute__((ext_vector_type(4)));
typedef __bf16 bf16v2_t __attribute__((ext_vector_type(2)));
typedef float f32x2 __attribute__((ext_vector_type(2)));
__device__ __forceinline__ uint32_t pack_bf2(float lo, float hi) {
    f32x2 v = {lo, hi};
    bf16v2_t b = __builtin_convertvector(v, bf16v2_t);
    return __builtin_bit_cast(uint32_t, b);
}
__device__ __forceinline__ void st_bf4(bf16_t* p, f32x4 v) {
    uint2 o; o.x = pack_bf2(v[0], v[1]); o.y = pack_bf2(v[2], v[3]);
    *(uint2*)p = o;
}
__device__ __forceinline__ float bf2f(bf16_t v) { return __uint_as_float(((uint32_t)v) << 16); }
__device__ __forceinline__ bf16_t f2bf(float f) {
    uint32_t u = __float_as_uint(f);
    u += 0x7fffu + ((u >> 16) & 1u);
    return (bf16_t)(u >> 16);
}
__device__ __forceinline__ float silu_f(float v) { return v * __builtin_amdgcn_rcpf(1.f + __expf(-v)); }
__device__ __forceinline__ float sigmoid_f(float v) { return __builtin_amdgcn_rcpf(1.f + __expf(-v)); }
template <int CTRL> __device__ __forceinline__ float dpp_mov(float v) {
    return __builtin_bit_cast(float, __builtin_amdgcn_update_dpp(0, __builtin_bit_cast(int, v), CTRL, 0xF, 0xF, true));
}
__device__ __forceinline__ float row16_sum(float v) {
    v += dpp_mov<0xB1>(v); v += dpp_mov<0x4E>(v); v += dpp_mov<0x141>(v); v += dpp_mov<0x140>(v); return v;
}
__device__ __forceinline__ float rdlane(float v, int l) { return __builtin_bit_cast(float, __builtin_amdgcn_readlane(__builtin_bit_cast(int, v), l)); }
__device__ __forceinline__ float wave_sum(float v) {
    v += dpp_mov<0xB1>(v);
    v += dpp_mov<0x4E>(v);
    v += dpp_mov<0x141>(v);
    v += dpp_mov<0x140>(v);
    return (rdlane(v, 0) + rdlane(v, 16)) + (rdlane(v, 32) + rdlane(v, 48));
}
__device__ __forceinline__ float xrow_sum(float v) { v += __shfl_xor(v, 16); v += __shfl_xor(v, 32); return v; }
__device__ __forceinline__ void ph_mod(const Params& p, int bid, int nb, char* smem) {
    float* sc = (float*)smem;
    for (int item = bid; item < 64; item += nb) {
        const int k0 = item * 16, tid = threadIdx.x;
        __syncthreads();
        if (tid < 144) {
            const int r = tid >> 4, kk = tid & 15;
            const float v = (r < 8) ? p.c[r * 1024 + k0 + kk] : p.c_ctx[k0 + kk];
            sc[tid] = silu_f(v);
        }
        __syncthreads();
#pragma unroll 1
        for (int half = 0; half < 2; ++half) {
            float acc[6][9];
#pragma unroll
            for (int q = 0; q < 6; ++q)
#pragma unroll
                for (int r = 0; r < 9; ++r) acc[q][r] = 0.f;
            const float* wp = p.w_mod + (size_t)k0 * 3072 + half * 1536 + tid;
#pragma unroll 4
            for (int kk = 0; kk < 16; ++kk) {
                float wv[6];
#pragma unroll
                for (int q = 0; q < 6; ++q) wv[q] = wp[(size_t)kk * 3072 + q * 256];
#pragma unroll
                for (int r = 0; r < 9; ++r) {
                    const float s = sc[r * 16 + kk];
#pragma unroll
                    for (int q = 0; q < 6; ++q) acc[q][r] += s * wv[q];
                }
            }
#pragma unroll
            for (int q = 0; q < 6; ++q) {
                const int j = half * 1536 + q * 256 + tid;
                const float bb = (item == 0) ? p.b_mod[j] : 0.f;
#pragma unroll
                for (int r = 0; r < 9; ++r) atomicAdd(p.mod + r * 3072 + j, acc[q][r] + bb);
            }
        }
    }
}

__device__ __forceinline__ void ph_norm(const Params& p, int bid, int nb, char* smem) {
    const int lane = threadIdx.x & 63, gw = bid * 4 + (threadIdx.x >> 6), nw = nb * 4;
    const int per = (NT + nw - 1) / nw;
    const int r0 = gw * per, r1 = (r0 + per < NT) ? r0 + per : NT;
    auto rowptr = [&](int rr) -> const float* { return (rr < NCTX) ? p.ctx + (size_t)rr * DM : p.x + (size_t)(rr - NCTX) * DM; };
    f32x4 v[4], vn[4], av[4], sv[4];
    int cur_m = -1;
    if (r0 < r1) {
        const float* src = rowptr(r0);
#pragma unroll
        for (int i = 0; i < 4; ++i) v[i] = *(const f32x4*)(src + i * 256 + lane * 4);
    }
    for (int r = r0; r < r1; ++r) {
        if (r + 1 < r1) {
            const float* src = rowptr(r + 1);
#pragma unroll
            for (int i = 0; i < 4; ++i) vn[i] = *(const f32x4*)(src + i * 256 + lane * 4);
        }
        const int mrow = (r < NCTX) ? 8 : (r - NCTX) / SEQ;
        if (mrow != cur_m) {
            cur_m = mrow;
            const float* shift = p.mod + mrow * 3072;
            const float* scale = shift + 1024;
#pragma unroll
            for (int i = 0; i < 4; ++i) {
                const int k = i * 256 + lane * 4;
                const f32x4 nwv = *(const f32x4*)(p.norm_w + k), sc = *(const f32x4*)(scale + k);
                sv[i] = *(const f32x4*)(shift + k);
#pragma unroll
                for (int e2 = 0; e2 < 4; ++e2) av[i][e2] = nwv[e2] * (1.f + sc[e2]);
            }
        }
        float ss = 0.f;
#pragma unroll
        for (int i = 0; i < 4; ++i) ss += v[i][0] * v[i][0] + v[i][1] * v[i][1] + v[i][2] * v[i][2] + v[i][3] * v[i][3];
        ss = wave_sum(ss);
        const float rstd = rsqrtf(ss * (1.f / 1024.f) + EPSF);
#pragma unroll
        for (int i = 0; i < 4; ++i) {
            f32x4 y;
#pragma unroll
            for (int e2 = 0; e2 < 4; ++e2) y[e2] = (v[i][e2] * rstd) * av[i][e2] + sv[i][e2];
            st_bf4(p.h + (size_t)r * DM + i * 256 + lane * 4, y);
        }
#pragma unroll
        for (int i = 0; i < 4; ++i) v[i] = vn[i];
    }
}


__device__ __forceinline__ void wprep_unit(const float* __restrict__ W, int ldw, int K, int n0, int k0, int srcbase, bf16_t* __restrict__ dst, float* tile,
                                           const float* __restrict__ kscale) {
    const int tid = threadIdx.x;
    {
        const int n4 = (tid & 7) * 4, kk = tid >> 3;
        float4 v[4];
#pragma unroll
        for (int q = 0; q < 4; ++q) {
            const int k = kk + 32 * q;
            v[q] = make_float4(0.f, 0.f, 0.f, 0.f);
            if (srcbase >= 0) v[q] = *(const float4*)(W + (size_t)(k0 + k) * ldw + srcbase + n4);
        }
#pragma unroll
        for (int q = 0; q < 4; ++q) {
            const int k = kk + 32 * q;
            if (kscale) { const float s = kscale[k0 + k]; v[q].x *= s; v[q].y *= s; v[q].z *= s; v[q].w *= s; }
            float* t = tile + k * 33 + n4;
            t[0] = v[q].x; t[1] = v[q].y; t[2] = v[q].z; t[3] = v[q].w;
        }
    }
    __syncthreads();
    {
        const int n = tid >> 3;
#pragma unroll
        for (int q = 0; q < 2; ++q) {
            const int kc = (tid & 7) + 8 * q;
            const float* t = tile + (kc * 8) * 33 + n;
            uint4 o;
            o.x = pack_bf2(t[0 * 33], t[1 * 33]); o.y = pack_bf2(t[2 * 33], t[3 * 33]);
            o.z = pack_bf2(t[4 * 33], t[5 * 33]); o.w = pack_bf2(t[6 * 33], t[7 * 33]);
            *(uint4*)(dst + (size_t)(n0 + n) * K + k0 + kc * 8) = o;
        }
    }
    __syncthreads();
}

__device__ __forceinline__ void ph_wprep(const Params& p, int bid, int nb, char* smem) {
    float* tile = (float*)smem;
    const int U0 = 72 * 8, U1 = 32 * 8, U2 = 64 * 8, U3 = 24 * 3, U4 = 32 * 2, U5 = 32 * 4, U6 = 32 * 4, U7 = 32 * 8;
    const int UT = U0 + U1 + U2 + U3 + U4 + U5 + U6 + U7;
    for (int u = bid; u < UT; u += nb) {
        int v = u;
        const float* W; int ldw, K; bf16_t* dst; int job;
        if (v < U0) { job = 0; W = p.w_in; ldw = IN_DIM; K = 1024; dst = p.Wt_a; }
        else if ((v -= U0) < U1) { job = 1; W = p.w_in; ldw = IN_DIM; K = 1024; dst = p.Wt_z; }
        else if ((v -= U1) < U2) { job = 2; W = p.w_in; ldw = IN_DIM; K = 1024; dst = p.Wt_g; }
        else if ((v -= U2) < U3) { job = 3; W = p.w_uq; ldw = 768; K = 384; dst = p.Wt_uq; }
        else if ((v -= U3) < U4) { job = 4; W = p.w_ukv; ldw = 1024; K = 256; dst = p.Wt_ukv; }
        else if ((v -= U4) < U5) { job = 5; W = p.mla_w_o; ldw = 1024; K = 512; dst = p.Wt_mo; }
        else if ((v -= U5) < U6) { job = 6; W = p.dn_w_o; ldw = 1024; K = 512; dst = p.Wt_do; }
        else { v -= U6; job = 7; W = p.w_out; ldw = 1024; K = 1024; dst = p.Wt_out; }
        const int nkt = K / 128;
        const int n0 = (v / nkt) * 32, k0 = (v % nkt) * 128;
        int srcbase = n0;
        if (job == 0) {
            if (n0 < 672) srcbase = n0;
            else if (n0 < 2208) { const int r = n0 - 672, hh = r / 192, g = (r % 192) >> 6, i0 = r & 63; srcbase = 1184 + g * 512 + hh * 64 + i0; }
            else srcbase = (n0 < 2240) ? n0 + 1024 : -1;
        }
        else if (job == 1) srcbase = (n0 < 512) ? 672 + n0 : 2208 + n0;
        else if (job == 2) srcbase = 3264 + n0;
        const float* ksc = (job == 3) ? p.q_norm_w : (job == 4) ? p.kv_norm_w : nullptr;
        wprep_unit(W, ldw, K, n0, k0, srcbase, dst, tile, ksc);
    }
    if (bid == nb - 1) {
        for (int i = threadIdx.x; i < 512; i += NTHR) {
            const int pos = i >> 3, f = i & 7;
            const float ang = (float)pos * powf(10000.f, -(float)f / 8.f);
            p.rope[2 * i] = cosf(ang); p.rope[2 * i + 1] = sinf(ang);
        }
    }
}

typedef short bf16x8 __attribute__((ext_vector_type(8)));


__device__ __forceinline__ int lds_off(int row, int chunk) { return row * 128 + (((chunk ^ (row >> 1)) & 7) << 4); }

__device__ __forceinline__ int epi_perm(int rho) { return 8 * ((rho >> 2) & 3) + 4 * (rho >> 4) + (rho & 3); }

template <int NTN>
__device__ __forceinline__ void gemm_compute_stage(f32x4 (&acc)[NTN][4], const char* sa, int wm, int wn, int l15, int lq) {
    const char* sb = sa + 16384;
#pragma unroll
    for (int ks = 0; ks < 2; ++ks) {
        bf16x8 af[4], bfr[NTN];
#pragma unroll
        for (int mt = 0; mt < 4; ++mt) af[mt] = *(const bf16x8*)(sa + lds_off(wm * 64 + mt * 16 + l15, ks * 4 + lq));
#pragma unroll
        for (int nt = 0; nt < NTN; ++nt) bfr[nt] = *(const bf16x8*)(sb + lds_off(wn * (16 * NTN) + nt * 16 + l15, ks * 4 + lq));
#pragma unroll
        for (int nt = 0; nt < NTN; ++nt)
#pragma unroll
            for (int mt = 0; mt < 4; ++mt)
                acc[nt][mt] = __builtin_amdgcn_mfma_f32_16x16x32_bf16(bfr[nt], af[mt], acc[nt][mt], 0, 0, 0);
    }
}
template <int NTN>
__device__ __forceinline__ void gemm_tile_acc(f32x4 (&acc)[NTN][4], const bf16_t* __restrict__ A, int lda, const bf16_t* __restrict__ Bt, int ldb,
                                              int K, int m0, int n0, char* smem) {
    int tid = threadIdx.x;
    asm volatile("" : "+v"(tid));
    const int lane = tid & 63, w = tid >> 6, wm = w >> 1, wn = w & 1;
    const int l15 = lane & 15, lq = lane >> 4;
    const int srow = tid >> 3, sch = (tid & 7) ^ ((srow >> 1) & 7);
    const bf16_t* ap = A + (size_t)(m0 + srow) * lda + sch * 8;
    const int prow = epi_perm(srow & 31);
    const bf16_t* bp = Bt + (size_t)(n0 + prow) * ldb + sch * 8;
    int KT = K >> 6;
    asm volatile("" : "+s"(KT));
    LAS char* lbase = (LAS char*)smem + w * 1024;
#define GT_STAGE(ST_, KT_) do { \
        _Pragma("unroll") for (int i = 0; i < 4; ++i) \
            __builtin_amdgcn_global_load_lds((const void*)(ap + (size_t)(32 * i) * lda + (KT_) * 64), (LAS void*)(lbase + (ST_) * 32768 + i * 4096), 16, 0, 0); \
        _Pragma("unroll") for (int i = 0; i < NTN; ++i) \
            __builtin_amdgcn_global_load_lds((const void*)(bp + (size_t)(32 * i) * ldb + (KT_) * 64), (LAS void*)(lbase + (ST_) * 32768 + 16384 + i * 4096), 16, 0, 0); } while (0)
    GT_STAGE(0, 0);
    __syncthreads();
    for (int kt = 0; kt < KT; ++kt) {
        if (kt + 1 < KT) GT_STAGE((kt + 1) & 1, kt + 1);
        gemm_compute_stage<NTN>(acc, smem + (kt & 1) * 32768, wm, wn, l15, lq);
        __syncthreads();
    }
#undef GT_STAGE
}

template <int NTN>
__device__ __forceinline__ void acc_zero(f32x4 (&acc)[NTN][4]) {
#pragma unroll
    for (int i = 0; i < NTN; ++i)
#pragma unroll
        for (int j = 0; j < 4; ++j) acc[i][j] = (f32x4){0.f, 0.f, 0.f, 0.f};
}

__device__ __forceinline__ bool next_unit(int it, int U, int bid, int nb, int& u) {
    const int x = bid & 7, li = bid >> 3, per = nb >> 3;
    const int lo = (int)(((long)U * x) >> 3), hi = (int)(((long)U * (x + 1)) >> 3);
    u = lo + li + it * per;
    return u < hi;
}
__device__ __forceinline__ void unit_mn(int u, int ntn, int& tm, int& tn) {
    const int g = u / (8 * ntn), r = u % (8 * ntn);
    tm = g * 8 + (r & 7); tn = r >> 3;
}


__device__ __forceinline__ f32x4 ld_bf4(const bf16_t* p) {
    const uint2 r = *(const uint2*)p;
    return (f32x4){__uint_as_float(r.x << 16), __uint_as_float(r.x & 0xffff0000u), __uint_as_float(r.y << 16), __uint_as_float(r.y & 0xffff0000u)};
}
#define EPI_COORDS_OPAQUE(SFX) int tid##SFX = threadIdx.x; asm volatile("" : "+v"(tid##SFX)); \
    const int lane_ = tid##SFX & 63, w_ = tid##SFX >> 6, wm_ = w_ >> 1, wn_ = w_ & 1, l15_ = lane_ & 15, lq_ = lane_ >> 4;
#define EPI_COORDS const int lane_ = threadIdx.x & 63, w_ = threadIdx.x >> 6, wm_ = w_ >> 1, wn_ = w_ & 1, l15_ = lane_ & 15, lq_ = lane_ >> 4;
#define EPI_ROW(mt) (m0 + wm_ * 64 + (mt) * 16 + l15_)
#define EPI_COL(nt) (n0 + wn_ * 64 + 32 * ((nt) >> 1) + 8 * lq_ + 4 * ((nt) & 1))

__device__ __forceinline__ void gemm_store_bf16(const bf16_t* A, int lda, const bf16_t* Bt, int K, int tm, int tn, bf16_t* C, int ldc, char* smem) {
    f32x4 acc[4][4];
    acc_zero<4>(acc);
    const int m0 = tm * 128, n0 = tn * 128;
    gemm_tile_acc<4>(acc, A, lda, Bt, K, K, m0, n0, smem);
    EPI_COORDS
#pragma unroll
    for (int j = 0; j < 2; ++j)
#pragma unroll
        for (int mt = 0; mt < 4; ++mt) {
            u32x4 o;
            o[0] = pack_bf2(acc[2 * j][mt][0], acc[2 * j][mt][1]); o[1] = pack_bf2(acc[2 * j][mt][2], acc[2 * j][mt][3]);
            o[2] = pack_bf2(acc[2 * j + 1][mt][0], acc[2 * j + 1][mt][1]); o[3] = pack_bf2(acc[2 * j + 1][mt][2], acc[2 * j + 1][mt][3]);
            *(u32x4*)(C + (size_t)EPI_ROW(mt) * ldc + EPI_COL(2 * j)) = o;
        }
}

template <int NTN>
__device__ __forceinline__ void gemm_rows_acc(f32x4 (&acc)[NTN][2], float (&ssq)[2], const bf16_t* __restrict__ A, int lda,
                                              const bf16_t* __restrict__ Bt, int ldb, int K, int m0, int n0, char* smem) {
    constexpr int NB_ = NTN / 2;
    int tid = threadIdx.x;
    asm volatile("" : "+v"(tid));
    const int lane = tid & 63, w = tid >> 6;
    const int l15 = lane & 15, lq = lane >> 4;
    const int srow = tid >> 3, sch = (tid & 7) ^ ((srow >> 1) & 7);
    const bf16_t* ap = A + (size_t)(m0 + srow) * lda + sch * 8;
    const bf16_t* bp = Bt + (size_t)(n0 + srow) * ldb + sch * 8;
    int KT = K >> 6;
    asm volatile("" : "+s"(KT));
    LAS char* lbase = (LAS char*)smem + w * 1024;
#define GR_STAGE(ST_, KT_) do { \
        _Pragma("unroll") for (int i = 0; i < 4; ++i) \
            __builtin_amdgcn_global_load_lds((const void*)(ap + (size_t)(32 * i) * lda + (KT_) * 64), (LAS void*)(lbase + (ST_) * 32768 + i * 4096), 16, 0, 0); \
        _Pragma("unroll") for (int i = 0; i < NB_; ++i) \
            __builtin_amdgcn_global_load_lds((const void*)(bp + (size_t)(32 * i) * ldb + (KT_) * 64), (LAS void*)(lbase + (ST_) * 32768 + 16384 + i * 4096), 16, 0, 0); } while (0)
    GR_STAGE(0, 0);
    __syncthreads();
    for (int kt = 0; kt < KT; ++kt) {
        if (kt + 1 < KT) GR_STAGE((kt + 1) & 1, kt + 1);
        const char* sa = smem + (kt & 1) * 32768;
        const char* sb = sa + 16384;
#pragma unroll
        for (int ks = 0; ks < 2; ++ks) {
            bf16x8 af[2], bfr[NTN];
#pragma unroll
            for (int mt = 0; mt < 2; ++mt) af[mt] = *(const bf16x8*)(sa + lds_off(w * 32 + mt * 16 + l15, ks * 4 + lq));
#pragma unroll
            for (int nt = 0; nt < NTN; ++nt) bfr[nt] = *(const bf16x8*)(sb + lds_off(nt * 16 + l15, ks * 4 + lq));
#pragma unroll
            for (int mt = 0; mt < 2; ++mt) {
                const u32x4 aw = __builtin_bit_cast(u32x4, af[mt]);
#pragma unroll
                for (int e2 = 0; e2 < 4; ++e2) {
                    const float lo = __uint_as_float(aw[e2] << 16), hi = __uint_as_float(aw[e2] & 0xffff0000u);
                    ssq[mt] += lo * lo + hi * hi;
                }
            }
#pragma unroll
            for (int nt = 0; nt < NTN; ++nt)
#pragma unroll
                for (int mt = 0; mt < 2; ++mt)
                    acc[nt][mt] = __builtin_amdgcn_mfma_f32_16x16x32_bf16(bfr[nt], af[mt], acc[nt][mt], 0, 0, 0);
        }
        __syncthreads();
    }
#undef GR_STAGE
    ssq[0] = xrow_sum(ssq[0]);
    ssq[1] = xrow_sum(ssq[1]);
}

__device__ __forceinline__ void ph_mla_proj(const Params& p, int bid, int nb, char* smem) {
    const int tid = threadIdx.x, lane = tid & 63, w = tid >> 6, l15 = lane & 15, lq = lane >> 4;
    float* s_rope = (float*)(smem + 65536);
    float* s_qhn = s_rope + 1024;
    float* s_khn = s_qhn + 96;
    for (int i = tid; i < 1024; i += NTHR) s_rope[i] = p.rope[i];
    if (tid < 96) { s_qhn[tid] = p.qhn_w[tid]; s_khn[tid] = p.khn_w[tid]; }
    __syncthreads();
    const int UQ = 128 * 8, UK = 144 * 8;
    int u;
    for (int it = 0; next_unit(it, UQ + UK, bid, nb, u); ++it) {
        if (u < UQ) {
            const int tm = u >> 3, hh = u & 7;
            const int m0 = NCTX + tm * 128;
            f32x4 acc[6][2];
            float ssq[2] = {0.f, 0.f};
#pragma unroll
            for (int i = 0; i < 6; ++i) { acc[i][0] = (f32x4){0.f, 0.f, 0.f, 0.f}; acc[i][1] = (f32x4){0.f, 0.f, 0.f, 0.f}; }
            gemm_rows_acc<6>(acc, ssq, p.Pa + PA_CQ, PA_W, p.Wt_uq, 384, 384, m0, hh * 96, smem);
#pragma unroll
            for (int mt = 0; mt < 2; ++mt) {
                const int ml = 32 * w + 16 * mt + l15;
                const int rl = tm * 128 + ml;
                const int b = rl >> 11, t = rl & 2047;
                const float rs = rsqrtf(ssq[mt] * (1.f / 384.f) + EPSF);
                float hs = 0.f;
#pragma unroll
                for (int nt = 0; nt < 6; ++nt)
#pragma unroll
                    for (int e = 0; e < 4; ++e) { const float v = acc[nt][mt][e] * rs; acc[nt][mt][e] = v; hs += v * v; }
                hs = xrow_sum(hs);
                const float hr = rsqrtf(hs * (1.f / 96.f) + EPSF) * (0.10206207261596575f * 1.4426950408889634f);
                bf16_t* qd = p.Qb + ((size_t)((b * 8 + hh) * SEQ + t)) * 96 + 4 * lq;
#pragma unroll
                for (int nt = 0; nt < 6; ++nt) {
                    const f32x4 wv = *(const f32x4*)(s_qhn + 16 * nt + 4 * lq);
                    f32x4 v;
#pragma unroll
                    for (int e = 0; e < 4; ++e) v[e] = acc[nt][mt][e] * hr * wv[e];
                    if (nt >= 4) {
                        const int pos = (nt == 4) ? (t >> 6) : (t & 63);
                        const int ph = lq >> 1;
#pragma unroll
                        for (int e = 0; e < 4; ++e) {
                            const float2 cs = *(const float2*)(s_rope + 2 * (pos * 8 + (lq & 1) * 4 + e));
                            const float partner = __shfl_xor(v[e], 32);
                            const float t1 = ph ? partner : v[e], t2 = ph ? v[e] : partner;
                            v[e] = ph ? (t1 * cs.y + t2 * cs.x) : (t1 * cs.x - t2 * cs.y);
                        }
                    }
                    st_bf4(qd + 16 * nt, v);
                }
            }
        } else {
            const int uu = u - UQ;
            const int tm = uu >> 3, hh = uu & 7;
            const int m0 = tm * 128;
            f32x4 acc[8][2];
            float ssq[2] = {0.f, 0.f};
#pragma unroll
            for (int i = 0; i < 8; ++i) { acc[i][0] = (f32x4){0.f, 0.f, 0.f, 0.f}; acc[i][1] = (f32x4){0.f, 0.f, 0.f, 0.f}; }
            gemm_rows_acc<8>(acc, ssq, p.Pa + PA_CKV, PA_W, p.Wt_ukv, 256, 256, m0, hh * 128, smem);
#pragma unroll
            for (int mt = 0; mt < 2; ++mt) {
                const int ml = 32 * w + 16 * mt + l15;
                const int r = m0 + ml;
                int b, pos, t = 0; const bool lat = (r >= NCTX);
                if (!lat) { b = r >> 8; pos = r & 255; }
                else { const int rl = r - NCTX; b = rl >> 11; t = rl & 2047; pos = CTXL + t; }
                const float rs = rsqrtf(ssq[mt] * (1.f / 256.f) + EPSF);
                const u32x4 krw = *(const u32x4*)(p.Pa + (size_t)r * PA_W + PA_KR + 8 * lq);
                float kr[8];
#pragma unroll
                for (int e = 0; e < 4; ++e) { kr[2 * e] = __uint_as_float(krw[e] << 16); kr[2 * e + 1] = __uint_as_float(krw[e] & 0xffff0000u); }
                float hs = 0.f;
#pragma unroll
                for (int e = 0; e < 8; ++e) hs += kr[e] * kr[e];
#pragma unroll
                for (int nt = 0; nt < 4; ++nt)
#pragma unroll
                    for (int e = 0; e < 4; ++e) { const float v = acc[nt][mt][e] * rs; acc[nt][mt][e] = v; hs += v * v; }
                hs = xrow_sum(hs);
                const float hr = rsqrtf(hs * (1.f / 96.f) + EPSF);
                bf16_t* kd = p.Kb + ((size_t)((b * 8 + hh) * TPB + pos)) * 96;
#pragma unroll
                for (int nt = 0; nt < 4; ++nt) {
                    const f32x4 wv = *(const f32x4*)(s_khn + 16 * nt + 4 * lq);
                    f32x4 v;
#pragma unroll
                    for (int e = 0; e < 4; ++e) v[e] = acc[nt][mt][e] * hr * wv[e];
                    st_bf4(kd + 16 * nt + 4 * lq, v);
                }
                {
                    const int ph = lq & 1;
                    const int rp = (lq >> 1) ? (t & 63) : (t >> 6);
                    float o[8];
#pragma unroll
                    for (int e = 0; e < 8; ++e) {
                        const float v = kr[e] * hr * s_khn[64 + 8 * lq + e];
                        const float partner = __shfl_xor(v, 16);
                        float2 cs = make_float2(1.f, 0.f);
                        if (lat) cs = *(const float2*)(s_rope + 2 * (rp * 8 + e));
                        const float t1 = ph ? partner : v, t2 = ph ? v : partner;
                        o[e] = ph ? (t1 * cs.y + t2 * cs.x) : (t1 * cs.x - t2 * cs.y);
                    }
                    u32x4 ov;
                    ov[0] = pack_bf2(o[0], o[1]); ov[1] = pack_bf2(o[2], o[3]); ov[2] = pack_bf2(o[4], o[5]); ov[3] = pack_bf2(o[6], o[7]);
                    *(u32x4*)(kd + 64 + 8 * lq) = ov;
                }
                {
                    const int kpos = (pos & ~12) | ((pos & 4) << 1) | ((pos & 8) >> 1);
                    bf16_t* vd = p.Vt + (size_t)((b * 8 + hh) * 64) * TPB + kpos;
#pragma unroll
                    for (int nt = 4; nt < 8; ++nt)
#pragma unroll
                        for (int e = 0; e < 4; ++e) vd[(size_t)(16 * (nt - 4) + 4 * lq + e) * TPB] = f2bf(acc[nt][mt][e] * rs);
                }
            }
        }
    }
}

typedef float f32x16 __attribute__((ext_vector_type(16)));
#define ATT_THR 6.0f
#define ATT_KROW 208
#define ATT_VROW 144
#define ATT_KBYTES (64 * ATT_KROW)
#define ATT_STAGE (ATT_KBYTES + 64 * ATT_VROW)
__device__ __forceinline__ void ph_attn(const Params& p, int bid, int nb, char* smem) {
    const int tid = threadIdx.x, lane = tid & 63, w = tid >> 6, r = lane & 31, h = lane >> 5;
    int u;
    for (int it = 0; next_unit(it, 1024, bid, nb, u); ++it) {
        const int bh = u >> 4, qb = u & 15;
        bf16x8 qf[6];
        {
            const bf16_t* Qp = p.Qb + ((size_t)bh * SEQ + qb * 128 + w * 32 + r) * 96 + h * 8;
#pragma unroll
            for (int s = 0; s < 6; ++s) qf[s] = *(const bf16x8*)(Qp + s * 16);
        }
        const bf16_t* Kg = p.Kb + (size_t)bh * TPB * 96 + tid * 8;
        const bf16_t* Vg = p.Vt + (size_t)bh * 64 * TPB + (size_t)(tid >> 3) * TPB + (tid & 7) * 8;
        int koff[3], voff[2];
#pragma unroll
        for (int i = 0; i < 3; ++i) { const int c = tid + 256 * i; koff[i] = (c / 12) * ATT_KROW + (c % 12) * 16; }
#pragma unroll
        for (int i = 0; i < 2; ++i) { const int c = tid + 256 * i; voff[i] = ATT_KBYTES + (c >> 3) * ATT_VROW + (c & 7) * 16; }
        u32x4 rk[3], rv[2];
#pragma unroll
        for (int i = 0; i < 3; ++i) rk[i] = *(const u32x4*)(Kg + i * 2048);
#pragma unroll
        for (int i = 0; i < 2; ++i) rv[i] = *(const u32x4*)(Vg + (size_t)(32 * i) * TPB);
#pragma unroll
        for (int i = 0; i < 3; ++i) *(u32x4*)(smem + koff[i]) = rk[i];
#pragma unroll
        for (int i = 0; i < 2; ++i) *(u32x4*)(smem + voff[i]) = rv[i];
        __syncthreads();
        f32x16 o0, o1;
#pragma unroll
        for (int i = 0; i < 16; ++i) { o0[i] = 0.f; o1[i] = 0.f; }
        float m = 0.f, l = 0.f;
        int NKT = TPB / 64;
        asm volatile("" : "+s"(NKT));
        for (int kt = 0; kt < NKT; ++kt) {
            if (kt + 1 < NKT) {
#pragma unroll
                for (int i = 0; i < 3; ++i) rk[i] = *(const u32x4*)(Kg + (size_t)(kt + 1) * 6144 + i * 2048);
#pragma unroll
                for (int i = 0; i < 2; ++i) rv[i] = *(const u32x4*)(Vg + (size_t)(32 * i) * TPB + (kt + 1) * 64);
            }
            const char* sk = smem + (kt & 1) * ATT_STAGE;
            const char* sv = sk + ATT_KBYTES;
            f32x16 s0, s1;
            {
                const float c0 = -m;
#pragma unroll
                for (int i = 0; i < 16; ++i) { s0[i] = c0; s1[i] = c0; }
            }
#pragma unroll
            for (int s = 0; s < 6; ++s) {
                const bf16x8 k0 = *(const bf16x8*)(sk + r * ATT_KROW + (2 * s + h) * 16);
                const bf16x8 k1 = *(const bf16x8*)(sk + (32 + r) * ATT_KROW + (2 * s + h) * 16);
                s0 = __builtin_amdgcn_mfma_f32_32x32x16_bf16(k0, qf[s], s0, 0, 0, 0);
                s1 = __builtin_amdgcn_mfma_f32_32x32x16_bf16(k1, qf[s], s1, 0, 0, 0);
            }
            float mx = fmaxf(s0[0], s1[0]);
#pragma unroll
            for (int i = 1; i < 16; ++i) mx = fmaxf(mx, fmaxf(s0[i], s1[i]));
            mx = fmaxf(mx, __shfl_xor(mx, 32));
            if (kt == 0 || __any(mx > ATT_THR)) {
                const float delta = (kt == 0) ? mx : fmaxf(mx, 0.f);
                const float alpha = (kt == 0) ? 1.f : __builtin_amdgcn_exp2f(-delta);
                m += delta;
                l *= alpha;
#pragma unroll
                for (int i = 0; i < 16; ++i) { o0[i] *= alpha; o1[i] *= alpha; s0[i] -= delta; s1[i] -= delta; }
            }
            float ls = 0.f;
#pragma unroll
            for (int i = 0; i < 16; ++i) {
                s0[i] = __builtin_amdgcn_exp2f(s0[i]);
                s1[i] = __builtin_amdgcn_exp2f(s1[i]);
                ls += s0[i] + s1[i];
            }
            l += ls;
#pragma unroll
            for (int ks = 0; ks < 4; ++ks) {
                u32x4 pw;
                if (ks < 2) {
                    pw[0] = pack_bf2(s0[8 * (ks & 1) + 0], s0[8 * (ks & 1) + 1]); pw[1] = pack_bf2(s0[8 * (ks & 1) + 2], s0[8 * (ks & 1) + 3]);
                    pw[2] = pack_bf2(s0[8 * (ks & 1) + 4], s0[8 * (ks & 1) + 5]); pw[3] = pack_bf2(s0[8 * (ks & 1) + 6], s0[8 * (ks & 1) + 7]);
                } else {
                    pw[0] = pack_bf2(s1[8 * (ks & 1) + 0], s1[8 * (ks & 1) + 1]); pw[1] = pack_bf2(s1[8 * (ks & 1) + 2], s1[8 * (ks & 1) + 3]);
                    pw[2] = pack_bf2(s1[8 * (ks & 1) + 4], s1[8 * (ks & 1) + 5]); pw[3] = pack_bf2(s1[8 * (ks & 1) + 6], s1[8 * (ks & 1) + 7]);
                }
                const bf16x8 pf = __builtin_bit_cast(bf16x8, pw);
                const bf16x8 v0 = *(const bf16x8*)(sv + r * ATT_VROW + (2 * ks + h) * 16);
                const bf16x8 v1 = *(const bf16x8*)(sv + (32 + r) * ATT_VROW + (2 * ks + h) * 16);
                o0 = __builtin_amdgcn_mfma_f32_32x32x16_bf16(v0, pf, o0, 0, 0, 0);
                o1 = __builtin_amdgcn_mfma_f32_32x32x16_bf16(v1, pf, o1, 0, 0, 0);
            }
            if (kt + 1 < NKT) {
                char* ds = smem + ((kt + 1) & 1) * ATT_STAGE;
#pragma unroll
                for (int i = 0; i < 3; ++i) *(u32x4*)(ds + koff[i]) = rk[i];
#pragma unroll
                for (int i = 0; i < 2; ++i) *(u32x4*)(ds + voff[i]) = rv[i];
            }
            __syncthreads();
        }
        l += __shfl_xor(l, 32);
        const float inv = 1.f / l;
        const int b = bh >> 3, hh = bh & 7;
        bf16_t* op = p.o_mla + ((size_t)(b * SEQ + qb * 128 + w * 32 + r)) * 512 + hh * 64 + 4 * h;
#pragma unroll
        for (int g = 0; g < 4; ++g) {
            uint2 a, c;
            a.x = pack_bf2(o0[4 * g + 0] * inv, o0[4 * g + 1] * inv); a.y = pack_bf2(o0[4 * g + 2] * inv, o0[4 * g + 3] * inv);
            c.x = pack_bf2(o1[4 * g + 0] * inv, o1[4 * g + 1] * inv); c.y = pack_bf2(o1[4 * g + 2] * inv, o1[4 * g + 3] * inv);
            *(uint2*)(op + 8 * g) = a;
            *(uint2*)(op + 32 + 8 * g) = c;
        }
    }
}

__device__ __forceinline__ int el_off(int row, int col) { return lds_off(row, col >> 3) + (col & 7) * 2; }

__device__ __forceinline__ void mm64(f32x4 (&acc)[4], const char* A, int arow0, const char* B, int l15, int lq) {
#pragma unroll
    for (int ks = 0; ks < 2; ++ks) {
        const bf16x8 a = *(const bf16x8*)(A + lds_off(arow0 + l15, ks * 4 + lq));
#pragma unroll
        for (int nt = 0; nt < 4; ++nt) {
            const bf16x8 b = *(const bf16x8*)(B + lds_off(nt * 16 + l15, ks * 4 + lq));
            acc[nt] = __builtin_amdgcn_mfma_f32_16x16x32_bf16(a, b, acc[nt], 0, 0, 0);
        }
    }
}
__device__ __forceinline__ void acc4_zero(f32x4 (&a)[4]) {
#pragma unroll
    for (int i = 0; i < 4; ++i) a[i] = (f32x4){0.f, 0.f, 0.f, 0.f};
}

#define DN_SQ 0
#define DN_SK 8192
#define DN_SV 16384
#define DN_LSTR 65
#define DN_LBYTES (64 * DN_LSTR * 4)
#define DN_SL 24576
#define DN_SA 57856
#define DN_SKD 66048
#define DN_SS 74240

typedef short s16x4 __attribute__((ext_vector_type(4)));
__device__ __forceinline__ s16x4 ds_tr(const char* p) { return __builtin_amdgcn_ds_read_tr16_b64_v4i16((LAS s16x4*)p); }

struct Dn1In { u32x4 rp[7]; float db, da, dtb, alog; float cw[4]; };
__device__ __forceinline__ void dn1_fetch(Dn1In& in, const Params& p, int u, int tid) {
    const int bh = u / 36, pb = u % 36, b = bh >> 3, h = bh & 7;
    int rowbase, seglen, lb;
    if (pb < 4) { rowbase = b * CTXL; seglen = CTXL; lb = pb; }
    else { rowbase = NCTX + b * SEQ; seglen = SEQ; lb = pb - 4; }
#pragma unroll
    for (int i = 0; i < 7; ++i) {
        const int c = tid + NTHR * i;
        const int g = c / 544, rem = c % 544, rr = rem >> 3, ch = rem & 7;
        const int lp = lb * 64 - 2 + rr;
        u32x4 val = (u32x4){0u, 0u, 0u, 0u};
        if (c < 3 * 68 * 8 && lp >= 0 && lp < seglen) val = *(const u32x4*)(p.Pa + (size_t)(rowbase + lp) * PA_W + PA_DQ + h * 192 + g * 64 + ch * 8);
        in.rp[i] = val;
    }
#pragma unroll
    for (int i = 0; i < 4; ++i) {
        const int idx = tid + NTHR * i, g = idx / 320, j = (idx % 320) >> 6, c = idx & 63;
        in.cw[i] = (idx < 960) ? p.conv_w[j * 1536 + g * 512 + h * 64 + c] : 0.f;
    }
    in.db = 0.f; in.da = 0.f; in.dtb = 0.f; in.alog = 0.f;
    if (tid < 128) {
        in.dtb = p.dt_bias[(tid >> 6) * 8 + h]; in.alog = p.a_log[(tid >> 6) * 8 + h];
        const int d = tid >> 6, tp = tid & 63;
        const int pos = d ? 63 - tp : tp;
        const bf16_t* row = p.Pa + (size_t)(rowbase + lb * 64 + pos) * PA_W;
        in.db = bf2f(row[PA_DB + d * 8 + h]);
        in.da = bf2f(row[PA_DA + d * 8 + h]);
    }
}

__device__ __forceinline__ void ph_dn1(const Params& p, int bid, int nb, char* smem) {
    char* sQ = smem + DN_SQ; char* sK = smem + DN_SK; char* sV = smem + DN_SV;
    char* sL = smem + DN_SL; char* sA = smem + DN_SA; char* sKd = smem + DN_SKD;
    float* sS = (float*)(smem + DN_SS);
    const int x_ = bid & 7, li_ = bid >> 3, per_ = nb >> 3;
#define DN1_UNIT(IT, U, VALID) do { const int q_ = li_ + (IT) * per_; const int grp_ = x_ + 8 * (q_ >> 3); VALID = (grp_ < 8 * 36); \
        const int b_ = grp_ / 36, pb_ = grp_ % 36; U = (b_ * 8 + (q_ & 7)) * 36 + pb_; } while (0)
    Dn1In in;
    int u, un; bool valid, validn;
    DN1_UNIT(0, u, valid);
    if (valid) dn1_fetch(in, p, u, threadIdx.x);
    for (int it = 0; valid; ++it, u = un, valid = validn) {
        DN1_UNIT(it + 1, un, validn);
        int tid = threadIdx.x;
        asm volatile("" : "+v"(tid));
        const int lane = tid & 63, w = tid >> 6, l15 = lane & 15, lq = lane >> 4;
        const int bh = u / 36, pb = u % 36, h = bh & 7;
        const bool lat = (pb >= 4);
        if (tid < 128) {
            const int d = tid >> 6, tp = lane;
            const float xx = in.da + in.dtb;
            const float sp = (xx > 20.f) ? xx : log1pf(__expf(xx));
            const float g = -__expf(in.alog) * sp;
            float gc = g;
#pragma unroll
            for (int o = 1; o < 64; o <<= 1) { const float t = __shfl_up(gc, o); if (lane >= o) gc += t; }
            const float gl = __shfl(gc, 63);
            const float bt = sigmoid_f(in.db), eg = __expf(gc);
            sS[(d * 5 + 0) * 64 + tp] = bt;
            sS[(d * 5 + 1) * 64 + tp] = gc;
            sS[(d * 5 + 2) * 64 + tp] = eg;
            sS[(d * 5 + 3) * 64 + tp] = __expf(gl - gc);
            sS[(d * 5 + 4) * 64 + tp] = bt * eg;
        }
        {
            char* raw = sL;
#pragma unroll
            for (int i = 0; i < 7; ++i) {
                const int c = tid + NTHR * i;
                const int g = c / 544, rem = c % 544, rr = rem >> 3, ch = rem & 7;
                if (c < 3 * 68 * 8) *(u32x4*)(raw + (g * 68 + rr) * 128 + ch * 16) = in.rp[i];
            }
            float* cwS = (float*)(sL + 26112);
#pragma unroll
            for (int i = 0; i < 4; ++i) { const int idx = tid + NTHR * i; if (idx < 960) cwS[idx] = in.cw[i]; }
            if (validn) dn1_fetch(in, p, un, tid);
            __syncthreads();
            const int o = tid & 7, r0 = tid >> 3;
#pragma unroll
            for (int g = 0; g < 3; ++g) {
                if (g == 0 && !lat) continue;
                float wj[5][8];
#pragma unroll
                for (int j = 0; j < 5; ++j) {
                    const f32x4 w0 = *(const f32x4*)(cwS + (g * 5 + j) * 64 + 8 * o), w1 = *(const f32x4*)(cwS + (g * 5 + j) * 64 + 8 * o + 4);
#pragma unroll
                    for (int e2 = 0; e2 < 4; ++e2) { wj[j][e2] = w0[e2]; wj[j][4 + e2] = w1[e2]; }
                }
#pragma unroll
                for (int hh = 0; hh < 2; ++hh) {
                    const int rr = r0 + 32 * hh;
                    float a[8];
#pragma unroll
                    for (int e2 = 0; e2 < 8; ++e2) a[e2] = 0.f;
#pragma unroll
                    for (int j = 0; j < 5; ++j) {
                        const u32x4 dv = *(const u32x4*)(raw + (g * 68 + rr + j) * 128 + o * 16);
#pragma unroll
                        for (int e2 = 0; e2 < 4; ++e2) {
                            a[2 * e2] += __uint_as_float(dv[e2] << 16) * wj[j][2 * e2];
                            a[2 * e2 + 1] += __uint_as_float(dv[e2] & 0xffff0000u) * wj[j][2 * e2 + 1];
                        }
                    }
                    float ss = 0.f;
#pragma unroll
                    for (int e2 = 0; e2 < 8; ++e2) { a[e2] = silu_f(a[e2]); ss += a[e2] * a[e2]; }
                    float sc = 1.f;
                    if (g < 2) {
                        ss += dpp_mov<0xB1>(ss); ss += dpp_mov<0x4E>(ss); ss += dpp_mov<0x141>(ss);
                        sc = rsqrtf(ss + EPSF) * (g == 0 ? 0.125f : 1.f);
                    }
                    u32x4 ov;
#pragma unroll
                    for (int e2 = 0; e2 < 4; ++e2) ov[e2] = pack_bf2(a[2 * e2] * sc, a[2 * e2 + 1] * sc);
                    *(u32x4*)((g == 0 ? sQ : g == 1 ? sK : sV) + lds_off(rr, o)) = ov;
                }
            }
            __syncthreads();
        }
        {
            f32x4 G[4];
            acc4_zero(G);
            mm64(G, sK, 16 * w, sK, l15, lq);
            float* L0 = (float*)sL; float* L1 = (float*)(sL + DN_LBYTES);
            const float* be0 = sS + 0 * 64; const float* gc0 = sS + 1 * 64;
            const float* be1 = sS + 5 * 64; const float* gc1 = sS + 6 * 64;
#pragma unroll
            for (int nt = 0; nt < 4; ++nt)
#pragma unroll
                for (int rg = 0; rg < 4; ++rg) {
                    const int t = 16 * w + 4 * lq + rg, s = 16 * nt + l15;
                    const float gv = G[nt][rg];
                    const int tp = 63 - t, sp = 63 - s;
                    L0[t * DN_LSTR + s] = (s < t) ? be0[t] * gv * __expf(gc0[t] - gc0[s]) : 0.f;
                    L1[tp * DN_LSTR + sp] = (s > t) ? be1[tp] * gv * __expf(gc1[tp] - gc1[sp]) : 0.f;
                }
            __syncthreads();
        }
        {
            int tid3 = tid;
            asm volatile("" : "+v"(tid3) :: "memory");
            const int lane3 = tid3 & 63, w3 = tid3 >> 6, l15c = lane3 & 15, lqc = lane3 >> 4;
            if (tid3 < 128) {
                float* Lb = (float*)(sL + w3 * DN_LBYTES) + (16 * lqc) * DN_LSTR + 16 * lqc;
                float x[16];
#pragma unroll
                for (int i = 0; i < 16; ++i) {
                    float v = (i == l15c) ? 1.f : 0.f;
#pragma unroll
                    for (int j = 0; j < i; ++j) v -= Lb[i * DN_LSTR + j] * x[j];
                    x[i] = v;
                }
#pragma unroll
                for (int i = 0; i < 16; ++i) Lb[i * DN_LSTR + l15c] = x[i];
            }
            __syncthreads();
            {
                const int d = w3 >> 1, pr = w3 & 1, b0 = 2 * pr, b1 = 2 * pr + 1;
                float* Ld = (float*)(sL + d * DN_LBYTES);
                float* scr = (float*)(sA) + w3 * 272;
                f32x4 P = (f32x4){0.f, 0.f, 0.f, 0.f};
#pragma unroll
                for (int kk = 0; kk < 4; ++kk)
                    P = __builtin_amdgcn_mfma_f32_16x16x4f32(Ld[(16 * b1 + l15c) * DN_LSTR + 16 * b0 + 4 * kk + lqc],
                                                            Ld[(16 * b0 + 4 * kk + lqc) * DN_LSTR + 16 * b0 + l15c], P, 0, 0, 0);
#pragma unroll
                for (int rg = 0; rg < 4; ++rg) scr[(4 * lqc + rg) * 17 + l15c] = P[rg];
                f32x4 R = (f32x4){0.f, 0.f, 0.f, 0.f};
#pragma unroll
                for (int kk = 0; kk < 4; ++kk)
                    R = __builtin_amdgcn_mfma_f32_16x16x4f32(Ld[(16 * b1 + l15c) * DN_LSTR + 16 * b1 + 4 * kk + lqc],
                                                            scr[(4 * kk + lqc) * 17 + l15c], R, 0, 0, 0);
#pragma unroll
                for (int rg = 0; rg < 4; ++rg) Ld[(16 * b1 + 4 * lqc + rg) * DN_LSTR + 16 * b0 + l15c] = -R[rg];
            }
            __syncthreads();
            {
                const int d = w3 >> 1, hf = w3 & 1;
                float* Ld = (float*)(sL + d * DN_LBYTES);
                float* scr2 = (float*)(d ? sKd : sA);
                f32x4 P2[2];
                P2[0] = (f32x4){0.f, 0.f, 0.f, 0.f}; P2[1] = (f32x4){0.f, 0.f, 0.f, 0.f};
#pragma unroll
                for (int kk = 0; kk < 8; ++kk) {
                    const float a = Ld[(32 + 16 * hf + l15c) * DN_LSTR + 4 * kk + lqc];
#pragma unroll
                    for (int n2 = 0; n2 < 2; ++n2)
                        P2[n2] = __builtin_amdgcn_mfma_f32_16x16x4f32(a, Ld[(4 * kk + lqc) * DN_LSTR + 16 * n2 + l15c], P2[n2], 0, 0, 0);
                }
#pragma unroll
                for (int n2 = 0; n2 < 2; ++n2)
#pragma unroll
                    for (int rg = 0; rg < 4; ++rg) scr2[(16 * hf + 4 * lqc + rg) * 33 + 16 * n2 + l15c] = P2[n2][rg];
                __syncthreads();
                f32x4 R2[2];
                R2[0] = (f32x4){0.f, 0.f, 0.f, 0.f}; R2[1] = (f32x4){0.f, 0.f, 0.f, 0.f};
#pragma unroll
                for (int kk = 0; kk < 8; ++kk) {
                    const float a = Ld[(32 + 16 * hf + l15c) * DN_LSTR + 32 + 4 * kk + lqc];
#pragma unroll
                    for (int n2 = 0; n2 < 2; ++n2)
                        R2[n2] = __builtin_amdgcn_mfma_f32_16x16x4f32(a, scr2[(4 * kk + lqc) * 33 + 16 * n2 + l15c], R2[n2], 0, 0, 0);
                }
#pragma unroll
                for (int n2 = 0; n2 < 2; ++n2)
#pragma unroll
                    for (int rg = 0; rg < 4; ++rg) Ld[(32 + 16 * hf + 4 * lqc + rg) * DN_LSTR + 16 * n2 + l15c] = -R2[n2][rg];
            }
            __syncthreads();
#pragma unroll 1
            for (int d = 0; d < 2; ++d) {
                const float* Td = (const float*)(sL + d * DN_LBYTES);
                {
                    const int tr = tid3 >> 2, cq = tid3 & 3;
                    const float* c1 = sS + (d * 5 + 0) * 64 + 16 * cq;
                    const float* c2 = sS + (d * 5 + 4) * 64 + 16 * cq;
                    const float* trow = Td + tr * DN_LSTR + 16 * cq;
                    float tv[16];
#pragma unroll
                    for (int e2 = 0; e2 < 16; ++e2) tv[e2] = trow[e2];
#pragma unroll
                    for (int q = 0; q < 2; ++q) {
                        u32x4 o1, o2;
#pragma unroll
                        for (int e2 = 0; e2 < 4; ++e2) {
                            const int i0 = 8 * q + 2 * e2;
                            o1[e2] = pack_bf2(tv[i0] * c1[i0], tv[i0 + 1] * c1[i0 + 1]);
                            o2[e2] = pack_bf2(tv[i0] * c2[i0], tv[i0 + 1] * c2[i0 + 1]);
                        }
                        *(u32x4*)(sA + lds_off(tr, 2 * cq + q)) = o1;
                        *(u32x4*)(sKd + lds_off(tr, 2 * cq + q)) = o2;
                    }
                }
                __syncthreads();
                f32x4 U[4], W[4];
                acc4_zero(U); acc4_zero(W);
                {
#pragma unroll
                    for (int ks = 0; ks < 2; ++ks) {
                        const bf16x8 a1 = *(const bf16x8*)(sA + lds_off(16 * w3 + l15c, ks * 4 + lqc));
                        const bf16x8 a2 = *(const bf16x8*)(sKd + lds_off(16 * w3 + l15c, ks * 4 + lqc));
                        const int r0 = 32 * ks + 8 * lqc + (l15c >> 2);
                        const int p0 = d ? 63 - r0 : r0, p1 = d ? 63 - (r0 + 4) : (r0 + 4);
#pragma unroll
                        for (int nt = 0; nt < 4; ++nt) {
                            const int col = 16 * nt + 4 * (l15c & 3);
                            const s16x4 v0 = ds_tr(sV + el_off(p0, col)), v1 = ds_tr(sV + el_off(p1, col));
                            const s16x4 k0 = ds_tr(sK + el_off(p0, col)), k1 = ds_tr(sK + el_off(p1, col));
                            U[nt] = __builtin_amdgcn_mfma_f32_16x16x32_bf16(a1, __builtin_shufflevector(v0, v1, 0, 1, 2, 3, 4, 5, 6, 7), U[nt], 0, 0, 0);
                            W[nt] = __builtin_amdgcn_mfma_f32_16x16x32_bf16(a2, __builtin_shufflevector(k0, k1, 0, 1, 2, 3, 4, 5, 6, 7), W[nt], 0, 0, 0);
                        }
                    }
                }
                __syncthreads();
                {
                    char* uT = sL + d * DN_LBYTES;
                    char* wT = uT + 8192;
                    const int t0 = 16 * w3 + 4 * lqc;
#pragma unroll
                    for (int nt = 0; nt < 4; ++nt) {
                        uint2 ou, ow;
                        ou.x = pack_bf2(U[nt][0], U[nt][1]); ou.y = pack_bf2(U[nt][2], U[nt][3]);
                        ow.x = pack_bf2(W[nt][0], W[nt][1]); ow.y = pack_bf2(W[nt][2], W[nt][3]);
                        *(uint2*)(uT + el_off(16 * nt + l15c, t0)) = ou;
                        *(uint2*)(wT + el_off(16 * nt + l15c, t0)) = ow;
                    }
                }
                __syncthreads();
            }
        }
        int tid5 = tid;
        asm volatile("" : "+v"(tid5) :: "memory");
        const int lane5 = tid5 & 63, w5 = tid5 >> 6, l15_5 = lane5 & 15, lq5 = lane5 >> 4;
        f32x4 QK[4];
        acc4_zero(QK);
        mm64(QK, sQ, 16 * w5, sK, l15_5, lq5);
#pragma unroll 1
        for (int d = 0; d < 2; ++d) {
            const float* gcd = sS + (d * 5 + 1) * 64;
            const float* egd = sS + (d * 5 + 2) * 64;
            const float* ekd = sS + (d * 5 + 3) * 64;
            {
                const int i = lane5, tq = w5;
                float kv[16];
#pragma unroll
                for (int e = 0; e < 16; ++e) {
                    const int tp = tq * 16 + e, pos = d ? 63 - tp : tp;
                    kv[e] = bf2f(*(const bf16_t*)(sK + el_off(pos, i))) * ekd[tp];
                }
#pragma unroll
                for (int q = 0; q < 2; ++q) {
                    u32x4 o;
                    o[0] = pack_bf2(kv[8 * q + 0], kv[8 * q + 1]); o[1] = pack_bf2(kv[8 * q + 2], kv[8 * q + 3]);
                    o[2] = pack_bf2(kv[8 * q + 4], kv[8 * q + 5]); o[3] = pack_bf2(kv[8 * q + 6], kv[8 * q + 7]);
                    *(u32x4*)(sKd + lds_off(i, 2 * tq + q)) = o;
                }
            }
#pragma unroll
            for (int nt = 0; nt < 4; ++nt)
#pragma unroll
                for (int rg = 0; rg < 4; ++rg) {
                    const int t = 16 * w5 + 4 * lq5 + rg, s = 16 * nt + l15_5;
                    const int tp = d ? 63 - t : t, sp = d ? 63 - s : s;
                    const float val = (sp <= tp) ? QK[nt][rg] * __expf(gcd[tp] - gcd[sp]) : 0.f;
                    *(bf16_t*)(sA + el_off(tp, sp)) = f2bf(val);
                }
            __syncthreads();
            const char* uT = sL + d * DN_LBYTES;
            const char* wT = uT + 8192;
            const int cd = (d == 0) ? pb : (pb < 4 ? 3 - pb : 39 - pb);
            bf16_t* Mg = p.MH + ((size_t)((bh * 2 + d) * 36 + cd) * 2) * 4096;
            bf16_t* Hg = Mg + 4096;
            {
                f32x4 MT[4];
                acc4_zero(MT);
                mm64(MT, wT, 16 * w5, sKd, l15_5, lq5);
                const float egl = egd[63];
                const int j0 = 16 * w5 + 4 * lq5;
#pragma unroll
                for (int nt = 0; nt < 4; ++nt) {
                    const int i = 16 * nt + l15_5;
                    f32x4 o;
#pragma unroll
                    for (int e = 0; e < 4; ++e) o[e] = ((i == j0 + e) ? egl : 0.f) - MT[nt][e];
                    st_bf4(Mg + i * 64 + j0, o);
                }
            }
            {
                f32x4 HH[4];
                acc4_zero(HH);
                mm64(HH, sKd, 16 * w5, uT, l15_5, lq5);
                const int i0 = 16 * w5 + 4 * lq5;
#pragma unroll
                for (int nt = 0; nt < 4; ++nt) st_bf4(Hg + (16 * nt + l15_5) * 64 + i0, HH[nt]);
            }
            if (lat) {
                bf16_t* Eg = p.EF + ((size_t)((bh * 2 + d) * 32 + (pb - 4)) * 2) * 4096;
                bf16_t* Fg = Eg + 4096;
                {
                    f32x4 ET[4];
                    acc4_zero(ET);
                    mm64(ET, wT, 16 * w5, sA, l15_5, lq5);
                    const int j0 = 16 * w5 + 4 * lq5;
#pragma unroll
                    for (int nt = 0; nt < 4; ++nt) {
                        const int sp = 16 * nt + l15_5, spos = d ? 63 - sp : sp;
                        const f32x4 qv = ld_bf4((const bf16_t*)(sQ + el_off(spos, j0)));
                        const float eg = egd[sp];
                        f32x4 o;
#pragma unroll
                        for (int e = 0; e < 4; ++e) o[e] = qv[e] * eg - ET[nt][e];
                        st_bf4(Eg + spos * 64 + j0, o);
                    }
                }
                {
                    f32x4 FF[4];
                    acc4_zero(FF);
                    mm64(FF, uT, 16 * w5, sA, l15_5, lq5);
                    const int c0 = 16 * w5 + 4 * lq5;
#pragma unroll
                    for (int nt = 0; nt < 4; ++nt) {
                        const int sp = 16 * nt + l15_5, spos = d ? 63 - sp : sp;
                        st_bf4(Fg + spos * 64 + c0, FF[nt]);
                    }
                }
            }
            __syncthreads();
        }
    }
}

struct Dn2Frag { bf16x8 am[2]; uint2 hr[2]; };
__device__ __forceinline__ void dn2_load(Dn2Frag& f, const bf16_t* Mg, int w, int l15, int lq, int i0, int hf) {
#pragma unroll
    for (int ks = 0; ks < 2; ++ks) f.am[ks] = *(const bf16x8*)(Mg + (16 * w + l15) * 64 + ks * 32 + lq * 8);
#pragma unroll
    for (int n2 = 0; n2 < 2; ++n2) f.hr[n2] = *(const uint2*)(Mg + 4096 + (32 * hf + 16 * n2 + l15) * 64 + i0);
}
__device__ __forceinline__ void dn2_step(const Dn2Frag& f, int c, int d, int hf, bf16_t* STc, char* smem, int l15, int lq, int i0) {
    const char* sS = smem + (c & 1) * 4096;
    char* sN = smem + ((c + 1) & 1) * 4096;
    f32x4 acc[2];
#pragma unroll
    for (int n2 = 0; n2 < 2; ++n2)
        acc[n2] = (f32x4){__uint_as_float(f.hr[n2].x << 16), __uint_as_float(f.hr[n2].x & 0xffff0000u),
                          __uint_as_float(f.hr[n2].y << 16), __uint_as_float(f.hr[n2].y & 0xffff0000u)};
#pragma unroll
    for (int ks = 0; ks < 2; ++ks)
#pragma unroll
        for (int n2 = 0; n2 < 2; ++n2) {
            const bf16x8 bs = *(const bf16x8*)(sS + lds_off(16 * n2 + l15, ks * 4 + lq));
            acc[n2] = __builtin_amdgcn_mfma_f32_16x16x32_bf16(f.am[ks], bs, acc[n2], 0, 0, 0);
        }
    const int cn = c + 1;
    const bool st = (cn >= 4 && cn <= 35);
    const int pbi = (d == 0 ? cn : 39 - cn) - 4;
#pragma unroll
    for (int n2 = 0; n2 < 2; ++n2) {
        uint2 o; o.x = pack_bf2(acc[n2][0], acc[n2][1]); o.y = pack_bf2(acc[n2][2], acc[n2][3]);
        const int cl = 16 * n2 + l15;
        *(uint2*)(sN + el_off(cl, i0)) = o;
        if (st) *(uint2*)(STc + (size_t)pbi * 4096 + (32 * hf + cl) * 64 + i0) = o;
    }
    __syncthreads();
}
__device__ __forceinline__ void ph_dn2(const Params& p, int bid, int nb, char* smem) {
    if (bid >= 256) return;
    const int tid = threadIdx.x, lane = tid & 63, w = tid >> 6, l15 = lane & 15, lq = lane >> 4;
    const int chain = bid >> 1, hf = bid & 1, d = chain & 1;
    const bf16_t* MHc = p.MH + (size_t)chain * 36 * 2 * 4096;
    bf16_t* STc = p.ST + (size_t)chain * 32 * 4096;
    for (int i = tid; i < 4096 / 16; i += NTHR) *(u32x4*)(smem + i * 16) = (u32x4){0u, 0u, 0u, 0u};
    __syncthreads();
    const int i0 = 16 * w + 4 * lq;
    Dn2Frag f0, f1, f2, f3;
    dn2_load(f0, MHc + (size_t)0 * 8192, w, l15, lq, i0, hf);
    dn2_load(f1, MHc + (size_t)1 * 8192, w, l15, lq, i0, hf);
    dn2_load(f2, MHc + (size_t)2 * 8192, w, l15, lq, i0, hf);
    dn2_load(f3, MHc + (size_t)3 * 8192, w, l15, lq, i0, hf);
    for (int c0 = 0; c0 < 36; c0 += 4) {
        const bool more = (c0 + 4 < 36);
        dn2_step(f0, c0 + 0, d, hf, STc, smem, l15, lq, i0);
        if (more) dn2_load(f0, MHc + (size_t)(c0 + 4) * 8192, w, l15, lq, i0, hf);
        dn2_step(f1, c0 + 1, d, hf, STc, smem, l15, lq, i0);
        if (more) dn2_load(f1, MHc + (size_t)(c0 + 5) * 8192, w, l15, lq, i0, hf);
        dn2_step(f2, c0 + 2, d, hf, STc, smem, l15, lq, i0);
        if (more) dn2_load(f2, MHc + (size_t)(c0 + 6) * 8192, w, l15, lq, i0, hf);
        dn2_step(f3, c0 + 3, d, hf, STc, smem, l15, lq, i0);
        if (more) dn2_load(f3, MHc + (size_t)(c0 + 7) * 8192, w, l15, lq, i0, hf);
    }
}

__device__ __forceinline__ void ph_dn3(const Params& p, int bid, int nb, char* smem) {
    const int tid = threadIdx.x, lane = tid & 63, w = tid >> 6, l15 = lane & 15, lq = lane >> 4;
    const int srow = tid >> 3, sch = (tid & 7) ^ ((srow >> 1) & 7);
    LAS char* lbase = (LAS char*)smem + w * 1024;
#define DN3_STAGE(BUF, U_) do { const int bh_ = (U_) >> 5, pbi_ = (U_) & 31; \
        _Pragma("unroll") for (int d_ = 0; d_ < 2; ++d_) { \
            const bf16_t* Sg_ = p.ST + ((size_t)(bh_ * 2 + d_) * 32 + pbi_) * 4096 + (size_t)srow * 64 + sch * 8; \
            _Pragma("unroll") for (int i_ = 0; i_ < 2; ++i_) \
                __builtin_amdgcn_global_load_lds((const void*)(Sg_ + (size_t)(32 * i_) * 64), (LAS void*)(lbase + (BUF) * 16384 + d_ * 8192 + i_ * 4096), 16, 0, 0); } } while (0)
    int u = bid, buf = 0;
    if (u < 64 * 32) DN3_STAGE(0, u);
    for (; u < 64 * 32; u += nb, buf ^= 1) {
        const int bh = u >> 5, pbi = u & 31, b = bh >> 3, h = bh & 7;
        const int s = 16 * w + l15;
        const size_t rl = (size_t)b * SEQ + pbi * 64 + s;
        f32x4 zdv[4];
#pragma unroll
        for (int mt = 0; mt < 4; ++mt) zdv[mt] = ld_bf4(p.Pz + rl * PZ_W + 512 + h * 64 + 16 * mt + 4 * lq);
        f32x4 acc[4];
        acc4_zero(acc);
        bf16x8 be[2][2];
#pragma unroll
        for (int d = 0; d < 2; ++d) {
            const bf16_t* Eg = p.EF + ((size_t)((bh * 2 + d) * 32 + pbi) * 2) * 4096;
            const bf16_t* Fg = Eg + 4096;
#pragma unroll
            for (int mt = 0; mt < 4; ++mt) acc[mt] += ld_bf4(Fg + s * 64 + 16 * mt + 4 * lq);
#pragma unroll
            for (int ks = 0; ks < 2; ++ks) be[d][ks] = *(const bf16x8*)(Eg + s * 64 + ks * 32 + lq * 8);
        }
        __syncthreads();
        if (u + nb < 64 * 32) DN3_STAGE(buf ^ 1, u + nb);
#pragma unroll
        for (int d = 0; d < 2; ++d) {
            const char* sS = smem + buf * 16384 + d * 8192;
#pragma unroll
            for (int ks = 0; ks < 2; ++ks)
#pragma unroll
                for (int mt = 0; mt < 4; ++mt) {
                    const bf16x8 as = *(const bf16x8*)(sS + lds_off(16 * mt + l15, ks * 4 + lq));
                    acc[mt] = __builtin_amdgcn_mfma_f32_16x16x32_bf16(as, be[d][ks], acc[mt], 0, 0, 0);
                }
        }
        float ss = 0.f;
#pragma unroll
        for (int mt = 0; mt < 4; ++mt)
#pragma unroll
            for (int rg = 0; rg < 4; ++rg) ss += acc[mt][rg] * acc[mt][rg];
        ss = xrow_sum(ss);
        const float rstd = rsqrtf(ss * (1.f / 64.f) + EPSF);
#pragma unroll
        for (int mt = 0; mt < 4; ++mt) {
            const f32x4 nw = *(const f32x4*)(p.dn_norm_w + 16 * mt + 4 * lq);
            f32x4 o;
#pragma unroll
            for (int rg = 0; rg < 4; ++rg) o[rg] = acc[mt][rg] * rstd * nw[rg] * silu_f(zdv[mt][rg]);
            st_bf4(p.A_dn + rl * 512 + h * 64 + 16 * mt + 4 * lq, o);
        }
    }
#undef DN3_STAGE
    __syncthreads();
    for (size_t i = (size_t)bid * NTHR + tid; i < (size_t)NL * 64; i += (size_t)nb * NTHR) {
        const size_t rl = i >> 6; const int c8 = (int)(i & 63) * 8;
        const u32x4 ov = *(const u32x4*)(p.o_mla + rl * 512 + c8);
        const u32x4 zv = *(const u32x4*)(p.Pz + rl * PZ_W + c8);
        u32x4 r;
#pragma unroll
        for (int e = 0; e < 4; ++e) {
            const float o0 = __uint_as_float(ov[e] << 16), o1 = __uint_as_float(ov[e] & 0xffff0000u);
            const float z0 = __uint_as_float(zv[e] << 16), z1 = __uint_as_float(zv[e] & 0xffff0000u);
            r[e] = pack_bf2(o0 * silu_f(z0), o1 * silu_f(z1));
        }
        *(u32x4*)(p.A_mla + rl * 512 + c8) = r;
    }
}


__device__ __forceinline__ void ph_inproj(const Params& p, int bid, int nb, char* smem) {
    const int UA = 2 * 120 + 16 * 144, UZ = 128 * 8;
    const bf16_t* hl = p.h + (size_t)NCTX * DM;
    int u, tm, tn;
    for (int it = 0; next_unit(it, UA + UZ, bid, nb, u); ++it) {
        if (u < 240) { const int g = u / 120, r = u % 120; tm = g * 8 + (r & 7); tn = 3 + (r >> 3); gemm_store_bf16(p.h, DM, p.Wt_a, 1024, tm, tn, p.Pa, PA_W, smem); }
        else if (u < UA) { unit_mn(u - 240 + 288, 18, tm, tn); gemm_store_bf16(p.h, DM, p.Wt_a, 1024, tm, tn, p.Pa, PA_W, smem); }
        else { unit_mn(u - UA, 8, tm, tn); gemm_store_bf16(hl, DM, p.Wt_z, 1024, tm, tn, p.Pz, PZ_W, smem); }
    }
}

__device__ __forceinline__ void ph_gates(const Params& p, int bid, int nb, char* smem) {
    const bf16_t* hl = p.h + (size_t)NCTX * DM;
    int u, tm, tn;
    for (int it = 0; next_unit(it, 128 * 16, bid, nb, u); ++it) {
        unit_mn(u, 16, tm, tn);
        gemm_store_bf16(hl, DM, p.Wt_g, 1024, tm, tn, p.Pg, PG_W, smem);
    }
}

__device__ __forceinline__ void ph_merge(const Params& p, int bid, int nb, char* smem) {
    int u, tm, tn;
    for (int it = 0; next_unit(it, 128 * 8, bid, nb, u); ++it) {
        unit_mn(u, 8, tm, tn);
        const int m0 = tm * 128, n0 = tn * 128;
        f32x4 acc[4][4];
        uint2 mm[4][4];
        u32x4 gw[2][4];
        {
        EPI_COORDS_OPAQUE(p1)
#pragma unroll
        for (int j = 0; j < 2; ++j)
#pragma unroll
            for (int mt = 0; mt < 4; ++mt) gw[j][mt] = *(const u32x4*)(p.Pg + (size_t)EPI_ROW(mt) * PG_W + EPI_COL(2 * j));
        }
        acc_zero<4>(acc);
        gemm_tile_acc<4>(acc, p.A_mla, 512, p.Wt_mo, 512, 512, m0, n0, smem);
#pragma unroll
        for (int j = 0; j < 2; ++j)
#pragma unroll
            for (int mt = 0; mt < 4; ++mt) {
#pragma unroll
                for (int q = 0; q < 2; ++q) {
                    const int nt = 2 * j + q;
                    const float g0 = __uint_as_float(gw[j][mt][2 * q] << 16), g1 = __uint_as_float(gw[j][mt][2 * q] & 0xffff0000u);
                    const float g2 = __uint_as_float(gw[j][mt][2 * q + 1] << 16), g3 = __uint_as_float(gw[j][mt][2 * q + 1] & 0xffff0000u);
                    mm[nt][mt].x = pack_bf2(sigmoid_f(g0) * acc[nt][mt][0], sigmoid_f(g1) * acc[nt][mt][1]);
                    mm[nt][mt].y = pack_bf2(sigmoid_f(g2) * acc[nt][mt][2], sigmoid_f(g3) * acc[nt][mt][3]);
                }
            }
        {
        EPI_COORDS_OPAQUE(p2)
#pragma unroll
        for (int j = 0; j < 2; ++j)
#pragma unroll
            for (int mt = 0; mt < 4; ++mt) gw[j][mt] = *(const u32x4*)(p.Pg + (size_t)EPI_ROW(mt) * PG_W + 1024 + EPI_COL(2 * j));
        }
        acc_zero<4>(acc);
        gemm_tile_acc<4>(acc, p.A_dn, 512, p.Wt_do, 512, 512, m0, n0, smem);
        {
        EPI_COORDS_OPAQUE(b)
#pragma unroll
        for (int j = 0; j < 2; ++j)
#pragma unroll
            for (int mt = 0; mt < 4; ++mt) {
                u32x4 ov;
#pragma unroll
                for (int q = 0; q < 2; ++q) {
                    const int nt = 2 * j + q;
                    const float g0 = __uint_as_float(gw[j][mt][2 * q] << 16), g1 = __uint_as_float(gw[j][mt][2 * q] & 0xffff0000u);
                    const float g2 = __uint_as_float(gw[j][mt][2 * q + 1] << 16), g3 = __uint_as_float(gw[j][mt][2 * q + 1] & 0xffff0000u);
                    const float o0 = __uint_as_float(mm[nt][mt].x << 16) + sigmoid_f(g0) * acc[nt][mt][0];
                    const float o1 = __uint_as_float(mm[nt][mt].x & 0xffff0000u) + sigmoid_f(g1) * acc[nt][mt][1];
                    const float o2 = __uint_as_float(mm[nt][mt].y << 16) + sigmoid_f(g2) * acc[nt][mt][2];
                    const float o3 = __uint_as_float(mm[nt][mt].y & 0xffff0000u) + sigmoid_f(g3) * acc[nt][mt][3];
                    ov[2 * q] = pack_bf2(o0, o1); ov[2 * q + 1] = pack_bf2(o2, o3);
                }
                *(u32x4*)(p.Mb + (size_t)EPI_ROW(mt) * 1024 + EPI_COL(2 * j)) = ov;
            }
        }
    }
}

__device__ __forceinline__ void ph_out(const Params& p, int bid, int nb, char* smem) {
    int u, tm, tn;
    for (int it = 0; next_unit(it, 128 * 8, bid, nb, u); ++it) {
        unit_mn(u, 8, tm, tn);
        const int m0 = tm * 128, n0 = tn * 128;
        f32x4 acc[4][4], xv[4][4];
        EPI_COORDS
#pragma unroll
        for (int nt = 0; nt < 4; ++nt)
#pragma unroll
            for (int mt = 0; mt < 4; ++mt) xv[nt][mt] = *(const f32x4*)(p.x + (size_t)EPI_ROW(mt) * DM + EPI_COL(nt));
        const float* gp = p.mod + (m0 / SEQ) * 3072 + 2048;
        f32x4 gate[4];
#pragma unroll
        for (int nt = 0; nt < 4; ++nt) gate[nt] = *(const f32x4*)(gp + EPI_COL(nt));
        acc_zero<4>(acc);
        gemm_tile_acc<4>(acc, p.Mb, 1024, p.Wt_out, 1024, 1024, m0, n0, smem);
#pragma unroll
        for (int nt = 0; nt < 4; ++nt)
#pragma unroll
            for (int mt = 0; mt < 4; ++mt)
                *(f32x4*)(p.out + (size_t)EPI_ROW(mt) * DM + EPI_COL(nt)) = xv[nt][mt] + gate[nt] * acc[nt][mt];
    }
}

#define XB_TMO      128
#define XB_XCNT(j)  (256  + 64 * (j))
#define XB_XSUB(j)  (1280 + 64 * (j))
#define XB_XGEN(j)  (2304 + 64 * (j))
#define XB_TOP      3328
#define XB_TOPGEN   3392
#define XCD_BAR_WORDS 3456
#define XB_SPIN_CAP (1u << 20)
__device__ __forceinline__ unsigned xb_ld(unsigned* p)              { return __hip_atomic_load(p, __ATOMIC_RELAXED, __HIP_MEMORY_SCOPE_AGENT); }
__device__ __forceinline__ unsigned xb_add(unsigned* p, unsigned v) { return __hip_atomic_fetch_add(p, v, __ATOMIC_RELAXED, __HIP_MEMORY_SCOPE_AGENT); }
__device__ __forceinline__ unsigned xb_xcc_id() { return (unsigned)__builtin_amdgcn_s_getreg((3 << 11) | 20) & 0xFu; }
#define XB_SPIN(cond, bar) do { unsigned _sp = 0; while (cond) { __builtin_amdgcn_s_sleep(1); \
    if ((++_sp & 255u) == 0u) { if (xb_ld(&(bar)[XB_TMO])) break; if (_sp > XB_SPIN_CAP) { atomicAdd(&(bar)[XB_TMO], 1u); break; } } } } while (0)
struct XcdBarrier { unsigned* bar; unsigned x; volatile LAS unsigned* st; };
__device__ __forceinline__ XcdBarrier xcd_barrier_post(unsigned* bar, volatile LAS unsigned* st) {
    XcdBarrier b; b.bar = bar; b.x = xb_xcc_id(); b.st = st;
    if (threadIdx.x == 0) (void)xb_add(&bar[XB_XCNT(b.x)], 1u);
    return b;
}
__device__ __forceinline__ void xcd_barrier_complete(unsigned* bar, unsigned x, unsigned& nloc, unsigned& nx) {
    const unsigned G = gridDim.x * gridDim.y * gridDim.z;
    unsigned sum, cnt, mine, sp = 0u;
    for (;;) {
        sum = 0u; cnt = 0u; mine = 0u;
#pragma unroll
        for (unsigned j = 0; j < 16; ++j) { const unsigned c = xb_ld(&bar[XB_XCNT(j)]); sum += c; cnt += (c > 0u) ? 1u : 0u; mine = (j == x) ? c : mine; }
        if (sum == G) break;
        __builtin_amdgcn_s_sleep(1);
        if ((++sp & 255u) == 0u) { if (xb_ld(&bar[XB_TMO])) break; if (sp > XB_SPIN_CAP) { atomicAdd(&bar[XB_TMO], 1u); break; } }
    }
    nloc = mine > 0u ? mine : 1u; nx = cnt > 0u ? cnt : 1u;
}
__device__ __forceinline__ void xcd_barrier(const XcdBarrier& b) {
    asm volatile("s_waitcnt vmcnt(0)" ::: "memory");
    __syncthreads();
    if (threadIdx.x == 0) {
        unsigned* bar = b.bar;
        __builtin_amdgcn_s_waitcnt(0);
        unsigned nloc = b.st[0], nx = b.st[1];
        if (nloc == 0u) { xcd_barrier_complete(bar, b.x, nloc, nx); b.st[0] = nloc; b.st[1] = nx; }
        const unsigned old = xb_add(&bar[XB_XSUB(b.x)], 1u);
        const unsigned gen = old / nloc;
        if (old + 1u == (gen + 1u) * nloc) {
            __builtin_amdgcn_fence(__ATOMIC_RELEASE, "agent");
            asm volatile("s_waitcnt vmcnt(0)" ::: "memory");
            const unsigned og = xb_add(&bar[XB_TOP], 1u);
            const unsigned tg = og / nx;
            if (og + 1u == (tg + 1u) * nx) xb_add(&bar[XB_TOPGEN], 1u);
            else XB_SPIN(xb_ld(&bar[XB_TOPGEN]) == tg, bar);
            __builtin_amdgcn_fence(__ATOMIC_ACQUIRE, "agent");
            xb_add(&bar[XB_XGEN(b.x)], 1u);
            asm volatile("s_waitcnt vmcnt(0)" ::: "memory");
        } else {
            XB_SPIN(xb_ld(&bar[XB_XGEN(b.x)]) == gen, bar);
            __builtin_amdgcn_fence(__ATOMIC_ACQUIRE, "agent");
            asm volatile("s_waitcnt vmcnt(0)" ::: "memory");
        }
    }
    __syncthreads();
}

__global__ void __launch_bounds__(NTHR, 2) fwd_megakernel(Params p) {
    __shared__ __attribute__((aligned(16))) char smem[SMEM_BYTES];
    const int bid = blockIdx.x, nb = gridDim.x;
    volatile LAS unsigned* bst = (volatile LAS unsigned*)(smem + SMEM_BYTES - 16);
    if (threadIdx.x == 0) { bst[0] = 0u; bst[1] = 0u; }
    __syncthreads();
    const XcdBarrier xb = xcd_barrier_post(p.bar, bst);

    ph_mod(p, bid, nb, smem);
    ph_wprep(p, bid, nb, smem);
    xcd_barrier(xb);
    ph_norm(p, bid, nb, smem);
    xcd_barrier(xb);
    ph_inproj(p, bid, nb, smem);
    xcd_barrier(xb);
    ph_mla_proj(p, bid, nb, smem);
    xcd_barrier(xb);
    ph_attn(p, bid, nb, smem);
    xcd_barrier(xb);
    ph_dn1(p, bid, nb, smem);
    xcd_barrier(xb);
    ph_dn2(p, bid, nb, smem);
    xcd_barrier(xb);
    ph_dn3(p, bid, nb, smem);
    ph_gates(p, bid, nb, smem);
    xcd_barrier(xb);
    ph_merge(p, bid, nb, smem);
    xcd_barrier(xb);
    ph_out(p, bid, nb, smem);
}

extern "C" void kernel_launch(void* const* d_in, const int* in_sizes, int n_in,
                              void* d_out, int out_size, void* d_ws, size_t ws_size,
                              hipStream_t stream) {
    static int grid_blocks = 0;
    if (!grid_blocks) {
        int dev = 0, cus = 0, per_cu = 0;
        (void)hipGetDevice(&dev);
        (void)hipDeviceGetAttribute(&cus, hipDeviceAttributeMultiprocessorCount, dev);
        (void)hipOccupancyMaxActiveBlocksPerMultiprocessor(&per_cu, fwd_megakernel, NTHR, 0);
        if (per_cu > 2) per_cu = 2;
        if (per_cu < 1) per_cu = 1;
        grid_blocks = cus * per_cu;
    }
    if (n_in != 21 || ws_size < (size_t)268435456 || out_size != NL * DM) {
        fprintf(stderr, "kernel_launch: built for 21 inputs, a %d-float output and >= 256 MiB of workspace (got %d inputs, out %d, ws %zu)\n", NL * DM, n_in, out_size, ws_size);
        return;
    }
    Params p{};
    const float** fp = (const float**)&p;
    for (int i = 0; i < 21; ++i) fp[i] = (const float*)d_in[i];
    p.out = (float*)d_out;
    char* ws = (char*)d_ws;
    char* ob = (char*)d_out;
    const size_t R_W = 0;
    const size_t R_H = 16777216;
    const size_t R_Z = R_H + 37748736;
    const size_t R_A = R_Z + 33554432;
    const size_t R_F = R_A + 84934656;
    {
        size_t o = R_W;
        p.Wt_a = (bf16_t*)(ws + o); o += 4718592;
        p.Wt_z = (bf16_t*)(ws + o); o += 2097152;
        p.Wt_g = (bf16_t*)(ws + o); o += 4194304;
        p.Wt_uq = (bf16_t*)(ws + o); o += 589824;
        p.Wt_ukv = (bf16_t*)(ws + o); o += 524288;
        p.Wt_mo = (bf16_t*)(ws + o); o += 1048576;
        p.Wt_do = (bf16_t*)(ws + o); o += 1048576;
        p.Wt_out = (bf16_t*)(ws + o); o += 2097152;
        p.mod = (float*)(ws + o); o += 110592;
        p.bar = (unsigned*)(ws + o); o += XCD_BAR_WORDS * 4;
        p.rope = (float*)(ws + o); o += 4096;
    }
    p.h = (bf16_t*)(ws + R_H);
    p.Pz = (bf16_t*)(ws + R_Z);
    p.Pa = (bf16_t*)(ws + R_A);
    p.Qb = (bf16_t*)(ws + R_F + 22020096);
    p.Kb = (bf16_t*)(ws + R_F + 47185920);
    p.Vt = (bf16_t*)(ws + R_F + 75497472);
    p.o_mla = (bf16_t*)(ws + R_F);
    p.MH = (bf16_t*)(ws + R_F + 16777216);
    p.EF = (bf16_t*)(ob);
    p.ST = (bf16_t*)(ws + R_A);
    p.A_mla = (bf16_t*)(ws + R_A + 33554432);
    p.A_dn = (bf16_t*)(ws + R_A + 50331648);
    p.Pg = (bf16_t*)(ws + R_F + 16777216);
    p.Mb = (bf16_t*)(ws + R_H);
    (void)hipMemsetAsync(p.mod, 0, 110592 + XCD_BAR_WORDS * 4, stream);
    void* args[] = {&p};
    hipError_t err = hipLaunchCooperativeKernel((void*)fwd_megakernel, dim3(grid_blocks), dim3(NTHR), args, 0, stream);
    if (err != hipSuccess) fprintf(stderr, "cooperative launch failed: %s (grid %d)\n", hipGetErrorString(err), grid_blocks);
}
```

```cpp
#include <hip/hip_runtime.h>
#include <stdint.h>
#include <cstdio>

typedef uint16_t bf16_t;
#define LAS __attribute__((address_space(3)))

#define NB 8
#define SEQ 2048
#define CTXL 256
#define TPB 2304
#define NCTX 2048
#define NL 16384
#define NT 18432
#define DM 1024
#define IN_DIM 5312
#define PA_W 2304
#define PZ_W 1024
#define PG_W 2048
#define PA_CQ 0
#define PA_CKV 384
#define PA_KR 640
#define PA_DQ 672
#define PA_DK 1184
#define PA_DV 1696
#define PA_DB 2208
#define PA_DA 2224
#define EPSF 1e-6f
#define NTHR 256
#define SMEM_BYTES 77824

struct Params {
    const float *x, *c, *ctx, *c_ctx, *w_mod, *b_mod, *norm_w, *w_in, *q_norm_w, *w_uq, *kv_norm_w, *w_ukv, *qhn_w, *khn_w,
        *mla_w_o, *conv_w, *a_log, *dt_bias, *dn_norm_w, *dn_w_o, *w_out;
    float* out;
    bf16_t *h, *Pa, *Pz, *Pg, *Qb, *Vt, *Kb, *MH, *EF, *ST, *A_mla, *A_dn, *Mb;
    bf16_t *Wt_a, *Wt_z, *Wt_g, *Wt_uq, *Wt_ukv, *Wt_mo, *Wt_do, *Wt_out;
    float *mod, *rope;
    unsigned* bar;
};

typedef float f32x4 __attribute__((ext_vector_type(4)));
typedef unsigned u32x4 __attribute__((ext_vector_type(4)));
typedef __bf16 bf16v2_t __attribute__((ext_vector_type(2)));
typedef float f32x2 __attribute__((ext_vector_type(2)));
__device__ __forceinline__ uint32_t pack_bf2(float lo, float hi) {
    f32x2 v = {lo, hi};
    bf16v2_t b = __builtin_convertvector(v, bf16v2_t);
    return __builtin_bit_cast(uint32_t, b);
}
__device__ __forceinline__ void st_bf4(bf16_t* p, f32x4 v) {
    uint2 o; o.x = pack_bf2(v[0], v[1]); o.y = pack_bf2(v[2], v[3]);
    *(uint2*)p = o;
}
__device__ __forceinline__ float bf2f(bf16_t v) { return __uint_as_float(((uint32_t)v) << 16); }
__device__ __forceinline__ bf16_t f2bf(float f) {
    uint32_t u = __float_as_uint(f);
    u += 0x7fffu + ((u >> 16) & 1u);
    return (bf16_t)(u >> 16);
}
__device__ __forceinline__ float silu_f(float v) { return v * __builtin_amdgcn_rcpf(1.f + __expf(-v)); }
__device__ __forceinline__ float sigmoid_f(float v) { return __builtin_amdgcn_rcpf(1.f + __expf(-v)); }
template <int CTRL> __device__ __forceinline__ float dpp_mov(float v) {
    return __builtin_bit_cast(float, __builtin_amdgcn_update_dpp(0, __builtin_bit_cast(int, v), CTRL, 0xF, 0xF, true));
}
__device__ __forceinline__ float row16_sum(float v) {
    v += dpp_mov<0xB1>(v); v += dpp_mov<0x4E>(v); v += dpp_mov<0x141>(v); v += dpp_mov<0x140>(v); return v;
}
__device__ __forceinline__ float rdlane(float v, int l) { return __builtin_bit_cast(float, __builtin_amdgcn_readlane(__builtin_bit_cast(int, v), l)); }
__device__ __forceinline__ float wave_sum(float v) {
    v += dpp_mov<0xB1>(v);
    v += dpp_mov<0x4E>(v);
    v += dpp_mov<0x141>(v);
    v += dpp_mov<0x140>(v);
    return (rdlane(v, 0) + rdlane(v, 16)) + (rdlane(v, 32) + rdlane(v, 48));
}
__device__ __forceinline__ float xrow_sum(float v) { v += __shfl_xor(v, 16); v += __shfl_xor(v, 32); return v; }
__device__ __forceinline__ void ph_mod(const Params& p, int bid, int nb, char* smem) {
    float* sc = (float*)smem;
    for (int item = bid; item < 64; item += nb) {
        const int k0 = item * 16, tid = threadIdx.x;
        __syncthreads();
        if (tid < 144) {
            const int r = tid >> 4, kk = tid & 15;
            const float v = (r < 8) ? p.c[r * 1024 + k0 + kk] : p.c_ctx[k0 + kk];
            sc[tid] = silu_f(v);
        }
        __syncthreads();
#pragma unroll 1
        for (int half = 0; half < 2; ++half) {
            float acc[6][9];
#pragma unroll
            for (int q = 0; q < 6; ++q)
#pragma unroll
                for (int r = 0; r < 9; ++r) acc[q][r] = 0.f;
            const float* wp = p.w_mod + (size_t)k0 * 3072 + half * 1536 + tid;
#pragma unroll 4
            for (int kk = 0; kk < 16; ++kk) {
                float wv[6];
#pragma unroll
                for (int q = 0; q < 6; ++q) wv[q] = wp[(size_t)kk * 3072 + q * 256];
#pragma unroll
                for (int r = 0; r < 9; ++r) {
                    const float s = sc[r * 16 + kk];
#pragma unroll
                    for (int q = 0; q < 6; ++q) acc[q][r] += s * wv[q];
                }
            }
#pragma unroll
            for (int q = 0; q < 6; ++q) {
                const int j = half * 1536 + q * 256 + tid;
                const float bb = (item == 0) ? p.b_mod[j] : 0.f;
#pragma unroll
                for (int r = 0; r < 9; ++r) atomicAdd(p.mod + r * 3072 + j, acc[q][r] + bb);
            }
        }
    }
}

__device__ __forceinline__ void ph_norm(const Params& p, int bid, int nb, char* smem) {
    const int lane = threadIdx.x & 63, gw = bid * 4 + (threadIdx.x >> 6), nw = nb * 4;
    const int per = (NT + nw - 1) / nw;
    const int r0 = gw * per, r1 = (r0 + per < NT) ? r0 + per : NT;
    auto rowptr = [&](int rr) -> const float* { return (rr < NCTX) ? p.ctx + (size_t)rr * DM : p.x + (size_t)(rr - NCTX) * DM; };
    f32x4 v[4], vn[4], av[4], sv[4];
    int cur_m = -1;
    if (r0 < r1) {
        const float* src = rowptr(r0);
#pragma unroll
        for (int i = 0; i < 4; ++i) v[i] = *(const f32x4*)(src + i * 256 + lane * 4);
    }
    for (int r = r0; r < r1; ++r) {
        if (r + 1 < r1) {
            const float* src = rowptr(r + 1);
#pragma unroll
            for (int i = 0; i < 4; ++i) vn[i] = *(const f32x4*)(src + i * 256 + lane * 4);
        }
        const int mrow = (r < NCTX) ? 8 : (r - NCTX) / SEQ;
        if (mrow != cur_m) {
            cur_m = mrow;
            const float* shift = p.mod + mrow * 3072;
            const float* scale = shift + 1024;
#pragma unroll
            for (int i = 0; i < 4; ++i) {
                const int k = i * 256 + lane * 4;
                const f32x4 nwv = *(const f32x4*)(p.norm_w + k), sc = *(const f32x4*)(scale + k);
                sv[i] = *(const f32x4*)(shift + k);
#pragma unroll
                for (int e2 = 0; e2 < 4; ++e2) av[i][e2] = nwv[e2] * (1.f + sc[e2]);
            }
        }
        float ss = 0.f;
#pragma unroll
        for (int i = 0; i < 4; ++i) ss += v[i][0] * v[i][0] + v[i][1] * v[i][1] + v[i][2] * v[i][2] + v[i][3] * v[i][3];
        ss = wave_sum(ss);
        const float rstd = rsqrtf(ss * (1.f / 1024.f) + EPSF);
#pragma unroll
        for (int i = 0; i < 4; ++i) {
            f32x4 y;
#pragma unroll
            for (int e2 = 0; e2 < 4; ++e2) y[e2] = (v[i][e2] * rstd) * av[i][e2] + sv[i][e2];
            st_bf4(p.h + (size_t)r * DM + i * 256 + lane * 4, y);
        }
#pragma unroll
        for (int i = 0; i < 4; ++i) v[i] = vn[i];
    }
}


__device__ __forceinline__ void wprep_unit(const float* __restrict__ W, int ldw, int K, int n0, int k0, int srcbase, bf16_t* __restrict__ dst, float* tile,
                                           const float* __restrict__ kscale) {
    const int tid = threadIdx.x;
    {
        const int n4 = (tid & 7) * 4, kk = tid >> 3;
        float4 v[4];
#pragma unroll
        for (int q = 0; q < 4; ++q) {
            const int k = kk + 32 * q;
            v[q] = make_float4(0.f, 0.f, 0.f, 0.f);
            if (srcbase >= 0) v[q] = *(const float4*)(W + (size_t)(k0 + k) * ldw + srcbase + n4);
        }
#pragma unroll
        for (int q = 0; q < 4; ++q) {
            const int k = kk + 32 * q;
            if (kscale) { const float s = kscale[k0 + k]; v[q].x *= s; v[q].y *= s; v[q].z *= s; v[q].w *= s; }
            float* t = tile + k * 33 + n4;
            t[0] = v[q].x; t[1] = v[q].y; t[2] = v[q].z; t[3] = v[q].w;
        }
    }
    __syncthreads();
    {
        const int n = tid >> 3;
#pragma unroll
        for (int q = 0; q < 2; ++q) {
            const int kc = (tid & 7) + 8 * q;
            const float* t = tile + (kc * 8) * 33 + n;
            uint4 o;
            o.x = pack_bf2(t[0 * 33], t[1 * 33]); o.y = pack_bf2(t[2 * 33], t[3 * 33]);
            o.z = pack_bf2(t[4 * 33], t[5 * 33]); o.w = pack_bf2(t[6 * 33], t[7 * 33]);
            *(uint4*)(dst + (size_t)(n0 + n) * K + k0 + kc * 8) = o;
        }
    }
    __syncthreads();
}

__device__ __forceinline__ void ph_wprep(const Params& p, int bid, int nb, char* smem) {
    float* tile = (float*)smem;
    const int U0 = 72 * 8, U1 = 32 * 8, U2 = 64 * 8, U3 = 24 * 3, U4 = 32 * 2, U5 = 32 * 4, U6 = 32 * 4, U7 = 32 * 8;
    const int UT = U0 + U1 + U2 + U3 + U4 + U5 + U6 + U7;
    for (int u = bid; u < UT; u += nb) {
        int v = u;
        const float* W; int ldw, K; bf16_t* dst; int job;
        if (v < U0) { job = 0; W = p.w_in; ldw = IN_DIM; K = 1024; dst = p.Wt_a; }
        else if ((v -= U0) < U1) { job = 1; W = p.w_in; ldw = IN_DIM; K = 1024; dst = p.Wt_z; }
        else if ((v -= U1) < U2) { job = 2; W = p.w_in; ldw = IN_DIM; K = 1024; dst = p.Wt_g; }
        else if ((v -= U2) < U3) { job = 3; W = p.w_uq; ldw = 768; K = 384; dst = p.Wt_uq; }
        else if ((v -= U3) < U4) { job = 4; W = p.w_ukv; ldw = 1024; K = 256; dst = p.Wt_ukv; }
        else if ((v -= U4) < U5) { job = 5; W = p.mla_w_o; ldw = 1024; K = 512; dst = p.Wt_mo; }
        else if ((v -= U5) < U6) { job = 6; W = p.dn_w_o; ldw = 1024; K = 512; dst = p.Wt_do; }
        else { v -= U6; job = 7; W = p.w_out; ldw = 1024; K = 1024; dst = p.Wt_out; }
        const int nkt = K / 128;
        const int n0 = (v / nkt) * 32, k0 = (v % nkt) * 128;
        int srcbase = n0;
        if (job == 0) {
            if (n0 < 672) srcbase = n0;
            else if (n0 < 2208) { const int r = n0 - 672, hh = r / 192, g = (r % 192) >> 6, i0 = r & 63; srcbase = 1184 + g * 512 + hh * 64 + i0; }
            else srcbase = (n0 < 2240) ? n0 + 1024 : -1;
        }
        else if (job == 1) srcbase = (n0 < 512) ? 672 + n0 : 2208 + n0;
        else if (job == 2) srcbase = 3264 + n0;
        const float* ksc = (job == 3) ? p.q_norm_w : (job == 4) ? p.kv_norm_w : nullptr;
        wprep_unit(W, ldw, K, n0, k0, srcbase, dst, tile, ksc);
    }
    if (bid == nb - 1) {
        for (int i = threadIdx.x; i < 512; i += NTHR) {
            const int pos = i >> 3, f = i & 7;
            const float ang = (float)pos * powf(10000.f, -(float)f / 8.f);
            p.rope[2 * i] = cosf(ang); p.rope[2 * i + 1] = sinf(ang);
        }
    }
}

typedef short bf16x8 __attribute__((ext_vector_type(8)));


__device__ __forceinline__ int lds_off(int row, int chunk) { return row * 128 + (((chunk ^ (row >> 1)) & 7) << 4); }

__device__ __forceinline__ int epi_perm(int rho) { return 8 * ((rho >> 2) & 3) + 4 * (rho >> 4) + (rho & 3); }

template <int NTN>
__device__ __forceinline__ void gemm_compute_stage(f32x4 (&acc)[NTN][4], const char* sa, int wm, int wn, int l15, int lq) {
    const char* sb = sa + 16384;
#pragma unroll
    for (int ks = 0; ks < 2; ++ks) {
        bf16x8 af[4], bfr[NTN];
#pragma unroll
        for (int mt = 0; mt < 4; ++mt) af[mt] = *(const bf16x8*)(sa + lds_off(wm * 64 + mt * 16 + l15, ks * 4 + lq));
#pragma unroll
        for (int nt = 0; nt < NTN; ++nt) bfr[nt] = *(const bf16x8*)(sb + lds_off(wn * (16 * NTN) + nt * 16 + l15, ks * 4 + lq));
#pragma unroll
        for (int nt = 0; nt < NTN; ++nt)
#pragma unroll
            for (int mt = 0; mt < 4; ++mt)
                acc[nt][mt] = __builtin_amdgcn_mfma_f32_16x16x32_bf16(bfr[nt], af[mt], acc[nt][mt], 0, 0, 0);
    }
}
template <int NTN>
__device__ __forceinline__ void gemm_tile_acc(f32x4 (&acc)[NTN][4], const bf16_t* __restrict__ A, int lda, const bf16_t* __restrict__ Bt, int ldb,
                                              int K, int m0, int n0, char* smem) {
    int tid = threadIdx.x;
    asm volatile("" : "+v"(tid));
    const int lane = tid & 63, w = tid >> 6, wm = w >> 1, wn = w & 1;
    const int l15 = lane & 15, lq = lane >> 4;
    const int srow = tid >> 3, sch = (tid & 7) ^ ((srow >> 1) & 7);
    const bf16_t* ap = A + (size_t)(m0 + srow) * lda + sch * 8;
    const int prow = epi_perm(srow & 31);
    const bf16_t* bp = Bt + (size_t)(n0 + prow) * ldb + sch * 8;
    int KT = K >> 6;
    asm volatile("" : "+s"(KT));
    LAS char* lbase = (LAS char*)smem + w * 1024;
#define GT_STAGE(ST_, KT_) do { \
        _Pragma("unroll") for (int i = 0; i < 4; ++i) \
            __builtin_amdgcn_global_load_lds((const void*)(ap + (size_t)(32 * i) * lda + (KT_) * 64), (LAS void*)(lbase + (ST_) * 32768 + i * 4096), 16, 0, 0); \
        _Pragma("unroll") for (int i = 0; i < NTN; ++i) \
            __builtin_amdgcn_global_load_lds((const void*)(bp + (size_t)(32 * i) * ldb + (KT_) * 64), (LAS void*)(lbase + (ST_) * 32768 + 16384 + i * 4096), 16, 0, 0); } while (0)
    GT_STAGE(0, 0);
    __syncthreads();
    for (int kt = 0; kt < KT; ++kt) {
        if (kt + 1 < KT) GT_STAGE((kt + 1) & 1, kt + 1);
        gemm_compute_stage<NTN>(acc, smem + (kt & 1) * 32768, wm, wn, l15, lq);
        __syncthreads();
    }
#undef GT_STAGE
}

template <int NTN>
__device__ __forceinline__ void acc_zero(f32x4 (&acc)[NTN][4]) {
#pragma unroll
    for (int i = 0; i < NTN; ++i)
#pragma unroll
        for (int j = 0; j < 4; ++j) acc[i][j] = (f32x4){0.f, 0.f, 0.f, 0.f};
}

__device__ __forceinline__ bool next_unit(int it, int U, int bid, int nb, int& u) {
    const int x = bid & 7, li = bid >> 3, per = nb >> 3;
    const int lo = (int)(((long)U * x) >> 3), hi = (int)(((long)U * (x + 1)) >> 3);
    u = lo + li + it * per;
    return u < hi;
}
__device__ __forceinline__ void unit_mn(int u, int ntn, int& tm, int& tn) {
    const int g = u / (8 * ntn), r = u % (8 * ntn);
    tm = g * 8 + (r & 7); tn = r >> 3;
}


__device__ __forceinline__ f32x4 ld_bf4(const bf16_t* p) {
    const uint2 r = *(const uint2*)p;
    return (f32x4){__uint_as_float(r.x << 16), __uint_as_float(r.x & 0xffff0000u), __uint_as_float(r.y << 16), __uint_as_float(r.y & 0xffff0000u)};
}
#define EPI_COORDS_OPAQUE(SFX) int tid##SFX = threadIdx.x; asm volatile("" : "+v"(tid##SFX)); \
    const int lane_ = tid##SFX & 63, w_ = tid##SFX >> 6, wm_ = w_ >> 1, wn_ = w_ & 1, l15_ = lane_ & 15, lq_ = lane_ >> 4;
#define EPI_COORDS const int lane_ = threadIdx.x & 63, w_ = threadIdx.x >> 6, wm_ = w_ >> 1, wn_ = w_ & 1, l15_ = lane_ & 15, lq_ = lane_ >> 4;
#define EPI_ROW(mt) (m0 + wm_ * 64 + (mt) * 16 + l15_)
#define EPI_COL(nt) (n0 + wn_ * 64 + 32 * ((nt) >> 1) + 8 * lq_ + 4 * ((nt) & 1))

__device__ __forceinline__ void gemm_store_bf16(const bf16_t* A, int lda, const bf16_t* Bt, int K, int tm, int tn, bf16_t* C, int ldc, char* smem) {
    f32x4 acc[4][4];
    acc_zero<4>(acc);
    const int m0 = tm * 128, n0 = tn * 128;
    gemm_tile_acc<4>(acc, A, lda, Bt, K, K, m0, n0, smem);
    EPI_COORDS
#pragma unroll
    for (int j = 0; j < 2; ++j)
#pragma unroll
        for (int mt = 0; mt < 4; ++mt) {
            u32x4 o;
            o[0] = pack_bf2(acc[2 * j][mt][0], acc[2 * j][mt][1]); o[1] = pack_bf2(acc[2 * j][mt][2], acc[2 * j][mt][3]);
            o[2] = pack_bf2(acc[2 * j + 1][mt][0], acc[2 * j + 1][mt][1]); o[3] = pack_bf2(acc[2 * j + 1][mt][2], acc[2 * j + 1][mt][3]);
            *(u32x4*)(C + (size_t)EPI_ROW(mt) * ldc + EPI_COL(2 * j)) = o;
        }
}

template <int NTN>
__device__ __forceinline__ void gemm_rows_acc(f32x4 (&acc)[NTN][2], float (&ssq)[2], const bf16_t* __restrict__ A, int lda,
                                              const bf16_t* __restrict__ Bt, int ldb, int K, int m0, int n0, char* smem) {
    constexpr int NB_ = NTN / 2;
    int tid = threadIdx.x;
    asm volatile("" : "+v"(tid));
    const int lane = tid & 63, w = tid >> 6;
    const int l15 = lane & 15, lq = lane >> 4;
    const int srow = tid >> 3, sch = (tid & 7) ^ ((srow >> 1) & 7);
    const bf16_t* ap = A + (size_t)(m0 + srow) * lda + sch * 8;
    const bf16_t* bp = Bt + (size_t)(n0 + srow) * ldb + sch * 8;
    int KT = K >> 6;
    asm volatile("" : "+s"(KT));
    LAS char* lbase = (LAS char*)smem + w * 1024;
#define GR_STAGE(ST_, KT_) do { \
        _Pragma("unroll") for (int i = 0; i < 4; ++i) \
            __builtin_amdgcn_global_load_lds((const void*)(ap + (size_t)(32 * i) * lda + (KT_) * 64), (LAS void*)(lbase + (ST_) * 32768 + i * 4096), 16, 0, 0); \
        _Pragma("unroll") for (int i = 0; i < NB_; ++i) \
            __builtin_amdgcn_global_load_lds((const void*)(bp + (size_t)(32 * i) * ldb + (KT_) * 64), (LAS void*)(lbase + (ST_) * 32768 + 16384 + i * 4096), 16, 0, 0); } while (0)
    GR_STAGE(0, 0);
    __syncthreads();
    for (int kt = 0; kt < KT; ++kt) {
        if (kt + 1 < KT) GR_STAGE((kt + 1) & 1, kt + 1);
        const char* sa = smem + (kt & 1) * 32768;
        const char* sb = sa + 16384;
#pragma unroll
        for (int ks = 0; ks < 2; ++ks) {
            bf16x8 af[2], bfr[NTN];
#pragma unroll
            for (int mt = 0; mt < 2; ++mt) af[mt] = *(const bf16x8*)(sa + lds_off(w * 32 + mt * 16 + l15, ks * 4 + lq));
#pragma unroll
            for (int nt = 0; nt < NTN; ++nt) bfr[nt] = *(const bf16x8*)(sb + lds_off(nt * 16 + l15, ks * 4 + lq));
#pragma unroll
            for (int mt = 0; mt < 2; ++mt) {
                const u32x4 aw = __builtin_bit_cast(u32x4, af[mt]);
#pragma unroll
                for (int e2 = 0; e2 < 4; ++e2) {
                    const float lo = __uint_as_float(aw[e2] << 16), hi = __uint_as_float(aw[e2] & 0xffff0000u);
                    ssq[mt] += lo * lo + hi * hi;
                }
            }
#pragma unroll
            for (int nt = 0; nt < NTN; ++nt)
#pragma unroll
                for (int mt = 0; mt < 2; ++mt)
                    acc[nt][mt] = __builtin_amdgcn_mfma_f32_16x16x32_bf16(bfr[nt], af[mt], acc[nt][mt], 0, 0, 0);
        }
        __syncthreads();
    }
#undef GR_STAGE
    ssq[0] = xrow_sum(ssq[0]);
    ssq[1] = xrow_sum(ssq[1]);
}

__device__ __forceinline__ void ph_mla_proj(const Params& p, int bid, int nb, char* smem) {
    const int tid = threadIdx.x, lane = tid & 63, w = tid >> 6, l15 = lane & 15, lq = lane >> 4;
    float* s_rope = (float*)(smem + 65536);
    float* s_qhn = s_rope + 1024;
    float* s_khn = s_qhn + 96;
    for (int i = tid; i < 1024; i += NTHR) s_rope[i] = p.rope[i];
    if (tid < 96) { s_qhn[tid] = p.qhn_w[tid]; s_khn[tid] = p.khn_w[tid]; }
    __syncthreads();
    const int UQ = 128 * 8, UK = 144 * 8;
    int u;
    for (int it = 0; next_unit(it, UQ + UK, bid, nb, u); ++it) {
        if (u < UQ) {
            const int tm = u >> 3, hh = u & 7;
            const int m0 = NCTX + tm * 128;
            f32x4 acc[6][2];
            float ssq[2] = {0.f, 0.f};
#pragma unroll
            for (int i = 0; i < 6; ++i) { acc[i][0] = (f32x4){0.f, 0.f, 0.f, 0.f}; acc[i][1] = (f32x4){0.f, 0.f, 0.f, 0.f}; }
            gemm_rows_acc<6>(acc, ssq, p.Pa + PA_CQ, PA_W, p.Wt_uq, 384, 384, m0, hh * 96, smem);
#pragma unroll
            for (int mt = 0; mt < 2; ++mt) {
                const int ml = 32 * w + 16 * mt + l15;
                const int rl = tm * 128 + ml;
                const int b = rl >> 11, t = rl & 2047;
                const float rs = rsqrtf(ssq[mt] * (1.f / 384.f) + EPSF);
                float hs = 0.f;
#pragma unroll
                for (int nt = 0; nt < 6; ++nt)
#pragma unroll
                    for (int e = 0; e < 4; ++e) { const float v = acc[nt][mt][e] * rs; acc[nt][mt][e] = v; hs += v * v; }
                hs = xrow_sum(hs);
                const float hr = rsqrtf(hs * (1.f / 96.f) + EPSF) * (0.10206207261596575f * 1.4426950408889634f);
                bf16_t* qd = p.Qb + ((size_t)((b * 8 + hh) * SEQ + t)) * 96 + 4 * lq;
#pragma unroll
                for (int nt = 0; nt < 6; ++nt) {
                    const f32x4 wv = *(const f32x4*)(s_qhn + 16 * nt + 4 * lq);
                    f32x4 v;
#pragma unroll
                    for (int e = 0; e < 4; ++e) v[e] = acc[nt][mt][e] * hr * wv[e];
                    if (nt >= 4) {
                        const int pos = (nt == 4) ? (t >> 6) : (t & 63);
                        const int ph = lq >> 1;
#pragma unroll
                        for (int e = 0; e < 4; ++e) {
                            const float2 cs = *(const float2*)(s_rope + 2 * (pos * 8 + (lq & 1) * 4 + e));
                            const float partner = __shfl_xor(v[e], 32);
                            const float t1 = ph ? partner : v[e], t2 = ph ? v[e] : partner;
                            v[e] = ph ? (t1 * cs.y + t2 * cs.x) : (t1 * cs.x - t2 * cs.y);
                        }
                    }
                    st_bf4(qd + 16 * nt, v);
                }
            }
        } else {
            const int uu = u - UQ;
            const int tm = uu >> 3, hh = uu & 7;
            const int m0 = tm * 128;
            f32x4 acc[8][2];
            float ssq[2] = {0.f, 0.f};
#pragma unroll
            for (int i = 0; i < 8; ++i) { acc[i][0] = (f32x4){0.f, 0.f, 0.f, 0.f}; acc[i][1] = (f32x4){0.f, 0.f, 0.f, 0.f}; }
            gemm_rows_acc<8>(acc, ssq, p.Pa + PA_CKV, PA_W, p.Wt_ukv, 256, 256, m0, hh * 128, smem);
#pragma unroll
            for (int mt = 0; mt < 2; ++mt) {
                const int ml = 32 * w + 16 * mt + l15;
                const int r = m0 + ml;
                int b, pos, t = 0; const bool lat = (r >= NCTX);
                if (!lat) { b = r >> 8; pos = r & 255; }
                else { const int rl = r - NCTX; b = rl >> 11; t = rl & 2047; pos = CTXL + t; }
                const float rs = rsqrtf(ssq[mt] * (1.f / 256.f) + EPSF);
                const u32x4 krw = *(const u32x4*)(p.Pa + (size_t)r * PA_W + PA_KR + 8 * lq);
                float kr[8];
#pragma unroll
                for (int e = 0; e < 4; ++e) { kr[2 * e] = __uint_as_float(krw[e] << 16); kr[2 * e + 1] = __uint_as_float(krw[e] & 0xffff0000u); }
                float hs = 0.f;
#pragma unroll
                for (int e = 0; e < 8; ++e) hs += kr[e] * kr[e];
#pragma unroll
                for (int nt = 0; nt < 4; ++nt)
#pragma unroll
                    for (int e = 0; e < 4; ++e) { const float v = acc[nt][mt][e] * rs; acc[nt][mt][e] = v; hs += v * v; }
                hs = xrow_sum(hs);
                const float hr = rsqrtf(hs * (1.f / 96.f) + EPSF);
                bf16_t* kd = p.Kb + ((size_t)((b * 8 + hh) * TPB + pos)) * 96;
#pragma unroll
                for (int nt = 0; nt < 4; ++nt) {
                    const f32x4 wv = *(const f32x4*)(s_khn + 16 * nt + 4 * lq);
                    f32x4 v;
#pragma unroll
                    for (int e = 0; e < 4; ++e) v[e] = acc[nt][mt][e] * hr * wv[e];
                    st_bf4(kd + 16 * nt + 4 * lq, v);
                }
                {
                    const int ph = lq & 1;
                    const int rp = (lq >> 1) ? (t & 63) : (t >> 6);
                    float o[8];
#pragma unroll
                    for (int e = 0; e < 8; ++e) {
                        const float v = kr[e] * hr * s_khn[64 + 8 * lq + e];
                        const float partner = __shfl_xor(v, 16);
                        float2 cs = make_float2(1.f, 0.f);
                        if (lat) cs = *(const float2*)(s_rope + 2 * (rp * 8 + e));
                        const float t1 = ph ? partner : v, t2 = ph ? v : partner;
                        o[e] = ph ? (t1 * cs.y + t2 * cs.x) : (t1 * cs.x - t2 * cs.y);
                    }
                    u32x4 ov;
                    ov[0] = pack_bf2(o[0], o[1]); ov[1] = pack_bf2(o[2], o[3]); ov[2] = pack_bf2(o[4], o[5]); ov[3] = pack_bf2(o[6], o[7]);
                    *(u32x4*)(kd + 64 + 8 * lq) = ov;
                }
                {
                    const int kpos = (pos & ~12) | ((pos & 4) << 1) | ((pos & 8) >> 1);
                    bf16_t* vd = p.Vt + (size_t)((b * 8 + hh) * 64) * TPB + kpos;
#pragma unroll
                    for (int nt = 4; nt < 8; ++nt)
#pragma unroll
                        for (int e = 0; e < 4; ++e) vd[(size_t)(16 * (nt - 4) + 4 * lq + e) * TPB] = f2bf(acc[nt][mt][e] * rs);
                }
            }
        }
    }
}

typedef float f32x16 __attribute__((ext_vector_type(16)));
#define ATT_KROW 208
#define ATT_VROW 144
#define ATT_KBYTES (64 * ATT_KROW)
#define ATT_STAGE (ATT_KBYTES + 64 * ATT_VROW)
__device__ __forceinline__ float max3_asm(float a, float b, float c) { float r; asm("v_max3_f32 %0, %1, %2, %3" : "=v"(r) : "v"(a), "v"(b), "v"(c)); return r; }
template <bool ZI>
__device__ __forceinline__ void ph_attn_t(const Params& p, int bid, int nb, char* smem, const float negB) {
    const int tid = threadIdx.x, lane = tid & 63, w = tid >> 6, r = lane & 31, h = lane >> 5;
    int u;
    for (int it = 0; next_unit(it, 1024, bid, nb, u); ++it) {
        const int bh = u >> 4, qb = u & 15;
        bf16x8 qf[6];
        {
            const bf16_t* Qp = p.Qb + ((size_t)bh * SEQ + qb * 128 + w * 32 + r) * 96 + h * 8;
#pragma unroll
            for (int s = 0; s < 6; ++s) qf[s] = *(const bf16x8*)(Qp + s * 16);
        }
        const bf16_t* Kg = p.Kb + (size_t)bh * TPB * 96 + tid * 8;
        const bf16_t* Vg = p.Vt + (size_t)bh * 64 * TPB + (size_t)(tid >> 3) * TPB + (tid & 7) * 8;
        int koff[3], voff[2];
#pragma unroll
        for (int i = 0; i < 3; ++i) { const int c = tid + 256 * i; koff[i] = (c / 12) * ATT_KROW + (c % 12) * 16; }
#pragma unroll
        for (int i = 0; i < 2; ++i) { const int c = tid + 256 * i; voff[i] = ATT_KBYTES + (c >> 3) * ATT_VROW + (c & 7) * 16; }
        u32x4 rk[3], rv[2];
#pragma unroll
        for (int i = 0; i < 3; ++i) rk[i] = *(const u32x4*)(Kg + i * 2048);
#pragma unroll
        for (int i = 0; i < 2; ++i) rv[i] = *(const u32x4*)(Vg + (size_t)(32 * i) * TPB);
#pragma unroll
        for (int i = 0; i < 3; ++i) *(u32x4*)(smem + koff[i]) = rk[i];
#pragma unroll
        for (int i = 0; i < 2; ++i) *(u32x4*)(smem + voff[i]) = rv[i];
        __syncthreads();
        f32x16 o0, o1;
#pragma unroll
        for (int i = 0; i < 16; ++i) { o0[i] = 0.f; o1[i] = 0.f; }
        float l = 0.f;
        int NKT = TPB / 64;
        asm volatile("" : "+s"(NKT));
        for (int kt = 0; kt < NKT; ++kt) {
            if (kt + 1 < NKT) {
#pragma unroll
                for (int i = 0; i < 3; ++i) rk[i] = *(const u32x4*)(Kg + (size_t)(kt + 1) * 6144 + i * 2048);
#pragma unroll
                for (int i = 0; i < 2; ++i) rv[i] = *(const u32x4*)(Vg + (size_t)(32 * i) * TPB + (kt + 1) * 64);
            }
            const char* sk = smem + (kt & 1) * ATT_STAGE;
            const char* sv = sk + ATT_KBYTES;
            f32x16 s0, s1;
            if (ZI) {
                const f32x16 z16 = {0.f, 0.f, 0.f, 0.f, 0.f, 0.f, 0.f, 0.f, 0.f, 0.f, 0.f, 0.f, 0.f, 0.f, 0.f, 0.f};
                const bf16x8 k0 = *(const bf16x8*)(sk + r * ATT_KROW + h * 16);
                const bf16x8 k1 = *(const bf16x8*)(sk + (32 + r) * ATT_KROW + h * 16);
                s0 = __builtin_amdgcn_mfma_f32_32x32x16_bf16(k0, qf[0], z16, 0, 0, 0);
                s1 = __builtin_amdgcn_mfma_f32_32x32x16_bf16(k1, qf[0], z16, 0, 0, 0);
            } else {
#pragma unroll
                for (int i = 0; i < 16; ++i) { s0[i] = negB; s1[i] = negB; }
            }
#pragma unroll
            for (int s = ZI ? 1 : 0; s < 6; ++s) {
                const bf16x8 k0 = *(const bf16x8*)(sk + r * ATT_KROW + (2 * s + h) * 16);
                const bf16x8 k1 = *(const bf16x8*)(sk + (32 + r) * ATT_KROW + (2 * s + h) * 16);
                s0 = __builtin_amdgcn_mfma_f32_32x32x16_bf16(k0, qf[s], s0, 0, 0, 0);
                s1 = __builtin_amdgcn_mfma_f32_32x32x16_bf16(k1, qf[s], s1, 0, 0, 0);
            }
            float ls = 0.f;
#pragma unroll
            for (int i = 0; i < 16; ++i) {
                s0[i] = __builtin_amdgcn_exp2f(s0[i]);
                s1[i] = __builtin_amdgcn_exp2f(s1[i]);
                ls += s0[i] + s1[i];
            }
            l += ls;
#pragma unroll
            for (int ks = 0; ks < 4; ++ks) {
                u32x4 pw;
                if (ks < 2) {
                    pw[0] = pack_bf2(s0[8 * (ks & 1) + 0], s0[8 * (ks & 1) + 1]); pw[1] = pack_bf2(s0[8 * (ks & 1) + 2], s0[8 * (ks & 1) + 3]);
                    pw[2] = pack_bf2(s0[8 * (ks & 1) + 4], s0[8 * (ks & 1) + 5]); pw[3] = pack_bf2(s0[8 * (ks & 1) + 6], s0[8 * (ks & 1) + 7]);
                } else {
                    pw[0] = pack_bf2(s1[8 * (ks & 1) + 0], s1[8 * (ks & 1) + 1]); pw[1] = pack_bf2(s1[8 * (ks & 1) + 2], s1[8 * (ks & 1) + 3]);
                    pw[2] = pack_bf2(s1[8 * (ks & 1) + 4], s1[8 * (ks & 1) + 5]); pw[3] = pack_bf2(s1[8 * (ks & 1) + 6], s1[8 * (ks & 1) + 7]);
                }
                const bf16x8 pf = __builtin_bit_cast(bf16x8, pw);
                const bf16x8 v0 = *(const bf16x8*)(sv + r * ATT_VROW + (2 * ks + h) * 16);
                const bf16x8 v1 = *(const bf16x8*)(sv + (32 + r) * ATT_VROW + (2 * ks + h) * 16);
                o0 = __builtin_amdgcn_mfma_f32_32x32x16_bf16(v0, pf, o0, 0, 0, 0);
                o1 = __builtin_amdgcn_mfma_f32_32x32x16_bf16(v1, pf, o1, 0, 0, 0);
            }
            if (kt + 1 < NKT) {
                char* ds = smem + ((kt + 1) & 1) * ATT_STAGE;
#pragma unroll
                for (int i = 0; i < 3; ++i) *(u32x4*)(ds + koff[i]) = rk[i];
#pragma unroll
                for (int i = 0; i < 2; ++i) *(u32x4*)(ds + voff[i]) = rv[i];
            }
            __syncthreads();
        }
        l += __shfl_xor(l, 32);
        const float inv = 1.f / l;
        const int b = bh >> 3, hh = bh & 7;
        const size_t rl = (size_t)(b * SEQ + qb * 128 + w * 32 + r);
        bf16_t* op = p.A_mla + rl * 512 + hh * 64 + 4 * h;
        const bf16_t* zp = p.Pz + rl * PZ_W + hh * 64 + 4 * h;
#pragma unroll
        for (int g = 0; g < 4; ++g) {
            const f32x4 z0 = ld_bf4(zp + 8 * g), z1 = ld_bf4(zp + 32 + 8 * g);
            uint2 a, c;
            a.x = pack_bf2(o0[4 * g + 0] * inv * silu_f(z0[0]), o0[4 * g + 1] * inv * silu_f(z0[1]));
            a.y = pack_bf2(o0[4 * g + 2] * inv * silu_f(z0[2]), o0[4 * g + 3] * inv * silu_f(z0[3]));
            c.x = pack_bf2(o1[4 * g + 0] * inv * silu_f(z1[0]), o1[4 * g + 1] * inv * silu_f(z1[1]));
            c.y = pack_bf2(o1[4 * g + 2] * inv * silu_f(z1[2]), o1[4 * g + 3] * inv * silu_f(z1[3]));
            *(uint2*)(op + 8 * g) = a;
            *(uint2*)(op + 32 + 8 * g) = c;
        }
    }
}

template <bool ZI>
__device__ __forceinline__ void ph_attn_d(const Params& p, int bid, int nb, char* smem, const float negB) {
    const int tid = threadIdx.x, lane = tid & 63, w = tid >> 6, r = lane & 31, h = lane >> 5;
    int u;
    for (int it = 0; next_unit(it, 512, bid, nb, u); ++it) {
        const int bh = u >> 3, qb = u & 7;
        bf16x8 qf[2][6];
#pragma unroll
        for (int t = 0; t < 2; ++t) {
            const bf16_t* Qp = p.Qb + ((size_t)bh * SEQ + qb * 256 + w * 64 + t * 32 + r) * 96 + h * 8;
#pragma unroll
            for (int s = 0; s < 6; ++s) qf[t][s] = *(const bf16x8*)(Qp + s * 16);
        }
        const bf16_t* Kg = p.Kb + (size_t)bh * TPB * 96 + tid * 8;
        const bf16_t* Vg = p.Vt + (size_t)bh * 64 * TPB + (size_t)(tid >> 3) * TPB + (tid & 7) * 8;
        int koff[3], voff[2];
#pragma unroll
        for (int i = 0; i < 3; ++i) { const int c = tid + 256 * i; koff[i] = (c / 12) * ATT_KROW + (c % 12) * 16; }
#pragma unroll
        for (int i = 0; i < 2; ++i) { const int c = tid + 256 * i; voff[i] = ATT_KBYTES + (c >> 3) * ATT_VROW + (c & 7) * 16; }
        u32x4 rk[3], rv[2];
#pragma unroll
        for (int i = 0; i < 3; ++i) rk[i] = *(const u32x4*)(Kg + i * 2048);
#pragma unroll
        for (int i = 0; i < 2; ++i) rv[i] = *(const u32x4*)(Vg + (size_t)(32 * i) * TPB);
#pragma unroll
        for (int i = 0; i < 3; ++i) *(u32x4*)(smem + koff[i]) = rk[i];
#pragma unroll
        for (int i = 0; i < 2; ++i) *(u32x4*)(smem + voff[i]) = rv[i];
        __syncthreads();
        f32x16 o[2][2];
#pragma unroll
        for (int t = 0; t < 2; ++t)
#pragma unroll
            for (int i = 0; i < 16; ++i) { o[t][0][i] = 0.f; o[t][1][i] = 0.f; }
        float l[2] = {0.f, 0.f};
        int NKT = TPB / 64;
        asm volatile("" : "+s"(NKT));
        for (int kt = 0; kt < NKT; ++kt) {
            if (kt + 1 < NKT) {
#pragma unroll
                for (int i = 0; i < 3; ++i) rk[i] = *(const u32x4*)(Kg + (size_t)(kt + 1) * 6144 + i * 2048);
#pragma unroll
                for (int i = 0; i < 2; ++i) rv[i] = *(const u32x4*)(Vg + (size_t)(32 * i) * TPB + (kt + 1) * 64);
            }
            const char* sk = smem + (kt & 1) * ATT_STAGE;
            const char* sv = sk + ATT_KBYTES;
            int NHF = 2;
            asm volatile("" : "+s"(NHF));
            for (int hf = 0; hf < NHF; ++hf) {
                const char* skh = sk + hf * 32 * ATT_KROW;
                f32x16 s[2];
                if (ZI) {
                    const f32x16 z16 = {0.f, 0.f, 0.f, 0.f, 0.f, 0.f, 0.f, 0.f, 0.f, 0.f, 0.f, 0.f, 0.f, 0.f, 0.f, 0.f};
                    const bf16x8 k0 = *(const bf16x8*)(skh + r * ATT_KROW + h * 16);
                    s[0] = __builtin_amdgcn_mfma_f32_32x32x16_bf16(k0, qf[0][0], z16, 0, 0, 0);
                    s[1] = __builtin_amdgcn_mfma_f32_32x32x16_bf16(k0, qf[1][0], z16, 0, 0, 0);
                } else {
#pragma unroll
                    for (int i = 0; i < 16; ++i) { s[0][i] = negB; s[1][i] = negB; }
                }
#pragma unroll
                for (int ss = ZI ? 1 : 0; ss < 6; ++ss) {
                    const bf16x8 k0 = *(const bf16x8*)(skh + r * ATT_KROW + (2 * ss + h) * 16);
                    s[0] = __builtin_amdgcn_mfma_f32_32x32x16_bf16(k0, qf[0][ss], s[0], 0, 0, 0);
                    s[1] = __builtin_amdgcn_mfma_f32_32x32x16_bf16(k0, qf[1][ss], s[1], 0, 0, 0);
                }
                bf16x8 pf[2][2];
#pragma unroll
                for (int t = 0; t < 2; ++t) {
                    float ls = 0.f;
#pragma unroll
                    for (int i = 0; i < 16; ++i) {
                        s[t][i] = __builtin_amdgcn_exp2f(s[t][i]);
                        ls += s[t][i];
                    }
                    l[t] += ls;
#pragma unroll
                    for (int ks = 0; ks < 2; ++ks) {
                        u32x4 pw;
#pragma unroll
                        for (int e = 0; e < 4; ++e) pw[e] = pack_bf2(s[t][8 * ks + 2 * e], s[t][8 * ks + 2 * e + 1]);
                        pf[t][ks] = __builtin_bit_cast(bf16x8, pw);
                    }
                }
#pragma unroll
                for (int ks = 0; ks < 2; ++ks) {
                    const bf16x8 v0 = *(const bf16x8*)(sv + r * ATT_VROW + (2 * (2 * hf + ks) + h) * 16);
                    const bf16x8 v1 = *(const bf16x8*)(sv + (32 + r) * ATT_VROW + (2 * (2 * hf + ks) + h) * 16);
#pragma unroll
                    for (int t = 0; t < 2; ++t) {
                        o[t][0] = __builtin_amdgcn_mfma_f32_32x32x16_bf16(v0, pf[t][ks], o[t][0], 0, 0, 0);
                        o[t][1] = __builtin_amdgcn_mfma_f32_32x32x16_bf16(v1, pf[t][ks], o[t][1], 0, 0, 0);
                    }
                }
            }
            if (kt + 1 < NKT) {
                char* ds = smem + ((kt + 1) & 1) * ATT_STAGE;
#pragma unroll
                for (int i = 0; i < 3; ++i) *(u32x4*)(ds + koff[i]) = rk[i];
#pragma unroll
                for (int i = 0; i < 2; ++i) *(u32x4*)(ds + voff[i]) = rv[i];
            }
            __syncthreads();
        }
        const int b = bh >> 3, hh = bh & 7;
#pragma unroll
        for (int t = 0; t < 2; ++t) {
            const float lt = l[t] + __shfl_xor(l[t], 32);
            const float inv = 1.f / lt;
            const size_t rl = (size_t)(b * SEQ + qb * 256 + w * 64 + t * 32 + r);
            bf16_t* op = p.A_mla + rl * 512 + hh * 64 + 4 * h;
            const bf16_t* zp = p.Pz + rl * PZ_W + hh * 64 + 4 * h;
#pragma unroll
            for (int g = 0; g < 4; ++g) {
                const f32x4 z0 = ld_bf4(zp + 8 * g), z1 = ld_bf4(zp + 32 + 8 * g);
                uint2 a, c;
                a.x = pack_bf2(o[t][0][4 * g + 0] * inv * silu_f(z0[0]), o[t][0][4 * g + 1] * inv * silu_f(z0[1]));
                a.y = pack_bf2(o[t][0][4 * g + 2] * inv * silu_f(z0[2]), o[t][0][4 * g + 3] * inv * silu_f(z0[3]));
                c.x = pack_bf2(o[t][1][4 * g + 0] * inv * silu_f(z1[0]), o[t][1][4 * g + 1] * inv * silu_f(z1[1]));
                c.y = pack_bf2(o[t][1][4 * g + 2] * inv * silu_f(z1[2]), o[t][1][4 * g + 3] * inv * silu_f(z1[3]));
                *(uint2*)(op + 8 * g) = a;
                *(uint2*)(op + 32 + 8 * g) = c;
            }
        }
    }
}

__device__ __forceinline__ void ph_attn(const Params& p, int bid, int nb, char* smem) {
    const int lane = threadIdx.x & 63;
    float mq = fmaxf(fabsf(p.qhn_w[lane]), (lane < 32) ? fabsf(p.qhn_w[64 + lane]) : 0.f);
    float mk = fmaxf(fabsf(p.khn_w[lane]), (lane < 32) ? fabsf(p.khn_w[64 + lane]) : 0.f);
#pragma unroll
    for (int o = 32; o > 0; o >>= 1) { mq = fmaxf(mq, __shfl_xor(mq, o)); mk = fmaxf(mk, __shfl_xor(mk, o)); }
    const float B = (9.797958971f * 1.4426950408889634f * 1.0001f) * mq * mk;
    if (B <= 40.f) ph_attn_d<true>(p, bid, nb, smem, 0.f);
    else ph_attn_t<false>(p, bid, nb, smem, -B);
}

__device__ __forceinline__ int el_off(int row, int col) { return lds_off(row, col >> 3) + (col & 7) * 2; }

__device__ __forceinline__ void mm64(f32x4 (&acc)[4], const char* A, int arow0, const char* B, int l15, int lq) {
#pragma unroll
    for (int ks = 0; ks < 2; ++ks) {
        const bf16x8 a = *(const bf16x8*)(A + lds_off(arow0 + l15, ks * 4 + lq));
#pragma unroll
        for (int nt = 0; nt < 4; ++nt) {
            const bf16x8 b = *(const bf16x8*)(B + lds_off(nt * 16 + l15, ks * 4 + lq));
            acc[nt] = __builtin_amdgcn_mfma_f32_16x16x32_bf16(a, b, acc[nt], 0, 0, 0);
        }
    }
}
__device__ __forceinline__ void acc4_zero(f32x4 (&a)[4]) {
#pragma unroll
    for (int i = 0; i < 4; ++i) a[i] = (f32x4){0.f, 0.f, 0.f, 0.f};
}

#define DN_SQ 0
#define DN_SK 8192
#define DN_SV 16384
#define DN_LSTR 65
#define DN_LBYTES (64 * DN_LSTR * 4)
#define DN_SL 24576
#define DN_SA 57856
#define DN_SKD 66048
#define DN_SS 74240

typedef short s16x4 __attribute__((ext_vector_type(4)));
__device__ __forceinline__ s16x4 ds_tr(const char* p) { return __builtin_amdgcn_ds_read_tr16_b64_v4i16((LAS s16x4*)p); }

struct Dn1In { u32x4 rp[7]; float db, da, dtb, alog; float cw[4]; };
__device__ __forceinline__ void dn1_fetch(Dn1In& in, const Params& p, int u, int tid) {
    const int bh = u / 36, pb = u % 36, b = bh >> 3, h = bh & 7;
    int rowbase, seglen, lb;
    if (pb < 4) { rowbase = b * CTXL; seglen = CTXL; lb = pb; }
    else { rowbase = NCTX + b * SEQ; seglen = SEQ; lb = pb - 4; }
#pragma unroll
    for (int i = 0; i < 7; ++i) {
        const int c = tid + NTHR * i;
        const int g = c / 544, rem = c % 544, rr = rem >> 3, ch = rem & 7;
        const int lp = lb * 64 - 2 + rr;
        u32x4 val = (u32x4){0u, 0u, 0u, 0u};
        if (c < 3 * 68 * 8 && lp >= 0 && lp < seglen) val = *(const u32x4*)(p.Pa + (size_t)(rowbase + lp) * PA_W + PA_DQ + h * 192 + g * 64 + ch * 8);
        in.rp[i] = val;
    }
#pragma unroll
    for (int i = 0; i < 4; ++i) {
        const int idx = tid + NTHR * i, g = idx / 320, j = (idx % 320) >> 6, c = idx & 63;
        in.cw[i] = (idx < 960) ? p.conv_w[j * 1536 + g * 512 + h * 64 + c] : 0.f;
    }
    in.db = 0.f; in.da = 0.f; in.dtb = 0.f; in.alog = 0.f;
    if (tid < 128) {
        in.dtb = p.dt_bias[(tid >> 6) * 8 + h]; in.alog = p.a_log[(tid >> 6) * 8 + h];
        const int d = tid >> 6, tp = tid & 63;
        const int pos = d ? 63 - tp : tp;
        const bf16_t* row = p.Pa + (size_t)(rowbase + lb * 64 + pos) * PA_W;
        in.db = bf2f(row[PA_DB + d * 8 + h]);
        in.da = bf2f(row[PA_DA + d * 8 + h]);
    }
}

__device__ __forceinline__ void ph_dn1(const Params& p, int bid, int nb, char* smem) {
    char* sQ = smem + DN_SQ; char* sK = smem + DN_SK; char* sV = smem + DN_SV;
    char* sL = smem + DN_SL; char* sA = smem + DN_SA; char* sKd = smem + DN_SKD;
    float* sS = (float*)(smem + DN_SS);
    const int x_ = bid & 7, li_ = bid >> 3, per_ = nb >> 3;
#define DN1_UNIT(IT, U, VALID) do { const int q_ = li_ + (IT) * per_; const int grp_ = x_ + 8 * (q_ >> 3); VALID = (grp_ < 8 * 36); \
        const int b_ = grp_ / 36, pb_ = grp_ % 36; U = (b_ * 8 + (q_ & 7)) * 36 + pb_; } while (0)
    Dn1In in;
    int u, un; bool valid, validn;
    DN1_UNIT(0, u, valid);
    if (valid) dn1_fetch(in, p, u, threadIdx.x);
    for (int it = 0; valid; ++it, u = un, valid = validn) {
        DN1_UNIT(it + 1, un, validn);
        int tid = threadIdx.x;
        asm volatile("" : "+v"(tid));
        const int lane = tid & 63, w = tid >> 6, l15 = lane & 15, lq = lane >> 4;
        const int bh = u / 36, pb = u % 36, h = bh & 7;
        const bool lat = (pb >= 4);
        if (tid < 128) {
            const int d = tid >> 6, tp = lane;
            const float xx = in.da + in.dtb;
            const float sp = (xx > 20.f) ? xx : log1pf(__expf(xx));
            const float g = -__expf(in.alog) * sp;
            float gc = g;
#pragma unroll
            for (int o = 1; o < 64; o <<= 1) { const float t = __shfl_up(gc, o); if (lane >= o) gc += t; }
            const float gl = __shfl(gc, 63);
            const float bt = sigmoid_f(in.db), eg = __expf(gc);
            sS[(d * 5 + 0) * 64 + tp] = bt;
            sS[(d * 5 + 1) * 64 + tp] = gc;
            sS[(d * 5 + 2) * 64 + tp] = eg;
            sS[(d * 5 + 3) * 64 + tp] = __expf(gl - gc);
            sS[(d * 5 + 4) * 64 + tp] = bt * eg;
        }
        {
            char* raw = sL;
#pragma unroll
            for (int i = 0; i < 7; ++i) {
                const int c = tid + NTHR * i;
                const int g = c / 544, rem = c % 544, rr = rem >> 3, ch = rem & 7;
                if (c < 3 * 68 * 8) *(u32x4*)(raw + (g * 68 + rr) * 128 + ch * 16) = in.rp[i];
            }
            float* cwS = (float*)(sL + 26112);
#pragma unroll
            for (int i = 0; i < 4; ++i) { const int idx = tid + NTHR * i; if (idx < 960) cwS[idx] = in.cw[i]; }
            if (validn) dn1_fetch(in, p, un, tid);
            __syncthreads();
            const int o = tid & 7, r0 = tid >> 3;
#pragma unroll
            for (int g = 0; g < 3; ++g) {
                if (g == 0 && !lat) continue;
                float wj[5][8];
#pragma unroll
                for (int j = 0; j < 5; ++j) {
                    const f32x4 w0 = *(const f32x4*)(cwS + (g * 5 + j) * 64 + 8 * o), w1 = *(const f32x4*)(cwS + (g * 5 + j) * 64 + 8 * o + 4);
#pragma unroll
                    for (int e2 = 0; e2 < 4; ++e2) { wj[j][e2] = w0[e2]; wj[j][4 + e2] = w1[e2]; }
                }
#pragma unroll
                for (int hh = 0; hh < 2; ++hh) {
                    const int rr = r0 + 32 * hh;
                    float a[8];
#pragma unroll
                    for (int e2 = 0; e2 < 8; ++e2) a[e2] = 0.f;
#pragma unroll
                    for (int j = 0; j < 5; ++j) {
                        const u32x4 dv = *(const u32x4*)(raw + (g * 68 + rr + j) * 128 + o * 16);
#pragma unroll
                        for (int e2 = 0; e2 < 4; ++e2) {
                            a[2 * e2] += __uint_as_float(dv[e2] << 16) * wj[j][2 * e2];
                            a[2 * e2 + 1] += __uint_as_float(dv[e2] & 0xffff0000u) * wj[j][2 * e2 + 1];
                        }
                    }
                    float ss = 0.f;
#pragma unroll
                    for (int e2 = 0; e2 < 8; ++e2) { a[e2] = silu_f(a[e2]); ss += a[e2] * a[e2]; }
                    float sc = 1.f;
                    if (g < 2) {
                        ss += dpp_mov<0xB1>(ss); ss += dpp_mov<0x4E>(ss); ss += dpp_mov<0x141>(ss);
                        sc = rsqrtf(ss + EPSF) * (g == 0 ? 0.125f : 1.f);
                    }
                    u32x4 ov;
#pragma unroll
                    for (int e2 = 0; e2 < 4; ++e2) ov[e2] = pack_bf2(a[2 * e2] * sc, a[2 * e2 + 1] * sc);
                    *(u32x4*)((g == 0 ? sQ : g == 1 ? sK : sV) + lds_off(rr, o)) = ov;
                }
            }
            __syncthreads();
        }
        {
            f32x4 G[4];
            acc4_zero(G);
            mm64(G, sK, 16 * w, sK, l15, lq);
            float* L0 = (float*)sL; float* L1 = (float*)(sL + DN_LBYTES);
            const float* be0 = sS + 0 * 64; const float* gc0 = sS + 1 * 64;
            const float* be1 = sS + 5 * 64; const float* gc1 = sS + 6 * 64;
#pragma unroll
            for (int nt = 0; nt < 4; ++nt)
#pragma unroll
                for (int rg = 0; rg < 4; ++rg) {
                    const int t = 16 * w + 4 * lq + rg, s = 16 * nt + l15;
                    const float gv = G[nt][rg];
                    const int tp = 63 - t, sp = 63 - s;
                    L0[t * DN_LSTR + s] = (s < t) ? be0[t] * gv * __expf(gc0[t] - gc0[s]) : 0.f;
                    L1[tp * DN_LSTR + sp] = (s > t) ? be1[tp] * gv * __expf(gc1[tp] - gc1[sp]) : 0.f;
                }
            __syncthreads();
        }
        {
            int tid3 = tid;
            asm volatile("" : "+v"(tid3) :: "memory");
            const int lane3 = tid3 & 63, w3 = tid3 >> 6, l15c = lane3 & 15, lqc = lane3 >> 4;
            if (tid3 < 128) {
                float* Lb = (float*)(sL + w3 * DN_LBYTES) + (16 * lqc) * DN_LSTR + 16 * lqc;
                float x[16];
#pragma unroll
                for (int i = 0; i < 16; ++i) {
                    float v = (i == l15c) ? 1.f : 0.f;
#pragma unroll
                    for (int j = 0; j < i; ++j) v -= Lb[i * DN_LSTR + j] * x[j];
                    x[i] = v;
                }
#pragma unroll
                for (int i = 0; i < 16; ++i) Lb[i * DN_LSTR + l15c] = x[i];
            }
            __syncthreads();
            {
                const int d = w3 >> 1, pr = w3 & 1, b0 = 2 * pr, b1 = 2 * pr + 1;
                float* Ld = (float*)(sL + d * DN_LBYTES);
                float* scr = (float*)(sA) + w3 * 272;
                f32x4 P = (f32x4){0.f, 0.f, 0.f, 0.f};
#pragma unroll
                for (int kk = 0; kk < 4; ++kk)
                    P = __builtin_amdgcn_mfma_f32_16x16x4f32(Ld[(16 * b1 + l15c) * DN_LSTR + 16 * b0 + 4 * kk + lqc],
                                                            Ld[(16 * b0 + 4 * kk + lqc) * DN_LSTR + 16 * b0 + l15c], P, 0, 0, 0);
#pragma unroll
                for (int rg = 0; rg < 4; ++rg) scr[(4 * lqc + rg) * 17 + l15c] = P[rg];
                f32x4 R = (f32x4){0.f, 0.f, 0.f, 0.f};
#pragma unroll
                for (int kk = 0; kk < 4; ++kk)
                    R = __builtin_amdgcn_mfma_f32_16x16x4f32(Ld[(16 * b1 + l15c) * DN_LSTR + 16 * b1 + 4 * kk + lqc],
                                                            scr[(4 * kk + lqc) * 17 + l15c], R, 0, 0, 0);
#pragma unroll
                for (int rg = 0; rg < 4; ++rg) Ld[(16 * b1 + 4 * lqc + rg) * DN_LSTR + 16 * b0 + l15c] = -R[rg];
            }
            __syncthreads();
            {
                const int d = w3 >> 1, hf = w3 & 1;
                float* Ld = (float*)(sL + d * DN_LBYTES);
                float* scr2 = (float*)(d ? sKd : sA);
                f32x4 P2[2];
                P2[0] = (f32x4){0.f, 0.f, 0.f, 0.f}; P2[1] = (f32x4){0.f, 0.f, 0.f, 0.f};
#pragma unroll
                for (int kk = 0; kk < 8; ++kk) {
                    const float a = Ld[(32 + 16 * hf + l15c) * DN_LSTR + 4 * kk + lqc];
#pragma unroll
                    for (int n2 = 0; n2 < 2; ++n2)
                        P2[n2] = __builtin_amdgcn_mfma_f32_16x16x4f32(a, Ld[(4 * kk + lqc) * DN_LSTR + 16 * n2 + l15c], P2[n2], 0, 0, 0);
                }
#pragma unroll
                for (int n2 = 0; n2 < 2; ++n2)
#pragma unroll
                    for (int rg = 0; rg < 4; ++rg) scr2[(16 * hf + 4 * lqc + rg) * 33 + 16 * n2 + l15c] = P2[n2][rg];
                __syncthreads();
                f32x4 R2[2];
                R2[0] = (f32x4){0.f, 0.f, 0.f, 0.f}; R2[1] = (f32x4){0.f, 0.f, 0.f, 0.f};
#pragma unroll
                for (int kk = 0; kk < 8; ++kk) {
                    const float a = Ld[(32 + 16 * hf + l15c) * DN_LSTR + 32 + 4 * kk + lqc];
#pragma unroll
                    for (int n2 = 0; n2 < 2; ++n2)
                        R2[n2] = __builtin_amdgcn_mfma_f32_16x16x4f32(a, scr2[(4 * kk + lqc) * 33 + 16 * n2 + l15c], R2[n2], 0, 0, 0);
                }
#pragma unroll
                for (int n2 = 0; n2 < 2; ++n2)
#pragma unroll
                    for (int rg = 0; rg < 4; ++rg) Ld[(32 + 16 * hf + 4 * lqc + rg) * DN_LSTR + 16 * n2 + l15c] = -R2[n2][rg];
            }
            __syncthreads();
#pragma unroll 1
            for (int d = 0; d < 2; ++d) {
                const float* Td = (const float*)(sL + d * DN_LBYTES);
                {
                    const int tr = tid3 >> 2, cq = tid3 & 3;
                    const float* c1 = sS + (d * 5 + 0) * 64 + 16 * cq;
                    const float* c2 = sS + (d * 5 + 4) * 64 + 16 * cq;
                    const float* trow = Td + tr * DN_LSTR + 16 * cq;
                    float tv[16];
#pragma unroll
                    for (int e2 = 0; e2 < 16; ++e2) tv[e2] = trow[e2];
#pragma unroll
                    for (int q = 0; q < 2; ++q) {
                        u32x4 o1, o2;
#pragma unroll
                        for (int e2 = 0; e2 < 4; ++e2) {
                            const int i0 = 8 * q + 2 * e2;
                            o1[e2] = pack_bf2(tv[i0] * c1[i0], tv[i0 + 1] * c1[i0 + 1]);
                            o2[e2] = pack_bf2(tv[i0] * c2[i0], tv[i0 + 1] * c2[i0 + 1]);
                        }
                        *(u32x4*)(sA + lds_off(tr, 2 * cq + q)) = o1;
                        *(u32x4*)(sKd + lds_off(tr, 2 * cq + q)) = o2;
                    }
                }
                __syncthreads();
                f32x4 U[4], W[4];
                acc4_zero(U); acc4_zero(W);
                {
#pragma unroll
                    for (int ks = 0; ks < 2; ++ks) {
                        const bf16x8 a1 = *(const bf16x8*)(sA + lds_off(16 * w3 + l15c, ks * 4 + lqc));
                        const bf16x8 a2 = *(const bf16x8*)(sKd + lds_off(16 * w3 + l15c, ks * 4 + lqc));
                        const int r0 = 32 * ks + 8 * lqc + (l15c >> 2);
                        const int p0 = d ? 63 - r0 : r0, p1 = d ? 63 - (r0 + 4) : (r0 + 4);
#pragma unroll
                        for (int nt = 0; nt < 4; ++nt) {
                            const int col = 16 * nt + 4 * (l15c & 3);
                            const s16x4 v0 = ds_tr(sV + el_off(p0, col)), v1 = ds_tr(sV + el_off(p1, col));
                            const s16x4 k0 = ds_tr(sK + el_off(p0, col)), k1 = ds_tr(sK + el_off(p1, col));
                            U[nt] = __builtin_amdgcn_mfma_f32_16x16x32_bf16(a1, __builtin_shufflevector(v0, v1, 0, 1, 2, 3, 4, 5, 6, 7), U[nt], 0, 0, 0);
                            W[nt] = __builtin_amdgcn_mfma_f32_16x16x32_bf16(a2, __builtin_shufflevector(k0, k1, 0, 1, 2, 3, 4, 5, 6, 7), W[nt], 0, 0, 0);
                        }
                    }
                }
                __syncthreads();
                {
                    char* uT = sL + d * DN_LBYTES;
                    char* wT = uT + 8192;
                    const int t0 = 16 * w3 + 4 * lqc;
#pragma unroll
                    for (int nt = 0; nt < 4; ++nt) {
                        uint2 ou, ow;
                        ou.x = pack_bf2(U[nt][0], U[nt][1]); ou.y = pack_bf2(U[nt][2], U[nt][3]);
                        ow.x = pack_bf2(W[nt][0], W[nt][1]); ow.y = pack_bf2(W[nt][2], W[nt][3]);
                        *(uint2*)(uT + el_off(16 * nt + l15c, t0)) = ou;
                        *(uint2*)(wT + el_off(16 * nt + l15c, t0)) = ow;
                    }
                }
                __syncthreads();
            }
        }
        int tid5 = tid;
        asm volatile("" : "+v"(tid5) :: "memory");
        const int lane5 = tid5 & 63, w5 = tid5 >> 6, l15_5 = lane5 & 15, lq5 = lane5 >> 4;
        f32x4 QK[4];
        acc4_zero(QK);
        mm64(QK, sQ, 16 * w5, sK, l15_5, lq5);
#pragma unroll 1
        for (int d = 0; d < 2; ++d) {
            const float* gcd = sS + (d * 5 + 1) * 64;
            const float* egd = sS + (d * 5 + 2) * 64;
            const float* ekd = sS + (d * 5 + 3) * 64;
            {
                const int i = lane5, tq = w5;
                float kv[16];
#pragma unroll
                for (int e = 0; e < 16; ++e) {
                    const int tp = tq * 16 + e, pos = d ? 63 - tp : tp;
                    kv[e] = bf2f(*(const bf16_t*)(sK + el_off(pos, i))) * ekd[tp];
                }
#pragma unroll
                for (int q = 0; q < 2; ++q) {
                    u32x4 o;
                    o[0] = pack_bf2(kv[8 * q + 0], kv[8 * q + 1]); o[1] = pack_bf2(kv[8 * q + 2], kv[8 * q + 3]);
                    o[2] = pack_bf2(kv[8 * q + 4], kv[8 * q + 5]); o[3] = pack_bf2(kv[8 * q + 6], kv[8 * q + 7]);
                    *(u32x4*)(sKd + lds_off(i, 2 * tq + q)) = o;
                }
            }
#pragma unroll
            for (int nt = 0; nt < 4; ++nt)
#pragma unroll
                for (int rg = 0; rg < 4; ++rg) {
                    const int t = 16 * w5 + 4 * lq5 + rg, s = 16 * nt + l15_5;
                    const int tp = d ? 63 - t : t, sp = d ? 63 - s : s;
                    const float val = (sp <= tp) ? QK[nt][rg] * __expf(gcd[tp] - gcd[sp]) : 0.f;
                    *(bf16_t*)(sA + el_off(tp, sp)) = f2bf(val);
                }
            __syncthreads();
            const char* uT = sL + d * DN_LBYTES;
            const char* wT = uT + 8192;
            const int cd = (d == 0) ? pb : (pb < 4 ? 3 - pb : 39 - pb);
            bf16_t* Mg = p.MH + ((size_t)((bh * 2 + d) * 36 + cd) * 2) * 4096;
            bf16_t* Hg = Mg + 4096;
            {
                f32x4 MT[4];
                acc4_zero(MT);
                mm64(MT, wT, 16 * w5, sKd, l15_5, lq5);
                const float egl = egd[63];
                const int j0 = 16 * w5 + 4 * lq5;
#pragma unroll
                for (int nt = 0; nt < 4; ++nt) {
                    const int i = 16 * nt + l15_5;
                    f32x4 o;
#pragma unroll
                    for (int e = 0; e < 4; ++e) o[e] = ((i == j0 + e) ? egl : 0.f) - MT[nt][e];
                    st_bf4(Mg + i * 64 + j0, o);
                }
            }
            {
                f32x4 HH[4];
                acc4_zero(HH);
                mm64(HH, sKd, 16 * w5, uT, l15_5, lq5);
                const int i0 = 16 * w5 + 4 * lq5;
#pragma unroll
                for (int nt = 0; nt < 4; ++nt) st_bf4(Hg + (16 * nt + l15_5) * 64 + i0, HH[nt]);
            }
            if (lat) {
                bf16_t* Eg = p.EF + ((size_t)((bh * 2 + d) * 32 + (pb - 4)) * 2) * 4096;
                bf16_t* Fg = Eg + 4096;
                {
                    f32x4 ET[4];
                    acc4_zero(ET);
                    mm64(ET, wT, 16 * w5, sA, l15_5, lq5);
                    const int j0 = 16 * w5 + 4 * lq5;
#pragma unroll
                    for (int nt = 0; nt < 4; ++nt) {
                        const int sp = 16 * nt + l15_5, spos = d ? 63 - sp : sp;
                        const f32x4 qv = ld_bf4((const bf16_t*)(sQ + el_off(spos, j0)));
                        const float eg = egd[sp];
                        f32x4 o;
#pragma unroll
                        for (int e = 0; e < 4; ++e) o[e] = qv[e] * eg - ET[nt][e];
                        st_bf4(Eg + spos * 64 + j0, o);
                    }
                }
                {
                    f32x4 FF[4];
                    acc4_zero(FF);
                    mm64(FF, uT, 16 * w5, sA, l15_5, lq5);
                    const int c0 = 16 * w5 + 4 * lq5;
#pragma unroll
                    for (int nt = 0; nt < 4; ++nt) {
                        const int sp = 16 * nt + l15_5, spos = d ? 63 - sp : sp;
                        st_bf4(Fg + spos * 64 + c0, FF[nt]);
                    }
                }
            }
            __syncthreads();
        }
    }
}

struct Dn2Frag { bf16x8 am[2]; uint2 hr[2]; };
__device__ __forceinline__ void dn2_load(Dn2Frag& f, const bf16_t* Mg, int w, int l15, int lq, int i0, int hf) {
#pragma unroll
    for (int ks = 0; ks < 2; ++ks) f.am[ks] = *(const bf16x8*)(Mg + (16 * w + l15) * 64 + ks * 32 + lq * 8);
#pragma unroll
    for (int n2 = 0; n2 < 2; ++n2) f.hr[n2] = *(const uint2*)(Mg + 4096 + (32 * hf + 16 * n2 + l15) * 64 + i0);
}
__device__ __forceinline__ void dn2_step(const Dn2Frag& f, int c, int d, int hf, bf16_t* STc, char* smem, int l15, int lq, int i0) {
    const char* sS = smem + (c & 1) * 4096;
    char* sN = smem + ((c + 1) & 1) * 4096;
    f32x4 acc[2];
#pragma unroll
    for (int n2 = 0; n2 < 2; ++n2)
        acc[n2] = (f32x4){__uint_as_float(f.hr[n2].x << 16), __uint_as_float(f.hr[n2].x & 0xffff0000u),
                          __uint_as_float(f.hr[n2].y << 16), __uint_as_float(f.hr[n2].y & 0xffff0000u)};
#pragma unroll
    for (int ks = 0; ks < 2; ++ks)
#pragma unroll
        for (int n2 = 0; n2 < 2; ++n2) {
            const bf16x8 bs = *(const bf16x8*)(sS + lds_off(16 * n2 + l15, ks * 4 + lq));
            acc[n2] = __builtin_amdgcn_mfma_f32_16x16x32_bf16(f.am[ks], bs, acc[n2], 0, 0, 0);
        }
    const int cn = c + 1;
    const bool st = (cn >= 4 && cn <= 35);
    const int pbi = (d == 0 ? cn : 39 - cn) - 4;
#pragma unroll
    for (int n2 = 0; n2 < 2; ++n2) {
        uint2 o; o.x = pack_bf2(acc[n2][0], acc[n2][1]); o.y = pack_bf2(acc[n2][2], acc[n2][3]);
        const int cl = 16 * n2 + l15;
        *(uint2*)(sN + el_off(cl, i0)) = o;
        if (st) *(uint2*)(STc + (size_t)pbi * 4096 + (32 * hf + cl) * 64 + i0) = o;
    }
    __syncthreads();
}
__device__ __forceinline__ void ph_dn2(const Params& p, int bid, int nb, char* smem) {
    if (bid >= 256) return;
    const int tid = threadIdx.x, lane = tid & 63, w = tid >> 6, l15 = lane & 15, lq = lane >> 4;
    const int chain = bid >> 1, hf = bid & 1, d = chain & 1;
    const bf16_t* MHc = p.MH + (size_t)chain * 36 * 2 * 4096;
    bf16_t* STc = p.ST + (size_t)chain * 32 * 4096;
    for (int i = tid; i < 4096 / 16; i += NTHR) *(u32x4*)(smem + i * 16) = (u32x4){0u, 0u, 0u, 0u};
    __syncthreads();
    const int i0 = 16 * w + 4 * lq;
    Dn2Frag f0, f1, f2, f3;
    dn2_load(f0, MHc + (size_t)0 * 8192, w, l15, lq, i0, hf);
    dn2_load(f1, MHc + (size_t)1 * 8192, w, l15, lq, i0, hf);
    dn2_load(f2, MHc + (size_t)2 * 8192, w, l15, lq, i0, hf);
    dn2_load(f3, MHc + (size_t)3 * 8192, w, l15, lq, i0, hf);
    for (int c0 = 0; c0 < 36; c0 += 4) {
        const bool more = (c0 + 4 < 36);
        dn2_step(f0, c0 + 0, d, hf, STc, smem, l15, lq, i0);
        if (more) dn2_load(f0, MHc + (size_t)(c0 + 4) * 8192, w, l15, lq, i0, hf);
        dn2_step(f1, c0 + 1, d, hf, STc, smem, l15, lq, i0);
        if (more) dn2_load(f1, MHc + (size_t)(c0 + 5) * 8192, w, l15, lq, i0, hf);
        dn2_step(f2, c0 + 2, d, hf, STc, smem, l15, lq, i0);
        if (more) dn2_load(f2, MHc + (size_t)(c0 + 6) * 8192, w, l15, lq, i0, hf);
        dn2_step(f3, c0 + 3, d, hf, STc, smem, l15, lq, i0);
        if (more) dn2_load(f3, MHc + (size_t)(c0 + 7) * 8192, w, l15, lq, i0, hf);
    }
}

__device__ __forceinline__ void ph_dn3(const Params& p, int bid, int nb, char* smem) {
    const int tid = threadIdx.x, lane = tid & 63, w = tid >> 6, l15 = lane & 15, lq = lane >> 4;
    const int srow = tid >> 3, sch = (tid & 7) ^ ((srow >> 1) & 7);
    LAS char* lbase = (LAS char*)smem + w * 1024;
#define DN3_STAGE(BUF, U_) do { const int bh_ = (U_) >> 5, pbi_ = (U_) & 31; \
        _Pragma("unroll") for (int d_ = 0; d_ < 2; ++d_) { \
            const bf16_t* Sg_ = p.ST + ((size_t)(bh_ * 2 + d_) * 32 + pbi_) * 4096 + (size_t)srow * 64 + sch * 8; \
            _Pragma("unroll") for (int i_ = 0; i_ < 2; ++i_) \
                __builtin_amdgcn_global_load_lds((const void*)(Sg_ + (size_t)(32 * i_) * 64), (LAS void*)(lbase + (BUF) * 16384 + d_ * 8192 + i_ * 4096), 16, 0, 0); } } while (0)
    int u = bid, buf = 0;
    if (u < 64 * 32) DN3_STAGE(0, u);
    for (; u < 64 * 32; u += nb, buf ^= 1) {
        const int bh = u >> 5, pbi = u & 31, b = bh >> 3, h = bh & 7;
        const int s = 16 * w + l15;
        const size_t rl = (size_t)b * SEQ + pbi * 64 + s;
        f32x4 zdv[4];
#pragma unroll
        for (int mt = 0; mt < 4; ++mt) zdv[mt] = ld_bf4(p.Pz + rl * PZ_W + 512 + h * 64 + 16 * mt + 4 * lq);
        f32x4 acc[4];
        acc4_zero(acc);
        bf16x8 be[2][2];
#pragma unroll
        for (int d = 0; d < 2; ++d) {
            const bf16_t* Eg = p.EF + ((size_t)((bh * 2 + d) * 32 + pbi) * 2) * 4096;
            const bf16_t* Fg = Eg + 4096;
#pragma unroll
            for (int mt = 0; mt < 4; ++mt) acc[mt] += ld_bf4(Fg + s * 64 + 16 * mt + 4 * lq);
#pragma unroll
            for (int ks = 0; ks < 2; ++ks) be[d][ks] = *(const bf16x8*)(Eg + s * 64 + ks * 32 + lq * 8);
        }
        __syncthreads();
        if (u + nb < 64 * 32) DN3_STAGE(buf ^ 1, u + nb);
#pragma unroll
        for (int d = 0; d < 2; ++d) {
            const char* sS = smem + buf * 16384 + d * 8192;
#pragma unroll
            for (int ks = 0; ks < 2; ++ks)
#pragma unroll
                for (int mt = 0; mt < 4; ++mt) {
                    const bf16x8 as = *(const bf16x8*)(sS + lds_off(16 * mt + l15, ks * 4 + lq));
                    acc[mt] = __builtin_amdgcn_mfma_f32_16x16x32_bf16(as, be[d][ks], acc[mt], 0, 0, 0);
                }
        }
        float ss = 0.f;
#pragma unroll
        for (int mt = 0; mt < 4; ++mt)
#pragma unroll
            for (int rg = 0; rg < 4; ++rg) ss += acc[mt][rg] * acc[mt][rg];
        ss = xrow_sum(ss);
        const float rstd = rsqrtf(ss * (1.f / 64.f) + EPSF);
#pragma unroll
        for (int mt = 0; mt < 4; ++mt) {
            const f32x4 nw = *(const f32x4*)(p.dn_norm_w + 16 * mt + 4 * lq);
            f32x4 o;
#pragma unroll
            for (int rg = 0; rg < 4; ++rg) o[rg] = acc[mt][rg] * rstd * nw[rg] * silu_f(zdv[mt][rg]);
            st_bf4(p.A_dn + rl * 512 + h * 64 + 16 * mt + 4 * lq, o);
        }
    }
#undef DN3_STAGE
    __syncthreads();
}


__device__ __forceinline__ void ph_inproj(const Params& p, int bid, int nb, char* smem) {
    const int UA = 2 * 120 + 16 * 144, UZ = 128 * 8;
    const bf16_t* hl = p.h + (size_t)NCTX * DM;
    int u, tm, tn;
    for (int it = 0; next_unit(it, UA + UZ, bid, nb, u); ++it) {
        if (u < 240) { const int g = u / 120, r = u % 120; tm = g * 8 + (r & 7); tn = 3 + (r >> 3); gemm_store_bf16(p.h, DM, p.Wt_a, 1024, tm, tn, p.Pa, PA_W, smem); }
        else if (u < UA) { unit_mn(u - 240 + 288, 18, tm, tn); gemm_store_bf16(p.h, DM, p.Wt_a, 1024, tm, tn, p.Pa, PA_W, smem); }
        else { unit_mn(u - UA, 8, tm, tn); gemm_store_bf16(hl, DM, p.Wt_z, 1024, tm, tn, p.Pz, PZ_W, smem); }
    }
}

__device__ __forceinline__ void ph_gates(const Params& p, int bid, int nb, char* smem) {
    const bf16_t* hl = p.h + (size_t)NCTX * DM;
    int u, tm, tn;
    for (int it = 0; next_unit(it, 128 * 16, bid, nb, u); ++it) {
        unit_mn(u, 16, tm, tn);
        gemm_store_bf16(hl, DM, p.Wt_g, 1024, tm, tn, p.Pg, PG_W, smem);
    }
}

__device__ __forceinline__ void ph_merge(const Params& p, int bid, int nb, char* smem) {
    int u, tm, tn;
    for (int it = 0; next_unit(it, 128 * 8, bid, nb, u); ++it) {
        unit_mn(u, 8, tm, tn);
        const int m0 = tm * 128, n0 = tn * 128;
        f32x4 acc[4][4];
        uint2 mm[4][4];
        u32x4 gw[2][4];
        {
        EPI_COORDS_OPAQUE(p1)
#pragma unroll
        for (int j = 0; j < 2; ++j)
#pragma unroll
            for (int mt = 0; mt < 4; ++mt) gw[j][mt] = *(const u32x4*)(p.Pg + (size_t)EPI_ROW(mt) * PG_W + EPI_COL(2 * j));
        }
        acc_zero<4>(acc);
        gemm_tile_acc<4>(acc, p.A_mla, 512, p.Wt_mo, 512, 512, m0, n0, smem);
#pragma unroll
        for (int j = 0; j < 2; ++j)
#pragma unroll
            for (int mt = 0; mt < 4; ++mt) {
#pragma unroll
                for (int q = 0; q < 2; ++q) {
                    const int nt = 2 * j + q;
                    const float g0 = __uint_as_float(gw[j][mt][2 * q] << 16), g1 = __uint_as_float(gw[j][mt][2 * q] & 0xffff0000u);
                    const float g2 = __uint_as_float(gw[j][mt][2 * q + 1] << 16), g3 = __uint_as_float(gw[j][mt][2 * q + 1] & 0xffff0000u);
                    mm[nt][mt].x = pack_bf2(sigmoid_f(g0) * acc[nt][mt][0], sigmoid_f(g1) * acc[nt][mt][1]);
                    mm[nt][mt].y = pack_bf2(sigmoid_f(g2) * acc[nt][mt][2], sigmoid_f(g3) * acc[nt][mt][3]);
                }
            }
        {
        EPI_COORDS_OPAQUE(p2)
#pragma unroll
        for (int j = 0; j < 2; ++j)
#pragma unroll
            for (int mt = 0; mt < 4; ++mt) gw[j][mt] = *(const u32x4*)(p.Pg + (size_t)EPI_ROW(mt) * PG_W + 1024 + EPI_COL(2 * j));
        }
        acc_zero<4>(acc);
        gemm_tile_acc<4>(acc, p.A_dn, 512, p.Wt_do, 512, 512, m0, n0, smem);
        {
        EPI_COORDS_OPAQUE(b)
#pragma unroll
        for (int j = 0; j < 2; ++j)
#pragma unroll
            for (int mt = 0; mt < 4; ++mt) {
                u32x4 ov;
#pragma unroll
                for (int q = 0; q < 2; ++q) {
                    const int nt = 2 * j + q;
                    const float g0 = __uint_as_float(gw[j][mt][2 * q] << 16), g1 = __uint_as_float(gw[j][mt][2 * q] & 0xffff0000u);
                    const float g2 = __uint_as_float(gw[j][mt][2 * q + 1] << 16), g3 = __uint_as_float(gw[j][mt][2 * q + 1] & 0xffff0000u);
                    const float o0 = __uint_as_float(mm[nt][mt].x << 16) + sigmoid_f(g0) * acc[nt][mt][0];
                    const float o1 = __uint_as_float(mm[nt][mt].x & 0xffff0000u) + sigmoid_f(g1) * acc[nt][mt][1];
                    const float o2 = __uint_as_float(mm[nt][mt].y << 16) + sigmoid_f(g2) * acc[nt][mt][2];
                    const float o3 = __uint_as_float(mm[nt][mt].y & 0xffff0000u) + sigmoid_f(g3) * acc[nt][mt][3];
                    ov[2 * q] = pack_bf2(o0, o1); ov[2 * q + 1] = pack_bf2(o2, o3);
                }
                *(u32x4*)(p.Mb + (size_t)EPI_ROW(mt) * 1024 + EPI_COL(2 * j)) = ov;
            }
        }
    }
}

__device__ __forceinline__ void ph_out(const Params& p, int bid, int nb, char* smem) {
    int u, tm, tn;
    for (int it = 0; next_unit(it, 128 * 8, bid, nb, u); ++it) {
        unit_mn(u, 8, tm, tn);
        const int m0 = tm * 128, n0 = tn * 128;
        f32x4 acc[4][4], xv[4][4];
        EPI_COORDS
#pragma unroll
        for (int nt = 0; nt < 4; ++nt)
#pragma unroll
            for (int mt = 0; mt < 4; ++mt) xv[nt][mt] = *(const f32x4*)(p.x + (size_t)EPI_ROW(mt) * DM + EPI_COL(nt));
        const float* gp = p.mod + (m0 / SEQ) * 3072 + 2048;
        f32x4 gate[4];
#pragma unroll
        for (int nt = 0; nt < 4; ++nt) gate[nt] = *(const f32x4*)(gp + EPI_COL(nt));
        acc_zero<4>(acc);
        gemm_tile_acc<4>(acc, p.Mb, 1024, p.Wt_out, 1024, 1024, m0, n0, smem);
#pragma unroll
        for (int nt = 0; nt < 4; ++nt)
#pragma unroll
            for (int mt = 0; mt < 4; ++mt)
                *(f32x4*)(p.out + (size_t)EPI_ROW(mt) * DM + EPI_COL(nt)) = xv[nt][mt] + gate[nt] * acc[nt][mt];
    }
}

#define XB_TMO      128
#define XB_XCNT(j)  (256  + 64 * (j))
#define XB_XSUB(j)  (1280 + 64 * (j))
#define XB_XGEN(j)  (2304 + 64 * (j))
#define XB_TOP      3328
#define XB_TOPGEN   3392
#define XCD_BAR_WORDS 3456
#define XB_SPIN_CAP (1u << 20)
__device__ __forceinline__ unsigned xb_ld(unsigned* p)              { return __hip_atomic_load(p, __ATOMIC_RELAXED, __HIP_MEMORY_SCOPE_AGENT); }
__device__ __forceinline__ unsigned xb_add(unsigned* p, unsigned v) { return __hip_atomic_fetch_add(p, v, __ATOMIC_RELAXED, __HIP_MEMORY_SCOPE_AGENT); }
__device__ __forceinline__ unsigned xb_xcc_id() { return (unsigned)__builtin_amdgcn_s_getreg((3 << 11) | 20) & 0xFu; }
#define XB_SPIN(cond, bar) do { unsigned _sp = 0; while (cond) { __builtin_amdgcn_s_sleep(1); \
    if ((++_sp & 255u) == 0u) { if (xb_ld(&(bar)[XB_TMO])) break; if (_sp > XB_SPIN_CAP) { atomicAdd(&(bar)[XB_TMO], 1u); break; } } } } while (0)
struct XcdBarrier { unsigned* bar; unsigned x; volatile LAS unsigned* st; };
__device__ __forceinline__ XcdBarrier xcd_barrier_post(unsigned* bar, volatile LAS unsigned* st) {
    XcdBarrier b; b.bar = bar; b.x = xb_xcc_id(); b.st = st;
    if (threadIdx.x == 0) (void)xb_add(&bar[XB_XCNT(b.x)], 1u);
    return b;
}
__device__ __forceinline__ void xcd_barrier_complete(unsigned* bar, unsigned x, unsigned& nloc, unsigned& nx) {
    const unsigned G = gridDim.x * gridDim.y * gridDim.z;
    unsigned sum, cnt, mine, sp = 0u;
    for (;;) {
        sum = 0u; cnt = 0u; mine = 0u;
#pragma unroll
        for (unsigned j = 0; j < 16; ++j) { const unsigned c = xb_ld(&bar[XB_XCNT(j)]); sum += c; cnt += (c > 0u) ? 1u : 0u; mine = (j == x) ? c : mine; }
        if (sum == G) break;
        __builtin_amdgcn_s_sleep(1);
        if ((++sp & 255u) == 0u) { if (xb_ld(&bar[XB_TMO])) break; if (sp > XB_SPIN_CAP) { atomicAdd(&bar[XB_TMO], 1u); break; } }
    }
    nloc = mine > 0u ? mine : 1u; nx = cnt > 0u ? cnt : 1u;
}
__device__ __forceinline__ void xcd_barrier(const XcdBarrier& b) {
    asm volatile("s_waitcnt vmcnt(0)" ::: "memory");
    __syncthreads();
    if (threadIdx.x == 0) {
        unsigned* bar = b.bar;
        __builtin_amdgcn_s_waitcnt(0);
        unsigned nloc = b.st[0], nx = b.st[1];
        if (nloc == 0u) { xcd_barrier_complete(bar, b.x, nloc, nx); b.st[0] = nloc; b.st[1] = nx; }
        const unsigned old = xb_add(&bar[XB_XSUB(b.x)], 1u);
        const unsigned gen = old / nloc;
        if (old + 1u == (gen + 1u) * nloc) {
            __builtin_amdgcn_fence(__ATOMIC_RELEASE, "agent");
            asm volatile("s_waitcnt vmcnt(0)" ::: "memory");
            const unsigned og = xb_add(&bar[XB_TOP], 1u);
            const unsigned tg = og / nx;
            if (og + 1u == (tg + 1u) * nx) xb_add(&bar[XB_TOPGEN], 1u);
            else XB_SPIN(xb_ld(&bar[XB_TOPGEN]) == tg, bar);
            __builtin_amdgcn_fence(__ATOMIC_ACQUIRE, "agent");
            xb_add(&bar[XB_XGEN(b.x)], 1u);
            asm volatile("s_waitcnt vmcnt(0)" ::: "memory");
        } else {
            XB_SPIN(xb_ld(&bar[XB_XGEN(b.x)]) == gen, bar);
            __builtin_amdgcn_fence(__ATOMIC_ACQUIRE, "agent");
            asm volatile("s_waitcnt vmcnt(0)" ::: "memory");
        }
    }
    __syncthreads();
}

__global__ void __launch_bounds__(NTHR, 2) fwd_megakernel(Params p) {
    __shared__ __attribute__((aligned(16))) char smem[SMEM_BYTES];
    const int bid = blockIdx.x, nb = gridDim.x;
    volatile LAS unsigned* bst = (volatile LAS unsigned*)(smem + SMEM_BYTES - 16);
    if (threadIdx.x == 0) { bst[0] = 0u; bst[1] = 0u; }
    __syncthreads();
    const XcdBarrier xb = xcd_barrier_post(p.bar, bst);

    ph_mod(p, bid, nb, smem);
    ph_wprep(p, bid, nb, smem);
    xcd_barrier(xb);
    ph_norm(p, bid, nb, smem);
    xcd_barrier(xb);
    ph_inproj(p, bid, nb, smem);
    xcd_barrier(xb);
    ph_mla_proj(p, bid, nb, smem);
    xcd_barrier(xb);
    ph_attn(p, bid, nb, smem);
    xcd_barrier(xb);
    ph_dn1(p, bid, nb, smem);
    xcd_barrier(xb);
    ph_dn2(p, bid, nb, smem);
    xcd_barrier(xb);
    ph_dn3(p, bid, nb, smem);
    ph_gates(p, bid, nb, smem);
    xcd_barrier(xb);
    ph_merge(p, bid, nb, smem);
    xcd_barrier(xb);
    ph_out(p, bid, nb, smem);
}

extern "C" void kernel_launch(void* const* d_in, const int* in_sizes, int n_in,
                              void* d_out, int out_size, void* d_ws, size_t ws_size,
                              hipStream_t stream) {
    static int grid_blocks = 0;
    if (!grid_blocks) {
        int dev = 0, cus = 0, per_cu = 0;
        (void)hipGetDevice(&dev);
        (void)hipDeviceGetAttribute(&cus, hipDeviceAttributeMultiprocessorCount, dev);
        (void)hipOccupancyMaxActiveBlocksPerMultiprocessor(&per_cu, fwd_megakernel, NTHR, 0);
        if (per_cu > 2) per_cu = 2;
        if (per_cu < 1) per_cu = 1;
        grid_blocks = cus * per_cu;
    }
    if (n_in != 21 || ws_size < (size_t)268435456 || out_size != NL * DM) {
        fprintf(stderr, "kernel_launch: built for 21 inputs, a %d-float output and >= 256 MiB of workspace (got %d inputs, out %d, ws %zu)\n", NL * DM, n_in, out_size, ws_size);
        return;
    }
    Params p{};
    const float** fp = (const float**)&p;
    for (int i = 0; i < 21; ++i) fp[i] = (const float*)d_in[i];
    p.out = (float*)d_out;
    char* ws = (char*)d_ws;
    char* ob = (char*)d_out;
    const size_t R_W = 0;
    const size_t R_H = 16777216;
    const size_t R_Z = R_H + 37748736;
    const size_t R_A = R_Z + 33554432;
    const size_t R_F = R_A + 84934656;
    {
        size_t o = R_W;
        p.Wt_a = (bf16_t*)(ws + o); o += 4718592;
        p.Wt_z = (bf16_t*)(ws + o); o += 2097152;
        p.Wt_g = (bf16_t*)(ws + o); o += 4194304;
        p.Wt_uq = (bf16_t*)(ws + o); o += 589824;
        p.Wt_ukv = (bf16_t*)(ws + o); o += 524288;
        p.Wt_mo = (bf16_t*)(ws + o); o += 1048576;
        p.Wt_do = (bf16_t*)(ws + o); o += 1048576;
        p.Wt_out = (bf16_t*)(ws + o); o += 2097152;
        p.mod = (float*)(ws + o); o += 110592;
        p.bar = (unsigned*)(ws + o); o += XCD_BAR_WORDS * 4;
        p.rope = (float*)(ws + o); o += 4096;
    }
    p.h = (bf16_t*)(ws + R_H);
    p.Pz = (bf16_t*)(ws + R_Z);
    p.Pa = (bf16_t*)(ws + R_A);
    p.Qb = (bf16_t*)(ws + R_F + 22020096);
    p.Kb = (bf16_t*)(ws + R_F + 47185920);
    p.Vt = (bf16_t*)(ws + R_F + 75497472);
    p.MH = (bf16_t*)(ws + R_F + 16777216);
    p.EF = (bf16_t*)(ob);
    p.ST = (bf16_t*)(ws + R_A);
    p.A_mla = (bf16_t*)(ws + R_F);
    p.A_dn = (bf16_t*)(ws + R_A + 50331648);
    p.Pg = (bf16_t*)(ws + R_F + 16777216);
    p.Mb = (bf16_t*)(ws + R_H);
    (void)hipMemsetAsync(p.mod, 0, 110592 + XCD_BAR_WORDS * 4, stream);
    void* args[] = {&p};
    hipError_t err = hipLaunchCooperativeKernel((void*)fwd_megakernel, dim3(grid_blocks), dim3(NTHR), args, 0, stream);
    if (err != hipSuccess) fprintf(stderr, "cooperative launch failed: %s (grid %d)\n", hipGetErrorString(err), grid_blocks);
}
```

```cpp
#include <hip/hip_runtime.h>
#include <stdint.h>
#include <cstdio>

typedef uint16_t bf16_t;
#define LAS __attribute__((address_space(3)))

#define NB 8
#define SEQ 2048
#define CTXL 256
#define TPB 2304
#define NCTX 2048
#define NL 16384
#define NT 18432
#define DM 1024
#define IN_DIM 5312
#define PA_W 2304
#define PZ_W 1024
#define PG_W 2048
#define PA_CQ 0
#define PA_CKV 384
#define PA_KR 640
#define PA_DQ 672
#define PA_DK 1184
#define PA_DV 1696
#define PA_DB 2208
#define PA_DA 2224
#define EPSF 1e-6f
#define NTHR 256
#define VTID ((int)(threadIdx.x & 255u))
#define SMEM_BYTES 77824

struct Params {
    const float *x, *c, *ctx, *c_ctx, *w_mod, *b_mod, *norm_w, *w_in, *q_norm_w, *w_uq, *kv_norm_w, *w_ukv, *qhn_w, *khn_w,
        *mla_w_o, *conv_w, *a_log, *dt_bias, *dn_norm_w, *dn_w_o, *w_out;
    float* out;
    bf16_t *h, *Pa, *Pz, *Pg, *Qb, *Vt, *Kb, *MH, *EF, *ST, *A_mla, *A_dn, *Mb;
    bf16_t *Wt_a, *Wt_z, *Wt_g, *Wt_uq, *Wt_ukv, *Wt_mo, *Wt_do, *Wt_out;
    float *mod, *rope;
    unsigned* bar;
};

typedef float f32x4 __attribute__((ext_vector_type(4)));
typedef unsigned u32x4 __attribute__((ext_vector_type(4)));
typedef __bf16 bf16v2_t __attribute__((ext_vector_type(2)));
typedef float f32x2 __attribute__((ext_vector_type(2)));
__device__ __forceinline__ uint32_t pack_bf2(float lo, float hi) {
    f32x2 v = {lo, hi};
    bf16v2_t b = __builtin_convertvector(v, bf16v2_t);
    return __builtin_bit_cast(uint32_t, b);
}
__device__ __forceinline__ void st_bf4(bf16_t* p, f32x4 v) {
    uint2 o; o.x = pack_bf2(v[0], v[1]); o.y = pack_bf2(v[2], v[3]);
    *(uint2*)p = o;
}
__device__ __forceinline__ float bf2f(bf16_t v) { return __uint_as_float(((uint32_t)v) << 16); }
__device__ __forceinline__ bf16_t f2bf(float f) {
    uint32_t u = __float_as_uint(f);
    u += 0x7fffu + ((u >> 16) & 1u);
    return (bf16_t)(u >> 16);
}
__device__ __forceinline__ float silu_f(float v) { return v * __builtin_amdgcn_rcpf(1.f + __expf(-v)); }
__device__ __forceinline__ float sigmoid_f(float v) { return __builtin_amdgcn_rcpf(1.f + __expf(-v)); }
template <int CTRL> __device__ __forceinline__ float dpp_mov(float v) {
    return __builtin_bit_cast(float, __builtin_amdgcn_update_dpp(0, __builtin_bit_cast(int, v), CTRL, 0xF, 0xF, true));
}
__device__ __forceinline__ float row16_sum(float v) {
    v += dpp_mov<0xB1>(v); v += dpp_mov<0x4E>(v); v += dpp_mov<0x141>(v); v += dpp_mov<0x140>(v); return v;
}
__device__ __forceinline__ float rdlane(float v, int l) { return __builtin_bit_cast(float, __builtin_amdgcn_readlane(__builtin_bit_cast(int, v), l)); }
__device__ __forceinline__ float wave_sum(float v) {
    v += dpp_mov<0xB1>(v);
    v += dpp_mov<0x4E>(v);
    v += dpp_mov<0x141>(v);
    v += dpp_mov<0x140>(v);
    return (rdlane(v, 0) + rdlane(v, 16)) + (rdlane(v, 32) + rdlane(v, 48));
}
__device__ __forceinline__ float xrow_sum(float v) { v += __shfl_xor(v, 16); v += __shfl_xor(v, 32); return v; }
__device__ __forceinline__ void ph_mod(const Params& p, int bid, int nb, char* smem) {
    float* sc = (float*)smem;
    for (int item = bid; item < 64; item += nb) {
        const int k0 = item * 16, tid = VTID;
        __syncthreads();
        if (tid < 144) {
            const int r = tid >> 4, kk = tid & 15;
            const float v = (r < 8) ? p.c[r * 1024 + k0 + kk] : p.c_ctx[k0 + kk];
            sc[tid] = silu_f(v);
        }
        __syncthreads();
#pragma unroll 1
        for (int half = 0; half < 2; ++half) {
            float acc[6][9];
#pragma unroll
            for (int q = 0; q < 6; ++q)
#pragma unroll
                for (int r = 0; r < 9; ++r) acc[q][r] = 0.f;
            const float* wp = p.w_mod + (size_t)k0 * 3072 + half * 1536 + tid;
#pragma unroll 4
            for (int kk = 0; kk < 16; ++kk) {
                float wv[6];
#pragma unroll
                for (int q = 0; q < 6; ++q) wv[q] = wp[(size_t)kk * 3072 + q * 256];
#pragma unroll
                for (int r = 0; r < 9; ++r) {
                    const float s = sc[r * 16 + kk];
#pragma unroll
                    for (int q = 0; q < 6; ++q) acc[q][r] += s * wv[q];
                }
            }
#pragma unroll
            for (int q = 0; q < 6; ++q) {
                const int j = half * 1536 + q * 256 + tid;
                const float bb = (item == 0) ? p.b_mod[j] : 0.f;
#pragma unroll
                for (int r = 0; r < 9; ++r) atomicAdd(p.mod + r * 3072 + j, acc[q][r] + bb);
            }
        }
    }
}

__device__ __forceinline__ void ph_norm(const Params& p, int bid, int nb, char* smem) {
    const int lane = VTID & 63, gw = bid * 4 + (VTID >> 6), nw = nb * 4;
    const int per = (NT + nw - 1) / nw;
    const int r0 = gw * per, r1 = (r0 + per < NT) ? r0 + per : NT;
    auto rowptr = [&](int rr) -> const float* { return (rr < NCTX) ? p.ctx + (size_t)rr * DM : p.x + (size_t)(rr - NCTX) * DM; };
    f32x4 v[4], vn[4], av[4], sv[4];
    int cur_m = -1;
    if (r0 < r1) {
        const float* src = rowptr(r0);
#pragma unroll
        for (int i = 0; i < 4; ++i) v[i] = *(const f32x4*)(src + i * 256 + lane * 4);
    }
    for (int r = r0; r < r1; ++r) {
        if (r + 1 < r1) {
            const float* src = rowptr(r + 1);
#pragma unroll
            for (int i = 0; i < 4; ++i) vn[i] = *(const f32x4*)(src + i * 256 + lane * 4);
        }
        const int mrow = (r < NCTX) ? 8 : (r - NCTX) / SEQ;
        if (mrow != cur_m) {
            cur_m = mrow;
            const float* shift = p.mod + mrow * 3072;
            const float* scale = shift + 1024;
#pragma unroll
            for (int i = 0; i < 4; ++i) {
                const int k = i * 256 + lane * 4;
                const f32x4 nwv = *(const f32x4*)(p.norm_w + k), sc = *(const f32x4*)(scale + k);
                sv[i] = *(const f32x4*)(shift + k);
#pragma unroll
                for (int e2 = 0; e2 < 4; ++e2) av[i][e2] = nwv[e2] * (1.f + sc[e2]);
            }
        }
        float ss = 0.f;
#pragma unroll
        for (int i = 0; i < 4; ++i) ss += v[i][0] * v[i][0] + v[i][1] * v[i][1] + v[i][2] * v[i][2] + v[i][3] * v[i][3];
        ss = wave_sum(ss);
        const float rstd = rsqrtf(ss * (1.f / 1024.f) + EPSF);
#pragma unroll
        for (int i = 0; i < 4; ++i) {
            f32x4 y;
#pragma unroll
            for (int e2 = 0; e2 < 4; ++e2) y[e2] = (v[i][e2] * rstd) * av[i][e2] + sv[i][e2];
            st_bf4(p.h + (size_t)r * DM + i * 256 + lane * 4, y);
        }
#pragma unroll
        for (int i = 0; i < 4; ++i) v[i] = vn[i];
    }
}


__device__ __forceinline__ void wprep_unit(const float* __restrict__ W, int ldw, int K, int n0, int k0, int srcbase, bf16_t* __restrict__ dst, float* tile,
                                           const float* __restrict__ kscale) {
    const int tid = VTID;
    {
        const int n4 = (tid & 7) * 4, kk = tid >> 3;
        float4 v[4];
#pragma unroll
        for (int q = 0; q < 4; ++q) {
            const int k = kk + 32 * q;
            v[q] = make_float4(0.f, 0.f, 0.f, 0.f);
            if (srcbase >= 0) v[q] = *(const float4*)(W + (size_t)(k0 + k) * ldw + srcbase + n4);
        }
#pragma unroll
        for (int q = 0; q < 4; ++q) {
            const int k = kk + 32 * q;
            if (kscale) { const float s = kscale[k0 + k]; v[q].x *= s; v[q].y *= s; v[q].z *= s; v[q].w *= s; }
            float* t = tile + k * 33 + n4;
            t[0] = v[q].x; t[1] = v[q].y; t[2] = v[q].z; t[3] = v[q].w;
        }
    }
    __syncthreads();
    {
        const int n = tid >> 3;
#pragma unroll
        for (int q = 0; q < 2; ++q) {
            const int kc = (tid & 7) + 8 * q;
            const float* t = tile + (kc * 8) * 33 + n;
            uint4 o;
            o.x = pack_bf2(t[0 * 33], t[1 * 33]); o.y = pack_bf2(t[2 * 33], t[3 * 33]);
            o.z = pack_bf2(t[4 * 33], t[5 * 33]); o.w = pack_bf2(t[6 * 33], t[7 * 33]);
            *(uint4*)(dst + (size_t)(n0 + n) * K + k0 + kc * 8) = o;
        }
    }
    __syncthreads();
}

__device__ __forceinline__ void ph_wprep(const Params& p, int bid, int nb, char* smem) {
    float* tile = (float*)smem;
    const int U0 = 72 * 8, U1 = 32 * 8, U2 = 64 * 8, U3 = 24 * 3, U4 = 32 * 2, U5 = 32 * 4, U6 = 32 * 4, U7 = 32 * 8;
    const int UT = U0 + U1 + U2 + U3 + U4 + U5 + U6 + U7;
    for (int u = bid; u < UT; u += nb) {
        int v = u;
        const float* W; int ldw, K; bf16_t* dst; int job;
        if (v < U0) { job = 0; W = p.w_in; ldw = IN_DIM; K = 1024; dst = p.Wt_a; }
        else if ((v -= U0) < U1) { job = 1; W = p.w_in; ldw = IN_DIM; K = 1024; dst = p.Wt_z; }
        else if ((v -= U1) < U2) { job = 2; W = p.w_in; ldw = IN_DIM; K = 1024; dst = p.Wt_g; }
        else if ((v -= U2) < U3) { job = 3; W = p.w_uq; ldw = 768; K = 384; dst = p.Wt_uq; }
        else if ((v -= U3) < U4) { job = 4; W = p.w_ukv; ldw = 1024; K = 256; dst = p.Wt_ukv; }
        else if ((v -= U4) < U5) { job = 5; W = p.mla_w_o; ldw = 1024; K = 512; dst = p.Wt_mo; }
        else if ((v -= U5) < U6) { job = 6; W = p.dn_w_o; ldw = 1024; K = 512; dst = p.Wt_do; }
        else { v -= U6; job = 7; W = p.w_out; ldw = 1024; K = 1024; dst = p.Wt_out; }
        const int nkt = K / 128;
        const int n0 = (v / nkt) * 32, k0 = (v % nkt) * 128;
        int srcbase = n0;
        if (job == 0) {
            if (n0 < 672) srcbase = n0;
            else if (n0 < 2208) { const int r = n0 - 672, hh = r / 192, g = (r % 192) >> 6, i0 = r & 63; srcbase = 1184 + g * 512 + hh * 64 + i0; }
            else srcbase = (n0 < 2240) ? n0 + 1024 : -1;
        }
        else if (job == 1) srcbase = (n0 < 512) ? 672 + n0 : 2208 + n0;
        else if (job == 2) srcbase = 3264 + n0;
        const float* ksc = (job == 3) ? p.q_norm_w : (job == 4) ? p.kv_norm_w : nullptr;
        wprep_unit(W, ldw, K, n0, k0, srcbase, dst, tile, ksc);
    }
    if (bid == nb - 1) {
        for (int i = VTID; i < 512; i += NTHR) {
            const int pos = i >> 3, f = i & 7;
            const float ang = (float)pos * powf(10000.f, -(float)f / 8.f);
            p.rope[2 * i] = cosf(ang); p.rope[2 * i + 1] = sinf(ang);
        }
    }
}

typedef short bf16x8 __attribute__((ext_vector_type(8)));


__device__ __forceinline__ int lds_off(int row, int chunk) { return row * 128 + (((chunk ^ (row >> 1)) & 7) << 4); }

__device__ __forceinline__ int epi_perm(int rho) { return 8 * ((rho >> 2) & 3) + 4 * (rho >> 4) + (rho & 3); }

template <int NTN>
__device__ __forceinline__ void gemm_compute_stage(f32x4 (&acc)[NTN][4], const char* sa, int wm, int wn, int l15, int lq) {
    const char* sb = sa + 16384;
#pragma unroll
    for (int ks = 0; ks < 2; ++ks) {
        bf16x8 af[4], bfr[NTN];
#pragma unroll
        for (int mt = 0; mt < 4; ++mt) af[mt] = *(const bf16x8*)(sa + lds_off(wm * 64 + mt * 16 + l15, ks * 4 + lq));
#pragma unroll
        for (int nt = 0; nt < NTN; ++nt) bfr[nt] = *(const bf16x8*)(sb + lds_off(wn * (16 * NTN) + nt * 16 + l15, ks * 4 + lq));
#pragma unroll
        for (int nt = 0; nt < NTN; ++nt)
#pragma unroll
            for (int mt = 0; mt < 4; ++mt)
                acc[nt][mt] = __builtin_amdgcn_mfma_f32_16x16x32_bf16(bfr[nt], af[mt], acc[nt][mt], 0, 0, 0);
    }
}
template <int NTN>
__device__ __forceinline__ void gemm_tile_acc(f32x4 (&acc)[NTN][4], const bf16_t* __restrict__ A, int lda, const bf16_t* __restrict__ Bt, int ldb,
                                              int K, int m0, int n0, char* smem) {
    int tid = VTID;
    asm volatile("" : "+v"(tid));
    const int lane = tid & 63, w = tid >> 6, wm = w >> 1, wn = w & 1;
    const int l15 = lane & 15, lq = lane >> 4;
    const int srow = tid >> 3, sch = (tid & 7) ^ ((srow >> 1) & 7);
    const bf16_t* ap = A + (size_t)(m0 + srow) * lda + sch * 8;
    const int prow = epi_perm(srow & 31);
    const bf16_t* bp = Bt + (size_t)(n0 + prow) * ldb + sch * 8;
    int KT = K >> 6;
    asm volatile("" : "+s"(KT));
    LAS char* lbase = (LAS char*)smem + w * 1024;
#define GT_STAGE(ST_, KT_) do { \
        _Pragma("unroll") for (int i = 0; i < 4; ++i) \
            __builtin_amdgcn_global_load_lds((const void*)(ap + (size_t)(32 * i) * lda + (KT_) * 64), (LAS void*)(lbase + (ST_) * 32768 + i * 4096), 16, 0, 0); \
        _Pragma("unroll") for (int i = 0; i < NTN; ++i) \
            __builtin_amdgcn_global_load_lds((const void*)(bp + (size_t)(32 * i) * ldb + (KT_) * 64), (LAS void*)(lbase + (ST_) * 32768 + 16384 + i * 4096), 16, 0, 0); } while (0)
    GT_STAGE(0, 0);
    __syncthreads();
    for (int kt = 0; kt < KT; ++kt) {
        if (kt + 1 < KT) GT_STAGE((kt + 1) & 1, kt + 1);
        gemm_compute_stage<NTN>(acc, smem + (kt & 1) * 32768, wm, wn, l15, lq);
        __syncthreads();
    }
#undef GT_STAGE
}

template <int NTN>
__device__ __forceinline__ void acc_zero(f32x4 (&acc)[NTN][4]) {
#pragma unroll
    for (int i = 0; i < NTN; ++i)
#pragma unroll
        for (int j = 0; j < 4; ++j) acc[i][j] = (f32x4){0.f, 0.f, 0.f, 0.f};
}

__device__ __forceinline__ bool next_unit(int it, int U, int bid, int nb, int& u) {
    const int x = bid & 7, li = bid >> 3, per = nb >> 3;
    const int lo = (int)(((long)U * x) >> 3), hi = (int)(((long)U * (x + 1)) >> 3);
    u = lo + li + it * per;
    return u < hi;
}
__device__ __forceinline__ void unit_mn(int u, int ntn, int& tm, int& tn) {
    const int g = u / (8 * ntn), r = u % (8 * ntn);
    tm = g * 8 + (r & 7); tn = r >> 3;
}


__device__ __forceinline__ f32x4 ld_bf4(const bf16_t* p) {
    const uint2 r = *(const uint2*)p;
    return (f32x4){__uint_as_float(r.x << 16), __uint_as_float(r.x & 0xffff0000u), __uint_as_float(r.y << 16), __uint_as_float(r.y & 0xffff0000u)};
}
#define EPI_COORDS_OPAQUE(SFX) int tid##SFX = VTID; asm volatile("" : "+v"(tid##SFX)); \
    const int lane_ = tid##SFX & 63, w_ = tid##SFX >> 6, wm_ = w_ >> 1, wn_ = w_ & 1, l15_ = lane_ & 15, lq_ = lane_ >> 4;
#define EPI_COORDS const int lane_ = VTID & 63, w_ = VTID >> 6, wm_ = w_ >> 1, wn_ = w_ & 1, l15_ = lane_ & 15, lq_ = lane_ >> 4;
#define EPI_ROW(mt) (m0 + wm_ * 64 + (mt) * 16 + l15_)
#define EPI_COL(nt) (n0 + wn_ * 64 + 32 * ((nt) >> 1) + 8 * lq_ + 4 * ((nt) & 1))

__device__ __forceinline__ void gemm_store_bf16(const bf16_t* A, int lda, const bf16_t* Bt, int K, int tm, int tn, bf16_t* C, int ldc, char* smem) {
    f32x4 acc[4][4];
    acc_zero<4>(acc);
    const int m0 = tm * 128, n0 = tn * 128;
    gemm_tile_acc<4>(acc, A, lda, Bt, K, K, m0, n0, smem);
    EPI_COORDS
#pragma unroll
    for (int j = 0; j < 2; ++j)
#pragma unroll
        for (int mt = 0; mt < 4; ++mt) {
            u32x4 o;
            o[0] = pack_bf2(acc[2 * j][mt][0], acc[2 * j][mt][1]); o[1] = pack_bf2(acc[2 * j][mt][2], acc[2 * j][mt][3]);
            o[2] = pack_bf2(acc[2 * j + 1][mt][0], acc[2 * j + 1][mt][1]); o[3] = pack_bf2(acc[2 * j + 1][mt][2], acc[2 * j + 1][mt][3]);
            *(u32x4*)(C + (size_t)EPI_ROW(mt) * ldc + EPI_COL(2 * j)) = o;
        }
}

template <int NTN>
__device__ __forceinline__ void gemm_rows_acc(f32x4 (&acc)[NTN][2], float (&ssq)[2], const bf16_t* __restrict__ A, int lda,
                                              const bf16_t* __restrict__ Bt, int ldb, int K, int m0, int n0, char* smem) {
    constexpr int NB_ = NTN / 2;
    int tid = VTID;
    asm volatile("" : "+v"(tid));
    const int lane = tid & 63, w = tid >> 6;
    const int l15 = lane & 15, lq = lane >> 4;
    const int srow = tid >> 3, sch = (tid & 7) ^ ((srow >> 1) & 7);
    const bf16_t* ap = A + (size_t)(m0 + srow) * lda + sch * 8;
    const bf16_t* bp = Bt + (size_t)(n0 + srow) * ldb + sch * 8;
    int KT = K >> 6;
    asm volatile("" : "+s"(KT));
    LAS char* lbase = (LAS char*)smem + w * 1024;
#define GR_STAGE(ST_, KT_) do { \
        _Pragma("unroll") for (int i = 0; i < 4; ++i) \
            __builtin_amdgcn_global_load_lds((const void*)(ap + (size_t)(32 * i) * lda + (KT_) * 64), (LAS void*)(lbase + (ST_) * 32768 + i * 4096), 16, 0, 0); \
        _Pragma("unroll") for (int i = 0; i < NB_; ++i) \
            __builtin_amdgcn_global_load_lds((const void*)(bp + (size_t)(32 * i) * ldb + (KT_) * 64), (LAS void*)(lbase + (ST_) * 32768 + 16384 + i * 4096), 16, 0, 0); } while (0)
    GR_STAGE(0, 0);
    __syncthreads();
    for (int kt = 0; kt < KT; ++kt) {
        if (kt + 1 < KT) GR_STAGE((kt + 1) & 1, kt + 1);
        const char* sa = smem + (kt & 1) * 32768;
        const char* sb = sa + 16384;
#pragma unroll
        for (int ks = 0; ks < 2; ++ks) {
            bf16x8 af[2], bfr[NTN];
#pragma unroll
            for (int mt = 0; mt < 2; ++mt) af[mt] = *(const bf16x8*)(sa + lds_off(w * 32 + mt * 16 + l15, ks * 4 + lq));
#pragma unroll
            for (int nt = 0; nt < NTN; ++nt) bfr[nt] = *(const bf16x8*)(sb + lds_off(nt * 16 + l15, ks * 4 + lq));
#pragma unroll
            for (int mt = 0; mt < 2; ++mt) {
                const u32x4 aw = __builtin_bit_cast(u32x4, af[mt]);
#pragma unroll
                for (int e2 = 0; e2 < 4; ++e2) {
                    const float lo = __uint_as_float(aw[e2] << 16), hi = __uint_as_float(aw[e2] & 0xffff0000u);
                    ssq[mt] += lo * lo + hi * hi;
                }
            }
#pragma unroll
            for (int nt = 0; nt < NTN; ++nt)
#pragma unroll
                for (int mt = 0; mt < 2; ++mt)
                    acc[nt][mt] = __builtin_amdgcn_mfma_f32_16x16x32_bf16(bfr[nt], af[mt], acc[nt][mt], 0, 0, 0);
        }
        __syncthreads();
    }
#undef GR_STAGE
    ssq[0] = xrow_sum(ssq[0]);
    ssq[1] = xrow_sum(ssq[1]);
}

__device__ __forceinline__ void ph_mla_proj(const Params& p, int bid, int nb, char* smem) {
    const int tid = VTID, lane = tid & 63, w = tid >> 6, l15 = lane & 15, lq = lane >> 4;
    float* s_rope = (float*)(smem + 65536);
    float* s_qhn = s_rope + 1024;
    float* s_khn = s_qhn + 96;
    for (int i = tid; i < 1024; i += NTHR) s_rope[i] = p.rope[i];
    if (tid < 96) { s_qhn[tid] = p.qhn_w[tid]; s_khn[tid] = p.khn_w[tid]; }
    __syncthreads();
    const int UQ = 128 * 8, UK = 144 * 8;
    int u;
    for (int it = 0; next_unit(it, UQ + UK, bid, nb, u); ++it) {
        if (u < UQ) {
            const int tm = u >> 3, hh = u & 7;
            const int m0 = NCTX + tm * 128;
            f32x4 acc[6][2];
            float ssq[2] = {0.f, 0.f};
#pragma unroll
            for (int i = 0; i < 6; ++i) { acc[i][0] = (f32x4){0.f, 0.f, 0.f, 0.f}; acc[i][1] = (f32x4){0.f, 0.f, 0.f, 0.f}; }
            gemm_rows_acc<6>(acc, ssq, p.Pa + PA_CQ, PA_W, p.Wt_uq, 384, 384, m0, hh * 96, smem);
#pragma unroll
            for (int mt = 0; mt < 2; ++mt) {
                const int ml = 32 * w + 16 * mt + l15;
                const int rl = tm * 128 + ml;
                const int b = rl >> 11, t = rl & 2047;
                const float rs = rsqrtf(ssq[mt] * (1.f / 384.f) + EPSF);
                float hs = 0.f;
#pragma unroll
                for (int nt = 0; nt < 6; ++nt)
#pragma unroll
                    for (int e = 0; e < 4; ++e) { const float v = acc[nt][mt][e] * rs; acc[nt][mt][e] = v; hs += v * v; }
                hs = xrow_sum(hs);
                const float hr = rsqrtf(hs * (1.f / 96.f) + EPSF) * (0.10206207261596575f * 1.4426950408889634f);
                bf16_t* qd = p.Qb + ((size_t)((b * 8 + hh) * SEQ + t)) * 96 + 4 * lq;
#pragma unroll
                for (int nt = 0; nt < 6; ++nt) {
                    const f32x4 wv = *(const f32x4*)(s_qhn + 16 * nt + 4 * lq);
                    f32x4 v;
#pragma unroll
                    for (int e = 0; e < 4; ++e) v[e] = acc[nt][mt][e] * hr * wv[e];
                    if (nt >= 4) {
                        const int pos = (nt == 4) ? (t >> 6) : (t & 63);
                        const int ph = lq >> 1;
#pragma unroll
                        for (int e = 0; e < 4; ++e) {
                            const float2 cs = *(const float2*)(s_rope + 2 * (pos * 8 + (lq & 1) * 4 + e));
                            const float partner = __shfl_xor(v[e], 32);
                            const float t1 = ph ? partner : v[e], t2 = ph ? v[e] : partner;
                            v[e] = ph ? (t1 * cs.y + t2 * cs.x) : (t1 * cs.x - t2 * cs.y);
                        }
                    }
                    st_bf4(qd + 16 * nt, v);
                }
            }
        } else {
            const int uu = u - UQ;
            const int tm = uu >> 3, hh = uu & 7;
            const int m0 = tm * 128;
            f32x4 acc[8][2];
            float ssq[2] = {0.f, 0.f};
#pragma unroll
            for (int i = 0; i < 8; ++i) { acc[i][0] = (f32x4){0.f, 0.f, 0.f, 0.f}; acc[i][1] = (f32x4){0.f, 0.f, 0.f, 0.f}; }
            gemm_rows_acc<8>(acc, ssq, p.Pa + PA_CKV, PA_W, p.Wt_ukv, 256, 256, m0, hh * 128, smem);
#pragma unroll
            for (int mt = 0; mt < 2; ++mt) {
                const int ml = 32 * w + 16 * mt + l15;
                const int r = m0 + ml;
                int b, pos, t = 0; const bool lat = (r >= NCTX);
                if (!lat) { b = r >> 8; pos = r & 255; }
                else { const int rl = r - NCTX; b = rl >> 11; t = rl & 2047; pos = CTXL + t; }
                const float rs = rsqrtf(ssq[mt] * (1.f / 256.f) + EPSF);
                const u32x4 krw = *(const u32x4*)(p.Pa + (size_t)r * PA_W + PA_KR + 8 * lq);
                float kr[8];
#pragma unroll
                for (int e = 0; e < 4; ++e) { kr[2 * e] = __uint_as_float(krw[e] << 16); kr[2 * e + 1] = __uint_as_float(krw[e] & 0xffff0000u); }
                float hs = 0.f;
#pragma unroll
                for (int e = 0; e < 8; ++e) hs += kr[e] * kr[e];
#pragma unroll
                for (int nt = 0; nt < 4; ++nt)
#pragma unroll
                    for (int e = 0; e < 4; ++e) { const float v = acc[nt][mt][e] * rs; acc[nt][mt][e] = v; hs += v * v; }
                hs = xrow_sum(hs);
                const float hr = rsqrtf(hs * (1.f / 96.f) + EPSF);
                bf16_t* kd = p.Kb + ((size_t)((b * 8 + hh) * TPB + pos)) * 96;
#pragma unroll
                for (int nt = 0; nt < 4; ++nt) {
                    const f32x4 wv = *(const f32x4*)(s_khn + 16 * nt + 4 * lq);
                    f32x4 v;
#pragma unroll
                    for (int e = 0; e < 4; ++e) v[e] = acc[nt][mt][e] * hr * wv[e];
                    st_bf4(kd + 16 * nt + 4 * lq, v);
                }
                {
                    const int ph = lq & 1;
                    const int rp = (lq >> 1) ? (t & 63) : (t >> 6);
                    float o[8];
#pragma unroll
                    for (int e = 0; e < 8; ++e) {
                        const float v = kr[e] * hr * s_khn[64 + 8 * lq + e];
                        const float partner = __shfl_xor(v, 16);
                        float2 cs = make_float2(1.f, 0.f);
                        if (lat) cs = *(const float2*)(s_rope + 2 * (rp * 8 + e));
                        const float t1 = ph ? partner : v, t2 = ph ? v : partner;
                        o[e] = ph ? (t1 * cs.y + t2 * cs.x) : (t1 * cs.x - t2 * cs.y);
                    }
                    u32x4 ov;
                    ov[0] = pack_bf2(o[0], o[1]); ov[1] = pack_bf2(o[2], o[3]); ov[2] = pack_bf2(o[4], o[5]); ov[3] = pack_bf2(o[6], o[7]);
                    *(u32x4*)(kd + 64 + 8 * lq) = ov;
                }
                {
                    const int kpos = (pos & ~12) | ((pos & 4) << 1) | ((pos & 8) >> 1);
                    bf16_t* vd = p.Vt + (size_t)((b * 8 + hh) * 64) * TPB + kpos;
#pragma unroll
                    for (int nt = 4; nt < 8; ++nt)
#pragma unroll
                        for (int e = 0; e < 4; ++e) vd[(size_t)(16 * (nt - 4) + 4 * lq + e) * TPB] = f2bf(acc[nt][mt][e] * rs);
                }
            }
        }
    }
}

typedef float f32x16 __attribute__((ext_vector_type(16)));
#define ATT_KROW 208
#define ATT_VROW 144
#define ATT_KBYTES (64 * ATT_KROW)
#define ATT_STAGE (ATT_KBYTES + 64 * ATT_VROW)
__device__ __forceinline__ float max3_asm(float a, float b, float c) { float r; asm("v_max3_f32 %0, %1, %2, %3" : "=v"(r) : "v"(a), "v"(b), "v"(c)); return r; }
template <bool ZI>
__device__ __forceinline__ void ph_attn_t(const Params& p, int bid, int nb, char* smem, const float negB) {
    const int tid = VTID, lane = tid & 63, w = tid >> 6, r = lane & 31, h = lane >> 5;
    int u;
    for (int it = 0; next_unit(it, 1024, bid, nb, u); ++it) {
        const int bh = u >> 4, qb = u & 15;
        bf16x8 qf[6];
        {
            const bf16_t* Qp = p.Qb + ((size_t)bh * SEQ + qb * 128 + w * 32 + r) * 96 + h * 8;
#pragma unroll
            for (int s = 0; s < 6; ++s) qf[s] = *(const bf16x8*)(Qp + s * 16);
        }
        const bf16_t* Kg = p.Kb + (size_t)bh * TPB * 96 + tid * 8;
        const bf16_t* Vg = p.Vt + (size_t)bh * 64 * TPB + (size_t)(tid >> 3) * TPB + (tid & 7) * 8;
        int koff[3], voff[2];
#pragma unroll
        for (int i = 0; i < 3; ++i) { const int c = tid + 256 * i; koff[i] = (c / 12) * ATT_KROW + (c % 12) * 16; }
#pragma unroll
        for (int i = 0; i < 2; ++i) { const int c = tid + 256 * i; voff[i] = ATT_KBYTES + (c >> 3) * ATT_VROW + (c & 7) * 16; }
        u32x4 rk[3], rv[2];
#pragma unroll
        for (int i = 0; i < 3; ++i) rk[i] = *(const u32x4*)(Kg + i * 2048);
#pragma unroll
        for (int i = 0; i < 2; ++i) rv[i] = *(const u32x4*)(Vg + (size_t)(32 * i) * TPB);
#pragma unroll
        for (int i = 0; i < 3; ++i) *(u32x4*)(smem + koff[i]) = rk[i];
#pragma unroll
        for (int i = 0; i < 2; ++i) *(u32x4*)(smem + voff[i]) = rv[i];
        __syncthreads();
        f32x16 o0, o1;
#pragma unroll
        for (int i = 0; i < 16; ++i) { o0[i] = 0.f; o1[i] = 0.f; }
        float l = 0.f;
        int NKT = TPB / 64;
        asm volatile("" : "+s"(NKT));
        for (int kt = 0; kt < NKT; ++kt) {
            if (kt + 1 < NKT) {
#pragma unroll
                for (int i = 0; i < 3; ++i) rk[i] = *(const u32x4*)(Kg + (size_t)(kt + 1) * 6144 + i * 2048);
#pragma unroll
                for (int i = 0; i < 2; ++i) rv[i] = *(const u32x4*)(Vg + (size_t)(32 * i) * TPB + (kt + 1) * 64);
            }
            const char* sk = smem + (kt & 1) * ATT_STAGE;
            const char* sv = sk + ATT_KBYTES;
            f32x16 s0, s1;
            if (ZI) {
                const f32x16 z16 = {0.f, 0.f, 0.f, 0.f, 0.f, 0.f, 0.f, 0.f, 0.f, 0.f, 0.f, 0.f, 0.f, 0.f, 0.f, 0.f};
                const bf16x8 k0 = *(const bf16x8*)(sk + r * ATT_KROW + h * 16);
                const bf16x8 k1 = *(const bf16x8*)(sk + (32 + r) * ATT_KROW + h * 16);
                s0 = __builtin_amdgcn_mfma_f32_32x32x16_bf16(k0, qf[0], z16, 0, 0, 0);
                s1 = __builtin_amdgcn_mfma_f32_32x32x16_bf16(k1, qf[0], z16, 0, 0, 0);
            } else {
#pragma unroll
                for (int i = 0; i < 16; ++i) { s0[i] = negB; s1[i] = negB; }
            }
#pragma unroll
            for (int s = ZI ? 1 : 0; s < 6; ++s) {
                const bf16x8 k0 = *(const bf16x8*)(sk + r * ATT_KROW + (2 * s + h) * 16);
                const bf16x8 k1 = *(const bf16x8*)(sk + (32 + r) * ATT_KROW + (2 * s + h) * 16);
                s0 = __builtin_amdgcn_mfma_f32_32x32x16_bf16(k0, qf[s], s0, 0, 0, 0);
                s1 = __builtin_amdgcn_mfma_f32_32x32x16_bf16(k1, qf[s], s1, 0, 0, 0);
            }
            float ls = 0.f;
#pragma unroll
            for (int i = 0; i < 16; ++i) {
                s0[i] = __builtin_amdgcn_exp2f(s0[i]);
                s1[i] = __builtin_amdgcn_exp2f(s1[i]);
                ls += s0[i] + s1[i];
            }
            l += ls;
#pragma unroll
            for (int ks = 0; ks < 4; ++ks) {
                u32x4 pw;
                if (ks < 2) {
                    pw[0] = pack_bf2(s0[8 * (ks & 1) + 0], s0[8 * (ks & 1) + 1]); pw[1] = pack_bf2(s0[8 * (ks & 1) + 2], s0[8 * (ks & 1) + 3]);
                    pw[2] = pack_bf2(s0[8 * (ks & 1) + 4], s0[8 * (ks & 1) + 5]); pw[3] = pack_bf2(s0[8 * (ks & 1) + 6], s0[8 * (ks & 1) + 7]);
                } else {
                    pw[0] = pack_bf2(s1[8 * (ks & 1) + 0], s1[8 * (ks & 1) + 1]); pw[1] = pack_bf2(s1[8 * (ks & 1) + 2], s1[8 * (ks & 1) + 3]);
                    pw[2] = pack_bf2(s1[8 * (ks & 1) + 4], s1[8 * (ks & 1) + 5]); pw[3] = pack_bf2(s1[8 * (ks & 1) + 6], s1[8 * (ks & 1) + 7]);
                }
                const bf16x8 pf = __builtin_bit_cast(bf16x8, pw);
                const bf16x8 v0 = *(const bf16x8*)(sv + r * ATT_VROW + (2 * ks + h) * 16);
                const bf16x8 v1 = *(const bf16x8*)(sv + (32 + r) * ATT_VROW + (2 * ks + h) * 16);
                o0 = __builtin_amdgcn_mfma_f32_32x32x16_bf16(v0, pf, o0, 0, 0, 0);
                o1 = __builtin_amdgcn_mfma_f32_32x32x16_bf16(v1, pf, o1, 0, 0, 0);
            }
            if (kt + 1 < NKT) {
                char* ds = smem + ((kt + 1) & 1) * ATT_STAGE;
#pragma unroll
                for (int i = 0; i < 3; ++i) *(u32x4*)(ds + koff[i]) = rk[i];
#pragma unroll
                for (int i = 0; i < 2; ++i) *(u32x4*)(ds + voff[i]) = rv[i];
            }
            __syncthreads();
        }
        l += __shfl_xor(l, 32);
        const float inv = 1.f / l;
        const int b = bh >> 3, hh = bh & 7;
        const size_t rl = (size_t)(b * SEQ + qb * 128 + w * 32 + r);
        bf16_t* op = p.A_mla + rl * 512 + hh * 64 + 4 * h;
        const bf16_t* zp = p.Pz + rl * PZ_W + hh * 64 + 4 * h;
#pragma unroll
        for (int g = 0; g < 4; ++g) {
            const f32x4 z0 = ld_bf4(zp + 8 * g), z1 = ld_bf4(zp + 32 + 8 * g);
            uint2 a, c;
            a.x = pack_bf2(o0[4 * g + 0] * inv * silu_f(z0[0]), o0[4 * g + 1] * inv * silu_f(z0[1]));
            a.y = pack_bf2(o0[4 * g + 2] * inv * silu_f(z0[2]), o0[4 * g + 3] * inv * silu_f(z0[3]));
            c.x = pack_bf2(o1[4 * g + 0] * inv * silu_f(z1[0]), o1[4 * g + 1] * inv * silu_f(z1[1]));
            c.y = pack_bf2(o1[4 * g + 2] * inv * silu_f(z1[2]), o1[4 * g + 3] * inv * silu_f(z1[3]));
            *(uint2*)(op + 8 * g) = a;
            *(uint2*)(op + 32 + 8 * g) = c;
        }
    }
}

template <bool ZI>
__device__ __forceinline__ void ph_attn_d(const Params& p, int bid, int nb, char* smem, const float negB) {
    const int tid = VTID, lane = tid & 63, w = tid >> 6, r = lane & 31, h = lane >> 5;
    int u;
    for (int it = 0; next_unit(it, 512, bid, nb, u); ++it) {
        const int bh = u >> 3, qb = u & 7;
        bf16x8 qf[2][6];
#pragma unroll
        for (int t = 0; t < 2; ++t) {
            const bf16_t* Qp = p.Qb + ((size_t)bh * SEQ + qb * 256 + w * 64 + t * 32 + r) * 96 + h * 8;
#pragma unroll
            for (int s = 0; s < 6; ++s) qf[t][s] = *(const bf16x8*)(Qp + s * 16);
        }
        const bf16_t* Kg = p.Kb + (size_t)bh * TPB * 96 + tid * 8;
        const bf16_t* Vg = p.Vt + (size_t)bh * 64 * TPB + (size_t)(tid >> 3) * TPB + (tid & 7) * 8;
        int koff[3], voff[2];
#pragma unroll
        for (int i = 0; i < 3; ++i) { const int c = tid + 256 * i; koff[i] = (c / 12) * ATT_KROW + (c % 12) * 16; }
#pragma unroll
        for (int i = 0; i < 2; ++i) { const int c = tid + 256 * i; voff[i] = ATT_KBYTES + (c >> 3) * ATT_VROW + (c & 7) * 16; }
        u32x4 rk[3], rv[2];
#pragma unroll
        for (int i = 0; i < 3; ++i) rk[i] = *(const u32x4*)(Kg + i * 2048);
#pragma unroll
        for (int i = 0; i < 2; ++i) rv[i] = *(const u32x4*)(Vg + (size_t)(32 * i) * TPB);
#pragma unroll
        for (int i = 0; i < 3; ++i) *(u32x4*)(smem + koff[i]) = rk[i];
#pragma unroll
        for (int i = 0; i < 2; ++i) *(u32x4*)(smem + voff[i]) = rv[i];
        __syncthreads();
        f32x16 o[2][2];
#pragma unroll
        for (int t = 0; t < 2; ++t)
#pragma unroll
            for (int i = 0; i < 16; ++i) { o[t][0][i] = 0.f; o[t][1][i] = 0.f; }
        float l[2] = {0.f, 0.f};
        int NKT = TPB / 64;
        asm volatile("" : "+s"(NKT));
        for (int kt = 0; kt < NKT; ++kt) {
            if (kt + 1 < NKT) {
#pragma unroll
                for (int i = 0; i < 3; ++i) rk[i] = *(const u32x4*)(Kg + (size_t)(kt + 1) * 6144 + i * 2048);
#pragma unroll
                for (int i = 0; i < 2; ++i) rv[i] = *(const u32x4*)(Vg + (size_t)(32 * i) * TPB + (kt + 1) * 64);
            }
            const char* sk = smem + (kt & 1) * ATT_STAGE;
            const char* sv = sk + ATT_KBYTES;
            int NHF = 2;
            asm volatile("" : "+s"(NHF));
            for (int hf = 0; hf < NHF; ++hf) {
                const char* skh = sk + hf * 32 * ATT_KROW;
                f32x16 s[2];
                if (ZI) {
                    const f32x16 z16 = {0.f, 0.f, 0.f, 0.f, 0.f, 0.f, 0.f, 0.f, 0.f, 0.f, 0.f, 0.f, 0.f, 0.f, 0.f, 0.f};
                    const bf16x8 k0 = *(const bf16x8*)(skh + r * ATT_KROW + h * 16);
                    s[0] = __builtin_amdgcn_mfma_f32_32x32x16_bf16(k0, qf[0][0], z16, 0, 0, 0);
                    s[1] = __builtin_amdgcn_mfma_f32_32x32x16_bf16(k0, qf[1][0], z16, 0, 0, 0);
                } else {
#pragma unroll
                    for (int i = 0; i < 16; ++i) { s[0][i] = negB; s[1][i] = negB; }
                }
#pragma unroll
                for (int ss = ZI ? 1 : 0; ss < 6; ++ss) {
                    const bf16x8 k0 = *(const bf16x8*)(skh + r * ATT_KROW + (2 * ss + h) * 16);
                    s[0] = __builtin_amdgcn_mfma_f32_32x32x16_bf16(k0, qf[0][ss], s[0], 0, 0, 0);
                    s[1] = __builtin_amdgcn_mfma_f32_32x32x16_bf16(k0, qf[1][ss], s[1], 0, 0, 0);
                }
                bf16x8 pf[2][2];
#pragma unroll
                for (int t = 0; t < 2; ++t) {
                    float ls = 0.f;
#pragma unroll
                    for (int i = 0; i < 16; ++i) {
                        s[t][i] = __builtin_amdgcn_exp2f(s[t][i]);
                        ls += s[t][i];
                    }
                    l[t] += ls;
#pragma unroll
                    for (int ks = 0; ks < 2; ++ks) {
                        u32x4 pw;
#pragma unroll
                        for (int e = 0; e < 4; ++e) pw[e] = pack_bf2(s[t][8 * ks + 2 * e], s[t][8 * ks + 2 * e + 1]);
                        pf[t][ks] = __builtin_bit_cast(bf16x8, pw);
                    }
                }
#pragma unroll
                for (int ks = 0; ks < 2; ++ks) {
                    const bf16x8 v0 = *(const bf16x8*)(sv + r * ATT_VROW + (2 * (2 * hf + ks) + h) * 16);
                    const bf16x8 v1 = *(const bf16x8*)(sv + (32 + r) * ATT_VROW + (2 * (2 * hf + ks) + h) * 16);
#pragma unroll
                    for (int t = 0; t < 2; ++t) {
                        o[t][0] = __builtin_amdgcn_mfma_f32_32x32x16_bf16(v0, pf[t][ks], o[t][0], 0, 0, 0);
                        o[t][1] = __builtin_amdgcn_mfma_f32_32x32x16_bf16(v1, pf[t][ks], o[t][1], 0, 0, 0);
                    }
                }
            }
            if (kt + 1 < NKT) {
                char* ds = smem + ((kt + 1) & 1) * ATT_STAGE;
#pragma unroll
                for (int i = 0; i < 3; ++i) *(u32x4*)(ds + koff[i]) = rk[i];
#pragma unroll
                for (int i = 0; i < 2; ++i) *(u32x4*)(ds + voff[i]) = rv[i];
            }
            __syncthreads();
        }
        const int b = bh >> 3, hh = bh & 7;
#pragma unroll
        for (int t = 0; t < 2; ++t) {
            const float lt = l[t] + __shfl_xor(l[t], 32);
            const float inv = 1.f / lt;
            const size_t rl = (size_t)(b * SEQ + qb * 256 + w * 64 + t * 32 + r);
            bf16_t* op = p.A_mla + rl * 512 + hh * 64 + 4 * h;
            const bf16_t* zp = p.Pz + rl * PZ_W + hh * 64 + 4 * h;
#pragma unroll
            for (int g = 0; g < 4; ++g) {
                const f32x4 z0 = ld_bf4(zp + 8 * g), z1 = ld_bf4(zp + 32 + 8 * g);
                uint2 a, c;
                a.x = pack_bf2(o[t][0][4 * g + 0] * inv * silu_f(z0[0]), o[t][0][4 * g + 1] * inv * silu_f(z0[1]));
                a.y = pack_bf2(o[t][0][4 * g + 2] * inv * silu_f(z0[2]), o[t][0][4 * g + 3] * inv * silu_f(z0[3]));
                c.x = pack_bf2(o[t][1][4 * g + 0] * inv * silu_f(z1[0]), o[t][1][4 * g + 1] * inv * silu_f(z1[1]));
                c.y = pack_bf2(o[t][1][4 * g + 2] * inv * silu_f(z1[2]), o[t][1][4 * g + 3] * inv * silu_f(z1[3]));
                *(uint2*)(op + 8 * g) = a;
                *(uint2*)(op + 32 + 8 * g) = c;
            }
        }
    }
}

#define AT8_VROW 272
#define AT8_KBYTES (128 * ATT_KROW)
#define AT8_STAGE (AT8_KBYTES + 64 * AT8_VROW)
__device__ __forceinline__ void ph_attn8(const Params& p, char* smem, const int pb) {
    int tid = threadIdx.x;
    asm volatile("" : "+v"(tid));
    const int lane = tid & 63, w = tid >> 6, r = lane & 31, h = lane >> 5;
    const int bh = (pb >> 5) * 8 + (pb & 7), qb = (pb >> 3) & 3;
    bf16x8 qf[2][6];
#pragma unroll
    for (int t = 0; t < 2; ++t) {
        const bf16_t* Qp = p.Qb + ((size_t)bh * SEQ + qb * 512 + w * 64 + t * 32 + r) * 96 + h * 8;
#pragma unroll
        for (int s = 0; s < 6; ++s) qf[t][s] = *(const bf16x8*)(Qp + s * 16);
    }
    const bf16_t* Kg = p.Kb + (size_t)bh * TPB * 96 + tid * 8;
    const bf16_t* Vg = p.Vt + (size_t)bh * 64 * TPB + (size_t)(tid >> 4) * TPB + (tid & 15) * 8;
    int koff[3], voff[2];
#pragma unroll
    for (int i = 0; i < 3; ++i) { const int c = tid + 512 * i; koff[i] = (c / 12) * ATT_KROW + (c % 12) * 16; }
#pragma unroll
    for (int i = 0; i < 2; ++i) { const int c = tid + 512 * i; voff[i] = AT8_KBYTES + (c >> 4) * AT8_VROW + (c & 15) * 16; }
    u32x4 rk[3], rv[2];
#pragma unroll
    for (int i = 0; i < 3; ++i) rk[i] = *(const u32x4*)(Kg + i * 4096);
#pragma unroll
    for (int i = 0; i < 2; ++i) rv[i] = *(const u32x4*)(Vg + (size_t)(32 * i) * TPB);
#pragma unroll
    for (int i = 0; i < 3; ++i) *(u32x4*)(smem + koff[i]) = rk[i];
#pragma unroll
    for (int i = 0; i < 2; ++i) *(u32x4*)(smem + voff[i]) = rv[i];
    __syncthreads();
    f32x16 o[2][2];
#pragma unroll
    for (int t = 0; t < 2; ++t)
#pragma unroll
        for (int i = 0; i < 16; ++i) { o[t][0][i] = 0.f; o[t][1][i] = 0.f; }
    float l[2] = {0.f, 0.f};
    int NKT = TPB / 128;
    asm volatile("" : "+s"(NKT));
    for (int kt = 0; kt < NKT; ++kt) {
        if (kt + 1 < NKT) {
#pragma unroll
            for (int i = 0; i < 3; ++i) rk[i] = *(const u32x4*)(Kg + (size_t)(kt + 1) * 12288 + i * 4096);
#pragma unroll
            for (int i = 0; i < 2; ++i) rv[i] = *(const u32x4*)(Vg + (size_t)(32 * i) * TPB + (kt + 1) * 128);
        }
        const char* sk = smem + (kt & 1) * AT8_STAGE;
        const char* sv = sk + AT8_KBYTES;
        int NHF = 4;
        asm volatile("" : "+s"(NHF));
        for (int hf = 0; hf < NHF; ++hf) {
            const char* skh = sk + hf * 32 * ATT_KROW;
            const char* svh = sv + hf * 64;
            f32x16 s[2];
            {
                const f32x16 z16 = {0.f, 0.f, 0.f, 0.f, 0.f, 0.f, 0.f, 0.f, 0.f, 0.f, 0.f, 0.f, 0.f, 0.f, 0.f, 0.f};
                const bf16x8 k0 = *(const bf16x8*)(skh + r * ATT_KROW + h * 16);
                s[0] = __builtin_amdgcn_mfma_f32_32x32x16_bf16(k0, qf[0][0], z16, 0, 0, 0);
                s[1] = __builtin_amdgcn_mfma_f32_32x32x16_bf16(k0, qf[1][0], z16, 0, 0, 0);
            }
#pragma unroll
            for (int ss = 1; ss < 6; ++ss) {
                const bf16x8 k0 = *(const bf16x8*)(skh + r * ATT_KROW + (2 * ss + h) * 16);
                s[0] = __builtin_amdgcn_mfma_f32_32x32x16_bf16(k0, qf[0][ss], s[0], 0, 0, 0);
                s[1] = __builtin_amdgcn_mfma_f32_32x32x16_bf16(k0, qf[1][ss], s[1], 0, 0, 0);
            }
            bf16x8 pf[2][2];
#pragma unroll
            for (int t = 0; t < 2; ++t) {
                float ls = 0.f;
#pragma unroll
                for (int i = 0; i < 16; ++i) {
                    s[t][i] = __builtin_amdgcn_exp2f(s[t][i]);
                    ls += s[t][i];
                }
                l[t] += ls;
#pragma unroll
                for (int ks = 0; ks < 2; ++ks) {
                    u32x4 pw;
#pragma unroll
                    for (int e = 0; e < 4; ++e) pw[e] = pack_bf2(s[t][8 * ks + 2 * e], s[t][8 * ks + 2 * e + 1]);
                    pf[t][ks] = __builtin_bit_cast(bf16x8, pw);
                }
            }
#pragma unroll
            for (int ks = 0; ks < 2; ++ks) {
                const bf16x8 v0 = *(const bf16x8*)(svh + r * AT8_VROW + (2 * ks + h) * 16);
                const bf16x8 v1 = *(const bf16x8*)(svh + (32 + r) * AT8_VROW + (2 * ks + h) * 16);
#pragma unroll
                for (int t = 0; t < 2; ++t) {
                    o[t][0] = __builtin_amdgcn_mfma_f32_32x32x16_bf16(v0, pf[t][ks], o[t][0], 0, 0, 0);
                    o[t][1] = __builtin_amdgcn_mfma_f32_32x32x16_bf16(v1, pf[t][ks], o[t][1], 0, 0, 0);
                }
            }
        }
        if (kt + 1 < NKT) {
            char* ds = smem + ((kt + 1) & 1) * AT8_STAGE;
#pragma unroll
            for (int i = 0; i < 3; ++i) *(u32x4*)(ds + koff[i]) = rk[i];
#pragma unroll
            for (int i = 0; i < 2; ++i) *(u32x4*)(ds + voff[i]) = rv[i];
        }
        __syncthreads();
    }
    const int b = bh >> 3, hh = bh & 7;
#pragma unroll
    for (int t = 0; t < 2; ++t) {
        const float lt = l[t] + __shfl_xor(l[t], 32);
        const float inv = 1.f / lt;
        const size_t rl = (size_t)(b * SEQ + qb * 512 + w * 64 + t * 32 + r);
        bf16_t* op = p.A_mla + rl * 512 + hh * 64 + 4 * h;
        const bf16_t* zp = p.Pz + rl * PZ_W + hh * 64 + 4 * h;
#pragma unroll
        for (int g = 0; g < 4; ++g) {
            const f32x4 z0 = ld_bf4(zp + 8 * g), z1 = ld_bf4(zp + 32 + 8 * g);
            uint2 a, c;
            a.x = pack_bf2(o[t][0][4 * g + 0] * inv * silu_f(z0[0]), o[t][0][4 * g + 1] * inv * silu_f(z0[1]));
            a.y = pack_bf2(o[t][0][4 * g + 2] * inv * silu_f(z0[2]), o[t][0][4 * g + 3] * inv * silu_f(z0[3]));
            c.x = pack_bf2(o[t][1][4 * g + 0] * inv * silu_f(z1[0]), o[t][1][4 * g + 1] * inv * silu_f(z1[1]));
            c.y = pack_bf2(o[t][1][4 * g + 2] * inv * silu_f(z1[2]), o[t][1][4 * g + 3] * inv * silu_f(z1[3]));
            *(uint2*)(op + 8 * g) = a;
            *(uint2*)(op + 32 + 8 * g) = c;
        }
    }
}

__device__ __forceinline__ void ph_attn(const Params& p, int bid, int nb, char* smem, char* smem_all, int pb) {
    const int lane = VTID & 63;
    float mq = fmaxf(fabsf(p.qhn_w[lane]), (lane < 32) ? fabsf(p.qhn_w[64 + lane]) : 0.f);
    float mk = fmaxf(fabsf(p.khn_w[lane]), (lane < 32) ? fabsf(p.khn_w[64 + lane]) : 0.f);
#pragma unroll
    for (int o = 32; o > 0; o >>= 1) { mq = fmaxf(mq, __shfl_xor(mq, o)); mk = fmaxf(mk, __shfl_xor(mk, o)); }
    const float B = (9.797958971f * 1.4426950408889634f * 1.0001f) * mq * mk;
    if (B <= 40.f) ph_attn8(p, smem_all, pb);
    else ph_attn_t<false>(p, bid, nb, smem, -B);
}

__device__ __forceinline__ int el_off(int row, int col) { return lds_off(row, col >> 3) + (col & 7) * 2; }

__device__ __forceinline__ void mm64(f32x4 (&acc)[4], const char* A, int arow0, const char* B, int l15, int lq) {
#pragma unroll
    for (int ks = 0; ks < 2; ++ks) {
        const bf16x8 a = *(const bf16x8*)(A + lds_off(arow0 + l15, ks * 4 + lq));
#pragma unroll
        for (int nt = 0; nt < 4; ++nt) {
            const bf16x8 b = *(const bf16x8*)(B + lds_off(nt * 16 + l15, ks * 4 + lq));
            acc[nt] = __builtin_amdgcn_mfma_f32_16x16x32_bf16(a, b, acc[nt], 0, 0, 0);
        }
    }
}
__device__ __forceinline__ void acc4_zero(f32x4 (&a)[4]) {
#pragma unroll
    for (int i = 0; i < 4; ++i) a[i] = (f32x4){0.f, 0.f, 0.f, 0.f};
}

#define DN_SQ 0
#define DN_SK 8192
#define DN_SV 16384
#define DN_LSTR 65
#define DN_LBYTES (64 * DN_LSTR * 4)
#define DN_SL 24576
#define DN_SA 57856
#define DN_SKD 66048
#define DN_SS 74240

typedef short s16x4 __attribute__((ext_vector_type(4)));
__device__ __forceinline__ s16x4 ds_tr(const char* p) { return __builtin_amdgcn_ds_read_tr16_b64_v4i16((LAS s16x4*)p); }

struct Dn1In { u32x4 rp[7]; float db, da, dtb, alog; float cw[4]; };
__device__ __forceinline__ void dn1_fetch(Dn1In& in, const Params& p, int u, int tid) {
    const int bh = u / 36, pb = u % 36, b = bh >> 3, h = bh & 7;
    int rowbase, seglen, lb;
    if (pb < 4) { rowbase = b * CTXL; seglen = CTXL; lb = pb; }
    else { rowbase = NCTX + b * SEQ; seglen = SEQ; lb = pb - 4; }
#pragma unroll
    for (int i = 0; i < 7; ++i) {
        const int c = tid + NTHR * i;
        const int g = c / 544, rem = c % 544, rr = rem >> 3, ch = rem & 7;
        const int lp = lb * 64 - 2 + rr;
        u32x4 val = (u32x4){0u, 0u, 0u, 0u};
        if (c < 3 * 68 * 8 && lp >= 0 && lp < seglen) val = *(const u32x4*)(p.Pa + (size_t)(rowbase + lp) * PA_W + PA_DQ + h * 192 + g * 64 + ch * 8);
        in.rp[i] = val;
    }
#pragma unroll
    for (int i = 0; i < 4; ++i) {
        const int idx = tid + NTHR * i, g = idx / 320, j = (idx % 320) >> 6, c = idx & 63;
        in.cw[i] = (idx < 960) ? p.conv_w[j * 1536 + g * 512 + h * 64 + c] : 0.f;
    }
    in.db = 0.f; in.da = 0.f; in.dtb = 0.f; in.alog = 0.f;
    if (tid < 128) {
        in.dtb = p.dt_bias[(tid >> 6) * 8 + h]; in.alog = p.a_log[(tid >> 6) * 8 + h];
        const int d = tid >> 6, tp = tid & 63;
        const int pos = d ? 63 - tp : tp;
        const bf16_t* row = p.Pa + (size_t)(rowbase + lb * 64 + pos) * PA_W;
        in.db = bf2f(row[PA_DB + d * 8 + h]);
        in.da = bf2f(row[PA_DA + d * 8 + h]);
    }
}

__device__ __forceinline__ void ph_dn1(const Params& p, int bid, int nb, char* smem) {
    char* sQ = smem + DN_SQ; char* sK = smem + DN_SK; char* sV = smem + DN_SV;
    char* sL = smem + DN_SL; char* sA = smem + DN_SA; char* sKd = smem + DN_SKD;
    float* sS = (float*)(smem + DN_SS);
    const int x_ = bid & 7, li_ = bid >> 3, per_ = nb >> 3;
#define DN1_UNIT(IT, U, VALID) do { const int q_ = li_ + (IT) * per_; const int grp_ = x_ + 8 * (q_ >> 3); VALID = (grp_ < 8 * 36); \
        const int b_ = grp_ / 36, pb_ = grp_ % 36; U = (b_ * 8 + (q_ & 7)) * 36 + pb_; } while (0)
    Dn1In in;
    int u, un; bool valid, validn;
    DN1_UNIT(0, u, valid);
    if (valid) dn1_fetch(in, p, u, VTID);
    for (int it = 0; valid; ++it, u = un, valid = validn) {
        DN1_UNIT(it + 1, un, validn);
        int tid = VTID;
        asm volatile("" : "+v"(tid));
        const int lane = tid & 63, w = tid >> 6, l15 = lane & 15, lq = lane >> 4;
        const int bh = u / 36, pb = u % 36, h = bh & 7;
        const bool lat = (pb >= 4);
        if (tid < 128) {
            const int d = tid >> 6, tp = lane;
            const float xx = in.da + in.dtb;
            const float sp = (xx > 20.f) ? xx : log1pf(__expf(xx));
            const float g = -__expf(in.alog) * sp;
            float gc = g;
#pragma unroll
            for (int o = 1; o < 64; o <<= 1) { const float t = __shfl_up(gc, o); if (lane >= o) gc += t; }
            const float gl = __shfl(gc, 63);
            const float bt = sigmoid_f(in.db), eg = __expf(gc);
            sS[(d * 5 + 0) * 64 + tp] = bt;
            sS[(d * 5 + 1) * 64 + tp] = gc;
            sS[(d * 5 + 2) * 64 + tp] = eg;
            sS[(d * 5 + 3) * 64 + tp] = __expf(gl - gc);
            sS[(d * 5 + 4) * 64 + tp] = bt * eg;
        }
        {
            char* raw = sL;
#pragma unroll
            for (int i = 0; i < 7; ++i) {
                const int c = tid + NTHR * i;
                const int g = c / 544, rem = c % 544, rr = rem >> 3, ch = rem & 7;
                if (c < 3 * 68 * 8) *(u32x4*)(raw + (g * 68 + rr) * 128 + ch * 16) = in.rp[i];
            }
            float* cwS = (float*)(sL + 26112);
#pragma unroll
            for (int i = 0; i < 4; ++i) { const int idx = tid + NTHR * i; if (idx < 960) cwS[idx] = in.cw[i]; }
            if (validn) dn1_fetch(in, p, un, tid);
            __syncthreads();
            const int o = tid & 7, r0 = tid >> 3;
#pragma unroll
            for (int g = 0; g < 3; ++g) {
                if (g == 0 && !lat) continue;
                float wj[5][8];
#pragma unroll
                for (int j = 0; j < 5; ++j) {
                    const f32x4 w0 = *(const f32x4*)(cwS + (g * 5 + j) * 64 + 8 * o), w1 = *(const f32x4*)(cwS + (g * 5 + j) * 64 + 8 * o + 4);
#pragma unroll
                    for (int e2 = 0; e2 < 4; ++e2) { wj[j][e2] = w0[e2]; wj[j][4 + e2] = w1[e2]; }
                }
#pragma unroll
                for (int hh = 0; hh < 2; ++hh) {
                    const int rr = r0 + 32 * hh;
                    float a[8];
#pragma unroll
                    for (int e2 = 0; e2 < 8; ++e2) a[e2] = 0.f;
#pragma unroll
                    for (int j = 0; j < 5; ++j) {
                        const u32x4 dv = *(const u32x4*)(raw + (g * 68 + rr + j) * 128 + o * 16);
#pragma unroll
                        for (int e2 = 0; e2 < 4; ++e2) {
                            a[2 * e2] += __uint_as_float(dv[e2] << 16) * wj[j][2 * e2];
                            a[2 * e2 + 1] += __uint_as_float(dv[e2] & 0xffff0000u) * wj[j][2 * e2 + 1];
                        }
                    }
                    float ss = 0.f;
#pragma unroll
                    for (int e2 = 0; e2 < 8; ++e2) { a[e2] = silu_f(a[e2]); ss += a[e2] * a[e2]; }
                    float sc = 1.f;
                    if (g < 2) {
                        ss += dpp_mov<0xB1>(ss); ss += dpp_mov<0x4E>(ss); ss += dpp_mov<0x141>(ss);
                        sc = rsqrtf(ss + EPSF) * (g == 0 ? 0.125f : 1.f);
                    }
                    u32x4 ov;
#pragma unroll
                    for (int e2 = 0; e2 < 4; ++e2) ov[e2] = pack_bf2(a[2 * e2] * sc, a[2 * e2 + 1] * sc);
                    *(u32x4*)((g == 0 ? sQ : g == 1 ? sK : sV) + lds_off(rr, o)) = ov;
                }
            }
            __syncthreads();
        }
        {
            f32x4 G[4];
            acc4_zero(G);
            mm64(G, sK, 16 * w, sK, l15, lq);
            float* L0 = (float*)sL; float* L1 = (float*)(sL + DN_LBYTES);
            const float* be0 = sS + 0 * 64; const float* gc0 = sS + 1 * 64;
            const float* be1 = sS + 5 * 64; const float* gc1 = sS + 6 * 64;
#pragma unroll
            for (int nt = 0; nt < 4; ++nt)
#pragma unroll
                for (int rg = 0; rg < 4; ++rg) {
                    const int t = 16 * w + 4 * lq + rg, s = 16 * nt + l15;
                    const float gv = G[nt][rg];
                    const int tp = 63 - t, sp = 63 - s;
                    L0[t * DN_LSTR + s] = (s < t) ? be0[t] * gv * __expf(gc0[t] - gc0[s]) : 0.f;
                    L1[tp * DN_LSTR + sp] = (s > t) ? be1[tp] * gv * __expf(gc1[tp] - gc1[sp]) : 0.f;
                }
            __syncthreads();
        }
        {
            int tid3 = tid;
            asm volatile("" : "+v"(tid3) :: "memory");
            const int lane3 = tid3 & 63, w3 = tid3 >> 6, l15c = lane3 & 15, lqc = lane3 >> 4;
            if (tid3 < 128) {
                float* Lb = (float*)(sL + w3 * DN_LBYTES) + (16 * lqc) * DN_LSTR + 16 * lqc;
                float x[16];
#pragma unroll
                for (int i = 0; i < 16; ++i) {
                    float v = (i == l15c) ? 1.f : 0.f;
#pragma unroll
                    for (int j = 0; j < i; ++j) v -= Lb[i * DN_LSTR + j] * x[j];
                    x[i] = v;
                }
#pragma unroll
                for (int i = 0; i < 16; ++i) Lb[i * DN_LSTR + l15c] = x[i];
            }
            __syncthreads();
            {
                const int d = w3 >> 1, pr = w3 & 1, b0 = 2 * pr, b1 = 2 * pr + 1;
                float* Ld = (float*)(sL + d * DN_LBYTES);
                float* scr = (float*)(sA) + w3 * 272;
                f32x4 P = (f32x4){0.f, 0.f, 0.f, 0.f};
#pragma unroll
                for (int kk = 0; kk < 4; ++kk)
                    P = __builtin_amdgcn_mfma_f32_16x16x4f32(Ld[(16 * b1 + l15c) * DN_LSTR + 16 * b0 + 4 * kk + lqc],
                                                            Ld[(16 * b0 + 4 * kk + lqc) * DN_LSTR + 16 * b0 + l15c], P, 0, 0, 0);
#pragma unroll
                for (int rg = 0; rg < 4; ++rg) scr[(4 * lqc + rg) * 17 + l15c] = P[rg];
                f32x4 R = (f32x4){0.f, 0.f, 0.f, 0.f};
#pragma unroll
                for (int kk = 0; kk < 4; ++kk)
                    R = __builtin_amdgcn_mfma_f32_16x16x4f32(Ld[(16 * b1 + l15c) * DN_LSTR + 16 * b1 + 4 * kk + lqc],
                                                            scr[(4 * kk + lqc) * 17 + l15c], R, 0, 0, 0);
#pragma unroll
                for (int rg = 0; rg < 4; ++rg) Ld[(16 * b1 + 4 * lqc + rg) * DN_LSTR + 16 * b0 + l15c] = -R[rg];
            }
            __syncthreads();
            {
                const int d = w3 >> 1, hf = w3 & 1;
                float* Ld = (float*)(sL + d * DN_LBYTES);
                float* scr2 = (float*)(d ? sKd : sA);
                f32x4 P2[2];
                P2[0] = (f32x4){0.f, 0.f, 0.f, 0.f}; P2[1] = (f32x4){0.f, 0.f, 0.f, 0.f};
#pragma unroll
                for (int kk = 0; kk < 8; ++kk) {
                    const float a = Ld[(32 + 16 * hf + l15c) * DN_LSTR + 4 * kk + lqc];
#pragma unroll
                    for (int n2 = 0; n2 < 2; ++n2)
                        P2[n2] = __builtin_amdgcn_mfma_f32_16x16x4f32(a, Ld[(4 * kk + lqc) * DN_LSTR + 16 * n2 + l15c], P2[n2], 0, 0, 0);
                }
#pragma unroll
                for (int n2 = 0; n2 < 2; ++n2)
#pragma unroll
                    for (int rg = 0; rg < 4; ++rg) scr2[(16 * hf + 4 * lqc + rg) * 33 + 16 * n2 + l15c] = P2[n2][rg];
                __syncthreads();
                f32x4 R2[2];
                R2[0] = (f32x4){0.f, 0.f, 0.f, 0.f}; R2[1] = (f32x4){0.f, 0.f, 0.f, 0.f};
#pragma unroll
                for (int kk = 0; kk < 8; ++kk) {
                    const float a = Ld[(32 + 16 * hf + l15c) * DN_LSTR + 32 + 4 * kk + lqc];
#pragma unroll
                    for (int n2 = 0; n2 < 2; ++n2)
                        R2[n2] = __builtin_amdgcn_mfma_f32_16x16x4f32(a, scr2[(4 * kk + lqc) * 33 + 16 * n2 + l15c], R2[n2], 0, 0, 0);
                }
#pragma unroll
                for (int n2 = 0; n2 < 2; ++n2)
#pragma unroll
                    for (int rg = 0; rg < 4; ++rg) Ld[(32 + 16 * hf + 4 * lqc + rg) * DN_LSTR + 16 * n2 + l15c] = -R2[n2][rg];
            }
            __syncthreads();
#pragma unroll 1
            for (int d = 0; d < 2; ++d) {
                const float* Td = (const float*)(sL + d * DN_LBYTES);
                {
                    const int tr = tid3 >> 2, cq = tid3 & 3;
                    const float* c1 = sS + (d * 5 + 0) * 64 + 16 * cq;
                    const float* c2 = sS + (d * 5 + 4) * 64 + 16 * cq;
                    const float* trow = Td + tr * DN_LSTR + 16 * cq;
                    float tv[16];
#pragma unroll
                    for (int e2 = 0; e2 < 16; ++e2) tv[e2] = trow[e2];
#pragma unroll
                    for (int q = 0; q < 2; ++q) {
                        u32x4 o1, o2;
#pragma unroll
                        for (int e2 = 0; e2 < 4; ++e2) {
                            const int i0 = 8 * q + 2 * e2;
                            o1[e2] = pack_bf2(tv[i0] * c1[i0], tv[i0 + 1] * c1[i0 + 1]);
                            o2[e2] = pack_bf2(tv[i0] * c2[i0], tv[i0 + 1] * c2[i0 + 1]);
                        }
                        *(u32x4*)(sA + lds_off(tr, 2 * cq + q)) = o1;
                        *(u32x4*)(sKd + lds_off(tr, 2 * cq + q)) = o2;
                    }
                }
                __syncthreads();
                f32x4 U[4], W[4];
                acc4_zero(U); acc4_zero(W);
                {
#pragma unroll
                    for (int ks = 0; ks < 2; ++ks) {
                        const bf16x8 a1 = *(const bf16x8*)(sA + lds_off(16 * w3 + l15c, ks * 4 + lqc));
                        const bf16x8 a2 = *(const bf16x8*)(sKd + lds_off(16 * w3 + l15c, ks * 4 + lqc));
                        const int r0 = 32 * ks + 8 * lqc + (l15c >> 2);
                        const int p0 = d ? 63 - r0 : r0, p1 = d ? 63 - (r0 + 4) : (r0 + 4);
#pragma unroll
                        for (int nt = 0; nt < 4; ++nt) {
                            const int col = 16 * nt + 4 * (l15c & 3);
                            const s16x4 v0 = ds_tr(sV + el_off(p0, col)), v1 = ds_tr(sV + el_off(p1, col));
                            const s16x4 k0 = ds_tr(sK + el_off(p0, col)), k1 = ds_tr(sK + el_off(p1, col));
                            U[nt] = __builtin_amdgcn_mfma_f32_16x16x32_bf16(a1, __builtin_shufflevector(v0, v1, 0, 1, 2, 3, 4, 5, 6, 7), U[nt], 0, 0, 0);
                            W[nt] = __builtin_amdgcn_mfma_f32_16x16x32_bf16(a2, __builtin_shufflevector(k0, k1, 0, 1, 2, 3, 4, 5, 6, 7), W[nt], 0, 0, 0);
                        }
                    }
                }
                __syncthreads();
                {
                    char* uT = sL + d * DN_LBYTES;
                    char* wT = uT + 8192;
                    const int t0 = 16 * w3 + 4 * lqc;
#pragma unroll
                    for (int nt = 0; nt < 4; ++nt) {
                        uint2 ou, ow;
                        ou.x = pack_bf2(U[nt][0], U[nt][1]); ou.y = pack_bf2(U[nt][2], U[nt][3]);
                        ow.x = pack_bf2(W[nt][0], W[nt][1]); ow.y = pack_bf2(W[nt][2], W[nt][3]);
                        *(uint2*)(uT + el_off(16 * nt + l15c, t0)) = ou;
                        *(uint2*)(wT + el_off(16 * nt + l15c, t0)) = ow;
                    }
                }
                __syncthreads();
            }
        }
        int tid5 = tid;
        asm volatile("" : "+v"(tid5) :: "memory");
        const int lane5 = tid5 & 63, w5 = tid5 >> 6, l15_5 = lane5 & 15, lq5 = lane5 >> 4;
        f32x4 QK[4];
        acc4_zero(QK);
        mm64(QK, sQ, 16 * w5, sK, l15_5, lq5);
#pragma unroll 1
        for (int d = 0; d < 2; ++d) {
            const float* gcd = sS + (d * 5 + 1) * 64;
            const float* egd = sS + (d * 5 + 2) * 64;
            const float* ekd = sS + (d * 5 + 3) * 64;
            {
                const int i = lane5, tq = w5;
                float kv[16];
#pragma unroll
                for (int e = 0; e < 16; ++e) {
                    const int tp = tq * 16 + e, pos = d ? 63 - tp : tp;
                    kv[e] = bf2f(*(const bf16_t*)(sK + el_off(pos, i))) * ekd[tp];
                }
#pragma unroll
                for (int q = 0; q < 2; ++q) {
                    u32x4 o;
                    o[0] = pack_bf2(kv[8 * q + 0], kv[8 * q + 1]); o[1] = pack_bf2(kv[8 * q + 2], kv[8 * q + 3]);
                    o[2] = pack_bf2(kv[8 * q + 4], kv[8 * q + 5]); o[3] = pack_bf2(kv[8 * q + 6], kv[8 * q + 7]);
                    *(u32x4*)(sKd + lds_off(i, 2 * tq + q)) = o;
                }
            }
#pragma unroll
            for (int nt = 0; nt < 4; ++nt)
#pragma unroll
                for (int rg = 0; rg < 4; ++rg) {
                    const int t = 16 * w5 + 4 * lq5 + rg, s = 16 * nt + l15_5;
                    const int tp = d ? 63 - t : t, sp = d ? 63 - s : s;
                    const float val = (sp <= tp) ? QK[nt][rg] * __expf(gcd[tp] - gcd[sp]) : 0.f;
                    *(bf16_t*)(sA + el_off(tp, sp)) = f2bf(val);
                }
            __syncthreads();
            const char* uT = sL + d * DN_LBYTES;
            const char* wT = uT + 8192;
            const int cd = (d == 0) ? pb : (pb < 4 ? 3 - pb : 39 - pb);
            bf16_t* Mg = p.MH + ((size_t)((bh * 2 + d) * 36 + cd) * 2) * 4096;
            bf16_t* Hg = Mg + 4096;
            {
                f32x4 MT[4];
                acc4_zero(MT);
                mm64(MT, wT, 16 * w5, sKd, l15_5, lq5);
                const float egl = egd[63];
                const int j0 = 16 * w5 + 4 * lq5;
#pragma unroll
                for (int nt = 0; nt < 4; ++nt) {
                    const int i = 16 * nt + l15_5;
                    f32x4 o;
#pragma unroll
                    for (int e = 0; e < 4; ++e) o[e] = ((i == j0 + e) ? egl : 0.f) - MT[nt][e];
                    st_bf4(Mg + i * 64 + j0, o);
                }
            }
            {
                f32x4 HH[4];
                acc4_zero(HH);
                mm64(HH, sKd, 16 * w5, uT, l15_5, lq5);
                const int i0 = 16 * w5 + 4 * lq5;
#pragma unroll
                for (int nt = 0; nt < 4; ++nt) st_bf4(Hg + (16 * nt + l15_5) * 64 + i0, HH[nt]);
            }
            if (lat) {
                bf16_t* Eg = p.EF + ((size_t)((bh * 2 + d) * 32 + (pb - 4)) * 2) * 4096;
                bf16_t* Fg = Eg + 4096;
                {
                    f32x4 ET[4];
                    acc4_zero(ET);
                    mm64(ET, wT, 16 * w5, sA, l15_5, lq5);
                    const int j0 = 16 * w5 + 4 * lq5;
#pragma unroll
                    for (int nt = 0; nt < 4; ++nt) {
                        const int sp = 16 * nt + l15_5, spos = d ? 63 - sp : sp;
                        const f32x4 qv = ld_bf4((const bf16_t*)(sQ + el_off(spos, j0)));
                        const float eg = egd[sp];
                        f32x4 o;
#pragma unroll
                        for (int e = 0; e < 4; ++e) o[e] = qv[e] * eg - ET[nt][e];
                        st_bf4(Eg + spos * 64 + j0, o);
                    }
                }
                {
                    f32x4 FF[4];
                    acc4_zero(FF);
                    mm64(FF, uT, 16 * w5, sA, l15_5, lq5);
                    const int c0 = 16 * w5 + 4 * lq5;
#pragma unroll
                    for (int nt = 0; nt < 4; ++nt) {
                        const int sp = 16 * nt + l15_5, spos = d ? 63 - sp : sp;
                        st_bf4(Fg + spos * 64 + c0, FF[nt]);
                    }
                }
            }
            __syncthreads();
        }
    }
}

struct Dn2Frag { bf16x8 am[2]; uint2 hr; };
__device__ __forceinline__ void dn2_load(Dn2Frag& f, const bf16_t* Mg, int w, int l15, int lq, int i0, int hf, int n2) {
#pragma unroll
    for (int ks = 0; ks < 2; ++ks) f.am[ks] = *(const bf16x8*)(Mg + (16 * w + l15) * 64 + ks * 32 + lq * 8);
    f.hr = *(const uint2*)(Mg + 4096 + (32 * hf + 16 * n2 + l15) * 64 + i0);
}
__device__ __forceinline__ void dn2_step(const Dn2Frag& f, int c, int d, int hf, int n2, bf16_t* STc, char* smem, int l15, int lq, int i0) {
    const char* sS = smem + (c & 1) * 4096;
    char* sN = smem + ((c + 1) & 1) * 4096;
    f32x4 acc = (f32x4){__uint_as_float(f.hr.x << 16), __uint_as_float(f.hr.x & 0xffff0000u), __uint_as_float(f.hr.y << 16), __uint_as_float(f.hr.y & 0xffff0000u)};
#pragma unroll
    for (int ks = 0; ks < 2; ++ks) {
        const bf16x8 bs = *(const bf16x8*)(sS + lds_off(16 * n2 + l15, ks * 4 + lq));
        acc = __builtin_amdgcn_mfma_f32_16x16x32_bf16(f.am[ks], bs, acc, 0, 0, 0);
    }
    const int cn = c + 1;
    const bool st = (cn >= 4 && cn <= 35);
    const int pbi = (d == 0 ? cn : 39 - cn) - 4;
    uint2 o; o.x = pack_bf2(acc[0], acc[1]); o.y = pack_bf2(acc[2], acc[3]);
    const int cl = 16 * n2 + l15;
    *(uint2*)(sN + el_off(cl, i0)) = o;
    if (st) *(uint2*)(STc + (size_t)pbi * 4096 + (32 * hf + cl) * 64 + i0) = o;
    __syncthreads();
}
__device__ __forceinline__ void ph_dn2(const Params& p, char* smem, const int pb) {
    const int tid = threadIdx.x, lane = tid & 63, w8 = tid >> 6, w = w8 & 3, n2 = w8 >> 2, l15 = lane & 15, lq = lane >> 4;
    const int x = pb & 7, j = pb >> 3;
    const int chain = (j >> 1) * 8 + x, hf = j & 1, d = chain & 1;
    const bf16_t* MHc = p.MH + (size_t)chain * 36 * 2 * 4096;
    bf16_t* STc = p.ST + (size_t)chain * 32 * 4096;
    if (tid < 256) *(u32x4*)(smem + tid * 16) = (u32x4){0u, 0u, 0u, 0u};
    __syncthreads();
    const int i0 = 16 * w + 4 * lq;
    Dn2Frag f0, f1, f2, f3;
    dn2_load(f0, MHc + (size_t)0 * 8192, w, l15, lq, i0, hf, n2);
    dn2_load(f1, MHc + (size_t)1 * 8192, w, l15, lq, i0, hf, n2);
    dn2_load(f2, MHc + (size_t)2 * 8192, w, l15, lq, i0, hf, n2);
    dn2_load(f3, MHc + (size_t)3 * 8192, w, l15, lq, i0, hf, n2);
    for (int c0 = 0; c0 < 36; c0 += 4) {
        const bool more = (c0 + 4 < 36);
        dn2_step(f0, c0 + 0, d, hf, n2, STc, smem, l15, lq, i0);
        if (more) dn2_load(f0, MHc + (size_t)(c0 + 4) * 8192, w, l15, lq, i0, hf, n2);
        dn2_step(f1, c0 + 1, d, hf, n2, STc, smem, l15, lq, i0);
        if (more) dn2_load(f1, MHc + (size_t)(c0 + 5) * 8192, w, l15, lq, i0, hf, n2);
        dn2_step(f2, c0 + 2, d, hf, n2, STc, smem, l15, lq, i0);
        if (more) dn2_load(f2, MHc + (size_t)(c0 + 6) * 8192, w, l15, lq, i0, hf, n2);
        dn2_step(f3, c0 + 3, d, hf, n2, STc, smem, l15, lq, i0);
        if (more) dn2_load(f3, MHc + (size_t)(c0 + 7) * 8192, w, l15, lq, i0, hf, n2);
    }
}

__device__ __forceinline__ void ph_dn3(const Params& p, int bid, int nb, char* smem) {
    const int tid = VTID, lane = tid & 63, w = tid >> 6, l15 = lane & 15, lq = lane >> 4;
    const int srow = tid >> 3, sch = (tid & 7) ^ ((srow >> 1) & 7);
    LAS char* lbase = (LAS char*)smem + w * 1024;
#define DN3_STAGE(BUF, U_) do { const int bh_ = (U_) >> 5, pbi_ = (U_) & 31; \
        _Pragma("unroll") for (int d_ = 0; d_ < 2; ++d_) { \
            const bf16_t* Sg_ = p.ST + ((size_t)(bh_ * 2 + d_) * 32 + pbi_) * 4096 + (size_t)srow * 64 + sch * 8; \
            _Pragma("unroll") for (int i_ = 0; i_ < 2; ++i_) \
                __builtin_amdgcn_global_load_lds((const void*)(Sg_ + (size_t)(32 * i_) * 64), (LAS void*)(lbase + (BUF) * 16384 + d_ * 8192 + i_ * 4096), 16, 0, 0); } } while (0)
    int u = bid, buf = 0;
    if (u < 64 * 32) DN3_STAGE(0, u);
    for (; u < 64 * 32; u += nb, buf ^= 1) {
        const int bh = u >> 5, pbi = u & 31, b = bh >> 3, h = bh & 7;
        const int s = 16 * w + l15;
        const size_t rl = (size_t)b * SEQ + pbi * 64 + s;
        f32x4 zdv[4];
#pragma unroll
        for (int mt = 0; mt < 4; ++mt) zdv[mt] = ld_bf4(p.Pz + rl * PZ_W + 512 + h * 64 + 16 * mt + 4 * lq);
        f32x4 acc[4];
        acc4_zero(acc);
        bf16x8 be[2][2];
#pragma unroll
        for (int d = 0; d < 2; ++d) {
            const bf16_t* Eg = p.EF + ((size_t)((bh * 2 + d) * 32 + pbi) * 2) * 4096;
            const bf16_t* Fg = Eg + 4096;
#pragma unroll
            for (int mt = 0; mt < 4; ++mt) acc[mt] += ld_bf4(Fg + s * 64 + 16 * mt + 4 * lq);
#pragma unroll
            for (int ks = 0; ks < 2; ++ks) be[d][ks] = *(const bf16x8*)(Eg + s * 64 + ks * 32 + lq * 8);
        }
        __syncthreads();
        if (u + nb < 64 * 32) DN3_STAGE(buf ^ 1, u + nb);
#pragma unroll
        for (int d = 0; d < 2; ++d) {
            const char* sS = smem + buf * 16384 + d * 8192;
#pragma unroll
            for (int ks = 0; ks < 2; ++ks)
#pragma unroll
                for (int mt = 0; mt < 4; ++mt) {
                    const bf16x8 as = *(const bf16x8*)(sS + lds_off(16 * mt + l15, ks * 4 + lq));
                    acc[mt] = __builtin_amdgcn_mfma_f32_16x16x32_bf16(as, be[d][ks], acc[mt], 0, 0, 0);
                }
        }
        float ss = 0.f;
#pragma unroll
        for (int mt = 0; mt < 4; ++mt)
#pragma unroll
            for (int rg = 0; rg < 4; ++rg) ss += acc[mt][rg] * acc[mt][rg];
        ss = xrow_sum(ss);
        const float rstd = rsqrtf(ss * (1.f / 64.f) + EPSF);
#pragma unroll
        for (int mt = 0; mt < 4; ++mt) {
            const f32x4 nw = *(const f32x4*)(p.dn_norm_w + 16 * mt + 4 * lq);
            f32x4 o;
#pragma unroll
            for (int rg = 0; rg < 4; ++rg) o[rg] = acc[mt][rg] * rstd * nw[rg] * silu_f(zdv[mt][rg]);
            st_bf4(p.A_dn + rl * 512 + h * 64 + 16 * mt + 4 * lq, o);
        }
    }
#undef DN3_STAGE
    __syncthreads();
}

namespace g8 {
constexpr int BM = 256, BK = 64, HALF = 128, HTB = HALF * BK * 2, STAGE_BYTES = 8 * HTB;
__device__ __forceinline__ int lds_byte(int r, int c) { const int st = (r >> 4) * 2 + (c >> 5), rr = r & 15, cc = c & 31, ob = rr * 64 + cc * 2; return st * 1024 + (ob ^ (((ob >> 9) & 1) << 5)); }
__device__ __forceinline__ void stage_rc(int b, int& R, int& C) { const int st = b / 1024, sb = b % 1024, swz = sb ^ (((sb >> 9) & 1) << 5); R = (st >> 1) * 16 + swz / 64; C = (st & 1) * 32 + (swz % 64) / 2; }
__device__ __forceinline__ int perm32(int rho) { const int n = rho >> 4, i = rho & 15; return 8 * (i >> 2) + 4 * n + (i & 3); }
struct Unit { int pm, pn, sel; };
typedef f32x4 Acc[2][2][4][2];

template <class Epi, class Sched>
__device__ __forceinline__ void gemm_phase(LAS unsigned char* lds, const bf16_t* A, const bf16_t* A1, int lda, const bf16_t* Bt, int K, const Sched& S, const Epi& E) {
    int tid = threadIdx.x;
    asm volatile("" : "+v"(tid));
    const int wid = __builtin_amdgcn_readfirstlane(tid >> 6), lane = tid & 63, wr = wid >> 2, wc = wid & 3, fr = lane & 15, fq = lane >> 4;
    const int nt = K / BK;
    unsigned voffA[2], voffB[2];
#pragma unroll
    for (int i = 0; i < 2; ++i) { int R, C; stage_rc(tid * 16 + i * 8192, R, C); const int Rb = Epi::PERM ? ((R & ~31) + perm32(R & 31)) : R;
        voffA[i] = (unsigned)(R * lda + C) * 2u; voffB[i] = (unsigned)(Rb * K + C) * 2u; }
    const size_t kstep = (size_t)(BK * 2);
    const size_t hstepA = (size_t)HALF * lda * 2, hstepB = (size_t)HALF * K * 2;
    const size_t tstepA = 2 * hstepA, tstepB = 2 * hstepB;
    const unsigned ldsw = (unsigned)wid * 1024u;
    const int aoff = lds_byte(wr * 64 + fr, fq * 8), boff = lds_byte(wc * 32 + fr, fq * 8);
#define G8_SA(b, h) (((b) * 2 + (h)) * HTB)
#define G8_SB(b, h) ((4 + (b) * 2 + (h)) * HTB)
#define G8_STAGE(bufoff, gbase, voff) do { _Pragma("unroll") for (int _i = 0; _i < 2; ++_i) \
        __builtin_amdgcn_global_load_lds((const unsigned*)((const char*)(gbase) + (voff)[_i]), (LAS unsigned*)(lds + (bufoff) + ldsw + _i * 8192), 16, 0, 0); } while (0)
#define G8_LDA(dst, b, h) do { _Pragma("unroll") for (int m = 0; m < 4; ++m) _Pragma("unroll") for (int k = 0; k < 2; ++k) dst[m][k] = *(const LAS bf16x8*)(lds + G8_SA(b, h) + aoff + m * 2048 + k * 1024); } while (0)
#define G8_LDB(dst, b, h) do { _Pragma("unroll") for (int n = 0; n < 2; ++n) _Pragma("unroll") for (int k = 0; k < 2; ++k) dst[n][k] = *(const LAS bf16x8*)(lds + G8_SB(b, h) + boff + n * 2048 + k * 1024); } while (0)
#define G8_MMA(ai, bj, At, Bt_) do { __builtin_amdgcn_s_setprio(1); _Pragma("unroll") for (int m = 0; m < 4; ++m) _Pragma("unroll") for (int n = 0; n < 2; ++n) _Pragma("unroll") for (int k = 0; k < 2; ++k) \
        acc[ai][bj][m][n] = __builtin_amdgcn_mfma_f32_16x16x32_bf16(Bt_[n][k], At[m][k], acc[ai][bj][m][n], 0, 0, 0); __builtin_amdgcn_s_setprio(0); } while (0)
#define G8_WAIT_V(n) asm volatile("s_waitcnt vmcnt(" #n ")" ::: "memory")
#define G8_WAIT_L(n) asm volatile("s_waitcnt lgkmcnt(" #n ")" ::: "memory")
#define G8_BAR __builtin_amdgcn_s_barrier()
#define G8_SCHED __builtin_amdgcn_sched_barrier(0)
    Unit cur, nxt; int ui = 0;
    if (!S.next(0, cur)) return;
    Acc acc;
#pragma unroll
    for (int a = 0; a < 2; ++a)
#pragma unroll
        for (int b = 0; b < 2; ++b)
#pragma unroll
            for (int m = 0; m < 4; ++m)
#pragma unroll
                for (int n = 0; n < 2; ++n) acc[a][b][m][n] = (f32x4){0.f, 0.f, 0.f, 0.f};
    bf16x8 At[4][2], B0[2][2], B1[2][2];
    const char* cA = (const char*)(cur.sel ? A1 : A) + (size_t)cur.pm * tstepA; const char* cB = (const char*)Bt + (size_t)cur.pn * tstepB;
    G8_STAGE(G8_SB(0, 0), cB, voffB); G8_STAGE(G8_SA(0, 0), cA, voffA); G8_STAGE(G8_SB(0, 1), cB + hstepB, voffB); G8_STAGE(G8_SA(0, 1), cA + hstepA, voffA);
    if (wr == 1) G8_BAR;
    G8_WAIT_V(4); G8_BAR;
    G8_STAGE(G8_SB(1, 0), cB + kstep, voffB); G8_STAGE(G8_SA(1, 0), cA + kstep, voffA); G8_STAGE(G8_SB(1, 1), cB + hstepB + kstep, voffB);
    G8_WAIT_V(6); G8_BAR;
    for (;;) {
        const bool has_next = S.next(ui + 1, nxt);
        const char* nA = has_next ? (const char*)(nxt.sel ? A1 : A) + (size_t)nxt.pm * tstepA : cA; const char* nB = has_next ? (const char*)Bt + (size_t)nxt.pn * tstepB : cB;
        for (int t = 0; t < nt; t += 2) {
            const bool last = (t == nt - 2);
            const char* a1 = cA + (size_t)(t + 1) * kstep;
            const char* a2 = last ? nA : cA + (size_t)(t + 2) * kstep; const char* b2 = last ? nB : cB + (size_t)(t + 2) * kstep;
            const char* a3 = a2 + kstep; const char* b3 = b2 + kstep;
            G8_LDB(B0, 0, 0); G8_SCHED; G8_LDA(At, 0, 0); G8_STAGE(G8_SA(1, 1), a1 + hstepA, voffA);
            G8_WAIT_L(8); G8_BAR; G8_WAIT_L(0); G8_MMA(0, 0, At, B0); G8_BAR; G8_SCHED;
            G8_LDB(B1, 0, 1); G8_STAGE(G8_SB(0, 0), b2, voffB);
            G8_BAR; G8_WAIT_L(0); G8_MMA(0, 1, At, B1); G8_BAR;
            G8_LDA(At, 0, 1); G8_STAGE(G8_SA(0, 0), a2, voffA);
            G8_BAR; G8_WAIT_L(0); G8_MMA(1, 0, At, B0); G8_BAR; G8_SCHED;
            G8_STAGE(G8_SB(0, 1), b2 + hstepB, voffB);
            G8_WAIT_V(6); G8_BAR; G8_MMA(1, 1, At, B1); G8_BAR;
            G8_LDB(B0, 1, 0); G8_SCHED; G8_LDA(At, 1, 0); G8_STAGE(G8_SA(0, 1), a2 + hstepA, voffA);
            G8_WAIT_L(8); G8_BAR; G8_WAIT_L(0); G8_MMA(0, 0, At, B0); G8_BAR; G8_SCHED;
            G8_LDB(B1, 1, 1); G8_STAGE(G8_SB(1, 0), b3, voffB);
            G8_BAR; G8_WAIT_L(0); G8_MMA(0, 1, At, B1); G8_BAR;
            G8_LDA(At, 1, 1); G8_STAGE(G8_SA(1, 0), a3, voffA);
            G8_BAR; G8_WAIT_L(0); G8_MMA(1, 0, At, B0); G8_BAR; G8_SCHED;
            G8_STAGE(G8_SB(1, 1), b3 + hstepB, voffB);
            G8_WAIT_V(6); G8_BAR; G8_MMA(1, 1, At, B1); G8_BAR;
        }
        E(acc, cur, wr, wc, fr, fq);
        if (!has_next) break;
#pragma unroll
        for (int a = 0; a < 2; ++a)
#pragma unroll
            for (int b = 0; b < 2; ++b)
#pragma unroll
                for (int m = 0; m < 4; ++m)
#pragma unroll
                    for (int n = 0; n < 2; ++n) acc[a][b][m][n] = (f32x4){0.f, 0.f, 0.f, 0.f};
        cur = nxt; cA = nA; cB = nB; ++ui;
    }
    G8_WAIT_V(0);
    if (wr == 0) G8_BAR;
    G8_BAR;
#undef G8_SA
#undef G8_SB
#undef G8_STAGE
#undef G8_LDA
#undef G8_LDB
#undef G8_MMA
#undef G8_WAIT_V
#undef G8_WAIT_L
#undef G8_BAR
#undef G8_SCHED
}

struct StaticOrder {
    int nM, nN, nwg, G, c;
    __device__ __forceinline__ void init(int M, int N, int G_, int c_) { nM = M / BM; nN = N / BM; nwg = nM * nN; G = G_; c = c_; }
    __device__ __forceinline__ bool next(int i, Unit& u) const {
        const int L = i * G + c; if (L >= nwg) return false;
        int wgid = L; { const int q = nwg / 8, r = nwg % 8, xcd = wgid % 8, off = wgid / 8; wgid = (xcd < r ? xcd * (q + 1) : r * (q + 1) + (xcd - r) * q) + off; }
        const int nig = 8 * nN, gid = wgid / nig, fm = gid * 8, gsz = (nM - fm) < 8 ? (nM - fm) : 8;
        u.pm = fm + ((wgid % nig) % gsz); u.pn = (wgid % nig) / gsz; u.sel = 0; return true;
    }
};
struct EpiStoreBf16 {
    static constexpr bool PERM = true;
    bf16_t* O; int ldc;
    __device__ __forceinline__ void operator()(const Acc& acc, const Unit& u, int wr, int wc, int fr, int fq) const {
        const int row0 = u.pm * BM + wr * 64 + fr, col0 = u.pn * BM + wc * 32 + 8 * fq;
#pragma unroll
        for (int ai = 0; ai < 2; ++ai)
#pragma unroll
            for (int m = 0; m < 4; ++m) { bf16_t* rowp = O + (size_t)(row0 + ai * HALF + m * 16) * ldc + col0;
#pragma unroll
                for (int bj = 0; bj < 2; ++bj) { const f32x4 v0 = acc[ai][bj][m][0], v1 = acc[ai][bj][m][1];
                    u32x4 w; w[0] = pack_bf2(v0[0], v0[1]); w[1] = pack_bf2(v0[2], v0[3]); w[2] = pack_bf2(v1[0], v1[1]); w[3] = pack_bf2(v1[2], v1[3]);
                    *(u32x4*)(rowp + bj * HALF) = w; } }
    }
};
}


__device__ __forceinline__ void ph_inproj(const Params& p, int bid, int nb, char* smem) {
    const int UA = 2 * 120 + 16 * 144, UZ = 128 * 8;
    const bf16_t* hl = p.h + (size_t)NCTX * DM;
    int u, tm, tn;
    for (int it = 0; next_unit(it, UA + UZ, bid, nb, u); ++it) {
        if (u < 240) { const int g = u / 120, r = u % 120; tm = g * 8 + (r & 7); tn = 3 + (r >> 3); gemm_store_bf16(p.h, DM, p.Wt_a, 1024, tm, tn, p.Pa, PA_W, smem); }
        else if (u < UA) { unit_mn(u - 240 + 288, 18, tm, tn); gemm_store_bf16(p.h, DM, p.Wt_a, 1024, tm, tn, p.Pa, PA_W, smem); }
        else { unit_mn(u - UA, 8, tm, tn); gemm_store_bf16(hl, DM, p.Wt_z, 1024, tm, tn, p.Pz, PZ_W, smem); }
    }
}

__device__ __forceinline__ void ph_gates(const Params& p, char* smem_all, const int pb) {
    g8::StaticOrder so; so.init(NL, PG_W, gridDim.x, pb);
    g8::EpiStoreBf16 ep; ep.O = p.Pg; ep.ldc = PG_W;
    g8::gemm_phase((LAS unsigned char*)smem_all, p.h + (size_t)NCTX * DM, nullptr, DM, p.Wt_g, 1024, so, ep);
}

__device__ __forceinline__ void ph_merge(const Params& p, int bid, int nb, char* smem) {
    int u, tm, tn;
    for (int it = 0; next_unit(it, 128 * 8, bid, nb, u); ++it) {
        unit_mn(u, 8, tm, tn);
        const int m0 = tm * 128, n0 = tn * 128;
        f32x4 acc[4][4];
        uint2 mm[4][4];
        u32x4 gw[2][4];
        {
        EPI_COORDS_OPAQUE(p1)
#pragma unroll
        for (int j = 0; j < 2; ++j)
#pragma unroll
            for (int mt = 0; mt < 4; ++mt) gw[j][mt] = *(const u32x4*)(p.Pg + (size_t)EPI_ROW(mt) * PG_W + EPI_COL(2 * j));
        }
        acc_zero<4>(acc);
        gemm_tile_acc<4>(acc, p.A_mla, 512, p.Wt_mo, 512, 512, m0, n0, smem);
#pragma unroll
        for (int j = 0; j < 2; ++j)
#pragma unroll
            for (int mt = 0; mt < 4; ++mt) {
#pragma unroll
                for (int q = 0; q < 2; ++q) {
                    const int nt = 2 * j + q;
                    const float g0 = __uint_as_float(gw[j][mt][2 * q] << 16), g1 = __uint_as_float(gw[j][mt][2 * q] & 0xffff0000u);
                    const float g2 = __uint_as_float(gw[j][mt][2 * q + 1] << 16), g3 = __uint_as_float(gw[j][mt][2 * q + 1] & 0xffff0000u);
                    mm[nt][mt].x = pack_bf2(sigmoid_f(g0) * acc[nt][mt][0], sigmoid_f(g1) * acc[nt][mt][1]);
                    mm[nt][mt].y = pack_bf2(sigmoid_f(g2) * acc[nt][mt][2], sigmoid_f(g3) * acc[nt][mt][3]);
                }
            }
        {
        EPI_COORDS_OPAQUE(p2)
#pragma unroll
        for (int j = 0; j < 2; ++j)
#pragma unroll
            for (int mt = 0; mt < 4; ++mt) gw[j][mt] = *(const u32x4*)(p.Pg + (size_t)EPI_ROW(mt) * PG_W + 1024 + EPI_COL(2 * j));
        }
        acc_zero<4>(acc);
        gemm_tile_acc<4>(acc, p.A_dn, 512, p.Wt_do, 512, 512, m0, n0, smem);
        {
        EPI_COORDS_OPAQUE(b)
#pragma unroll
        for (int j = 0; j < 2; ++j)
#pragma unroll
            for (int mt = 0; mt < 4; ++mt) {
                u32x4 ov;
#pragma unroll
                for (int q = 0; q < 2; ++q) {
                    const int nt = 2 * j + q;
                    const float g0 = __uint_as_float(gw[j][mt][2 * q] << 16), g1 = __uint_as_float(gw[j][mt][2 * q] & 0xffff0000u);
                    const float g2 = __uint_as_float(gw[j][mt][2 * q + 1] << 16), g3 = __uint_as_float(gw[j][mt][2 * q + 1] & 0xffff0000u);
                    const float o0 = __uint_as_float(mm[nt][mt].x << 16) + sigmoid_f(g0) * acc[nt][mt][0];
                    const float o1 = __uint_as_float(mm[nt][mt].x & 0xffff0000u) + sigmoid_f(g1) * acc[nt][mt][1];
                    const float o2 = __uint_as_float(mm[nt][mt].y << 16) + sigmoid_f(g2) * acc[nt][mt][2];
                    const float o3 = __uint_as_float(mm[nt][mt].y & 0xffff0000u) + sigmoid_f(g3) * acc[nt][mt][3];
                    ov[2 * q] = pack_bf2(o0, o1); ov[2 * q + 1] = pack_bf2(o2, o3);
                }
                *(u32x4*)(p.Mb + (size_t)EPI_ROW(mt) * 1024 + EPI_COL(2 * j)) = ov;
            }
        }
    }
}

__device__ __forceinline__ void ph_out(const Params& p, int bid, int nb, char* smem) {
    int u, tm, tn;
    for (int it = 0; next_unit(it, 128 * 8, bid, nb, u); ++it) {
        unit_mn(u, 8, tm, tn);
        const int m0 = tm * 128, n0 = tn * 128;
        f32x4 acc[4][4], xv[4][4];
        EPI_COORDS
#pragma unroll
        for (int nt = 0; nt < 4; ++nt)
#pragma unroll
            for (int mt = 0; mt < 4; ++mt) xv[nt][mt] = *(const f32x4*)(p.x + (size_t)EPI_ROW(mt) * DM + EPI_COL(nt));
        const float* gp = p.mod + (m0 / SEQ) * 3072 + 2048;
        f32x4 gate[4];
#pragma unroll
        for (int nt = 0; nt < 4; ++nt) gate[nt] = *(const f32x4*)(gp + EPI_COL(nt));
        acc_zero<4>(acc);
        gemm_tile_acc<4>(acc, p.Mb, 1024, p.Wt_out, 1024, 1024, m0, n0, smem);
#pragma unroll
        for (int nt = 0; nt < 4; ++nt)
#pragma unroll
            for (int mt = 0; mt < 4; ++mt)
                *(f32x4*)(p.out + (size_t)EPI_ROW(mt) * DM + EPI_COL(nt)) = xv[nt][mt] + gate[nt] * acc[nt][mt];
    }
}

struct InprojOrder {
    int c;
    __device__ __forceinline__ bool next(int i, g8::Unit& u) const {
        const int x = c & 7, off = i * 32 + (c >> 3);
        if (off >= 112) return false;
        if (off < 104) { u.pm = 8 + 8 * x + (off & 7); u.pn = off >> 3; }
        else { u.pm = x; u.pn = 1 + (off - 104); }
        u.sel = 0; return true;
    }
};
template <int LDC>
__device__ __forceinline__ void epi_store_tile(const g8::Acc& acc, bf16_t* O, int row0, int col0) {
#pragma unroll
    for (int ai = 0; ai < 2; ++ai)
#pragma unroll
        for (int m = 0; m < 4; ++m) { bf16_t* rowp = O + (size_t)(row0 + ai * 128 + m * 16) * LDC + col0;
#pragma unroll
            for (int bj = 0; bj < 2; ++bj) { const f32x4 v0 = acc[ai][bj][m][0], v1 = acc[ai][bj][m][1];
                u32x4 w; w[0] = pack_bf2(v0[0], v0[1]); w[1] = pack_bf2(v0[2], v0[3]); w[2] = pack_bf2(v1[0], v1[1]); w[3] = pack_bf2(v1[2], v1[3]);
                *(u32x4*)(rowp + bj * 128) = w; } }
}
struct EpiInproj {
    static constexpr bool PERM = true;
    bf16_t* Pa; bf16_t* Pz;
    __device__ __forceinline__ void operator()(const g8::Acc& acc, const g8::Unit& u, int wr, int wc, int, int) const {
        int t = threadIdx.x; asm volatile("" : "+v"(t));
        const int fr = t & 15, fq = (t >> 4) & 3;
        if (u.pn < 9) epi_store_tile<PA_W>(acc, Pa, u.pm * 256 + wr * 64 + fr, u.pn * 256 + wc * 32 + 8 * fq);
        else epi_store_tile<PZ_W>(acc, Pz, u.pm * 256 - NCTX + wr * 64 + fr, (u.pn - 9) * 256 + wc * 32 + 8 * fq);
    }
};
__device__ __forceinline__ void ph_inproj8(const Params& p, char* smem_all, const int pb) {
    InprojOrder so; so.c = pb;
    EpiInproj ep; ep.Pa = p.Pa; ep.Pz = p.Pz;
    g8::gemm_phase((LAS unsigned char*)smem_all, p.h, nullptr, DM, p.Wt_a, 1024, so, ep);
}

struct MergeOrder {
    g8::StaticOrder so;
    __device__ __forceinline__ bool next(int i, g8::Unit& u) const {
        if (i >= 2) return false;
        const bool ok = so.next(0, u); u.sel = i; u.pn += 4 * i; return ok;
    }
};
struct EpiMerge {
    static constexpr bool PERM = true;
    const bf16_t* Pg; bf16_t* Mb;
    __device__ __forceinline__ void operator()(const g8::Acc& acc, const g8::Unit& u, int wr, int wc, int fr, int fq) const {
        const int row0 = u.pm * 256 + wr * 64 + fr, col0 = (u.pn & 3) * 256 + wc * 32 + 8 * fq;
#pragma unroll
        for (int ai = 0; ai < 2; ++ai) {
#pragma unroll
            for (int m = 0; m < 4; ++m) {
                const size_t row = (size_t)(row0 + ai * 128 + m * 16);
                u32x4 gv[2], pv[2];
#pragma unroll
                for (int bj = 0; bj < 2; ++bj) {
                    gv[bj] = *(const u32x4*)(Pg + row * PG_W + u.sel * 1024 + col0 + bj * 128);
                    if (u.sel) pv[bj] = *(const u32x4*)(Mb + row * 1024 + col0 + bj * 128);
                }
#pragma unroll
                for (int bj = 0; bj < 2; ++bj) {
                    u32x4 w;
#pragma unroll
                    for (int n = 0; n < 2; ++n) {
                        const f32x4 v = acc[ai][bj][m][n];
                        const unsigned g01 = gv[bj][2 * n], g23 = gv[bj][2 * n + 1];
                        float o0 = sigmoid_f(__uint_as_float(g01 << 16)) * v[0], o1 = sigmoid_f(__uint_as_float(g01 & 0xffff0000u)) * v[1];
                        float o2 = sigmoid_f(__uint_as_float(g23 << 16)) * v[2], o3 = sigmoid_f(__uint_as_float(g23 & 0xffff0000u)) * v[3];
                        if (u.sel) {
                            const unsigned p01 = pv[bj][2 * n], p23 = pv[bj][2 * n + 1];
                            o0 += __uint_as_float(p01 << 16); o1 += __uint_as_float(p01 & 0xffff0000u);
                            o2 += __uint_as_float(p23 << 16); o3 += __uint_as_float(p23 & 0xffff0000u);
                        }
                        w[2 * n] = pack_bf2(o0, o1); w[2 * n + 1] = pack_bf2(o2, o3);
                    }
                    *(u32x4*)(Mb + row * 1024 + col0 + bj * 128) = w;
                }
            }
            asm volatile("" ::: "memory");
        }
    }
};
__device__ __forceinline__ void ph_merge8(const Params& p, char* smem_all, const int pb) {
    MergeOrder mo; mo.so.init(NL, 1024, gridDim.x, pb);
    EpiMerge ep; ep.Pg = p.Pg; ep.Mb = p.Mb;
    g8::gemm_phase((LAS unsigned char*)smem_all, p.A_mla, p.A_dn, 512, p.Wt_mo, 512, mo, ep);
}

struct EpiOut {
    static constexpr bool PERM = false;
    const float* x; const float* mod; float* out;
    __device__ __forceinline__ void operator()(const g8::Acc& acc, const g8::Unit& u, int wr, int wc, int fr, int fq) const {
        const int row0 = u.pm * 256 + wr * 64 + fr, col0 = u.pn * 256 + wc * 32 + 4 * fq;
        const float* gp = mod + ((u.pm * 256) / SEQ) * 3072 + 2048 + col0;
        f32x4 gate[2][2];
#pragma unroll
        for (int bj = 0; bj < 2; ++bj)
#pragma unroll
            for (int n = 0; n < 2; ++n) gate[bj][n] = *(const f32x4*)(gp + bj * 128 + n * 16);
#pragma unroll
        for (int ai = 0; ai < 2; ++ai)
#pragma unroll
            for (int m = 0; m < 4; ++m) {
                const size_t off = (size_t)(row0 + ai * 128 + m * 16) * DM + col0;
                f32x4 xv[2][2];
#pragma unroll
                for (int bj = 0; bj < 2; ++bj)
#pragma unroll
                    for (int n = 0; n < 2; ++n) xv[bj][n] = *(const f32x4*)(x + off + bj * 128 + n * 16);
#pragma unroll
                for (int bj = 0; bj < 2; ++bj)
#pragma unroll
                    for (int n = 0; n < 2; ++n) *(f32x4*)(out + off + bj * 128 + n * 16) = xv[bj][n] + gate[bj][n] * acc[ai][bj][m][n];
                if (m & 1) asm volatile("" ::: "memory");
            }
    }
};
__device__ __forceinline__ void ph_out8(const Params& p, char* smem_all, const int pb) {
    g8::StaticOrder so; so.init(NL, DM, gridDim.x, pb);
    EpiOut ep; ep.x = p.x; ep.mod = p.mod; ep.out = p.out;
    g8::gemm_phase((LAS unsigned char*)smem_all, p.Mb, nullptr, DM, p.Wt_out, 1024, so, ep);
}

#define XB_TMO      128
#define XB_XCNT(j)  (256  + 64 * (j))
#define XB_XSUB(j)  (1280 + 64 * (j))
#define XB_XGEN(j)  (2304 + 64 * (j))
#define XB_TOP      3328
#define XB_TOPGEN   3392
#define XCD_BAR_WORDS 3456
#define XB_SPIN_CAP (1u << 20)
__device__ __forceinline__ unsigned xb_ld(unsigned* p)              { return __hip_atomic_load(p, __ATOMIC_RELAXED, __HIP_MEMORY_SCOPE_AGENT); }
__device__ __forceinline__ unsigned xb_add(unsigned* p, unsigned v) { return __hip_atomic_fetch_add(p, v, __ATOMIC_RELAXED, __HIP_MEMORY_SCOPE_AGENT); }
__device__ __forceinline__ unsigned xb_xcc_id() { return (unsigned)__builtin_amdgcn_s_getreg((3 << 11) | 20) & 0xFu; }
#define XB_SPIN(cond, bar) do { unsigned _sp = 0; while (cond) { __builtin_amdgcn_s_sleep(1); \
    if ((++_sp & 255u) == 0u) { if (xb_ld(&(bar)[XB_TMO])) break; if (_sp > XB_SPIN_CAP) { atomicAdd(&(bar)[XB_TMO], 1u); break; } } } } while (0)
struct XcdBarrier { unsigned* bar; unsigned x; volatile LAS unsigned* st; };
__device__ __forceinline__ XcdBarrier xcd_barrier_post(unsigned* bar, volatile LAS unsigned* st) {
    XcdBarrier b; b.bar = bar; b.x = xb_xcc_id(); b.st = st;
    if (threadIdx.x == 0) (void)xb_add(&bar[XB_XCNT(b.x)], 1u);
    return b;
}
__device__ __forceinline__ void xcd_barrier_complete(unsigned* bar, unsigned x, unsigned& nloc, unsigned& nx) {
    const unsigned G = gridDim.x * gridDim.y * gridDim.z;
    unsigned sum, cnt, mine, sp = 0u;
    for (;;) {
        sum = 0u; cnt = 0u; mine = 0u;
#pragma unroll
        for (unsigned j = 0; j < 16; ++j) { const unsigned c = xb_ld(&bar[XB_XCNT(j)]); sum += c; cnt += (c > 0u) ? 1u : 0u; mine = (j == x) ? c : mine; }
        if (sum == G) break;
        __builtin_amdgcn_s_sleep(1);
        if ((++sp & 255u) == 0u) { if (xb_ld(&bar[XB_TMO])) break; if (sp > XB_SPIN_CAP) { atomicAdd(&bar[XB_TMO], 1u); break; } }
    }
    nloc = mine > 0u ? mine : 1u; nx = cnt > 0u ? cnt : 1u;
}
__device__ __forceinline__ void xcd_barrier(const XcdBarrier& b) {
    asm volatile("s_waitcnt vmcnt(0)" ::: "memory");
    __syncthreads();
    if (threadIdx.x == 0) {
        unsigned* bar = b.bar;
        __builtin_amdgcn_s_waitcnt(0);
        unsigned nloc = b.st[0], nx = b.st[1];
        if (nloc == 0u) { xcd_barrier_complete(bar, b.x, nloc, nx); b.st[0] = nloc; b.st[1] = nx; }
        const unsigned old = xb_add(&bar[XB_XSUB(b.x)], 1u);
        const unsigned gen = old / nloc;
        if (old + 1u == (gen + 1u) * nloc) {
            __builtin_amdgcn_fence(__ATOMIC_RELEASE, "agent");
            asm volatile("s_waitcnt vmcnt(0)" ::: "memory");
            const unsigned og = xb_add(&bar[XB_TOP], 1u);
            const unsigned tg = og / nx;
            if (og + 1u == (tg + 1u) * nx) xb_add(&bar[XB_TOPGEN], 1u);
            else XB_SPIN(xb_ld(&bar[XB_TOPGEN]) == tg, bar);
            __builtin_amdgcn_fence(__ATOMIC_ACQUIRE, "agent");
            xb_add(&bar[XB_XGEN(b.x)], 1u);
            asm volatile("s_waitcnt vmcnt(0)" ::: "memory");
        } else {
            XB_SPIN(xb_ld(&bar[XB_XGEN(b.x)]) == gen, bar);
            __builtin_amdgcn_fence(__ATOMIC_ACQUIRE, "agent");
            asm volatile("s_waitcnt vmcnt(0)" ::: "memory");
        }
    }
    __syncthreads();
}

__global__ void __launch_bounds__(2 * NTHR, 2) fwd_megakernel(Params p) {
    __shared__ __attribute__((aligned(16))) char smem_all[2 * SMEM_BYTES];
    const int half = threadIdx.x >> 8, pb = blockIdx.x;
    const int bid = 16 * (pb >> 3) + 8 * half + (pb & 7), nb = 2 * gridDim.x;
    const int bid2 = 2 * pb + half;
    char* smem = smem_all + half * SMEM_BYTES;
    volatile LAS unsigned* bst = (volatile LAS unsigned*)(smem_all + 2 * SMEM_BYTES - 16);
    if (threadIdx.x == 0) { bst[0] = 0u; bst[1] = 0u; }
    __syncthreads();
    const XcdBarrier xb = xcd_barrier_post(p.bar, bst);

    ph_mod(p, bid, nb, smem);
    ph_wprep(p, bid2, nb, smem);
    xcd_barrier(xb);
    ph_norm(p, bid, nb, smem);
    xcd_barrier(xb);
    ph_inproj8(p, smem_all, pb);
    xcd_barrier(xb);
    ph_mla_proj(p, bid, nb, smem);
    xcd_barrier(xb);
    ph_attn(p, bid, nb, smem, smem_all, pb);
    xcd_barrier(xb);
    ph_dn1(p, bid, nb, smem);
    xcd_barrier(xb);
    ph_dn2(p, smem_all, pb);
    xcd_barrier(xb);
    ph_dn3(p, bid, nb, smem);
    ph_gates(p, smem_all, pb);
    xcd_barrier(xb);
    ph_merge8(p, smem_all, pb);
    xcd_barrier(xb);
    ph_out8(p, smem_all, pb);
}

extern "C" void kernel_launch(void* const* d_in, const int* in_sizes, int n_in,
                              void* d_out, int out_size, void* d_ws, size_t ws_size,
                              hipStream_t stream) {
    static int grid_blocks = 0;
    if (!grid_blocks) {
        int dev = 0, cus = 0, per_cu = 0;
        (void)hipGetDevice(&dev);
        (void)hipDeviceGetAttribute(&cus, hipDeviceAttributeMultiprocessorCount, dev);
        (void)hipOccupancyMaxActiveBlocksPerMultiprocessor(&per_cu, fwd_megakernel, 2 * NTHR, 0);
        if (per_cu > 1) per_cu = 1;
        if (per_cu < 1) per_cu = 1;
        grid_blocks = cus * per_cu;
    }
    if (n_in != 21 || ws_size < (size_t)268435456 || out_size != NL * DM) {
        fprintf(stderr, "kernel_launch: built for 21 inputs, a %d-float output and >= 256 MiB of workspace (got %d inputs, out %d, ws %zu)\n", NL * DM, n_in, out_size, ws_size);
        return;
    }
    Params p{};
    const float** fp = (const float**)&p;
    for (int i = 0; i < 21; ++i) fp[i] = (const float*)d_in[i];
    p.out = (float*)d_out;
    char* ws = (char*)d_ws;
    char* ob = (char*)d_out;
    const size_t R_W = 0;
    const size_t R_H = 16777216;
    const size_t R_Z = R_H + 37748736;
    const size_t R_A = R_Z + 33554432;
    const size_t R_F = R_A + 84934656;
    {
        size_t o = R_W;
        p.Wt_a = (bf16_t*)(ws + o); o += 4718592;
        p.Wt_z = (bf16_t*)(ws + o); o += 2097152;
        p.Wt_g = (bf16_t*)(ws + o); o += 4194304;
        p.Wt_uq = (bf16_t*)(ws + o); o += 589824;
        p.Wt_ukv = (bf16_t*)(ws + o); o += 524288;
        p.Wt_mo = (bf16_t*)(ws + o); o += 1048576;
        p.Wt_do = (bf16_t*)(ws + o); o += 1048576;
        p.Wt_out = (bf16_t*)(ws + o); o += 2097152;
        p.mod = (float*)(ws + o); o += 110592;
        p.bar = (unsigned*)(ws + o); o += XCD_BAR_WORDS * 4;
        p.rope = (float*)(ws + o); o += 4096;
    }
    p.h = (bf16_t*)(ws + R_H);
    p.Pz = (bf16_t*)(ws + R_Z);
    p.Pa = (bf16_t*)(ws + R_A);
    p.Qb = (bf16_t*)(ws + R_F + 22020096);
    p.Kb = (bf16_t*)(ws + R_F + 47185920);
    p.Vt = (bf16_t*)(ws + R_F + 75497472);
    p.MH = (bf16_t*)(ws + R_F + 16777216);
    p.EF = (bf16_t*)(ob);
    p.ST = (bf16_t*)(ws + R_A);
    p.A_mla = (bf16_t*)(ws + R_F);
    p.A_dn = (bf16_t*)(ws + R_A + 50331648);
    p.Pg = (bf16_t*)(ws + R_F + 16777216);
    p.Mb = (bf16_t*)(ws + R_H);
    (void)hipMemsetAsync(p.mod, 0, 110592 + XCD_BAR_WORDS * 4, stream);
    void* args[] = {&p};
    hipError_t err = hipLaunchCooperativeKernel((void*)fwd_megakernel, dim3(grid_blocks), dim3(2 * NTHR), args, 0, stream);
    if (err != hipSuccess) fprintf(stderr, "cooperative launch failed: %s (grid %d)\n", hipGetErrorString(err), grid_blocks);
}
```

```cpp
#include <hip/hip_runtime.h>
#include <stdint.h>
#include <cstdio>

typedef uint16_t bf16_t;
#define LAS __attribute__((address_space(3)))

#define NB 8
#define SEQ 2048
#define CTXL 256
#define TPB 2304
#define NCTX 2048
#define NL 16384
#define NT 18432
#define DM 1024
#define IN_DIM 5312
#define PA_W 2304
#define PZ_W 1024
#define PG_W 2048
#define PA_CQ 0
#define PA_CKV 384
#define PA_KR 640
#define PA_DQ 672
#define PA_DK 1184
#define PA_DV 1696
#define PA_DB 2208
#define PA_DA 2224
#define EPSF 1e-6f
#define NTHR 256
#define VTID ((int)(threadIdx.x & 255u))
#define SMEM_BYTES 77824

struct Params {
    const float *x, *c, *ctx, *c_ctx, *w_mod, *b_mod, *norm_w, *w_in, *q_norm_w, *w_uq, *kv_norm_w, *w_ukv, *qhn_w, *khn_w,
        *mla_w_o, *conv_w, *a_log, *dt_bias, *dn_norm_w, *dn_w_o, *w_out;
    float* out;
    bf16_t *h, *Pa, *Pz, *Pg, *Qb, *Vt, *Kb, *MH, *EF, *ST, *A_mla, *A_dn, *Mb;
    bf16_t *Wt_a, *Wt_z, *Wt_g, *Wt_uq, *Wt_ukv, *Wt_mo, *Wt_do, *Wt_out;
    float *mod, *rope;
    unsigned* bar;
};

typedef float f32x4 __attribute__((ext_vector_type(4)));
typedef unsigned u32x4 __attribute__((ext_vector_type(4)));
typedef __bf16 bf16v2_t __attribute__((ext_vector_type(2)));
typedef float f32x2 __attribute__((ext_vector_type(2)));
__device__ __forceinline__ uint32_t pack_bf2(float lo, float hi) {
    f32x2 v = {lo, hi};
    bf16v2_t b = __builtin_convertvector(v, bf16v2_t);
    return __builtin_bit_cast(uint32_t, b);
}
__device__ __forceinline__ void st_bf4(bf16_t* p, f32x4 v) {
    uint2 o; o.x = pack_bf2(v[0], v[1]); o.y = pack_bf2(v[2], v[3]);
    *(uint2*)p = o;
}
__device__ __forceinline__ float bf2f(bf16_t v) { return __uint_as_float(((uint32_t)v) << 16); }
__device__ __forceinline__ bf16_t f2bf(float f) {
    uint32_t u = __float_as_uint(f);
    u += 0x7fffu + ((u >> 16) & 1u);
    return (bf16_t)(u >> 16);
}
__device__ __forceinline__ float silu_f(float v) { return v * __builtin_amdgcn_rcpf(1.f + __expf(-v)); }
__device__ __forceinline__ float sigmoid_f(float v) { return __builtin_amdgcn_rcpf(1.f + __expf(-v)); }
template <int CTRL> __device__ __forceinline__ float dpp_mov(float v) {
    return __builtin_bit_cast(float, __builtin_amdgcn_update_dpp(0, __builtin_bit_cast(int, v), CTRL, 0xF, 0xF, true));
}
__device__ __forceinline__ float row16_sum(float v) {
    v += dpp_mov<0xB1>(v); v += dpp_mov<0x4E>(v); v += dpp_mov<0x141>(v); v += dpp_mov<0x140>(v); return v;
}
__device__ __forceinline__ float rdlane(float v, int l) { return __builtin_bit_cast(float, __builtin_amdgcn_readlane(__builtin_bit_cast(int, v), l)); }
__device__ __forceinline__ float wave_sum(float v) {
    v += dpp_mov<0xB1>(v);
    v += dpp_mov<0x4E>(v);
    v += dpp_mov<0x141>(v);
    v += dpp_mov<0x140>(v);
    return (rdlane(v, 0) + rdlane(v, 16)) + (rdlane(v, 32) + rdlane(v, 48));
}
__device__ __forceinline__ float xrow_sum(float v) { v += __shfl_xor(v, 16); v += __shfl_xor(v, 32); return v; }
__device__ __forceinline__ void ph_mod(const Params& p, int bid, int nb, char* smem) {
    float* sc = (float*)smem;
    const int item = bid & 511;
    const int k0 = (item >> 4) * 32, cb = (item & 15) * 192, tid = VTID;
    for (int i = tid; i < 288; i += NTHR) {
        const int r = i >> 5, kk = i & 31;
        const float v = (r < 8) ? p.c[r * 1024 + k0 + kk] : p.c_ctx[k0 + kk];
        sc[i] = silu_f(v);
    }
    __syncthreads();
    if (tid < 192) {
        const float* wp = p.w_mod + (size_t)k0 * 3072 + cb;
        float acc[9];
#pragma unroll
        for (int r = 0; r < 9; ++r) acc[r] = 0.f;
        int NH = 2;
        asm volatile("" : "+s"(NH));
        for (int hh = 0; hh < NH; ++hh) {
            float wv[16];
#pragma unroll
            for (int kk = 0; kk < 16; ++kk) wv[kk] = wp[(size_t)(hh * 16 + kk) * 3072 + tid];
#pragma unroll
            for (int k4 = 0; k4 < 4; ++k4)
#pragma unroll
                for (int r = 0; r < 9; ++r) {
                    const f32x4 s4 = *(const f32x4*)(sc + r * 32 + hh * 16 + 4 * k4);
                    acc[r] += s4[0] * wv[4 * k4] + s4[1] * wv[4 * k4 + 1] + s4[2] * wv[4 * k4 + 2] + s4[3] * wv[4 * k4 + 3];
                }
        }
        const float bb = (k0 == 0) ? p.b_mod[cb + tid] : 0.f;
#pragma unroll
        for (int r = 0; r < 9; ++r) atomicAdd(p.mod + r * 3072 + cb + tid, acc[r] + bb);
    }
    __syncthreads();
}

__device__ __forceinline__ void ph_norm(const Params& p, int bid, int nb, char* smem) {
    const int lane = VTID & 63, gw = bid * 4 + (VTID >> 6), nw = nb * 4;
    const int per = (NT + nw - 1) / nw;
    const int r0 = gw * per, r1 = (r0 + per < NT) ? r0 + per : NT;
    auto rowptr = [&](int rr) -> const float* { return (rr < NCTX) ? p.ctx + (size_t)rr * DM : p.x + (size_t)(rr - NCTX) * DM; };
    f32x4 v[4], vn[4], av[4], sv[4];
    int cur_m = -1;
    if (r0 < r1) {
        const float* src = rowptr(r0);
#pragma unroll
        for (int i = 0; i < 4; ++i) v[i] = *(const f32x4*)(src + i * 256 + lane * 4);
    }
    for (int r = r0; r < r1; ++r) {
        if (r + 1 < r1) {
            const float* src = rowptr(r + 1);
#pragma unroll
            for (int i = 0; i < 4; ++i) vn[i] = *(const f32x4*)(src + i * 256 + lane * 4);
        }
        const int mrow = (r < NCTX) ? 8 : (r - NCTX) / SEQ;
        if (mrow != cur_m) {
            cur_m = mrow;
            const float* shift = p.mod + mrow * 3072;
            const float* scale = shift + 1024;
#pragma unroll
            for (int i = 0; i < 4; ++i) {
                const int k = i * 256 + lane * 4;
                const f32x4 nwv = *(const f32x4*)(p.norm_w + k), sc = *(const f32x4*)(scale + k);
                sv[i] = *(const f32x4*)(shift + k);
#pragma unroll
                for (int e2 = 0; e2 < 4; ++e2) av[i][e2] = nwv[e2] * (1.f + sc[e2]);
            }
        }
        float ss = 0.f;
#pragma unroll
        for (int i = 0; i < 4; ++i) ss += v[i][0] * v[i][0] + v[i][1] * v[i][1] + v[i][2] * v[i][2] + v[i][3] * v[i][3];
        ss = wave_sum(ss);
        const float rstd = rsqrtf(ss * (1.f / 1024.f) + EPSF);
#pragma unroll
        for (int i = 0; i < 4; ++i) {
            f32x4 y;
#pragma unroll
            for (int e2 = 0; e2 < 4; ++e2) y[e2] = (v[i][e2] * rstd) * av[i][e2] + sv[i][e2];
            st_bf4(p.h + (size_t)r * DM + i * 256 + lane * 4, y);
        }
#pragma unroll
        for (int i = 0; i < 4; ++i) v[i] = vn[i];
    }
}


struct WprepDesc { const float* W; const float* ksc; bf16_t* dst; int ldw, K, n0, k0, srcbase; };
__device__ __forceinline__ void wprep_decode(const Params& p, int u, WprepDesc& d) {
    const int U0 = 72 * 8, U1 = 32 * 8, U2 = 64 * 8, U3 = 24 * 3, U4 = 32 * 2, U5 = 32 * 4, U6 = 32 * 4;
    int v = u, job;
    if (v < U0) { job = 0; d.W = p.w_in; d.ldw = IN_DIM; d.K = 1024; d.dst = p.Wt_a; }
    else if ((v -= U0) < U1) { job = 1; d.W = p.w_in; d.ldw = IN_DIM; d.K = 1024; d.dst = p.Wt_z; }
    else if ((v -= U1) < U2) { job = 2; d.W = p.w_in; d.ldw = IN_DIM; d.K = 1024; d.dst = p.Wt_g; }
    else if ((v -= U2) < U3) { job = 3; d.W = p.w_uq; d.ldw = 768; d.K = 384; d.dst = p.Wt_uq; }
    else if ((v -= U3) < U4) { job = 4; d.W = p.w_ukv; d.ldw = 1024; d.K = 256; d.dst = p.Wt_ukv; }
    else if ((v -= U4) < U5) { job = 5; d.W = p.mla_w_o; d.ldw = 1024; d.K = 512; d.dst = p.Wt_mo; }
    else if ((v -= U5) < U6) { job = 6; d.W = p.dn_w_o; d.ldw = 1024; d.K = 512; d.dst = p.Wt_do; }
    else { v -= U6; job = 7; d.W = p.w_out; d.ldw = 1024; d.K = 1024; d.dst = p.Wt_out; }
    const int nkt = d.K / 128;
    d.n0 = (v / nkt) * 32; d.k0 = (v % nkt) * 128;
    const int n0 = d.n0;
    int srcbase = n0;
    if (job == 0) {
        if (n0 < 672) srcbase = n0;
        else if (n0 < 2208) { const int r = n0 - 672, hh = r / 192, g = (r % 192) >> 6, i0 = r & 63; srcbase = 1184 + g * 512 + hh * 64 + i0; }
        else srcbase = (n0 < 2240) ? n0 + 1024 : -1;
    }
    else if (job == 1) srcbase = (n0 < 512) ? 672 + n0 : 2208 + n0;
    else if (job == 2) srcbase = 3264 + n0;
    d.srcbase = srcbase;
    d.ksc = (job == 3) ? p.q_norm_w : (job == 4) ? p.kv_norm_w : nullptr;
}
__device__ __forceinline__ void wprep_load(const WprepDesc& d, f32x4 (&v)[4], int tid) {
    const int n4 = (tid & 7) * 4, kk = tid >> 3;
#pragma unroll
    for (int q = 0; q < 4; ++q) {
        v[q] = (f32x4){0.f, 0.f, 0.f, 0.f};
        if (d.srcbase >= 0) v[q] = *(const f32x4*)(d.W + (size_t)(d.k0 + kk + 32 * q) * d.ldw + d.srcbase + n4);
    }
}
__device__ __forceinline__ void wprep_emit(const WprepDesc& d, const f32x4 (&v)[4], float* tile, int tid) {
    {
        const int n4 = (tid & 7) * 4, kk = tid >> 3;
#pragma unroll
        for (int q = 0; q < 4; ++q) {
            const int k = kk + 32 * q;
            const float s = d.ksc ? d.ksc[d.k0 + k] : 1.f;
            float* t = tile + k * 33 + n4;
            t[0] = v[q][0] * s; t[1] = v[q][1] * s; t[2] = v[q][2] * s; t[3] = v[q][3] * s;
        }
    }
    __syncthreads();
    {
        const int n = tid >> 3;
#pragma unroll
        for (int q = 0; q < 2; ++q) {
            const int kc = (tid & 7) + 8 * q;
            const float* t = tile + (kc * 8) * 33 + n;
            u32x4 o;
            o[0] = pack_bf2(t[0 * 33], t[1 * 33]); o[1] = pack_bf2(t[2 * 33], t[3 * 33]);
            o[2] = pack_bf2(t[4 * 33], t[5 * 33]); o[3] = pack_bf2(t[6 * 33], t[7 * 33]);
            *(u32x4*)(d.dst + (size_t)(d.n0 + n) * d.K + d.k0 + kc * 8) = o;
        }
    }
    __syncthreads();
}

__device__ __forceinline__ void ph_wprep(const Params& p, int bid, int nb, char* smem) {
    float* tile = (float*)smem;
    const int UT = 72 * 8 + 32 * 8 + 64 * 8 + 24 * 3 + 32 * 2 + 32 * 4 + 32 * 4 + 32 * 8;
    const int tid = VTID;
    WprepDesc d, dn;
    f32x4 v[4], vn[4];
    int u = bid;
    if (u < UT) { wprep_decode(p, u, d); wprep_load(d, v, tid); }
    for (; u < UT; u += nb) {
        const bool more = (u + nb < UT);
        if (more) { wprep_decode(p, u + nb, dn); wprep_load(dn, vn, tid); }
        wprep_emit(d, v, tile, tid);
        if (more) {
            d = dn;
#pragma unroll
            for (int q = 0; q < 4; ++q) v[q] = vn[q];
        }
    }
    if (bid == nb - 1) {
        for (int i = VTID; i < 512; i += NTHR) {
            const int pos = i >> 3, f = i & 7;
            const float ang = (float)pos * powf(10000.f, -(float)f / 8.f);
            p.rope[2 * i] = cosf(ang); p.rope[2 * i + 1] = sinf(ang);
        }
    }
}

typedef short bf16x8 __attribute__((ext_vector_type(8)));


__device__ __forceinline__ int lds_off(int row, int chunk) { return row * 128 + (((chunk ^ (row >> 1)) & 7) << 4); }

__device__ __forceinline__ int epi_perm(int rho) { return 8 * ((rho >> 2) & 3) + 4 * (rho >> 4) + (rho & 3); }

template <int NTN>
__device__ __forceinline__ void gemm_compute_stage(f32x4 (&acc)[NTN][4], const char* sa, int wm, int wn, int l15, int lq) {
    const char* sb = sa + 16384;
#pragma unroll
    for (int ks = 0; ks < 2; ++ks) {
        bf16x8 af[4], bfr[NTN];
#pragma unroll
        for (int mt = 0; mt < 4; ++mt) af[mt] = *(const bf16x8*)(sa + lds_off(wm * 64 + mt * 16 + l15, ks * 4 + lq));
#pragma unroll
        for (int nt = 0; nt < NTN; ++nt) bfr[nt] = *(const bf16x8*)(sb + lds_off(wn * (16 * NTN) + nt * 16 + l15, ks * 4 + lq));
#pragma unroll
        for (int nt = 0; nt < NTN; ++nt)
#pragma unroll
            for (int mt = 0; mt < 4; ++mt)
                acc[nt][mt] = __builtin_amdgcn_mfma_f32_16x16x32_bf16(bfr[nt], af[mt], acc[nt][mt], 0, 0, 0);
    }
}
template <int NTN>
__device__ __forceinline__ void gemm_tile_acc(f32x4 (&acc)[NTN][4], const bf16_t* __restrict__ A, int lda, const bf16_t* __restrict__ Bt, int ldb,
                                              int K, int m0, int n0, char* smem) {
    int tid = VTID;
    asm volatile("" : "+v"(tid));
    const int lane = tid & 63, w = tid >> 6, wm = w >> 1, wn = w & 1;
    const int l15 = lane & 15, lq = lane >> 4;
    const int srow = tid >> 3, sch = (tid & 7) ^ ((srow >> 1) & 7);
    const bf16_t* ap = A + (size_t)(m0 + srow) * lda + sch * 8;
    const int prow = epi_perm(srow & 31);
    const bf16_t* bp = Bt + (size_t)(n0 + prow) * ldb + sch * 8;
    int KT = K >> 6;
    asm volatile("" : "+s"(KT));
    LAS char* lbase = (LAS char*)smem + w * 1024;
#define GT_STAGE(ST_, KT_) do { \
        _Pragma("unroll") for (int i = 0; i < 4; ++i) \
            __builtin_amdgcn_global_load_lds((const void*)(ap + (size_t)(32 * i) * lda + (KT_) * 64), (LAS void*)(lbase + (ST_) * 32768 + i * 4096), 16, 0, 0); \
        _Pragma("unroll") for (int i = 0; i < NTN; ++i) \
            __builtin_amdgcn_global_load_lds((const void*)(bp + (size_t)(32 * i) * ldb + (KT_) * 64), (LAS void*)(lbase + (ST_) * 32768 + 16384 + i * 4096), 16, 0, 0); } while (0)
    GT_STAGE(0, 0);
    __syncthreads();
    for (int kt = 0; kt < KT; ++kt) {
        if (kt + 1 < KT) GT_STAGE((kt + 1) & 1, kt + 1);
        gemm_compute_stage<NTN>(acc, smem + (kt & 1) * 32768, wm, wn, l15, lq);
        __syncthreads();
    }
#undef GT_STAGE
}

template <int NTN>
__device__ __forceinline__ void acc_zero(f32x4 (&acc)[NTN][4]) {
#pragma unroll
    for (int i = 0; i < NTN; ++i)
#pragma unroll
        for (int j = 0; j < 4; ++j) acc[i][j] = (f32x4){0.f, 0.f, 0.f, 0.f};
}

__device__ __forceinline__ bool next_unit(int it, int U, int bid, int nb, int& u) {
    const int x = bid & 7, li = bid >> 3, per = nb >> 3;
    const int lo = (int)(((long)U * x) >> 3), hi = (int)(((long)U * (x + 1)) >> 3);
    u = lo + li + it * per;
    return u < hi;
}
__device__ __forceinline__ void unit_mn(int u, int ntn, int& tm, int& tn) {
    const int g = u / (8 * ntn), r = u % (8 * ntn);
    tm = g * 8 + (r & 7); tn = r >> 3;
}


__device__ __forceinline__ f32x4 ld_bf4(const bf16_t* p) {
    const uint2 r = *(const uint2*)p;
    return (f32x4){__uint_as_float(r.x << 16), __uint_as_float(r.x & 0xffff0000u), __uint_as_float(r.y << 16), __uint_as_float(r.y & 0xffff0000u)};
}
#define EPI_COORDS_OPAQUE(SFX) int tid##SFX = VTID; asm volatile("" : "+v"(tid##SFX)); \
    const int lane_ = tid##SFX & 63, w_ = tid##SFX >> 6, wm_ = w_ >> 1, wn_ = w_ & 1, l15_ = lane_ & 15, lq_ = lane_ >> 4;
#define EPI_COORDS const int lane_ = VTID & 63, w_ = VTID >> 6, wm_ = w_ >> 1, wn_ = w_ & 1, l15_ = lane_ & 15, lq_ = lane_ >> 4;
#define EPI_ROW(mt) (m0 + wm_ * 64 + (mt) * 16 + l15_)
#define EPI_COL(nt) (n0 + wn_ * 64 + 32 * ((nt) >> 1) + 8 * lq_ + 4 * ((nt) & 1))

__device__ __forceinline__ void gemm_store_bf16(const bf16_t* A, int lda, const bf16_t* Bt, int K, int tm, int tn, bf16_t* C, int ldc, char* smem) {
    f32x4 acc[4][4];
    acc_zero<4>(acc);
    const int m0 = tm * 128, n0 = tn * 128;
    gemm_tile_acc<4>(acc, A, lda, Bt, K, K, m0, n0, smem);
    EPI_COORDS
#pragma unroll
    for (int j = 0; j < 2; ++j)
#pragma unroll
        for (int mt = 0; mt < 4; ++mt) {
            u32x4 o;
            o[0] = pack_bf2(acc[2 * j][mt][0], acc[2 * j][mt][1]); o[1] = pack_bf2(acc[2 * j][mt][2], acc[2 * j][mt][3]);
            o[2] = pack_bf2(acc[2 * j + 1][mt][0], acc[2 * j + 1][mt][1]); o[3] = pack_bf2(acc[2 * j + 1][mt][2], acc[2 * j + 1][mt][3]);
            *(u32x4*)(C + (size_t)EPI_ROW(mt) * ldc + EPI_COL(2 * j)) = o;
        }
}

template <int NTN>
__device__ __forceinline__ void gemm_rows_acc(f32x4 (&acc)[NTN][2], float (&ssq)[2], const bf16_t* __restrict__ A, int lda,
                                              const bf16_t* __restrict__ Bt, int ldb, int K, int m0, int n0, char* smem) {
    constexpr int NB_ = NTN / 2;
    int tid = VTID;
    asm volatile("" : "+v"(tid));
    const int lane = tid & 63, w = tid >> 6;
    const int l15 = lane & 15, lq = lane >> 4;
    const int srow = tid >> 3, sch = (tid & 7) ^ ((srow >> 1) & 7);
    const bf16_t* ap = A + (size_t)(m0 + srow) * lda + sch * 8;
    const bf16_t* bp = Bt + (size_t)(n0 + srow) * ldb + sch * 8;
    int KT = K >> 6;
    asm volatile("" : "+s"(KT));
    LAS char* lbase = (LAS char*)smem + w * 1024;
#define GR_STAGE(ST_, KT_) do { \
        _Pragma("unroll") for (int i = 0; i < 4; ++i) \
            __builtin_amdgcn_global_load_lds((const void*)(ap + (size_t)(32 * i) * lda + (KT_) * 64), (LAS void*)(lbase + (ST_) * 32768 + i * 4096), 16, 0, 0); \
        _Pragma("unroll") for (int i = 0; i < NB_; ++i) \
            __builtin_amdgcn_global_load_lds((const void*)(bp + (size_t)(32 * i) * ldb + (KT_) * 64), (LAS void*)(lbase + (ST_) * 32768 + 16384 + i * 4096), 16, 0, 0); } while (0)
    GR_STAGE(0, 0);
    __syncthreads();
    for (int kt = 0; kt < KT; ++kt) {
        if (kt + 1 < KT) GR_STAGE((kt + 1) & 1, kt + 1);
        const char* sa = smem + (kt & 1) * 32768;
        const char* sb = sa + 16384;
#pragma unroll
        for (int ks = 0; ks < 2; ++ks) {
            bf16x8 af[2], bfr[NTN];
#pragma unroll
            for (int mt = 0; mt < 2; ++mt) af[mt] = *(const bf16x8*)(sa + lds_off(w * 32 + mt * 16 + l15, ks * 4 + lq));
#pragma unroll
            for (int nt = 0; nt < NTN; ++nt) bfr[nt] = *(const bf16x8*)(sb + lds_off(nt * 16 + l15, ks * 4 + lq));
#pragma unroll
            for (int mt = 0; mt < 2; ++mt) {
                const u32x4 aw = __builtin_bit_cast(u32x4, af[mt]);
#pragma unroll
                for (int e2 = 0; e2 < 4; ++e2) {
                    const float lo = __uint_as_float(aw[e2] << 16), hi = __uint_as_float(aw[e2] & 0xffff0000u);
                    ssq[mt] += lo * lo + hi * hi;
                }
            }
#pragma unroll
            for (int nt = 0; nt < NTN; ++nt)
#pragma unroll
                for (int mt = 0; mt < 2; ++mt)
                    acc[nt][mt] = __builtin_amdgcn_mfma_f32_16x16x32_bf16(bfr[nt], af[mt], acc[nt][mt], 0, 0, 0);
        }
        __syncthreads();
    }
#undef GR_STAGE
    ssq[0] = xrow_sum(ssq[0]);
    ssq[1] = xrow_sum(ssq[1]);
}

__device__ __forceinline__ void ph_mla_proj(const Params& p, int bid, int nb, char* smem) {
    const int tid = VTID, lane = tid & 63, w = tid >> 6, l15 = lane & 15, lq = lane >> 4;
    float* s_rope = (float*)(smem + 65536);
    float* s_qhn = s_rope + 1024;
    float* s_khn = s_qhn + 96;
    for (int i = tid; i < 1024; i += NTHR) s_rope[i] = p.rope[i];
    if (tid < 96) { s_qhn[tid] = p.qhn_w[tid]; s_khn[tid] = p.khn_w[tid]; }
    __syncthreads();
    const int UQ = 128 * 8, UK = 144 * 8;
    int u;
    for (int it = 0; next_unit(it, UQ + UK, bid, nb, u); ++it) {
        if (u < UQ) {
            const int tm = u >> 3, hh = u & 7;
            const int m0 = NCTX + tm * 128;
            f32x4 acc[6][2];
            float ssq[2] = {0.f, 0.f};
#pragma unroll
            for (int i = 0; i < 6; ++i) { acc[i][0] = (f32x4){0.f, 0.f, 0.f, 0.f}; acc[i][1] = (f32x4){0.f, 0.f, 0.f, 0.f}; }
            gemm_rows_acc<6>(acc, ssq, p.Pa + PA_CQ, PA_W, p.Wt_uq, 384, 384, m0, hh * 96, smem);
#pragma unroll
            for (int mt = 0; mt < 2; ++mt) {
                const int ml = 32 * w + 16 * mt + l15;
                const int rl = tm * 128 + ml;
                const int b = rl >> 11, t = rl & 2047;
                const float rs = rsqrtf(ssq[mt] * (1.f / 384.f) + EPSF);
                float hs = 0.f;
#pragma unroll
                for (int nt = 0; nt < 6; ++nt)
#pragma unroll
                    for (int e = 0; e < 4; ++e) { const float v = acc[nt][mt][e] * rs; acc[nt][mt][e] = v; hs += v * v; }
                hs = xrow_sum(hs);
                const float hr = rsqrtf(hs * (1.f / 96.f) + EPSF) * (0.10206207261596575f * 1.4426950408889634f);
                bf16_t* qd = p.Qb + ((size_t)((b * 8 + hh) * SEQ + t)) * 96 + 4 * lq;
#pragma unroll
                for (int nt = 0; nt < 6; ++nt) {
                    const f32x4 wv = *(const f32x4*)(s_qhn + 16 * nt + 4 * lq);
                    f32x4 v;
#pragma unroll
                    for (int e = 0; e < 4; ++e) v[e] = acc[nt][mt][e] * hr * wv[e];
                    if (nt >= 4) {
                        const int pos = (nt == 4) ? (t >> 6) : (t & 63);
                        const int ph = lq >> 1;
#pragma unroll
                        for (int e = 0; e < 4; ++e) {
                            const float2 cs = *(const float2*)(s_rope + 2 * (pos * 8 + (lq & 1) * 4 + e));
                            const float partner = __shfl_xor(v[e], 32);
                            const float t1 = ph ? partner : v[e], t2 = ph ? v[e] : partner;
                            v[e] = ph ? (t1 * cs.y + t2 * cs.x) : (t1 * cs.x - t2 * cs.y);
                        }
                    }
                    st_bf4(qd + 16 * nt, v);
                }
            }
        } else {
            const int uu = u - UQ;
            const int tm = uu >> 3, hh = uu & 7;
            const int m0 = tm * 128;
            f32x4 acc[8][2];
            float ssq[2] = {0.f, 0.f};
#pragma unroll
            for (int i = 0; i < 8; ++i) { acc[i][0] = (f32x4){0.f, 0.f, 0.f, 0.f}; acc[i][1] = (f32x4){0.f, 0.f, 0.f, 0.f}; }
            gemm_rows_acc<8>(acc, ssq, p.Pa + PA_CKV, PA_W, p.Wt_ukv, 256, 256, m0, hh * 128, smem);
#pragma unroll
            for (int mt = 0; mt < 2; ++mt) {
                const int ml = 32 * w + 16 * mt + l15;
                const int r = m0 + ml;
                int b, pos, t = 0; const bool lat = (r >= NCTX);
                if (!lat) { b = r >> 8; pos = r & 255; }
                else { const int rl = r - NCTX; b = rl >> 11; t = rl & 2047; pos = CTXL + t; }
                const float rs = rsqrtf(ssq[mt] * (1.f / 256.f) + EPSF);
                const u32x4 krw = *(const u32x4*)(p.Pa + (size_t)r * PA_W + PA_KR + 8 * lq);
                float kr[8];
#pragma unroll
                for (int e = 0; e < 4; ++e) { kr[2 * e] = __uint_as_float(krw[e] << 16); kr[2 * e + 1] = __uint_as_float(krw[e] & 0xffff0000u); }
                float hs = 0.f;
#pragma unroll
                for (int e = 0; e < 8; ++e) hs += kr[e] * kr[e];
#pragma unroll
                for (int nt = 0; nt < 4; ++nt)
#pragma unroll
                    for (int e = 0; e < 4; ++e) { const float v = acc[nt][mt][e] * rs; acc[nt][mt][e] = v; hs += v * v; }
                hs = xrow_sum(hs);
                const float hr = rsqrtf(hs * (1.f / 96.f) + EPSF);
                bf16_t* kd = p.Kb + ((size_t)((b * 8 + hh) * TPB + pos)) * 96;
#pragma unroll
                for (int nt = 0; nt < 4; ++nt) {
                    const f32x4 wv = *(const f32x4*)(s_khn + 16 * nt + 4 * lq);
                    f32x4 v;
#pragma unroll
                    for (int e = 0; e < 4; ++e) v[e] = acc[nt][mt][e] * hr * wv[e];
                    st_bf4(kd + 16 * nt + 4 * lq, v);
                }
                {
                    const int ph = lq & 1;
                    const int rp = (lq >> 1) ? (t & 63) : (t >> 6);
                    float o[8];
#pragma unroll
                    for (int e = 0; e < 8; ++e) {
                        const float v = kr[e] * hr * s_khn[64 + 8 * lq + e];
                        const float partner = __shfl_xor(v, 16);
                        float2 cs = make_float2(1.f, 0.f);
                        if (lat) cs = *(const float2*)(s_rope + 2 * (rp * 8 + e));
                        const float t1 = ph ? partner : v, t2 = ph ? v : partner;
                        o[e] = ph ? (t1 * cs.y + t2 * cs.x) : (t1 * cs.x - t2 * cs.y);
                    }
                    u32x4 ov;
                    ov[0] = pack_bf2(o[0], o[1]); ov[1] = pack_bf2(o[2], o[3]); ov[2] = pack_bf2(o[4], o[5]); ov[3] = pack_bf2(o[6], o[7]);
                    *(u32x4*)(kd + 64 + 8 * lq) = ov;
                }
                {
                    const int kpos = (pos & ~12) | ((pos & 4) << 1) | ((pos & 8) >> 1);
                    bf16_t* vd = p.Vt + (size_t)((b * 8 + hh) * 64) * TPB + kpos;
#pragma unroll
                    for (int nt = 4; nt < 8; ++nt)
#pragma unroll
                        for (int e = 0; e < 4; ++e) vd[(size_t)(16 * (nt - 4) + 4 * lq + e) * TPB] = f2bf(acc[nt][mt][e] * rs);
                }
            }
        }
    }
}

typedef float f32x16 __attribute__((ext_vector_type(16)));
#define ATT_KROW 208
#define ATT_VROW 144
#define ATT_KBYTES (64 * ATT_KROW)
#define ATT_STAGE (ATT_KBYTES + 64 * ATT_VROW)
__device__ __forceinline__ float max3_asm(float a, float b, float c) { float r; asm("v_max3_f32 %0, %1, %2, %3" : "=v"(r) : "v"(a), "v"(b), "v"(c)); return r; }
template <bool ZI>
__device__ __forceinline__ void ph_attn_t(const Params& p, int bid, int nb, char* smem, const float negB) {
    const int tid = VTID, lane = tid & 63, w = tid >> 6, r = lane & 31, h = lane >> 5;
    int u;
    for (int it = 0; next_unit(it, 1024, bid, nb, u); ++it) {
        const int bh = u >> 4, qb = u & 15;
        bf16x8 qf[6];
        {
            const bf16_t* Qp = p.Qb + ((size_t)bh * SEQ + qb * 128 + w * 32 + r) * 96 + h * 8;
#pragma unroll
            for (int s = 0; s < 6; ++s) qf[s] = *(const bf16x8*)(Qp + s * 16);
        }
        const bf16_t* Kg = p.Kb + (size_t)bh * TPB * 96 + tid * 8;
        const bf16_t* Vg = p.Vt + (size_t)bh * 64 * TPB + (size_t)(tid >> 3) * TPB + (tid & 7) * 8;
        int koff[3], voff[2];
#pragma unroll
        for (int i = 0; i < 3; ++i) { const int c = tid + 256 * i; koff[i] = (c / 12) * ATT_KROW + (c % 12) * 16; }
#pragma unroll
        for (int i = 0; i < 2; ++i) { const int c = tid + 256 * i; voff[i] = ATT_KBYTES + (c >> 3) * ATT_VROW + (c & 7) * 16; }
        u32x4 rk[3], rv[2];
#pragma unroll
        for (int i = 0; i < 3; ++i) rk[i] = *(const u32x4*)(Kg + i * 2048);
#pragma unroll
        for (int i = 0; i < 2; ++i) rv[i] = *(const u32x4*)(Vg + (size_t)(32 * i) * TPB);
#pragma unroll
        for (int i = 0; i < 3; ++i) *(u32x4*)(smem + koff[i]) = rk[i];
#pragma unroll
        for (int i = 0; i < 2; ++i) *(u32x4*)(smem + voff[i]) = rv[i];
        __syncthreads();
        f32x16 o0, o1;
#pragma unroll
        for (int i = 0; i < 16; ++i) { o0[i] = 0.f; o1[i] = 0.f; }
        float l = 0.f;
        int NKT = TPB / 64;
        asm volatile("" : "+s"(NKT));
        for (int kt = 0; kt < NKT; ++kt) {
            if (kt + 1 < NKT) {
#pragma unroll
                for (int i = 0; i < 3; ++i) rk[i] = *(const u32x4*)(Kg + (size_t)(kt + 1) * 6144 + i * 2048);
#pragma unroll
                for (int i = 0; i < 2; ++i) rv[i] = *(const u32x4*)(Vg + (size_t)(32 * i) * TPB + (kt + 1) * 64);
            }
            const char* sk = smem + (kt & 1) * ATT_STAGE;
            const char* sv = sk + ATT_KBYTES;
            f32x16 s0, s1;
            if (ZI) {
                const f32x16 z16 = {0.f, 0.f, 0.f, 0.f, 0.f, 0.f, 0.f, 0.f, 0.f, 0.f, 0.f, 0.f, 0.f, 0.f, 0.f, 0.f};
                const bf16x8 k0 = *(const bf16x8*)(sk + r * ATT_KROW + h * 16);
                const bf16x8 k1 = *(const bf16x8*)(sk + (32 + r) * ATT_KROW + h * 16);
                s0 = __builtin_amdgcn_mfma_f32_32x32x16_bf16(k0, qf[0], z16, 0, 0, 0);
                s1 = __builtin_amdgcn_mfma_f32_32x32x16_bf16(k1, qf[0], z16, 0, 0, 0);
            } else {
#pragma unroll
                for (int i = 0; i < 16; ++i) { s0[i] = negB; s1[i] = negB; }
            }
#pragma unroll
            for (int s = ZI ? 1 : 0; s < 6; ++s) {
                const bf16x8 k0 = *(const bf16x8*)(sk + r * ATT_KROW + (2 * s + h) * 16);
                const bf16x8 k1 = *(const bf16x8*)(sk + (32 + r) * ATT_KROW + (2 * s + h) * 16);
                s0 = __builtin_amdgcn_mfma_f32_32x32x16_bf16(k0, qf[s], s0, 0, 0, 0);
                s1 = __builtin_amdgcn_mfma_f32_32x32x16_bf16(k1, qf[s], s1, 0, 0, 0);
            }
            float ls = 0.f;
#pragma unroll
            for (int i = 0; i < 16; ++i) {
                s0[i] = __builtin_amdgcn_exp2f(s0[i]);
                s1[i] = __builtin_amdgcn_exp2f(s1[i]);
                ls += s0[i] + s1[i];
            }
            l += ls;
#pragma unroll
            for (int ks = 0; ks < 4; ++ks) {
                u32x4 pw;
                if (ks < 2) {
                    pw[0] = pack_bf2(s0[8 * (ks & 1) + 0], s0[8 * (ks & 1) + 1]); pw[1] = pack_bf2(s0[8 * (ks & 1) + 2], s0[8 * (ks & 1) + 3]);
                    pw[2] = pack_bf2(s0[8 * (ks & 1) + 4], s0[8 * (ks & 1) + 5]); pw[3] = pack_bf2(s0[8 * (ks & 1) + 6], s0[8 * (ks & 1) + 7]);
                } else {
                    pw[0] = pack_bf2(s1[8 * (ks & 1) + 0], s1[8 * (ks & 1) + 1]); pw[1] = pack_bf2(s1[8 * (ks & 1) + 2], s1[8 * (ks & 1) + 3]);
                    pw[2] = pack_bf2(s1[8 * (ks & 1) + 4], s1[8 * (ks & 1) + 5]); pw[3] = pack_bf2(s1[8 * (ks & 1) + 6], s1[8 * (ks & 1) + 7]);
                }
                const bf16x8 pf = __builtin_bit_cast(bf16x8, pw);
                const bf16x8 v0 = *(const bf16x8*)(sv + r * ATT_VROW + (2 * ks + h) * 16);
                const bf16x8 v1 = *(const bf16x8*)(sv + (32 + r) * ATT_VROW + (2 * ks + h) * 16);
                o0 = __builtin_amdgcn_mfma_f32_32x32x16_bf16(v0, pf, o0, 0, 0, 0);
                o1 = __builtin_amdgcn_mfma_f32_32x32x16_bf16(v1, pf, o1, 0, 0, 0);
            }
            if (kt + 1 < NKT) {
                char* ds = smem + ((kt + 1) & 1) * ATT_STAGE;
#pragma unroll
                for (int i = 0; i < 3; ++i) *(u32x4*)(ds + koff[i]) = rk[i];
#pragma unroll
                for (int i = 0; i < 2; ++i) *(u32x4*)(ds + voff[i]) = rv[i];
            }
            __syncthreads();
        }
        l += __shfl_xor(l, 32);
        const float inv = 1.f / l;
        const int b = bh >> 3, hh = bh & 7;
        const size_t rl = (size_t)(b * SEQ + qb * 128 + w * 32 + r);
        bf16_t* op = p.A_mla + rl * 512 + hh * 64 + 4 * h;
        const bf16_t* zp = p.Pz + rl * PZ_W + hh * 64 + 4 * h;
#pragma unroll
        for (int g = 0; g < 4; ++g) {
            const f32x4 z0 = ld_bf4(zp + 8 * g), z1 = ld_bf4(zp + 32 + 8 * g);
            uint2 a, c;
            a.x = pack_bf2(o0[4 * g + 0] * inv * silu_f(z0[0]), o0[4 * g + 1] * inv * silu_f(z0[1]));
            a.y = pack_bf2(o0[4 * g + 2] * inv * silu_f(z0[2]), o0[4 * g + 3] * inv * silu_f(z0[3]));
            c.x = pack_bf2(o1[4 * g + 0] * inv * silu_f(z1[0]), o1[4 * g + 1] * inv * silu_f(z1[1]));
            c.y = pack_bf2(o1[4 * g + 2] * inv * silu_f(z1[2]), o1[4 * g + 3] * inv * silu_f(z1[3]));
            *(uint2*)(op + 8 * g) = a;
            *(uint2*)(op + 32 + 8 * g) = c;
        }
    }
}

template <bool ZI>
__device__ __forceinline__ void ph_attn_d(const Params& p, int bid, int nb, char* smem, const float negB) {
    const int tid = VTID, lane = tid & 63, w = tid >> 6, r = lane & 31, h = lane >> 5;
    int u;
    for (int it = 0; next_unit(it, 512, bid, nb, u); ++it) {
        const int bh = u >> 3, qb = u & 7;
        bf16x8 qf[2][6];
#pragma unroll
        for (int t = 0; t < 2; ++t) {
            const bf16_t* Qp = p.Qb + ((size_t)bh * SEQ + qb * 256 + w * 64 + t * 32 + r) * 96 + h * 8;
#pragma unroll
            for (int s = 0; s < 6; ++s) qf[t][s] = *(const bf16x8*)(Qp + s * 16);
        }
        const bf16_t* Kg = p.Kb + (size_t)bh * TPB * 96 + tid * 8;
        const bf16_t* Vg = p.Vt + (size_t)bh * 64 * TPB + (size_t)(tid >> 3) * TPB + (tid & 7) * 8;
        int koff[3], voff[2];
#pragma unroll
        for (int i = 0; i < 3; ++i) { const int c = tid + 256 * i; koff[i] = (c / 12) * ATT_KROW + (c % 12) * 16; }
#pragma unroll
        for (int i = 0; i < 2; ++i) { const int c = tid + 256 * i; voff[i] = ATT_KBYTES + (c >> 3) * ATT_VROW + (c & 7) * 16; }
        u32x4 rk[3], rv[2];
#pragma unroll
        for (int i = 0; i < 3; ++i) rk[i] = *(const u32x4*)(Kg + i * 2048);
#pragma unroll
        for (int i = 0; i < 2; ++i) rv[i] = *(const u32x4*)(Vg + (size_t)(32 * i) * TPB);
#pragma unroll
        for (int i = 0; i < 3; ++i) *(u32x4*)(smem + koff[i]) = rk[i];
#pragma unroll
        for (int i = 0; i < 2; ++i) *(u32x4*)(smem + voff[i]) = rv[i];
        __syncthreads();
        f32x16 o[2][2];
#pragma unroll
        for (int t = 0; t < 2; ++t)
#pragma unroll
            for (int i = 0; i < 16; ++i) { o[t][0][i] = 0.f; o[t][1][i] = 0.f; }
        float l[2] = {0.f, 0.f};
        int NKT = TPB / 64;
        asm volatile("" : "+s"(NKT));
        for (int kt = 0; kt < NKT; ++kt) {
            if (kt + 1 < NKT) {
#pragma unroll
                for (int i = 0; i < 3; ++i) rk[i] = *(const u32x4*)(Kg + (size_t)(kt + 1) * 6144 + i * 2048);
#pragma unroll
                for (int i = 0; i < 2; ++i) rv[i] = *(const u32x4*)(Vg + (size_t)(32 * i) * TPB + (kt + 1) * 64);
            }
            const char* sk = smem + (kt & 1) * ATT_STAGE;
            const char* sv = sk + ATT_KBYTES;
            int NHF = 2;
            asm volatile("" : "+s"(NHF));
            for (int hf = 0; hf < NHF; ++hf) {
                const char* skh = sk + hf * 32 * ATT_KROW;
                f32x16 s[2];
                if (ZI) {
                    const f32x16 z16 = {0.f, 0.f, 0.f, 0.f, 0.f, 0.f, 0.f, 0.f, 0.f, 0.f, 0.f, 0.f, 0.f, 0.f, 0.f, 0.f};
                    const bf16x8 k0 = *(const bf16x8*)(skh + r * ATT_KROW + h * 16);
                    s[0] = __builtin_amdgcn_mfma_f32_32x32x16_bf16(k0, qf[0][0], z16, 0, 0, 0);
                    s[1] = __builtin_amdgcn_mfma_f32_32x32x16_bf16(k0, qf[1][0], z16, 0, 0, 0);
                } else {
#pragma unroll
                    for (int i = 0; i < 16; ++i) { s[0][i] = negB; s[1][i] = negB; }
                }
#pragma unroll
                for (int ss = ZI ? 1 : 0; ss < 6; ++ss) {
                    const bf16x8 k0 = *(const bf16x8*)(skh + r * ATT_KROW + (2 * ss + h) * 16);
                    s[0] = __builtin_amdgcn_mfma_f32_32x32x16_bf16(k0, qf[0][ss], s[0], 0, 0, 0);
                    s[1] = __builtin_amdgcn_mfma_f32_32x32x16_bf16(k0, qf[1][ss], s[1], 0, 0, 0);
                }
                bf16x8 pf[2][2];
#pragma unroll
                for (int t = 0; t < 2; ++t) {
                    float ls = 0.f;
#pragma unroll
                    for (int i = 0; i < 16; ++i) {
                        s[t][i] = __builtin_amdgcn_exp2f(s[t][i]);
                        ls += s[t][i];
                    }
                    l[t] += ls;
#pragma unroll
                    for (int ks = 0; ks < 2; ++ks) {
                        u32x4 pw;
#pragma unroll
                        for (int e = 0; e < 4; ++e) pw[e] = pack_bf2(s[t][8 * ks + 2 * e], s[t][8 * ks + 2 * e + 1]);
                        pf[t][ks] = __builtin_bit_cast(bf16x8, pw);
                    }
                }
#pragma unroll
                for (int ks = 0; ks < 2; ++ks) {
                    const bf16x8 v0 = *(const bf16x8*)(sv + r * ATT_VROW + (2 * (2 * hf + ks) + h) * 16);
                    const bf16x8 v1 = *(const bf16x8*)(sv + (32 + r) * ATT_VROW + (2 * (2 * hf + ks) + h) * 16);
#pragma unroll
                    for (int t = 0; t < 2; ++t) {
                        o[t][0] = __builtin_amdgcn_mfma_f32_32x32x16_bf16(v0, pf[t][ks], o[t][0], 0, 0, 0);
                        o[t][1] = __builtin_amdgcn_mfma_f32_32x32x16_bf16(v1, pf[t][ks], o[t][1], 0, 0, 0);
                    }
                }
            }
            if (kt + 1 < NKT) {
                char* ds = smem + ((kt + 1) & 1) * ATT_STAGE;
#pragma unroll
                for (int i = 0; i < 3; ++i) *(u32x4*)(ds + koff[i]) = rk[i];
#pragma unroll
                for (int i = 0; i < 2; ++i) *(u32x4*)(ds + voff[i]) = rv[i];
            }
            __syncthreads();
        }
        const int b = bh >> 3, hh = bh & 7;
#pragma unroll
        for (int t = 0; t < 2; ++t) {
            const float lt = l[t] + __shfl_xor(l[t], 32);
            const float inv = 1.f / lt;
            const size_t rl = (size_t)(b * SEQ + qb * 256 + w * 64 + t * 32 + r);
            bf16_t* op = p.A_mla + rl * 512 + hh * 64 + 4 * h;
            const bf16_t* zp = p.Pz + rl * PZ_W + hh * 64 + 4 * h;
#pragma unroll
            for (int g = 0; g < 4; ++g) {
                const f32x4 z0 = ld_bf4(zp + 8 * g), z1 = ld_bf4(zp + 32 + 8 * g);
                uint2 a, c;
                a.x = pack_bf2(o[t][0][4 * g + 0] * inv * silu_f(z0[0]), o[t][0][4 * g + 1] * inv * silu_f(z0[1]));
                a.y = pack_bf2(o[t][0][4 * g + 2] * inv * silu_f(z0[2]), o[t][0][4 * g + 3] * inv * silu_f(z0[3]));
                c.x = pack_bf2(o[t][1][4 * g + 0] * inv * silu_f(z1[0]), o[t][1][4 * g + 1] * inv * silu_f(z1[1]));
                c.y = pack_bf2(o[t][1][4 * g + 2] * inv * silu_f(z1[2]), o[t][1][4 * g + 3] * inv * silu_f(z1[3]));
                *(uint2*)(op + 8 * g) = a;
                *(uint2*)(op + 32 + 8 * g) = c;
            }
        }
    }
}

#define AT8_VROW 272
#define AT8_KBYTES (128 * ATT_KROW)
#define AT8_STAGE (AT8_KBYTES + 64 * AT8_VROW)
__device__ __forceinline__ void ph_attn8(const Params& p, char* smem, const int pb) {
    int tid = threadIdx.x;
    asm volatile("" : "+v"(tid));
    const int lane = tid & 63, w = tid >> 6, r = lane & 31, h = lane >> 5;
    const int bh = (pb >> 5) * 8 + (pb & 7), qb = (pb >> 3) & 3;
    bf16x8 qf[2][6];
#pragma unroll
    for (int t = 0; t < 2; ++t) {
        const bf16_t* Qp = p.Qb + ((size_t)bh * SEQ + qb * 512 + w * 64 + t * 32 + r) * 96 + h * 8;
#pragma unroll
        for (int s = 0; s < 6; ++s) qf[t][s] = *(const bf16x8*)(Qp + s * 16);
    }
    const bf16_t* Kg = p.Kb + (size_t)bh * TPB * 96 + tid * 8;
    const bf16_t* Vg = p.Vt + (size_t)bh * 64 * TPB + (size_t)(tid >> 4) * TPB + (tid & 15) * 8;
    int koff[3], voff[2];
#pragma unroll
    for (int i = 0; i < 3; ++i) { const int c = tid + 512 * i; koff[i] = (c / 12) * ATT_KROW + (c % 12) * 16; }
#pragma unroll
    for (int i = 0; i < 2; ++i) { const int c = tid + 512 * i; voff[i] = AT8_KBYTES + (c >> 4) * AT8_VROW + (c & 15) * 16; }
    u32x4 rk[3], rv[2];
#pragma unroll
    for (int i = 0; i < 3; ++i) rk[i] = *(const u32x4*)(Kg + i * 4096);
#pragma unroll
    for (int i = 0; i < 2; ++i) rv[i] = *(const u32x4*)(Vg + (size_t)(32 * i) * TPB);
#pragma unroll
    for (int i = 0; i < 3; ++i) *(u32x4*)(smem + koff[i]) = rk[i];
#pragma unroll
    for (int i = 0; i < 2; ++i) *(u32x4*)(smem + voff[i]) = rv[i];
    __syncthreads();
    f32x16 o[2][2];
#pragma unroll
    for (int t = 0; t < 2; ++t)
#pragma unroll
        for (int i = 0; i < 16; ++i) { o[t][0][i] = 0.f; o[t][1][i] = 0.f; }
    float l[2] = {0.f, 0.f};
    int NKT = TPB / 128;
    asm volatile("" : "+s"(NKT));
    for (int kt = 0; kt < NKT; ++kt) {
        if (kt + 1 < NKT) {
#pragma unroll
            for (int i = 0; i < 3; ++i) rk[i] = *(const u32x4*)(Kg + (size_t)(kt + 1) * 12288 + i * 4096);
#pragma unroll
            for (int i = 0; i < 2; ++i) rv[i] = *(const u32x4*)(Vg + (size_t)(32 * i) * TPB + (kt + 1) * 128);
        }
        const char* sk = smem + (kt & 1) * AT8_STAGE;
        const char* sv = sk + AT8_KBYTES;
        int NHF = 4;
        asm volatile("" : "+s"(NHF));
        for (int hf = 0; hf < NHF; ++hf) {
            const char* skh = sk + hf * 32 * ATT_KROW;
            const char* svh = sv + hf * 64;
            f32x16 s[2];
            {
                const f32x16 z16 = {0.f, 0.f, 0.f, 0.f, 0.f, 0.f, 0.f, 0.f, 0.f, 0.f, 0.f, 0.f, 0.f, 0.f, 0.f, 0.f};
                const bf16x8 k0 = *(const bf16x8*)(skh + r * ATT_KROW + h * 16);
                s[0] = __builtin_amdgcn_mfma_f32_32x32x16_bf16(k0, qf[0][0], z16, 0, 0, 0);
                s[1] = __builtin_amdgcn_mfma_f32_32x32x16_bf16(k0, qf[1][0], z16, 0, 0, 0);
            }
#pragma unroll
            for (int ss = 1; ss < 6; ++ss) {
                const bf16x8 k0 = *(const bf16x8*)(skh + r * ATT_KROW + (2 * ss + h) * 16);
                s[0] = __builtin_amdgcn_mfma_f32_32x32x16_bf16(k0, qf[0][ss], s[0], 0, 0, 0);
                s[1] = __builtin_amdgcn_mfma_f32_32x32x16_bf16(k0, qf[1][ss], s[1], 0, 0, 0);
            }
            bf16x8 pf[2][2];
#pragma unroll
            for (int t = 0; t < 2; ++t) {
                float ls = 0.f;
#pragma unroll
                for (int i = 0; i < 16; ++i) {
                    s[t][i] = __builtin_amdgcn_exp2f(s[t][i]);
                    ls += s[t][i];
                }
                l[t] += ls;
#pragma unroll
                for (int ks = 0; ks < 2; ++ks) {
                    u32x4 pw;
#pragma unroll
                    for (int e = 0; e < 4; ++e) pw[e] = pack_bf2(s[t][8 * ks + 2 * e], s[t][8 * ks + 2 * e + 1]);
                    pf[t][ks] = __builtin_bit_cast(bf16x8, pw);
                }
            }
#pragma unroll
            for (int ks = 0; ks < 2; ++ks) {
                const bf16x8 v0 = *(const bf16x8*)(svh + r * AT8_VROW + (2 * ks + h) * 16);
                const bf16x8 v1 = *(const bf16x8*)(svh + (32 + r) * AT8_VROW + (2 * ks + h) * 16);
#pragma unroll
                for (int t = 0; t < 2; ++t) {
                    o[t][0] = __builtin_amdgcn_mfma_f32_32x32x16_bf16(v0, pf[t][ks], o[t][0], 0, 0, 0);
                    o[t][1] = __builtin_amdgcn_mfma_f32_32x32x16_bf16(v1, pf[t][ks], o[t][1], 0, 0, 0);
                }
            }
        }
        if (kt + 1 < NKT) {
            char* ds = smem + ((kt + 1) & 1) * AT8_STAGE;
#pragma unroll
            for (int i = 0; i < 3; ++i) *(u32x4*)(ds + koff[i]) = rk[i];
#pragma unroll
            for (int i = 0; i < 2; ++i) *(u32x4*)(ds + voff[i]) = rv[i];
        }
        __syncthreads();
    }
    const int b = bh >> 3, hh = bh & 7;
#pragma unroll
    for (int t = 0; t < 2; ++t) {
        const float lt = l[t] + __shfl_xor(l[t], 32);
        const float inv = 1.f / lt;
        const size_t rl = (size_t)(b * SEQ + qb * 512 + w * 64 + t * 32 + r);
        bf16_t* op = p.A_mla + rl * 512 + hh * 64 + 4 * h;
        const bf16_t* zp = p.Pz + rl * PZ_W + hh * 64 + 4 * h;
#pragma unroll
        for (int g = 0; g < 4; ++g) {
            const f32x4 z0 = ld_bf4(zp + 8 * g), z1 = ld_bf4(zp + 32 + 8 * g);
            uint2 a, c;
            a.x = pack_bf2(o[t][0][4 * g + 0] * inv * silu_f(z0[0]), o[t][0][4 * g + 1] * inv * silu_f(z0[1]));
            a.y = pack_bf2(o[t][0][4 * g + 2] * inv * silu_f(z0[2]), o[t][0][4 * g + 3] * inv * silu_f(z0[3]));
            c.x = pack_bf2(o[t][1][4 * g + 0] * inv * silu_f(z1[0]), o[t][1][4 * g + 1] * inv * silu_f(z1[1]));
            c.y = pack_bf2(o[t][1][4 * g + 2] * inv * silu_f(z1[2]), o[t][1][4 * g + 3] * inv * silu_f(z1[3]));
            *(uint2*)(op + 8 * g) = a;
            *(uint2*)(op + 32 + 8 * g) = c;
        }
    }
}

__device__ __forceinline__ void ph_attn(const Params& p, int bid, int nb, char* smem, char* smem_all, int pb) {
    const int lane = VTID & 63;
    float mq = fmaxf(fabsf(p.qhn_w[lane]), (lane < 32) ? fabsf(p.qhn_w[64 + lane]) : 0.f);
    float mk = fmaxf(fabsf(p.khn_w[lane]), (lane < 32) ? fabsf(p.khn_w[64 + lane]) : 0.f);
#pragma unroll
    for (int o = 32; o > 0; o >>= 1) { mq = fmaxf(mq, __shfl_xor(mq, o)); mk = fmaxf(mk, __shfl_xor(mk, o)); }
    const float B = (9.797958971f * 1.4426950408889634f * 1.0001f) * mq * mk;
    if (B <= 40.f) ph_attn8(p, smem_all, pb);
    else ph_attn_t<false>(p, bid, nb, smem, -B);
}

__device__ __forceinline__ int el_off(int row, int col) { return lds_off(row, col >> 3) + (col & 7) * 2; }

__device__ __forceinline__ void mm64(f32x4 (&acc)[4], const char* A, int arow0, const char* B, int l15, int lq) {
#pragma unroll
    for (int ks = 0; ks < 2; ++ks) {
        const bf16x8 a = *(const bf16x8*)(A + lds_off(arow0 + l15, ks * 4 + lq));
#pragma unroll
        for (int nt = 0; nt < 4; ++nt) {
            const bf16x8 b = *(const bf16x8*)(B + lds_off(nt * 16 + l15, ks * 4 + lq));
            acc[nt] = __builtin_amdgcn_mfma_f32_16x16x32_bf16(a, b, acc[nt], 0, 0, 0);
        }
    }
}
__device__ __forceinline__ void acc4_zero(f32x4 (&a)[4]) {
#pragma unroll
    for (int i = 0; i < 4; ++i) a[i] = (f32x4){0.f, 0.f, 0.f, 0.f};
}

#define DN_SQ 0
#define DN_SK 8192
#define DN_SV 16384
#define DN_LSTR 65
#define DN_LBYTES (64 * DN_LSTR * 4)
#define DN_SL 24576
#define DN_SA 57856
#define DN_SKD 66048
#define DN_SS 74240

typedef short s16x4 __attribute__((ext_vector_type(4)));
__device__ __forceinline__ s16x4 ds_tr(const char* p) { return __builtin_amdgcn_ds_read_tr16_b64_v4i16((LAS s16x4*)p); }

struct Dn1In { u32x4 rp[7]; float db, da, dtb, alog; float cw[4]; };
__device__ __forceinline__ void dn1_fetch(Dn1In& in, const Params& p, int u, int tid) {
    const int bh = u / 36, pb = u % 36, b = bh >> 3, h = bh & 7;
    int rowbase, seglen, lb;
    if (pb < 4) { rowbase = b * CTXL; seglen = CTXL; lb = pb; }
    else { rowbase = NCTX + b * SEQ; seglen = SEQ; lb = pb - 4; }
#pragma unroll
    for (int i = 0; i < 7; ++i) {
        const int c = tid + NTHR * i;
        const int g = c / 544, rem = c % 544, rr = rem >> 3, ch = rem & 7;
        const int lp = lb * 64 - 2 + rr;
        u32x4 val = (u32x4){0u, 0u, 0u, 0u};
        if (c < 3 * 68 * 8 && lp >= 0 && lp < seglen) val = *(const u32x4*)(p.Pa + (size_t)(rowbase + lp) * PA_W + PA_DQ + h * 192 + g * 64 + ch * 8);
        in.rp[i] = val;
    }
#pragma unroll
    for (int i = 0; i < 4; ++i) {
        const int idx = tid + NTHR * i, g = idx / 320, j = (idx % 320) >> 6, c = idx & 63;
        in.cw[i] = (idx < 960) ? p.conv_w[j * 1536 + g * 512 + h * 64 + c] : 0.f;
    }
    in.db = 0.f; in.da = 0.f; in.dtb = 0.f; in.alog = 0.f;
    if (tid < 128) {
        in.dtb = p.dt_bias[(tid >> 6) * 8 + h]; in.alog = p.a_log[(tid >> 6) * 8 + h];
        const int d = tid >> 6, tp = tid & 63;
        const int pos = d ? 63 - tp : tp;
        const bf16_t* row = p.Pa + (size_t)(rowbase + lb * 64 + pos) * PA_W;
        in.db = bf2f(row[PA_DB + d * 8 + h]);
        in.da = bf2f(row[PA_DA + d * 8 + h]);
    }
}

__device__ __forceinline__ void ph_dn1(const Params& p, int bid, int nb, char* smem) {
    char* sQ = smem + DN_SQ; char* sK = smem + DN_SK; char* sV = smem + DN_SV;
    char* sL = smem + DN_SL; char* sA = smem + DN_SA; char* sKd = smem + DN_SKD;
    float* sS = (float*)(smem + DN_SS);
    const int x_ = bid & 7, li_ = bid >> 3, per_ = nb >> 3;
#define DN1_UNIT(IT, U, VALID) do { const int q_ = li_ + (IT) * per_; const int grp_ = x_ + 8 * (q_ >> 3); VALID = (grp_ < 8 * 36); \
        const int b_ = grp_ / 36, pb_ = grp_ % 36; U = (b_ * 8 + (q_ & 7)) * 36 + pb_; } while (0)
    Dn1In in;
    int u, un; bool valid, validn;
    DN1_UNIT(0, u, valid);
    if (valid) dn1_fetch(in, p, u, VTID);
    for (int it = 0; valid; ++it, u = un, valid = validn) {
        DN1_UNIT(it + 1, un, validn);
        int tid = VTID;
        asm volatile("" : "+v"(tid));
        const int lane = tid & 63, w = tid >> 6, l15 = lane & 15, lq = lane >> 4;
        const int bh = u / 36, pb = u % 36, h = bh & 7;
        const bool lat = (pb >= 4);
        if (tid < 128) {
            const int d = tid >> 6, tp = lane;
            const float xx = in.da + in.dtb;
            const float sp = (xx > 20.f) ? xx : log1pf(__expf(xx));
            const float g = -__expf(in.alog) * sp;
            float gc = g;
#pragma unroll
            for (int o = 1; o < 64; o <<= 1) { const float t = __shfl_up(gc, o); if (lane >= o) gc += t; }
            const float gl = __shfl(gc, 63);
            const float bt = sigmoid_f(in.db), eg = __expf(gc);
            sS[(d * 5 + 0) * 64 + tp] = bt;
            sS[(d * 5 + 1) * 64 + tp] = gc;
            sS[(d * 5 + 2) * 64 + tp] = eg;
            sS[(d * 5 + 3) * 64 + tp] = __expf(gl - gc);
            sS[(d * 5 + 4) * 64 + tp] = bt * eg;
        }
        {
            char* raw = sL;
#pragma unroll
            for (int i = 0; i < 7; ++i) {
                const int c = tid + NTHR * i;
                const int g = c / 544, rem = c % 544, rr = rem >> 3, ch = rem & 7;
                if (c < 3 * 68 * 8) *(u32x4*)(raw + (g * 68 + rr) * 128 + ch * 16) = in.rp[i];
            }
            float* cwS = (float*)(sL + 26112);
#pragma unroll
            for (int i = 0; i < 4; ++i) { const int idx = tid + NTHR * i; if (idx < 960) cwS[idx] = in.cw[i]; }
            if (validn) dn1_fetch(in, p, un, tid);
            __syncthreads();
            const int o = tid & 7, r0 = tid >> 3;
#pragma unroll
            for (int g = 0; g < 3; ++g) {
                if (g == 0 && !lat) continue;
                float wj[5][8];
#pragma unroll
                for (int j = 0; j < 5; ++j) {
                    const f32x4 w0 = *(const f32x4*)(cwS + (g * 5 + j) * 64 + 8 * o), w1 = *(const f32x4*)(cwS + (g * 5 + j) * 64 + 8 * o + 4);
#pragma unroll
                    for (int e2 = 0; e2 < 4; ++e2) { wj[j][e2] = w0[e2]; wj[j][4 + e2] = w1[e2]; }
                }
#pragma unroll
                for (int hh = 0; hh < 2; ++hh) {
                    const int rr = r0 + 32 * hh;
                    float a[8];
#pragma unroll
                    for (int e2 = 0; e2 < 8; ++e2) a[e2] = 0.f;
#pragma unroll
                    for (int j = 0; j < 5; ++j) {
                        const u32x4 dv = *(const u32x4*)(raw + (g * 68 + rr + j) * 128 + o * 16);
#pragma unroll
                        for (int e2 = 0; e2 < 4; ++e2) {
                            a[2 * e2] += __uint_as_float(dv[e2] << 16) * wj[j][2 * e2];
                            a[2 * e2 + 1] += __uint_as_float(dv[e2] & 0xffff0000u) * wj[j][2 * e2 + 1];
                        }
                    }
                    float ss = 0.f;
#pragma unroll
                    for (int e2 = 0; e2 < 8; ++e2) { a[e2] = silu_f(a[e2]); ss += a[e2] * a[e2]; }
                    float sc = 1.f;
                    if (g < 2) {
                        ss += dpp_mov<0xB1>(ss); ss += dpp_mov<0x4E>(ss); ss += dpp_mov<0x141>(ss);
                        sc = rsqrtf(ss + EPSF) * (g == 0 ? 0.125f : 1.f);
                    }
                    u32x4 ov;
#pragma unroll
                    for (int e2 = 0; e2 < 4; ++e2) ov[e2] = pack_bf2(a[2 * e2] * sc, a[2 * e2 + 1] * sc);
                    *(u32x4*)((g == 0 ? sQ : g == 1 ? sK : sV) + lds_off(rr, o)) = ov;
                }
            }
            __syncthreads();
        }
        {
            f32x4 G[4];
            acc4_zero(G);
            mm64(G, sK, 16 * w, sK, l15, lq);
            float* L0 = (float*)sL; float* L1 = (float*)(sL + DN_LBYTES);
            const float* be0 = sS + 0 * 64; const float* gc0 = sS + 1 * 64;
            const float* be1 = sS + 5 * 64; const float* gc1 = sS + 6 * 64;
#pragma unroll
            for (int nt = 0; nt < 4; ++nt)
#pragma unroll
                for (int rg = 0; rg < 4; ++rg) {
                    const int t = 16 * w + 4 * lq + rg, s = 16 * nt + l15;
                    const float gv = G[nt][rg];
                    const int tp = 63 - t, sp = 63 - s;
                    L0[t * DN_LSTR + s] = (s < t) ? be0[t] * gv * __expf(gc0[t] - gc0[s]) : 0.f;
                    L1[tp * DN_LSTR + sp] = (s > t) ? be1[tp] * gv * __expf(gc1[tp] - gc1[sp]) : 0.f;
                }
            __syncthreads();
        }
        {
            int tid3 = tid;
            asm volatile("" : "+v"(tid3) :: "memory");
            const int lane3 = tid3 & 63, w3 = tid3 >> 6, l15c = lane3 & 15, lqc = lane3 >> 4;
            if (tid3 < 128) {
                float* Lb = (float*)(sL + w3 * DN_LBYTES) + (16 * lqc) * DN_LSTR + 16 * lqc;
                float x[16];
#pragma unroll
                for (int i = 0; i < 16; ++i) {
                    float v = (i == l15c) ? 1.f : 0.f;
#pragma unroll
                    for (int j = 0; j < i; ++j) v -= Lb[i * DN_LSTR + j] * x[j];
                    x[i] = v;
                }
#pragma unroll
                for (int i = 0; i < 16; ++i) Lb[i * DN_LSTR + l15c] = x[i];
            }
            __syncthreads();
            {
                const int d = w3 >> 1, pr = w3 & 1, b0 = 2 * pr, b1 = 2 * pr + 1;
                float* Ld = (float*)(sL + d * DN_LBYTES);
                float* scr = (float*)(sA) + w3 * 272;
                f32x4 P = (f32x4){0.f, 0.f, 0.f, 0.f};
#pragma unroll
                for (int kk = 0; kk < 4; ++kk)
                    P = __builtin_amdgcn_mfma_f32_16x16x4f32(Ld[(16 * b1 + l15c) * DN_LSTR + 16 * b0 + 4 * kk + lqc],
                                                            Ld[(16 * b0 + 4 * kk + lqc) * DN_LSTR + 16 * b0 + l15c], P, 0, 0, 0);
#pragma unroll
                for (int rg = 0; rg < 4; ++rg) scr[(4 * lqc + rg) * 17 + l15c] = P[rg];
                f32x4 R = (f32x4){0.f, 0.f, 0.f, 0.f};
#pragma unroll
                for (int kk = 0; kk < 4; ++kk)
                    R = __builtin_amdgcn_mfma_f32_16x16x4f32(Ld[(16 * b1 + l15c) * DN_LSTR + 16 * b1 + 4 * kk + lqc],
                                                            scr[(4 * kk + lqc) * 17 + l15c], R, 0, 0, 0);
#pragma unroll
                for (int rg = 0; rg < 4; ++rg) Ld[(16 * b1 + 4 * lqc + rg) * DN_LSTR + 16 * b0 + l15c] = -R[rg];
            }
            __syncthreads();
            {
                const int d = w3 >> 1, hf = w3 & 1;
                float* Ld = (float*)(sL + d * DN_LBYTES);
                float* scr2 = (float*)(d ? sKd : sA);
                f32x4 P2[2];
                P2[0] = (f32x4){0.f, 0.f, 0.f, 0.f}; P2[1] = (f32x4){0.f, 0.f, 0.f, 0.f};
#pragma unroll
                for (int kk = 0; kk < 8; ++kk) {
                    const float a = Ld[(32 + 16 * hf + l15c) * DN_LSTR + 4 * kk + lqc];
#pragma unroll
                    for (int n2 = 0; n2 < 2; ++n2)
                        P2[n2] = __builtin_amdgcn_mfma_f32_16x16x4f32(a, Ld[(4 * kk + lqc) * DN_LSTR + 16 * n2 + l15c], P2[n2], 0, 0, 0);
                }
#pragma unroll
                for (int n2 = 0; n2 < 2; ++n2)
#pragma unroll
                    for (int rg = 0; rg < 4; ++rg) scr2[(16 * hf + 4 * lqc + rg) * 33 + 16 * n2 + l15c] = P2[n2][rg];
                __syncthreads();
                f32x4 R2[2];
                R2[0] = (f32x4){0.f, 0.f, 0.f, 0.f}; R2[1] = (f32x4){0.f, 0.f, 0.f, 0.f};
#pragma unroll
                for (int kk = 0; kk < 8; ++kk) {
                    const float a = Ld[(32 + 16 * hf + l15c) * DN_LSTR + 32 + 4 * kk + lqc];
#pragma unroll
                    for (int n2 = 0; n2 < 2; ++n2)
                        R2[n2] = __builtin_amdgcn_mfma_f32_16x16x4f32(a, scr2[(4 * kk + lqc) * 33 + 16 * n2 + l15c], R2[n2], 0, 0, 0);
                }
#pragma unroll
                for (int n2 = 0; n2 < 2; ++n2)
#pragma unroll
                    for (int rg = 0; rg < 4; ++rg) Ld[(32 + 16 * hf + 4 * lqc + rg) * DN_LSTR + 16 * n2 + l15c] = -R2[n2][rg];
            }
            __syncthreads();
#pragma unroll 1
            for (int d = 0; d < 2; ++d) {
                const float* Td = (const float*)(sL + d * DN_LBYTES);
                {
                    const int tr = tid3 >> 2, cq = tid3 & 3;
                    const float* c1 = sS + (d * 5 + 0) * 64 + 16 * cq;
                    const float* c2 = sS + (d * 5 + 4) * 64 + 16 * cq;
                    const float* trow = Td + tr * DN_LSTR + 16 * cq;
                    float tv[16];
#pragma unroll
                    for (int e2 = 0; e2 < 16; ++e2) tv[e2] = trow[e2];
#pragma unroll
                    for (int q = 0; q < 2; ++q) {
                        u32x4 o1, o2;
#pragma unroll
                        for (int e2 = 0; e2 < 4; ++e2) {
                            const int i0 = 8 * q + 2 * e2;
                            o1[e2] = pack_bf2(tv[i0] * c1[i0], tv[i0 + 1] * c1[i0 + 1]);
                            o2[e2] = pack_bf2(tv[i0] * c2[i0], tv[i0 + 1] * c2[i0 + 1]);
                        }
                        *(u32x4*)(sA + lds_off(tr, 2 * cq + q)) = o1;
                        *(u32x4*)(sKd + lds_off(tr, 2 * cq + q)) = o2;
                    }
                }
                __syncthreads();
                f32x4 U[4], W[4];
                acc4_zero(U); acc4_zero(W);
                {
#pragma unroll
                    for (int ks = 0; ks < 2; ++ks) {
                        const bf16x8 a1 = *(const bf16x8*)(sA + lds_off(16 * w3 + l15c, ks * 4 + lqc));
                        const bf16x8 a2 = *(const bf16x8*)(sKd + lds_off(16 * w3 + l15c, ks * 4 + lqc));
                        const int r0 = 32 * ks + 8 * lqc + (l15c >> 2);
                        const int p0 = d ? 63 - r0 : r0, p1 = d ? 63 - (r0 + 4) : (r0 + 4);
#pragma unroll
                        for (int nt = 0; nt < 4; ++nt) {
                            const int col = 16 * nt + 4 * (l15c & 3);
                            const s16x4 v0 = ds_tr(sV + el_off(p0, col)), v1 = ds_tr(sV + el_off(p1, col));
                            const s16x4 k0 = ds_tr(sK + el_off(p0, col)), k1 = ds_tr(sK + el_off(p1, col));
                            U[nt] = __builtin_amdgcn_mfma_f32_16x16x32_bf16(a1, __builtin_shufflevector(v0, v1, 0, 1, 2, 3, 4, 5, 6, 7), U[nt], 0, 0, 0);
                            W[nt] = __builtin_amdgcn_mfma_f32_16x16x32_bf16(a2, __builtin_shufflevector(k0, k1, 0, 1, 2, 3, 4, 5, 6, 7), W[nt], 0, 0, 0);
                        }
                    }
                }
                __syncthreads();
                {
                    char* uT = sL + d * DN_LBYTES;
                    char* wT = uT + 8192;
                    const int t0 = 16 * w3 + 4 * lqc;
#pragma unroll
                    for (int nt = 0; nt < 4; ++nt) {
                        uint2 ou, ow;
                        ou.x = pack_bf2(U[nt][0], U[nt][1]); ou.y = pack_bf2(U[nt][2], U[nt][3]);
                        ow.x = pack_bf2(W[nt][0], W[nt][1]); ow.y = pack_bf2(W[nt][2], W[nt][3]);
                        *(uint2*)(uT + el_off(16 * nt + l15c, t0)) = ou;
                        *(uint2*)(wT + el_off(16 * nt + l15c, t0)) = ow;
                    }
                }
                __syncthreads();
            }
        }
        int tid5 = tid;
        asm volatile("" : "+v"(tid5) :: "memory");
        const int lane5 = tid5 & 63, w5 = tid5 >> 6, l15_5 = lane5 & 15, lq5 = lane5 >> 4;
        f32x4 QK[4];
        acc4_zero(QK);
        mm64(QK, sQ, 16 * w5, sK, l15_5, lq5);
#pragma unroll 1
        for (int d = 0; d < 2; ++d) {
            const float* gcd = sS + (d * 5 + 1) * 64;
            const float* egd = sS + (d * 5 + 2) * 64;
            const float* ekd = sS + (d * 5 + 3) * 64;
            {
                const int i = lane5, tq = w5;
                float kv[16];
#pragma unroll
                for (int e = 0; e < 16; ++e) {
                    const int tp = tq * 16 + e, pos = d ? 63 - tp : tp;
                    kv[e] = bf2f(*(const bf16_t*)(sK + el_off(pos, i))) * ekd[tp];
                }
#pragma unroll
                for (int q = 0; q < 2; ++q) {
                    u32x4 o;
                    o[0] = pack_bf2(kv[8 * q + 0], kv[8 * q + 1]); o[1] = pack_bf2(kv[8 * q + 2], kv[8 * q + 3]);
                    o[2] = pack_bf2(kv[8 * q + 4], kv[8 * q + 5]); o[3] = pack_bf2(kv[8 * q + 6], kv[8 * q + 7]);
                    *(u32x4*)(sKd + lds_off(i, 2 * tq + q)) = o;
                }
            }
#pragma unroll
            for (int nt = 0; nt < 4; ++nt)
#pragma unroll
                for (int rg = 0; rg < 4; ++rg) {
                    const int t = 16 * w5 + 4 * lq5 + rg, s = 16 * nt + l15_5;
                    const int tp = d ? 63 - t : t, sp = d ? 63 - s : s;
                    const float val = (sp <= tp) ? QK[nt][rg] * __expf(gcd[tp] - gcd[sp]) : 0.f;
                    *(bf16_t*)(sA + el_off(tp, sp)) = f2bf(val);
                }
            __syncthreads();
            const char* uT = sL + d * DN_LBYTES;
            const char* wT = uT + 8192;
            const int cd = (d == 0) ? pb : (pb < 4 ? 3 - pb : 39 - pb);
            bf16_t* Mg = p.MH + ((size_t)((bh * 2 + d) * 36 + cd) * 2) * 4096;
            bf16_t* Hg = Mg + 4096;
            {
                f32x4 MT[4];
                acc4_zero(MT);
                mm64(MT, wT, 16 * w5, sKd, l15_5, lq5);
                const float egl = egd[63];
                const int j0 = 16 * w5 + 4 * lq5;
#pragma unroll
                for (int nt = 0; nt < 4; ++nt) {
                    const int i = 16 * nt + l15_5;
                    f32x4 o;
#pragma unroll
                    for (int e = 0; e < 4; ++e) o[e] = ((i == j0 + e) ? egl : 0.f) - MT[nt][e];
                    st_bf4(Mg + i * 64 + j0, o);
                }
            }
            {
                f32x4 HH[4];
                acc4_zero(HH);
                mm64(HH, sKd, 16 * w5, uT, l15_5, lq5);
                const int i0 = 16 * w5 + 4 * lq5;
#pragma unroll
                for (int nt = 0; nt < 4; ++nt) st_bf4(Hg + (16 * nt + l15_5) * 64 + i0, HH[nt]);
            }
            if (lat) {
                bf16_t* Eg = p.EF + ((size_t)((bh * 2 + d) * 32 + (pb - 4)) * 2) * 4096;
                bf16_t* Fg = Eg + 4096;
                {
                    f32x4 ET[4];
                    acc4_zero(ET);
                    mm64(ET, wT, 16 * w5, sA, l15_5, lq5);
                    const int j0 = 16 * w5 + 4 * lq5;
#pragma unroll
                    for (int nt = 0; nt < 4; ++nt) {
                        const int sp = 16 * nt + l15_5, spos = d ? 63 - sp : sp;
                        const f32x4 qv = ld_bf4((const bf16_t*)(sQ + el_off(spos, j0)));
                        const float eg = egd[sp];
                        f32x4 o;
#pragma unroll
                        for (int e = 0; e < 4; ++e) o[e] = qv[e] * eg - ET[nt][e];
                        st_bf4(Eg + spos * 64 + j0, o);
                    }
                }
                {
                    f32x4 FF[4];
                    acc4_zero(FF);
                    mm64(FF, uT, 16 * w5, sA, l15_5, lq5);
                    const int c0 = 16 * w5 + 4 * lq5;
#pragma unroll
                    for (int nt = 0; nt < 4; ++nt) {
                        const int sp = 16 * nt + l15_5, spos = d ? 63 - sp : sp;
                        st_bf4(Fg + spos * 64 + c0, FF[nt]);
                    }
                }
            }
            __syncthreads();
        }
    }
}

struct Dn2Frag { bf16x8 am[2]; uint2 hr; };
__device__ __forceinline__ void dn2_load(Dn2Frag& f, const bf16_t* Mg, int w, int l15, int lq, int i0, int hf, int n2) {
#pragma unroll
    for (int ks = 0; ks < 2; ++ks) f.am[ks] = *(const bf16x8*)(Mg + (16 * w + l15) * 64 + ks * 32 + lq * 8);
    f.hr = *(const uint2*)(Mg + 4096 + (32 * hf + 16 * n2 + l15) * 64 + i0);
}
__device__ __forceinline__ void dn2_step(const Dn2Frag& f, int c, int d, int hf, int n2, bf16_t* STc, char* smem, int l15, int lq, int i0) {
    const char* sS = smem + (c & 1) * 4096;
    char* sN = smem + ((c + 1) & 1) * 4096;
    f32x4 acc = (f32x4){__uint_as_float(f.hr.x << 16), __uint_as_float(f.hr.x & 0xffff0000u), __uint_as_float(f.hr.y << 16), __uint_as_float(f.hr.y & 0xffff0000u)};
#pragma unroll
    for (int ks = 0; ks < 2; ++ks) {
        const bf16x8 bs = *(const bf16x8*)(sS + lds_off(16 * n2 + l15, ks * 4 + lq));
        acc = __builtin_amdgcn_mfma_f32_16x16x32_bf16(f.am[ks], bs, acc, 0, 0, 0);
    }
    const int cn = c + 1;
    const bool st = (cn >= 4 && cn <= 35);
    const int pbi = (d == 0 ? cn : 39 - cn) - 4;
    uint2 o; o.x = pack_bf2(acc[0], acc[1]); o.y = pack_bf2(acc[2], acc[3]);
    const int cl = 16 * n2 + l15;
    *(uint2*)(sN + el_off(cl, i0)) = o;
    if (st) *(uint2*)(STc + (size_t)pbi * 4096 + (32 * hf + cl) * 64 + i0) = o;
    __syncthreads();
}
__device__ __forceinline__ void ph_dn2(const Params& p, char* smem, const int pb) {
    const int tid = threadIdx.x, lane = tid & 63, w8 = tid >> 6, w = w8 & 3, n2 = w8 >> 2, l15 = lane & 15, lq = lane >> 4;
    const int x = pb & 7, j = pb >> 3;
    const int chain = (j >> 1) * 8 + x, hf = j & 1, d = chain & 1;
    const bf16_t* MHc = p.MH + (size_t)chain * 36 * 2 * 4096;
    bf16_t* STc = p.ST + (size_t)chain * 32 * 4096;
    if (tid < 256) *(u32x4*)(smem + tid * 16) = (u32x4){0u, 0u, 0u, 0u};
    __syncthreads();
    const int i0 = 16 * w + 4 * lq;
    Dn2Frag f0, f1, f2, f3;
    dn2_load(f0, MHc + (size_t)0 * 8192, w, l15, lq, i0, hf, n2);
    dn2_load(f1, MHc + (size_t)1 * 8192, w, l15, lq, i0, hf, n2);
    dn2_load(f2, MHc + (size_t)2 * 8192, w, l15, lq, i0, hf, n2);
    dn2_load(f3, MHc + (size_t)3 * 8192, w, l15, lq, i0, hf, n2);
    for (int c0 = 0; c0 < 36; c0 += 4) {
        const bool more = (c0 + 4 < 36);
        dn2_step(f0, c0 + 0, d, hf, n2, STc, smem, l15, lq, i0);
        if (more) dn2_load(f0, MHc + (size_t)(c0 + 4) * 8192, w, l15, lq, i0, hf, n2);
        dn2_step(f1, c0 + 1, d, hf, n2, STc, smem, l15, lq, i0);
        if (more) dn2_load(f1, MHc + (size_t)(c0 + 5) * 8192, w, l15, lq, i0, hf, n2);
        dn2_step(f2, c0 + 2, d, hf, n2, STc, smem, l15, lq, i0);
        if (more) dn2_load(f2, MHc + (size_t)(c0 + 6) * 8192, w, l15, lq, i0, hf, n2);
        dn2_step(f3, c0 + 3, d, hf, n2, STc, smem, l15, lq, i0);
        if (more) dn2_load(f3, MHc + (size_t)(c0 + 7) * 8192, w, l15, lq, i0, hf, n2);
    }
}

__device__ __forceinline__ void ph_dn3(const Params& p, int bid, int nb, char* smem) {
    const int tid = VTID, lane = tid & 63, w = tid >> 6, l15 = lane & 15, lq = lane >> 4;
    const int srow = tid >> 3, sch = (tid & 7) ^ ((srow >> 1) & 7);
    LAS char* lbase = (LAS char*)smem + w * 1024;
#define DN3_STAGE(BUF, U_) do { const int bh_ = (U_) >> 5, pbi_ = (U_) & 31; \
        _Pragma("unroll") for (int d_ = 0; d_ < 2; ++d_) { \
            const bf16_t* Sg_ = p.ST + ((size_t)(bh_ * 2 + d_) * 32 + pbi_) * 4096 + (size_t)srow * 64 + sch * 8; \
            _Pragma("unroll") for (int i_ = 0; i_ < 2; ++i_) \
                __builtin_amdgcn_global_load_lds((const void*)(Sg_ + (size_t)(32 * i_) * 64), (LAS void*)(lbase + (BUF) * 16384 + d_ * 8192 + i_ * 4096), 16, 0, 0); } } while (0)
    int u = bid, buf = 0;
    if (u < 64 * 32) DN3_STAGE(0, u);
    for (; u < 64 * 32; u += nb, buf ^= 1) {
        const int bh = u >> 5, pbi = u & 31, b = bh >> 3, h = bh & 7;
        const int s = 16 * w + l15;
        const size_t rl = (size_t)b * SEQ + pbi * 64 + s;
        f32x4 zdv[4];
#pragma unroll
        for (int mt = 0; mt < 4; ++mt) zdv[mt] = ld_bf4(p.Pz + rl * PZ_W + 512 + h * 64 + 16 * mt + 4 * lq);
        f32x4 acc[4];
        acc4_zero(acc);
        bf16x8 be[2][2];
#pragma unroll
        for (int d = 0; d < 2; ++d) {
            const bf16_t* Eg = p.EF + ((size_t)((bh * 2 + d) * 32 + pbi) * 2) * 4096;
            const bf16_t* Fg = Eg + 4096;
#pragma unroll
            for (int mt = 0; mt < 4; ++mt) acc[mt] += ld_bf4(Fg + s * 64 + 16 * mt + 4 * lq);
#pragma unroll
            for (int ks = 0; ks < 2; ++ks) be[d][ks] = *(const bf16x8*)(Eg + s * 64 + ks * 32 + lq * 8);
        }
        __syncthreads();
        if (u + nb < 64 * 32) DN3_STAGE(buf ^ 1, u + nb);
#pragma unroll
        for (int d = 0; d < 2; ++d) {
            const char* sS = smem + buf * 16384 + d * 8192;
#pragma unroll
            for (int ks = 0; ks < 2; ++ks)
#pragma unroll
                for (int mt = 0; mt < 4; ++mt) {
                    const bf16x8 as = *(const bf16x8*)(sS + lds_off(16 * mt + l15, ks * 4 + lq));
                    acc[mt] = __builtin_amdgcn_mfma_f32_16x16x32_bf16(as, be[d][ks], acc[mt], 0, 0, 0);
                }
        }
        float ss = 0.f;
#pragma unroll
        for (int mt = 0; mt < 4; ++mt)
#pragma unroll
            for (int rg = 0; rg < 4; ++rg) ss += acc[mt][rg] * acc[mt][rg];
        ss = xrow_sum(ss);
        const float rstd = rsqrtf(ss * (1.f / 64.f) + EPSF);
#pragma unroll
        for (int mt = 0; mt < 4; ++mt) {
            const f32x4 nw = *(const f32x4*)(p.dn_norm_w + 16 * mt + 4 * lq);
            f32x4 o;
#pragma unroll
            for (int rg = 0; rg < 4; ++rg) o[rg] = acc[mt][rg] * rstd * nw[rg] * silu_f(zdv[mt][rg]);
            st_bf4(p.A_dn + rl * 512 + h * 64 + 16 * mt + 4 * lq, o);
        }
    }
#undef DN3_STAGE
    __syncthreads();
}

namespace g8 {
constexpr int BM = 256, BK = 64, HALF = 128, HTB = HALF * BK * 2, STAGE_BYTES = 8 * HTB;
__device__ __forceinline__ int lds_byte(int r, int c) { const int st = (r >> 4) * 2 + (c >> 5), rr = r & 15, cc = c & 31, ob = rr * 64 + cc * 2; return st * 1024 + (ob ^ (((ob >> 9) & 1) << 5)); }
__device__ __forceinline__ void stage_rc(int b, int& R, int& C) { const int st = b / 1024, sb = b % 1024, swz = sb ^ (((sb >> 9) & 1) << 5); R = (st >> 1) * 16 + swz / 64; C = (st & 1) * 32 + (swz % 64) / 2; }
__device__ __forceinline__ int perm32(int rho) { const int n = rho >> 4, i = rho & 15; return 8 * (i >> 2) + 4 * n + (i & 3); }
struct Unit { int pm, pn, sel; };
typedef f32x4 Acc[2][2][4][2];

template <class Epi, class Sched>
__device__ __forceinline__ void gemm_phase(LAS unsigned char* lds, const bf16_t* A, const bf16_t* A1, int lda, const bf16_t* Bt, int K, const Sched& S, const Epi& E) {
    int tid = threadIdx.x;
    asm volatile("" : "+v"(tid));
    const int wid = __builtin_amdgcn_readfirstlane(tid >> 6), lane = tid & 63, wr = wid >> 2, wc = wid & 3, fr = lane & 15, fq = lane >> 4;
    const int nt = K / BK;
    unsigned voffA[2], voffB[2];
#pragma unroll
    for (int i = 0; i < 2; ++i) { int R, C; stage_rc(tid * 16 + i * 8192, R, C); const int Rb = Epi::PERM ? ((R & ~31) + perm32(R & 31)) : R;
        voffA[i] = (unsigned)(R * lda + C) * 2u; voffB[i] = (unsigned)(Rb * K + C) * 2u; }
    const size_t kstep = (size_t)(BK * 2);
    const size_t hstepA = (size_t)HALF * lda * 2, hstepB = (size_t)HALF * K * 2;
    const size_t tstepA = 2 * hstepA, tstepB = 2 * hstepB;
    const unsigned ldsw = (unsigned)wid * 1024u;
    const int aoff = lds_byte(wr * 64 + fr, fq * 8), boff = lds_byte(wc * 32 + fr, fq * 8);
#define G8_SA(b, h) (((b) * 2 + (h)) * HTB)
#define G8_SB(b, h) ((4 + (b) * 2 + (h)) * HTB)
#define G8_STAGE(bufoff, gbase, voff) do { _Pragma("unroll") for (int _i = 0; _i < 2; ++_i) \
        __builtin_amdgcn_global_load_lds((const unsigned*)((const char*)(gbase) + (voff)[_i]), (LAS unsigned*)(lds + (bufoff) + ldsw + _i * 8192), 16, 0, 0); } while (0)
#define G8_LDA(dst, b, h) do { _Pragma("unroll") for (int m = 0; m < 4; ++m) _Pragma("unroll") for (int k = 0; k < 2; ++k) dst[m][k] = *(const LAS bf16x8*)(lds + G8_SA(b, h) + aoff + m * 2048 + k * 1024); } while (0)
#define G8_LDB(dst, b, h) do { _Pragma("unroll") for (int n = 0; n < 2; ++n) _Pragma("unroll") for (int k = 0; k < 2; ++k) dst[n][k] = *(const LAS bf16x8*)(lds + G8_SB(b, h) + boff + n * 2048 + k * 1024); } while (0)
#define G8_MMA(ai, bj, At, Bt_) do { __builtin_amdgcn_s_setprio(1); _Pragma("unroll") for (int m = 0; m < 4; ++m) _Pragma("unroll") for (int n = 0; n < 2; ++n) _Pragma("unroll") for (int k = 0; k < 2; ++k) \
        acc[ai][bj][m][n] = __builtin_amdgcn_mfma_f32_16x16x32_bf16(Bt_[n][k], At[m][k], acc[ai][bj][m][n], 0, 0, 0); __builtin_amdgcn_s_setprio(0); } while (0)
#define G8_WAIT_V(n) asm volatile("s_waitcnt vmcnt(" #n ")" ::: "memory")
#define G8_WAIT_L(n) asm volatile("s_waitcnt lgkmcnt(" #n ")" ::: "memory")
#define G8_BAR __builtin_amdgcn_s_barrier()
#define G8_SCHED __builtin_amdgcn_sched_barrier(0)
    Unit cur, nxt; int ui = 0;
    if (!S.next(0, cur)) return;
    Acc acc;
#pragma unroll
    for (int a = 0; a < 2; ++a)
#pragma unroll
        for (int b = 0; b < 2; ++b)
#pragma unroll
            for (int m = 0; m < 4; ++m)
#pragma unroll
                for (int n = 0; n < 2; ++n) acc[a][b][m][n] = (f32x4){0.f, 0.f, 0.f, 0.f};
    bf16x8 At[4][2], B0[2][2], B1[2][2];
    const char* cA = (const char*)(cur.sel ? A1 : A) + (size_t)cur.pm * tstepA; const char* cB = (const char*)Bt + (size_t)cur.pn * tstepB;
    G8_STAGE(G8_SB(0, 0), cB, voffB); G8_STAGE(G8_SA(0, 0), cA, voffA); G8_STAGE(G8_SB(0, 1), cB + hstepB, voffB); G8_STAGE(G8_SA(0, 1), cA + hstepA, voffA);
    if (wr == 1) G8_BAR;
    G8_WAIT_V(4); G8_BAR;
    G8_STAGE(G8_SB(1, 0), cB + kstep, voffB); G8_STAGE(G8_SA(1, 0), cA + kstep, voffA); G8_STAGE(G8_SB(1, 1), cB + hstepB + kstep, voffB);
    G8_WAIT_V(6); G8_BAR;
    for (;;) {
        const bool has_next = S.next(ui + 1, nxt);
        const char* nA = has_next ? (const char*)(nxt.sel ? A1 : A) + (size_t)nxt.pm * tstepA : cA; const char* nB = has_next ? (const char*)Bt + (size_t)nxt.pn * tstepB : cB;
        for (int t = 0; t < nt; t += 2) {
            const bool last = (t == nt - 2);
            const char* a1 = cA + (size_t)(t + 1) * kstep;
            const char* a2 = last ? nA : cA + (size_t)(t + 2) * kstep; const char* b2 = last ? nB : cB + (size_t)(t + 2) * kstep;
            const char* a3 = a2 + kstep; const char* b3 = b2 + kstep;
            G8_LDB(B0, 0, 0); G8_SCHED; G8_LDA(At, 0, 0); G8_STAGE(G8_SA(1, 1), a1 + hstepA, voffA);
            G8_WAIT_L(8); G8_BAR; G8_WAIT_L(0); G8_MMA(0, 0, At, B0); G8_BAR; G8_SCHED;
            G8_LDB(B1, 0, 1); G8_STAGE(G8_SB(0, 0), b2, voffB);
            G8_BAR; G8_WAIT_L(0); G8_MMA(0, 1, At, B1); G8_BAR;
            G8_LDA(At, 0, 1); G8_STAGE(G8_SA(0, 0), a2, voffA);
            G8_BAR; G8_WAIT_L(0); G8_MMA(1, 0, At, B0); G8_BAR; G8_SCHED;
            G8_STAGE(G8_SB(0, 1), b2 + hstepB, voffB);
            G8_WAIT_V(6); G8_BAR; G8_MMA(1, 1, At, B1); G8_BAR;
            G8_LDB(B0, 1, 0); G8_SCHED; G8_LDA(At, 1, 0); G8_STAGE(G8_SA(0, 1), a2 + hstepA, voffA);
            G8_WAIT_L(8); G8_BAR; G8_WAIT_L(0); G8_MMA(0, 0, At, B0); G8_BAR; G8_SCHED;
            G8_LDB(B1, 1, 1); G8_STAGE(G8_SB(1, 0), b3, voffB);
            G8_BAR; G8_WAIT_L(0); G8_MMA(0, 1, At, B1); G8_BAR;
            G8_LDA(At, 1, 1); G8_STAGE(G8_SA(1, 0), a3, voffA);
            G8_BAR; G8_WAIT_L(0); G8_MMA(1, 0, At, B0); G8_BAR; G8_SCHED;
            G8_STAGE(G8_SB(1, 1), b3 + hstepB, voffB);
            G8_WAIT_V(6); G8_BAR; G8_MMA(1, 1, At, B1); G8_BAR;
        }
        const bool keep = E(acc, cur, wr, wc, fr, fq);
        if (!has_next) break;
        if (!keep) {
#pragma unroll
            for (int a = 0; a < 2; ++a)
#pragma unroll
                for (int b = 0; b < 2; ++b)
#pragma unroll
                    for (int m = 0; m < 4; ++m)
#pragma unroll
                        for (int n = 0; n < 2; ++n) acc[a][b][m][n] = (f32x4){0.f, 0.f, 0.f, 0.f};
        }
        cur = nxt; cA = nA; cB = nB; ++ui;
    }
    G8_WAIT_V(0);
    if (wr == 0) G8_BAR;
    G8_BAR;
#undef G8_SA
#undef G8_SB
#undef G8_STAGE
#undef G8_LDA
#undef G8_LDB
#undef G8_MMA
#undef G8_WAIT_V
#undef G8_WAIT_L
#undef G8_BAR
#undef G8_SCHED
}

struct StaticOrder {
    int nM, nN, nwg, G, c;
    __device__ __forceinline__ void init(int M, int N, int G_, int c_) { nM = M / BM; nN = N / BM; nwg = nM * nN; G = G_; c = c_; }
    __device__ __forceinline__ bool next(int i, Unit& u) const {
        const int L = i * G + c; if (L >= nwg) return false;
        int wgid = L; { const int q = nwg / 8, r = nwg % 8, xcd = wgid % 8, off = wgid / 8; wgid = (xcd < r ? xcd * (q + 1) : r * (q + 1) + (xcd - r) * q) + off; }
        const int nig = 8 * nN, gid = wgid / nig, fm = gid * 8, gsz = (nM - fm) < 8 ? (nM - fm) : 8;
        u.pm = fm + ((wgid % nig) % gsz); u.pn = (wgid % nig) / gsz; u.sel = 0; return true;
    }
};
struct EpiStoreBf16 {
    static constexpr bool PERM = true;
    bf16_t* O; int ldc;
    __device__ __forceinline__ bool operator()(Acc& acc, const Unit& u, int wr, int wc, int fr, int fq) const {
        const int row0 = u.pm * BM + wr * 64 + fr, col0 = u.pn * BM + wc * 32 + 8 * fq;
#pragma unroll
        for (int ai = 0; ai < 2; ++ai)
#pragma unroll
            for (int m = 0; m < 4; ++m) { bf16_t* rowp = O + (size_t)(row0 + ai * HALF + m * 16) * ldc + col0;
#pragma unroll
                for (int bj = 0; bj < 2; ++bj) { const f32x4 v0 = acc[ai][bj][m][0], v1 = acc[ai][bj][m][1];
                    u32x4 w; w[0] = pack_bf2(v0[0], v0[1]); w[1] = pack_bf2(v0[2], v0[3]); w[2] = pack_bf2(v1[0], v1[1]); w[3] = pack_bf2(v1[2], v1[3]);
                    *(u32x4*)(rowp + bj * HALF) = w; } }
        return false;
    }
};
}


__device__ __forceinline__ void ph_inproj(const Params& p, int bid, int nb, char* smem) {
    const int UA = 2 * 120 + 16 * 144, UZ = 128 * 8;
    const bf16_t* hl = p.h + (size_t)NCTX * DM;
    int u, tm, tn;
    for (int it = 0; next_unit(it, UA + UZ, bid, nb, u); ++it) {
        if (u < 240) { const int g = u / 120, r = u % 120; tm = g * 8 + (r & 7); tn = 3 + (r >> 3); gemm_store_bf16(p.h, DM, p.Wt_a, 1024, tm, tn, p.Pa, PA_W, smem); }
        else if (u < UA) { unit_mn(u - 240 + 288, 18, tm, tn); gemm_store_bf16(p.h, DM, p.Wt_a, 1024, tm, tn, p.Pa, PA_W, smem); }
        else { unit_mn(u - UA, 8, tm, tn); gemm_store_bf16(hl, DM, p.Wt_z, 1024, tm, tn, p.Pz, PZ_W, smem); }
    }
}

__device__ __forceinline__ void ph_gates(const Params& p, char* smem_all, const int pb) {
    g8::StaticOrder so; so.init(NL, PG_W, gridDim.x, pb);
    g8::EpiStoreBf16 ep; ep.O = p.Pg; ep.ldc = PG_W;
    g8::gemm_phase((LAS unsigned char*)smem_all, p.h + (size_t)NCTX * DM, nullptr, DM, p.Wt_g, 1024, so, ep);
}

__device__ __forceinline__ void ph_merge(const Params& p, int bid, int nb, char* smem) {
    int u, tm, tn;
    for (int it = 0; next_unit(it, 128 * 8, bid, nb, u); ++it) {
        unit_mn(u, 8, tm, tn);
        const int m0 = tm * 128, n0 = tn * 128;
        f32x4 acc[4][4];
        uint2 mm[4][4];
        u32x4 gw[2][4];
        {
        EPI_COORDS_OPAQUE(p1)
#pragma unroll
        for (int j = 0; j < 2; ++j)
#pragma unroll
            for (int mt = 0; mt < 4; ++mt) gw[j][mt] = *(const u32x4*)(p.Pg + (size_t)EPI_ROW(mt) * PG_W + EPI_COL(2 * j));
        }
        acc_zero<4>(acc);
        gemm_tile_acc<4>(acc, p.A_mla, 512, p.Wt_mo, 512, 512, m0, n0, smem);
#pragma unroll
        for (int j = 0; j < 2; ++j)
#pragma unroll
            for (int mt = 0; mt < 4; ++mt) {
#pragma unroll
                for (int q = 0; q < 2; ++q) {
                    const int nt = 2 * j + q;
                    const float g0 = __uint_as_float(gw[j][mt][2 * q] << 16), g1 = __uint_as_float(gw[j][mt][2 * q] & 0xffff0000u);
                    const float g2 = __uint_as_float(gw[j][mt][2 * q + 1] << 16), g3 = __uint_as_float(gw[j][mt][2 * q + 1] & 0xffff0000u);
                    mm[nt][mt].x = pack_bf2(sigmoid_f(g0) * acc[nt][mt][0], sigmoid_f(g1) * acc[nt][mt][1]);
                    mm[nt][mt].y = pack_bf2(sigmoid_f(g2) * acc[nt][mt][2], sigmoid_f(g3) * acc[nt][mt][3]);
                }
            }
        {
        EPI_COORDS_OPAQUE(p2)
#pragma unroll
        for (int j = 0; j < 2; ++j)
#pragma unroll
            for (int mt = 0; mt < 4; ++mt) gw[j][mt] = *(const u32x4*)(p.Pg + (size_t)EPI_ROW(mt) * PG_W + 1024 + EPI_COL(2 * j));
        }
        acc_zero<4>(acc);
        gemm_tile_acc<4>(acc, p.A_dn, 512, p.Wt_do, 512, 512, m0, n0, smem);
        {
        EPI_COORDS_OPAQUE(b)
#pragma unroll
        for (int j = 0; j < 2; ++j)
#pragma unroll
            for (int mt = 0; mt < 4; ++mt) {
                u32x4 ov;
#pragma unroll
                for (int q = 0; q < 2; ++q) {
                    const int nt = 2 * j + q;
                    const float g0 = __uint_as_float(gw[j][mt][2 * q] << 16), g1 = __uint_as_float(gw[j][mt][2 * q] & 0xffff0000u);
                    const float g2 = __uint_as_float(gw[j][mt][2 * q + 1] << 16), g3 = __uint_as_float(gw[j][mt][2 * q + 1] & 0xffff0000u);
                    const float o0 = __uint_as_float(mm[nt][mt].x << 16) + sigmoid_f(g0) * acc[nt][mt][0];
                    const float o1 = __uint_as_float(mm[nt][mt].x & 0xffff0000u) + sigmoid_f(g1) * acc[nt][mt][1];
                    const float o2 = __uint_as_float(mm[nt][mt].y << 16) + sigmoid_f(g2) * acc[nt][mt][2];
                    const float o3 = __uint_as_float(mm[nt][mt].y & 0xffff0000u) + sigmoid_f(g3) * acc[nt][mt][3];
                    ov[2 * q] = pack_bf2(o0, o1); ov[2 * q + 1] = pack_bf2(o2, o3);
                }
                *(u32x4*)(p.Mb + (size_t)EPI_ROW(mt) * 1024 + EPI_COL(2 * j)) = ov;
            }
        }
    }
}

__device__ __forceinline__ void ph_out(const Params& p, int bid, int nb, char* smem) {
    int u, tm, tn;
    for (int it = 0; next_unit(it, 128 * 8, bid, nb, u); ++it) {
        unit_mn(u, 8, tm, tn);
        const int m0 = tm * 128, n0 = tn * 128;
        f32x4 acc[4][4], xv[4][4];
        EPI_COORDS
#pragma unroll
        for (int nt = 0; nt < 4; ++nt)
#pragma unroll
            for (int mt = 0; mt < 4; ++mt) xv[nt][mt] = *(const f32x4*)(p.x + (size_t)EPI_ROW(mt) * DM + EPI_COL(nt));
        const float* gp = p.mod + (m0 / SEQ) * 3072 + 2048;
        f32x4 gate[4];
#pragma unroll
        for (int nt = 0; nt < 4; ++nt) gate[nt] = *(const f32x4*)(gp + EPI_COL(nt));
        acc_zero<4>(acc);
        gemm_tile_acc<4>(acc, p.Mb, 1024, p.Wt_out, 1024, 1024, m0, n0, smem);
#pragma unroll
        for (int nt = 0; nt < 4; ++nt)
#pragma unroll
            for (int mt = 0; mt < 4; ++mt)
                *(f32x4*)(p.out + (size_t)EPI_ROW(mt) * DM + EPI_COL(nt)) = xv[nt][mt] + gate[nt] * acc[nt][mt];
    }
}

struct InprojOrder {
    int c;
    __device__ __forceinline__ bool next(int i, g8::Unit& u) const {
        const int x = c & 7, off = i * 32 + (c >> 3);
        if (off >= 112) return false;
        if (off < 104) { u.pm = 8 + 8 * x + (off & 7); u.pn = off >> 3; }
        else { u.pm = x; u.pn = 1 + (off - 104); }
        u.sel = 0; return true;
    }
};
template <int LDC>
__device__ __forceinline__ void epi_store_tile(const g8::Acc& acc, bf16_t* O, int row0, int col0) {
#pragma unroll
    for (int ai = 0; ai < 2; ++ai)
#pragma unroll
        for (int m = 0; m < 4; ++m) { bf16_t* rowp = O + (size_t)(row0 + ai * 128 + m * 16) * LDC + col0;
#pragma unroll
            for (int bj = 0; bj < 2; ++bj) { const f32x4 v0 = acc[ai][bj][m][0], v1 = acc[ai][bj][m][1];
                u32x4 w; w[0] = pack_bf2(v0[0], v0[1]); w[1] = pack_bf2(v0[2], v0[3]); w[2] = pack_bf2(v1[0], v1[1]); w[3] = pack_bf2(v1[2], v1[3]);
                *(u32x4*)(rowp + bj * 128) = w; } }
}
struct EpiInproj {
    static constexpr bool PERM = true;
    bf16_t* Pa; bf16_t* Pz;
    __device__ __forceinline__ bool operator()(g8::Acc& acc, const g8::Unit& u, int wr, int wc, int, int) const {
        int t = threadIdx.x; asm volatile("" : "+v"(t));
        const int fr = t & 15, fq = (t >> 4) & 3;
        if (u.pn < 9) epi_store_tile<PA_W>(acc, Pa, u.pm * 256 + wr * 64 + fr, u.pn * 256 + wc * 32 + 8 * fq);
        else epi_store_tile<PZ_W>(acc, Pz, u.pm * 256 - NCTX + wr * 64 + fr, (u.pn - 9) * 256 + wc * 32 + 8 * fq);
        return false;
    }
};
__device__ __forceinline__ void ph_inproj8(const Params& p, char* smem_all, const int pb) {
    InprojOrder so; so.c = pb;
    EpiInproj ep; ep.Pa = p.Pa; ep.Pz = p.Pz;
    g8::gemm_phase((LAS unsigned char*)smem_all, p.h, nullptr, DM, p.Wt_a, 1024, so, ep);
}

struct MergeOrder {
    g8::StaticOrder so;
    __device__ __forceinline__ bool next(int i, g8::Unit& u) const {
        if (i >= 2) return false;
        const bool ok = so.next(0, u); u.sel = i; u.pn += 4 * i; return ok;
    }
};
struct EpiMerge {
    static constexpr bool PERM = true;
    const bf16_t* Pg; bf16_t* Mb;
    __device__ __forceinline__ bool operator()(g8::Acc& acc, const g8::Unit& u, int wr, int wc, int, int) const {
        int t = threadIdx.x; asm volatile("" : "+v"(t));
        const int fr = t & 15, fq = (t >> 4) & 3;
        const int row0 = u.pm * 256 + wr * 64 + fr, col0 = (u.pn & 3) * 256 + wc * 32 + 8 * fq;
        if (u.sel == 0) {
#pragma unroll
            for (int ai = 0; ai < 2; ++ai) {
#pragma unroll
                for (int m = 0; m < 4; ++m) {
                    const bf16_t* gp = Pg + (size_t)(row0 + ai * 128 + m * 16) * PG_W + col0;
                    u32x4 g1[2], g2[2];
#pragma unroll
                    for (int bj = 0; bj < 2; ++bj) { g1[bj] = *(const u32x4*)(gp + bj * 128); g2[bj] = *(const u32x4*)(gp + 1024 + bj * 128); }
#pragma unroll
                    for (int bj = 0; bj < 2; ++bj)
#pragma unroll
                        for (int n = 0; n < 2; ++n)
#pragma unroll
                            for (int e = 0; e < 4; ++e) {
                                const unsigned w1 = g1[bj][2 * n + (e >> 1)], w2 = g2[bj][2 * n + (e >> 1)];
                                const float a1 = (e & 1) ? __uint_as_float(w1 & 0xffff0000u) : __uint_as_float(w1 << 16);
                                const float a2 = fmaxf((e & 1) ? __uint_as_float(w2 & 0xffff0000u) : __uint_as_float(w2 << 16), -30.f);
                                acc[ai][bj][m][n][e] *= (1.f + __expf(-a2)) * __builtin_amdgcn_rcpf(1.f + __expf(-a1));
                            }
                }
                asm volatile("" ::: "memory");
            }
            return true;
        }
#pragma unroll
        for (int ai = 0; ai < 2; ++ai) {
#pragma unroll
            for (int m = 0; m < 4; ++m) {
                const size_t row = (size_t)(row0 + ai * 128 + m * 16);
                u32x4 g2[2];
#pragma unroll
                for (int bj = 0; bj < 2; ++bj) g2[bj] = *(const u32x4*)(Pg + row * PG_W + 1024 + col0 + bj * 128);
#pragma unroll
                for (int bj = 0; bj < 2; ++bj) {
                    u32x4 w;
#pragma unroll
                    for (int n = 0; n < 2; ++n) {
                        float o[4];
#pragma unroll
                        for (int e = 0; e < 4; ++e) {
                            const unsigned w2 = g2[bj][2 * n + (e >> 1)];
                            const float a2 = fmaxf((e & 1) ? __uint_as_float(w2 & 0xffff0000u) : __uint_as_float(w2 << 16), -30.f);
                            o[e] = acc[ai][bj][m][n][e] * __builtin_amdgcn_rcpf(1.f + __expf(-a2));
                        }
                        w[2 * n] = pack_bf2(o[0], o[1]); w[2 * n + 1] = pack_bf2(o[2], o[3]);
                    }
                    *(u32x4*)(Mb + row * 1024 + col0 + bj * 128) = w;
                }
            }
            asm volatile("" ::: "memory");
        }
        return false;
    }
};
__device__ __forceinline__ void ph_merge8(const Params& p, char* smem_all, const int pb) {
    MergeOrder mo; mo.so.init(NL, 1024, gridDim.x, pb);
    EpiMerge ep; ep.Pg = p.Pg; ep.Mb = p.Mb;
    g8::gemm_phase((LAS unsigned char*)smem_all, p.A_mla, p.A_dn, 512, p.Wt_mo, 512, mo, ep);
}

struct EpiOut {
    static constexpr bool PERM = false;
    const float* x; const float* mod; float* out;
    __device__ __forceinline__ bool operator()(g8::Acc& acc, const g8::Unit& u, int wr, int wc, int fr, int fq) const {
        const int row0 = u.pm * 256 + wr * 64 + fr, col0 = u.pn * 256 + wc * 32 + 4 * fq;
        const float* gp = mod + ((u.pm * 256) / SEQ) * 3072 + 2048 + col0;
        f32x4 gate[2][2];
#pragma unroll
        for (int bj = 0; bj < 2; ++bj)
#pragma unroll
            for (int n = 0; n < 2; ++n) gate[bj][n] = *(const f32x4*)(gp + bj * 128 + n * 16);
#pragma unroll
        for (int ai = 0; ai < 2; ++ai)
#pragma unroll
            for (int m = 0; m < 4; ++m) {
                const size_t off = (size_t)(row0 + ai * 128 + m * 16) * DM + col0;
                f32x4 xv[2][2];
#pragma unroll
                for (int bj = 0; bj < 2; ++bj)
#pragma unroll
                    for (int n = 0; n < 2; ++n) xv[bj][n] = *(const f32x4*)(x + off + bj * 128 + n * 16);
#pragma unroll
                for (int bj = 0; bj < 2; ++bj)
#pragma unroll
                    for (int n = 0; n < 2; ++n) *(f32x4*)(out + off + bj * 128 + n * 16) = xv[bj][n] + gate[bj][n] * acc[ai][bj][m][n];
                if (m & 1) asm volatile("" ::: "memory");
            }
        return false;
    }
};
__device__ __forceinline__ void ph_out8(const Params& p, char* smem_all, const int pb) {
    g8::StaticOrder so; so.init(NL, DM, gridDim.x, pb);
    EpiOut ep; ep.x = p.x; ep.mod = p.mod; ep.out = p.out;
    g8::gemm_phase((LAS unsigned char*)smem_all, p.Mb, nullptr, DM, p.Wt_out, 1024, so, ep);
}

#define XB_TMO      128
#define XB_XCNT(j)  (256  + 64 * (j))
#define XB_XSUB(j)  (1280 + 64 * (j))
#define XB_XGEN(j)  (2304 + 64 * (j))
#define XB_TOP      3328
#define XB_TOPGEN   3392
#define XCD_BAR_WORDS 3456
#define XB_SPIN_CAP (1u << 20)
__device__ __forceinline__ unsigned xb_ld(unsigned* p)              { return __hip_atomic_load(p, __ATOMIC_RELAXED, __HIP_MEMORY_SCOPE_AGENT); }
__device__ __forceinline__ unsigned xb_add(unsigned* p, unsigned v) { return __hip_atomic_fetch_add(p, v, __ATOMIC_RELAXED, __HIP_MEMORY_SCOPE_AGENT); }
__device__ __forceinline__ unsigned xb_xcc_id() { return (unsigned)__builtin_amdgcn_s_getreg((3 << 11) | 20) & 0xFu; }
#define XB_SPIN(cond, bar) do { unsigned _sp = 0; while (cond) { __builtin_amdgcn_s_sleep(1); \
    if ((++_sp & 255u) == 0u) { if (xb_ld(&(bar)[XB_TMO])) break; if (_sp > XB_SPIN_CAP) { atomicAdd(&(bar)[XB_TMO], 1u); break; } } } } while (0)
struct XcdBarrier { unsigned* bar; unsigned x; volatile LAS unsigned* st; };
__device__ __forceinline__ XcdBarrier xcd_barrier_post(unsigned* bar, volatile LAS unsigned* st) {
    XcdBarrier b; b.bar = bar; b.x = xb_xcc_id(); b.st = st;
    if (threadIdx.x == 0) (void)xb_add(&bar[XB_XCNT(b.x)], 1u);
    return b;
}
__device__ __forceinline__ void xcd_barrier_complete(unsigned* bar, unsigned x, unsigned& nloc, unsigned& nx) {
    const unsigned G = gridDim.x * gridDim.y * gridDim.z;
    unsigned sum, cnt, mine, sp = 0u;
    for (;;) {
        sum = 0u; cnt = 0u; mine = 0u;
#pragma unroll
        for (unsigned j = 0; j < 16; ++j) { const unsigned c = xb_ld(&bar[XB_XCNT(j)]); sum += c; cnt += (c > 0u) ? 1u : 0u; mine = (j == x) ? c : mine; }
        if (sum == G) break;
        __builtin_amdgcn_s_sleep(1);
        if ((++sp & 255u) == 0u) { if (xb_ld(&bar[XB_TMO])) break; if (sp > XB_SPIN_CAP) { atomicAdd(&bar[XB_TMO], 1u); break; } }
    }
    nloc = mine > 0u ? mine : 1u; nx = cnt > 0u ? cnt : 1u;
}
__device__ __forceinline__ void xcd_barrier(const XcdBarrier& b) {
    asm volatile("s_waitcnt vmcnt(0)" ::: "memory");
    __syncthreads();
    if (threadIdx.x == 0) {
        unsigned* bar = b.bar;
        __builtin_amdgcn_s_waitcnt(0);
        unsigned nloc = b.st[0], nx = b.st[1];
        if (nloc == 0u) { xcd_barrier_complete(bar, b.x, nloc, nx); b.st[0] = nloc; b.st[1] = nx; }
        const unsigned old = xb_add(&bar[XB_XSUB(b.x)], 1u);
        const unsigned gen = old / nloc;
        if (old + 1u == (gen + 1u) * nloc) {
            __builtin_amdgcn_fence(__ATOMIC_RELEASE, "agent");
            asm volatile("s_waitcnt vmcnt(0)" ::: "memory");
            const unsigned og = xb_add(&bar[XB_TOP], 1u);
            const unsigned tg = og / nx;
            if (og + 1u == (tg + 1u) * nx) xb_add(&bar[XB_TOPGEN], 1u);
            else XB_SPIN(xb_ld(&bar[XB_TOPGEN]) == tg, bar);
            __builtin_amdgcn_fence(__ATOMIC_ACQUIRE, "agent");
            xb_add(&bar[XB_XGEN(b.x)], 1u);
            asm volatile("s_waitcnt vmcnt(0)" ::: "memory");
        } else {
            XB_SPIN(xb_ld(&bar[XB_XGEN(b.x)]) == gen, bar);
            __builtin_amdgcn_fence(__ATOMIC_ACQUIRE, "agent");
            asm volatile("s_waitcnt vmcnt(0)" ::: "memory");
        }
    }
    __syncthreads();
}

__global__ void __launch_bounds__(2 * NTHR, 2) fwd_megakernel(Params p) {
    __shared__ __attribute__((aligned(16))) char smem_all[2 * SMEM_BYTES];
    const int half = __builtin_amdgcn_readfirstlane((int)(threadIdx.x >> 8)), pb = blockIdx.x;
    const int bid = 16 * (pb >> 3) + 8 * half + (pb & 7), nb = 2 * gridDim.x;
    const int bid2 = 2 * pb + half;
    char* smem = smem_all + half * SMEM_BYTES;
    volatile LAS unsigned* bst = (volatile LAS unsigned*)(smem_all + 2 * SMEM_BYTES - 16);
    if (threadIdx.x == 0) { bst[0] = 0u; bst[1] = 0u; }
    __syncthreads();
    const XcdBarrier xb = xcd_barrier_post(p.bar, bst);

    ph_mod(p, bid, nb, smem);
    ph_wprep(p, bid2, nb, smem);
    xcd_barrier(xb);
    ph_norm(p, bid, nb, smem);
    xcd_barrier(xb);
    ph_inproj8(p, smem_all, pb);
    xcd_barrier(xb);
    ph_mla_proj(p, bid, nb, smem);
    xcd_barrier(xb);
    ph_attn(p, bid, nb, smem, smem_all, pb);
    xcd_barrier(xb);
    ph_dn1(p, bid, nb, smem);
    xcd_barrier(xb);
    ph_dn2(p, smem_all, pb);
    xcd_barrier(xb);
    ph_dn3(p, bid, nb, smem);
    ph_gates(p, smem_all, pb);
    xcd_barrier(xb);
    ph_merge8(p, smem_all, pb);
    xcd_barrier(xb);
    ph_out8(p, smem_all, pb);
}

extern "C" void kernel_launch(void* const* d_in, const int* in_sizes, int n_in,
                              void* d_out, int out_size, void* d_ws, size_t ws_size,
                              hipStream_t stream) {
    static int grid_blocks = 0;
    if (!grid_blocks) {
        int dev = 0, cus = 0, per_cu = 0;
        (void)hipGetDevice(&dev);
        (void)hipDeviceGetAttribute(&cus, hipDeviceAttributeMultiprocessorCount, dev);
        (void)hipOccupancyMaxActiveBlocksPerMultiprocessor(&per_cu, fwd_megakernel, 2 * NTHR, 0);
        if (per_cu > 1) per_cu = 1;
        if (per_cu < 1) per_cu = 1;
        grid_blocks = cus * per_cu;
    }
    if (n_in != 21 || ws_size < (size_t)268435456 || out_size != NL * DM) {
        fprintf(stderr, "kernel_launch: built for 21 inputs, a %d-float output and >= 256 MiB of workspace (got %d inputs, out %d, ws %zu)\n", NL * DM, n_in, out_size, ws_size);
        return;
    }
    Params p{};
    const float** fp = (const float**)&p;
    for (int i = 0; i < 21; ++i) fp[i] = (const float*)d_in[i];
    p.out = (float*)d_out;
    char* ws = (char*)d_ws;
    char* ob = (char*)d_out;
    const size_t R_W = 0;
    const size_t R_H = 16777216;
    const size_t R_Z = R_H + 37748736;
    const size_t R_A = R_Z + 33554432;
    const size_t R_F = R_A + 84934656;
    {
        size_t o = R_W;
        p.Wt_a = (bf16_t*)(ws + o); o += 4718592;
        p.Wt_z = (bf16_t*)(ws + o); o += 2097152;
        p.Wt_g = (bf16_t*)(ws + o); o += 4194304;
        p.Wt_uq = (bf16_t*)(ws + o); o += 589824;
        p.Wt_ukv = (bf16_t*)(ws + o); o += 524288;
        p.Wt_mo = (bf16_t*)(ws + o); o += 1048576;
        p.Wt_do = (bf16_t*)(ws + o); o += 1048576;
        p.Wt_out = (bf16_t*)(ws + o); o += 2097152;
        p.mod = (float*)(ws + o); o += 110592;
        p.bar = (unsigned*)(ws + o); o += XCD_BAR_WORDS * 4;
        p.rope = (float*)(ws + o); o += 4096;
    }
    p.h = (bf16_t*)(ws + R_H);
    p.Pz = (bf16_t*)(ws + R_Z);
    p.Pa = (bf16_t*)(ws + R_A);
    p.Qb = (bf16_t*)(ws + R_F + 22020096);
    p.Kb = (bf16_t*)(ws + R_F + 47185920);
    p.Vt = (bf16_t*)(ws + R_F + 75497472);
    p.MH = (bf16_t*)(ws + R_F + 16777216);
    p.EF = (bf16_t*)(ob);
    p.ST = (bf16_t*)(ws + R_A);
    p.A_mla = (bf16_t*)(ws + R_F);
    p.A_dn = (bf16_t*)(ws + R_A + 50331648);
    p.Pg = (bf16_t*)(ws + R_F + 16777216);
    p.Mb = (bf16_t*)(ws + R_H);
    (void)hipMemsetAsync(p.mod, 0, 110592 + XCD_BAR_WORDS * 4, stream);
    void* args[] = {&p};
    hipError_t err = hipLaunchCooperativeKernel((void*)fwd_megakernel, dim3(grid_blocks), dim3(2 * NTHR), args, 0, stream);
    if (err != hipSuccess) fprintf(stderr, "cooperative launch failed: %s (grid %d)\n", hipGetErrorString(err), grid_blocks);
}
```

```cpp
#include <hip/hip_runtime.h>
#include <stdint.h>
#include <cstdio>

typedef uint16_t bf16_t;
#define LAS __attribute__((address_space(3)))

#define NB 8
#define SEQ 2048
#define CTXL 256
#define TPB 2304
#define NCTX 2048
#define NL 16384
#define NT 18432
#define DM 1024
#define IN_DIM 5312
#define PA_W 2304
#define PZ_W 1024
#define PG_W 2048
#define PA_CQ 0
#define PA_CKV 384
#define PA_KR 640
#define PA_DQ 672
#define PA_DK 1184
#define PA_DV 1696
#define PA_DB 2208
#define PA_DA 2224
#define EPSF 1e-6f
#define NTHR 256
#define VTID ((int)(threadIdx.x & 255u))
#define SMEM_BYTES 77824

struct Params {
    const float *x, *c, *ctx, *c_ctx, *w_mod, *b_mod, *norm_w, *w_in, *q_norm_w, *w_uq, *kv_norm_w, *w_ukv, *qhn_w, *khn_w,
        *mla_w_o, *conv_w, *a_log, *dt_bias, *dn_norm_w, *dn_w_o, *w_out;
    float* out;
    bf16_t *h, *Pa, *Pz, *Pg, *Qb, *Vt, *Kb, *MH, *EF, *ST, *A_mla, *A_dn, *Mb;
    bf16_t *Wt_a, *Wt_z, *Wt_g, *Wt_uq, *Wt_ukv, *Wt_mo, *Wt_do, *Wt_out;
    float *mod, *rope;
    unsigned* bar;
};

typedef float f32x4 __attribute__((ext_vector_type(4)));
typedef unsigned u32x4 __attribute__((ext_vector_type(4)));
typedef __bf16 bf16v2_t __attribute__((ext_vector_type(2)));
typedef float f32x2 __attribute__((ext_vector_type(2)));
__device__ __forceinline__ uint32_t pack_bf2(float lo, float hi) {
    f32x2 v = {lo, hi};
    bf16v2_t b = __builtin_convertvector(v, bf16v2_t);
    return __builtin_bit_cast(uint32_t, b);
}
__device__ __forceinline__ void st_bf4(bf16_t* p, f32x4 v) {
    uint2 o; o.x = pack_bf2(v[0], v[1]); o.y = pack_bf2(v[2], v[3]);
    *(uint2*)p = o;
}
__device__ __forceinline__ float bf2f(bf16_t v) { return __uint_as_float(((uint32_t)v) << 16); }
__device__ __forceinline__ bf16_t f2bf(float f) {
    uint32_t u = __float_as_uint(f);
    u += 0x7fffu + ((u >> 16) & 1u);
    return (bf16_t)(u >> 16);
}
__device__ __forceinline__ float silu_f(float v) { return v * __builtin_amdgcn_rcpf(1.f + __expf(-v)); }
__device__ __forceinline__ float sigmoid_f(float v) { return __builtin_amdgcn_rcpf(1.f + __expf(-v)); }
template <int CTRL> __device__ __forceinline__ float dpp_mov(float v) {
    return __builtin_bit_cast(float, __builtin_amdgcn_update_dpp(0, __builtin_bit_cast(int, v), CTRL, 0xF, 0xF, true));
}
__device__ __forceinline__ float row16_sum(float v) {
    v += dpp_mov<0xB1>(v); v += dpp_mov<0x4E>(v); v += dpp_mov<0x141>(v); v += dpp_mov<0x140>(v); return v;
}
__device__ __forceinline__ float rdlane(float v, int l) { return __builtin_bit_cast(float, __builtin_amdgcn_readlane(__builtin_bit_cast(int, v), l)); }
__device__ __forceinline__ float wave_sum(float v) {
    v += dpp_mov<0xB1>(v);
    v += dpp_mov<0x4E>(v);
    v += dpp_mov<0x141>(v);
    v += dpp_mov<0x140>(v);
    return (rdlane(v, 0) + rdlane(v, 16)) + (rdlane(v, 32) + rdlane(v, 48));
}
__device__ __forceinline__ float xrow_sum(float v) { v += __shfl_xor(v, 16); v += __shfl_xor(v, 32); return v; }
__device__ __forceinline__ void ph_mod(const Params& p, int bid, int nb, char* smem) {
    float* sc = (float*)smem;
    const int item = bid & 511;
    const int k0 = (item >> 4) * 32, cb = (item & 15) * 192, tid = VTID;
    for (int i = tid; i < 288; i += NTHR) {
        const int r = i >> 5, kk = i & 31;
        const float v = (r < 8) ? p.c[r * 1024 + k0 + kk] : p.c_ctx[k0 + kk];
        sc[i] = silu_f(v);
    }
    __syncthreads();
    if (tid < 192) {
        const float* wp = p.w_mod + (size_t)k0 * 3072 + cb;
        float acc[9];
#pragma unroll
        for (int r = 0; r < 9; ++r) acc[r] = 0.f;
        int NH = 2;
        asm volatile("" : "+s"(NH));
        for (int hh = 0; hh < NH; ++hh) {
            float wv[16];
#pragma unroll
            for (int kk = 0; kk < 16; ++kk) wv[kk] = wp[(size_t)(hh * 16 + kk) * 3072 + tid];
#pragma unroll
            for (int k4 = 0; k4 < 4; ++k4)
#pragma unroll
                for (int r = 0; r < 9; ++r) {
                    const f32x4 s4 = *(const f32x4*)(sc + r * 32 + hh * 16 + 4 * k4);
                    acc[r] += s4[0] * wv[4 * k4] + s4[1] * wv[4 * k4 + 1] + s4[2] * wv[4 * k4 + 2] + s4[3] * wv[4 * k4 + 3];
                }
        }
        const float bb = (k0 == 0) ? p.b_mod[cb + tid] : 0.f;
#pragma unroll
        for (int r = 0; r < 9; ++r) atomicAdd(p.mod + r * 3072 + cb + tid, acc[r] + bb);
    }
    __syncthreads();
}

__device__ __forceinline__ void ph_norm(const Params& p, int bid, int nb, char* smem) {
    const int lane = VTID & 63, gw = bid * 4 + (VTID >> 6), nw = nb * 4;
    const int per = (NT + nw - 1) / nw;
    const int r0 = gw * per, r1 = (r0 + per < NT) ? r0 + per : NT;
    auto rowptr = [&](int rr) -> const float* { return (rr < NCTX) ? p.ctx + (size_t)rr * DM : p.x + (size_t)(rr - NCTX) * DM; };
    f32x4 v[4], vn[4], av[4], sv[4];
    int cur_m = -1;
    if (r0 < r1) {
        const float* src = rowptr(r0);
#pragma unroll
        for (int i = 0; i < 4; ++i) v[i] = *(const f32x4*)(src + i * 256 + lane * 4);
    }
    for (int r = r0; r < r1; ++r) {
        if (r + 1 < r1) {
            const float* src = rowptr(r + 1);
#pragma unroll
            for (int i = 0; i < 4; ++i) vn[i] = *(const f32x4*)(src + i * 256 + lane * 4);
        }
        const int mrow = (r < NCTX) ? 8 : (r - NCTX) / SEQ;
        if (mrow != cur_m) {
            cur_m = mrow;
            const float* shift = p.mod + mrow * 3072;
            const float* scale = shift + 1024;
#pragma unroll
            for (int i = 0; i < 4; ++i) {
                const int k = i * 256 + lane * 4;
                const f32x4 nwv = *(const f32x4*)(p.norm_w + k), sc = *(const f32x4*)(scale + k);
                sv[i] = *(const f32x4*)(shift + k);
#pragma unroll
                for (int e2 = 0; e2 < 4; ++e2) av[i][e2] = nwv[e2] * (1.f + sc[e2]);
            }
        }
        float ss = 0.f;
#pragma unroll
        for (int i = 0; i < 4; ++i) ss += v[i][0] * v[i][0] + v[i][1] * v[i][1] + v[i][2] * v[i][2] + v[i][3] * v[i][3];
        ss = wave_sum(ss);
        const float rstd = rsqrtf(ss * (1.f / 1024.f) + EPSF);
#pragma unroll
        for (int i = 0; i < 4; ++i) {
            f32x4 y;
#pragma unroll
            for (int e2 = 0; e2 < 4; ++e2) y[e2] = (v[i][e2] * rstd) * av[i][e2] + sv[i][e2];
            st_bf4(p.h + (size_t)r * DM + i * 256 + lane * 4, y);
        }
#pragma unroll
        for (int i = 0; i < 4; ++i) v[i] = vn[i];
    }
}


struct WprepDesc { const float* W; const float* ksc; bf16_t* dst; int ldw, K, n0, k0, srcbase; };
__device__ __forceinline__ void wprep_decode(const Params& p, int u, WprepDesc& d) {
    const int U0 = 72 * 8, U1 = 32 * 8, U2 = 64 * 8, U3 = 24 * 3, U4 = 32 * 2, U5 = 32 * 4, U6 = 32 * 4;
    int v = u, job;
    if (v < U0) { job = 0; d.W = p.w_in; d.ldw = IN_DIM; d.K = 1024; d.dst = p.Wt_a; }
    else if ((v -= U0) < U1) { job = 1; d.W = p.w_in; d.ldw = IN_DIM; d.K = 1024; d.dst = p.Wt_z; }
    else if ((v -= U1) < U2) { job = 2; d.W = p.w_in; d.ldw = IN_DIM; d.K = 1024; d.dst = p.Wt_g; }
    else if ((v -= U2) < U3) { job = 3; d.W = p.w_uq; d.ldw = 768; d.K = 384; d.dst = p.Wt_uq; }
    else if ((v -= U3) < U4) { job = 4; d.W = p.w_ukv; d.ldw = 1024; d.K = 256; d.dst = p.Wt_ukv; }
    else if ((v -= U4) < U5) { job = 5; d.W = p.mla_w_o; d.ldw = 1024; d.K = 512; d.dst = p.Wt_mo; }
    else if ((v -= U5) < U6) { job = 6; d.W = p.dn_w_o; d.ldw = 1024; d.K = 512; d.dst = p.Wt_do; }
    else { v -= U6; job = 7; d.W = p.w_out; d.ldw = 1024; d.K = 1024; d.dst = p.Wt_out; }
    const int nkt = d.K / 128;
    d.n0 = (v / nkt) * 32; d.k0 = (v % nkt) * 128;
    const int n0 = d.n0;
    int srcbase = n0;
    if (job == 0) {
        if (n0 < 672) srcbase = n0;
        else if (n0 < 2208) { const int r = n0 - 672, hh = r / 192, g = (r % 192) >> 6, i0 = r & 63; srcbase = 1184 + g * 512 + hh * 64 + i0; }
        else srcbase = (n0 < 2240) ? n0 + 1024 : -1;
    }
    else if (job == 1) srcbase = (n0 < 512) ? 672 + n0 : 2208 + n0;
    else if (job == 2) srcbase = 3264 + n0;
    d.srcbase = srcbase;
    d.ksc = (job == 3) ? p.q_norm_w : (job == 4) ? p.kv_norm_w : nullptr;
}
__device__ __forceinline__ void wprep_load(const WprepDesc& d, f32x4 (&v)[4], int tid) {
    const int n4 = (tid & 7) * 4, kk = tid >> 3;
#pragma unroll
    for (int q = 0; q < 4; ++q) {
        v[q] = (f32x4){0.f, 0.f, 0.f, 0.f};
        if (d.srcbase >= 0) v[q] = *(const f32x4*)(d.W + (size_t)(d.k0 + kk + 32 * q) * d.ldw + d.srcbase + n4);
    }
}
__device__ __forceinline__ void wprep_emit(const WprepDesc& d, const f32x4 (&v)[4], float* tile, int tid) {
    {
        const int n4 = (tid & 7) * 4, kk = tid >> 3;
#pragma unroll
        for (int q = 0; q < 4; ++q) {
            const int k = kk + 32 * q;
            const float s = d.ksc ? d.ksc[d.k0 + k] : 1.f;
            float* t = tile + k * 33 + n4;
            t[0] = v[q][0] * s; t[1] = v[q][1] * s; t[2] = v[q][2] * s; t[3] = v[q][3] * s;
        }
    }
    __syncthreads();
    {
        const int n = tid >> 3;
#pragma unroll
        for (int q = 0; q < 2; ++q) {
            const int kc = (tid & 7) + 8 * q;
            const float* t = tile + (kc * 8) * 33 + n;
            u32x4 o;
            o[0] = pack_bf2(t[0 * 33], t[1 * 33]); o[1] = pack_bf2(t[2 * 33], t[3 * 33]);
            o[2] = pack_bf2(t[4 * 33], t[5 * 33]); o[3] = pack_bf2(t[6 * 33], t[7 * 33]);
            *(u32x4*)(d.dst + (size_t)(d.n0 + n) * d.K + d.k0 + kc * 8) = o;
        }
    }
    __syncthreads();
}

__device__ __forceinline__ void ph_wprep(const Params& p, int bid, int nb, char* smem) {
    float* tile = (float*)smem;
    const int UT = 72 * 8 + 32 * 8 + 64 * 8 + 24 * 3 + 32 * 2 + 32 * 4 + 32 * 4 + 32 * 8;
    const int tid = VTID;
    WprepDesc d, dn;
    f32x4 v[4], vn[4];
    int u = bid;
    if (u < UT) { wprep_decode(p, u, d); wprep_load(d, v, tid); }
    for (; u < UT; u += nb) {
        const bool more = (u + nb < UT);
        if (more) { wprep_decode(p, u + nb, dn); wprep_load(dn, vn, tid); }
        wprep_emit(d, v, tile, tid);
        if (more) {
            d = dn;
#pragma unroll
            for (int q = 0; q < 4; ++q) v[q] = vn[q];
        }
    }
    if (bid == nb - 1) {
        for (int i = VTID; i < 512; i += NTHR) {
            const int pos = i >> 3, f = i & 7;
            const float ang = (float)pos * powf(10000.f, -(float)f / 8.f);
            p.rope[2 * i] = cosf(ang); p.rope[2 * i + 1] = sinf(ang);
        }
    }
}

typedef short bf16x8 __attribute__((ext_vector_type(8)));


__device__ __forceinline__ int lds_off(int row, int chunk) { return row * 128 + (((chunk ^ (row >> 1)) & 7) << 4); }

__device__ __forceinline__ int epi_perm(int rho) { return 8 * ((rho >> 2) & 3) + 4 * (rho >> 4) + (rho & 3); }

template <int NTN>
__device__ __forceinline__ void gemm_compute_stage(f32x4 (&acc)[NTN][4], const char* sa, int wm, int wn, int l15, int lq) {
    const char* sb = sa + 16384;
#pragma unroll
    for (int ks = 0; ks < 2; ++ks) {
        bf16x8 af[4], bfr[NTN];
#pragma unroll
        for (int mt = 0; mt < 4; ++mt) af[mt] = *(const bf16x8*)(sa + lds_off(wm * 64 + mt * 16 + l15, ks * 4 + lq));
#pragma unroll
        for (int nt = 0; nt < NTN; ++nt) bfr[nt] = *(const bf16x8*)(sb + lds_off(wn * (16 * NTN) + nt * 16 + l15, ks * 4 + lq));
#pragma unroll
        for (int nt = 0; nt < NTN; ++nt)
#pragma unroll
            for (int mt = 0; mt < 4; ++mt)
                acc[nt][mt] = __builtin_amdgcn_mfma_f32_16x16x32_bf16(bfr[nt], af[mt], acc[nt][mt], 0, 0, 0);
    }
}
template <int NTN>
__device__ __forceinline__ void gemm_tile_acc(f32x4 (&acc)[NTN][4], const bf16_t* __restrict__ A, int lda, const bf16_t* __restrict__ Bt, int ldb,
                                              int K, int m0, int n0, char* smem) {
    int tid = VTID;
    asm volatile("" : "+v"(tid));
    const int lane = tid & 63, w = tid >> 6, wm = w >> 1, wn = w & 1;
    const int l15 = lane & 15, lq = lane >> 4;
    const int srow = tid >> 3, sch = (tid & 7) ^ ((srow >> 1) & 7);
    const bf16_t* ap = A + (size_t)(m0 + srow) * lda + sch * 8;
    const int prow = epi_perm(srow & 31);
    const bf16_t* bp = Bt + (size_t)(n0 + prow) * ldb + sch * 8;
    int KT = K >> 6;
    asm volatile("" : "+s"(KT));
    LAS char* lbase = (LAS char*)smem + w * 1024;
#define GT_STAGE(ST_, KT_) do { \
        _Pragma("unroll") for (int i = 0; i < 4; ++i) \
            __builtin_amdgcn_global_load_lds((const void*)(ap + (size_t)(32 * i) * lda + (KT_) * 64), (LAS void*)(lbase + (ST_) * 32768 + i * 4096), 16, 0, 0); \
        _Pragma("unroll") for (int i = 0; i < NTN; ++i) \
            __builtin_amdgcn_global_load_lds((const void*)(bp + (size_t)(32 * i) * ldb + (KT_) * 64), (LAS void*)(lbase + (ST_) * 32768 + 16384 + i * 4096), 16, 0, 0); } while (0)
    GT_STAGE(0, 0);
    __syncthreads();
    for (int kt = 0; kt < KT; ++kt) {
        if (kt + 1 < KT) GT_STAGE((kt + 1) & 1, kt + 1);
        gemm_compute_stage<NTN>(acc, smem + (kt & 1) * 32768, wm, wn, l15, lq);
        __syncthreads();
    }
#undef GT_STAGE
}

template <int NTN>
__device__ __forceinline__ void acc_zero(f32x4 (&acc)[NTN][4]) {
#pragma unroll
    for (int i = 0; i < NTN; ++i)
#pragma unroll
        for (int j = 0; j < 4; ++j) acc[i][j] = (f32x4){0.f, 0.f, 0.f, 0.f};
}

__device__ __forceinline__ bool next_unit(int it, int U, int bid, int nb, int& u) {
    const int x = bid & 7, li = bid >> 3, per = nb >> 3;
    const int lo = (int)(((long)U * x) >> 3), hi = (int)(((long)U * (x + 1)) >> 3);
    u = lo + li + it * per;
    return u < hi;
}
__device__ __forceinline__ void unit_mn(int u, int ntn, int& tm, int& tn) {
    const int g = u / (8 * ntn), r = u % (8 * ntn);
    tm = g * 8 + (r & 7); tn = r >> 3;
}


__device__ __forceinline__ f32x4 ld_bf4(const bf16_t* p) {
    const uint2 r = *(const uint2*)p;
    return (f32x4){__uint_as_float(r.x << 16), __uint_as_float(r.x & 0xffff0000u), __uint_as_float(r.y << 16), __uint_as_float(r.y & 0xffff0000u)};
}
#define EPI_COORDS_OPAQUE(SFX) int tid##SFX = VTID; asm volatile("" : "+v"(tid##SFX)); \
    const int lane_ = tid##SFX & 63, w_ = tid##SFX >> 6, wm_ = w_ >> 1, wn_ = w_ & 1, l15_ = lane_ & 15, lq_ = lane_ >> 4;
#define EPI_COORDS const int lane_ = VTID & 63, w_ = VTID >> 6, wm_ = w_ >> 1, wn_ = w_ & 1, l15_ = lane_ & 15, lq_ = lane_ >> 4;
#define EPI_ROW(mt) (m0 + wm_ * 64 + (mt) * 16 + l15_)
#define EPI_COL(nt) (n0 + wn_ * 64 + 32 * ((nt) >> 1) + 8 * lq_ + 4 * ((nt) & 1))

__device__ __forceinline__ void gemm_store_bf16(const bf16_t* A, int lda, const bf16_t* Bt, int K, int tm, int tn, bf16_t* C, int ldc, char* smem) {
    f32x4 acc[4][4];
    acc_zero<4>(acc);
    const int m0 = tm * 128, n0 = tn * 128;
    gemm_tile_acc<4>(acc, A, lda, Bt, K, K, m0, n0, smem);
    EPI_COORDS
#pragma unroll
    for (int j = 0; j < 2; ++j)
#pragma unroll
        for (int mt = 0; mt < 4; ++mt) {
            u32x4 o;
            o[0] = pack_bf2(acc[2 * j][mt][0], acc[2 * j][mt][1]); o[1] = pack_bf2(acc[2 * j][mt][2], acc[2 * j][mt][3]);
            o[2] = pack_bf2(acc[2 * j + 1][mt][0], acc[2 * j + 1][mt][1]); o[3] = pack_bf2(acc[2 * j + 1][mt][2], acc[2 * j + 1][mt][3]);
            *(u32x4*)(C + (size_t)EPI_ROW(mt) * ldc + EPI_COL(2 * j)) = o;
        }
}

template <int NTN>
__device__ __forceinline__ void gemm_rows_acc(f32x4 (&acc)[NTN][2], float (&ssq)[2], const bf16_t* __restrict__ A, int lda,
                                              const bf16_t* __restrict__ Bt, int ldb, int K, int m0, int n0, char* smem) {
    constexpr int NB_ = NTN / 2;
    int tid = VTID;
    asm volatile("" : "+v"(tid));
    const int lane = tid & 63, w = tid >> 6;
    const int l15 = lane & 15, lq = lane >> 4;
    const int srow = tid >> 3, sch = (tid & 7) ^ ((srow >> 1) & 7);
    const bf16_t* ap = A + (size_t)(m0 + srow) * lda + sch * 8;
    const bf16_t* bp = Bt + (size_t)(n0 + srow) * ldb + sch * 8;
    int KT = K >> 6;
    asm volatile("" : "+s"(KT));
    LAS char* lbase = (LAS char*)smem + w * 1024;
#define GR_STAGE(ST_, KT_) do { \
        _Pragma("unroll") for (int i = 0; i < 4; ++i) \
            __builtin_amdgcn_global_load_lds((const void*)(ap + (size_t)(32 * i) * lda + (KT_) * 64), (LAS void*)(lbase + (ST_) * 32768 + i * 4096), 16, 0, 0); \
        _Pragma("unroll") for (int i = 0; i < NB_; ++i) \
            __builtin_amdgcn_global_load_lds((const void*)(bp + (size_t)(32 * i) * ldb + (KT_) * 64), (LAS void*)(lbase + (ST_) * 32768 + 16384 + i * 4096), 16, 0, 0); } while (0)
    GR_STAGE(0, 0);
    __syncthreads();
    for (int kt = 0; kt < KT; ++kt) {
        if (kt + 1 < KT) GR_STAGE((kt + 1) & 1, kt + 1);
        const char* sa = smem + (kt & 1) * 32768;
        const char* sb = sa + 16384;
#pragma unroll
        for (int ks = 0; ks < 2; ++ks) {
            bf16x8 af[2], bfr[NTN];
#pragma unroll
            for (int mt = 0; mt < 2; ++mt) af[mt] = *(const bf16x8*)(sa + lds_off(w * 32 + mt * 16 + l15, ks * 4 + lq));
#pragma unroll
            for (int nt = 0; nt < NTN; ++nt) bfr[nt] = *(const bf16x8*)(sb + lds_off(nt * 16 + l15, ks * 4 + lq));
#pragma unroll
            for (int mt = 0; mt < 2; ++mt) {
                const u32x4 aw = __builtin_bit_cast(u32x4, af[mt]);
#pragma unroll
                for (int e2 = 0; e2 < 4; ++e2) {
                    const float lo = __uint_as_float(aw[e2] << 16), hi = __uint_as_float(aw[e2] & 0xffff0000u);
                    ssq[mt] += lo * lo + hi * hi;
                }
            }
#pragma unroll
            for (int nt = 0; nt < NTN; ++nt)
#pragma unroll
                for (int mt = 0; mt < 2; ++mt)
                    acc[nt][mt] = __builtin_amdgcn_mfma_f32_16x16x32_bf16(bfr[nt], af[mt], acc[nt][mt], 0, 0, 0);
        }
        __syncthreads();
    }
#undef GR_STAGE
    ssq[0] = xrow_sum(ssq[0]);
    ssq[1] = xrow_sum(ssq[1]);
}

__device__ __forceinline__ void ph_mla_proj(const Params& p, int bid, int nb, char* smem) {
    const int tid = VTID, lane = tid & 63, w = tid >> 6, l15 = lane & 15, lq = lane >> 4;
    float* s_rope = (float*)(smem + 65536);
    float* s_qhn = s_rope + 1024;
    float* s_khn = s_qhn + 96;
    for (int i = tid; i < 1024; i += NTHR) s_rope[i] = p.rope[i];
    if (tid < 96) { s_qhn[tid] = p.qhn_w[tid]; s_khn[tid] = p.khn_w[tid]; }
    __syncthreads();
    const int UQ = 128 * 8, UK = 144 * 8;
    int u;
    for (int it = 0; next_unit(it, UQ + UK, bid, nb, u); ++it) {
        if (u < UQ) {
            const int tm = u >> 3, hh = u & 7;
            const int m0 = NCTX + tm * 128;
            f32x4 acc[6][2];
            float ssq[2] = {0.f, 0.f};
#pragma unroll
            for (int i = 0; i < 6; ++i) { acc[i][0] = (f32x4){0.f, 0.f, 0.f, 0.f}; acc[i][1] = (f32x4){0.f, 0.f, 0.f, 0.f}; }
            gemm_rows_acc<6>(acc, ssq, p.Pa + PA_CQ, PA_W, p.Wt_uq, 384, 384, m0, hh * 96, smem);
#pragma unroll
            for (int mt = 0; mt < 2; ++mt) {
                const int ml = 32 * w + 16 * mt + l15;
                const int rl = tm * 128 + ml;
                const int b = rl >> 11, t = rl & 2047;
                const float rs = rsqrtf(ssq[mt] * (1.f / 384.f) + EPSF);
                float hs = 0.f;
#pragma unroll
                for (int nt = 0; nt < 6; ++nt)
#pragma unroll
                    for (int e = 0; e < 4; ++e) { const float v = acc[nt][mt][e] * rs; acc[nt][mt][e] = v; hs += v * v; }
                hs = xrow_sum(hs);
                const float hr = rsqrtf(hs * (1.f / 96.f) + EPSF) * (0.10206207261596575f * 1.4426950408889634f);
                bf16_t* qd = p.Qb + ((size_t)((b * 8 + hh) * SEQ + t)) * 96 + 4 * lq;
#pragma unroll
                for (int nt = 0; nt < 6; ++nt) {
                    const f32x4 wv = *(const f32x4*)(s_qhn + 16 * nt + 4 * lq);
                    f32x4 v;
#pragma unroll
                    for (int e = 0; e < 4; ++e) v[e] = acc[nt][mt][e] * hr * wv[e];
                    if (nt >= 4) {
                        const int pos = (nt == 4) ? (t >> 6) : (t & 63);
                        const int ph = lq >> 1;
#pragma unroll
                        for (int e = 0; e < 4; ++e) {
                            const float2 cs = *(const float2*)(s_rope + 2 * (pos * 8 + (lq & 1) * 4 + e));
                            const float partner = __shfl_xor(v[e], 32);
                            const float t1 = ph ? partner : v[e], t2 = ph ? v[e] : partner;
                            v[e] = ph ? (t1 * cs.y + t2 * cs.x) : (t1 * cs.x - t2 * cs.y);
                        }
                    }
                    st_bf4(qd + 16 * nt, v);
                }
            }
        } else {
            const int uu = u - UQ;
            const int tm = uu >> 3, hh = uu & 7;
            const int m0 = tm * 128;
            f32x4 acc[8][2];
            float ssq[2] = {0.f, 0.f};
#pragma unroll
            for (int i = 0; i < 8; ++i) { acc[i][0] = (f32x4){0.f, 0.f, 0.f, 0.f}; acc[i][1] = (f32x4){0.f, 0.f, 0.f, 0.f}; }
            gemm_rows_acc<8>(acc, ssq, p.Pa + PA_CKV, PA_W, p.Wt_ukv, 256, 256, m0, hh * 128, smem);
#pragma unroll
            for (int mt = 0; mt < 2; ++mt) {
                const int ml = 32 * w + 16 * mt + l15;
                const int r = m0 + ml;
                int b, pos, t = 0; const bool lat = (r >= NCTX);
                if (!lat) { b = r >> 8; pos = r & 255; }
                else { const int rl = r - NCTX; b = rl >> 11; t = rl & 2047; pos = CTXL + t; }
                const float rs = rsqrtf(ssq[mt] * (1.f / 256.f) + EPSF);
                const u32x4 krw = *(const u32x4*)(p.Pa + (size_t)r * PA_W + PA_KR + 8 * lq);
                float kr[8];
#pragma unroll
                for (int e = 0; e < 4; ++e) { kr[2 * e] = __uint_as_float(krw[e] << 16); kr[2 * e + 1] = __uint_as_float(krw[e] & 0xffff0000u); }
                float hs = 0.f;
#pragma unroll
                for (int e = 0; e < 8; ++e) hs += kr[e] * kr[e];
#pragma unroll
                for (int nt = 0; nt < 4; ++nt)
#pragma unroll
                    for (int e = 0; e < 4; ++e) { const float v = acc[nt][mt][e] * rs; acc[nt][mt][e] = v; hs += v * v; }
                hs = xrow_sum(hs);
                const float hr = rsqrtf(hs * (1.f / 96.f) + EPSF);
                bf16_t* kd = p.Kb + ((size_t)((b * 8 + hh) * TPB + pos)) * 96;
#pragma unroll
                for (int nt = 0; nt < 4; ++nt) {
                    const f32x4 wv = *(const f32x4*)(s_khn + 16 * nt + 4 * lq);
                    f32x4 v;
#pragma unroll
                    for (int e = 0; e < 4; ++e) v[e] = acc[nt][mt][e] * hr * wv[e];
                    st_bf4(kd + 16 * nt + 4 * lq, v);
                }
                {
                    const int ph = lq & 1;
                    const int rp = (lq >> 1) ? (t & 63) : (t >> 6);
                    float o[8];
#pragma unroll
                    for (int e = 0; e < 8; ++e) {
                        const float v = kr[e] * hr * s_khn[64 + 8 * lq + e];
                        const float partner = __shfl_xor(v, 16);
                        float2 cs = make_float2(1.f, 0.f);
                        if (lat) cs = *(const float2*)(s_rope + 2 * (rp * 8 + e));
                        const float t1 = ph ? partner : v, t2 = ph ? v : partner;
                        o[e] = ph ? (t1 * cs.y + t2 * cs.x) : (t1 * cs.x - t2 * cs.y);
                    }
                    u32x4 ov;
                    ov[0] = pack_bf2(o[0], o[1]); ov[1] = pack_bf2(o[2], o[3]); ov[2] = pack_bf2(o[4], o[5]); ov[3] = pack_bf2(o[6], o[7]);
                    *(u32x4*)(kd + 64 + 8 * lq) = ov;
                }
                {
                    const int kpos = (pos & ~12) | ((pos & 4) << 1) | ((pos & 8) >> 1);
                    bf16_t* vd = p.Vt + (size_t)((b * 8 + hh) * 64) * TPB + kpos;
#pragma unroll
                    for (int nt = 4; nt < 8; ++nt)
#pragma unroll
                        for (int e = 0; e < 4; ++e) vd[(size_t)(16 * (nt - 4) + 4 * lq + e) * TPB] = f2bf(acc[nt][mt][e] * rs);
                }
            }
        }
    }
}

typedef float f32x16 __attribute__((ext_vector_type(16)));
#define ATT_KROW 208
#define ATT_VROW 144
#define ATT_KBYTES (64 * ATT_KROW)
#define ATT_STAGE (ATT_KBYTES + 64 * ATT_VROW)
__device__ __forceinline__ float max3_asm(float a, float b, float c) { float r; asm("v_max3_f32 %0, %1, %2, %3" : "=v"(r) : "v"(a), "v"(b), "v"(c)); return r; }
template <bool ZI>
__device__ __forceinline__ void ph_attn_t(const Params& p, int bid, int nb, char* smem, const float negB) {
    const int tid = VTID, lane = tid & 63, w = tid >> 6, r = lane & 31, h = lane >> 5;
    int u;
    for (int it = 0; next_unit(it, 1024, bid, nb, u); ++it) {
        const int bh = u >> 4, qb = u & 15;
        bf16x8 qf[6];
        {
            const bf16_t* Qp = p.Qb + ((size_t)bh * SEQ + qb * 128 + w * 32 + r) * 96 + h * 8;
#pragma unroll
            for (int s = 0; s < 6; ++s) qf[s] = *(const bf16x8*)(Qp + s * 16);
        }
        const bf16_t* Kg = p.Kb + (size_t)bh * TPB * 96 + tid * 8;
        const bf16_t* Vg = p.Vt + (size_t)bh * 64 * TPB + (size_t)(tid >> 3) * TPB + (tid & 7) * 8;
        int koff[3], voff[2];
#pragma unroll
        for (int i = 0; i < 3; ++i) { const int c = tid + 256 * i; koff[i] = (c / 12) * ATT_KROW + (c % 12) * 16; }
#pragma unroll
        for (int i = 0; i < 2; ++i) { const int c = tid + 256 * i; voff[i] = ATT_KBYTES + (c >> 3) * ATT_VROW + (c & 7) * 16; }
        u32x4 rk[3], rv[2];
#pragma unroll
        for (int i = 0; i < 3; ++i) rk[i] = *(const u32x4*)(Kg + i * 2048);
#pragma unroll
        for (int i = 0; i < 2; ++i) rv[i] = *(const u32x4*)(Vg + (size_t)(32 * i) * TPB);
#pragma unroll
        for (int i = 0; i < 3; ++i) *(u32x4*)(smem + koff[i]) = rk[i];
#pragma unroll
        for (int i = 0; i < 2; ++i) *(u32x4*)(smem + voff[i]) = rv[i];
        __syncthreads();
        f32x16 o0, o1;
#pragma unroll
        for (int i = 0; i < 16; ++i) { o0[i] = 0.f; o1[i] = 0.f; }
        float l = 0.f;
        int NKT = TPB / 64;
        asm volatile("" : "+s"(NKT));
        for (int kt = 0; kt < NKT; ++kt) {
            if (kt + 1 < NKT) {
#pragma unroll
                for (int i = 0; i < 3; ++i) rk[i] = *(const u32x4*)(Kg + (size_t)(kt + 1) * 6144 + i * 2048);
#pragma unroll
                for (int i = 0; i < 2; ++i) rv[i] = *(const u32x4*)(Vg + (size_t)(32 * i) * TPB + (kt + 1) * 64);
            }
            const char* sk = smem + (kt & 1) * ATT_STAGE;
            const char* sv = sk + ATT_KBYTES;
            f32x16 s0, s1;
            if (ZI) {
                const f32x16 z16 = {0.f, 0.f, 0.f, 0.f, 0.f, 0.f, 0.f, 0.f, 0.f, 0.f, 0.f, 0.f, 0.f, 0.f, 0.f, 0.f};
                const bf16x8 k0 = *(const bf16x8*)(sk + r * ATT_KROW + h * 16);
                const bf16x8 k1 = *(const bf16x8*)(sk + (32 + r) * ATT_KROW + h * 16);
                s0 = __builtin_amdgcn_mfma_f32_32x32x16_bf16(k0, qf[0], z16, 0, 0, 0);
                s1 = __builtin_amdgcn_mfma_f32_32x32x16_bf16(k1, qf[0], z16, 0, 0, 0);
            } else {
#pragma unroll
                for (int i = 0; i < 16; ++i) { s0[i] = negB; s1[i] = negB; }
            }
#pragma unroll
            for (int s = ZI ? 1 : 0; s < 6; ++s) {
                const bf16x8 k0 = *(const bf16x8*)(sk + r * ATT_KROW + (2 * s + h) * 16);
                const bf16x8 k1 = *(const bf16x8*)(sk + (32 + r) * ATT_KROW + (2 * s + h) * 16);
                s0 = __builtin_amdgcn_mfma_f32_32x32x16_bf16(k0, qf[s], s0, 0, 0, 0);
                s1 = __builtin_amdgcn_mfma_f32_32x32x16_bf16(k1, qf[s], s1, 0, 0, 0);
            }
            float ls = 0.f;
#pragma unroll
            for (int i = 0; i < 16; ++i) {
                s0[i] = __builtin_amdgcn_exp2f(s0[i]);
                s1[i] = __builtin_amdgcn_exp2f(s1[i]);
                ls += s0[i] + s1[i];
            }
            l += ls;
#pragma unroll
            for (int ks = 0; ks < 4; ++ks) {
                u32x4 pw;
                if (ks < 2) {
                    pw[0] = pack_bf2(s0[8 * (ks & 1) + 0], s0[8 * (ks & 1) + 1]); pw[1] = pack_bf2(s0[8 * (ks & 1) + 2], s0[8 * (ks & 1) + 3]);
                    pw[2] = pack_bf2(s0[8 * (ks & 1) + 4], s0[8 * (ks & 1) + 5]); pw[3] = pack_bf2(s0[8 * (ks & 1) + 6], s0[8 * (ks & 1) + 7]);
                } else {
                    pw[0] = pack_bf2(s1[8 * (ks & 1) + 0], s1[8 * (ks & 1) + 1]); pw[1] = pack_bf2(s1[8 * (ks & 1) + 2], s1[8 * (ks & 1) + 3]);
                    pw[2] = pack_bf2(s1[8 * (ks & 1) + 4], s1[8 * (ks & 1) + 5]); pw[3] = pack_bf2(s1[8 * (ks & 1) + 6], s1[8 * (ks & 1) + 7]);
                }
                const bf16x8 pf = __builtin_bit_cast(bf16x8, pw);
                const bf16x8 v0 = *(const bf16x8*)(sv + r * ATT_VROW + (2 * ks + h) * 16);
                const bf16x8 v1 = *(const bf16x8*)(sv + (32 + r) * ATT_VROW + (2 * ks + h) * 16);
                o0 = __builtin_amdgcn_mfma_f32_32x32x16_bf16(v0, pf, o0, 0, 0, 0);
                o1 = __builtin_amdgcn_mfma_f32_32x32x16_bf16(v1, pf, o1, 0, 0, 0);
            }
            if (kt + 1 < NKT) {
                char* ds = smem + ((kt + 1) & 1) * ATT_STAGE;
#pragma unroll
                for (int i = 0; i < 3; ++i) *(u32x4*)(ds + koff[i]) = rk[i];
#pragma unroll
                for (int i = 0; i < 2; ++i) *(u32x4*)(ds + voff[i]) = rv[i];
            }
            __syncthreads();
        }
        l += __shfl_xor(l, 32);
        const float inv = 1.f / l;
        const int b = bh >> 3, hh = bh & 7;
        const size_t rl = (size_t)(b * SEQ + qb * 128 + w * 32 + r);
        bf16_t* op = p.A_mla + rl * 512 + hh * 64 + 4 * h;
        const bf16_t* zp = p.Pz + rl * PZ_W + hh * 64 + 4 * h;
#pragma unroll
        for (int g = 0; g < 4; ++g) {
            const f32x4 z0 = ld_bf4(zp + 8 * g), z1 = ld_bf4(zp + 32 + 8 * g);
            uint2 a, c;
            a.x = pack_bf2(o0[4 * g + 0] * inv * silu_f(z0[0]), o0[4 * g + 1] * inv * silu_f(z0[1]));
            a.y = pack_bf2(o0[4 * g + 2] * inv * silu_f(z0[2]), o0[4 * g + 3] * inv * silu_f(z0[3]));
            c.x = pack_bf2(o1[4 * g + 0] * inv * silu_f(z1[0]), o1[4 * g + 1] * inv * silu_f(z1[1]));
            c.y = pack_bf2(o1[4 * g + 2] * inv * silu_f(z1[2]), o1[4 * g + 3] * inv * silu_f(z1[3]));
            *(uint2*)(op + 8 * g) = a;
            *(uint2*)(op + 32 + 8 * g) = c;
        }
    }
}

template <bool ZI>
__device__ __forceinline__ void ph_attn_d(const Params& p, int bid, int nb, char* smem, const float negB) {
    const int tid = VTID, lane = tid & 63, w = tid >> 6, r = lane & 31, h = lane >> 5;
    int u;
    for (int it = 0; next_unit(it, 512, bid, nb, u); ++it) {
        const int bh = u >> 3, qb = u & 7;
        bf16x8 qf[2][6];
#pragma unroll
        for (int t = 0; t < 2; ++t) {
            const bf16_t* Qp = p.Qb + ((size_t)bh * SEQ + qb * 256 + w * 64 + t * 32 + r) * 96 + h * 8;
#pragma unroll
            for (int s = 0; s < 6; ++s) qf[t][s] = *(const bf16x8*)(Qp + s * 16);
        }
        const bf16_t* Kg = p.Kb + (size_t)bh * TPB * 96 + tid * 8;
        const bf16_t* Vg = p.Vt + (size_t)bh * 64 * TPB + (size_t)(tid >> 3) * TPB + (tid & 7) * 8;
        int koff[3], voff[2];
#pragma unroll
        for (int i = 0; i < 3; ++i) { const int c = tid + 256 * i; koff[i] = (c / 12) * ATT_KROW + (c % 12) * 16; }
#pragma unroll
        for (int i = 0; i < 2; ++i) { const int c = tid + 256 * i; voff[i] = ATT_KBYTES + (c >> 3) * ATT_VROW + (c & 7) * 16; }
        u32x4 rk[3], rv[2];
#pragma unroll
        for (int i = 0; i < 3; ++i) rk[i] = *(const u32x4*)(Kg + i * 2048);
#pragma unroll
        for (int i = 0; i < 2; ++i) rv[i] = *(const u32x4*)(Vg + (size_t)(32 * i) * TPB);
#pragma unroll
        for (int i = 0; i < 3; ++i) *(u32x4*)(smem + koff[i]) = rk[i];
#pragma unroll
        for (int i = 0; i < 2; ++i) *(u32x4*)(smem + voff[i]) = rv[i];
        __syncthreads();
        f32x16 o[2][2];
#pragma unroll
        for (int t = 0; t < 2; ++t)
#pragma unroll
            for (int i = 0; i < 16; ++i) { o[t][0][i] = 0.f; o[t][1][i] = 0.f; }
        float l[2] = {0.f, 0.f};
        int NKT = TPB / 64;
        asm volatile("" : "+s"(NKT));
        for (int kt = 0; kt < NKT; ++kt) {
            if (kt + 1 < NKT) {
#pragma unroll
                for (int i = 0; i < 3; ++i) rk[i] = *(const u32x4*)(Kg + (size_t)(kt + 1) * 6144 + i * 2048);
#pragma unroll
                for (int i = 0; i < 2; ++i) rv[i] = *(const u32x4*)(Vg + (size_t)(32 * i) * TPB + (kt + 1) * 64);
            }
            const char* sk = smem + (kt & 1) * ATT_STAGE;
            const char* sv = sk + ATT_KBYTES;
            int NHF = 2;
            asm volatile("" : "+s"(NHF));
            for (int hf = 0; hf < NHF; ++hf) {
                const char* skh = sk + hf * 32 * ATT_KROW;
                f32x16 s[2];
                if (ZI) {
                    const f32x16 z16 = {0.f, 0.f, 0.f, 0.f, 0.f, 0.f, 0.f, 0.f, 0.f, 0.f, 0.f, 0.f, 0.f, 0.f, 0.f, 0.f};
                    const bf16x8 k0 = *(const bf16x8*)(skh + r * ATT_KROW + h * 16);
                    s[0] = __builtin_amdgcn_mfma_f32_32x32x16_bf16(k0, qf[0][0], z16, 0, 0, 0);
                    s[1] = __builtin_amdgcn_mfma_f32_32x32x16_bf16(k0, qf[1][0], z16, 0, 0, 0);
                } else {
#pragma unroll
                    for (int i = 0; i < 16; ++i) { s[0][i] = negB; s[1][i] = negB; }
                }
#pragma unroll
                for (int ss = ZI ? 1 : 0; ss < 6; ++ss) {
                    const bf16x8 k0 = *(const bf16x8*)(skh + r * ATT_KROW + (2 * ss + h) * 16);
                    s[0] = __builtin_amdgcn_mfma_f32_32x32x16_bf16(k0, qf[0][ss], s[0], 0, 0, 0);
                    s[1] = __builtin_amdgcn_mfma_f32_32x32x16_bf16(k0, qf[1][ss], s[1], 0, 0, 0);
                }
                bf16x8 pf[2][2];
#pragma unroll
                for (int t = 0; t < 2; ++t) {
                    float ls = 0.f;
#pragma unroll
                    for (int i = 0; i < 16; ++i) {
                        s[t][i] = __builtin_amdgcn_exp2f(s[t][i]);
                        ls += s[t][i];
                    }
                    l[t] += ls;
#pragma unroll
                    for (int ks = 0; ks < 2; ++ks) {
                        u32x4 pw;
#pragma unroll
                        for (int e = 0; e < 4; ++e) pw[e] = pack_bf2(s[t][8 * ks + 2 * e], s[t][8 * ks + 2 * e + 1]);
                        pf[t][ks] = __builtin_bit_cast(bf16x8, pw);
                    }
                }
#pragma unroll
                for (int ks = 0; ks < 2; ++ks) {
                    const bf16x8 v0 = *(const bf16x8*)(sv + r * ATT_VROW + (2 * (2 * hf + ks) + h) * 16);
                    const bf16x8 v1 = *(const bf16x8*)(sv + (32 + r) * ATT_VROW + (2 * (2 * hf + ks) + h) * 16);
#pragma unroll
                    for (int t = 0; t < 2; ++t) {
                        o[t][0] = __builtin_amdgcn_mfma_f32_32x32x16_bf16(v0, pf[t][ks], o[t][0], 0, 0, 0);
                        o[t][1] = __builtin_amdgcn_mfma_f32_32x32x16_bf16(v1, pf[t][ks], o[t][1], 0, 0, 0);
                    }
                }
            }
            if (kt + 1 < NKT) {
                char* ds = smem + ((kt + 1) & 1) * ATT_STAGE;
#pragma unroll
                for (int i = 0; i < 3; ++i) *(u32x4*)(ds + koff[i]) = rk[i];
#pragma unroll
                for (int i = 0; i < 2; ++i) *(u32x4*)(ds + voff[i]) = rv[i];
            }
            __syncthreads();
        }
        const int b = bh >> 3, hh = bh & 7;
#pragma unroll
        for (int t = 0; t < 2; ++t) {
            const float lt = l[t] + __shfl_xor(l[t], 32);
            const float inv = 1.f / lt;
            const size_t rl = (size_t)(b * SEQ + qb * 256 + w * 64 + t * 32 + r);
            bf16_t* op = p.A_mla + rl * 512 + hh * 64 + 4 * h;
            const bf16_t* zp = p.Pz + rl * PZ_W + hh * 64 + 4 * h;
#pragma unroll
            for (int g = 0; g < 4; ++g) {
                const f32x4 z0 = ld_bf4(zp + 8 * g), z1 = ld_bf4(zp + 32 + 8 * g);
                uint2 a, c;
                a.x = pack_bf2(o[t][0][4 * g + 0] * inv * silu_f(z0[0]), o[t][0][4 * g + 1] * inv * silu_f(z0[1]));
                a.y = pack_bf2(o[t][0][4 * g + 2] * inv * silu_f(z0[2]), o[t][0][4 * g + 3] * inv * silu_f(z0[3]));
                c.x = pack_bf2(o[t][1][4 * g + 0] * inv * silu_f(z1[0]), o[t][1][4 * g + 1] * inv * silu_f(z1[1]));
                c.y = pack_bf2(o[t][1][4 * g + 2] * inv * silu_f(z1[2]), o[t][1][4 * g + 3] * inv * silu_f(z1[3]));
                *(uint2*)(op + 8 * g) = a;
                *(uint2*)(op + 32 + 8 * g) = c;
            }
        }
    }
}

#define AT8_VROW 272
#define AT8_KBYTES (128 * ATT_KROW)
#define AT8_STAGE (AT8_KBYTES + 64 * AT8_VROW)
__device__ __forceinline__ void ph_attn8(const Params& p, char* smem, const int pb) {
    int tid = threadIdx.x;
    asm volatile("" : "+v"(tid));
    const int lane = tid & 63, w = tid >> 6, r = lane & 31, h = lane >> 5;
    const int bh = (pb >> 5) * 8 + (pb & 7), qb = (pb >> 3) & 3;
    bf16x8 qf[2][6];
#pragma unroll
    for (int t = 0; t < 2; ++t) {
        const bf16_t* Qp = p.Qb + ((size_t)bh * SEQ + qb * 512 + w * 64 + t * 32 + r) * 96 + h * 8;
#pragma unroll
        for (int s = 0; s < 6; ++s) qf[t][s] = *(const bf16x8*)(Qp + s * 16);
    }
    const bf16_t* Kg = p.Kb + (size_t)bh * TPB * 96 + tid * 8;
    const bf16_t* Vg = p.Vt + (size_t)bh * 64 * TPB + (size_t)(tid >> 4) * TPB + (tid & 15) * 8;
    int koff[3], voff[2];
#pragma unroll
    for (int i = 0; i < 3; ++i) { const int c = tid + 512 * i; koff[i] = (c / 12) * ATT_KROW + (c % 12) * 16; }
#pragma unroll
    for (int i = 0; i < 2; ++i) { const int c = tid + 512 * i; voff[i] = AT8_KBYTES + (c >> 4) * AT8_VROW + (c & 15) * 16; }
    u32x4 rk[3], rv[2];
#pragma unroll
    for (int i = 0; i < 3; ++i) rk[i] = *(const u32x4*)(Kg + i * 4096);
#pragma unroll
    for (int i = 0; i < 2; ++i) rv[i] = *(const u32x4*)(Vg + (size_t)(32 * i) * TPB);
#pragma unroll
    for (int i = 0; i < 3; ++i) *(u32x4*)(smem + koff[i]) = rk[i];
#pragma unroll
    for (int i = 0; i < 2; ++i) *(u32x4*)(smem + voff[i]) = rv[i];
    __syncthreads();
    f32x16 o[2][2];
#pragma unroll
    for (int t = 0; t < 2; ++t)
#pragma unroll
        for (int i = 0; i < 16; ++i) { o[t][0][i] = 0.f; o[t][1][i] = 0.f; }
    float l[2] = {0.f, 0.f};
    int NKT = TPB / 128;
    asm volatile("" : "+s"(NKT));
    for (int kt = 0; kt < NKT; ++kt) {
        if (kt + 1 < NKT) {
#pragma unroll
            for (int i = 0; i < 3; ++i) rk[i] = *(const u32x4*)(Kg + (size_t)(kt + 1) * 12288 + i * 4096);
#pragma unroll
            for (int i = 0; i < 2; ++i) rv[i] = *(const u32x4*)(Vg + (size_t)(32 * i) * TPB + (kt + 1) * 128);
        }
        const char* sk = smem + (kt & 1) * AT8_STAGE;
        const char* sv = sk + AT8_KBYTES;
        int NHF = 4;
        asm volatile("" : "+s"(NHF));
        for (int hf = 0; hf < NHF; ++hf) {
            const char* skh = sk + hf * 32 * ATT_KROW;
            const char* svh = sv + hf * 64;
            f32x16 s[2];
            {
                const f32x16 z16 = {0.f, 0.f, 0.f, 0.f, 0.f, 0.f, 0.f, 0.f, 0.f, 0.f, 0.f, 0.f, 0.f, 0.f, 0.f, 0.f};
                const bf16x8 k0 = *(const bf16x8*)(skh + r * ATT_KROW + h * 16);
                s[0] = __builtin_amdgcn_mfma_f32_32x32x16_bf16(k0, qf[0][0], z16, 0, 0, 0);
                s[1] = __builtin_amdgcn_mfma_f32_32x32x16_bf16(k0, qf[1][0], z16, 0, 0, 0);
            }
#pragma unroll
            for (int ss = 1; ss < 6; ++ss) {
                const bf16x8 k0 = *(const bf16x8*)(skh + r * ATT_KROW + (2 * ss + h) * 16);
                s[0] = __builtin_amdgcn_mfma_f32_32x32x16_bf16(k0, qf[0][ss], s[0], 0, 0, 0);
                s[1] = __builtin_amdgcn_mfma_f32_32x32x16_bf16(k0, qf[1][ss], s[1], 0, 0, 0);
            }
            bf16x8 pf[2][2];
#pragma unroll
            for (int t = 0; t < 2; ++t) {
                float ls = 0.f;
#pragma unroll
                for (int i = 0; i < 16; ++i) {
                    s[t][i] = __builtin_amdgcn_exp2f(s[t][i]);
                    ls += s[t][i];
                }
                l[t] += ls;
#pragma unroll
                for (int ks = 0; ks < 2; ++ks) {
                    u32x4 pw;
#pragma unroll
                    for (int e = 0; e < 4; ++e) pw[e] = pack_bf2(s[t][8 * ks + 2 * e], s[t][8 * ks + 2 * e + 1]);
                    pf[t][ks] = __builtin_bit_cast(bf16x8, pw);
                }
            }
#pragma unroll
            for (int ks = 0; ks < 2; ++ks) {
                const bf16x8 v0 = *(const bf16x8*)(svh + r * AT8_VROW + (2 * ks + h) * 16);
                const bf16x8 v1 = *(const bf16x8*)(svh + (32 + r) * AT8_VROW + (2 * ks + h) * 16);
#pragma unroll
                for (int t = 0; t < 2; ++t) {
                    o[t][0] = __builtin_amdgcn_mfma_f32_32x32x16_bf16(v0, pf[t][ks], o[t][0], 0, 0, 0);
                    o[t][1] = __builtin_amdgcn_mfma_f32_32x32x16_bf16(v1, pf[t][ks], o[t][1], 0, 0, 0);
                }
            }
        }
        if (kt + 1 < NKT) {
            char* ds = smem + ((kt + 1) & 1) * AT8_STAGE;
#pragma unroll
            for (int i = 0; i < 3; ++i) *(u32x4*)(ds + koff[i]) = rk[i];
#pragma unroll
            for (int i = 0; i < 2; ++i) *(u32x4*)(ds + voff[i]) = rv[i];
        }
        __syncthreads();
    }
    const int b = bh >> 3, hh = bh & 7;
#pragma unroll
    for (int t = 0; t < 2; ++t) {
        const float lt = l[t] + __shfl_xor(l[t], 32);
        const float inv = 1.f / lt;
        const size_t rl = (size_t)(b * SEQ + qb * 512 + w * 64 + t * 32 + r);
        bf16_t* op = p.A_mla + rl * 512 + hh * 64 + 4 * h;
        const bf16_t* zp = p.Pz + rl * PZ_W + hh * 64 + 4 * h;
#pragma unroll
        for (int g = 0; g < 4; ++g) {
            const f32x4 z0 = ld_bf4(zp + 8 * g), z1 = ld_bf4(zp + 32 + 8 * g);
            uint2 a, c;
            a.x = pack_bf2(o[t][0][4 * g + 0] * inv * silu_f(z0[0]), o[t][0][4 * g + 1] * inv * silu_f(z0[1]));
            a.y = pack_bf2(o[t][0][4 * g + 2] * inv * silu_f(z0[2]), o[t][0][4 * g + 3] * inv * silu_f(z0[3]));
            c.x = pack_bf2(o[t][1][4 * g + 0] * inv * silu_f(z1[0]), o[t][1][4 * g + 1] * inv * silu_f(z1[1]));
            c.y = pack_bf2(o[t][1][4 * g + 2] * inv * silu_f(z1[2]), o[t][1][4 * g + 3] * inv * silu_f(z1[3]));
            *(uint2*)(op + 8 * g) = a;
            *(uint2*)(op + 32 + 8 * g) = c;
        }
    }
}

__device__ __forceinline__ void ph_attn(const Params& p, int bid, int nb, char* smem, char* smem_all, int pb) {
    const int lane = VTID & 63;
    float mq = fmaxf(fabsf(p.qhn_w[lane]), (lane < 32) ? fabsf(p.qhn_w[64 + lane]) : 0.f);
    float mk = fmaxf(fabsf(p.khn_w[lane]), (lane < 32) ? fabsf(p.khn_w[64 + lane]) : 0.f);
#pragma unroll
    for (int o = 32; o > 0; o >>= 1) { mq = fmaxf(mq, __shfl_xor(mq, o)); mk = fmaxf(mk, __shfl_xor(mk, o)); }
    const float B = (9.797958971f * 1.4426950408889634f * 1.0001f) * mq * mk;
    if (B <= 40.f) ph_attn8(p, smem_all, pb);
    else ph_attn_t<false>(p, bid, nb, smem, -B);
}

__device__ __forceinline__ int el_off(int row, int col) { return lds_off(row, col >> 3) + (col & 7) * 2; }

__device__ __forceinline__ void mm64(f32x4 (&acc)[4], const char* A, int arow0, const char* B, int l15, int lq) {
#pragma unroll
    for (int ks = 0; ks < 2; ++ks) {
        const bf16x8 a = *(const bf16x8*)(A + lds_off(arow0 + l15, ks * 4 + lq));
#pragma unroll
        for (int nt = 0; nt < 4; ++nt) {
            const bf16x8 b = *(const bf16x8*)(B + lds_off(nt * 16 + l15, ks * 4 + lq));
            acc[nt] = __builtin_amdgcn_mfma_f32_16x16x32_bf16(a, b, acc[nt], 0, 0, 0);
        }
    }
}
__device__ __forceinline__ void acc4_zero(f32x4 (&a)[4]) {
#pragma unroll
    for (int i = 0; i < 4; ++i) a[i] = (f32x4){0.f, 0.f, 0.f, 0.f};
}

#define DN_SQ 0
#define DN_SK 8192
#define DN_SV 16384
#define DN_LSTR 65
#define DN_LBYTES (64 * DN_LSTR * 4)
#define DN_SL 24576
#define DN_SA 57856
#define DN_SKD 66048
#define DN_SS 74240

typedef short s16x4 __attribute__((ext_vector_type(4)));
__device__ __forceinline__ s16x4 ds_tr(const char* p) { return __builtin_amdgcn_ds_read_tr16_b64_v4i16((LAS s16x4*)p); }

struct Dn1In { u32x4 rp[7]; float db, da, dtb, alog; float cw[4]; };
__device__ __forceinline__ void dn1_fetch(Dn1In& in, const Params& p, int u, int tid) {
    const int bh = u / 36, pb = u % 36, b = bh >> 3, h = bh & 7;
    int rowbase, seglen, lb;
    if (pb < 4) { rowbase = b * CTXL; seglen = CTXL; lb = pb; }
    else { rowbase = NCTX + b * SEQ; seglen = SEQ; lb = pb - 4; }
#pragma unroll
    for (int i = 0; i < 7; ++i) {
        const int c = tid + NTHR * i;
        const int g = c / 544, rem = c % 544, rr = rem >> 3, ch = rem & 7;
        const int lp = lb * 64 - 2 + rr;
        u32x4 val = (u32x4){0u, 0u, 0u, 0u};
        if (c < 3 * 68 * 8 && lp >= 0 && lp < seglen) val = *(const u32x4*)(p.Pa + (size_t)(rowbase + lp) * PA_W + PA_DQ + h * 192 + g * 64 + ch * 8);
        in.rp[i] = val;
    }
#pragma unroll
    for (int i = 0; i < 4; ++i) {
        const int idx = tid + NTHR * i, g = idx / 320, j = (idx % 320) >> 6, c = idx & 63;
        in.cw[i] = (idx < 960) ? p.conv_w[j * 1536 + g * 512 + h * 64 + c] : 0.f;
    }
    in.db = 0.f; in.da = 0.f; in.dtb = 0.f; in.alog = 0.f;
    if (tid < 128) {
        in.dtb = p.dt_bias[(tid >> 6) * 8 + h]; in.alog = p.a_log[(tid >> 6) * 8 + h];
        const int d = tid >> 6, tp = tid & 63;
        const int pos = d ? 63 - tp : tp;
        const bf16_t* row = p.Pa + (size_t)(rowbase + lb * 64 + pos) * PA_W;
        in.db = bf2f(row[PA_DB + d * 8 + h]);
        in.da = bf2f(row[PA_DA + d * 8 + h]);
    }
}

__device__ __forceinline__ void ph_dn1(const Params& p, int bid, int nb, char* smem) {
    char* sQ = smem + DN_SQ; char* sK = smem + DN_SK; char* sV = smem + DN_SV;
    char* sL = smem + DN_SL; char* sA = smem + DN_SA; char* sKd = smem + DN_SKD;
    float* sS = (float*)(smem + DN_SS);
    const int x_ = bid & 7, li_ = bid >> 3;
#define DN1_UNIT(IT, U, VALID) do { const int it_ = (IT); const int q_ = li_ + (it_ < 4 ? it_ * 64 : 0); const int grp_ = x_ + 8 * (q_ >> 3); \
        VALID = (it_ < 4) || (it_ == 4 && li_ < 32); \
        const int b_ = (it_ < 4) ? (grp_ >> 5) : (grp_ >> 2), pb_ = (it_ < 4) ? 4 + (grp_ & 31) : (grp_ & 3); U = (b_ * 8 + (q_ & 7)) * 36 + pb_; } while (0)
    Dn1In in;
    int u, un; bool valid, validn;
    DN1_UNIT(0, u, valid);
    if (valid) dn1_fetch(in, p, u, VTID);
    for (int it = 0; valid; ++it, u = un, valid = validn) {
        DN1_UNIT(it + 1, un, validn);
        int tid = VTID;
        asm volatile("" : "+v"(tid));
        const int lane = tid & 63, w = tid >> 6, l15 = lane & 15, lq = lane >> 4;
        const int bh = u / 36, pb = u % 36, h = bh & 7;
        const bool lat = (pb >= 4);
        if (tid < 128) {
            const int d = tid >> 6, tp = lane;
            const float xx = in.da + in.dtb;
            const float sp = (xx > 20.f) ? xx : log1pf(__expf(xx));
            const float g = -__expf(in.alog) * sp;
            float gc = g;
#pragma unroll
            for (int o = 1; o < 64; o <<= 1) { const float t = __shfl_up(gc, o); if (lane >= o) gc += t; }
            const float gl = __shfl(gc, 63);
            const float bt = sigmoid_f(in.db), eg = __expf(gc);
            sS[(d * 5 + 0) * 64 + tp] = bt;
            sS[(d * 5 + 1) * 64 + tp] = gc;
            sS[(d * 5 + 2) * 64 + tp] = eg;
            sS[(d * 5 + 3) * 64 + tp] = __expf(gl - gc);
            sS[(d * 5 + 4) * 64 + tp] = bt * eg;
        }
        {
            char* raw = sL;
#pragma unroll
            for (int i = 0; i < 7; ++i) {
                const int c = tid + NTHR * i;
                const int g = c / 544, rem = c % 544, rr = rem >> 3, ch = rem & 7;
                if (c < 3 * 68 * 8) *(u32x4*)(raw + (g * 68 + rr) * 128 + ch * 16) = in.rp[i];
            }
            float* cwS = (float*)(sL + 26112);
#pragma unroll
            for (int i = 0; i < 4; ++i) { const int idx = tid + NTHR * i; if (idx < 960) cwS[idx] = in.cw[i]; }
            if (validn) dn1_fetch(in, p, un, tid);
            __syncthreads();
            const int o = tid & 7, r0 = tid >> 3;
#pragma unroll
            for (int g = 0; g < 3; ++g) {
                if (g == 0 && !lat) continue;
                float wj[5][8];
#pragma unroll
                for (int j = 0; j < 5; ++j) {
                    const f32x4 w0 = *(const f32x4*)(cwS + (g * 5 + j) * 64 + 8 * o), w1 = *(const f32x4*)(cwS + (g * 5 + j) * 64 + 8 * o + 4);
#pragma unroll
                    for (int e2 = 0; e2 < 4; ++e2) { wj[j][e2] = w0[e2]; wj[j][4 + e2] = w1[e2]; }
                }
#pragma unroll
                for (int hh = 0; hh < 2; ++hh) {
                    const int rr = r0 + 32 * hh;
                    float a[8];
#pragma unroll
                    for (int e2 = 0; e2 < 8; ++e2) a[e2] = 0.f;
#pragma unroll
                    for (int j = 0; j < 5; ++j) {
                        const u32x4 dv = *(const u32x4*)(raw + (g * 68 + rr + j) * 128 + o * 16);
#pragma unroll
                        for (int e2 = 0; e2 < 4; ++e2) {
                            a[2 * e2] += __uint_as_float(dv[e2] << 16) * wj[j][2 * e2];
                            a[2 * e2 + 1] += __uint_as_float(dv[e2] & 0xffff0000u) * wj[j][2 * e2 + 1];
                        }
                    }
                    float ss = 0.f;
#pragma unroll
                    for (int e2 = 0; e2 < 8; ++e2) { a[e2] = silu_f(a[e2]); ss += a[e2] * a[e2]; }
                    float sc = 1.f;
                    if (g < 2) {
                        ss += dpp_mov<0xB1>(ss); ss += dpp_mov<0x4E>(ss); ss += dpp_mov<0x141>(ss);
                        sc = rsqrtf(ss + EPSF) * (g == 0 ? 0.125f : 1.f);
                    }
                    u32x4 ov;
#pragma unroll
                    for (int e2 = 0; e2 < 4; ++e2) ov[e2] = pack_bf2(a[2 * e2] * sc, a[2 * e2 + 1] * sc);
                    *(u32x4*)((g == 0 ? sQ : g == 1 ? sK : sV) + lds_off(rr, o)) = ov;
                }
            }
            __syncthreads();
        }
        {
            f32x4 G[4];
            acc4_zero(G);
            mm64(G, sK, 16 * w, sK, l15, lq);
            float* L0 = (float*)sL; float* L1 = (float*)(sL + DN_LBYTES);
            const float* be0 = sS + 0 * 64; const float* gc0 = sS + 1 * 64;
            const float* be1 = sS + 5 * 64; const float* gc1 = sS + 6 * 64;
#pragma unroll
            for (int nt = 0; nt < 4; ++nt)
#pragma unroll
                for (int rg = 0; rg < 4; ++rg) {
                    const int t = 16 * w + 4 * lq + rg, s = 16 * nt + l15;
                    const float gv = G[nt][rg];
                    const int tp = 63 - t, sp = 63 - s;
                    L0[t * DN_LSTR + s] = (s < t) ? be0[t] * gv * __expf(gc0[t] - gc0[s]) : 0.f;
                    L1[tp * DN_LSTR + sp] = (s > t) ? be1[tp] * gv * __expf(gc1[tp] - gc1[sp]) : 0.f;
                }
            __syncthreads();
        }
        {
            int tid3 = tid;
            asm volatile("" : "+v"(tid3) :: "memory");
            const int lane3 = tid3 & 63, w3 = tid3 >> 6, l15c = lane3 & 15, lqc = lane3 >> 4;
            if (tid3 < 128) {
                float* Lb = (float*)(sL + w3 * DN_LBYTES) + (16 * lqc) * DN_LSTR + 16 * lqc;
                float x[16];
#pragma unroll
                for (int i = 0; i < 16; ++i) {
                    float v = (i == l15c) ? 1.f : 0.f;
#pragma unroll
                    for (int j = 0; j < i; ++j) v -= Lb[i * DN_LSTR + j] * x[j];
                    x[i] = v;
                }
#pragma unroll
                for (int i = 0; i < 16; ++i) Lb[i * DN_LSTR + l15c] = x[i];
            }
            __syncthreads();
            {
                const int d = w3 >> 1, pr = w3 & 1, b0 = 2 * pr, b1 = 2 * pr + 1;
                float* Ld = (float*)(sL + d * DN_LBYTES);
                float* scr = (float*)(sA) + w3 * 272;
                f32x4 P = (f32x4){0.f, 0.f, 0.f, 0.f};
#pragma unroll
                for (int kk = 0; kk < 4; ++kk)
                    P = __builtin_amdgcn_mfma_f32_16x16x4f32(Ld[(16 * b1 + l15c) * DN_LSTR + 16 * b0 + 4 * kk + lqc],
                                                            Ld[(16 * b0 + 4 * kk + lqc) * DN_LSTR + 16 * b0 + l15c], P, 0, 0, 0);
#pragma unroll
                for (int rg = 0; rg < 4; ++rg) scr[(4 * lqc + rg) * 17 + l15c] = P[rg];
                f32x4 R = (f32x4){0.f, 0.f, 0.f, 0.f};
#pragma unroll
                for (int kk = 0; kk < 4; ++kk)
                    R = __builtin_amdgcn_mfma_f32_16x16x4f32(Ld[(16 * b1 + l15c) * DN_LSTR + 16 * b1 + 4 * kk + lqc],
                                                            scr[(4 * kk + lqc) * 17 + l15c], R, 0, 0, 0);
#pragma unroll
                for (int rg = 0; rg < 4; ++rg) Ld[(16 * b1 + 4 * lqc + rg) * DN_LSTR + 16 * b0 + l15c] = -R[rg];
            }
            __syncthreads();
            {
                const int d = w3 >> 1, hf = w3 & 1;
                float* Ld = (float*)(sL + d * DN_LBYTES);
                float* scr2 = (float*)(d ? sKd : sA);
                f32x4 P2[2];
                P2[0] = (f32x4){0.f, 0.f, 0.f, 0.f}; P2[1] = (f32x4){0.f, 0.f, 0.f, 0.f};
#pragma unroll
                for (int kk = 0; kk < 8; ++kk) {
                    const float a = Ld[(32 + 16 * hf + l15c) * DN_LSTR + 4 * kk + lqc];
#pragma unroll
                    for (int n2 = 0; n2 < 2; ++n2)
                        P2[n2] = __builtin_amdgcn_mfma_f32_16x16x4f32(a, Ld[(4 * kk + lqc) * DN_LSTR + 16 * n2 + l15c], P2[n2], 0, 0, 0);
                }
#pragma unroll
                for (int n2 = 0; n2 < 2; ++n2)
#pragma unroll
                    for (int rg = 0; rg < 4; ++rg) scr2[(16 * hf + 4 * lqc + rg) * 33 + 16 * n2 + l15c] = P2[n2][rg];
                __syncthreads();
                f32x4 R2[2];
                R2[0] = (f32x4){0.f, 0.f, 0.f, 0.f}; R2[1] = (f32x4){0.f, 0.f, 0.f, 0.f};
#pragma unroll
                for (int kk = 0; kk < 8; ++kk) {
                    const float a = Ld[(32 + 16 * hf + l15c) * DN_LSTR + 32 + 4 * kk + lqc];
#pragma unroll
                    for (int n2 = 0; n2 < 2; ++n2)
                        R2[n2] = __builtin_amdgcn_mfma_f32_16x16x4f32(a, scr2[(4 * kk + lqc) * 33 + 16 * n2 + l15c], R2[n2], 0, 0, 0);
                }
#pragma unroll
                for (int n2 = 0; n2 < 2; ++n2)
#pragma unroll
                    for (int rg = 0; rg < 4; ++rg) Ld[(32 + 16 * hf + 4 * lqc + rg) * DN_LSTR + 16 * n2 + l15c] = -R2[n2][rg];
            }
            __syncthreads();
#pragma unroll 1
            for (int d = 0; d < 2; ++d) {
                const float* Td = (const float*)(sL + d * DN_LBYTES);
                {
                    const int tr = tid3 >> 2, cq = tid3 & 3;
                    const float* c1 = sS + (d * 5 + 0) * 64 + 16 * cq;
                    const float* c2 = sS + (d * 5 + 4) * 64 + 16 * cq;
                    const float* trow = Td + tr * DN_LSTR + 16 * cq;
                    float tv[16];
#pragma unroll
                    for (int e2 = 0; e2 < 16; ++e2) tv[e2] = trow[e2];
#pragma unroll
                    for (int q = 0; q < 2; ++q) {
                        u32x4 o1, o2;
#pragma unroll
                        for (int e2 = 0; e2 < 4; ++e2) {
                            const int i0 = 8 * q + 2 * e2;
                            o1[e2] = pack_bf2(tv[i0] * c1[i0], tv[i0 + 1] * c1[i0 + 1]);
                            o2[e2] = pack_bf2(tv[i0] * c2[i0], tv[i0 + 1] * c2[i0 + 1]);
                        }
                        *(u32x4*)(sA + lds_off(tr, 2 * cq + q)) = o1;
                        *(u32x4*)(sKd + lds_off(tr, 2 * cq + q)) = o2;
                    }
                }
                __syncthreads();
                f32x4 U[4], W[4];
                acc4_zero(U); acc4_zero(W);
                {
#pragma unroll
                    for (int ks = 0; ks < 2; ++ks) {
                        const bf16x8 a1 = *(const bf16x8*)(sA + lds_off(16 * w3 + l15c, ks * 4 + lqc));
                        const bf16x8 a2 = *(const bf16x8*)(sKd + lds_off(16 * w3 + l15c, ks * 4 + lqc));
                        const int r0 = 32 * ks + 8 * lqc + (l15c >> 2);
                        const int p0 = d ? 63 - r0 : r0, p1 = d ? 63 - (r0 + 4) : (r0 + 4);
#pragma unroll
                        for (int nt = 0; nt < 4; ++nt) {
                            const int col = 16 * nt + 4 * (l15c & 3);
                            const s16x4 v0 = ds_tr(sV + el_off(p0, col)), v1 = ds_tr(sV + el_off(p1, col));
                            const s16x4 k0 = ds_tr(sK + el_off(p0, col)), k1 = ds_tr(sK + el_off(p1, col));
                            U[nt] = __builtin_amdgcn_mfma_f32_16x16x32_bf16(a1, __builtin_shufflevector(v0, v1, 0, 1, 2, 3, 4, 5, 6, 7), U[nt], 0, 0, 0);
                            W[nt] = __builtin_amdgcn_mfma_f32_16x16x32_bf16(a2, __builtin_shufflevector(k0, k1, 0, 1, 2, 3, 4, 5, 6, 7), W[nt], 0, 0, 0);
                        }
                    }
                }
                __syncthreads();
                {
                    char* uT = sL + d * DN_LBYTES;
                    char* wT = uT + 8192;
                    const int t0 = 16 * w3 + 4 * lqc;
#pragma unroll
                    for (int nt = 0; nt < 4; ++nt) {
                        uint2 ou, ow;
                        ou.x = pack_bf2(U[nt][0], U[nt][1]); ou.y = pack_bf2(U[nt][2], U[nt][3]);
                        ow.x = pack_bf2(W[nt][0], W[nt][1]); ow.y = pack_bf2(W[nt][2], W[nt][3]);
                        *(uint2*)(uT + el_off(16 * nt + l15c, t0)) = ou;
                        *(uint2*)(wT + el_off(16 * nt + l15c, t0)) = ow;
                    }
                }
                __syncthreads();
            }
        }
        int tid5 = tid;
        asm volatile("" : "+v"(tid5) :: "memory");
        const int lane5 = tid5 & 63, w5 = tid5 >> 6, l15_5 = lane5 & 15, lq5 = lane5 >> 4;
        f32x4 QK[4];
        acc4_zero(QK);
        mm64(QK, sQ, 16 * w5, sK, l15_5, lq5);
#pragma unroll 1
        for (int d = 0; d < 2; ++d) {
            const float* gcd = sS + (d * 5 + 1) * 64;
            const float* egd = sS + (d * 5 + 2) * 64;
            const float* ekd = sS + (d * 5 + 3) * 64;
            {
                const int i = lane5, tq = w5;
                float kv[16];
#pragma unroll
                for (int e = 0; e < 16; ++e) {
                    const int tp = tq * 16 + e, pos = d ? 63 - tp : tp;
                    kv[e] = bf2f(*(const bf16_t*)(sK + el_off(pos, i))) * ekd[tp];
                }
#pragma unroll
                for (int q = 0; q < 2; ++q) {
                    u32x4 o;
                    o[0] = pack_bf2(kv[8 * q + 0], kv[8 * q + 1]); o[1] = pack_bf2(kv[8 * q + 2], kv[8 * q + 3]);
                    o[2] = pack_bf2(kv[8 * q + 4], kv[8 * q + 5]); o[3] = pack_bf2(kv[8 * q + 6], kv[8 * q + 7]);
                    *(u32x4*)(sKd + lds_off(i, 2 * tq + q)) = o;
                }
            }
#pragma unroll
            for (int nt = 0; nt < 4; ++nt)
#pragma unroll
                for (int rg = 0; rg < 4; ++rg) {
                    const int t = 16 * w5 + 4 * lq5 + rg, s = 16 * nt + l15_5;
                    const int tp = d ? 63 - t : t, sp = d ? 63 - s : s;
                    const float val = (sp <= tp) ? QK[nt][rg] * __expf(gcd[tp] - gcd[sp]) : 0.f;
                    *(bf16_t*)(sA + el_off(tp, sp)) = f2bf(val);
                }
            __syncthreads();
            const char* uT = sL + d * DN_LBYTES;
            const char* wT = uT + 8192;
            const int cd = (d == 0) ? pb : (pb < 4 ? 3 - pb : 39 - pb);
            bf16_t* Mg = p.MH + ((size_t)((bh * 2 + d) * 36 + cd) * 2) * 4096;
            bf16_t* Hg = Mg + 4096;
            {
                f32x4 MT[4];
                acc4_zero(MT);
                mm64(MT, wT, 16 * w5, sKd, l15_5, lq5);
                const float egl = egd[63];
                const int j0 = 16 * w5 + 4 * lq5;
#pragma unroll
                for (int nt = 0; nt < 4; ++nt) {
                    const int i = 16 * nt + l15_5;
                    f32x4 o;
#pragma unroll
                    for (int e = 0; e < 4; ++e) o[e] = ((i == j0 + e) ? egl : 0.f) - MT[nt][e];
                    st_bf4(Mg + i * 64 + j0, o);
                }
            }
            {
                f32x4 HH[4];
                acc4_zero(HH);
                mm64(HH, sKd, 16 * w5, uT, l15_5, lq5);
                const int i0 = 16 * w5 + 4 * lq5;
#pragma unroll
                for (int nt = 0; nt < 4; ++nt) st_bf4(Hg + (16 * nt + l15_5) * 64 + i0, HH[nt]);
            }
            if (lat) {
                bf16_t* Eg = p.EF + ((size_t)((bh * 2 + d) * 32 + (pb - 4)) * 2) * 4096;
                bf16_t* Fg = Eg + 4096;
                {
                    f32x4 ET[4];
                    acc4_zero(ET);
                    mm64(ET, wT, 16 * w5, sA, l15_5, lq5);
                    const int j0 = 16 * w5 + 4 * lq5;
#pragma unroll
                    for (int nt = 0; nt < 4; ++nt) {
                        const int sp = 16 * nt + l15_5, spos = d ? 63 - sp : sp;
                        const f32x4 qv = ld_bf4((const bf16_t*)(sQ + el_off(spos, j0)));
                        const float eg = egd[sp];
                        f32x4 o;
#pragma unroll
                        for (int e = 0; e < 4; ++e) o[e] = qv[e] * eg - ET[nt][e];
                        st_bf4(Eg + spos * 64 + j0, o);
                    }
                }
                {
                    f32x4 FF[4];
                    acc4_zero(FF);
                    mm64(FF, uT, 16 * w5, sA, l15_5, lq5);
                    const int c0 = 16 * w5 + 4 * lq5;
#pragma unroll
                    for (int nt = 0; nt < 4; ++nt) {
                        const int sp = 16 * nt + l15_5, spos = d ? 63 - sp : sp;
                        st_bf4(Fg + spos * 64 + c0, FF[nt]);
                    }
                }
            }
            __syncthreads();
        }
    }
}

struct Dn2Frag { bf16x8 am[2]; uint2 hr; };
__device__ __forceinline__ void dn2_load(Dn2Frag& f, const bf16_t* Mg, int w, int l15, int lq, int i0, int hf, int n2) {
#pragma unroll
    for (int ks = 0; ks < 2; ++ks) f.am[ks] = *(const bf16x8*)(Mg + (16 * w + l15) * 64 + ks * 32 + lq * 8);
    f.hr = *(const uint2*)(Mg + 4096 + (32 * hf + 16 * n2 + l15) * 64 + i0);
}
__device__ __forceinline__ void dn2_step(const Dn2Frag& f, int c, int d, int hf, int n2, bf16_t* STc, char* smem, int l15, int lq, int i0) {
    const char* sS = smem + (c & 1) * 4096;
    char* sN = smem + ((c + 1) & 1) * 4096;
    f32x4 acc = (f32x4){__uint_as_float(f.hr.x << 16), __uint_as_float(f.hr.x & 0xffff0000u), __uint_as_float(f.hr.y << 16), __uint_as_float(f.hr.y & 0xffff0000u)};
#pragma unroll
    for (int ks = 0; ks < 2; ++ks) {
        const bf16x8 bs = *(const bf16x8*)(sS + lds_off(16 * n2 + l15, ks * 4 + lq));
        acc = __builtin_amdgcn_mfma_f32_16x16x32_bf16(f.am[ks], bs, acc, 0, 0, 0);
    }
    const int cn = c + 1;
    const bool st = (cn >= 4 && cn <= 35);
    const int pbi = (d == 0 ? cn : 39 - cn) - 4;
    uint2 o; o.x = pack_bf2(acc[0], acc[1]); o.y = pack_bf2(acc[2], acc[3]);
    const int cl = 16 * n2 + l15;
    *(uint2*)(sN + el_off(cl, i0)) = o;
    if (st) *(uint2*)(STc + (size_t)pbi * 4096 + (32 * hf + cl) * 64 + i0) = o;
    __syncthreads();
}
__device__ __forceinline__ void ph_dn2(const Params& p, char* smem, const int pb) {
    const int tid = threadIdx.x, lane = tid & 63, w8 = tid >> 6, w = w8 & 3, n2 = w8 >> 2, l15 = lane & 15, lq = lane >> 4;
    const int x = pb & 7, j = pb >> 3;
    const int chain = (j >> 1) * 8 + x, hf = j & 1, d = chain & 1;
    const bf16_t* MHc = p.MH + (size_t)chain * 36 * 2 * 4096;
    bf16_t* STc = p.ST + (size_t)chain * 32 * 4096;
    if (tid < 256) *(u32x4*)(smem + tid * 16) = (u32x4){0u, 0u, 0u, 0u};
    __syncthreads();
    const int i0 = 16 * w + 4 * lq;
    Dn2Frag f0, f1, f2, f3;
    dn2_load(f0, MHc + (size_t)0 * 8192, w, l15, lq, i0, hf, n2);
    dn2_load(f1, MHc + (size_t)1 * 8192, w, l15, lq, i0, hf, n2);
    dn2_load(f2, MHc + (size_t)2 * 8192, w, l15, lq, i0, hf, n2);
    dn2_load(f3, MHc + (size_t)3 * 8192, w, l15, lq, i0, hf, n2);
    for (int c0 = 0; c0 < 36; c0 += 4) {
        const bool more = (c0 + 4 < 36);
        dn2_step(f0, c0 + 0, d, hf, n2, STc, smem, l15, lq, i0);
        if (more) dn2_load(f0, MHc + (size_t)(c0 + 4) * 8192, w, l15, lq, i0, hf, n2);
        dn2_step(f1, c0 + 1, d, hf, n2, STc, smem, l15, lq, i0);
        if (more) dn2_load(f1, MHc + (size_t)(c0 + 5) * 8192, w, l15, lq, i0, hf, n2);
        dn2_step(f2, c0 + 2, d, hf, n2, STc, smem, l15, lq, i0);
        if (more) dn2_load(f2, MHc + (size_t)(c0 + 6) * 8192, w, l15, lq, i0, hf, n2);
        dn2_step(f3, c0 + 3, d, hf, n2, STc, smem, l15, lq, i0);
        if (more) dn2_load(f3, MHc + (size_t)(c0 + 7) * 8192, w, l15, lq, i0, hf, n2);
    }
}

__device__ __forceinline__ void ph_dn3(const Params& p, int bid, int nb, char* smem) {
    const int tid = VTID, lane = tid & 63, w = tid >> 6, l15 = lane & 15, lq = lane >> 4;
    const int srow = tid >> 3, sch = (tid & 7) ^ ((srow >> 1) & 7);
    LAS char* lbase = (LAS char*)smem + w * 1024;
#define DN3_STAGE(BUF, U_) do { const int bh_ = (U_) >> 5, pbi_ = (U_) & 31; \
        _Pragma("unroll") for (int d_ = 0; d_ < 2; ++d_) { \
            const bf16_t* Sg_ = p.ST + ((size_t)(bh_ * 2 + d_) * 32 + pbi_) * 4096 + (size_t)srow * 64 + sch * 8; \
            _Pragma("unroll") for (int i_ = 0; i_ < 2; ++i_) \
                __builtin_amdgcn_global_load_lds((const void*)(Sg_ + (size_t)(32 * i_) * 64), (LAS void*)(lbase + (BUF) * 16384 + d_ * 8192 + i_ * 4096), 16, 0, 0); } } while (0)
    int u = bid, buf = 0;
    if (u < 64 * 32) DN3_STAGE(0, u);
    for (; u < 64 * 32; u += nb, buf ^= 1) {
        const int bh = u >> 5, pbi = u & 31, b = bh >> 3, h = bh & 7;
        const int s = 16 * w + l15;
        const size_t rl = (size_t)b * SEQ + pbi * 64 + s;
        f32x4 zdv[4];
#pragma unroll
        for (int mt = 0; mt < 4; ++mt) zdv[mt] = ld_bf4(p.Pz + rl * PZ_W + 512 + h * 64 + 16 * mt + 4 * lq);
        f32x4 acc[4];
        acc4_zero(acc);
        bf16x8 be[2][2];
#pragma unroll
        for (int d = 0; d < 2; ++d) {
            const bf16_t* Eg = p.EF + ((size_t)((bh * 2 + d) * 32 + pbi) * 2) * 4096;
            const bf16_t* Fg = Eg + 4096;
#pragma unroll
            for (int mt = 0; mt < 4; ++mt) acc[mt] += ld_bf4(Fg + s * 64 + 16 * mt + 4 * lq);
#pragma unroll
            for (int ks = 0; ks < 2; ++ks) be[d][ks] = *(const bf16x8*)(Eg + s * 64 + ks * 32 + lq * 8);
        }
        __syncthreads();
        if (u + nb < 64 * 32) DN3_STAGE(buf ^ 1, u + nb);
#pragma unroll
        for (int d = 0; d < 2; ++d) {
            const char* sS = smem + buf * 16384 + d * 8192;
#pragma unroll
            for (int ks = 0; ks < 2; ++ks)
#pragma unroll
                for (int mt = 0; mt < 4; ++mt) {
                    const bf16x8 as = *(const bf16x8*)(sS + lds_off(16 * mt + l15, ks * 4 + lq));
                    acc[mt] = __builtin_amdgcn_mfma_f32_16x16x32_bf16(as, be[d][ks], acc[mt], 0, 0, 0);
                }
        }
        float ss = 0.f;
#pragma unroll
        for (int mt = 0; mt < 4; ++mt)
#pragma unroll
            for (int rg = 0; rg < 4; ++rg) ss += acc[mt][rg] * acc[mt][rg];
        ss = xrow_sum(ss);
        const float rstd = rsqrtf(ss * (1.f / 64.f) + EPSF);
#pragma unroll
        for (int mt = 0; mt < 4; ++mt) {
            const f32x4 nw = *(const f32x4*)(p.dn_norm_w + 16 * mt + 4 * lq);
            f32x4 o;
#pragma unroll
            for (int rg = 0; rg < 4; ++rg) o[rg] = acc[mt][rg] * rstd * nw[rg] * silu_f(zdv[mt][rg]);
            st_bf4(p.A_dn + rl * 512 + h * 64 + 16 * mt + 4 * lq, o);
        }
    }
#undef DN3_STAGE
    __syncthreads();
}

namespace g8 {
constexpr int BM = 256, BK = 64, HALF = 128, HTB = HALF * BK * 2, STAGE_BYTES = 8 * HTB;
__device__ __forceinline__ int lds_byte(int r, int c) { const int st = (r >> 4) * 2 + (c >> 5), rr = r & 15, cc = c & 31, ob = rr * 64 + cc * 2; return st * 1024 + (ob ^ (((ob >> 9) & 1) << 5)); }
__device__ __forceinline__ void stage_rc(int b, int& R, int& C) { const int st = b / 1024, sb = b % 1024, swz = sb ^ (((sb >> 9) & 1) << 5); R = (st >> 1) * 16 + swz / 64; C = (st & 1) * 32 + (swz % 64) / 2; }
__device__ __forceinline__ int perm32(int rho) { const int n = rho >> 4, i = rho & 15; return 8 * (i >> 2) + 4 * n + (i & 3); }
struct Unit { int pm, pn, sel; };
typedef f32x4 Acc[2][2][4][2];

template <class Epi, class Sched>
__device__ __forceinline__ void gemm_phase(LAS unsigned char* lds, const bf16_t* A, const bf16_t* A1, int lda, const bf16_t* Bt, int K, const Sched& S, const Epi& E) {
    int tid = threadIdx.x;
    asm volatile("" : "+v"(tid));
    const int wid = __builtin_amdgcn_readfirstlane(tid >> 6), lane = tid & 63, wr = wid >> 2, wc = wid & 3, fr = lane & 15, fq = lane >> 4;
    const int nt = K / BK;
    unsigned voffA[2], voffB[2];
#pragma unroll
    for (int i = 0; i < 2; ++i) { int R, C; stage_rc(tid * 16 + i * 8192, R, C); const int Rb = Epi::PERM ? ((R & ~31) + perm32(R & 31)) : R;
        voffA[i] = (unsigned)(R * lda + C) * 2u; voffB[i] = (unsigned)(Rb * K + C) * 2u; }
    const size_t kstep = (size_t)(BK * 2);
    const size_t hstepA = (size_t)HALF * lda * 2, hstepB = (size_t)HALF * K * 2;
    const size_t tstepA = 2 * hstepA, tstepB = 2 * hstepB;
    const unsigned ldsw = (unsigned)wid * 1024u;
    const int aoff = lds_byte(wr * 64 + fr, fq * 8), boff = lds_byte(wc * 32 + fr, fq * 8);
#define G8_SA(b, h) (((b) * 2 + (h)) * HTB)
#define G8_SB(b, h) ((4 + (b) * 2 + (h)) * HTB)
#define G8_STAGE(bufoff, gbase, voff) do { _Pragma("unroll") for (int _i = 0; _i < 2; ++_i) \
        __builtin_amdgcn_global_load_lds((const unsigned*)((const char*)(gbase) + (voff)[_i]), (LAS unsigned*)(lds + (bufoff) + ldsw + _i * 8192), 16, 0, 0); } while (0)
#define G8_LDA(dst, b, h) do { _Pragma("unroll") for (int m = 0; m < 4; ++m) _Pragma("unroll") for (int k = 0; k < 2; ++k) dst[m][k] = *(const LAS bf16x8*)(lds + G8_SA(b, h) + aoff + m * 2048 + k * 1024); } while (0)
#define G8_LDB(dst, b, h) do { _Pragma("unroll") for (int n = 0; n < 2; ++n) _Pragma("unroll") for (int k = 0; k < 2; ++k) dst[n][k] = *(const LAS bf16x8*)(lds + G8_SB(b, h) + boff + n * 2048 + k * 1024); } while (0)
#define G8_MMA(ai, bj, At, Bt_) do { __builtin_amdgcn_s_setprio(1); _Pragma("unroll") for (int m = 0; m < 4; ++m) _Pragma("unroll") for (int n = 0; n < 2; ++n) _Pragma("unroll") for (int k = 0; k < 2; ++k) \
        acc[ai][bj][m][n] = __builtin_amdgcn_mfma_f32_16x16x32_bf16(Bt_[n][k], At[m][k], acc[ai][bj][m][n], 0, 0, 0); __builtin_amdgcn_s_setprio(0); } while (0)
#define G8_WAIT_V(n) asm volatile("s_waitcnt vmcnt(" #n ")" ::: "memory")
#define G8_WAIT_L(n) asm volatile("s_waitcnt lgkmcnt(" #n ")" ::: "memory")
#define G8_BAR __builtin_amdgcn_s_barrier()
#define G8_SCHED __builtin_amdgcn_sched_barrier(0)
    Unit cur, nxt; int ui = 0;
    if (!S.next(0, cur)) return;
    Acc acc;
#pragma unroll
    for (int a = 0; a < 2; ++a)
#pragma unroll
        for (int b = 0; b < 2; ++b)
#pragma unroll
            for (int m = 0; m < 4; ++m)
#pragma unroll
                for (int n = 0; n < 2; ++n) acc[a][b][m][n] = (f32x4){0.f, 0.f, 0.f, 0.f};
    bf16x8 At[4][2], B0[2][2], B1[2][2];
    const char* cA = (const char*)(cur.sel ? A1 : A) + (size_t)cur.pm * tstepA; const char* cB = (const char*)Bt + (size_t)cur.pn * tstepB;
    G8_STAGE(G8_SB(0, 0), cB, voffB); G8_STAGE(G8_SA(0, 0), cA, voffA); G8_STAGE(G8_SB(0, 1), cB + hstepB, voffB); G8_STAGE(G8_SA(0, 1), cA + hstepA, voffA);
    if (wr == 1) G8_BAR;
    G8_WAIT_V(4); G8_BAR;
    G8_STAGE(G8_SB(1, 0), cB + kstep, voffB); G8_STAGE(G8_SA(1, 0), cA + kstep, voffA); G8_STAGE(G8_SB(1, 1), cB + hstepB + kstep, voffB);
    G8_WAIT_V(6); G8_BAR;
    for (;;) {
        const bool has_next = S.next(ui + 1, nxt);
        const char* nA = has_next ? (const char*)(nxt.sel ? A1 : A) + (size_t)nxt.pm * tstepA : cA; const char* nB = has_next ? (const char*)Bt + (size_t)nxt.pn * tstepB : cB;
        for (int t = 0; t < nt; t += 2) {
            const bool last = (t == nt - 2);
            const char* a1 = cA + (size_t)(t + 1) * kstep;
            const char* a2 = last ? nA : cA + (size_t)(t + 2) * kstep; const char* b2 = last ? nB : cB + (size_t)(t + 2) * kstep;
            const char* a3 = a2 + kstep; const char* b3 = b2 + kstep;
            G8_LDB(B0, 0, 0); G8_SCHED; G8_LDA(At, 0, 0); G8_STAGE(G8_SA(1, 1), a1 + hstepA, voffA);
            G8_WAIT_L(8); G8_BAR; G8_WAIT_L(0); G8_MMA(0, 0, At, B0); G8_BAR; G8_SCHED;
            G8_LDB(B1, 0, 1); G8_STAGE(G8_SB(0, 0), b2, voffB);
            G8_BAR; G8_WAIT_L(0); G8_MMA(0, 1, At, B1); G8_BAR;
            G8_LDA(At, 0, 1); G8_STAGE(G8_SA(0, 0), a2, voffA);
            G8_BAR; G8_WAIT_L(0); G8_MMA(1, 0, At, B0); G8_BAR; G8_SCHED;
            G8_STAGE(G8_SB(0, 1), b2 + hstepB, voffB);
            G8_WAIT_V(6); G8_BAR; G8_MMA(1, 1, At, B1); G8_BAR;
            G8_LDB(B0, 1, 0); G8_SCHED; G8_LDA(At, 1, 0); G8_STAGE(G8_SA(0, 1), a2 + hstepA, voffA);
            G8_WAIT_L(8); G8_BAR; G8_WAIT_L(0); G8_MMA(0, 0, At, B0); G8_BAR; G8_SCHED;
            G8_LDB(B1, 1, 1); G8_STAGE(G8_SB(1, 0), b3, voffB);
            G8_BAR; G8_WAIT_L(0); G8_MMA(0, 1, At, B1); G8_BAR;
            G8_LDA(At, 1, 1); G8_STAGE(G8_SA(1, 0), a3, voffA);
            G8_BAR; G8_WAIT_L(0); G8_MMA(1, 0, At, B0); G8_BAR; G8_SCHED;
            G8_STAGE(G8_SB(1, 1), b3 + hstepB, voffB);
            G8_WAIT_V(6); G8_BAR; G8_MMA(1, 1, At, B1); G8_BAR;
        }
        const bool keep = E(acc, cur, wr, wc, fr, fq);
        if (!has_next) break;
        if (!keep) {
#pragma unroll
            for (int a = 0; a < 2; ++a)
#pragma unroll
                for (int b = 0; b < 2; ++b)
#pragma unroll
                    for (int m = 0; m < 4; ++m)
#pragma unroll
                        for (int n = 0; n < 2; ++n) acc[a][b][m][n] = (f32x4){0.f, 0.f, 0.f, 0.f};
        }
        cur = nxt; cA = nA; cB = nB; ++ui;
    }
    G8_WAIT_V(0);
    if (wr == 0) G8_BAR;
    G8_BAR;
#undef G8_SA
#undef G8_SB
#undef G8_STAGE
#undef G8_LDA
#undef G8_LDB
#undef G8_MMA
#undef G8_WAIT_V
#undef G8_WAIT_L
#undef G8_BAR
#undef G8_SCHED
}

struct StaticOrder {
    int nM, nN, nwg, G, c;
    __device__ __forceinline__ void init(int M, int N, int G_, int c_) { nM = M / BM; nN = N / BM; nwg = nM * nN; G = G_; c = c_; }
    __device__ __forceinline__ bool next(int i, Unit& u) const {
        const int L = i * G + c; if (L >= nwg) return false;
        int wgid = L; { const int q = nwg / 8, r = nwg % 8, xcd = wgid % 8, off = wgid / 8; wgid = (xcd < r ? xcd * (q + 1) : r * (q + 1) + (xcd - r) * q) + off; }
        const int nig = 8 * nN, gid = wgid / nig, fm = gid * 8, gsz = (nM - fm) < 8 ? (nM - fm) : 8;
        u.pm = fm + ((wgid % nig) % gsz); u.pn = (wgid % nig) / gsz; u.sel = 0; return true;
    }
};
struct EpiStoreBf16 {
    static constexpr bool PERM = true;
    bf16_t* O; int ldc;
    __device__ __forceinline__ bool operator()(Acc& acc, const Unit& u, int wr, int wc, int fr, int fq) const {
        const int row0 = u.pm * BM + wr * 64 + fr, col0 = u.pn * BM + wc * 32 + 8 * fq;
#pragma unroll
        for (int ai = 0; ai < 2; ++ai)
#pragma unroll
            for (int m = 0; m < 4; ++m) { bf16_t* rowp = O + (size_t)(row0 + ai * HALF + m * 16) * ldc + col0;
#pragma unroll
                for (int bj = 0; bj < 2; ++bj) { const f32x4 v0 = acc[ai][bj][m][0], v1 = acc[ai][bj][m][1];
                    u32x4 w; w[0] = pack_bf2(v0[0], v0[1]); w[1] = pack_bf2(v0[2], v0[3]); w[2] = pack_bf2(v1[0], v1[1]); w[3] = pack_bf2(v1[2], v1[3]);
                    *(u32x4*)(rowp + bj * HALF) = w; } }
        return false;
    }
};
}


__device__ __forceinline__ void ph_inproj(const Params& p, int bid, int nb, char* smem) {
    const int UA = 2 * 120 + 16 * 144, UZ = 128 * 8;
    const bf16_t* hl = p.h + (size_t)NCTX * DM;
    int u, tm, tn;
    for (int it = 0; next_unit(it, UA + UZ, bid, nb, u); ++it) {
        if (u < 240) { const int g = u / 120, r = u % 120; tm = g * 8 + (r & 7); tn = 3 + (r >> 3); gemm_store_bf16(p.h, DM, p.Wt_a, 1024, tm, tn, p.Pa, PA_W, smem); }
        else if (u < UA) { unit_mn(u - 240 + 288, 18, tm, tn); gemm_store_bf16(p.h, DM, p.Wt_a, 1024, tm, tn, p.Pa, PA_W, smem); }
        else { unit_mn(u - UA, 8, tm, tn); gemm_store_bf16(hl, DM, p.Wt_z, 1024, tm, tn, p.Pz, PZ_W, smem); }
    }
}

__device__ __forceinline__ void ph_gates(const Params& p, char* smem_all, const int pb) {
    g8::StaticOrder so; so.init(NL, PG_W, gridDim.x, pb);
    g8::EpiStoreBf16 ep; ep.O = p.Pg; ep.ldc = PG_W;
    g8::gemm_phase((LAS unsigned char*)smem_all, p.h + (size_t)NCTX * DM, nullptr, DM, p.Wt_g, 1024, so, ep);
}

__device__ __forceinline__ void ph_merge(const Params& p, int bid, int nb, char* smem) {
    int u, tm, tn;
    for (int it = 0; next_unit(it, 128 * 8, bid, nb, u); ++it) {
        unit_mn(u, 8, tm, tn);
        const int m0 = tm * 128, n0 = tn * 128;
        f32x4 acc[4][4];
        uint2 mm[4][4];
        u32x4 gw[2][4];
        {
        EPI_COORDS_OPAQUE(p1)
#pragma unroll
        for (int j = 0; j < 2; ++j)
#pragma unroll
            for (int mt = 0; mt < 4; ++mt) gw[j][mt] = *(const u32x4*)(p.Pg + (size_t)EPI_ROW(mt) * PG_W + EPI_COL(2 * j));
        }
        acc_zero<4>(acc);
        gemm_tile_acc<4>(acc, p.A_mla, 512, p.Wt_mo, 512, 512, m0, n0, smem);
#pragma unroll
        for (int j = 0; j < 2; ++j)
#pragma unroll
            for (int mt = 0; mt < 4; ++mt) {
#pragma unroll
                for (int q = 0; q < 2; ++q) {
                    const int nt = 2 * j + q;
                    const float g0 = __uint_as_float(gw[j][mt][2 * q] << 16), g1 = __uint_as_float(gw[j][mt][2 * q] & 0xffff0000u);
                    const float g2 = __uint_as_float(gw[j][mt][2 * q + 1] << 16), g3 = __uint_as_float(gw[j][mt][2 * q + 1] & 0xffff0000u);
                    mm[nt][mt].x = pack_bf2(sigmoid_f(g0) * acc[nt][mt][0], sigmoid_f(g1) * acc[nt][mt][1]);
                    mm[nt][mt].y = pack_bf2(sigmoid_f(g2) * acc[nt][mt][2], sigmoid_f(g3) * acc[nt][mt][3]);
                }
            }
        {
        EPI_COORDS_OPAQUE(p2)
#pragma unroll
        for (int j = 0; j < 2; ++j)
#pragma unroll
            for (int mt = 0; mt < 4; ++mt) gw[j][mt] = *(const u32x4*)(p.Pg + (size_t)EPI_ROW(mt) * PG_W + 1024 + EPI_COL(2 * j));
        }
        acc_zero<4>(acc);
        gemm_tile_acc<4>(acc, p.A_dn, 512, p.Wt_do, 512, 512, m0, n0, smem);
        {
        EPI_COORDS_OPAQUE(b)
#pragma unroll
        for (int j = 0; j < 2; ++j)
#pragma unroll
            for (int mt = 0; mt < 4; ++mt) {
                u32x4 ov;
#pragma unroll
                for (int q = 0; q < 2; ++q) {
                    const int nt = 2 * j + q;
                    const float g0 = __uint_as_float(gw[j][mt][2 * q] << 16), g1 = __uint_as_float(gw[j][mt][2 * q] & 0xffff0000u);
                    const float g2 = __uint_as_float(gw[j][mt][2 * q + 1] << 16), g3 = __uint_as_float(gw[j][mt][2 * q + 1] & 0xffff0000u);
                    const float o0 = __uint_as_float(mm[nt][mt].x << 16) + sigmoid_f(g0) * acc[nt][mt][0];
                    const float o1 = __uint_as_float(mm[nt][mt].x & 0xffff0000u) + sigmoid_f(g1) * acc[nt][mt][1];
                    const float o2 = __uint_as_float(mm[nt][mt].y << 16) + sigmoid_f(g2) * acc[nt][mt][2];
                    const float o3 = __uint_as_float(mm[nt][mt].y & 0xffff0000u) + sigmoid_f(g3) * acc[nt][mt][3];
                    ov[2 * q] = pack_bf2(o0, o1); ov[2 * q + 1] = pack_bf2(o2, o3);
                }
                *(u32x4*)(p.Mb + (size_t)EPI_ROW(mt) * 1024 + EPI_COL(2 * j)) = ov;
            }
        }
    }
}

__device__ __forceinline__ void ph_out(const Params& p, int bid, int nb, char* smem) {
    int u, tm, tn;
    for (int it = 0; next_unit(it, 128 * 8, bid, nb, u); ++it) {
        unit_mn(u, 8, tm, tn);
        const int m0 = tm * 128, n0 = tn * 128;
        f32x4 acc[4][4], xv[4][4];
        EPI_COORDS
#pragma unroll
        for (int nt = 0; nt < 4; ++nt)
#pragma unroll
            for (int mt = 0; mt < 4; ++mt) xv[nt][mt] = *(const f32x4*)(p.x + (size_t)EPI_ROW(mt) * DM + EPI_COL(nt));
        const float* gp = p.mod + (m0 / SEQ) * 3072 + 2048;
        f32x4 gate[4];
#pragma unroll
        for (int nt = 0; nt < 4; ++nt) gate[nt] = *(const f32x4*)(gp + EPI_COL(nt));
        acc_zero<4>(acc);
        gemm_tile_acc<4>(acc, p.Mb, 1024, p.Wt_out, 1024, 1024, m0, n0, smem);
#pragma unroll
        for (int nt = 0; nt < 4; ++nt)
#pragma unroll
            for (int mt = 0; mt < 4; ++mt)
                *(f32x4*)(p.out + (size_t)EPI_ROW(mt) * DM + EPI_COL(nt)) = xv[nt][mt] + gate[nt] * acc[nt][mt];
    }
}

struct InprojOrder {
    int c;
    __device__ __forceinline__ bool next(int i, g8::Unit& u) const {
        const int x = c & 7, off = i * 32 + (c >> 3);
        if (off >= 96) return false;
        if (off < 88) { u.pm = 8 + 8 * x + (off & 7); u.pn = off >> 3; }
        else { u.pm = x; u.pn = 1 + (off - 88); }
        u.sel = 0; return true;
    }
};
struct ZdOrder {
    int c;
    __device__ __forceinline__ bool next(int i, g8::Unit& u) const {
        const int idx = (c >> 3) - 16;
        if (i > 0 || idx < 0) return false;
        u.pm = 8 + 8 * (c & 7) + (idx & 7); u.pn = 11 + (idx >> 3); u.sel = 0; return true;
    }
};
template <int LDC>
__device__ __forceinline__ void epi_store_tile(const g8::Acc& acc, bf16_t* O, int row0, int col0) {
#pragma unroll
    for (int ai = 0; ai < 2; ++ai)
#pragma unroll
        for (int m = 0; m < 4; ++m) { bf16_t* rowp = O + (size_t)(row0 + ai * 128 + m * 16) * LDC + col0;
#pragma unroll
            for (int bj = 0; bj < 2; ++bj) { const f32x4 v0 = acc[ai][bj][m][0], v1 = acc[ai][bj][m][1];
                u32x4 w; w[0] = pack_bf2(v0[0], v0[1]); w[1] = pack_bf2(v0[2], v0[3]); w[2] = pack_bf2(v1[0], v1[1]); w[3] = pack_bf2(v1[2], v1[3]);
                *(u32x4*)(rowp + bj * 128) = w; } }
}
struct EpiInproj {
    static constexpr bool PERM = true;
    bf16_t* Pa; bf16_t* Pz;
    __device__ __forceinline__ bool operator()(g8::Acc& acc, const g8::Unit& u, int wr, int wc, int, int) const {
        int t = threadIdx.x; asm volatile("" : "+v"(t));
        const int fr = t & 15, fq = (t >> 4) & 3;
        if (u.pn < 9) epi_store_tile<PA_W>(acc, Pa, u.pm * 256 + wr * 64 + fr, u.pn * 256 + wc * 32 + 8 * fq);
        else epi_store_tile<PZ_W>(acc, Pz, u.pm * 256 - NCTX + wr * 64 + fr, (u.pn - 9) * 256 + wc * 32 + 8 * fq);
        return false;
    }
};
__device__ __forceinline__ void ph_zd8(const Params& p, char* smem_all, const int pb) {
    ZdOrder so; so.c = pb;
    EpiInproj ep; ep.Pa = p.Pa; ep.Pz = p.Pz;
    g8::gemm_phase((LAS unsigned char*)smem_all, p.h, nullptr, DM, p.Wt_a, 1024, so, ep);
}
__device__ __forceinline__ void ph_inproj8(const Params& p, char* smem_all, const int pb) {
    InprojOrder so; so.c = pb;
    EpiInproj ep; ep.Pa = p.Pa; ep.Pz = p.Pz;
    g8::gemm_phase((LAS unsigned char*)smem_all, p.h, nullptr, DM, p.Wt_a, 1024, so, ep);
}

struct MergeOrder {
    g8::StaticOrder so;
    __device__ __forceinline__ bool next(int i, g8::Unit& u) const {
        if (i >= 2) return false;
        const bool ok = so.next(0, u); u.sel = i; u.pn += 4 * i; return ok;
    }
};
struct EpiMerge {
    static constexpr bool PERM = true;
    const bf16_t* Pg; bf16_t* Mb;
    __device__ __forceinline__ bool operator()(g8::Acc& acc, const g8::Unit& u, int wr, int wc, int, int) const {
        int t = threadIdx.x; asm volatile("" : "+v"(t));
        const int fr = t & 15, fq = (t >> 4) & 3;
        const int row0 = u.pm * 256 + wr * 64 + fr, col0 = (u.pn & 3) * 256 + wc * 32 + 8 * fq;
        if (u.sel == 0) {
#pragma unroll
            for (int ai = 0; ai < 2; ++ai) {
#pragma unroll
                for (int m = 0; m < 4; ++m) {
                    const bf16_t* gp = Pg + (size_t)(row0 + ai * 128 + m * 16) * PG_W + col0;
                    u32x4 g1[2], g2[2];
#pragma unroll
                    for (int bj = 0; bj < 2; ++bj) { g1[bj] = *(const u32x4*)(gp + bj * 128); g2[bj] = *(const u32x4*)(gp + 1024 + bj * 128); }
#pragma unroll
                    for (int bj = 0; bj < 2; ++bj)
#pragma unroll
                        for (int n = 0; n < 2; ++n)
#pragma unroll
                            for (int e = 0; e < 4; ++e) {
                                const unsigned w1 = g1[bj][2 * n + (e >> 1)], w2 = g2[bj][2 * n + (e >> 1)];
                                const float a1 = (e & 1) ? __uint_as_float(w1 & 0xffff0000u) : __uint_as_float(w1 << 16);
                                const float a2 = fmaxf((e & 1) ? __uint_as_float(w2 & 0xffff0000u) : __uint_as_float(w2 << 16), -30.f);
                                acc[ai][bj][m][n][e] *= (1.f + __expf(-a2)) * __builtin_amdgcn_rcpf(1.f + __expf(-a1));
                            }
                }
                asm volatile("" ::: "memory");
            }
            return true;
        }
#pragma unroll
        for (int ai = 0; ai < 2; ++ai) {
#pragma unroll
            for (int m = 0; m < 4; ++m) {
                const size_t row = (size_t)(row0 + ai * 128 + m * 16);
                u32x4 g2[2];
#pragma unroll
                for (int bj = 0; bj < 2; ++bj) g2[bj] = *(const u32x4*)(Pg + row * PG_W + 1024 + col0 + bj * 128);
#pragma unroll
                for (int bj = 0; bj < 2; ++bj) {
                    u32x4 w;
#pragma unroll
                    for (int n = 0; n < 2; ++n) {
                        float o[4];
#pragma unroll
                        for (int e = 0; e < 4; ++e) {
                            const unsigned w2 = g2[bj][2 * n + (e >> 1)];
                            const float a2 = fmaxf((e & 1) ? __uint_as_float(w2 & 0xffff0000u) : __uint_as_float(w2 << 16), -30.f);
                            o[e] = acc[ai][bj][m][n][e] * __builtin_amdgcn_rcpf(1.f + __expf(-a2));
                        }
                        w[2 * n] = pack_bf2(o[0], o[1]); w[2 * n + 1] = pack_bf2(o[2], o[3]);
                    }
                    *(u32x4*)(Mb + row * 1024 + col0 + bj * 128) = w;
                }
            }
            asm volatile("" ::: "memory");
        }
        return false;
    }
};
__device__ __forceinline__ void ph_merge8(const Params& p, char* smem_all, const int pb) {
    MergeOrder mo; mo.so.init(NL, 1024, gridDim.x, pb);
    EpiMerge ep; ep.Pg = p.Pg; ep.Mb = p.Mb;
    g8::gemm_phase((LAS unsigned char*)smem_all, p.A_mla, p.A_dn, 512, p.Wt_mo, 512, mo, ep);
}

struct EpiOut {
    static constexpr bool PERM = false;
    const float* x; const float* mod; float* out;
    __device__ __forceinline__ bool operator()(g8::Acc& acc, const g8::Unit& u, int wr, int wc, int fr, int fq) const {
        const int row0 = u.pm * 256 + wr * 64 + fr, col0 = u.pn * 256 + wc * 32 + 4 * fq;
        const float* gp = mod + ((u.pm * 256) / SEQ) * 3072 + 2048 + col0;
        f32x4 gate[2][2];
#pragma unroll
        for (int bj = 0; bj < 2; ++bj)
#pragma unroll
            for (int n = 0; n < 2; ++n) gate[bj][n] = *(const f32x4*)(gp + bj * 128 + n * 16);
#pragma unroll
        for (int ai = 0; ai < 2; ++ai)
#pragma unroll
            for (int m = 0; m < 4; ++m) {
                const size_t off = (size_t)(row0 + ai * 128 + m * 16) * DM + col0;
                f32x4 xv[2][2];
#pragma unroll
                for (int bj = 0; bj < 2; ++bj)
#pragma unroll
                    for (int n = 0; n < 2; ++n) xv[bj][n] = *(const f32x4*)(x + off + bj * 128 + n * 16);
#pragma unroll
                for (int bj = 0; bj < 2; ++bj)
#pragma unroll
                    for (int n = 0; n < 2; ++n) *(f32x4*)(out + off + bj * 128 + n * 16) = xv[bj][n] + gate[bj][n] * acc[ai][bj][m][n];
                if (m & 1) asm volatile("" ::: "memory");
            }
        return false;
    }
};
__device__ __forceinline__ void ph_out8(const Params& p, char* smem_all, const int pb) {
    g8::StaticOrder so; so.init(NL, DM, gridDim.x, pb);
    EpiOut ep; ep.x = p.x; ep.mod = p.mod; ep.out = p.out;
    g8::gemm_phase((LAS unsigned char*)smem_all, p.Mb, nullptr, DM, p.Wt_out, 1024, so, ep);
}

#define XB_TMO      128
#define XB_XCNT(j)  (256  + 64 * (j))
#define XB_XSUB(j)  (1280 + 64 * (j))
#define XB_XGEN(j)  (2304 + 64 * (j))
#define XB_TOP      3328
#define XB_TOPGEN   3392
#define XCD_BAR_WORDS 3456
#define XB_SPIN_CAP (1u << 20)
__device__ __forceinline__ unsigned xb_ld(unsigned* p)              { return __hip_atomic_load(p, __ATOMIC_RELAXED, __HIP_MEMORY_SCOPE_AGENT); }
__device__ __forceinline__ unsigned xb_add(unsigned* p, unsigned v) { return __hip_atomic_fetch_add(p, v, __ATOMIC_RELAXED, __HIP_MEMORY_SCOPE_AGENT); }
__device__ __forceinline__ unsigned xb_xcc_id() { return (unsigned)__builtin_amdgcn_s_getreg((3 << 11) | 20) & 0xFu; }
#define XB_SPIN(cond, bar) do { unsigned _sp = 0; while (cond) { __builtin_amdgcn_s_sleep(1); \
    if ((++_sp & 255u) == 0u) { if (xb_ld(&(bar)[XB_TMO])) break; if (_sp > XB_SPIN_CAP) { atomicAdd(&(bar)[XB_TMO], 1u); break; } } } } while (0)
struct XcdBarrier { unsigned* bar; unsigned x; volatile LAS unsigned* st; };
__device__ __forceinline__ XcdBarrier xcd_barrier_post(unsigned* bar, volatile LAS unsigned* st) {
    XcdBarrier b; b.bar = bar; b.x = xb_xcc_id(); b.st = st;
    if (threadIdx.x == 0) (void)xb_add(&bar[XB_XCNT(b.x)], 1u);
    return b;
}
__device__ __forceinline__ void xcd_barrier_complete(unsigned* bar, unsigned x, unsigned& nloc, unsigned& nx) {
    const unsigned G = gridDim.x * gridDim.y * gridDim.z;
    unsigned sum, cnt, mine, sp = 0u;
    for (;;) {
        sum = 0u; cnt = 0u; mine = 0u;
#pragma unroll
        for (unsigned j = 0; j < 16; ++j) { const unsigned c = xb_ld(&bar[XB_XCNT(j)]); sum += c; cnt += (c > 0u) ? 1u : 0u; mine = (j == x) ? c : mine; }
        if (sum == G) break;
        __builtin_amdgcn_s_sleep(1);
        if ((++sp & 255u) == 0u) { if (xb_ld(&bar[XB_TMO])) break; if (sp > XB_SPIN_CAP) { atomicAdd(&bar[XB_TMO], 1u); break; } }
    }
    nloc = mine > 0u ? mine : 1u; nx = cnt > 0u ? cnt : 1u;
}
__device__ __forceinline__ void xcd_barrier(const XcdBarrier& b) {
    asm volatile("s_waitcnt vmcnt(0)" ::: "memory");
    __syncthreads();
    if (threadIdx.x == 0) {
        unsigned* bar = b.bar;
        __builtin_amdgcn_s_waitcnt(0);
        unsigned nloc = b.st[0], nx = b.st[1];
        if (nloc == 0u) { xcd_barrier_complete(bar, b.x, nloc, nx); b.st[0] = nloc; b.st[1] = nx; }
        const unsigned old = xb_add(&bar[XB_XSUB(b.x)], 1u);
        const unsigned gen = old / nloc;
        if (old + 1u == (gen + 1u) * nloc) {
            __builtin_amdgcn_fence(__ATOMIC_RELEASE, "agent");
            asm volatile("s_waitcnt vmcnt(0)" ::: "memory");
            const unsigned og = xb_add(&bar[XB_TOP], 1u);
            const unsigned tg = og / nx;
            if (og + 1u == (tg + 1u) * nx) xb_add(&bar[XB_TOPGEN], 1u);
            else XB_SPIN(xb_ld(&bar[XB_TOPGEN]) == tg, bar);
            __builtin_amdgcn_fence(__ATOMIC_ACQUIRE, "agent");
            xb_add(&bar[XB_XGEN(b.x)], 1u);
            asm volatile("s_waitcnt vmcnt(0)" ::: "memory");
        } else {
            XB_SPIN(xb_ld(&bar[XB_XGEN(b.x)]) == gen, bar);
            __builtin_amdgcn_fence(__ATOMIC_ACQUIRE, "agent");
            asm volatile("s_waitcnt vmcnt(0)" ::: "memory");
        }
    }
    __syncthreads();
}

__global__ void __launch_bounds__(2 * NTHR, 2) fwd_megakernel(Params p) {
    __shared__ __attribute__((aligned(16))) char smem_all[2 * SMEM_BYTES];
    const int half = __builtin_amdgcn_readfirstlane((int)(threadIdx.x >> 8)), pb = blockIdx.x;
    const int bid = 16 * (pb >> 3) + 8 * half + (pb & 7), nb = 2 * gridDim.x;
    const int bid2 = 2 * pb + half;
    char* smem = smem_all + half * SMEM_BYTES;
    volatile LAS unsigned* bst = (volatile LAS unsigned*)(smem_all + 2 * SMEM_BYTES - 16);
    if (threadIdx.x == 0) { bst[0] = 0u; bst[1] = 0u; }
    __syncthreads();
    const XcdBarrier xb = xcd_barrier_post(p.bar, bst);

    ph_mod(p, bid, nb, smem);
    ph_wprep(p, bid2, nb, smem);
    xcd_barrier(xb);
    ph_norm(p, bid, nb, smem);
    xcd_barrier(xb);
    ph_inproj8(p, smem_all, pb);
    xcd_barrier(xb);
    ph_mla_proj(p, bid, nb, smem);
    xcd_barrier(xb);
    ph_attn(p, bid, nb, smem, smem_all, pb);
    xcd_barrier(xb);
    ph_dn1(p, bid, nb, smem);
    __syncthreads();
    ph_zd8(p, smem_all, pb);
    xcd_barrier(xb);
    ph_dn2(p, smem_all, pb);
    xcd_barrier(xb);
    ph_dn3(p, bid, nb, smem);
    ph_gates(p, smem_all, pb);
    xcd_barrier(xb);
    ph_merge8(p, smem_all, pb);
    xcd_barrier(xb);
    ph_out8(p, smem_all, pb);
}

extern "C" void kernel_launch(void* const* d_in, const int* in_sizes, int n_in,
                              void* d_out, int out_size, void* d_ws, size_t ws_size,
                              hipStream_t stream) {
    static int grid_blocks = 0;
    if (!grid_blocks) {
        int dev = 0, cus = 0, per_cu = 0;
        (void)hipGetDevice(&dev);
        (void)hipDeviceGetAttribute(&cus, hipDeviceAttributeMultiprocessorCount, dev);
        (void)hipOccupancyMaxActiveBlocksPerMultiprocessor(&per_cu, fwd_megakernel, 2 * NTHR, 0);
        if (per_cu > 1) per_cu = 1;
        if (per_cu < 1) per_cu = 1;
        grid_blocks = cus * per_cu;
    }
    if (n_in != 21 || ws_size < (size_t)268435456 || out_size != NL * DM) {
        fprintf(stderr, "kernel_launch: built for 21 inputs, a %d-float output and >= 256 MiB of workspace (got %d inputs, out %d, ws %zu)\n", NL * DM, n_in, out_size, ws_size);
        return;
    }
    Params p{};
    const float** fp = (const float**)&p;
    for (int i = 0; i < 21; ++i) fp[i] = (const float*)d_in[i];
    p.out = (float*)d_out;
    char* ws = (char*)d_ws;
    char* ob = (char*)d_out;
    const size_t R_W = 0;
    const size_t R_H = 16777216;
    const size_t R_Z = R_H + 37748736;
    const size_t R_A = R_Z + 33554432;
    const size_t R_F = R_A + 84934656;
    {
        size_t o = R_W;
        p.Wt_a = (bf16_t*)(ws + o); o += 4718592;
        p.Wt_z = (bf16_t*)(ws + o); o += 2097152;
        p.Wt_g = (bf16_t*)(ws + o); o += 4194304;
        p.Wt_uq = (bf16_t*)(ws + o); o += 589824;
        p.Wt_ukv = (bf16_t*)(ws + o); o += 524288;
        p.Wt_mo = (bf16_t*)(ws + o); o += 1048576;
        p.Wt_do = (bf16_t*)(ws + o); o += 1048576;
        p.Wt_out = (bf16_t*)(ws + o); o += 2097152;
        p.mod = (float*)(ws + o); o += 110592;
        p.bar = (unsigned*)(ws + o); o += XCD_BAR_WORDS * 4;
        p.rope = (float*)(ws + o); o += 4096;
    }
    p.h = (bf16_t*)(ws + R_H);
    p.Pz = (bf16_t*)(ws + R_Z);
    p.Pa = (bf16_t*)(ws + R_A);
    p.Qb = (bf16_t*)(ws + R_F + 22020096);
    p.Kb = (bf16_t*)(ws + R_F + 47185920);
    p.Vt = (bf16_t*)(ws + R_F + 75497472);
    p.MH = (bf16_t*)(ws + R_F + 16777216);
    p.EF = (bf16_t*)(ob);
    p.ST = (bf16_t*)(ws + R_A);
    p.A_mla = (bf16_t*)(ws + R_F);
    p.A_dn = (bf16_t*)(ws + R_A + 50331648);
    p.Pg = (bf16_t*)(ws + R_F + 16777216);
    p.Mb = (bf16_t*)(ws + R_H);
    (void)hipMemsetAsync(p.mod, 0, 110592 + XCD_BAR_WORDS * 4, stream);
    void* args[] = {&p};
    hipError_t err = hipLaunchCooperativeKernel((void*)fwd_megakernel, dim3(grid_blocks), dim3(2 * NTHR), args, 0, stream);
    if (err != hipSuccess) fprintf(stderr, "cooperative launch failed: %s (grid %d)\n", hipGetErrorString(err), grid_blocks);
}
```

```cpp
#include <hip/hip_runtime.h>
#include <stdint.h>
#include <cstdio>

typedef uint16_t bf16_t;
#define LAS __attribute__((address_space(3)))

#define NB 8
#define SEQ 2048
#define CTXL 256
#define TPB 2304
#define NCTX 2048
#define NL 16384
#define NT 18432
#define DM 1024
#define IN_DIM 5312
#define PA_W 2304
#define PZ_W 1024
#define PG_W 2048
#define PA_CQ 0
#define PA_CKV 384
#define PA_KR 640
#define PA_DQ 672
#define PA_DK 1184
#define PA_DV 1696
#define PA_DB 2208
#define PA_DA 2224
#define EPSF 1e-6f
#define NTHR 256
#define VTID ((int)(threadIdx.x & 255u))
#define SMEM_BYTES 77824

struct Params {
    const float *x, *c, *ctx, *c_ctx, *w_mod, *b_mod, *norm_w, *w_in, *q_norm_w, *w_uq, *kv_norm_w, *w_ukv, *qhn_w, *khn_w,
        *mla_w_o, *conv_w, *a_log, *dt_bias, *dn_norm_w, *dn_w_o, *w_out;
    float* out;
    bf16_t *h, *Pa, *Pz, *Pg, *Qb, *Vt, *Kb, *MH, *EF, *ST, *A_mla, *A_dn, *Mb;
    bf16_t *Wt_a, *Wt_z, *Wt_g, *Wt_uq, *Wt_ukv, *Wt_mo, *Wt_do, *Wt_out;
    float *mod, *rope;
    unsigned* bar;
};

typedef float f32x4 __attribute__((ext_vector_type(4)));
typedef unsigned u32x4 __attribute__((ext_vector_type(4)));
typedef __bf16 bf16v2_t __attribute__((ext_vector_type(2)));
typedef float f32x2 __attribute__((ext_vector_type(2)));
__device__ __forceinline__ uint32_t pack_bf2(float lo, float hi) {
    f32x2 v = {lo, hi};
    bf16v2_t b = __builtin_convertvector(v, bf16v2_t);
    return __builtin_bit_cast(uint32_t, b);
}
__device__ __forceinline__ void st_bf4(bf16_t* p, f32x4 v) {
    uint2 o; o.x = pack_bf2(v[0], v[1]); o.y = pack_bf2(v[2], v[3]);
    *(uint2*)p = o;
}
__device__ __forceinline__ float bf2f(bf16_t v) { return __uint_as_float(((uint32_t)v) << 16); }
__device__ __forceinline__ bf16_t f2bf(float f) {
    uint32_t u = __float_as_uint(f);
    u += 0x7fffu + ((u >> 16) & 1u);
    return (bf16_t)(u >> 16);
}
__device__ __forceinline__ float silu_f(float v) { return v * __builtin_amdgcn_rcpf(1.f + __expf(-v)); }
__device__ __forceinline__ float sigmoid_f(float v) { return __builtin_amdgcn_rcpf(1.f + __expf(-v)); }
template <int CTRL> __device__ __forceinline__ float dpp_mov(float v) {
    return __builtin_bit_cast(float, __builtin_amdgcn_update_dpp(0, __builtin_bit_cast(int, v), CTRL, 0xF, 0xF, true));
}
__device__ __forceinline__ float row16_sum(float v) {
    v += dpp_mov<0xB1>(v); v += dpp_mov<0x4E>(v); v += dpp_mov<0x141>(v); v += dpp_mov<0x140>(v); return v;
}
__device__ __forceinline__ float rdlane(float v, int l) { return __builtin_bit_cast(float, __builtin_amdgcn_readlane(__builtin_bit_cast(int, v), l)); }
__device__ __forceinline__ float wave_sum(float v) {
    v += dpp_mov<0xB1>(v);
    v += dpp_mov<0x4E>(v);
    v += dpp_mov<0x141>(v);
    v += dpp_mov<0x140>(v);
    return (rdlane(v, 0) + rdlane(v, 16)) + (rdlane(v, 32) + rdlane(v, 48));
}
__device__ __forceinline__ float xrow_sum(float v) { v += __shfl_xor(v, 16); v += __shfl_xor(v, 32); return v; }
__device__ __forceinline__ void ph_mod(const Params& p, int bid, int nb, char* smem) {
    float* sc = (float*)smem;
    const int item = bid & 511;
    const int k0 = (item >> 4) * 32, cb = (item & 15) * 192, tid = VTID;
    for (int i = tid; i < 288; i += NTHR) {
        const int r = i >> 5, kk = i & 31;
        const float v = (r < 8) ? p.c[r * 1024 + k0 + kk] : p.c_ctx[k0 + kk];
        sc[i] = silu_f(v);
    }
    __syncthreads();
    if (tid < 192) {
        const float* wp = p.w_mod + (size_t)k0 * 3072 + cb;
        float acc[9];
#pragma unroll
        for (int r = 0; r < 9; ++r) acc[r] = 0.f;
        int NH = 2;
        asm volatile("" : "+s"(NH));
        for (int hh = 0; hh < NH; ++hh) {
            float wv[16];
#pragma unroll
            for (int kk = 0; kk < 16; ++kk) wv[kk] = wp[(size_t)(hh * 16 + kk) * 3072 + tid];
#pragma unroll
            for (int k4 = 0; k4 < 4; ++k4)
#pragma unroll
                for (int r = 0; r < 9; ++r) {
                    const f32x4 s4 = *(const f32x4*)(sc + r * 32 + hh * 16 + 4 * k4);
                    acc[r] += s4[0] * wv[4 * k4] + s4[1] * wv[4 * k4 + 1] + s4[2] * wv[4 * k4 + 2] + s4[3] * wv[4 * k4 + 3];
                }
        }
        const float bb = (k0 == 0) ? p.b_mod[cb + tid] : 0.f;
#pragma unroll
        for (int r = 0; r < 9; ++r) atomicAdd(p.mod + r * 3072 + cb + tid, acc[r] + bb);
    }
    __syncthreads();
}

__device__ __forceinline__ void ph_norm(const Params& p, int bid, int nb, char* smem) {
    const int lane = VTID & 63, gw = bid * 4 + (VTID >> 6), nw = nb * 4;
    const int per = (NT + nw - 1) / nw;
    const int r0 = gw * per, r1 = (r0 + per < NT) ? r0 + per : NT;
    auto rowptr = [&](int rr) -> const float* { return ((rr < NCTX) ? p.ctx + (size_t)rr * DM : p.x + (size_t)(rr - NCTX) * DM) + lane * 8; };
#define NORM_LOAD(V, RR) do { const float* s_ = rowptr(RR); V[0] = *(const f32x4*)(s_); V[1] = *(const f32x4*)(s_ + 4); V[2] = *(const f32x4*)(s_ + 512); V[3] = *(const f32x4*)(s_ + 516); } while (0)
    f32x4 v[4], v1[4], v2[4], av[4], sv[4];
    int cur_m = -1;
    if (r0 < r1) NORM_LOAD(v, r0);
    if (r0 + 1 < r1) NORM_LOAD(v1, r0 + 1);
    for (int r = r0; r < r1; ++r) {
        if (r + 2 < r1) NORM_LOAD(v2, r + 2);
        const int mrow = (r < NCTX) ? 8 : (r - NCTX) / SEQ;
        if (mrow != cur_m) {
            cur_m = mrow;
            const float* shift = p.mod + mrow * 3072;
            const float* scale = shift + 1024;
#pragma unroll
            for (int i = 0; i < 4; ++i) {
                const int k = (i >> 1) * 512 + lane * 8 + (i & 1) * 4;
                const f32x4 nwv = *(const f32x4*)(p.norm_w + k), sc = *(const f32x4*)(scale + k);
                sv[i] = *(const f32x4*)(shift + k);
#pragma unroll
                for (int e2 = 0; e2 < 4; ++e2) av[i][e2] = nwv[e2] * (1.f + sc[e2]);
            }
        }
        float ss = 0.f;
#pragma unroll
        for (int i = 0; i < 4; ++i) ss += v[i][0] * v[i][0] + v[i][1] * v[i][1] + v[i][2] * v[i][2] + v[i][3] * v[i][3];
        ss = wave_sum(ss);
        const float rstd = rsqrtf(ss * (1.f / 1024.f) + EPSF);
#pragma unroll
        for (int c = 0; c < 2; ++c) {
            u32x4 o;
#pragma unroll
            for (int q = 0; q < 2; ++q) {
                const int i = 2 * c + q;
                o[2 * q] = pack_bf2((v[i][0] * rstd) * av[i][0] + sv[i][0], (v[i][1] * rstd) * av[i][1] + sv[i][1]);
                o[2 * q + 1] = pack_bf2((v[i][2] * rstd) * av[i][2] + sv[i][2], (v[i][3] * rstd) * av[i][3] + sv[i][3]);
            }
            *(u32x4*)(p.h + (size_t)r * DM + c * 512 + lane * 8) = o;
        }
#pragma unroll
        for (int i = 0; i < 4; ++i) { v[i] = v1[i]; v1[i] = v2[i]; }
    }
#undef NORM_LOAD
}


struct WprepDesc { const float* W; const float* ksc; bf16_t* dst; int ldw, K, n0, k0, srcbase; };
__device__ __forceinline__ void wprep_decode(const Params& p, int u, WprepDesc& d) {
    const int U0 = 72 * 8, U1 = 32 * 8, U2 = 64 * 8, U3 = 24 * 3, U4 = 32 * 2, U5 = 32 * 4, U6 = 32 * 4;
    int v = u, job;
    if (v < U0) { job = 0; d.W = p.w_in; d.ldw = IN_DIM; d.K = 1024; d.dst = p.Wt_a; }
    else if ((v -= U0) < U1) { job = 1; d.W = p.w_in; d.ldw = IN_DIM; d.K = 1024; d.dst = p.Wt_z; }
    else if ((v -= U1) < U2) { job = 2; d.W = p.w_in; d.ldw = IN_DIM; d.K = 1024; d.dst = p.Wt_g; }
    else if ((v -= U2) < U3) { job = 3; d.W = p.w_uq; d.ldw = 768; d.K = 384; d.dst = p.Wt_uq; }
    else if ((v -= U3) < U4) { job = 4; d.W = p.w_ukv; d.ldw = 1024; d.K = 256; d.dst = p.Wt_ukv; }
    else if ((v -= U4) < U5) { job = 5; d.W = p.mla_w_o; d.ldw = 1024; d.K = 512; d.dst = p.Wt_mo; }
    else if ((v -= U5) < U6) { job = 6; d.W = p.dn_w_o; d.ldw = 1024; d.K = 512; d.dst = p.Wt_do; }
    else { v -= U6; job = 7; d.W = p.w_out; d.ldw = 1024; d.K = 1024; d.dst = p.Wt_out; }
    const int nkt = d.K / 128;
    d.n0 = (v / nkt) * 32; d.k0 = (v % nkt) * 128;
    const int n0 = d.n0;
    int srcbase = n0;
    if (job == 0) {
        if (n0 < 672) srcbase = n0;
        else if (n0 < 2208) { const int r = n0 - 672, hh = r / 192, g = (r % 192) >> 6, i0 = r & 63; srcbase = 1184 + g * 512 + hh * 64 + i0; }
        else srcbase = (n0 < 2240) ? n0 + 1024 : -1;
    }
    else if (job == 1) srcbase = (n0 < 512) ? 672 + n0 : 2208 + n0;
    else if (job == 2) srcbase = 3264 + n0;
    d.srcbase = srcbase;
    d.ksc = (job == 3) ? p.q_norm_w : (job == 4) ? p.kv_norm_w : nullptr;
}
__device__ __forceinline__ void wprep_load(const WprepDesc& d, f32x4 (&v)[4], int tid) {
    const int n4 = (tid & 7) * 4, kk = tid >> 3;
#pragma unroll
    for (int q = 0; q < 4; ++q) {
        v[q] = (f32x4){0.f, 0.f, 0.f, 0.f};
        if (d.srcbase >= 0) v[q] = *(const f32x4*)(d.W + (size_t)(d.k0 + kk + 32 * q) * d.ldw + d.srcbase + n4);
    }
}
__device__ __forceinline__ void wprep_emit(const WprepDesc& d, const f32x4 (&v)[4], float* tile, int tid) {
    {
        const int n4 = (tid & 7) * 4, kk = tid >> 3;
#pragma unroll
        for (int q = 0; q < 4; ++q) {
            const int k = kk + 32 * q;
            const float s = d.ksc ? d.ksc[d.k0 + k] : 1.f;
            float* t = tile + k * 33 + n4;
            t[0] = v[q][0] * s; t[1] = v[q][1] * s; t[2] = v[q][2] * s; t[3] = v[q][3] * s;
        }
    }
    __syncthreads();
    {
        const int n = tid >> 3;
#pragma unroll
        for (int q = 0; q < 2; ++q) {
            const int kc = (tid & 7) + 8 * q;
            const float* t = tile + (kc * 8) * 33 + n;
            u32x4 o;
            o[0] = pack_bf2(t[0 * 33], t[1 * 33]); o[1] = pack_bf2(t[2 * 33], t[3 * 33]);
            o[2] = pack_bf2(t[4 * 33], t[5 * 33]); o[3] = pack_bf2(t[6 * 33], t[7 * 33]);
            *(u32x4*)(d.dst + (size_t)(d.n0 + n) * d.K + d.k0 + kc * 8) = o;
        }
    }
    __syncthreads();
}

__device__ __forceinline__ void ph_wprep(const Params& p, int bid, int nb, char* smem) {
    float* tile = (float*)smem;
    const int UT = 72 * 8 + 32 * 8 + 64 * 8 + 24 * 3 + 32 * 2 + 32 * 4 + 32 * 4 + 32 * 8;
    const int tid = VTID;
    WprepDesc d, dn;
    f32x4 v[4], vn[4];
    int u = bid;
    if (u < UT) { wprep_decode(p, u, d); wprep_load(d, v, tid); }
    for (; u < UT; u += nb) {
        const bool more = (u + nb < UT);
        if (more) { wprep_decode(p, u + nb, dn); wprep_load(dn, vn, tid); }
        wprep_emit(d, v, tile, tid);
        if (more) {
            d = dn;
#pragma unroll
            for (int q = 0; q < 4; ++q) v[q] = vn[q];
        }
    }
    if (bid == nb - 1) {
        for (int i = VTID; i < 512; i += NTHR) {
            const int pos = i >> 3, f = i & 7;
            const float ang = (float)pos * powf(10000.f, -(float)f / 8.f);
            p.rope[2 * i] = cosf(ang); p.rope[2 * i + 1] = sinf(ang);
        }
    }
}

typedef short bf16x8 __attribute__((ext_vector_type(8)));


__device__ __forceinline__ int lds_off(int row, int chunk) { return row * 128 + (((chunk ^ (row >> 1)) & 7) << 4); }

__device__ __forceinline__ int epi_perm(int rho) { return 8 * ((rho >> 2) & 3) + 4 * (rho >> 4) + (rho & 3); }

__device__ __forceinline__ bool next_unit(int it, int U, int bid, int nb, int& u) {
    const int x = bid & 7, li = bid >> 3, per = nb >> 3;
    const int lo = (int)(((long)U * x) >> 3), hi = (int)(((long)U * (x + 1)) >> 3);
    u = lo + li + it * per;
    return u < hi;
}
__device__ __forceinline__ f32x4 ld_bf4(const bf16_t* p) {
    const uint2 r = *(const uint2*)p;
    return (f32x4){__uint_as_float(r.x << 16), __uint_as_float(r.x & 0xffff0000u), __uint_as_float(r.y << 16), __uint_as_float(r.y & 0xffff0000u)};
}
template <int NTN>
__device__ __forceinline__ void gemm_rows_acc(f32x4 (&acc)[NTN][2], float (&ssq)[2], const bf16_t* __restrict__ A, int lda,
                                              const bf16_t* __restrict__ Bt, int ldb, int K, int m0, int n0, char* smem) {
    constexpr int NB_ = NTN / 2;
    int tid = VTID;
    asm volatile("" : "+v"(tid));
    const int lane = tid & 63, w = tid >> 6;
    const int l15 = lane & 15, lq = lane >> 4;
    const int srow = tid >> 3, sch = (tid & 7) ^ ((srow >> 1) & 7);
    const bf16_t* ap = A + (size_t)(m0 + srow) * lda + sch * 8;
    const bf16_t* bp = Bt + (size_t)(n0 + srow) * ldb + sch * 8;
    int KT = K >> 6;
    asm volatile("" : "+s"(KT));
    LAS char* lbase = (LAS char*)smem + w * 1024;
#define GR_STAGE(ST_, KT_) do { \
        _Pragma("unroll") for (int i = 0; i < 4; ++i) \
            __builtin_amdgcn_global_load_lds((const void*)(ap + (size_t)(32 * i) * lda + (KT_) * 64), (LAS void*)(lbase + (ST_) * 32768 + i * 4096), 16, 0, 0); \
        _Pragma("unroll") for (int i = 0; i < NB_; ++i) \
            __builtin_amdgcn_global_load_lds((const void*)(bp + (size_t)(32 * i) * ldb + (KT_) * 64), (LAS void*)(lbase + (ST_) * 32768 + 16384 + i * 4096), 16, 0, 0); } while (0)
    GR_STAGE(0, 0);
    __syncthreads();
    for (int kt = 0; kt < KT; ++kt) {
        if (kt + 1 < KT) GR_STAGE((kt + 1) & 1, kt + 1);
        const char* sa = smem + (kt & 1) * 32768;
        const char* sb = sa + 16384;
#pragma unroll
        for (int ks = 0; ks < 2; ++ks) {
            bf16x8 af[2], bfr[NTN];
#pragma unroll
            for (int mt = 0; mt < 2; ++mt) af[mt] = *(const bf16x8*)(sa + lds_off(w * 32 + mt * 16 + l15, ks * 4 + lq));
#pragma unroll
            for (int nt = 0; nt < NTN; ++nt) bfr[nt] = *(const bf16x8*)(sb + lds_off(nt * 16 + l15, ks * 4 + lq));
#pragma unroll
            for (int mt = 0; mt < 2; ++mt) {
                const u32x4 aw = __builtin_bit_cast(u32x4, af[mt]);
#pragma unroll
                for (int e2 = 0; e2 < 4; ++e2) {
                    const float lo = __uint_as_float(aw[e2] << 16), hi = __uint_as_float(aw[e2] & 0xffff0000u);
                    ssq[mt] += lo * lo + hi * hi;
                }
            }
#pragma unroll
            for (int nt = 0; nt < NTN; ++nt)
#pragma unroll
                for (int mt = 0; mt < 2; ++mt)
                    acc[nt][mt] = __builtin_amdgcn_mfma_f32_16x16x32_bf16(bfr[nt], af[mt], acc[nt][mt], 0, 0, 0);
        }
        __syncthreads();
    }
#undef GR_STAGE
    ssq[0] = xrow_sum(ssq[0]);
    ssq[1] = xrow_sum(ssq[1]);
}

__device__ __forceinline__ void ph_mla_proj(const Params& p, int bid, int nb, char* smem) {
    const int tid = VTID, lane = tid & 63, w = tid >> 6, l15 = lane & 15, lq = lane >> 4;
    float* s_rope = (float*)(smem + 65536);
    float* s_qhn = s_rope + 1024;
    float* s_khn = s_qhn + 96;
    for (int i = tid; i < 1024; i += NTHR) s_rope[i] = p.rope[i];
    if (tid < 96) { s_qhn[tid] = p.qhn_w[tid]; s_khn[tid] = p.khn_w[tid]; }
    __syncthreads();
    const int UQ = 128 * 8, UK = 144 * 8;
    int u;
    for (int it = 0; next_unit(it, UQ + UK, bid, nb, u); ++it) {
        if (u < UQ) {
            const int tm = u >> 3, hh = u & 7;
            const int m0 = NCTX + tm * 128;
            f32x4 acc[6][2];
            float ssq[2] = {0.f, 0.f};
#pragma unroll
            for (int i = 0; i < 6; ++i) { acc[i][0] = (f32x4){0.f, 0.f, 0.f, 0.f}; acc[i][1] = (f32x4){0.f, 0.f, 0.f, 0.f}; }
            gemm_rows_acc<6>(acc, ssq, p.Pa + PA_CQ, PA_W, p.Wt_uq, 384, 384, m0, hh * 96, smem);
#pragma unroll
            for (int mt = 0; mt < 2; ++mt) {
                const int ml = 32 * w + 16 * mt + l15;
                const int rl = tm * 128 + ml;
                const int b = rl >> 11, t = rl & 2047;
                const float rs = rsqrtf(ssq[mt] * (1.f / 384.f) + EPSF);
                float hs = 0.f;
#pragma unroll
                for (int nt = 0; nt < 6; ++nt)
#pragma unroll
                    for (int e = 0; e < 4; ++e) { const float v = acc[nt][mt][e] * rs; acc[nt][mt][e] = v; hs += v * v; }
                hs = xrow_sum(hs);
                const float hr = rsqrtf(hs * (1.f / 96.f) + EPSF) * (0.10206207261596575f * 1.4426950408889634f);
                bf16_t* qd = p.Qb + ((size_t)((b * 8 + hh) * SEQ + t)) * 96 + 4 * lq;
#pragma unroll
                for (int nt = 0; nt < 6; ++nt) {
                    const f32x4 wv = *(const f32x4*)(s_qhn + 16 * nt + 4 * lq);
                    f32x4 v;
#pragma unroll
                    for (int e = 0; e < 4; ++e) v[e] = acc[nt][mt][e] * hr * wv[e];
                    if (nt >= 4) {
                        const int pos = (nt == 4) ? (t >> 6) : (t & 63);
                        const int ph = lq >> 1;
#pragma unroll
                        for (int e = 0; e < 4; ++e) {
                            const float2 cs = *(const float2*)(s_rope + 2 * (pos * 8 + (lq & 1) * 4 + e));
                            const float partner = __shfl_xor(v[e], 32);
                            const float t1 = ph ? partner : v[e], t2 = ph ? v[e] : partner;
                            v[e] = ph ? (t1 * cs.y + t2 * cs.x) : (t1 * cs.x - t2 * cs.y);
                        }
                    }
                    st_bf4(qd + 16 * nt, v);
                }
            }
        } else {
            const int uu = u - UQ;
            const int tm = uu >> 3, hh = uu & 7;
            const int m0 = tm * 128;
            f32x4 acc[8][2];
            float ssq[2] = {0.f, 0.f};
#pragma unroll
            for (int i = 0; i < 8; ++i) { acc[i][0] = (f32x4){0.f, 0.f, 0.f, 0.f}; acc[i][1] = (f32x4){0.f, 0.f, 0.f, 0.f}; }
            gemm_rows_acc<8>(acc, ssq, p.Pa + PA_CKV, PA_W, p.Wt_ukv, 256, 256, m0, hh * 128, smem);
#pragma unroll
            for (int mt = 0; mt < 2; ++mt) {
                const int ml = 32 * w + 16 * mt + l15;
                const int r = m0 + ml;
                int b, pos, t = 0; const bool lat = (r >= NCTX);
                if (!lat) { b = r >> 8; pos = r & 255; }
                else { const int rl = r - NCTX; b = rl >> 11; t = rl & 2047; pos = CTXL + t; }
                const float rs = rsqrtf(ssq[mt] * (1.f / 256.f) + EPSF);
                const u32x4 krw = *(const u32x4*)(p.Pa + (size_t)r * PA_W + PA_KR + 8 * lq);
                float kr[8];
#pragma unroll
                for (int e = 0; e < 4; ++e) { kr[2 * e] = __uint_as_float(krw[e] << 16); kr[2 * e + 1] = __uint_as_float(krw[e] & 0xffff0000u); }
                float hs = 0.f;
#pragma unroll
                for (int e = 0; e < 8; ++e) hs += kr[e] * kr[e];
#pragma unroll
                for (int nt = 0; nt < 4; ++nt)
#pragma unroll
                    for (int e = 0; e < 4; ++e) { const float v = acc[nt][mt][e] * rs; acc[nt][mt][e] = v; hs += v * v; }
                hs = xrow_sum(hs);
                const float hr = rsqrtf(hs * (1.f / 96.f) + EPSF);
                bf16_t* kd = p.Kb + ((size_t)((b * 8 + hh) * TPB + pos)) * 96;
#pragma unroll
                for (int nt = 0; nt < 4; ++nt) {
                    const f32x4 wv = *(const f32x4*)(s_khn + 16 * nt + 4 * lq);
                    f32x4 v;
#pragma unroll
                    for (int e = 0; e < 4; ++e) v[e] = acc[nt][mt][e] * hr * wv[e];
                    st_bf4(kd + 16 * nt + 4 * lq, v);
                }
                {
                    const int ph = lq & 1;
                    const int rp = (lq >> 1) ? (t & 63) : (t >> 6);
                    float o[8];
#pragma unroll
                    for (int e = 0; e < 8; ++e) {
                        const float v = kr[e] * hr * s_khn[64 + 8 * lq + e];
                        const float partner = __shfl_xor(v, 16);
                        float2 cs = make_float2(1.f, 0.f);
                        if (lat) cs = *(const float2*)(s_rope + 2 * (rp * 8 + e));
                        const float t1 = ph ? partner : v, t2 = ph ? v : partner;
                        o[e] = ph ? (t1 * cs.y + t2 * cs.x) : (t1 * cs.x - t2 * cs.y);
                    }
                    u32x4 ov;
                    ov[0] = pack_bf2(o[0], o[1]); ov[1] = pack_bf2(o[2], o[3]); ov[2] = pack_bf2(o[4], o[5]); ov[3] = pack_bf2(o[6], o[7]);
                    *(u32x4*)(kd + 64 + 8 * lq) = ov;
                }
                {
                    const int kpos = (pos & ~12) | ((pos & 4) << 1) | ((pos & 8) >> 1);
                    bf16_t* vd = p.Vt + (size_t)((b * 8 + hh) * 64) * TPB + kpos;
#pragma unroll
                    for (int nt = 4; nt < 8; ++nt)
#pragma unroll
                        for (int e = 0; e < 4; ++e) vd[(size_t)(16 * (nt - 4) + 4 * lq + e) * TPB] = f2bf(acc[nt][mt][e] * rs);
                }
            }
        }
    }
}

typedef float f32x16 __attribute__((ext_vector_type(16)));
#define ATT_KROW 208
#define ATT_VROW 144
#define ATT_KBYTES (64 * ATT_KROW)
#define ATT_STAGE (ATT_KBYTES + 64 * ATT_VROW)
template <bool ZI>
__device__ __forceinline__ void ph_attn_t(const Params& p, int bid, int nb, char* smem, const float negB) {
    const int tid = VTID, lane = tid & 63, w = tid >> 6, r = lane & 31, h = lane >> 5;
    int u;
    for (int it = 0; next_unit(it, 1024, bid, nb, u); ++it) {
        const int bh = u >> 4, qb = u & 15;
        bf16x8 qf[6];
        {
            const bf16_t* Qp = p.Qb + ((size_t)bh * SEQ + qb * 128 + w * 32 + r) * 96 + h * 8;
#pragma unroll
            for (int s = 0; s < 6; ++s) qf[s] = *(const bf16x8*)(Qp + s * 16);
        }
        const bf16_t* Kg = p.Kb + (size_t)bh * TPB * 96 + tid * 8;
        const bf16_t* Vg = p.Vt + (size_t)bh * 64 * TPB + (size_t)(tid >> 3) * TPB + (tid & 7) * 8;
        int koff[3], voff[2];
#pragma unroll
        for (int i = 0; i < 3; ++i) { const int c = tid + 256 * i; koff[i] = (c / 12) * ATT_KROW + (c % 12) * 16; }
#pragma unroll
        for (int i = 0; i < 2; ++i) { const int c = tid + 256 * i; voff[i] = ATT_KBYTES + (c >> 3) * ATT_VROW + (c & 7) * 16; }
        u32x4 rk[3], rv[2];
#pragma unroll
        for (int i = 0; i < 3; ++i) rk[i] = *(const u32x4*)(Kg + i * 2048);
#pragma unroll
        for (int i = 0; i < 2; ++i) rv[i] = *(const u32x4*)(Vg + (size_t)(32 * i) * TPB);
#pragma unroll
        for (int i = 0; i < 3; ++i) *(u32x4*)(smem + koff[i]) = rk[i];
#pragma unroll
        for (int i = 0; i < 2; ++i) *(u32x4*)(smem + voff[i]) = rv[i];
        __syncthreads();
        f32x16 o0, o1;
#pragma unroll
        for (int i = 0; i < 16; ++i) { o0[i] = 0.f; o1[i] = 0.f; }
        float l = 0.f;
        int NKT = TPB / 64;
        asm volatile("" : "+s"(NKT));
        for (int kt = 0; kt < NKT; ++kt) {
            if (kt + 1 < NKT) {
#pragma unroll
                for (int i = 0; i < 3; ++i) rk[i] = *(const u32x4*)(Kg + (size_t)(kt + 1) * 6144 + i * 2048);
#pragma unroll
                for (int i = 0; i < 2; ++i) rv[i] = *(const u32x4*)(Vg + (size_t)(32 * i) * TPB + (kt + 1) * 64);
            }
            const char* sk = smem + (kt & 1) * ATT_STAGE;
            const char* sv = sk + ATT_KBYTES;
            f32x16 s0, s1;
            if (ZI) {
                const f32x16 z16 = {0.f, 0.f, 0.f, 0.f, 0.f, 0.f, 0.f, 0.f, 0.f, 0.f, 0.f, 0.f, 0.f, 0.f, 0.f, 0.f};
                const bf16x8 k0 = *(const bf16x8*)(sk + r * ATT_KROW + h * 16);
                const bf16x8 k1 = *(const bf16x8*)(sk + (32 + r) * ATT_KROW + h * 16);
                s0 = __builtin_amdgcn_mfma_f32_32x32x16_bf16(k0, qf[0], z16, 0, 0, 0);
                s1 = __builtin_amdgcn_mfma_f32_32x32x16_bf16(k1, qf[0], z16, 0, 0, 0);
            } else {
#pragma unroll
                for (int i = 0; i < 16; ++i) { s0[i] = negB; s1[i] = negB; }
            }
#pragma unroll
            for (int s = ZI ? 1 : 0; s < 6; ++s) {
                const bf16x8 k0 = *(const bf16x8*)(sk + r * ATT_KROW + (2 * s + h) * 16);
                const bf16x8 k1 = *(const bf16x8*)(sk + (32 + r) * ATT_KROW + (2 * s + h) * 16);
                s0 = __builtin_amdgcn_mfma_f32_32x32x16_bf16(k0, qf[s], s0, 0, 0, 0);
                s1 = __builtin_amdgcn_mfma_f32_32x32x16_bf16(k1, qf[s], s1, 0, 0, 0);
            }
            float ls = 0.f;
#pragma unroll
            for (int i = 0; i < 16; ++i) {
                s0[i] = __builtin_amdgcn_exp2f(s0[i]);
                s1[i] = __builtin_amdgcn_exp2f(s1[i]);
                ls += s0[i] + s1[i];
            }
            l += ls;
#pragma unroll
            for (int ks = 0; ks < 4; ++ks) {
                u32x4 pw;
                if (ks < 2) {
                    pw[0] = pack_bf2(s0[8 * (ks & 1) + 0], s0[8 * (ks & 1) + 1]); pw[1] = pack_bf2(s0[8 * (ks & 1) + 2], s0[8 * (ks & 1) + 3]);
                    pw[2] = pack_bf2(s0[8 * (ks & 1) + 4], s0[8 * (ks & 1) + 5]); pw[3] = pack_bf2(s0[8 * (ks & 1) + 6], s0[8 * (ks & 1) + 7]);
                } else {
                    pw[0] = pack_bf2(s1[8 * (ks & 1) + 0], s1[8 * (ks & 1) + 1]); pw[1] = pack_bf2(s1[8 * (ks & 1) + 2], s1[8 * (ks & 1) + 3]);
                    pw[2] = pack_bf2(s1[8 * (ks & 1) + 4], s1[8 * (ks & 1) + 5]); pw[3] = pack_bf2(s1[8 * (ks & 1) + 6], s1[8 * (ks & 1) + 7]);
                }
                const bf16x8 pf = __builtin_bit_cast(bf16x8, pw);
                const bf16x8 v0 = *(const bf16x8*)(sv + r * ATT_VROW + (2 * ks + h) * 16);
                const bf16x8 v1 = *(const bf16x8*)(sv + (32 + r) * ATT_VROW + (2 * ks + h) * 16);
                o0 = __builtin_amdgcn_mfma_f32_32x32x16_bf16(v0, pf, o0, 0, 0, 0);
                o1 = __builtin_amdgcn_mfma_f32_32x32x16_bf16(v1, pf, o1, 0, 0, 0);
            }
            if (kt + 1 < NKT) {
                char* ds = smem + ((kt + 1) & 1) * ATT_STAGE;
#pragma unroll
                for (int i = 0; i < 3; ++i) *(u32x4*)(ds + koff[i]) = rk[i];
#pragma unroll
                for (int i = 0; i < 2; ++i) *(u32x4*)(ds + voff[i]) = rv[i];
            }
            __syncthreads();
        }
        l += __shfl_xor(l, 32);
        const float inv = 1.f / l;
        const int b = bh >> 3, hh = bh & 7;
        const size_t rl = (size_t)(b * SEQ + qb * 128 + w * 32 + r);
        bf16_t* op = p.A_mla + rl * 512 + hh * 64 + 4 * h;
        const bf16_t* zp = p.Pz + rl * PZ_W + hh * 64 + 4 * h;
#pragma unroll
        for (int g = 0; g < 4; ++g) {
            const f32x4 z0 = ld_bf4(zp + 8 * g), z1 = ld_bf4(zp + 32 + 8 * g);
            uint2 a, c;
            a.x = pack_bf2(o0[4 * g + 0] * inv * silu_f(z0[0]), o0[4 * g + 1] * inv * silu_f(z0[1]));
            a.y = pack_bf2(o0[4 * g + 2] * inv * silu_f(z0[2]), o0[4 * g + 3] * inv * silu_f(z0[3]));
            c.x = pack_bf2(o1[4 * g + 0] * inv * silu_f(z1[0]), o1[4 * g + 1] * inv * silu_f(z1[1]));
            c.y = pack_bf2(o1[4 * g + 2] * inv * silu_f(z1[2]), o1[4 * g + 3] * inv * silu_f(z1[3]));
            *(uint2*)(op + 8 * g) = a;
            *(uint2*)(op + 32 + 8 * g) = c;
        }
    }
}

#define AT8_VROW 272
#define AT8_KBYTES (128 * ATT_KROW)
#define AT8_STAGE (AT8_KBYTES + 64 * AT8_VROW)
__device__ __forceinline__ void ph_attn8(const Params& p, char* smem, const int pb) {
    int tid = threadIdx.x;
    asm volatile("" : "+v"(tid));
    const int lane = tid & 63, w = tid >> 6, r = lane & 31, h = lane >> 5;
    const int bh = (pb >> 5) * 8 + (pb & 7), qb = (pb >> 3) & 3;
    bf16x8 qf[2][6];
#pragma unroll
    for (int t = 0; t < 2; ++t) {
        const bf16_t* Qp = p.Qb + ((size_t)bh * SEQ + qb * 512 + w * 64 + t * 32 + r) * 96 + h * 8;
#pragma unroll
        for (int s = 0; s < 6; ++s) qf[t][s] = *(const bf16x8*)(Qp + s * 16);
    }
    const bf16_t* Kg = p.Kb + (size_t)bh * TPB * 96 + tid * 8;
    const bf16_t* Vg = p.Vt + (size_t)bh * 64 * TPB + (size_t)(tid >> 4) * TPB + (tid & 15) * 8;
    int koff[3], voff[2];
#pragma unroll
    for (int i = 0; i < 3; ++i) { const int c = tid + 512 * i; koff[i] = (c / 12) * ATT_KROW + (c % 12) * 16; }
#pragma unroll
    for (int i = 0; i < 2; ++i) { const int c = tid + 512 * i; voff[i] = AT8_KBYTES + (c >> 4) * AT8_VROW + (c & 15) * 16; }
    u32x4 rk[3], rv[2];
#pragma unroll
    for (int i = 0; i < 3; ++i) rk[i] = *(const u32x4*)(Kg + i * 4096);
#pragma unroll
    for (int i = 0; i < 2; ++i) rv[i] = *(const u32x4*)(Vg + (size_t)(32 * i) * TPB);
#pragma unroll
    for (int i = 0; i < 3; ++i) *(u32x4*)(smem + koff[i]) = rk[i];
#pragma unroll
    for (int i = 0; i < 2; ++i) *(u32x4*)(smem + voff[i]) = rv[i];
    __syncthreads();
    f32x16 o[2][2];
#pragma unroll
    for (int t = 0; t < 2; ++t)
#pragma unroll
        for (int i = 0; i < 16; ++i) { o[t][0][i] = 0.f; o[t][1][i] = 0.f; }
    float l[2] = {0.f, 0.f};
    int NKT = TPB / 128;
    asm volatile("" : "+s"(NKT));
    for (int kt = 0; kt < NKT; ++kt) {
        if (kt + 1 < NKT) {
#pragma unroll
            for (int i = 0; i < 3; ++i) rk[i] = *(const u32x4*)(Kg + (size_t)(kt + 1) * 12288 + i * 4096);
#pragma unroll
            for (int i = 0; i < 2; ++i) rv[i] = *(const u32x4*)(Vg + (size_t)(32 * i) * TPB + (kt + 1) * 128);
        }
        const char* sk = smem + (kt & 1) * AT8_STAGE;
        const char* sv = sk + AT8_KBYTES;
        int NHF = 4;
        asm volatile("" : "+s"(NHF));
        for (int hf = 0; hf < NHF; ++hf) {
            const char* skh = sk + hf * 32 * ATT_KROW;
            const char* svh = sv + hf * 64;
            f32x16 s[2];
            {
                const f32x16 z16 = {0.f, 0.f, 0.f, 0.f, 0.f, 0.f, 0.f, 0.f, 0.f, 0.f, 0.f, 0.f, 0.f, 0.f, 0.f, 0.f};
                const bf16x8 k0 = *(const bf16x8*)(skh + r * ATT_KROW + h * 16);
                s[0] = __builtin_amdgcn_mfma_f32_32x32x16_bf16(k0, qf[0][0], z16, 0, 0, 0);
                s[1] = __builtin_amdgcn_mfma_f32_32x32x16_bf16(k0, qf[1][0], z16, 0, 0, 0);
            }
#pragma unroll
            for (int ss = 1; ss < 6; ++ss) {
                const bf16x8 k0 = *(const bf16x8*)(skh + r * ATT_KROW + (2 * ss + h) * 16);
                s[0] = __builtin_amdgcn_mfma_f32_32x32x16_bf16(k0, qf[0][ss], s[0], 0, 0, 0);
                s[1] = __builtin_amdgcn_mfma_f32_32x32x16_bf16(k0, qf[1][ss], s[1], 0, 0, 0);
            }
            bf16x8 pf[2][2];
#pragma unroll
            for (int t = 0; t < 2; ++t) {
                float ls = 0.f;
#pragma unroll
                for (int i = 0; i < 16; ++i) {
                    s[t][i] = __builtin_amdgcn_exp2f(s[t][i]);
                    ls += s[t][i];
                }
                l[t] += ls;
#pragma unroll
                for (int ks = 0; ks < 2; ++ks) {
                    u32x4 pw;
#pragma unroll
                    for (int e = 0; e < 4; ++e) pw[e] = pack_bf2(s[t][8 * ks + 2 * e], s[t][8 * ks + 2 * e + 1]);
                    pf[t][ks] = __builtin_bit_cast(bf16x8, pw);
                }
            }
#pragma unroll
            for (int ks = 0; ks < 2; ++ks) {
                const bf16x8 v0 = *(const bf16x8*)(svh + r * AT8_VROW + (2 * ks + h) * 16);
                const bf16x8 v1 = *(const bf16x8*)(svh + (32 + r) * AT8_VROW + (2 * ks + h) * 16);
#pragma unroll
                for (int t = 0; t < 2; ++t) {
                    o[t][0] = __builtin_amdgcn_mfma_f32_32x32x16_bf16(v0, pf[t][ks], o[t][0], 0, 0, 0);
                    o[t][1] = __builtin_amdgcn_mfma_f32_32x32x16_bf16(v1, pf[t][ks], o[t][1], 0, 0, 0);
                }
            }
        }
        if (kt + 1 < NKT) {
            char* ds = smem + ((kt + 1) & 1) * AT8_STAGE;
#pragma unroll
            for (int i = 0; i < 3; ++i) *(u32x4*)(ds + koff[i]) = rk[i];
#pragma unroll
            for (int i = 0; i < 2; ++i) *(u32x4*)(ds + voff[i]) = rv[i];
        }
        __syncthreads();
    }
    const int b = bh >> 3, hh = bh & 7;
#pragma unroll
    for (int t = 0; t < 2; ++t) {
        const float lt = l[t] + __shfl_xor(l[t], 32);
        const float inv = 1.f / lt;
        const size_t rl = (size_t)(b * SEQ + qb * 512 + w * 64 + t * 32 + r);
        bf16_t* op = p.A_mla + rl * 512 + hh * 64 + 4 * h;
        const bf16_t* zp = p.Pz + rl * PZ_W + hh * 64 + 4 * h;
#pragma unroll
        for (int g = 0; g < 4; ++g) {
            const f32x4 z0 = ld_bf4(zp + 8 * g), z1 = ld_bf4(zp + 32 + 8 * g);
            uint2 a, c;
            a.x = pack_bf2(o[t][0][4 * g + 0] * inv * silu_f(z0[0]), o[t][0][4 * g + 1] * inv * silu_f(z0[1]));
            a.y = pack_bf2(o[t][0][4 * g + 2] * inv * silu_f(z0[2]), o[t][0][4 * g + 3] * inv * silu_f(z0[3]));
            c.x = pack_bf2(o[t][1][4 * g + 0] * inv * silu_f(z1[0]), o[t][1][4 * g + 1] * inv * silu_f(z1[1]));
            c.y = pack_bf2(o[t][1][4 * g + 2] * inv * silu_f(z1[2]), o[t][1][4 * g + 3] * inv * silu_f(z1[3]));
            *(uint2*)(op + 8 * g) = a;
            *(uint2*)(op + 32 + 8 * g) = c;
        }
    }
}

__device__ __forceinline__ void ph_attn(const Params& p, int bid, int nb, char* smem, char* smem_all, int pb) {
    const int lane = VTID & 63;
    float mq = fmaxf(fabsf(p.qhn_w[lane]), (lane < 32) ? fabsf(p.qhn_w[64 + lane]) : 0.f);
    float mk = fmaxf(fabsf(p.khn_w[lane]), (lane < 32) ? fabsf(p.khn_w[64 + lane]) : 0.f);
#pragma unroll
    for (int o = 32; o > 0; o >>= 1) { mq = fmaxf(mq, __shfl_xor(mq, o)); mk = fmaxf(mk, __shfl_xor(mk, o)); }
    const float B = (9.797958971f * 1.4426950408889634f * 1.0001f) * mq * mk;
    if (B <= 40.f) ph_attn8(p, smem_all, pb);
    else ph_attn_t<false>(p, bid, nb, smem, -B);
}

__device__ __forceinline__ int el_off(int row, int col) { return lds_off(row, col >> 3) + (col & 7) * 2; }

__device__ __forceinline__ void mm64(f32x4 (&acc)[4], const char* A, int arow0, const char* B, int l15, int lq) {
#pragma unroll
    for (int ks = 0; ks < 2; ++ks) {
        const bf16x8 a = *(const bf16x8*)(A + lds_off(arow0 + l15, ks * 4 + lq));
#pragma unroll
        for (int nt = 0; nt < 4; ++nt) {
            const bf16x8 b = *(const bf16x8*)(B + lds_off(nt * 16 + l15, ks * 4 + lq));
            acc[nt] = __builtin_amdgcn_mfma_f32_16x16x32_bf16(a, b, acc[nt], 0, 0, 0);
        }
    }
}
__device__ __forceinline__ void acc4_zero(f32x4 (&a)[4]) {
#pragma unroll
    for (int i = 0; i < 4; ++i) a[i] = (f32x4){0.f, 0.f, 0.f, 0.f};
}

#define DN_SQ 0
#define DN_SK 8192
#define DN_SV 16384
#define DN_LSTR 65
#define DN_LBYTES (64 * DN_LSTR * 4)
#define DN_SL 24576
#define DN_SA 57856
#define DN_SKD 66048
#define DN_SS 74240

typedef short s16x4 __attribute__((ext_vector_type(4)));
__device__ __forceinline__ s16x4 ds_tr(const char* p) { return __builtin_amdgcn_ds_read_tr16_b64_v4i16((LAS s16x4*)p); }

struct Dn1In { u32x4 rp[7]; float db, da, dtb, alog; float cw[4]; };
__device__ __forceinline__ void dn1_fetch(Dn1In& in, const Params& p, int u, int tid) {
    const int bh = u / 36, pb = u % 36, b = bh >> 3, h = bh & 7;
    int rowbase, seglen, lb;
    if (pb < 4) { rowbase = b * CTXL; seglen = CTXL; lb = pb; }
    else { rowbase = NCTX + b * SEQ; seglen = SEQ; lb = pb - 4; }
#pragma unroll
    for (int i = 0; i < 7; ++i) {
        const int c = tid + NTHR * i;
        const int g = c / 544, rem = c % 544, rr = rem >> 3, ch = rem & 7;
        const int lp = lb * 64 - 2 + rr;
        u32x4 val = (u32x4){0u, 0u, 0u, 0u};
        if (c < 3 * 68 * 8 && lp >= 0 && lp < seglen) val = *(const u32x4*)(p.Pa + (size_t)(rowbase + lp) * PA_W + PA_DQ + h * 192 + g * 64 + ch * 8);
        in.rp[i] = val;
    }
#pragma unroll
    for (int i = 0; i < 4; ++i) {
        const int idx = tid + NTHR * i, g = idx / 320, j = (idx % 320) >> 6, c = idx & 63;
        in.cw[i] = (idx < 960) ? p.conv_w[j * 1536 + g * 512 + h * 64 + c] : 0.f;
    }
    in.db = 0.f; in.da = 0.f; in.dtb = 0.f; in.alog = 0.f;
    if (tid < 128) {
        in.dtb = p.dt_bias[(tid >> 6) * 8 + h]; in.alog = p.a_log[(tid >> 6) * 8 + h];
        const int d = tid >> 6, tp = tid & 63;
        const int pos = d ? 63 - tp : tp;
        const bf16_t* row = p.Pa + (size_t)(rowbase + lb * 64 + pos) * PA_W;
        in.db = bf2f(row[PA_DB + d * 8 + h]);
        in.da = bf2f(row[PA_DA + d * 8 + h]);
    }
}

__device__ __forceinline__ void ph_dn1(const Params& p, int bid, int nb, char* smem) {
    char* sQ = smem + DN_SQ; char* sK = smem + DN_SK; char* sV = smem + DN_SV;
    char* sL = smem + DN_SL; char* sA = smem + DN_SA; char* sKd = smem + DN_SKD;
    float* sS = (float*)(smem + DN_SS);
    const int x_ = bid & 7, li_ = bid >> 3;
#define DN1_UNIT(IT, U, VALID) do { const int it_ = (IT); const int q_ = li_ + (it_ < 4 ? it_ * 64 : 0); const int grp_ = x_ + 8 * (q_ >> 3); \
        VALID = (it_ < 4) || (it_ == 4 && li_ < 32); \
        const int b_ = (it_ < 4) ? (grp_ >> 5) : (grp_ >> 2), pb_ = (it_ < 4) ? 4 + (grp_ & 31) : (grp_ & 3); U = (b_ * 8 + (q_ & 7)) * 36 + pb_; } while (0)
    Dn1In in;
    int u, un; bool valid, validn;
    DN1_UNIT(0, u, valid);
    if (valid) dn1_fetch(in, p, u, VTID);
    for (int it = 0; valid; ++it, u = un, valid = validn) {
        DN1_UNIT(it + 1, un, validn);
        int tid = VTID;
        asm volatile("" : "+v"(tid));
        const int lane = tid & 63, w = tid >> 6, l15 = lane & 15, lq = lane >> 4;
        const int bh = u / 36, pb = u % 36, h = bh & 7;
        const bool lat = (pb >= 4);
        if (tid < 128) {
            const int d = tid >> 6, tp = lane;
            const float xx = in.da + in.dtb;
            const float sp = (xx > 20.f) ? xx : log1pf(__expf(xx));
            const float g = -__expf(in.alog) * sp;
            float gc = g;
#pragma unroll
            for (int o = 1; o < 64; o <<= 1) { const float t = __shfl_up(gc, o); if (lane >= o) gc += t; }
            const float gl = __shfl(gc, 63);
            const float bt = sigmoid_f(in.db), eg = __expf(gc);
            sS[(d * 5 + 0) * 64 + tp] = bt;
            sS[(d * 5 + 1) * 64 + tp] = gc;
            sS[(d * 5 + 2) * 64 + tp] = eg;
            sS[(d * 5 + 3) * 64 + tp] = __expf(gl - gc);
            sS[(d * 5 + 4) * 64 + tp] = bt * eg;
        }
        {
            char* raw = sL;
#pragma unroll
            for (int i = 0; i < 7; ++i) {
                const int c = tid + NTHR * i;
                const int g = c / 544, rem = c % 544, rr = rem >> 3, ch = rem & 7;
                if (c < 3 * 68 * 8) *(u32x4*)(raw + (g * 68 + rr) * 128 + ch * 16) = in.rp[i];
            }
            float* cwS = (float*)(sL + 26112);
#pragma unroll
            for (int i = 0; i < 4; ++i) { const int idx = tid + NTHR * i; if (idx < 960) cwS[idx] = in.cw[i]; }
            if (validn) dn1_fetch(in, p, un, tid);
            __syncthreads();
            const int o = tid & 7, r0 = tid >> 3;
#pragma unroll
            for (int g = 0; g < 3; ++g) {
                if (g == 0 && !lat) continue;
                float wj[5][8];
#pragma unroll
                for (int j = 0; j < 5; ++j) {
                    const f32x4 w0 = *(const f32x4*)(cwS + (g * 5 + j) * 64 + 8 * o), w1 = *(const f32x4*)(cwS + (g * 5 + j) * 64 + 8 * o + 4);
#pragma unroll
                    for (int e2 = 0; e2 < 4; ++e2) { wj[j][e2] = w0[e2]; wj[j][4 + e2] = w1[e2]; }
                }
#pragma unroll
                for (int hh = 0; hh < 2; ++hh) {
                    const int rr = r0 + 32 * hh;
                    float a[8];
#pragma unroll
                    for (int e2 = 0; e2 < 8; ++e2) a[e2] = 0.f;
#pragma unroll
                    for (int j = 0; j < 5; ++j) {
                        const u32x4 dv = *(const u32x4*)(raw + (g * 68 + rr + j) * 128 + o * 16);
#pragma unroll
                        for (int e2 = 0; e2 < 4; ++e2) {
                            a[2 * e2] += __uint_as_float(dv[e2] << 16) * wj[j][2 * e2];
                            a[2 * e2 + 1] += __uint_as_float(dv[e2] & 0xffff0000u) * wj[j][2 * e2 + 1];
                        }
                    }
                    float ss = 0.f;
#pragma unroll
                    for (int e2 = 0; e2 < 8; ++e2) { a[e2] = silu_f(a[e2]); ss += a[e2] * a[e2]; }
                    float sc = 1.f;
                    if (g < 2) {
                        ss += dpp_mov<0xB1>(ss); ss += dpp_mov<0x4E>(ss); ss += dpp_mov<0x141>(ss);
                        sc = rsqrtf(ss + EPSF) * (g == 0 ? 0.125f : 1.f);
                    }
                    u32x4 ov;
#pragma unroll
                    for (int e2 = 0; e2 < 4; ++e2) ov[e2] = pack_bf2(a[2 * e2] * sc, a[2 * e2 + 1] * sc);
                    *(u32x4*)((g == 0 ? sQ : g == 1 ? sK : sV) + lds_off(rr, o)) = ov;
                }
            }
            __syncthreads();
        }
        {
            f32x4 G[4];
            acc4_zero(G);
            mm64(G, sK, 16 * w, sK, l15, lq);
            float* L0 = (float*)sL; float* L1 = (float*)(sL + DN_LBYTES);
            const int t0 = 16 * w + 4 * lq;
            const f32x4 be0t = *(const f32x4*)(sS + 0 * 64 + t0), gc0t = *(const f32x4*)(sS + 1 * 64 + t0);
            const f32x4 be1r = *(const f32x4*)(sS + 5 * 64 + 60 - t0), gc1r = *(const f32x4*)(sS + 6 * 64 + 60 - t0);
            float gc0s[4], gc1s[4];
#pragma unroll
            for (int nt = 0; nt < 4; ++nt) { gc0s[nt] = sS[1 * 64 + 16 * nt + l15]; gc1s[nt] = sS[6 * 64 + 63 - (16 * nt + l15)]; }
#pragma unroll
            for (int nt = 0; nt < 4; ++nt)
#pragma unroll
                for (int rg = 0; rg < 4; ++rg) {
                    const int t = t0 + rg, s = 16 * nt + l15;
                    const float gv = G[nt][rg];
                    const int tp = 63 - t, sp = 63 - s;
                    const float e0 = be0t[rg] * gv * __expf(gc0t[rg] - gc0s[nt]);
                    const float e1 = be1r[3 - rg] * gv * __expf(gc1r[3 - rg] - gc1s[nt]);
                    L0[t * DN_LSTR + s] = (s < t) ? e0 : 0.f;
                    L1[tp * DN_LSTR + sp] = (s > t) ? e1 : 0.f;
                }
            __syncthreads();
        }
        {
            int tid3 = tid;
            asm volatile("" : "+v"(tid3) :: "memory");
            const int lane3 = tid3 & 63, w3 = tid3 >> 6, l15c = lane3 & 15, lqc = lane3 >> 4;
            if (tid3 < 128) {
                float* Lb = (float*)(sL + w3 * DN_LBYTES) + (16 * lqc) * DN_LSTR + 16 * lqc;
                float x[16];
#pragma unroll
                for (int i = 0; i < 16; ++i) {
                    float v = (i == l15c) ? 1.f : 0.f;
#pragma unroll
                    for (int j = 0; j < i; ++j) v -= Lb[i * DN_LSTR + j] * x[j];
                    x[i] = v;
                }
#pragma unroll
                for (int i = 0; i < 16; ++i) Lb[i * DN_LSTR + l15c] = x[i];
            }
            __syncthreads();
            {
                const int d = w3 >> 1, pr = w3 & 1, b0 = 2 * pr, b1 = 2 * pr + 1;
                float* Ld = (float*)(sL + d * DN_LBYTES);
                float* scr = (float*)(sA) + w3 * 272;
                f32x4 P = (f32x4){0.f, 0.f, 0.f, 0.f};
#pragma unroll
                for (int kk = 0; kk < 4; ++kk)
                    P = __builtin_amdgcn_mfma_f32_16x16x4f32(Ld[(16 * b1 + l15c) * DN_LSTR + 16 * b0 + 4 * kk + lqc],
                                                            Ld[(16 * b0 + 4 * kk + lqc) * DN_LSTR + 16 * b0 + l15c], P, 0, 0, 0);
#pragma unroll
                for (int rg = 0; rg < 4; ++rg) scr[(4 * lqc + rg) * 17 + l15c] = P[rg];
                f32x4 R = (f32x4){0.f, 0.f, 0.f, 0.f};
#pragma unroll
                for (int kk = 0; kk < 4; ++kk)
                    R = __builtin_amdgcn_mfma_f32_16x16x4f32(Ld[(16 * b1 + l15c) * DN_LSTR + 16 * b1 + 4 * kk + lqc],
                                                            scr[(4 * kk + lqc) * 17 + l15c], R, 0, 0, 0);
#pragma unroll
                for (int rg = 0; rg < 4; ++rg) Ld[(16 * b1 + 4 * lqc + rg) * DN_LSTR + 16 * b0 + l15c] = -R[rg];
            }
            __syncthreads();
            {
                const int d = w3 >> 1, hf = w3 & 1;
                float* Ld = (float*)(sL + d * DN_LBYTES);
                float* scr2 = (float*)(d ? sKd : sA);
                f32x4 P2[2];
                P2[0] = (f32x4){0.f, 0.f, 0.f, 0.f}; P2[1] = (f32x4){0.f, 0.f, 0.f, 0.f};
#pragma unroll
                for (int kk = 0; kk < 8; ++kk) {
                    const float a = Ld[(32 + 16 * hf + l15c) * DN_LSTR + 4 * kk + lqc];
#pragma unroll
                    for (int n2 = 0; n2 < 2; ++n2)
                        P2[n2] = __builtin_amdgcn_mfma_f32_16x16x4f32(a, Ld[(4 * kk + lqc) * DN_LSTR + 16 * n2 + l15c], P2[n2], 0, 0, 0);
                }
#pragma unroll
                for (int n2 = 0; n2 < 2; ++n2)
#pragma unroll
                    for (int rg = 0; rg < 4; ++rg) scr2[(16 * hf + 4 * lqc + rg) * 33 + 16 * n2 + l15c] = P2[n2][rg];
                __syncthreads();
                f32x4 R2[2];
                R2[0] = (f32x4){0.f, 0.f, 0.f, 0.f}; R2[1] = (f32x4){0.f, 0.f, 0.f, 0.f};
#pragma unroll
                for (int kk = 0; kk < 8; ++kk) {
                    const float a = Ld[(32 + 16 * hf + l15c) * DN_LSTR + 32 + 4 * kk + lqc];
#pragma unroll
                    for (int n2 = 0; n2 < 2; ++n2)
                        R2[n2] = __builtin_amdgcn_mfma_f32_16x16x4f32(a, scr2[(4 * kk + lqc) * 33 + 16 * n2 + l15c], R2[n2], 0, 0, 0);
                }
#pragma unroll
                for (int n2 = 0; n2 < 2; ++n2)
#pragma unroll
                    for (int rg = 0; rg < 4; ++rg) Ld[(32 + 16 * hf + 4 * lqc + rg) * DN_LSTR + 16 * n2 + l15c] = -R2[n2][rg];
            }
            __syncthreads();
#pragma unroll 1
            for (int d = 0; d < 2; ++d) {
                const float* Td = (const float*)(sL + d * DN_LBYTES);
                {
                    const int tr = tid3 >> 2, cq = tid3 & 3;
                    const float* c1 = sS + (d * 5 + 0) * 64 + 16 * cq;
                    const float* c2 = sS + (d * 5 + 4) * 64 + 16 * cq;
                    const float* trow = Td + tr * DN_LSTR + 16 * cq;
                    float tv[16];
#pragma unroll
                    for (int e2 = 0; e2 < 16; ++e2) tv[e2] = trow[e2];
#pragma unroll
                    for (int q = 0; q < 2; ++q) {
                        u32x4 o1, o2;
#pragma unroll
                        for (int e2 = 0; e2 < 4; ++e2) {
                            const int i0 = 8 * q + 2 * e2;
                            o1[e2] = pack_bf2(tv[i0] * c1[i0], tv[i0 + 1] * c1[i0 + 1]);
                            o2[e2] = pack_bf2(tv[i0] * c2[i0], tv[i0 + 1] * c2[i0 + 1]);
                        }
                        *(u32x4*)(sA + lds_off(tr, 2 * cq + q)) = o1;
                        *(u32x4*)(sKd + lds_off(tr, 2 * cq + q)) = o2;
                    }
                }
                __syncthreads();
                f32x4 U[4], W[4];
                acc4_zero(U); acc4_zero(W);
                {
#pragma unroll
                    for (int ks = 0; ks < 2; ++ks) {
                        const bf16x8 a1 = *(const bf16x8*)(sA + lds_off(16 * w3 + l15c, ks * 4 + lqc));
                        const bf16x8 a2 = *(const bf16x8*)(sKd + lds_off(16 * w3 + l15c, ks * 4 + lqc));
                        const int r0 = 32 * ks + 8 * lqc + (l15c >> 2);
                        const int p0 = d ? 63 - r0 : r0, p1 = d ? 63 - (r0 + 4) : (r0 + 4);
#pragma unroll
                        for (int nt = 0; nt < 4; ++nt) {
                            const int col = 16 * nt + 4 * (l15c & 3);
                            const s16x4 v0 = ds_tr(sV + el_off(p0, col)), v1 = ds_tr(sV + el_off(p1, col));
                            const s16x4 k0 = ds_tr(sK + el_off(p0, col)), k1 = ds_tr(sK + el_off(p1, col));
                            U[nt] = __builtin_amdgcn_mfma_f32_16x16x32_bf16(a1, __builtin_shufflevector(v0, v1, 0, 1, 2, 3, 4, 5, 6, 7), U[nt], 0, 0, 0);
                            W[nt] = __builtin_amdgcn_mfma_f32_16x16x32_bf16(a2, __builtin_shufflevector(k0, k1, 0, 1, 2, 3, 4, 5, 6, 7), W[nt], 0, 0, 0);
                        }
                    }
                }
                __syncthreads();
                {
                    char* uT = sL + d * DN_LBYTES;
                    char* wT = uT + 8192;
                    const int t0 = 16 * w3 + 4 * lqc;
#pragma unroll
                    for (int nt = 0; nt < 4; ++nt) {
                        uint2 ou, ow;
                        ou.x = pack_bf2(U[nt][0], U[nt][1]); ou.y = pack_bf2(U[nt][2], U[nt][3]);
                        ow.x = pack_bf2(W[nt][0], W[nt][1]); ow.y = pack_bf2(W[nt][2], W[nt][3]);
                        *(uint2*)(uT + el_off(16 * nt + l15c, t0)) = ou;
                        *(uint2*)(wT + el_off(16 * nt + l15c, t0)) = ow;
                    }
                }
                __syncthreads();
            }
        }
        int tid5 = tid;
        asm volatile("" : "+v"(tid5) :: "memory");
        const int lane5 = tid5 & 63, w5 = tid5 >> 6, l15_5 = lane5 & 15, lq5 = lane5 >> 4;
        f32x4 QK[4];
        acc4_zero(QK);
        mm64(QK, sQ, 16 * w5, sK, l15_5, lq5);
#pragma unroll 1
        for (int d = 0; d < 2; ++d) {
            const float* gcd = sS + (d * 5 + 1) * 64;
            const float* egd = sS + (d * 5 + 2) * 64;
            const float* ekd = sS + (d * 5 + 3) * 64;
            {
                const int i = lane5, tq = w5;
                float kv[16];
#pragma unroll
                for (int e = 0; e < 16; ++e) {
                    const int tp = tq * 16 + e, pos = d ? 63 - tp : tp;
                    kv[e] = bf2f(*(const bf16_t*)(sK + el_off(pos, i))) * ekd[tp];
                }
#pragma unroll
                for (int q = 0; q < 2; ++q) {
                    u32x4 o;
                    o[0] = pack_bf2(kv[8 * q + 0], kv[8 * q + 1]); o[1] = pack_bf2(kv[8 * q + 2], kv[8 * q + 3]);
                    o[2] = pack_bf2(kv[8 * q + 4], kv[8 * q + 5]); o[3] = pack_bf2(kv[8 * q + 6], kv[8 * q + 7]);
                    *(u32x4*)(sKd + lds_off(i, 2 * tq + q)) = o;
                }
            }
#pragma unroll
            for (int nt = 0; nt < 4; ++nt)
#pragma unroll
                for (int rg = 0; rg < 4; ++rg) {
                    const int t = 16 * w5 + 4 * lq5 + rg, s = 16 * nt + l15_5;
                    const int tp = d ? 63 - t : t, sp = d ? 63 - s : s;
                    const float val = (sp <= tp) ? QK[nt][rg] * __expf(gcd[tp] - gcd[sp]) : 0.f;
                    *(bf16_t*)(sA + el_off(tp, sp)) = f2bf(val);
                }
            __syncthreads();
            const char* uT = sL + d * DN_LBYTES;
            const char* wT = uT + 8192;
            const int cd = (d == 0) ? pb : (pb < 4 ? 3 - pb : 39 - pb);
            bf16_t* Mg = p.MH + ((size_t)((bh * 2 + d) * 36 + cd) * 2) * 4096;
            bf16_t* Hg = Mg + 4096;
            {
                f32x4 MT[4];
                acc4_zero(MT);
                mm64(MT, wT, 16 * w5, sKd, l15_5, lq5);
                const float egl = egd[63];
                const int j0 = 16 * w5 + 4 * lq5;
#pragma unroll
                for (int nt = 0; nt < 4; ++nt) {
                    const int i = 16 * nt + l15_5;
                    f32x4 o;
#pragma unroll
                    for (int e = 0; e < 4; ++e) o[e] = ((i == j0 + e) ? egl : 0.f) - MT[nt][e];
                    st_bf4(Mg + i * 64 + j0, o);
                }
            }
            {
                f32x4 HH[4];
                acc4_zero(HH);
                mm64(HH, sKd, 16 * w5, uT, l15_5, lq5);
                const int i0 = 16 * w5 + 4 * lq5;
#pragma unroll
                for (int nt = 0; nt < 4; ++nt) st_bf4(Hg + (16 * nt + l15_5) * 64 + i0, HH[nt]);
            }
            if (lat) {
                bf16_t* Eg = p.EF + ((size_t)((bh * 2 + d) * 32 + (pb - 4)) * 2) * 4096;
                bf16_t* Fg = Eg + 4096;
                {
                    f32x4 ET[4];
                    acc4_zero(ET);
                    mm64(ET, wT, 16 * w5, sA, l15_5, lq5);
                    const int j0 = 16 * w5 + 4 * lq5;
#pragma unroll
                    for (int nt = 0; nt < 4; ++nt) {
                        const int sp = 16 * nt + l15_5, spos = d ? 63 - sp : sp;
                        const f32x4 qv = ld_bf4((const bf16_t*)(sQ + el_off(spos, j0)));
                        const float eg = egd[sp];
                        f32x4 o;
#pragma unroll
                        for (int e = 0; e < 4; ++e) o[e] = qv[e] * eg - ET[nt][e];
                        st_bf4(Eg + spos * 64 + j0, o);
                    }
                }
                {
                    f32x4 FF[4];
                    acc4_zero(FF);
                    mm64(FF, uT, 16 * w5, sA, l15_5, lq5);
                    const int c0 = 16 * w5 + 4 * lq5;
#pragma unroll
                    for (int nt = 0; nt < 4; ++nt) {
                        const int sp = 16 * nt + l15_5, spos = d ? 63 - sp : sp;
                        st_bf4(Fg + spos * 64 + c0, FF[nt]);
                    }
                }
            }
            __syncthreads();
        }
    }
}

struct Dn2Frag { bf16x8 am[2]; uint2 hr; };
__device__ __forceinline__ void dn2_load(Dn2Frag& f, const bf16_t* Mg, int w, int l15, int lq, int i0, int hf, int n2) {
#pragma unroll
    for (int ks = 0; ks < 2; ++ks) f.am[ks] = *(const bf16x8*)(Mg + (16 * w + l15) * 64 + ks * 32 + lq * 8);
    f.hr = *(const uint2*)(Mg + 4096 + (32 * hf + 16 * n2 + l15) * 64 + i0);
}
__device__ __forceinline__ void dn2_step(const Dn2Frag& f, int c, int d, int hf, int n2, bf16_t* STc, char* smem, int l15, int lq, int i0) {
    const char* sS = smem + (c & 1) * 4096;
    char* sN = smem + ((c + 1) & 1) * 4096;
    f32x4 acc = (f32x4){__uint_as_float(f.hr.x << 16), __uint_as_float(f.hr.x & 0xffff0000u), __uint_as_float(f.hr.y << 16), __uint_as_float(f.hr.y & 0xffff0000u)};
#pragma unroll
    for (int ks = 0; ks < 2; ++ks) {
        const bf16x8 bs = *(const bf16x8*)(sS + lds_off(16 * n2 + l15, ks * 4 + lq));
        acc = __builtin_amdgcn_mfma_f32_16x16x32_bf16(f.am[ks], bs, acc, 0, 0, 0);
    }
    const int cn = c + 1;
    const bool st = (cn >= 4 && cn <= 35);
    const int pbi = (d == 0 ? cn : 39 - cn) - 4;
    uint2 o; o.x = pack_bf2(acc[0], acc[1]); o.y = pack_bf2(acc[2], acc[3]);
    const int cl = 16 * n2 + l15;
    *(uint2*)(sN + el_off(cl, i0)) = o;
    if (st) *(uint2*)(STc + (size_t)pbi * 4096 + (32 * hf + cl) * 64 + i0) = o;
    __syncthreads();
}
__device__ __forceinline__ void ph_dn2(const Params& p, char* smem, const int pb) {
    const int tid = threadIdx.x, lane = tid & 63, w8 = tid >> 6, w = w8 & 3, n2 = w8 >> 2, l15 = lane & 15, lq = lane >> 4;
    const int x = pb & 7, j = pb >> 3;
    const int chain = (j >> 1) * 8 + x, hf = j & 1, d = chain & 1;
    const bf16_t* MHc = p.MH + (size_t)chain * 36 * 2 * 4096;
    bf16_t* STc = p.ST + (size_t)chain * 32 * 4096;
    if (tid < 256) *(u32x4*)(smem + tid * 16) = (u32x4){0u, 0u, 0u, 0u};
    __syncthreads();
    const int i0 = 16 * w + 4 * lq;
    Dn2Frag f0, f1, f2, f3;
    dn2_load(f0, MHc + (size_t)0 * 8192, w, l15, lq, i0, hf, n2);
    dn2_load(f1, MHc + (size_t)1 * 8192, w, l15, lq, i0, hf, n2);
    dn2_load(f2, MHc + (size_t)2 * 8192, w, l15, lq, i0, hf, n2);
    dn2_load(f3, MHc + (size_t)3 * 8192, w, l15, lq, i0, hf, n2);
    for (int c0 = 0; c0 < 36; c0 += 4) {
        const bool more = (c0 + 4 < 36);
        dn2_step(f0, c0 + 0, d, hf, n2, STc, smem, l15, lq, i0);
        if (more) dn2_load(f0, MHc + (size_t)(c0 + 4) * 8192, w, l15, lq, i0, hf, n2);
        dn2_step(f1, c0 + 1, d, hf, n2, STc, smem, l15, lq, i0);
        if (more) dn2_load(f1, MHc + (size_t)(c0 + 5) * 8192, w, l15, lq, i0, hf, n2);
        dn2_step(f2, c0 + 2, d, hf, n2, STc, smem, l15, lq, i0);
        if (more) dn2_load(f2, MHc + (size_t)(c0 + 6) * 8192, w, l15, lq, i0, hf, n2);
        dn2_step(f3, c0 + 3, d, hf, n2, STc, smem, l15, lq, i0);
        if (more) dn2_load(f3, MHc + (size_t)(c0 + 7) * 8192, w, l15, lq, i0, hf, n2);
    }
}

__device__ __forceinline__ void ph_dn3(const Params& p, int bid, int nb, char* smem) {
    const int tid = VTID, lane = tid & 63, w = tid >> 6, l15 = lane & 15, lq = lane >> 4;
    const int srow = tid >> 3, sch = (tid & 7) ^ ((srow >> 1) & 7);
    LAS char* lbase = (LAS char*)smem + w * 1024;
#define DN3_STAGE(BUF, U_) do { const int bh_ = (U_) >> 5, pbi_ = (U_) & 31; \
        _Pragma("unroll") for (int d_ = 0; d_ < 2; ++d_) { \
            const bf16_t* Sg_ = p.ST + ((size_t)(bh_ * 2 + d_) * 32 + pbi_) * 4096 + (size_t)srow * 64 + sch * 8; \
            _Pragma("unroll") for (int i_ = 0; i_ < 2; ++i_) \
                __builtin_amdgcn_global_load_lds((const void*)(Sg_ + (size_t)(32 * i_) * 64), (LAS void*)(lbase + (BUF) * 16384 + d_ * 8192 + i_ * 4096), 16, 0, 0); } } while (0)
    int u = bid, buf = 0;
    if (u < 64 * 32) DN3_STAGE(0, u);
    for (; u < 64 * 32; u += nb, buf ^= 1) {
        const int bh = u >> 5, pbi = u & 31, b = bh >> 3, h = bh & 7;
        const int s = 16 * w + l15;
        const size_t rl = (size_t)b * SEQ + pbi * 64 + s;
        f32x4 zdv[4];
#pragma unroll
        for (int mt = 0; mt < 4; ++mt) zdv[mt] = ld_bf4(p.Pz + rl * PZ_W + 512 + h * 64 + 16 * mt + 4 * lq);
        f32x4 acc[4];
        acc4_zero(acc);
        bf16x8 be[2][2];
#pragma unroll
        for (int d = 0; d < 2; ++d) {
            const bf16_t* Eg = p.EF + ((size_t)((bh * 2 + d) * 32 + pbi) * 2) * 4096;
            const bf16_t* Fg = Eg + 4096;
#pragma unroll
            for (int mt = 0; mt < 4; ++mt) acc[mt] += ld_bf4(Fg + s * 64 + 16 * mt + 4 * lq);
#pragma unroll
            for (int ks = 0; ks < 2; ++ks) be[d][ks] = *(const bf16x8*)(Eg + s * 64 + ks * 32 + lq * 8);
        }
        __syncthreads();
        if (u + nb < 64 * 32) DN3_STAGE(buf ^ 1, u + nb);
#pragma unroll
        for (int d = 0; d < 2; ++d) {
            const char* sS = smem + buf * 16384 + d * 8192;
#pragma unroll
            for (int ks = 0; ks < 2; ++ks)
#pragma unroll
                for (int mt = 0; mt < 4; ++mt) {
                    const bf16x8 as = *(const bf16x8*)(sS + lds_off(16 * mt + l15, ks * 4 + lq));
                    acc[mt] = __builtin_amdgcn_mfma_f32_16x16x32_bf16(as, be[d][ks], acc[mt], 0, 0, 0);
                }
        }
        float ss = 0.f;
#pragma unroll
        for (int mt = 0; mt < 4; ++mt)
#pragma unroll
            for (int rg = 0; rg < 4; ++rg) ss += acc[mt][rg] * acc[mt][rg];
        ss = xrow_sum(ss);
        const float rstd = rsqrtf(ss * (1.f / 64.f) + EPSF);
#pragma unroll
        for (int mt = 0; mt < 4; ++mt) {
            const f32x4 nw = *(const f32x4*)(p.dn_norm_w + 16 * mt + 4 * lq);
            f32x4 o;
#pragma unroll
            for (int rg = 0; rg < 4; ++rg) o[rg] = acc[mt][rg] * rstd * nw[rg] * silu_f(zdv[mt][rg]);
            st_bf4(p.A_dn + rl * 512 + h * 64 + 16 * mt + 4 * lq, o);
        }
    }
#undef DN3_STAGE
    __syncthreads();
}

namespace g8 {
constexpr int BM = 256, BK = 64, HALF = 128, HTB = HALF * BK * 2, STAGE_BYTES = 8 * HTB;
__device__ __forceinline__ int lds_byte(int r, int c) { const int st = (r >> 4) * 2 + (c >> 5), rr = r & 15, cc = c & 31, ob = rr * 64 + cc * 2; return st * 1024 + (ob ^ (((ob >> 9) & 1) << 5)); }
__device__ __forceinline__ void stage_rc(int b, int& R, int& C) { const int st = b / 1024, sb = b % 1024, swz = sb ^ (((sb >> 9) & 1) << 5); R = (st >> 1) * 16 + swz / 64; C = (st & 1) * 32 + (swz % 64) / 2; }
__device__ __forceinline__ int perm32(int rho) { const int n = rho >> 4, i = rho & 15; return 8 * (i >> 2) + 4 * n + (i & 3); }
struct Unit { int pm, pn, sel; };
typedef f32x4 Acc[2][2][4][2];

template <class Epi, class Sched>
__device__ __forceinline__ void gemm_phase(LAS unsigned char* lds, const bf16_t* A, const bf16_t* A1, int lda, const bf16_t* Bt, int K, const Sched& S, const Epi& E) {
    int tid = threadIdx.x;
    asm volatile("" : "+v"(tid));
    const int wid = __builtin_amdgcn_readfirstlane(tid >> 6), lane = tid & 63, wr = wid >> 2, wc = wid & 3, fr = lane & 15, fq = lane >> 4;
    const int nt = K / BK;
    unsigned voffA[2], voffB[2];
#pragma unroll
    for (int i = 0; i < 2; ++i) { int R, C; stage_rc(tid * 16 + i * 8192, R, C); const int Rb = Epi::PERM ? ((R & ~31) + perm32(R & 31)) : R;
        voffA[i] = (unsigned)(R * lda + C) * 2u; voffB[i] = (unsigned)(Rb * K + C) * 2u; }
    const size_t kstep = (size_t)(BK * 2);
    const size_t hstepA = (size_t)HALF * lda * 2, hstepB = (size_t)HALF * K * 2;
    const size_t tstepA = 2 * hstepA, tstepB = 2 * hstepB;
    const unsigned ldsw = (unsigned)wid * 1024u;
    const int aoff = lds_byte(wr * 64 + fr, fq * 8), boff = lds_byte(wc * 32 + fr, fq * 8);
#define G8_SA(b, h) (((b) * 2 + (h)) * HTB)
#define G8_SB(b, h) ((4 + (b) * 2 + (h)) * HTB)
#define G8_STAGE(bufoff, gbase, voff) do { _Pragma("unroll") for (int _i = 0; _i < 2; ++_i) \
        __builtin_amdgcn_global_load_lds((const unsigned*)((const char*)(gbase) + (voff)[_i]), (LAS unsigned*)(lds + (bufoff) + ldsw + _i * 8192), 16, 0, 0); } while (0)
#define G8_LDA(dst, b, h) do { _Pragma("unroll") for (int m = 0; m < 4; ++m) _Pragma("unroll") for (int k = 0; k < 2; ++k) dst[m][k] = *(const LAS bf16x8*)(lds + G8_SA(b, h) + aoff + m * 2048 + k * 1024); } while (0)
#define G8_LDB(dst, b, h) do { _Pragma("unroll") for (int n = 0; n < 2; ++n) _Pragma("unroll") for (int k = 0; k < 2; ++k) dst[n][k] = *(const LAS bf16x8*)(lds + G8_SB(b, h) + boff + n * 2048 + k * 1024); } while (0)
#define G8_MMA(ai, bj, At, Bt_) do { __builtin_amdgcn_s_setprio(1); _Pragma("unroll") for (int m = 0; m < 4; ++m) _Pragma("unroll") for (int n = 0; n < 2; ++n) _Pragma("unroll") for (int k = 0; k < 2; ++k) \
        acc[ai][bj][m][n] = __builtin_amdgcn_mfma_f32_16x16x32_bf16(Bt_[n][k], At[m][k], acc[ai][bj][m][n], 0, 0, 0); __builtin_amdgcn_s_setprio(0); } while (0)
#define G8_WAIT_V(n) asm volatile("s_waitcnt vmcnt(" #n ")" ::: "memory")
#define G8_WAIT_L(n) asm volatile("s_waitcnt lgkmcnt(" #n ")" ::: "memory")
#define G8_BAR __builtin_amdgcn_s_barrier()
#define G8_SCHED __builtin_amdgcn_sched_barrier(0)
    Unit cur, nxt; int ui = 0;
    if (!S.next(0, cur)) return;
    Acc acc;
#pragma unroll
    for (int a = 0; a < 2; ++a)
#pragma unroll
        for (int b = 0; b < 2; ++b)
#pragma unroll
            for (int m = 0; m < 4; ++m)
#pragma unroll
                for (int n = 0; n < 2; ++n) acc[a][b][m][n] = (f32x4){0.f, 0.f, 0.f, 0.f};
    bf16x8 At[4][2], B0[2][2], B1[2][2];
    const char* cA = (const char*)(cur.sel ? A1 : A) + (size_t)cur.pm * tstepA; const char* cB = (const char*)Bt + (size_t)cur.pn * tstepB;
    G8_STAGE(G8_SB(0, 0), cB, voffB); G8_STAGE(G8_SA(0, 0), cA, voffA); G8_STAGE(G8_SB(0, 1), cB + hstepB, voffB); G8_STAGE(G8_SA(0, 1), cA + hstepA, voffA);
    if (wr == 1) G8_BAR;
    G8_WAIT_V(4); G8_BAR;
    G8_STAGE(G8_SB(1, 0), cB + kstep, voffB); G8_STAGE(G8_SA(1, 0), cA + kstep, voffA); G8_STAGE(G8_SB(1, 1), cB + hstepB + kstep, voffB);
    G8_WAIT_V(6); G8_BAR;
    for (;;) {
        const bool has_next = S.next(ui + 1, nxt);
        const char* nA = has_next ? (const char*)(nxt.sel ? A1 : A) + (size_t)nxt.pm * tstepA : cA; const char* nB = has_next ? (const char*)Bt + (size_t)nxt.pn * tstepB : cB;
        for (int t = 0; t < nt; t += 2) {
            const bool last = (t == nt - 2);
            const char* a1 = cA + (size_t)(t + 1) * kstep;
            const char* a2 = last ? nA : cA + (size_t)(t + 2) * kstep; const char* b2 = last ? nB : cB + (size_t)(t + 2) * kstep;
            const char* a3 = a2 + kstep; const char* b3 = b2 + kstep;
            G8_LDB(B0, 0, 0); G8_SCHED; G8_LDA(At, 0, 0); G8_STAGE(G8_SA(1, 1), a1 + hstepA, voffA);
            G8_WAIT_L(8); G8_BAR; G8_WAIT_L(0); G8_MMA(0, 0, At, B0); G8_BAR; G8_SCHED;
            G8_LDB(B1, 0, 1); G8_STAGE(G8_SB(0, 0), b2, voffB);
            G8_BAR; G8_WAIT_L(0); G8_MMA(0, 1, At, B1); G8_BAR;
            G8_LDA(At, 0, 1); G8_STAGE(G8_SA(0, 0), a2, voffA);
            G8_BAR; G8_WAIT_L(0); G8_MMA(1, 0, At, B0); G8_BAR; G8_SCHED;
            G8_STAGE(G8_SB(0, 1), b2 + hstepB, voffB);
            G8_WAIT_V(6); G8_BAR; G8_MMA(1, 1, At, B1); G8_BAR;
            G8_LDB(B0, 1, 0); G8_SCHED; G8_LDA(At, 1, 0); G8_STAGE(G8_SA(0, 1), a2 + hstepA, voffA);
            G8_WAIT_L(8); G8_BAR; G8_WAIT_L(0); G8_MMA(0, 0, At, B0); G8_BAR; G8_SCHED;
            G8_LDB(B1, 1, 1); G8_STAGE(G8_SB(1, 0), b3, voffB);
            G8_BAR; G8_WAIT_L(0); G8_MMA(0, 1, At, B1); G8_BAR;
            G8_LDA(At, 1, 1); G8_STAGE(G8_SA(1, 0), a3, voffA);
            G8_BAR; G8_WAIT_L(0); G8_MMA(1, 0, At, B0); G8_BAR; G8_SCHED;
            G8_STAGE(G8_SB(1, 1), b3 + hstepB, voffB);
            G8_WAIT_V(6); G8_BAR; G8_MMA(1, 1, At, B1); G8_BAR;
        }
        const bool keep = E(acc, cur, wr, wc, fr, fq);
        if (!has_next) break;
        if (!keep) {
#pragma unroll
            for (int a = 0; a < 2; ++a)
#pragma unroll
                for (int b = 0; b < 2; ++b)
#pragma unroll
                    for (int m = 0; m < 4; ++m)
#pragma unroll
                        for (int n = 0; n < 2; ++n) acc[a][b][m][n] = (f32x4){0.f, 0.f, 0.f, 0.f};
        }
        cur = nxt; cA = nA; cB = nB; ++ui;
    }
    G8_WAIT_V(0);
    if (wr == 0) G8_BAR;
    G8_BAR;
#undef G8_SA
#undef G8_SB
#undef G8_STAGE
#undef G8_LDA
#undef G8_LDB
#undef G8_MMA
#undef G8_WAIT_V
#undef G8_WAIT_L
#undef G8_BAR
#undef G8_SCHED
}

struct StaticOrder {
    int nM, nN, nwg, G, c;
    __device__ __forceinline__ void init(int M, int N, int G_, int c_) { nM = M / BM; nN = N / BM; nwg = nM * nN; G = G_; c = c_; }
    __device__ __forceinline__ bool next(int i, Unit& u) const {
        const int L = i * G + c; if (L >= nwg) return false;
        int wgid = L; { const int q = nwg / 8, r = nwg % 8, xcd = wgid % 8, off = wgid / 8; wgid = (xcd < r ? xcd * (q + 1) : r * (q + 1) + (xcd - r) * q) + off; }
        const int nig = 8 * nN, gid = wgid / nig, fm = gid * 8, gsz = (nM - fm) < 8 ? (nM - fm) : 8;
        u.pm = fm + ((wgid % nig) % gsz); u.pn = (wgid % nig) / gsz; u.sel = 0; return true;
    }
};
struct EpiStoreBf16 {
    static constexpr bool PERM = true;
    bf16_t* O; int ldc;
    __device__ __forceinline__ bool operator()(Acc& acc, const Unit& u, int wr, int wc, int fr, int fq) const {
        const int row0 = u.pm * BM + wr * 64 + fr, col0 = u.pn * BM + wc * 32 + 8 * fq;
#pragma unroll
        for (int ai = 0; ai < 2; ++ai)
#pragma unroll
            for (int m = 0; m < 4; ++m) { bf16_t* rowp = O + (size_t)(row0 + ai * HALF + m * 16) * ldc + col0;
#pragma unroll
                for (int bj = 0; bj < 2; ++bj) { const f32x4 v0 = acc[ai][bj][m][0], v1 = acc[ai][bj][m][1];
                    u32x4 w; w[0] = pack_bf2(v0[0], v0[1]); w[1] = pack_bf2(v0[2], v0[3]); w[2] = pack_bf2(v1[0], v1[1]); w[3] = pack_bf2(v1[2], v1[3]);
                    *(u32x4*)(rowp + bj * HALF) = w; } }
        return false;
    }
};
}


__device__ __forceinline__ void ph_gates(const Params& p, char* smem_all, const int pb) {
    g8::StaticOrder so; so.init(NL, PG_W, gridDim.x, pb);
    g8::EpiStoreBf16 ep; ep.O = p.Pg; ep.ldc = PG_W;
    g8::gemm_phase((LAS unsigned char*)smem_all, p.h + (size_t)NCTX * DM, nullptr, DM, p.Wt_g, 1024, so, ep);
}

struct InprojOrder {
    int c;
    __device__ __forceinline__ bool next(int i, g8::Unit& u) const {
        const int x = c & 7, off = i * 32 + (c >> 3);
        if (off >= 96) return false;
        if (off < 88) { u.pm = 8 + 8 * x + (off & 7); u.pn = off >> 3; }
        else { u.pm = x; u.pn = 1 + (off - 88); }
        u.sel = 0; return true;
    }
};
struct ZdOrder {
    int c;
    __device__ __forceinline__ bool next(int i, g8::Unit& u) const {
        const int idx = (c >> 3) - 16;
        if (i > 0 || idx < 0) return false;
        u.pm = 8 + 8 * (c & 7) + (idx & 7); u.pn = 11 + (idx >> 3); u.sel = 0; return true;
    }
};
template <int LDC>
__device__ __forceinline__ void epi_store_tile(const g8::Acc& acc, bf16_t* O, int row0, int col0) {
#pragma unroll
    for (int ai = 0; ai < 2; ++ai)
#pragma unroll
        for (int m = 0; m < 4; ++m) { bf16_t* rowp = O + (size_t)(row0 + ai * 128 + m * 16) * LDC + col0;
#pragma unroll
            for (int bj = 0; bj < 2; ++bj) { const f32x4 v0 = acc[ai][bj][m][0], v1 = acc[ai][bj][m][1];
                u32x4 w; w[0] = pack_bf2(v0[0], v0[1]); w[1] = pack_bf2(v0[2], v0[3]); w[2] = pack_bf2(v1[0], v1[1]); w[3] = pack_bf2(v1[2], v1[3]);
                *(u32x4*)(rowp + bj * 128) = w; } }
}
struct EpiInproj {
    static constexpr bool PERM = true;
    bf16_t* Pa; bf16_t* Pz;
    __device__ __forceinline__ bool operator()(g8::Acc& acc, const g8::Unit& u, int wr, int wc, int, int) const {
        int t = threadIdx.x; asm volatile("" : "+v"(t));
        const int fr = t & 15, fq = (t >> 4) & 3;
        if (u.pn < 9) epi_store_tile<PA_W>(acc, Pa, u.pm * 256 + wr * 64 + fr, u.pn * 256 + wc * 32 + 8 * fq);
        else epi_store_tile<PZ_W>(acc, Pz, u.pm * 256 - NCTX + wr * 64 + fr, (u.pn - 9) * 256 + wc * 32 + 8 * fq);
        return false;
    }
};
__device__ __forceinline__ void ph_zd8(const Params& p, char* smem_all, const int pb) {
    ZdOrder so; so.c = pb;
    EpiInproj ep; ep.Pa = p.Pa; ep.Pz = p.Pz;
    g8::gemm_phase((LAS unsigned char*)smem_all, p.h, nullptr, DM, p.Wt_a, 1024, so, ep);
}
__device__ __forceinline__ void ph_inproj8(const Params& p, char* smem_all, const int pb) {
    InprojOrder so; so.c = pb;
    EpiInproj ep; ep.Pa = p.Pa; ep.Pz = p.Pz;
    g8::gemm_phase((LAS unsigned char*)smem_all, p.h, nullptr, DM, p.Wt_a, 1024, so, ep);
}

struct MergeOrder {
    g8::StaticOrder so;
    __device__ __forceinline__ bool next(int i, g8::Unit& u) const {
        if (i >= 2) return false;
        const bool ok = so.next(0, u); u.sel = i; u.pn += 4 * i; return ok;
    }
};
struct EpiMerge {
    static constexpr bool PERM = true;
    const bf16_t* Pg; bf16_t* Mb;
    __device__ __forceinline__ bool operator()(g8::Acc& acc, const g8::Unit& u, int wr, int wc, int, int) const {
        int t = threadIdx.x; asm volatile("" : "+v"(t));
        const int fr = t & 15, fq = (t >> 4) & 3;
        const int row0 = u.pm * 256 + wr * 64 + fr, col0 = (u.pn & 3) * 256 + wc * 32 + 8 * fq;
        if (u.sel == 0) {
#pragma unroll
            for (int ai = 0; ai < 2; ++ai) {
#pragma unroll
                for (int m = 0; m < 4; ++m) {
                    const bf16_t* gp = Pg + (size_t)(row0 + ai * 128 + m * 16) * PG_W + col0;
                    u32x4 g1[2], g2[2];
#pragma unroll
                    for (int bj = 0; bj < 2; ++bj) { g1[bj] = *(const u32x4*)(gp + bj * 128); g2[bj] = *(const u32x4*)(gp + 1024 + bj * 128); }
#pragma unroll
                    for (int bj = 0; bj < 2; ++bj)
#pragma unroll
                        for (int n = 0; n < 2; ++n)
#pragma unroll
                            for (int e = 0; e < 4; ++e) {
                                const unsigned w1 = g1[bj][2 * n + (e >> 1)], w2 = g2[bj][2 * n + (e >> 1)];
                                const float a1 = (e & 1) ? __uint_as_float(w1 & 0xffff0000u) : __uint_as_float(w1 << 16);
                                const float a2 = fmaxf((e & 1) ? __uint_as_float(w2 & 0xffff0000u) : __uint_as_float(w2 << 16), -30.f);
                                acc[ai][bj][m][n][e] *= (1.f + __expf(-a2)) * __builtin_amdgcn_rcpf(1.f + __expf(-a1));
                            }
                }
                asm volatile("" ::: "memory");
            }
            return true;
        }
#pragma unroll
        for (int ai = 0; ai < 2; ++ai) {
#pragma unroll
            for (int m = 0; m < 4; ++m) {
                const size_t row = (size_t)(row0 + ai * 128 + m * 16);
                u32x4 g2[2];
#pragma unroll
                for (int bj = 0; bj < 2; ++bj) g2[bj] = *(const u32x4*)(Pg + row * PG_W + 1024 + col0 + bj * 128);
#pragma unroll
                for (int bj = 0; bj < 2; ++bj) {
                    u32x4 w;
#pragma unroll
                    for (int n = 0; n < 2; ++n) {
                        float o[4];
#pragma unroll
                        for (int e = 0; e < 4; ++e) {
                            const unsigned w2 = g2[bj][2 * n + (e >> 1)];
                            const float a2 = fmaxf((e & 1) ? __uint_as_float(w2 & 0xffff0000u) : __uint_as_float(w2 << 16), -30.f);
                            o[e] = acc[ai][bj][m][n][e] * __builtin_amdgcn_rcpf(1.f + __expf(-a2));
                        }
                        w[2 * n] = pack_bf2(o[0], o[1]); w[2 * n + 1] = pack_bf2(o[2], o[3]);
                    }
                    *(u32x4*)(Mb + row * 1024 + col0 + bj * 128) = w;
                }
            }
            asm volatile("" ::: "memory");
        }
        return false;
    }
};
__device__ __forceinline__ void ph_merge8(const Params& p, char* smem_all, const int pb) {
    MergeOrder mo; mo.so.init(NL, 1024, gridDim.x, pb);
    EpiMerge ep; ep.Pg = p.Pg; ep.Mb = p.Mb;
    g8::gemm_phase((LAS unsigned char*)smem_all, p.A_mla, p.A_dn, 512, p.Wt_mo, 512, mo, ep);
}

struct EpiOut {
    static constexpr bool PERM = false;
    const float* x; const float* mod; float* out;
    __device__ __forceinline__ bool operator()(g8::Acc& acc, const g8::Unit& u, int wr, int wc, int fr, int fq) const {
        const int row0 = u.pm * 256 + wr * 64 + fr, col0 = u.pn * 256 + wc * 32 + 4 * fq;
        const float* gp = mod + ((u.pm * 256) / SEQ) * 3072 + 2048 + col0;
        f32x4 gate[2][2];
#pragma unroll
        for (int bj = 0; bj < 2; ++bj)
#pragma unroll
            for (int n = 0; n < 2; ++n) gate[bj][n] = *(const f32x4*)(gp + bj * 128 + n * 16);
#pragma unroll
        for (int ai = 0; ai < 2; ++ai)
#pragma unroll
            for (int m = 0; m < 4; ++m) {
                const size_t off = (size_t)(row0 + ai * 128 + m * 16) * DM + col0;
                f32x4 xv[2][2];
#pragma unroll
                for (int bj = 0; bj < 2; ++bj)
#pragma unroll
                    for (int n = 0; n < 2; ++n) xv[bj][n] = *(const f32x4*)(x + off + bj * 128 + n * 16);
#pragma unroll
                for (int bj = 0; bj < 2; ++bj)
#pragma unroll
                    for (int n = 0; n < 2; ++n) *(f32x4*)(out + off + bj * 128 + n * 16) = xv[bj][n] + gate[bj][n] * acc[ai][bj][m][n];
                if (m & 1) asm volatile("" ::: "memory");
            }
        return false;
    }
};
__device__ __forceinline__ void ph_out8(const Params& p, char* smem_all, const int pb) {
    g8::StaticOrder so; so.init(NL, DM, gridDim.x, pb);
    EpiOut ep; ep.x = p.x; ep.mod = p.mod; ep.out = p.out;
    g8::gemm_phase((LAS unsigned char*)smem_all, p.Mb, nullptr, DM, p.Wt_out, 1024, so, ep);
}

#define XB_TMO      128
#define XB_XCNT(j)  (256  + 64 * (j))
#define XB_XSUB(j)  (1280 + 64 * (j))
#define XB_XGEN(j)  (2304 + 64 * (j))
#define XB_TOP      3328
#define XB_TOPGEN   3392
#define XCD_BAR_WORDS 3456
#define XB_SPIN_CAP (1u << 20)
__device__ __forceinline__ unsigned xb_ld(unsigned* p)              { return __hip_atomic_load(p, __ATOMIC_RELAXED, __HIP_MEMORY_SCOPE_AGENT); }
__device__ __forceinline__ unsigned xb_add(unsigned* p, unsigned v) { return __hip_atomic_fetch_add(p, v, __ATOMIC_RELAXED, __HIP_MEMORY_SCOPE_AGENT); }
__device__ __forceinline__ unsigned xb_xcc_id() { return (unsigned)__builtin_amdgcn_s_getreg((3 << 11) | 20) & 0xFu; }
#define XB_SPIN(cond, bar) do { unsigned _sp = 0; while (cond) { __builtin_amdgcn_s_sleep(1); \
    if ((++_sp & 255u) == 0u) { if (xb_ld(&(bar)[XB_TMO])) break; if (_sp > XB_SPIN_CAP) { atomicAdd(&(bar)[XB_TMO], 1u); break; } } } } while (0)
struct XcdBarrier { unsigned* bar; unsigned x; volatile LAS unsigned* st; };
__device__ __forceinline__ XcdBarrier xcd_barrier_post(unsigned* bar, volatile LAS unsigned* st) {
    XcdBarrier b; b.bar = bar; b.x = xb_xcc_id(); b.st = st;
    if (threadIdx.x == 0) (void)xb_add(&bar[XB_XCNT(b.x)], 1u);
    return b;
}
__device__ __forceinline__ void xcd_barrier_complete(unsigned* bar, unsigned x, unsigned& nloc, unsigned& nx) {
    const unsigned G = gridDim.x * gridDim.y * gridDim.z;
    unsigned sum, cnt, mine, sp = 0u;
    for (;;) {
        sum = 0u; cnt = 0u; mine = 0u;
#pragma unroll
        for (unsigned j = 0; j < 16; ++j) { const unsigned c = xb_ld(&bar[XB_XCNT(j)]); sum += c; cnt += (c > 0u) ? 1u : 0u; mine = (j == x) ? c : mine; }
        if (sum == G) break;
        __builtin_amdgcn_s_sleep(1);
        if ((++sp & 255u) == 0u) { if (xb_ld(&bar[XB_TMO])) break; if (sp > XB_SPIN_CAP) { atomicAdd(&bar[XB_TMO], 1u); break; } }
    }
    nloc = mine > 0u ? mine : 1u; nx = cnt > 0u ? cnt : 1u;
}
__device__ __forceinline__ void xcd_barrier(const XcdBarrier& b) {
    asm volatile("s_waitcnt vmcnt(0)" ::: "memory");
    __syncthreads();
    if (threadIdx.x == 0) {
        unsigned* bar = b.bar;
        __builtin_amdgcn_s_waitcnt(0);
        unsigned nloc = b.st[0], nx = b.st[1];
        if (nloc == 0u) { xcd_barrier_complete(bar, b.x, nloc, nx); b.st[0] = nloc; b.st[1] = nx; }
        const unsigned old = xb_add(&bar[XB_XSUB(b.x)], 1u);
        const unsigned gen = old / nloc;
        if (old + 1u == (gen + 1u) * nloc) {
            __builtin_amdgcn_fence(__ATOMIC_RELEASE, "agent");
            asm volatile("s_waitcnt vmcnt(0)" ::: "memory");
            const unsigned og = xb_add(&bar[XB_TOP], 1u);
            const unsigned tg = og / nx;
            if (og + 1u == (tg + 1u) * nx) xb_add(&bar[XB_TOPGEN], 1u);
            else XB_SPIN(xb_ld(&bar[XB_TOPGEN]) == tg, bar);
            __builtin_amdgcn_fence(__ATOMIC_ACQUIRE, "agent");
            xb_add(&bar[XB_XGEN(b.x)], 1u);
            asm volatile("s_waitcnt vmcnt(0)" ::: "memory");
        } else {
            XB_SPIN(xb_ld(&bar[XB_XGEN(b.x)]) == gen, bar);
            __builtin_amdgcn_fence(__ATOMIC_ACQUIRE, "agent");
            asm volatile("s_waitcnt vmcnt(0)" ::: "memory");
        }
    }
    __syncthreads();
}

__global__ void __launch_bounds__(2 * NTHR, 2) fwd_megakernel(Params p) {
    __shared__ __attribute__((aligned(16))) char smem_all[2 * SMEM_BYTES];
    const int half = __builtin_amdgcn_readfirstlane((int)(threadIdx.x >> 8)), pb = blockIdx.x;
    const int bid = 16 * (pb >> 3) + 8 * half + (pb & 7), nb = 2 * gridDim.x;
    const int bid2 = 2 * pb + half;
    char* smem = smem_all + half * SMEM_BYTES;
    volatile LAS unsigned* bst = (volatile LAS unsigned*)(smem_all + 2 * SMEM_BYTES - 16);
    if (threadIdx.x == 0) { bst[0] = 0u; bst[1] = 0u; }
    __syncthreads();
    const XcdBarrier xb = xcd_barrier_post(p.bar, bst);

    ph_mod(p, bid, nb, smem);
    ph_wprep(p, bid2, nb, smem);
    xcd_barrier(xb);
    ph_norm(p, bid, nb, smem);
    xcd_barrier(xb);
    ph_inproj8(p, smem_all, pb);
    xcd_barrier(xb);
    ph_mla_proj(p, bid, nb, smem);
    xcd_barrier(xb);
    ph_attn(p, bid, nb, smem, smem_all, pb);
    xcd_barrier(xb);
    ph_dn1(p, bid, nb, smem);
    __syncthreads();
    ph_zd8(p, smem_all, pb);
    xcd_barrier(xb);
    ph_dn2(p, smem_all, pb);
    xcd_barrier(xb);
    ph_dn3(p, bid, nb, smem);
    ph_gates(p, smem_all, pb);
    xcd_barrier(xb);
    ph_merge8(p, smem_all, pb);
    xcd_barrier(xb);
    ph_out8(p, smem_all, pb);
}

extern "C" void kernel_launch(void* const* d_in, const int* in_sizes, int n_in,
                              void* d_out, int out_size, void* d_ws, size_t ws_size,
                              hipStream_t stream) {
    static int grid_blocks = 0;
    if (!grid_blocks) {
        int dev = 0, cus = 0, per_cu = 0;
        (void)hipGetDevice(&dev);
        (void)hipDeviceGetAttribute(&cus, hipDeviceAttributeMultiprocessorCount, dev);
        (void)hipOccupancyMaxActiveBlocksPerMultiprocessor(&per_cu, fwd_megakernel, 2 * NTHR, 0);
        if (per_cu > 1) per_cu = 1;
        if (per_cu < 1) per_cu = 1;
        grid_blocks = cus * per_cu;
    }
    if (n_in != 21 || ws_size < (size_t)268435456 || out_size != NL * DM) {
        fprintf(stderr, "kernel_launch: built for 21 inputs, a %d-float output and >= 256 MiB of workspace (got %d inputs, out %d, ws %zu)\n", NL * DM, n_in, out_size, ws_size);
        return;
    }
    Params p{};
    const float** fp = (const float**)&p;
    for (int i = 0; i < 21; ++i) fp[i] = (const float*)d_in[i];
    p.out = (float*)d_out;
    char* ws = (char*)d_ws;
    char* ob = (char*)d_out;
    const size_t R_W = 0;
    const size_t R_H = 16777216;
    const size_t R_Z = R_H + 37748736;
    const size_t R_A = R_Z + 33554432;
    const size_t R_F = R_A + 84934656;
    {
        size_t o = R_W;
        p.Wt_a = (bf16_t*)(ws + o); o += 4718592;
        p.Wt_z = (bf16_t*)(ws + o); o += 2097152;
        p.Wt_g = (bf16_t*)(ws + o); o += 4194304;
        p.Wt_uq = (bf16_t*)(ws + o); o += 589824;
        p.Wt_ukv = (bf16_t*)(ws + o); o += 524288;
        p.Wt_mo = (bf16_t*)(ws + o); o += 1048576;
        p.Wt_do = (bf16_t*)(ws + o); o += 1048576;
        p.Wt_out = (bf16_t*)(ws + o); o += 2097152;
        p.mod = (float*)(ws + o); o += 110592;
        p.bar = (unsigned*)(ws + o); o += XCD_BAR_WORDS * 4;
        p.rope = (float*)(ws + o); o += 4096;
    }
    p.h = (bf16_t*)(ws + R_H);
    p.Pz = (bf16_t*)(ws + R_Z);
    p.Pa = (bf16_t*)(ws + R_A);
    p.Qb = (bf16_t*)(ws + R_F + 22020096);
    p.Kb = (bf16_t*)(ws + R_F + 47185920);
    p.Vt = (bf16_t*)(ws + R_F + 75497472);
    p.MH = (bf16_t*)(ws + R_F + 16777216);
    p.EF = (bf16_t*)(ob);
    p.ST = (bf16_t*)(ws + R_A);
    p.A_mla = (bf16_t*)(ws + R_F);
    p.A_dn = (bf16_t*)(ws + R_A + 50331648);
    p.Pg = (bf16_t*)(ws + R_F + 16777216);
    p.Mb = (bf16_t*)(ws + R_H);
    (void)hipMemsetAsync(p.mod, 0, 110592 + XCD_BAR_WORDS * 4, stream);
    void* args[] = {&p};
    hipError_t err = hipLaunchCooperativeKernel((void*)fwd_megakernel, dim3(grid_blocks), dim3(2 * NTHR), args, 0, stream);
    if (err != hipSuccess) fprintf(stderr, "cooperative launch failed: %s (grid %d)\n", hipGetErrorString(err), grid_blocks);
}
```

```cpp
#include <hip/hip_runtime.h>
#include <stdint.h>
#include <cstdio>

typedef uint16_t bf16_t;
#define LAS __attribute__((address_space(3)))

#define NB 8
#define SEQ 2048
#define CTXL 256
#define TPB 2304
#define NCTX 2048
#define NL 16384
#define NT 18432
#define DM 1024
#define IN_DIM 5312
#define PA_W 2304
#define PZ_W 1024
#define PG_W 2048
#define PA_CQ 0
#define PA_CKV 384
#define PA_KR 640
#define PA_DQ 672
#define PA_DK 1184
#define PA_DV 1696
#define PA_DB 2208
#define PA_DA 2224
#define EPSF 1e-6f
#define NTHR 256
#define VTID ((int)(threadIdx.x & 255u))
#define SMEM_BYTES 77824

struct Params {
    const float *x, *c, *ctx, *c_ctx, *w_mod, *b_mod, *norm_w, *w_in, *q_norm_w, *w_uq, *kv_norm_w, *w_ukv, *qhn_w, *khn_w,
        *mla_w_o, *conv_w, *a_log, *dt_bias, *dn_norm_w, *dn_w_o, *w_out;
    float* out;
    char* ws;
#define WS_ACC(T, NAME, OFF) __device__ __forceinline__ T* NAME() const { return (T*)(ws + (size_t)(OFF)); }
    WS_ACC(bf16_t, Wt_a, 0) WS_ACC(bf16_t, Wt_z, 4718592) WS_ACC(bf16_t, Wt_g, 6815744) WS_ACC(bf16_t, Wt_uq, 11010048) WS_ACC(bf16_t, Wt_ukv, 11599872)
    WS_ACC(bf16_t, Wt_mo, 12124160) WS_ACC(bf16_t, Wt_do, 13172736) WS_ACC(bf16_t, Wt_out, 14221312)
    WS_ACC(float, mod, 16318464) WS_ACC(unsigned, bar, 16429056) WS_ACC(float, rope, 16442880)
    WS_ACC(bf16_t, h, 16777216) WS_ACC(bf16_t, Mb, 16777216) WS_ACC(bf16_t, Pz, 54525952) WS_ACC(bf16_t, Pa, 88080384) WS_ACC(bf16_t, ST, 88080384)
    WS_ACC(bf16_t, A_dn, 138412032) WS_ACC(bf16_t, A_mla, 173015040) WS_ACC(bf16_t, MH, 189792256) WS_ACC(bf16_t, Pg, 189792256)
    WS_ACC(bf16_t, Qb, 195035136) WS_ACC(bf16_t, Kb, 220200960) WS_ACC(bf16_t, Vt, 248512512)
#undef WS_ACC
    __device__ __forceinline__ bf16_t* EF() const { return (bf16_t*)out; }
};

typedef float f32x4 __attribute__((ext_vector_type(4)));
typedef unsigned u32x4 __attribute__((ext_vector_type(4)));
typedef __bf16 bf16v2_t __attribute__((ext_vector_type(2)));
typedef float f32x2 __attribute__((ext_vector_type(2)));
__device__ __forceinline__ uint32_t pack_bf2(float lo, float hi) {
    f32x2 v = {lo, hi};
    bf16v2_t b = __builtin_convertvector(v, bf16v2_t);
    return __builtin_bit_cast(uint32_t, b);
}
__device__ __forceinline__ void st_bf4(bf16_t* p, f32x4 v) {
    uint2 o; o.x = pack_bf2(v[0], v[1]); o.y = pack_bf2(v[2], v[3]);
    *(uint2*)p = o;
}
__device__ __forceinline__ float bf2f(bf16_t v) { return __uint_as_float(((uint32_t)v) << 16); }
__device__ __forceinline__ bf16_t f2bf(float f) {
    uint32_t u = __float_as_uint(f);
    u += 0x7fffu + ((u >> 16) & 1u);
    return (bf16_t)(u >> 16);
}
__device__ __forceinline__ float silu_f(float v) { return v * __builtin_amdgcn_rcpf(1.f + __expf(-v)); }
__device__ __forceinline__ float sigmoid_f(float v) { return __builtin_amdgcn_rcpf(1.f + __expf(-v)); }
template <int CTRL> __device__ __forceinline__ float dpp_mov(float v) {
    return __builtin_bit_cast(float, __builtin_amdgcn_update_dpp(0, __builtin_bit_cast(int, v), CTRL, 0xF, 0xF, true));
}
__device__ __forceinline__ float row16_sum(float v) {
    v += dpp_mov<0xB1>(v); v += dpp_mov<0x4E>(v); v += dpp_mov<0x141>(v); v += dpp_mov<0x140>(v); return v;
}
__device__ __forceinline__ float rdlane(float v, int l) { return __builtin_bit_cast(float, __builtin_amdgcn_readlane(__builtin_bit_cast(int, v), l)); }
__device__ __forceinline__ float wave_sum(float v) {
    v += dpp_mov<0xB1>(v);
    v += dpp_mov<0x4E>(v);
    v += dpp_mov<0x141>(v);
    v += dpp_mov<0x140>(v);
    return (rdlane(v, 0) + rdlane(v, 16)) + (rdlane(v, 32) + rdlane(v, 48));
}
__device__ __forceinline__ float xrow_sum(float v) { v += __shfl_xor(v, 16); v += __shfl_xor(v, 32); return v; }
__device__ __forceinline__ void ph_mod(const Params& p, int bid, int nb, char* smem) {
    float* sc = (float*)smem;
    const int item = bid & 511;
    const int k0 = (item >> 4) * 32, cb = (item & 15) * 192, tid = VTID;
    for (int i = tid; i < 288; i += NTHR) {
        const int r = i >> 5, kk = i & 31;
        const float v = (r < 8) ? p.c[r * 1024 + k0 + kk] : p.c_ctx[k0 + kk];
        sc[i] = silu_f(v);
    }
    __syncthreads();
    if (tid < 192) {
        const float* wp = p.w_mod + (size_t)k0 * 3072 + cb;
        float acc[9];
#pragma unroll
        for (int r = 0; r < 9; ++r) acc[r] = 0.f;
        int NH = 2;
        asm volatile("" : "+s"(NH));
        for (int hh = 0; hh < NH; ++hh) {
            float wv[16];
#pragma unroll
            for (int kk = 0; kk < 16; ++kk) wv[kk] = wp[(size_t)(hh * 16 + kk) * 3072 + tid];
#pragma unroll
            for (int k4 = 0; k4 < 4; ++k4)
#pragma unroll
                for (int r = 0; r < 9; ++r) {
                    const f32x4 s4 = *(const f32x4*)(sc + r * 32 + hh * 16 + 4 * k4);
                    acc[r] += s4[0] * wv[4 * k4] + s4[1] * wv[4 * k4 + 1] + s4[2] * wv[4 * k4 + 2] + s4[3] * wv[4 * k4 + 3];
                }
        }
        const float bb = (k0 == 0) ? p.b_mod[cb + tid] : 0.f;
        float back = 0.f;
#pragma unroll
        for (int r = 0; r < 9; ++r) back += atomicAdd(p.mod() + r * 3072 + cb + tid, acc[r] + bb);
        asm volatile("" :: "v"(back));
    }
    asm volatile("s_waitcnt vmcnt(0)" ::: "memory");
    __syncthreads();
}

__device__ __forceinline__ void ph_norm(const Params& p, int bid, int nb, char* smem) {
    const int lane = VTID & 63, gw = bid * 4 + (VTID >> 6), nw = nb * 4;
    const int per = (NT + nw - 1) / nw;
    const int r0 = gw * per, r1 = (r0 + per < NT) ? r0 + per : NT;
    auto rowptr = [&](int rr) -> const float* { return ((rr < NCTX) ? p.ctx + (size_t)rr * DM : p.x + (size_t)(rr - NCTX) * DM) + lane * 8; };
#define NORM_LOAD(V, RR) do { const float* s_ = rowptr(RR); V[0] = *(const f32x4*)(s_); V[1] = *(const f32x4*)(s_ + 4); V[2] = *(const f32x4*)(s_ + 512); V[3] = *(const f32x4*)(s_ + 516); } while (0)
    f32x4 va[4], vb[4], vc[4], av[4], sv[4];
    int cur_m = -1;
#define NORM_ROW(V, RR) do { const int r_ = (RR); \
        const int mrow = (r_ < NCTX) ? 8 : (r_ - NCTX) / SEQ; \
        if (mrow != cur_m) { \
            cur_m = mrow; \
            const float* shift = p.mod() + mrow * 3072; \
            const float* scale = shift + 1024; \
            _Pragma("unroll") for (int i = 0; i < 4; ++i) { \
                const int k = (i >> 1) * 512 + lane * 8 + (i & 1) * 4; \
                const f32x4 nwv = *(const f32x4*)(p.norm_w + k), sc = *(const f32x4*)(scale + k); \
                sv[i] = *(const f32x4*)(shift + k); \
                _Pragma("unroll") for (int e2 = 0; e2 < 4; ++e2) av[i][e2] = nwv[e2] * (1.f + sc[e2]); \
            } \
        } \
        float ss = 0.f; \
        _Pragma("unroll") for (int i = 0; i < 4; ++i) ss += V[i][0] * V[i][0] + V[i][1] * V[i][1] + V[i][2] * V[i][2] + V[i][3] * V[i][3]; \
        ss = wave_sum(ss); \
        const float rstd = rsqrtf(ss * (1.f / 1024.f) + EPSF); \
        _Pragma("unroll") for (int c = 0; c < 2; ++c) { \
            u32x4 o; \
            _Pragma("unroll") for (int q = 0; q < 2; ++q) { \
                const int i = 2 * c + q; \
                o[2 * q] = pack_bf2((V[i][0] * rstd) * av[i][0] + sv[i][0], (V[i][1] * rstd) * av[i][1] + sv[i][1]); \
                o[2 * q + 1] = pack_bf2((V[i][2] * rstd) * av[i][2] + sv[i][2], (V[i][3] * rstd) * av[i][3] + sv[i][3]); \
            } \
            *(u32x4*)(p.h() + (size_t)r_ * DM + c * 512 + lane * 8) = o; \
        } } while (0)
    if (r0 < r1) NORM_LOAD(va, r0);
    if (r0 + 1 < r1) NORM_LOAD(vb, r0 + 1);
    for (int r = r0; r < r1; r += 3) {
        if (r + 2 < r1) NORM_LOAD(vc, r + 2);
        NORM_ROW(va, r);
        if (r + 1 < r1) {
            if (r + 3 < r1) NORM_LOAD(va, r + 3);
            NORM_ROW(vb, r + 1);
        }
        if (r + 2 < r1) {
            if (r + 4 < r1) NORM_LOAD(vb, r + 4);
            NORM_ROW(vc, r + 2);
        }
    }
#undef NORM_ROW
#undef NORM_LOAD
}


struct WprepDesc { const float* W; const float* ksc; bf16_t* dst; int ldw, K, n0, k0, srcbase; };
__device__ __forceinline__ void wprep_decode(const Params& p, int u, WprepDesc& d) {
    const int U0 = 72 * 8, U1 = 32 * 8, U2 = 64 * 8, U3 = 24 * 3, U4 = 32 * 2, U5 = 32 * 4, U6 = 32 * 4;
    int v = u, job;
    if (v < U0) { job = 0; d.W = p.w_in; d.ldw = IN_DIM; d.K = 1024; d.dst = p.Wt_a(); }
    else if ((v -= U0) < U1) { job = 1; d.W = p.w_in; d.ldw = IN_DIM; d.K = 1024; d.dst = p.Wt_z(); }
    else if ((v -= U1) < U2) { job = 2; d.W = p.w_in; d.ldw = IN_DIM; d.K = 1024; d.dst = p.Wt_g(); }
    else if ((v -= U2) < U3) { job = 3; d.W = p.w_uq; d.ldw = 768; d.K = 384; d.dst = p.Wt_uq(); }
    else if ((v -= U3) < U4) { job = 4; d.W = p.w_ukv; d.ldw = 1024; d.K = 256; d.dst = p.Wt_ukv(); }
    else if ((v -= U4) < U5) { job = 5; d.W = p.mla_w_o; d.ldw = 1024; d.K = 512; d.dst = p.Wt_mo(); }
    else if ((v -= U5) < U6) { job = 6; d.W = p.dn_w_o; d.ldw = 1024; d.K = 512; d.dst = p.Wt_do(); }
    else { v -= U6; job = 7; d.W = p.w_out; d.ldw = 1024; d.K = 1024; d.dst = p.Wt_out(); }
    const int nkt = d.K / 128;
    d.n0 = (v / nkt) * 32; d.k0 = (v % nkt) * 128;
    const int n0 = d.n0;
    int srcbase = n0;
    if (job == 0) {
        if (n0 < 672) srcbase = n0;
        else if (n0 < 2208) { const int r = n0 - 672, hh = r / 192, g = (r % 192) >> 6, i0 = r & 63; srcbase = 1184 + g * 512 + hh * 64 + i0; }
        else srcbase = (n0 < 2240) ? n0 + 1024 : -1;
    }
    else if (job == 1) srcbase = (n0 < 512) ? 672 + n0 : 2208 + n0;
    else if (job == 2) srcbase = 3264 + n0;
    d.srcbase = srcbase;
    d.ksc = (job == 3) ? p.q_norm_w : (job == 4) ? p.kv_norm_w : nullptr;
}
__device__ __forceinline__ void wprep_load(const WprepDesc& d, f32x4 (&v)[4], int tid) {
    const int n4 = (tid & 7) * 4, kk = tid >> 3;
#pragma unroll
    for (int q = 0; q < 4; ++q) {
        v[q] = (f32x4){0.f, 0.f, 0.f, 0.f};
        if (d.srcbase >= 0) v[q] = *(const f32x4*)(d.W + (size_t)(d.k0 + kk + 32 * q) * d.ldw + d.srcbase + n4);
    }
}
__device__ __forceinline__ void wprep_emit(const WprepDesc& d, const f32x4 (&v)[4], float* tile, int tid) {
    {
        const int n4 = (tid & 7) * 4, kk = tid >> 3;
#pragma unroll
        for (int q = 0; q < 4; ++q) {
            const int k = kk + 32 * q;
            const float s = d.ksc ? d.ksc[d.k0 + k] : 1.f;
            float* t = tile + k * 33 + n4;
            t[0] = v[q][0] * s; t[1] = v[q][1] * s; t[2] = v[q][2] * s; t[3] = v[q][3] * s;
        }
    }
    __syncthreads();
    {
        const int n = tid >> 3;
#pragma unroll
        for (int q = 0; q < 2; ++q) {
            const int kc = (tid & 7) + 8 * q;
            const float* t = tile + (kc * 8) * 33 + n;
            u32x4 o;
            o[0] = pack_bf2(t[0 * 33], t[1 * 33]); o[1] = pack_bf2(t[2 * 33], t[3 * 33]);
            o[2] = pack_bf2(t[4 * 33], t[5 * 33]); o[3] = pack_bf2(t[6 * 33], t[7 * 33]);
            *(u32x4*)(d.dst + (size_t)(d.n0 + n) * d.K + d.k0 + kc * 8) = o;
        }
    }
    __syncthreads();
}

__device__ __forceinline__ void ph_wprep(const Params& p, int bid, int nb, char* smem) {
    float* tile = (float*)smem;
    const int UT = 72 * 8 + 32 * 8 + 64 * 8 + 24 * 3 + 32 * 2 + 32 * 4 + 32 * 4 + 32 * 8;
    const int tid = VTID;
    WprepDesc d0, d1;
    f32x4 v0[4], v1[4];
    int u = bid;
    if (u < UT) { wprep_decode(p, u, d0); wprep_load(d0, v0, tid); }
    for (; u < UT; u += 2 * nb) {
        const bool m1 = (u + nb < UT), m2 = (u + 2 * nb < UT);
        if (m1) { wprep_decode(p, u + nb, d1); wprep_load(d1, v1, tid); }
        wprep_emit(d0, v0, tile, tid);
        if (m1) {
            if (m2) { wprep_decode(p, u + 2 * nb, d0); wprep_load(d0, v0, tid); }
            wprep_emit(d1, v1, tile, tid);
        }
    }
    if (bid == nb - 1) {
        for (int i = VTID; i < 512; i += NTHR) {
            const int pos = i >> 3, f = i & 7;
            const float ang = (float)pos * powf(10000.f, -(float)f / 8.f);
            p.rope()[2 * i] = cosf(ang); p.rope()[2 * i + 1] = sinf(ang);
        }
    }
}

typedef short bf16x8 __attribute__((ext_vector_type(8)));


__device__ __forceinline__ int lds_off(int row, int chunk) { return row * 128 + (((chunk ^ (row >> 1)) & 7) << 4); }

__device__ __forceinline__ int epi_perm(int rho) { return 8 * ((rho >> 2) & 3) + 4 * (rho >> 4) + (rho & 3); }

__device__ __forceinline__ bool next_unit(int it, int U, int bid, int nb, int& u) {
    const int x = bid & 7, li = bid >> 3, per = nb >> 3;
    const int lo = (int)(((long)U * x) >> 3), hi = (int)(((long)U * (x + 1)) >> 3);
    u = lo + li + it * per;
    return u < hi;
}
__device__ __forceinline__ f32x4 ld_bf4(const bf16_t* p) {
    const uint2 r = *(const uint2*)p;
    return (f32x4){__uint_as_float(r.x << 16), __uint_as_float(r.x & 0xffff0000u), __uint_as_float(r.y << 16), __uint_as_float(r.y & 0xffff0000u)};
}
template <int NTN>
__device__ __forceinline__ void gemm_rows_acc(f32x4 (&acc)[NTN][2], float (&ssq)[2], const bf16_t* __restrict__ A, int lda,
                                              const bf16_t* __restrict__ Bt, int ldb, int K, int m0, int n0, char* smem, char* smA, const bool loadA,
                                              const float* g_rope, const float* g_qhn, const float* g_khn, float* s_tab, const bool fill) {
    constexpr int NB_ = NTN / 2;
    int tid = VTID;
    asm volatile("" : "+v"(tid));
    const int lane = tid & 63, w = __builtin_amdgcn_readfirstlane(tid >> 6);
    const int l15 = lane & 15, lq = lane >> 4;
    const int srow = tid >> 3, sch = (tid & 7) ^ ((srow >> 1) & 7);
    const bf16_t* ap = A + (size_t)(m0 + srow) * lda + sch * 8;
    const bf16_t* bp = Bt + (size_t)(n0 + epi_perm(srow)) * ldb + sch * 8;
    const bf16_t* bpn = Bt + (size_t)(n0 + srow) * ldb + sch * 8;
    int KT = K >> 6;
    asm volatile("" : "+s"(KT));
    LAS char* lbase = (LAS char*)smem + w * 1024;
    LAS char* lbaseA = (LAS char*)smA + w * 1024;
#define GR_STAGE(ST_, KT_) do { \
        if (loadA) { _Pragma("unroll") for (int i = 0; i < 4; ++i) \
            __builtin_amdgcn_global_load_lds((const void*)(ap + (size_t)(32 * i) * lda + (KT_) * 64), (LAS void*)(lbaseA + (ST_) * 32768 + i * 4096), 16, 0, 0); } \
        _Pragma("unroll") for (int i = 0; i < NB_; ++i) \
            __builtin_amdgcn_global_load_lds((const void*)((i < 2 ? bp : bpn) + (size_t)(32 * i) * ldb + (KT_) * 64), (LAS void*)(lbase + (ST_) * 32768 + 16384 + i * 4096), 16, 0, 0); } while (0)
    GR_STAGE(0, 0);
    if (fill) {
        for (int i = tid; i < 1024; i += NTHR) s_tab[i] = g_rope[i];
        if (tid < 96) { s_tab[1024 + tid] = g_qhn[tid]; s_tab[1120 + tid] = g_khn[tid]; }
    }
    __syncthreads();
    for (int kt = 0; kt < KT; ++kt) {
        if (kt + 1 < KT) GR_STAGE((kt + 1) & 1, kt + 1);
        const char* sa = smA + (kt & 1) * 32768;
        const char* sb = smem + (kt & 1) * 32768 + 16384;
#pragma unroll
        for (int ks = 0; ks < 2; ++ks) {
            bf16x8 af[2], bfr[NTN];
#pragma unroll
            for (int mt = 0; mt < 2; ++mt) af[mt] = *(const bf16x8*)(sa + lds_off(w * 32 + mt * 16 + l15, ks * 4 + lq));
#pragma unroll
            for (int nt = 0; nt < NTN; ++nt) bfr[nt] = *(const bf16x8*)(sb + lds_off(nt * 16 + l15, ks * 4 + lq));
#pragma unroll
            for (int mt = 0; mt < 2; ++mt) {
                const u32x4 aw = __builtin_bit_cast(u32x4, af[mt]);
#pragma unroll
                for (int e2 = 0; e2 < 4; ++e2) {
                    const float lo = __uint_as_float(aw[e2] << 16), hi = __uint_as_float(aw[e2] & 0xffff0000u);
                    ssq[mt] += lo * lo + hi * hi;
                }
            }
#pragma unroll
            for (int nt = 0; nt < NTN; ++nt)
#pragma unroll
                for (int mt = 0; mt < 2; ++mt)
                    acc[nt][mt] = __builtin_amdgcn_mfma_f32_16x16x32_bf16(bfr[nt], af[mt], acc[nt][mt], 0, 0, 0);
        }
        __syncthreads();
    }
#undef GR_STAGE
    ssq[0] = xrow_sum(ssq[0]);
    ssq[1] = xrow_sum(ssq[1]);
}

__device__ __forceinline__ void ph_mla_proj(const Params& p, int bid, int nb, char* smem, char* smem_all, const int half) {
    const int tid = VTID, lane = tid & 63, w = __builtin_amdgcn_readfirstlane(tid >> 6), l15 = lane & 15, lq = lane >> 4;
    float* s_rope = (float*)(smem + 65536);
    float* s_qhn = s_rope + 1024;
    float* s_khn = s_qhn + 96;
    const int UQ = 128 * 8, UK = 144 * 8;
    int u;
    for (int it = 0; next_unit(it, UQ + UK, bid, nb, u); ++it) {
        if (u < UQ) {
            const int tm = u >> 3, hh = u & 7;
            const int m0 = NCTX + tm * 128;
            f32x4 acc[6][2];
            float ssq[2] = {0.f, 0.f};
#pragma unroll
            for (int i = 0; i < 6; ++i) { acc[i][0] = (f32x4){0.f, 0.f, 0.f, 0.f}; acc[i][1] = (f32x4){0.f, 0.f, 0.f, 0.f}; }
            gemm_rows_acc<6>(acc, ssq, p.Pa() + PA_CQ, PA_W, p.Wt_uq(), 384, 384, m0, hh * 96, smem, smem_all, half == 0, p.rope(), p.qhn_w, p.khn_w, s_rope, it == 0);
#pragma unroll
            for (int mt = 0; mt < 2; ++mt) {
                const int ml = 32 * w + 16 * mt + l15;
                const int rl = tm * 128 + ml;
                const int b = rl >> 11, t = rl & 2047;
                const float rs = rsqrtf(ssq[mt] * (1.f / 384.f) + EPSF);
                float hs = 0.f;
#pragma unroll
                for (int nt = 0; nt < 6; ++nt)
#pragma unroll
                    for (int e = 0; e < 4; ++e) { const float v = acc[nt][mt][e] * rs; acc[nt][mt][e] = v; hs += v * v; }
                hs = xrow_sum(hs);
                const float hr = rsqrtf(hs * (1.f / 96.f) + EPSF) * (0.10206207261596575f * 1.4426950408889634f);
                bf16_t* qd = p.Qb() + ((size_t)((b * 8 + hh) * SEQ + t)) * 96 + 4 * lq;
#pragma unroll
                for (int j = 0; j < 2; ++j) {
                    const f32x4 w0 = *(const f32x4*)(s_qhn + 32 * j + 8 * lq), w1 = *(const f32x4*)(s_qhn + 32 * j + 8 * lq + 4);
                    u32x4 ov;
                    ov[0] = pack_bf2(acc[2 * j][mt][0] * hr * w0[0], acc[2 * j][mt][1] * hr * w0[1]); ov[1] = pack_bf2(acc[2 * j][mt][2] * hr * w0[2], acc[2 * j][mt][3] * hr * w0[3]);
                    ov[2] = pack_bf2(acc[2 * j + 1][mt][0] * hr * w1[0], acc[2 * j + 1][mt][1] * hr * w1[1]); ov[3] = pack_bf2(acc[2 * j + 1][mt][2] * hr * w1[2], acc[2 * j + 1][mt][3] * hr * w1[3]);
                    *(u32x4*)(qd - 4 * lq + 32 * j + 8 * lq) = ov;
                }
#pragma unroll
                for (int nt = 4; nt < 6; ++nt) {
                    const f32x4 wv = *(const f32x4*)(s_qhn + 16 * nt + 4 * lq);
                    f32x4 v;
#pragma unroll
                    for (int e = 0; e < 4; ++e) v[e] = acc[nt][mt][e] * hr * wv[e];
                    if (nt >= 4) {
                        const int pos = (nt == 4) ? (t >> 6) : (t & 63);
                        const int ph = lq >> 1;
#pragma unroll
                        for (int e = 0; e < 4; ++e) {
                            const float2 cs = *(const float2*)(s_rope + 2 * (pos * 8 + (lq & 1) * 4 + e));
                            const float partner = __shfl_xor(v[e], 32);
                            const float t1 = ph ? partner : v[e], t2 = ph ? v[e] : partner;
                            v[e] = ph ? (t1 * cs.y + t2 * cs.x) : (t1 * cs.x - t2 * cs.y);
                        }
                    }
                    st_bf4(qd + 16 * nt, v);
                }
            }
        } else {
            const int uu = u - UQ;
            const int tm = uu >> 3, hh = uu & 7;
            const int m0 = tm * 128;
            f32x4 acc[8][2];
            float ssq[2] = {0.f, 0.f};
#pragma unroll
            for (int i = 0; i < 8; ++i) { acc[i][0] = (f32x4){0.f, 0.f, 0.f, 0.f}; acc[i][1] = (f32x4){0.f, 0.f, 0.f, 0.f}; }
            gemm_rows_acc<8>(acc, ssq, p.Pa() + PA_CKV, PA_W, p.Wt_ukv(), 256, 256, m0, hh * 128, smem, smem_all, half == 0, p.rope(), p.qhn_w, p.khn_w, s_rope, it == 0);
#pragma unroll
            for (int mt = 0; mt < 2; ++mt) {
                const int ml = 32 * w + 16 * mt + l15;
                const int r = m0 + ml;
                int b, pos, t = 0; const bool lat = (r >= NCTX);
                if (!lat) { b = r >> 8; pos = r & 255; }
                else { const int rl = r - NCTX; b = rl >> 11; t = rl & 2047; pos = CTXL + t; }
                const float rs = rsqrtf(ssq[mt] * (1.f / 256.f) + EPSF);
                const u32x4 krw = *(const u32x4*)(p.Pa() + (size_t)r * PA_W + PA_KR + 8 * lq);
                float kr[8];
#pragma unroll
                for (int e = 0; e < 4; ++e) { kr[2 * e] = __uint_as_float(krw[e] << 16); kr[2 * e + 1] = __uint_as_float(krw[e] & 0xffff0000u); }
                float hs = 0.f;
#pragma unroll
                for (int e = 0; e < 8; ++e) hs += kr[e] * kr[e];
#pragma unroll
                for (int nt = 0; nt < 4; ++nt)
#pragma unroll
                    for (int e = 0; e < 4; ++e) { const float v = acc[nt][mt][e] * rs; acc[nt][mt][e] = v; hs += v * v; }
                hs = xrow_sum(hs);
                const float hr = rsqrtf(hs * (1.f / 96.f) + EPSF);
                bf16_t* kd = p.Kb() + ((size_t)((b * 8 + hh) * TPB + pos)) * 96;
#pragma unroll
                for (int j = 0; j < 2; ++j) {
                    const f32x4 w0 = *(const f32x4*)(s_khn + 32 * j + 8 * lq), w1 = *(const f32x4*)(s_khn + 32 * j + 8 * lq + 4);
                    u32x4 ov;
                    ov[0] = pack_bf2(acc[2 * j][mt][0] * hr * w0[0], acc[2 * j][mt][1] * hr * w0[1]); ov[1] = pack_bf2(acc[2 * j][mt][2] * hr * w0[2], acc[2 * j][mt][3] * hr * w0[3]);
                    ov[2] = pack_bf2(acc[2 * j + 1][mt][0] * hr * w1[0], acc[2 * j + 1][mt][1] * hr * w1[1]); ov[3] = pack_bf2(acc[2 * j + 1][mt][2] * hr * w1[2], acc[2 * j + 1][mt][3] * hr * w1[3]);
                    *(u32x4*)(kd + 32 * j + 8 * lq) = ov;
                }
                {
                    const int ph = lq & 1;
                    const int rp = (lq >> 1) ? (t & 63) : (t >> 6);
                    float o[8];
#pragma unroll
                    for (int e = 0; e < 8; ++e) {
                        const float v = kr[e] * hr * s_khn[64 + 8 * lq + e];
                        const float partner = __shfl_xor(v, 16);
                        float2 cs = make_float2(1.f, 0.f);
                        if (lat) cs = *(const float2*)(s_rope + 2 * (rp * 8 + e));
                        const float t1 = ph ? partner : v, t2 = ph ? v : partner;
                        o[e] = ph ? (t1 * cs.y + t2 * cs.x) : (t1 * cs.x - t2 * cs.y);
                    }
                    u32x4 ov;
                    ov[0] = pack_bf2(o[0], o[1]); ov[1] = pack_bf2(o[2], o[3]); ov[2] = pack_bf2(o[4], o[5]); ov[3] = pack_bf2(o[6], o[7]);
                    *(u32x4*)(kd + 64 + 8 * lq) = ov;
                }
                {
                    const int kpos = (pos & ~12) | ((pos & 4) << 1) | ((pos & 8) >> 1);
                    bf16_t* vd = p.Vt() + (size_t)((b * 8 + hh) * 64) * TPB + kpos;
#pragma unroll
                    for (int nt = 4; nt < 8; ++nt)
#pragma unroll
                        for (int e = 0; e < 4; ++e) vd[(size_t)(16 * (nt - 4) + 4 * lq + e) * TPB] = f2bf(acc[nt][mt][e] * rs);
                }
            }
        }
    }
    {
        float mq = fmaxf(fabsf(s_qhn[lane]), (lane < 32) ? fabsf(s_qhn[64 + lane]) : 0.f);
        float mk = fmaxf(fabsf(s_khn[lane]), (lane < 32) ? fabsf(s_khn[64 + lane]) : 0.f);
#pragma unroll
        for (int o = 32; o > 0; o >>= 1) { mq = fmaxf(mq, __shfl_xor(mq, o)); mk = fmaxf(mk, __shfl_xor(mk, o)); }
        if (threadIdx.x == 0) ((volatile LAS unsigned*)(smem_all + 2 * SMEM_BYTES - 16))[2] = __float_as_uint((9.797958971f * 1.4426950408889634f * 1.0001f) * mq * mk);
    }
}

typedef float f32x16 __attribute__((ext_vector_type(16)));
#define ATT_KROW 208
#define ATT_VROW 144
#define ATT_KBYTES (64 * ATT_KROW)
#define ATT_STAGE (ATT_KBYTES + 64 * ATT_VROW)
template <bool ZI>
__device__ __forceinline__ void ph_attn_t(const Params& p, int bid, int nb, char* smem, const float negB) {
    const int tid = VTID, lane = tid & 63, w = tid >> 6, r = lane & 31, h = lane >> 5;
    int u;
    for (int it = 0; next_unit(it, 1024, bid, nb, u); ++it) {
        const int bh = u >> 4, qb = u & 15;
        bf16x8 qf[6];
        {
            const bf16_t* Qp = p.Qb() + ((size_t)bh * SEQ + qb * 128 + w * 32 + r) * 96 + h * 8;
#pragma unroll
            for (int s = 0; s < 6; ++s) qf[s] = *(const bf16x8*)(Qp + s * 16);
        }
        const bf16_t* Kg = p.Kb() + (size_t)bh * TPB * 96 + tid * 8;
        const bf16_t* Vg = p.Vt() + (size_t)bh * 64 * TPB + (size_t)(tid >> 3) * TPB + (tid & 7) * 8;
        int koff[3], voff[2];
#pragma unroll
        for (int i = 0; i < 3; ++i) { const int c = tid + 256 * i; koff[i] = (c / 12) * ATT_KROW + (c % 12) * 16; }
#pragma unroll
        for (int i = 0; i < 2; ++i) { const int c = tid + 256 * i; voff[i] = ATT_KBYTES + (c >> 3) * ATT_VROW + (c & 7) * 16; }
        u32x4 rk[3], rv[2];
#pragma unroll
        for (int i = 0; i < 3; ++i) rk[i] = *(const u32x4*)(Kg + i * 2048);
#pragma unroll
        for (int i = 0; i < 2; ++i) rv[i] = *(const u32x4*)(Vg + (size_t)(32 * i) * TPB);
#pragma unroll
        for (int i = 0; i < 3; ++i) *(u32x4*)(smem + koff[i]) = rk[i];
#pragma unroll
        for (int i = 0; i < 2; ++i) *(u32x4*)(smem + voff[i]) = rv[i];
        __syncthreads();
        f32x16 o0, o1;
#pragma unroll
        for (int i = 0; i < 16; ++i) { o0[i] = 0.f; o1[i] = 0.f; }
        float l = 0.f;
        int NKT = TPB / 64;
        asm volatile("" : "+s"(NKT));
        for (int kt = 0; kt < NKT; ++kt) {
            if (kt + 1 < NKT) {
#pragma unroll
                for (int i = 0; i < 3; ++i) rk[i] = *(const u32x4*)(Kg + (size_t)(kt + 1) * 6144 + i * 2048);
#pragma unroll
                for (int i = 0; i < 2; ++i) rv[i] = *(const u32x4*)(Vg + (size_t)(32 * i) * TPB + (kt + 1) * 64);
            }
            const char* sk = smem + (kt & 1) * ATT_STAGE;
            const char* sv = sk + ATT_KBYTES;
            f32x16 s0, s1;
            if (ZI) {
                const f32x16 z16 = {0.f, 0.f, 0.f, 0.f, 0.f, 0.f, 0.f, 0.f, 0.f, 0.f, 0.f, 0.f, 0.f, 0.f, 0.f, 0.f};
                const bf16x8 k0 = *(const bf16x8*)(sk + r * ATT_KROW + h * 16);
                const bf16x8 k1 = *(const bf16x8*)(sk + (32 + r) * ATT_KROW + h * 16);
                s0 = __builtin_amdgcn_mfma_f32_32x32x16_bf16(k0, qf[0], z16, 0, 0, 0);
                s1 = __builtin_amdgcn_mfma_f32_32x32x16_bf16(k1, qf[0], z16, 0, 0, 0);
            } else {
#pragma unroll
                for (int i = 0; i < 16; ++i) { s0[i] = negB; s1[i] = negB; }
            }
#pragma unroll
            for (int s = ZI ? 1 : 0; s < 6; ++s) {
                const bf16x8 k0 = *(const bf16x8*)(sk + r * ATT_KROW + (2 * s + h) * 16);
                const bf16x8 k1 = *(const bf16x8*)(sk + (32 + r) * ATT_KROW + (2 * s + h) * 16);
                s0 = __builtin_amdgcn_mfma_f32_32x32x16_bf16(k0, qf[s], s0, 0, 0, 0);
                s1 = __builtin_amdgcn_mfma_f32_32x32x16_bf16(k1, qf[s], s1, 0, 0, 0);
            }
            float ls = 0.f;
#pragma unroll
            for (int i = 0; i < 16; ++i) {
                s0[i] = __builtin_amdgcn_exp2f(s0[i]);
                s1[i] = __builtin_amdgcn_exp2f(s1[i]);
                ls += s0[i] + s1[i];
            }
            l += ls;
#pragma unroll
            for (int ks = 0; ks < 4; ++ks) {
                u32x4 pw;
                if (ks < 2) {
                    pw[0] = pack_bf2(s0[8 * (ks & 1) + 0], s0[8 * (ks & 1) + 1]); pw[1] = pack_bf2(s0[8 * (ks & 1) + 2], s0[8 * (ks & 1) + 3]);
                    pw[2] = pack_bf2(s0[8 * (ks & 1) + 4], s0[8 * (ks & 1) + 5]); pw[3] = pack_bf2(s0[8 * (ks & 1) + 6], s0[8 * (ks & 1) + 7]);
                } else {
                    pw[0] = pack_bf2(s1[8 * (ks & 1) + 0], s1[8 * (ks & 1) + 1]); pw[1] = pack_bf2(s1[8 * (ks & 1) + 2], s1[8 * (ks & 1) + 3]);
                    pw[2] = pack_bf2(s1[8 * (ks & 1) + 4], s1[8 * (ks & 1) + 5]); pw[3] = pack_bf2(s1[8 * (ks & 1) + 6], s1[8 * (ks & 1) + 7]);
                }
                const bf16x8 pf = __builtin_bit_cast(bf16x8, pw);
                const bf16x8 v0 = *(const bf16x8*)(sv + r * ATT_VROW + (2 * ks + h) * 16);
                const bf16x8 v1 = *(const bf16x8*)(sv + (32 + r) * ATT_VROW + (2 * ks + h) * 16);
                o0 = __builtin_amdgcn_mfma_f32_32x32x16_bf16(v0, pf, o0, 0, 0, 0);
                o1 = __builtin_amdgcn_mfma_f32_32x32x16_bf16(v1, pf, o1, 0, 0, 0);
            }
            if (kt + 1 < NKT) {
                char* ds = smem + ((kt + 1) & 1) * ATT_STAGE;
#pragma unroll
                for (int i = 0; i < 3; ++i) *(u32x4*)(ds + koff[i]) = rk[i];
#pragma unroll
                for (int i = 0; i < 2; ++i) *(u32x4*)(ds + voff[i]) = rv[i];
            }
            __syncthreads();
        }
        l += __shfl_xor(l, 32);
        const float inv = 1.f / l;
        const int b = bh >> 3, hh = bh & 7;
        const size_t rl = (size_t)(b * SEQ + qb * 128 + w * 32 + r);
        bf16_t* op = p.A_mla() + rl * 512 + hh * 64 + 4 * h;
        const bf16_t* zp = p.Pz() + rl * PZ_W + hh * 64 + 4 * h;
#pragma unroll
        for (int g = 0; g < 4; ++g) {
            const f32x4 z0 = ld_bf4(zp + 8 * g), z1 = ld_bf4(zp + 32 + 8 * g);
            uint2 a, c;
            a.x = pack_bf2(o0[4 * g + 0] * inv * silu_f(z0[0]), o0[4 * g + 1] * inv * silu_f(z0[1]));
            a.y = pack_bf2(o0[4 * g + 2] * inv * silu_f(z0[2]), o0[4 * g + 3] * inv * silu_f(z0[3]));
            c.x = pack_bf2(o1[4 * g + 0] * inv * silu_f(z1[0]), o1[4 * g + 1] * inv * silu_f(z1[1]));
            c.y = pack_bf2(o1[4 * g + 2] * inv * silu_f(z1[2]), o1[4 * g + 3] * inv * silu_f(z1[3]));
            *(uint2*)(op + 8 * g) = a;
            *(uint2*)(op + 32 + 8 * g) = c;
        }
    }
}

#define AT8_VROW 272
#define AT8_KBYTES (128 * ATT_KROW)
#define AT8_STAGE (AT8_KBYTES + 64 * AT8_VROW)
__device__ __forceinline__ void ph_attn8(const Params& p, char* smem, const int pb) {
    int tid = threadIdx.x;
    asm volatile("" : "+v"(tid));
    const int lane = tid & 63, w = tid >> 6, r = lane & 31, h = lane >> 5;
    const int bh = (pb >> 5) * 8 + (pb & 7), qb = (pb >> 3) & 3;
    bf16x8 qf[2][6];
#pragma unroll
    for (int t = 0; t < 2; ++t) {
        const bf16_t* Qp = p.Qb() + ((size_t)bh * SEQ + qb * 512 + w * 64 + t * 32 + r) * 96 + h * 8;
#pragma unroll
        for (int s = 0; s < 6; ++s) qf[t][s] = *(const bf16x8*)(Qp + s * 16);
    }
    const bf16_t* Kg = p.Kb() + (size_t)bh * TPB * 96 + tid * 8;
    const bf16_t* Vg = p.Vt() + (size_t)bh * 64 * TPB + (size_t)(tid >> 4) * TPB + (tid & 15) * 8;
    int koff[3], voff[2];
#pragma unroll
    for (int i = 0; i < 3; ++i) { const int c = tid + 512 * i; koff[i] = (c / 12) * ATT_KROW + (c % 12) * 16; }
#pragma unroll
    for (int i = 0; i < 2; ++i) { const int c = tid + 512 * i; voff[i] = AT8_KBYTES + (c >> 4) * AT8_VROW + (c & 15) * 16; }
    u32x4 rk[3], rv[2];
#pragma unroll
    for (int i = 0; i < 3; ++i) rk[i] = *(const u32x4*)(Kg + i * 4096);
#pragma unroll
    for (int i = 0; i < 2; ++i) rv[i] = *(const u32x4*)(Vg + (size_t)(32 * i) * TPB);
#pragma unroll
    for (int i = 0; i < 3; ++i) *(u32x4*)(smem + koff[i]) = rk[i];
#pragma unroll
    for (int i = 0; i < 2; ++i) *(u32x4*)(smem + voff[i]) = rv[i];
    __syncthreads();
#pragma unroll
    for (int t = 0; t < 2; ++t)
#pragma unroll
        for (int s = 0; s < 6; ++s) asm volatile("" :: "v"(qf[t][s]));
    f32x16 o[2][2];
#pragma unroll
    for (int t = 0; t < 2; ++t)
#pragma unroll
        for (int i = 0; i < 16; ++i) { o[t][0][i] = 0.f; o[t][1][i] = 0.f; }
    float l[2] = {0.f, 0.f};
    int NKT = TPB / 128;
    asm volatile("" : "+s"(NKT));
    for (int kt = 0; kt < NKT; ++kt) {
        if (kt + 1 < NKT) {
#pragma unroll
            for (int i = 0; i < 3; ++i) rk[i] = *(const u32x4*)(Kg + (size_t)(kt + 1) * 12288 + i * 4096);
#pragma unroll
            for (int i = 0; i < 2; ++i) rv[i] = *(const u32x4*)(Vg + (size_t)(32 * i) * TPB + (kt + 1) * 128);
        }
        const char* sk = smem + (kt & 1) * AT8_STAGE;
        const char* sv = sk + AT8_KBYTES;
        int NHF = 4;
        asm volatile("" : "+s"(NHF));
        for (int hf = 0; hf < NHF; ++hf) {
            const char* skh = sk + hf * 32 * ATT_KROW;
            const char* svh = sv + hf * 64;
            f32x16 s[2];
            {
                const f32x16 z16 = {0.f, 0.f, 0.f, 0.f, 0.f, 0.f, 0.f, 0.f, 0.f, 0.f, 0.f, 0.f, 0.f, 0.f, 0.f, 0.f};
                const bf16x8 k0 = *(const bf16x8*)(skh + r * ATT_KROW + h * 16);
                s[0] = __builtin_amdgcn_mfma_f32_32x32x16_bf16(k0, qf[0][0], z16, 0, 0, 0);
                s[1] = __builtin_amdgcn_mfma_f32_32x32x16_bf16(k0, qf[1][0], z16, 0, 0, 0);
            }
#pragma unroll
            for (int ss = 1; ss < 6; ++ss) {
                const bf16x8 k0 = *(const bf16x8*)(skh + r * ATT_KROW + (2 * ss + h) * 16);
                s[0] = __builtin_amdgcn_mfma_f32_32x32x16_bf16(k0, qf[0][ss], s[0], 0, 0, 0);
                s[1] = __builtin_amdgcn_mfma_f32_32x32x16_bf16(k0, qf[1][ss], s[1], 0, 0, 0);
            }
            bf16x8 pf[2][2];
#pragma unroll
            for (int t = 0; t < 2; ++t) {
                float ls = 0.f;
#pragma unroll
                for (int i = 0; i < 16; ++i) {
                    s[t][i] = __builtin_amdgcn_exp2f(s[t][i]);
                    ls += s[t][i];
                }
                l[t] += ls;
#pragma unroll
                for (int ks = 0; ks < 2; ++ks) {
                    u32x4 pw;
#pragma unroll
                    for (int e = 0; e < 4; ++e) pw[e] = pack_bf2(s[t][8 * ks + 2 * e], s[t][8 * ks + 2 * e + 1]);
                    pf[t][ks] = __builtin_bit_cast(bf16x8, pw);
                }
            }
#pragma unroll
            for (int ks = 0; ks < 2; ++ks) {
                const bf16x8 v0 = *(const bf16x8*)(svh + r * AT8_VROW + (2 * ks + h) * 16);
                const bf16x8 v1 = *(const bf16x8*)(svh + (32 + r) * AT8_VROW + (2 * ks + h) * 16);
#pragma unroll
                for (int t = 0; t < 2; ++t) {
                    o[t][0] = __builtin_amdgcn_mfma_f32_32x32x16_bf16(v0, pf[t][ks], o[t][0], 0, 0, 0);
                    o[t][1] = __builtin_amdgcn_mfma_f32_32x32x16_bf16(v1, pf[t][ks], o[t][1], 0, 0, 0);
                }
            }
        }
        if (kt + 1 < NKT) {
            char* ds = smem + ((kt + 1) & 1) * AT8_STAGE;
#pragma unroll
            for (int i = 0; i < 3; ++i) *(u32x4*)(ds + koff[i]) = rk[i];
#pragma unroll
            for (int i = 0; i < 2; ++i) *(u32x4*)(ds + voff[i]) = rv[i];
        }
        __syncthreads();
    }
    const int b = bh >> 3, hh = bh & 7;
    char* so = smem + w * 8704;
    const int er = lane >> 3, ec = lane & 7;
#pragma unroll
    for (int t = 0; t < 2; ++t) {
        const size_t rl0 = (size_t)(b * SEQ + qb * 512 + w * 64 + t * 32);
        u32x4 zr[4];
#pragma unroll
        for (int it = 0; it < 4; ++it) zr[it] = *(const u32x4*)(p.Pz() + (rl0 + 8 * it + er) * PZ_W + hh * 64 + 8 * ec);
        const float lt = l[t] + __shfl_xor(l[t], 32);
        const float inv = 1.f / lt;
#pragma unroll
        for (int g = 0; g < 4; ++g) {
            f32x4 v0, v1;
#pragma unroll
            for (int e = 0; e < 4; ++e) { v0[e] = o[t][0][4 * g + e] * inv; v1[e] = o[t][1][4 * g + e] * inv; }
            *(f32x4*)(so + r * 272 + (8 * g + 4 * h) * 4) = v0;
            *(f32x4*)(so + r * 272 + (32 + 8 * g + 4 * h) * 4) = v1;
        }
        asm volatile("s_waitcnt lgkmcnt(0)" ::: "memory");
#pragma unroll
        for (int it = 0; it < 4; ++it) {
            const int row = 8 * it + er;
            const f32x4 a0 = *(const f32x4*)(so + row * 272 + ec * 32), a1 = *(const f32x4*)(so + row * 272 + ec * 32 + 16);
            u32x4 ov;
#pragma unroll
            for (int k = 0; k < 2; ++k) {
                const float z0 = __uint_as_float(zr[it][k] << 16), z1 = __uint_as_float(zr[it][k] & 0xffff0000u);
                const float z2 = __uint_as_float(zr[it][2 + k] << 16), z3 = __uint_as_float(zr[it][2 + k] & 0xffff0000u);
                ov[k] = pack_bf2(a0[2 * k] * silu_f(z0), a0[2 * k + 1] * silu_f(z1));
                ov[2 + k] = pack_bf2(a1[2 * k] * silu_f(z2), a1[2 * k + 1] * silu_f(z3));
            }
            *(u32x4*)(p.A_mla() + (rl0 + row) * 512 + hh * 64 + 8 * ec) = ov;
        }
        asm volatile("s_waitcnt lgkmcnt(0)" ::: "memory");
    }
}

__device__ __forceinline__ void ph_attn(const Params& p, int bid, int nb, char* smem, char* smem_all, int pb) {
    const float B = __uint_as_float((unsigned)__builtin_amdgcn_readfirstlane((int)((volatile LAS unsigned*)(smem_all + 2 * SMEM_BYTES - 16))[2]));
    if (B <= 40.f) ph_attn8(p, smem_all, pb);
    else ph_attn_t<false>(p, bid, nb, smem, -B);
}

__device__ __forceinline__ int el_off(int row, int col) { return lds_off(row, col >> 3) + (col & 7) * 2; }

__device__ __forceinline__ void mm64(f32x4 (&acc)[4], const char* A, int arow0, const char* B, int l15, int lq) {
#pragma unroll
    for (int ks = 0; ks < 2; ++ks) {
        const bf16x8 a = *(const bf16x8*)(A + lds_off(arow0 + l15, ks * 4 + lq));
#pragma unroll
        for (int nt = 0; nt < 4; ++nt) {
            const bf16x8 b = *(const bf16x8*)(B + lds_off(nt * 16 + l15, ks * 4 + lq));
            acc[nt] = __builtin_amdgcn_mfma_f32_16x16x32_bf16(a, b, acc[nt], 0, 0, 0);
        }
    }
}
__device__ __forceinline__ void acc4_zero(f32x4 (&a)[4]) {
#pragma unroll
    for (int i = 0; i < 4; ++i) a[i] = (f32x4){0.f, 0.f, 0.f, 0.f};
}

#define DN_SQ 0
#define DN_SK 8192
#define DN_SV 16384
#define DN_LSTR 65
#define DN_LBYTES (64 * DN_LSTR * 4)
#define DN_SL 24576
#define DN_SA 57856
#define DN_SKD 66048
#define DN_SS 74240

typedef short s16x4 __attribute__((ext_vector_type(4)));
__device__ __forceinline__ s16x4 ds_tr(const char* p) { return __builtin_amdgcn_ds_read_tr16_b64_v4i16((LAS s16x4*)p); }
__device__ __forceinline__ bf16x8 frag_tr(const char* X, int ks, int tile, int l15, int lq) {
    const int r0 = 32 * ks + 8 * lq + (l15 >> 2), col = 16 * tile + 4 * (l15 & 3);
    const s16x4 v0 = ds_tr(X + el_off(r0, col)), v1 = ds_tr(X + el_off(r0 + 4, col));
    return __builtin_shufflevector(v0, v1, 0, 1, 2, 3, 4, 5, 6, 7);
}

#define CHOP_OFF(W_, NT_, LANE_) ((((W_) * 4 + (NT_)) * 64 + (LANE_)) * 4)
struct Dn1In { u32x4 rp[7]; float dtb, alog; bf16_t db, da; float cw[4]; };
__device__ __forceinline__ void dn1_fetch(Dn1In& in, const Params& p, int u, int tid) {
    const int bh = u / 36, pb = u % 36, b = bh >> 3, h = bh & 7;
    int rowbase, seglen, lb;
    if (pb < 4) { rowbase = b * CTXL; seglen = CTXL; lb = pb; }
    else { rowbase = NCTX + b * SEQ; seglen = SEQ; lb = pb - 4; }
    const int ch = tid & 7, r5 = tid >> 3;
#pragma unroll
    for (int i = 0; i < 7; ++i) {
        const int ri = r5 + 32 * i;
        const int g = (i < 2) ? 0 : (i == 2) ? (ri >= 68 ? 1 : 0) : (i == 3) ? 1 : (i == 4) ? (ri >= 136 ? 2 : 1) : 2;
        const int rr = ri - 68 * g;
        const int lp = lb * 64 - 2 + rr;
        u32x4 val = (u32x4){0u, 0u, 0u, 0u};
        if (ri < 3 * 68 && lp >= 0 && lp < seglen) val = *(const u32x4*)(p.Pa() + (size_t)(rowbase + lp) * PA_W + PA_DQ + h * 192 + g * 64 + ch * 8);
        in.rp[i] = val;
    }
#pragma unroll
    for (int i = 0; i < 4; ++i) {
        const int q = (tid >> 6) + 4 * i, g = (q >= 5 ? 1 : 0) + (q >= 10 ? 1 : 0), j = q - 5 * g, c = tid & 63;
        in.cw[i] = (q < 15) ? p.conv_w[j * 1536 + g * 512 + h * 64 + c] : 0.f;
    }
    in.db = 0; in.da = 0; in.dtb = 0.f; in.alog = 0.f;
    if (tid < 128) {
        in.dtb = p.dt_bias[(tid >> 6) * 8 + h]; in.alog = p.a_log[(tid >> 6) * 8 + h];
        const int d = tid >> 6, tp = tid & 63;
        const int pos = d ? 63 - tp : tp;
        const bf16_t* row = p.Pa() + (size_t)(rowbase + lb * 64 + pos) * PA_W;
        in.db = row[PA_DB + d * 8 + h];
        in.da = row[PA_DA + d * 8 + h];
    }
}

__device__ __forceinline__ void ph_dn1(const Params& p, int bid, int nb, char* smem) {
    char* sQ = smem + DN_SQ; char* sK = smem + DN_SK; char* sV = smem + DN_SV;
    char* sL = smem + DN_SL; char* sA = smem + DN_SA; char* sKd = smem + DN_SKD;
    float* sS = (float*)(smem + DN_SS);
    const int x_ = bid & 7, li_ = bid >> 3;
#define DN1_UNIT(IT, U, VALID) do { const int it_ = (IT); const int q_ = li_ + (it_ < 4 ? it_ * 64 : 0); const int grp_ = x_ + 8 * (q_ >> 3); \
        VALID = (it_ < 4) || (it_ == 4 && li_ < 32); \
        const int b_ = (it_ < 4) ? (grp_ >> 5) : (grp_ >> 2), pb_ = (it_ < 4) ? 4 + (grp_ & 31) : (grp_ & 3); U = (b_ * 8 + (q_ & 7)) * 36 + pb_; } while (0)
    Dn1In in;
    int u, un; bool valid, validn;
    DN1_UNIT(0, u, valid);
    if (valid) dn1_fetch(in, p, u, VTID);
    for (int it = 0; valid; ++it, u = un, valid = validn) {
        DN1_UNIT(it + 1, un, validn);
        int tid = VTID;
        asm volatile("" : "+v"(tid));
        const int lane = tid & 63, w = __builtin_amdgcn_readfirstlane(tid >> 6), l15 = lane & 15, lq = lane >> 4;
        const int bh = u / 36, pb = u % 36, h = bh & 7;
        const bool lat = (pb >= 4);
        if (w < 2) {
            const int d = w, tp = lane;
            const float xx = bf2f(in.da) + in.dtb;
            const float sp = (xx > 20.f) ? xx : __logf(1.f + __expf(xx));
            const float g = -__expf(in.alog) * sp;
            float gc = g;
#pragma unroll
            for (int o = 1; o < 64; o <<= 1) { const float t = __shfl_up(gc, o); if (lane >= o) gc += t; }
            const float gl = __shfl(gc, 63);
            const float bt = sigmoid_f(bf2f(in.db)), eg = __expf(gc);
            sS[(d * 5 + 0) * 64 + tp] = bt;
            sS[(d * 5 + 1) * 64 + tp] = gc;
            sS[(d * 5 + 2) * 64 + tp] = eg;
            sS[(d * 5 + 3) * 64 + tp] = __expf(gl - gc);
            sS[(d * 5 + 4) * 64 + tp] = bt * eg;
        }
        {
            char* raw = sL;
#pragma unroll
            for (int i = 0; i < 7; ++i)
                if (tid + NTHR * i < 3 * 68 * 8) *(u32x4*)(raw + tid * 16 + i * 4096) = in.rp[i];
            float* cwS = (float*)(sL + 26112);
#pragma unroll
            for (int i = 0; i < 4; ++i) { const int idx = tid + NTHR * i; if (idx < 960) cwS[idx] = in.cw[i]; }
            if (validn) dn1_fetch(in, p, un, tid);
            __syncthreads();
            const int o = tid & 7, r0 = tid >> 3;
#pragma unroll
            for (int g = 0; g < 3; ++g) {
                if (g == 0 && !lat) continue;
                float wj[5][8];
#pragma unroll
                for (int j = 0; j < 5; ++j) {
                    const f32x4 w0 = *(const f32x4*)(cwS + (g * 5 + j) * 64 + 8 * o), w1 = *(const f32x4*)(cwS + (g * 5 + j) * 64 + 8 * o + 4);
#pragma unroll
                    for (int e2 = 0; e2 < 4; ++e2) { wj[j][e2] = w0[e2]; wj[j][4 + e2] = w1[e2]; }
                }
                {
                    const int rr = 2 * r0;
                    float a0[8], a1[8];
#pragma unroll
                    for (int e2 = 0; e2 < 8; ++e2) { a0[e2] = 0.f; a1[e2] = 0.f; }
#pragma unroll
                    for (int i = 0; i < 6; ++i) {
                        const u32x4 dv = *(const u32x4*)(raw + (g * 68 + rr + i) * 128 + o * 16);
#pragma unroll
                        for (int e2 = 0; e2 < 4; ++e2) {
                            const float lo = __uint_as_float(dv[e2] << 16), hi = __uint_as_float(dv[e2] & 0xffff0000u);
                            if (i < 5) { a0[2 * e2] += lo * wj[i][2 * e2]; a0[2 * e2 + 1] += hi * wj[i][2 * e2 + 1]; }
                            if (i > 0) { a1[2 * e2] += lo * wj[i - 1][2 * e2]; a1[2 * e2 + 1] += hi * wj[i - 1][2 * e2 + 1]; }
                        }
                    }
#pragma unroll
                    for (int hh = 0; hh < 2; ++hh) {
                        float a[8];
#pragma unroll
                        for (int e2 = 0; e2 < 8; ++e2) a[e2] = hh ? a1[e2] : a0[e2];
                        float ss = 0.f;
#pragma unroll
                        for (int e2 = 0; e2 < 8; ++e2) { a[e2] = silu_f(a[e2]); ss += a[e2] * a[e2]; }
                        float sc = 1.f;
                        if (g < 2) {
                            ss += dpp_mov<0xB1>(ss); ss += dpp_mov<0x4E>(ss); ss += dpp_mov<0x141>(ss);
                            sc = rsqrtf(ss + EPSF) * (g == 0 ? 0.125f : 1.f);
                        }
                        u32x4 ov;
#pragma unroll
                        for (int e2 = 0; e2 < 4; ++e2) ov[e2] = pack_bf2(a[2 * e2] * sc, a[2 * e2 + 1] * sc);
                        *(u32x4*)((g == 0 ? sQ : g == 1 ? sK : sV) + lds_off(rr + hh, o)) = ov;
                    }
                }
            }
            __syncthreads();
        }
        {
            f32x4 G[4];
            acc4_zero(G);
            mm64(G, sK, 16 * w, sK, l15, lq);
            float* L0 = (float*)sL; float* L1 = (float*)(sL + DN_LBYTES);
            const int t0 = 16 * w + 4 * lq;
            const f32x4 be0t = *(const f32x4*)(sS + 0 * 64 + t0), gc0t = *(const f32x4*)(sS + 1 * 64 + t0);
            const f32x4 be1r = *(const f32x4*)(sS + 5 * 64 + 60 - t0), gc1r = *(const f32x4*)(sS + 6 * 64 + 60 - t0);
            float gc0s[4], gc1s[4];
#pragma unroll
            for (int nt = 0; nt < 4; ++nt) { gc0s[nt] = sS[1 * 64 + 16 * nt + l15]; gc1s[nt] = sS[6 * 64 + 63 - (16 * nt + l15)]; }
#pragma unroll
            for (int nt = 0; nt < 4; ++nt)
#pragma unroll
                for (int rg = 0; rg < 4; ++rg) {
                    const int t = t0 + rg, s = 16 * nt + l15;
                    const float gv = G[nt][rg];
                    const int tp = 63 - t, sp = 63 - s;
                    const float e0 = be0t[rg] * gv * __expf(gc0t[rg] - gc0s[nt]);
                    const float e1 = be1r[3 - rg] * gv * __expf(gc1r[3 - rg] - gc1s[nt]);
                    L0[t * DN_LSTR + s] = (s < t) ? e0 : 0.f;
                    L1[tp * DN_LSTR + sp] = (s > t) ? e1 : 0.f;
                }
            __syncthreads();
        }
        {
            int tid3 = tid;
            asm volatile("" : "+v"(tid3) :: "memory");
            const int lane3 = tid3 & 63, w3 = __builtin_amdgcn_readfirstlane(tid3 >> 6), l15c = lane3 & 15, lqc = lane3 >> 4;
            if (w3 < 2) {
                float* Lb = (float*)(sL + w3 * DN_LBYTES) + (16 * lqc) * DN_LSTR + 16 * lqc;
                float Lr[120];
#pragma unroll
                for (int i = 1; i < 16; ++i)
#pragma unroll
                    for (int j = 0; j < i; ++j) Lr[i * (i - 1) / 2 + j] = Lb[i * DN_LSTR + j];
                float x[16];
#pragma unroll
                for (int i = 0; i < 16; ++i) {
                    float v0 = (i == l15c) ? 1.f : 0.f, v1 = 0.f;
#pragma unroll
                    for (int j = 0; j < i; ++j) { if (j & 1) v1 -= Lr[i * (i - 1) / 2 + j] * x[j]; else v0 -= Lr[i * (i - 1) / 2 + j] * x[j]; }
                    x[i] = v0 + v1;
                }
#pragma unroll
                for (int i = 0; i < 16; ++i) Lb[i * DN_LSTR + l15c] = x[i];
            }
            __syncthreads();
            {
                const int d = w3 >> 1, pr = w3 & 1, b0 = 2 * pr, b1 = 2 * pr + 1;
                float* Ld = (float*)(sL + d * DN_LBYTES);
                float* scr = (float*)(sA) + w3 * 272;
                float pa[4], pb[4], ra[4], rb[4];
#pragma unroll
                for (int kk = 0; kk < 4; ++kk) {
                    pa[kk] = Ld[(16 * b1 + l15c) * DN_LSTR + 16 * b0 + 4 * kk + lqc];
                    pb[kk] = Ld[(16 * b0 + 4 * kk + lqc) * DN_LSTR + 16 * b0 + l15c];
                    ra[kk] = Ld[(16 * b1 + l15c) * DN_LSTR + 16 * b1 + 4 * kk + lqc];
                }
                f32x4 P = (f32x4){0.f, 0.f, 0.f, 0.f};
#pragma unroll
                for (int kk = 0; kk < 4; ++kk) P = __builtin_amdgcn_mfma_f32_16x16x4f32(pa[kk], pb[kk], P, 0, 0, 0);
#pragma unroll
                for (int rg = 0; rg < 4; ++rg) scr[(4 * lqc + rg) * 17 + l15c] = P[rg];
                asm volatile("s_waitcnt lgkmcnt(0)" ::: "memory");
#pragma unroll
                for (int kk = 0; kk < 4; ++kk) rb[kk] = scr[(4 * kk + lqc) * 17 + l15c];
                f32x4 R = (f32x4){0.f, 0.f, 0.f, 0.f};
#pragma unroll
                for (int kk = 0; kk < 4; ++kk) R = __builtin_amdgcn_mfma_f32_16x16x4f32(ra[kk], rb[kk], R, 0, 0, 0);
#pragma unroll
                for (int rg = 0; rg < 4; ++rg) Ld[(16 * b1 + 4 * lqc + rg) * DN_LSTR + 16 * b0 + l15c] = -R[rg];
            }
            __syncthreads();
            {
                const int d = w3 >> 1, hf = w3 & 1;
                float* Ld = (float*)(sL + d * DN_LBYTES);
                float* scr2 = (float*)(d ? sKd : sA);
                float qa[8], qb[8][2], sa2[8];
#pragma unroll
                for (int kk = 0; kk < 8; ++kk) {
                    qa[kk] = Ld[(32 + 16 * hf + l15c) * DN_LSTR + 4 * kk + lqc];
                    qb[kk][0] = Ld[(4 * kk + lqc) * DN_LSTR + l15c]; qb[kk][1] = Ld[(4 * kk + lqc) * DN_LSTR + 16 + l15c];
                    sa2[kk] = Ld[(32 + 16 * hf + l15c) * DN_LSTR + 32 + 4 * kk + lqc];
                }
                f32x4 P2[2];
                P2[0] = (f32x4){0.f, 0.f, 0.f, 0.f}; P2[1] = (f32x4){0.f, 0.f, 0.f, 0.f};
#pragma unroll
                for (int kk = 0; kk < 8; ++kk)
#pragma unroll
                    for (int n2 = 0; n2 < 2; ++n2) P2[n2] = __builtin_amdgcn_mfma_f32_16x16x4f32(qa[kk], qb[kk][n2], P2[n2], 0, 0, 0);
#pragma unroll
                for (int n2 = 0; n2 < 2; ++n2)
#pragma unroll
                    for (int rg = 0; rg < 4; ++rg) scr2[(16 * hf + 4 * lqc + rg) * 33 + 16 * n2 + l15c] = P2[n2][rg];
                __syncthreads();
                float sb2[8][2];
#pragma unroll
                for (int kk = 0; kk < 8; ++kk) { sb2[kk][0] = scr2[(4 * kk + lqc) * 33 + l15c]; sb2[kk][1] = scr2[(4 * kk + lqc) * 33 + 16 + l15c]; }
                f32x4 R2[2];
                R2[0] = (f32x4){0.f, 0.f, 0.f, 0.f}; R2[1] = (f32x4){0.f, 0.f, 0.f, 0.f};
#pragma unroll
                for (int kk = 0; kk < 8; ++kk)
#pragma unroll
                    for (int n2 = 0; n2 < 2; ++n2) R2[n2] = __builtin_amdgcn_mfma_f32_16x16x4f32(sa2[kk], sb2[kk][n2], R2[n2], 0, 0, 0);
#pragma unroll
                for (int n2 = 0; n2 < 2; ++n2)
#pragma unroll
                    for (int rg = 0; rg < 4; ++rg) Ld[(32 + 16 * hf + 4 * lqc + rg) * DN_LSTR + 16 * n2 + l15c] = -R2[n2][rg];
            }
            __syncthreads();
#define DN1_CONV_T(D_) do { \
                const float* Td_ = (const float*)(sL + (D_) * DN_LBYTES); \
                const int tr = tid3 >> 2, cq = tid3 & 3; \
                const float* c1 = sS + ((D_) * 5 + 0) * 64 + 16 * cq; \
                const float* c2 = sS + ((D_) * 5 + 4) * 64 + 16 * cq; \
                const float* trow = Td_ + tr * DN_LSTR + 16 * cq; \
                float tv[16]; \
                _Pragma("unroll") for (int e2 = 0; e2 < 16; ++e2) tv[e2] = trow[e2]; \
                _Pragma("unroll") for (int q = 0; q < 2; ++q) { \
                    u32x4 o1, o2; \
                    _Pragma("unroll") for (int e2 = 0; e2 < 4; ++e2) { \
                        const int i0 = 8 * q + 2 * e2; \
                        o1[e2] = pack_bf2(tv[i0] * c1[i0], tv[i0 + 1] * c1[i0 + 1]); \
                        o2[e2] = pack_bf2(tv[i0] * c2[i0], tv[i0 + 1] * c2[i0 + 1]); \
                    } \
                    *(u32x4*)(sA + lds_off(tr, 2 * cq + q)) = o1; \
                    *(u32x4*)(sKd + lds_off(tr, 2 * cq + q)) = o2; \
                } } while (0)
            DN1_CONV_T(0);
#pragma unroll 1
            for (int d = 0; d < 2; ++d) {
                __syncthreads();
                f32x4 U[4], W[4];
                acc4_zero(U); acc4_zero(W);
                {
#pragma unroll
                    for (int ks = 0; ks < 2; ++ks) {
                        const bf16x8 a1 = *(const bf16x8*)(sA + lds_off(16 * w3 + l15c, ks * 4 + lqc));
                        const bf16x8 a2 = *(const bf16x8*)(sKd + lds_off(16 * w3 + l15c, ks * 4 + lqc));
                        const int r0 = 32 * ks + 8 * lqc + (l15c >> 2);
                        const int p0 = d ? 63 - r0 : r0, p1 = d ? 63 - (r0 + 4) : (r0 + 4);
#pragma unroll
                        for (int nt = 0; nt < 4; ++nt) {
                            const int col = 16 * nt + 4 * (l15c & 3);
                            const s16x4 v0 = ds_tr(sV + el_off(p0, col)), v1 = ds_tr(sV + el_off(p1, col));
                            const s16x4 k0 = ds_tr(sK + el_off(p0, col)), k1 = ds_tr(sK + el_off(p1, col));
                            U[nt] = __builtin_amdgcn_mfma_f32_16x16x32_bf16(a1, __builtin_shufflevector(v0, v1, 0, 1, 2, 3, 4, 5, 6, 7), U[nt], 0, 0, 0);
                            W[nt] = __builtin_amdgcn_mfma_f32_16x16x32_bf16(a2, __builtin_shufflevector(k0, k1, 0, 1, 2, 3, 4, 5, 6, 7), W[nt], 0, 0, 0);
                        }
                    }
                }
                __syncthreads();
                {
                    char* uT = sL + d * DN_LBYTES;
                    char* wT = uT + 8192;
                    const int t0 = 16 * w3 + 4 * lqc;
#pragma unroll
                    for (int nt = 0; nt < 4; ++nt) {
                        uint2 ou, ow;
                        ou.x = pack_bf2(U[nt][0], U[nt][1]); ou.y = pack_bf2(U[nt][2], U[nt][3]);
                        ow.x = pack_bf2(W[nt][0], W[nt][1]); ow.y = pack_bf2(W[nt][2], W[nt][3]);
                        *(uint2*)(uT + el_off(16 * nt + l15c, t0)) = ou;
                        *(uint2*)(wT + el_off(16 * nt + l15c, t0)) = ow;
                    }
                }
                if (d == 0) DN1_CONV_T(1);
            }
#undef DN1_CONV_T
        }
        int tid5 = tid;
        asm volatile("" : "+v"(tid5) :: "memory");
        const int lane5 = tid5 & 63, w5 = __builtin_amdgcn_readfirstlane(tid5 >> 6), l15_5 = lane5 & 15, lq5 = lane5 >> 4;
        f32x4 QK[4];
        acc4_zero(QK);
        mm64(QK, sK, 16 * w5, sQ, l15_5, lq5);
#pragma unroll 1
        for (int d = 0; d < 2; ++d) {
            const float* gcd = sS + (d * 5 + 1) * 64;
            const float* egd = sS + (d * 5 + 2) * 64;
            const float* ekd = sS + (d * 5 + 3) * 64;
            {
                const int tp = tid5 >> 2, cq = tid5 & 3, pos = d ? 63 - tp : tp;
                const float ek = ekd[tp];
#pragma unroll
                for (int q = 0; q < 2; ++q) {
                    const u32x4 kw = *(const u32x4*)(sK + lds_off(pos, 2 * cq + q));
                    u32x4 o;
#pragma unroll
                    for (int e = 0; e < 4; ++e) o[e] = pack_bf2(__uint_as_float(kw[e] << 16) * ek, __uint_as_float(kw[e] & 0xffff0000u) * ek);
                    *(u32x4*)(sKd + lds_off(tp, 2 * cq + q)) = o;
                }
            }
            {
                const int s0 = 16 * w5 + 4 * lq5;
                const int sp0 = d ? 60 - s0 : s0;
                const f32x4 gsp = *(const f32x4*)(gcd + sp0);
#pragma unroll
                for (int nt = 0; nt < 4; ++nt) {
                    const int t = 16 * nt + l15_5, tp = d ? 63 - t : t;
                    const float gt = gcd[tp];
                    float v[4];
#pragma unroll
                    for (int k = 0; k < 4; ++k) {
                        const float qk = d ? QK[nt][3 - k] : QK[nt][k];
                        v[k] = (sp0 + k <= tp) ? qk * __expf(gt - gsp[k]) : 0.f;
                    }
                    uint2 o; o.x = pack_bf2(v[0], v[1]); o.y = pack_bf2(v[2], v[3]);
                    *(uint2*)(sA + el_off(tp, sp0)) = o;
                }
            }
            __syncthreads();
            const char* uT = sL + d * DN_LBYTES;
            const char* wT = uT + 8192;
            const int cd = (d == 0) ? pb : (pb < 4 ? 3 - pb : 39 - pb);
            bf16_t* Mg = p.MH() + ((size_t)((bh * 2 + d) * 36 + cd) * 2) * 4096;
            bf16_t* Hg = Mg + 4096;
            {
                f32x4 MT[4];
                acc4_zero(MT);
#pragma unroll
                for (int ks = 0; ks < 2; ++ks) {
                    const bf16x8 a = *(const bf16x8*)(wT + lds_off(16 * w5 + l15_5, ks * 4 + lq5));
#pragma unroll
                    for (int nt = 0; nt < 4; ++nt) MT[nt] = __builtin_amdgcn_mfma_f32_16x16x32_bf16(a, frag_tr(sKd, ks, nt, l15_5, lq5), MT[nt], 0, 0, 0);
                }
                const float egl = egd[63];
                const int j0 = 16 * w5 + 4 * lq5;
#pragma unroll
                for (int nt = 0; nt < 4; ++nt) {
                    const int i = 16 * nt + l15_5;
                    f32x4 o;
#pragma unroll
                    for (int e = 0; e < 4; ++e) o[e] = ((i == j0 + e) ? egl : 0.f) - MT[nt][e];
                    st_bf4(Mg + CHOP_OFF(w5, nt, lane5), o);
                }
            }
            {
                f32x4 HH[4];
                acc4_zero(HH);
#pragma unroll
                for (int ks = 0; ks < 2; ++ks) {
                    const bf16x8 a = frag_tr(sKd, ks, w5, l15_5, lq5);
#pragma unroll
                    for (int nt = 0; nt < 4; ++nt) HH[nt] = __builtin_amdgcn_mfma_f32_16x16x32_bf16(a, *(const bf16x8*)(uT + lds_off(16 * nt + l15_5, ks * 4 + lq5)), HH[nt], 0, 0, 0);
                }
                const int i0 = 16 * w5 + 4 * lq5;
#pragma unroll
                for (int nt = 0; nt < 4; ++nt) st_bf4(Hg + CHOP_OFF(w5, nt, lane5), HH[nt]);
            }
            if (lat) {
                bf16_t* Eg = p.EF() + ((size_t)((bh * 2 + d) * 32 + (pb - 4)) * 2) * 4096;
                bf16_t* Fg = Eg + 4096;
                {
                    f32x4 ET[4];
                    acc4_zero(ET);
                    mm64(ET, wT, 16 * w5, sA, l15_5, lq5);
                    const int j0 = 16 * w5 + 4 * lq5;
#pragma unroll
                    for (int nt = 0; nt < 4; ++nt) {
                        const int sp = 16 * nt + l15_5, spos = d ? 63 - sp : sp;
                        const f32x4 qv = ld_bf4((const bf16_t*)(sQ + el_off(spos, j0)));
                        const float eg = egd[sp];
                        f32x4 o;
#pragma unroll
                        for (int e = 0; e < 4; ++e) o[e] = qv[e] * eg - ET[nt][e];
                        st_bf4(Eg + CHOP_OFF(w5, nt, lane5), o);
                    }
                }
                {
                    f32x4 FF[4];
                    acc4_zero(FF);
                    mm64(FF, uT, 16 * w5, sA, l15_5, lq5);
                    const int c0 = 16 * w5 + 4 * lq5;
#pragma unroll
                    for (int nt = 0; nt < 4; ++nt) {
                        const int sp = 16 * nt + l15_5, spos = d ? 63 - sp : sp;
                        st_bf4(Fg + CHOP_OFF(w5, nt, lane5), FF[nt]);
                    }
                }
            }
            __syncthreads();
        }
    }
}

struct Dn2Frag { bf16x8 am[2]; uint2 hr; };
__device__ __forceinline__ void dn2_load(Dn2Frag& f, const bf16_t* Mg, int w, int l15, int lq, int i0, int hf, int n2) {
#pragma unroll
    for (int ks = 0; ks < 2; ++ks) {
        const uint2 lo = *(const uint2*)(Mg + CHOP_OFF(2 * ks + (lq >> 1), w, ((lq & 1) * 2) * 16 + l15));
        const uint2 hi = *(const uint2*)(Mg + CHOP_OFF(2 * ks + (lq >> 1), w, ((lq & 1) * 2 + 1) * 16 + l15));
        f.am[ks] = __builtin_bit_cast(bf16x8, (u32x4){lo.x, lo.y, hi.x, hi.y});
    }
    f.hr = *(const uint2*)(Mg + 4096 + CHOP_OFF(w, 2 * hf + n2, lq * 16 + l15));
}
__device__ __forceinline__ void dn2_step(const Dn2Frag& f, int c, int d, int hf, int n2, bf16_t* STc, char* smem, int l15, int lq, int i0) {
    const char* sS = smem + (c & 1) * 4096;
    char* sN = smem + ((c + 1) & 1) * 4096;
    f32x4 acc = (f32x4){__uint_as_float(f.hr.x << 16), __uint_as_float(f.hr.x & 0xffff0000u), __uint_as_float(f.hr.y << 16), __uint_as_float(f.hr.y & 0xffff0000u)};
#pragma unroll
    for (int ks = 0; ks < 2; ++ks) {
        const bf16x8 bs = *(const bf16x8*)(sS + lds_off(16 * n2 + l15, ks * 4 + lq));
        acc = __builtin_amdgcn_mfma_f32_16x16x32_bf16(f.am[ks], bs, acc, 0, 0, 0);
    }
    const int cn = c + 1;
    const bool st = (cn >= 4 && cn <= 35);
    const int pbi = (d == 0 ? cn : 39 - cn) - 4;
    uint2 o; o.x = pack_bf2(acc[0], acc[1]); o.y = pack_bf2(acc[2], acc[3]);
    const int cl = 16 * n2 + l15;
    *(uint2*)(sN + el_off(cl, i0)) = o;
    if (st) *(uint2*)(STc + (size_t)pbi * 4096 + ((i0 >> 4) * 64 + 32 * hf + cl) * 16 + (i0 & 15)) = o;
    __syncthreads();
}
__device__ __forceinline__ void ph_dn2(const Params& p, char* smem, const int pb) {
    const int tid = threadIdx.x, lane = tid & 63, w8 = tid >> 6, w = w8 & 3, n2 = w8 >> 2, l15 = lane & 15, lq = lane >> 4;
    const int x = pb & 7, j = pb >> 3;
    const int chain = (j >> 1) * 8 + x, hf = j & 1, d = chain & 1;
    const bf16_t* MHc = p.MH() + (size_t)chain * 36 * 2 * 4096;
    bf16_t* STc = p.ST() + (size_t)chain * 32 * 4096;
    if (tid < 256) *(u32x4*)(smem + tid * 16) = (u32x4){0u, 0u, 0u, 0u};
    __syncthreads();
    const int i0 = 16 * w + 4 * lq;
    Dn2Frag f0, f1, f2, f3;
    dn2_load(f0, MHc + (size_t)0 * 8192, w, l15, lq, i0, hf, n2);
    dn2_load(f1, MHc + (size_t)1 * 8192, w, l15, lq, i0, hf, n2);
    dn2_load(f2, MHc + (size_t)2 * 8192, w, l15, lq, i0, hf, n2);
    dn2_load(f3, MHc + (size_t)3 * 8192, w, l15, lq, i0, hf, n2);
    for (int c0 = 0; c0 < 36; c0 += 4) {
        const bool more = (c0 + 4 < 36);
        dn2_step(f0, c0 + 0, d, hf, n2, STc, smem, l15, lq, i0);
        if (more) dn2_load(f0, MHc + (size_t)(c0 + 4) * 8192, w, l15, lq, i0, hf, n2);
        dn2_step(f1, c0 + 1, d, hf, n2, STc, smem, l15, lq, i0);
        if (more) dn2_load(f1, MHc + (size_t)(c0 + 5) * 8192, w, l15, lq, i0, hf, n2);
        dn2_step(f2, c0 + 2, d, hf, n2, STc, smem, l15, lq, i0);
        if (more) dn2_load(f2, MHc + (size_t)(c0 + 6) * 8192, w, l15, lq, i0, hf, n2);
        dn2_step(f3, c0 + 3, d, hf, n2, STc, smem, l15, lq, i0);
        if (more) dn2_load(f3, MHc + (size_t)(c0 + 7) * 8192, w, l15, lq, i0, hf, n2);
    }
}

__device__ __forceinline__ void ph_dn3(const Params& p, int bid, int nb, char* smem) {
    const int tid = VTID, lane = tid & 63, w = __builtin_amdgcn_readfirstlane(tid >> 6), l15 = lane & 15, lq = lane >> 4;
    const int srow = tid >> 3, sch = (tid & 7) ^ ((srow >> 1) & 7);
    LAS char* lbase = (LAS char*)smem + w * 1024;
#define DN3_STAGE(BUF, U_) do { const int bh_ = (U_) >> 5, pbi_ = (U_) & 31; \
        _Pragma("unroll") for (int d_ = 0; d_ < 2; ++d_) { \
            const bf16_t* Sg_ = p.ST() + ((size_t)(bh_ * 2 + d_) * 32 + pbi_) * 4096 + ((sch >> 1) * 64 + srow) * 16 + (sch & 1) * 8;     \
            _Pragma("unroll") for (int i_ = 0; i_ < 2; ++i_) \
                __builtin_amdgcn_global_load_lds((const void*)(Sg_ + (size_t)(32 * i_) * 16), (LAS void*)(lbase + (BUF) * 16384 + d_ * 8192 + i_ * 4096), 16, 0, 0); } } while (0)
    uint2 zrA[4], frA[2][4], zrB[4], frB[2][4]; bf16x8 beA[2][2], beB[2][2];
#define DN3_FETCH(ZR, FR, BE, U_) do { const int bh_ = (U_) >> 5, pbi_ = (U_) & 31, s_ = 16 * w + l15; \
        const size_t rl_ = (size_t)(bh_ >> 3) * SEQ + pbi_ * 64 + s_; \
        _Pragma("unroll") for (int mt = 0; mt < 4; ++mt) ZR[mt] = *(const uint2*)(p.Pz() + rl_ * PZ_W + 512 + (bh_ & 7) * 64 + 16 * mt + 4 * lq); \
        _Pragma("unroll") for (int d = 0; d < 2; ++d) { \
            const bf16_t* Eg_ = p.EF() + ((size_t)((bh_ * 2 + d) * 32 + pbi_) * 2) * 4096; \
            const int sp_ = d ? 63 - s_ : s_;          \
            _Pragma("unroll") for (int mt = 0; mt < 4; ++mt) FR[d][mt] = *(const uint2*)(Eg_ + 4096 + CHOP_OFF(mt, sp_ >> 4, lq * 16 + (sp_ & 15))); \
            _Pragma("unroll") for (int ks = 0; ks < 2; ++ks) { \
                const uint2 lo_ = *(const uint2*)(Eg_ + CHOP_OFF(2 * ks + (lq >> 1), sp_ >> 4, ((lq & 1) * 2) * 16 + (sp_ & 15))); \
                const uint2 hi_ = *(const uint2*)(Eg_ + CHOP_OFF(2 * ks + (lq >> 1), sp_ >> 4, ((lq & 1) * 2 + 1) * 16 + (sp_ & 15))); \
                BE[d][ks] = __builtin_bit_cast(bf16x8, (u32x4){lo_.x, lo_.y, hi_.x, hi_.y}); } } } while (0)
#define DN3_BF4(R_) ((f32x4){__uint_as_float((R_).x << 16), __uint_as_float((R_).x & 0xffff0000u), __uint_as_float((R_).y << 16), __uint_as_float((R_).y & 0xffff0000u)})
#define DN3_BODY(ZR, FR, BE, U_, BUF) do { const int u_ = (U_); \
        const int bh = u_ >> 5, pbi = u_ & 31, b = bh >> 3, h = bh & 7; \
        const int s = 16 * w + l15; \
        const size_t rl = (size_t)b * SEQ + pbi * 64 + s; \
        f32x4 acc[4]; \
        _Pragma("unroll") for (int mt = 0; mt < 4; ++mt) acc[mt] = DN3_BF4(FR[0][mt]) + DN3_BF4(FR[1][mt]); \
        _Pragma("unroll") for (int d = 0; d < 2; ++d) { \
            const char* sS = smem + (BUF) * 16384 + d * 8192; \
            _Pragma("unroll") for (int ks = 0; ks < 2; ++ks) \
                _Pragma("unroll") for (int mt = 0; mt < 4; ++mt) { \
                    const bf16x8 as = *(const bf16x8*)(sS + lds_off(16 * mt + l15, ks * 4 + lq)); \
                    acc[mt] = __builtin_amdgcn_mfma_f32_16x16x32_bf16(as, BE[d][ks], acc[mt], 0, 0, 0); \
                } \
        } \
        float ss = 0.f; \
        _Pragma("unroll") for (int mt = 0; mt < 4; ++mt) \
            _Pragma("unroll") for (int rg = 0; rg < 4; ++rg) ss += acc[mt][rg] * acc[mt][rg]; \
        ss = xrow_sum(ss); \
        const float rstd = rsqrtf(ss * (1.f / 64.f) + EPSF); \
        _Pragma("unroll") for (int mt = 0; mt < 4; ++mt) { \
            const f32x4 nw = *(const f32x4*)(p.dn_norm_w + 16 * mt + 4 * lq); \
            const f32x4 zdv = DN3_BF4(ZR[mt]); \
            f32x4 o; \
            _Pragma("unroll") for (int rg = 0; rg < 4; ++rg) o[rg] = acc[mt][rg] * rstd * nw[rg] * silu_f(zdv[rg]); \
            st_bf4(p.A_dn() + rl * 512 + h * 64 + 16 * mt + 4 * lq, o); \
        } } while (0)
    const int NU = 64 * 32;
    int u = bid;
    if (u < NU) { DN3_STAGE(0, u); DN3_FETCH(zrA, frA, beA, u); }
    for (; u < NU; u += 2 * nb) {
        const bool m1 = (u + nb < NU), m2 = (u + 2 * nb < NU);
        __syncthreads();
        if (m1) { DN3_STAGE(1, u + nb); DN3_FETCH(zrB, frB, beB, u + nb); }
        DN3_BODY(zrA, frA, beA, u, 0);
        if (m1) {
            __syncthreads();
            if (m2) { DN3_STAGE(0, u + 2 * nb); DN3_FETCH(zrA, frA, beA, u + 2 * nb); }
            DN3_BODY(zrB, frB, beB, u + nb, 1);
        }
    }
#undef DN3_FETCH
#undef DN3_BF4
#undef DN3_BODY
#undef DN3_STAGE
    __syncthreads();
}

template <int LDC, class AccT>
__device__ __forceinline__ void epi_store_quad(const AccT& acc, bf16_t* O, int row_base, int col_base, int ai, int bj, int wr, int wc) {
    int t = threadIdx.x; asm volatile("" : "+v"(t));
    const int fr = t & 15, fq = (t >> 4) & 3;
    bf16_t* qp = O + (size_t)(row_base + wr * 64 + fr + ai * 128) * LDC + col_base + wc * 32 + 8 * fq + bj * 128;
#pragma unroll
    for (int m = 0; m < 4; ++m) {
        const f32x4 v0 = acc[ai][bj][m][0], v1 = acc[ai][bj][m][1];
        u32x4 w; w[0] = pack_bf2(v0[0], v0[1]); w[1] = pack_bf2(v0[2], v0[3]); w[2] = pack_bf2(v1[0], v1[1]); w[3] = pack_bf2(v1[2], v1[3]);
        *(u32x4*)(qp + (size_t)(m * 16) * LDC) = w;
    }
}
template <int LDC, class AccT>
__device__ __forceinline__ void epi_store_lines(const AccT& acc, bf16_t* O, int row_base, int col_base, int ai, int M0, int M1, int wr, int wc) {
    int t = threadIdx.x; asm volatile("" : "+v"(t));
    const int fr = t & 15, fq = (t >> 4) & 3, odd = fr & 1;
    bf16_t* p1 = O + (size_t)(row_base + 128 * ai + 64 * wr + (fr & ~1)) * LDC + col_base + 64 * wc + 32 * odd + 8 * fq;
    bf16_t* p2 = p1 + LDC;
#pragma unroll
    for (int m = 0; m < 4; ++m) {
        if (m < M0 || m >= M1) continue;
        u32x4 P0, P1, X, Y;
        { const f32x4 v0 = acc[ai][0][m][0], v1 = acc[ai][0][m][1]; P0[0] = pack_bf2(v0[0], v0[1]); P0[1] = pack_bf2(v0[2], v0[3]); P0[2] = pack_bf2(v1[0], v1[1]); P0[3] = pack_bf2(v1[2], v1[3]); }
        { const f32x4 v0 = acc[ai][1][m][0], v1 = acc[ai][1][m][1]; P1[0] = pack_bf2(v0[0], v0[1]); P1[1] = pack_bf2(v0[2], v0[3]); P1[2] = pack_bf2(v1[0], v1[1]); P1[3] = pack_bf2(v1[2], v1[3]); }
#pragma unroll
        for (int k = 0; k < 4; ++k) { X[k] = odd ? P0[k] : P1[k]; Y[k] = (unsigned)__builtin_amdgcn_update_dpp(0, (int)X[k], 0xB1, 0xF, 0xF, true); }
        u32x4 S1, S2;
#pragma unroll
        for (int k = 0; k < 4; ++k) { S1[k] = odd ? Y[k] : P0[k]; S2[k] = odd ? P1[k] : Y[k]; }
        *(u32x4*)(p1 + (size_t)(m * 16) * LDC) = S1;
        *(u32x4*)(p2 + (size_t)(m * 16) * LDC) = S2;
    }
}
namespace g8 {
constexpr int BM = 256, BK = 64, HALF = 128, HTB = HALF * BK * 2, STAGE_BYTES = 8 * HTB;
__device__ __forceinline__ int lds_byte(int r, int c) { const int st = (r >> 4) * 2 + (c >> 5), rr = r & 15, cc = c & 31, ob = rr * 64 + cc * 2; return st * 1024 + (ob ^ (((ob >> 9) & 1) << 5)); }
__device__ __forceinline__ void stage_rc(int b, int& R, int& C) { const int st = b / 1024, sb = b % 1024, swz = sb ^ (((sb >> 9) & 1) << 5); R = (st >> 1) * 16 + swz / 64; C = (st & 1) * 32 + (swz % 64) / 2; }
__device__ __forceinline__ int perm32(int rho) { const int n = rho >> 4, i = rho & 15; return 8 * (i >> 2) + 4 * n + (i & 3); }
struct Unit { int pm, pn, sel; };
typedef f32x4 Acc[2][2][4][2];

template <class Epi, class Sched>
__device__ __forceinline__ void gemm_phase(LAS unsigned char* lds, const bf16_t* A, const bf16_t* A1, int lda, const bf16_t* Bt, int K, const Sched& S, const Epi& E) {
    int tid = threadIdx.x;
    asm volatile("" : "+v"(tid));
    const int wid = __builtin_amdgcn_readfirstlane(tid >> 6), lane = tid & 63, wr = wid >> 2, wc = wid & 3, fr = lane & 15, fq = lane >> 4;
    const int nt = K / BK;
    unsigned voffA[2], voffB[2];
#pragma unroll
    for (int i = 0; i < 2; ++i) { int R, C; stage_rc(tid * 16 + i * 8192, R, C); const int Rb = Epi::GPAIR ? (32 * (R >> 5) + perm32(R & 31)) : Epi::LINE ? (64 * (R >> 5) + perm32(R & 31)) : Epi::PERM ? ((R & ~31) + perm32(R & 31)) : R;
        voffA[i] = (unsigned)(R * lda + C) * 2u; voffB[i] = (unsigned)(Rb * K + C) * 2u; }
    const size_t kstep = (size_t)(BK * 2);
    const size_t hstepA = (size_t)HALF * lda * 2, hstepB = (size_t)(Epi::GPAIR ? 1024 : Epi::LINE ? 32 : HALF) * K * 2;
    const size_t tstepA = 2 * hstepA, tstepB = (size_t)(Epi::GPAIR ? 128 : BM) * K * 2;
    const unsigned ldsw = (unsigned)wid * 1024u;
    const int aoff = lds_byte(wr * 64 + fr, fq * 8), boff = lds_byte(wc * 32 + fr, fq * 8);
#define G8_SA(b, h) (((b) * 2 + (h)) * HTB)
#define G8_SB(b, h) ((4 + (b) * 2 + (h)) * HTB)
#define G8_STAGE(bufoff, gbase, voff) do { _Pragma("unroll") for (int _i = 0; _i < 2; ++_i) \
        __builtin_amdgcn_global_load_lds((const unsigned*)((const char*)(gbase) + (voff)[_i]), (LAS unsigned*)(lds + (bufoff) + ldsw + _i * 8192), 16, 0, 0); } while (0)
#define G8_LDA(dst, b, h) do { _Pragma("unroll") for (int m = 0; m < 4; ++m) _Pragma("unroll") for (int k = 0; k < 2; ++k) dst[m][k] = *(const LAS bf16x8*)(lds + G8_SA(b, h) + aoff + m * 2048 + k * 1024); } while (0)
#define G8_LDB(dst, b, h) do { _Pragma("unroll") for (int n = 0; n < 2; ++n) _Pragma("unroll") for (int k = 0; k < 2; ++k) dst[n][k] = *(const LAS bf16x8*)(lds + G8_SB(b, h) + boff + n * 2048 + k * 1024); } while (0)
#define G8_MMA(ai, bj, At, Bt_) do { __builtin_amdgcn_s_setprio(1); _Pragma("unroll") for (int m = 0; m < 4; ++m) _Pragma("unroll") for (int n = 0; n < 2; ++n) _Pragma("unroll") for (int k = 0; k < 2; ++k) \
        acc[ai][bj][m][n] = __builtin_amdgcn_mfma_f32_16x16x32_bf16(Bt_[n][k], At[m][k], acc[ai][bj][m][n], 0, 0, 0); __builtin_amdgcn_s_setprio(0); } while (0)
#define G8_WAIT_V(n) asm volatile("s_waitcnt vmcnt(" #n ")" ::: "memory")
#define G8_WAIT_L(n) asm volatile("s_waitcnt lgkmcnt(" #n ")" ::: "memory")
#define G8_BAR __builtin_amdgcn_s_barrier()
#define G8_SCHED __builtin_amdgcn_sched_barrier(0)
    Unit cur, nxt; int ui = 0;
    if (!S.next(0, cur)) return;
    Acc acc;
#pragma unroll
    for (int a = 0; a < 2; ++a)
#pragma unroll
        for (int b = 0; b < 2; ++b)
#pragma unroll
            for (int m = 0; m < 4; ++m)
#pragma unroll
                for (int n = 0; n < 2; ++n) acc[a][b][m][n] = (f32x4){0.f, 0.f, 0.f, 0.f};
    bf16x8 At[4][2], B0[2][2], B1[2][2];
    const char* cA = (const char*)(cur.sel ? A1 : A) + (size_t)cur.pm * tstepA; const char* cB = (const char*)Bt + (size_t)cur.pn * tstepB;
    G8_STAGE(G8_SB(0, 0), cB, voffB); G8_STAGE(G8_SA(0, 0), cA, voffA); G8_STAGE(G8_SB(0, 1), cB + hstepB, voffB); G8_STAGE(G8_SA(0, 1), cA + hstepA, voffA);
    if (wr == 1) G8_BAR;
    G8_WAIT_V(4); G8_BAR;
    G8_STAGE(G8_SB(1, 0), cB + kstep, voffB); G8_STAGE(G8_SA(1, 0), cA + kstep, voffA); G8_STAGE(G8_SB(1, 1), cB + hstepB + kstep, voffB);
    G8_WAIT_V(6); G8_BAR;
    for (;;) {
        const bool has_next = S.next(ui + 1, nxt);
        const char* nA = has_next ? (const char*)(nxt.sel ? A1 : A) + (size_t)nxt.pm * tstepA : cA; const char* nB = has_next ? (const char*)Bt + (size_t)nxt.pn * tstepB : cB;
        for (int t = 0; t < nt; t += 2) {
            const bool last = (t == nt - 2);
            const char* a1 = cA + (size_t)(t + 1) * kstep;
            const char* a2 = last ? nA : cA + (size_t)(t + 2) * kstep; const char* b2 = last ? nB : cB + (size_t)(t + 2) * kstep;
            const char* a3 = a2 + kstep; const char* b3 = b2 + kstep;
            G8_LDB(B0, 0, 0); G8_SCHED; G8_LDA(At, 0, 0); G8_STAGE(G8_SA(1, 1), a1 + hstepA, voffA);
            G8_WAIT_L(8); G8_BAR; G8_WAIT_L(0); G8_MMA(0, 0, At, B0); G8_BAR; G8_SCHED;
            G8_LDB(B1, 0, 1); G8_STAGE(G8_SB(0, 0), b2, voffB);
            G8_BAR; G8_WAIT_L(0); G8_MMA(0, 1, At, B1); G8_BAR;
            G8_LDA(At, 0, 1); G8_STAGE(G8_SA(0, 0), a2, voffA);
            G8_BAR; G8_WAIT_L(0); G8_MMA(1, 0, At, B0); G8_BAR; G8_SCHED;
            G8_STAGE(G8_SB(0, 1), b2 + hstepB, voffB);
            G8_WAIT_V(6); G8_BAR; G8_MMA(1, 1, At, B1); G8_BAR;
            G8_LDB(B0, 1, 0); G8_SCHED; G8_LDA(At, 1, 0); G8_STAGE(G8_SA(0, 1), a2 + hstepA, voffA);
            G8_WAIT_L(8); G8_BAR; G8_WAIT_L(0); G8_MMA(0, 0, At, B0); G8_BAR; G8_SCHED;
            G8_LDB(B1, 1, 1); G8_STAGE(G8_SB(1, 0), b3, voffB);
            G8_BAR; G8_WAIT_L(0); G8_MMA(0, 1, At, B1);
            if constexpr (Epi::QUAD) { if (last) E.quad(acc, cur, 0, 0, wr, wc); }
            G8_BAR;
            G8_LDA(At, 1, 1); G8_STAGE(G8_SA(1, 0), a3, voffA);
            G8_BAR; G8_WAIT_L(0); G8_MMA(1, 0, At, B0);
            if constexpr (Epi::QUAD) { if (last) E.quad(acc, cur, 0, 1, wr, wc); }
            if constexpr (Epi::HALFEPI) { if (last) E.half(acc, cur, 0, 0, 2, wr, wc); }
            G8_BAR; G8_SCHED;
            G8_STAGE(G8_SB(1, 1), b3 + hstepB, voffB);
            if (Epi::QUAD && last) { G8_WAIT_V(14); } else if (Epi::HALFEPI && last) { G8_WAIT_V(10); } else { G8_WAIT_V(6); }
            G8_BAR; G8_MMA(1, 1, At, B1);
            if constexpr (Epi::QUAD) { if (last) E.quad(acc, cur, 1, 0, wr, wc); }
            if constexpr (Epi::HALFEPI) { if (last) E.half(acc, cur, 0, 2, 4, wr, wc); }
            G8_BAR;
        }
        bool keep = false;
        if constexpr (Epi::QUAD) E.quad(acc, cur, 1, 1, wr, wc);
        else if constexpr (Epi::HALFEPI) E.half(acc, cur, 1, 0, 4, wr, wc);
        else keep = E(acc, cur, wr, wc, fr, fq);
        if (!has_next) break;
        if (!keep) {
#pragma unroll
            for (int a = 0; a < 2; ++a)
#pragma unroll
                for (int b = 0; b < 2; ++b)
#pragma unroll
                    for (int m = 0; m < 4; ++m)
#pragma unroll
                        for (int n = 0; n < 2; ++n) acc[a][b][m][n] = (f32x4){0.f, 0.f, 0.f, 0.f};
        }
        cur = nxt; cA = nA; cB = nB; ++ui;
    }
    G8_WAIT_V(0);
    if (wr == 0) G8_BAR;
    G8_BAR;
#undef G8_SA
#undef G8_SB
#undef G8_STAGE
#undef G8_LDA
#undef G8_LDB
#undef G8_MMA
#undef G8_WAIT_V
#undef G8_WAIT_L
#undef G8_BAR
#undef G8_SCHED
}

struct StaticOrder {
    int nM, nN, nwg, G, c;
    __device__ __forceinline__ void init(int M, int N, int G_, int c_) { nM = M / BM; nN = N / BM; nwg = nM * nN; G = G_; c = c_; }
    __device__ __forceinline__ bool next(int i, Unit& u) const {
        const int L = i * G + c; if (L >= nwg) return false;
        int wgid = L; { const int q = nwg / 8, r = nwg % 8, xcd = wgid % 8, off = wgid / 8; wgid = (xcd < r ? xcd * (q + 1) : r * (q + 1) + (xcd - r) * q) + off; }
        const int nig = 8 * nN, gid = wgid / nig, fm = gid * 8, gsz = (nM - fm) < 8 ? (nM - fm) : 8;
        u.pm = fm + ((wgid % nig) % gsz); u.pn = (wgid % nig) / gsz; u.sel = 0; return true;
    }
};
struct EpiStoreBf16 {
    static constexpr bool PERM = true, QUAD = false, LINE = true, GPAIR = false, HALFEPI = true;
    __device__ __forceinline__ void half(const Acc& acc, const Unit& u, int ai, int m0, int m1, int wr, int wc) const {
        epi_store_lines<PG_W>(acc, O, u.pm * BM, u.pn * BM, ai, m0, m1, wr, wc);
    }
    bf16_t* O; int ldc;
    __device__ __forceinline__ void quad(const Acc& acc, const Unit& u, int ai, int bj, int wr, int wc) const {
        epi_store_quad<PG_W>(acc, O, u.pm * BM, u.pn * BM, ai, bj, wr, wc);
    }
    __device__ __forceinline__ bool operator()(Acc& acc, const Unit& u, int wr, int wc, int fr, int fq) const {
        const int row0 = u.pm * BM + wr * 64 + fr, col0 = u.pn * BM + wc * 32 + 8 * fq;
#pragma unroll
        for (int ai = 0; ai < 2; ++ai)
#pragma unroll
            for (int m = 0; m < 4; ++m) { bf16_t* rowp = O + (size_t)(row0 + ai * HALF + m * 16) * ldc + col0;
#pragma unroll
                for (int bj = 0; bj < 2; ++bj) { const f32x4 v0 = acc[ai][bj][m][0], v1 = acc[ai][bj][m][1];
                    u32x4 w; w[0] = pack_bf2(v0[0], v0[1]); w[1] = pack_bf2(v0[2], v0[3]); w[2] = pack_bf2(v1[0], v1[1]); w[3] = pack_bf2(v1[2], v1[3]);
                    *(u32x4*)(rowp + bj * HALF) = w; } }
        return false;
    }
};
}


struct EpiGates {
    static constexpr bool PERM = true, QUAD = false, LINE = false, GPAIR = true, HALFEPI = true;
    bf16_t* Pg;
    __device__ __forceinline__ void half(const g8::Acc& acc, const g8::Unit& u, int ai, int M0, int M1, int wr, int wc) const {
        int t = threadIdx.x; asm volatile("" : "+v"(t));
        const int fr = t & 15, fq = (t >> 4) & 3;
        bf16_t* qp = Pg + (size_t)(u.pm * 256 + 128 * ai + 64 * wr + fr) * PG_W + u.pn * 128 + wc * 32 + 8 * fq;
#pragma unroll
        for (int m = 0; m < 4; ++m) {
            if (m < M0 || m >= M1) continue;
            float rr[8], ss[8];
#pragma unroll
            for (int n = 0; n < 2; ++n)
#pragma unroll
                for (int e = 0; e < 4; ++e) {
                    const float e1 = __expf(-acc[ai][0][m][n][e]), e2 = __expf(-fmaxf(acc[ai][1][m][n][e], -30.f));
                    ss[4 * n + e] = __builtin_amdgcn_rcpf(1.f + e2);
                    rr[4 * n + e] = (1.f + e2) * __builtin_amdgcn_rcpf(1.f + e1);
                }
            u32x4 wr_, ws_;
#pragma unroll
            for (int k = 0; k < 4; ++k) { wr_[k] = pack_bf2(rr[2 * k], rr[2 * k + 1]); ws_[k] = pack_bf2(ss[2 * k], ss[2 * k + 1]); }
            *(u32x4*)(qp + (size_t)(m * 16) * PG_W) = wr_;
            *(u32x4*)(qp + (size_t)(m * 16) * PG_W + 1024) = ws_;
        }
    }
    __device__ __forceinline__ bool operator()(g8::Acc&, const g8::Unit&, int, int, int, int) const { return false; }
};
__device__ __forceinline__ void ph_gates(const Params& p, char* smem_all, const int pb) {
    g8::StaticOrder so; so.init(NL, PG_W, gridDim.x, pb);
    EpiGates ep; ep.Pg = p.Pg();
    g8::gemm_phase((LAS unsigned char*)smem_all, p.h() + (size_t)NCTX * DM, nullptr, DM, p.Wt_g(), 1024, so, ep);
}

struct InprojOrder {
    int c;
    __device__ __forceinline__ bool next(int i, g8::Unit& u) const {
        const int x = c & 7, off = i * 32 + (c >> 3);
        if (off >= 96) return false;
        if (off < 88) { u.pm = 8 + 8 * x + (off & 7); u.pn = off >> 3; }
        else { u.pm = x; u.pn = 1 + (off - 88); }
        u.sel = 0; return true;
    }
};
struct ZdOrder {
    int c;
    __device__ __forceinline__ bool next(int i, g8::Unit& u) const {
        const int idx = (c >> 3) - 16;
        if (i > 0 || idx < 0) return false;
        u.pm = 8 + 8 * (c & 7) + (idx & 7); u.pn = 11 + (idx >> 3); u.sel = 0; return true;
    }
};
template <int LDC>
__device__ __forceinline__ void epi_store_tile(const g8::Acc& acc, bf16_t* O, int row0, int col0) {
#pragma unroll
    for (int ai = 0; ai < 2; ++ai)
#pragma unroll
        for (int m = 0; m < 4; ++m) { bf16_t* rowp = O + (size_t)(row0 + ai * 128 + m * 16) * LDC + col0;
#pragma unroll
            for (int bj = 0; bj < 2; ++bj) { const f32x4 v0 = acc[ai][bj][m][0], v1 = acc[ai][bj][m][1];
                u32x4 w; w[0] = pack_bf2(v0[0], v0[1]); w[1] = pack_bf2(v0[2], v0[3]); w[2] = pack_bf2(v1[0], v1[1]); w[3] = pack_bf2(v1[2], v1[3]);
                *(u32x4*)(rowp + bj * 128) = w; } }
}
struct EpiInproj {
    static constexpr bool PERM = true, QUAD = false, LINE = true, GPAIR = false, HALFEPI = true;
    __device__ __forceinline__ void half(const g8::Acc& acc, const g8::Unit& u, int ai, int m0, int m1, int wr, int wc) const {
        if (u.pn < 9) epi_store_lines<PA_W>(acc, Pa, u.pm * 256, u.pn * 256, ai, m0, m1, wr, wc);
        else epi_store_lines<PZ_W>(acc, Pz, u.pm * 256 - NCTX, (u.pn - 9) * 256, ai, m0, m1, wr, wc);
    }
    bf16_t* Pa; bf16_t* Pz;
    __device__ __forceinline__ void quad(const g8::Acc& acc, const g8::Unit& u, int ai, int bj, int wr, int wc) const {
        if (u.pn < 9) epi_store_quad<PA_W>(acc, Pa, u.pm * 256, u.pn * 256, ai, bj, wr, wc);
        else epi_store_quad<PZ_W>(acc, Pz, u.pm * 256 - NCTX, (u.pn - 9) * 256, ai, bj, wr, wc);
    }
    __device__ __forceinline__ bool operator()(g8::Acc& acc, const g8::Unit& u, int wr, int wc, int, int) const {
        int t = threadIdx.x; asm volatile("" : "+v"(t));
        const int fr = t & 15, fq = (t >> 4) & 3;
        if (u.pn < 9) epi_store_tile<PA_W>(acc, Pa, u.pm * 256 + wr * 64 + fr, u.pn * 256 + wc * 32 + 8 * fq);
        else epi_store_tile<PZ_W>(acc, Pz, u.pm * 256 - NCTX + wr * 64 + fr, (u.pn - 9) * 256 + wc * 32 + 8 * fq);
        return false;
    }
};
__device__ __forceinline__ void ph_zd8(const Params& p, char* smem_all, const int pb) {
    ZdOrder so; so.c = pb;
    EpiInproj ep; ep.Pa = p.Pa(); ep.Pz = p.Pz();
    g8::gemm_phase((LAS unsigned char*)smem_all, p.h(), nullptr, DM, p.Wt_a(), 1024, so, ep);
}
__device__ __forceinline__ void ph_inproj8(const Params& p, char* smem_all, const int pb) {
    InprojOrder so; so.c = pb;
    EpiInproj ep; ep.Pa = p.Pa(); ep.Pz = p.Pz();
    g8::gemm_phase((LAS unsigned char*)smem_all, p.h(), nullptr, DM, p.Wt_a(), 1024, so, ep);
}

struct MergeOrder {
    g8::StaticOrder so;
    __device__ __forceinline__ bool next(int i, g8::Unit& u) const {
        if (i >= 2) return false;
        const bool ok = so.next(0, u); u.sel = i; u.pn += 4 * i; return ok;
    }
};
struct EpiMerge {
    static constexpr bool PERM = true, QUAD = false, LINE = false, GPAIR = false, HALFEPI = false;
    const bf16_t* Pg; bf16_t* Mb;
    __device__ __forceinline__ bool operator()(g8::Acc& acc, const g8::Unit& u, int wr, int wc, int, int) const {
        int t = threadIdx.x; asm volatile("" : "+v"(t));
        const int fr = t & 15, fq = (t >> 4) & 3;
        const int row0 = u.pm * 256 + wr * 64 + fr, col0 = (u.pn & 3) * 256 + wc * 32 + 8 * fq;
        if (u.sel == 0) {
#pragma unroll
            for (int ai = 0; ai < 2; ++ai) {
#pragma unroll
                for (int m = 0; m < 4; ++m) {
                    const bf16_t* gp = Pg + (size_t)(row0 + ai * 128 + m * 16) * PG_W + col0;
                    u32x4 g1[2];
#pragma unroll
                    for (int bj = 0; bj < 2; ++bj) g1[bj] = *(const u32x4*)(gp + bj * 128);
#pragma unroll
                    for (int bj = 0; bj < 2; ++bj)
#pragma unroll
                        for (int n = 0; n < 2; ++n)
#pragma unroll
                            for (int e = 0; e < 4; ++e) {
                                const unsigned w1 = g1[bj][2 * n + (e >> 1)];
                                acc[ai][bj][m][n][e] *= (e & 1) ? __uint_as_float(w1 & 0xffff0000u) : __uint_as_float(w1 << 16);
                            }
                }
                asm volatile("" ::: "memory");
            }
            return true;
        }
#pragma unroll
        for (int ai = 0; ai < 2; ++ai) {
#pragma unroll
            for (int m = 0; m < 4; ++m) {
                const size_t row = (size_t)(row0 + ai * 128 + m * 16);
                u32x4 g2[2];
#pragma unroll
                for (int bj = 0; bj < 2; ++bj) g2[bj] = *(const u32x4*)(Pg + row * PG_W + 1024 + col0 + bj * 128);
#pragma unroll
                for (int bj = 0; bj < 2; ++bj) {
                    u32x4 w;
#pragma unroll
                    for (int n = 0; n < 2; ++n) {
                        float o[4];
#pragma unroll
                        for (int e = 0; e < 4; ++e) {
                            const unsigned w2 = g2[bj][2 * n + (e >> 1)];
                            o[e] = acc[ai][bj][m][n][e] * ((e & 1) ? __uint_as_float(w2 & 0xffff0000u) : __uint_as_float(w2 << 16));
                        }
                        w[2 * n] = pack_bf2(o[0], o[1]); w[2 * n + 1] = pack_bf2(o[2], o[3]);
                    }
                    *(u32x4*)(Mb + row * 1024 + col0 + bj * 128) = w;
                }
            }
            asm volatile("" ::: "memory");
        }
        return false;
    }
};
__device__ __forceinline__ void ph_merge8(const Params& p, char* smem_all, const int pb) {
    MergeOrder mo; mo.so.init(NL, 1024, gridDim.x, pb);
    EpiMerge ep; ep.Pg = p.Pg(); ep.Mb = p.Mb();
    g8::gemm_phase((LAS unsigned char*)smem_all, p.A_mla(), p.A_dn(), 512, p.Wt_mo(), 512, mo, ep);
}

template <class V4>
__device__ __forceinline__ V4 dpp_swap_adj(V4 v) {
    u32x4 x = __builtin_bit_cast(u32x4, v), y;
#pragma unroll
    for (int k = 0; k < 4; ++k) y[k] = (unsigned)__builtin_amdgcn_update_dpp(0, (int)x[k], 0xB1, 0xF, 0xF, true);
    return __builtin_bit_cast(V4, y);
}
template <class V4>
__device__ __forceinline__ void line_load2(const void* p1, const void* p2, int odd, V4& lower, V4& upper) {
    const V4 L1 = *(const V4*)p1, L2 = *(const V4*)p2;
    const u32x4 l1 = __builtin_bit_cast(u32x4, L1), l2 = __builtin_bit_cast(u32x4, L2), y1 = __builtin_bit_cast(u32x4, dpp_swap_adj(L1)), y2 = __builtin_bit_cast(u32x4, dpp_swap_adj(L2));
    u32x4 lo, up;
#pragma unroll
    for (int k = 0; k < 4; ++k) { lo[k] = odd ? y2[k] : l1[k]; up[k] = odd ? l2[k] : y1[k]; }
    lower = __builtin_bit_cast(V4, lo); upper = __builtin_bit_cast(V4, up);
}
template <class V4>
__device__ __forceinline__ void line_store2(void* p1, void* p2, int odd, V4 lower, V4 upper) {
    const u32x4 lo = __builtin_bit_cast(u32x4, lower), up = __builtin_bit_cast(u32x4, upper);
    u32x4 x, s1, s2;
#pragma unroll
    for (int k = 0; k < 4; ++k) x[k] = odd ? lo[k] : up[k];
    const u32x4 y = dpp_swap_adj(x);
#pragma unroll
    for (int k = 0; k < 4; ++k) { s1[k] = odd ? y[k] : lo[k]; s2[k] = odd ? up[k] : y[k]; }
    *(u32x4*)p1 = s1; *(u32x4*)p2 = s2;
}
struct EpiOut {
    static constexpr bool PERM = false, QUAD = false, LINE = false, GPAIR = false, HALFEPI = false;
    const float* x; const float* mod; float* out;
    __device__ __forceinline__ bool operator()(g8::Acc& acc, const g8::Unit& u, int wr, int wc, int, int) const {
        int t = threadIdx.x; asm volatile("" : "+v"(t));
        const int fr = t & 15, fq = (t >> 4) & 3, odd = fr & 1;
        const int col0 = u.pn * 256 + wc * 32 + 4 * fq;
        const float* gp = mod + ((u.pm * 256) / SEQ) * 3072 + 2048 + col0;
        f32x4 gate[2][2];
#pragma unroll
        for (int bj = 0; bj < 2; ++bj)
#pragma unroll
            for (int n = 0; n < 2; ++n) gate[bj][n] = *(const f32x4*)(gp + bj * 128 + n * 16);
        const size_t offe = (size_t)(u.pm * 256 + wr * 64 + (fr & ~1)) * DM + u.pn * 256 + wc * 32 + 16 * odd + 4 * fq;
#pragma unroll
        for (int ai = 0; ai < 2; ++ai)
#pragma unroll
            for (int m = 0; m < 4; ++m) {
                const size_t off = offe + (size_t)(ai * 128 + m * 16) * DM;
                f32x4 xv[2][2];
#pragma unroll
                for (int bj = 0; bj < 2; ++bj) line_load2(x + off + bj * 128, x + off + bj * 128 + DM, odd, xv[bj][0], xv[bj][1]);
#pragma unroll
                for (int bj = 0; bj < 2; ++bj)
                    line_store2(out + off + bj * 128, out + off + bj * 128 + DM, odd, xv[bj][0] + gate[bj][0] * acc[ai][bj][m][0], xv[bj][1] + gate[bj][1] * acc[ai][bj][m][1]);
                if (m & 1) asm volatile("" ::: "memory");
            }
        return false;
    }
};
__device__ __forceinline__ void ph_out8(const Params& p, char* smem_all, const int pb) {
    g8::StaticOrder so; so.init(NL, DM, gridDim.x, pb);
    EpiOut ep; ep.x = p.x; ep.mod = p.mod(); ep.out = p.out;
    g8::gemm_phase((LAS unsigned char*)smem_all, p.Mb(), nullptr, DM, p.Wt_out(), 1024, so, ep);
}

#define XB_TMO      128
#define XB_XCNT(j)  (256  + 64 * (j))
#define XB_XSUB(j)  (1280 + 64 * (j))
#define XB_XGEN(j)  (2304 + 64 * (j))
#define XB_TOP      3328
#define XB_TOPGEN   3392
#define XB_MODCNT   3392
#define XCD_BAR_WORDS 3456
#define XB_SPIN_CAP (1u << 20)
__device__ __forceinline__ unsigned xb_ld(unsigned* p)              { return __hip_atomic_load(p, __ATOMIC_RELAXED, __HIP_MEMORY_SCOPE_AGENT); }
__device__ __forceinline__ unsigned xb_add(unsigned* p, unsigned v) { return __hip_atomic_fetch_add(p, v, __ATOMIC_RELAXED, __HIP_MEMORY_SCOPE_AGENT); }
__device__ __forceinline__ unsigned xb_xcc_id() { return (unsigned)__builtin_amdgcn_s_getreg((3 << 11) | 20) & 0xFu; }
#define XB_SPIN(cond, bar) do { unsigned _sp = 0; while (cond) { __builtin_amdgcn_s_sleep(1); \
    if ((++_sp & 255u) == 0u) { if (xb_ld(&(bar)[XB_TMO])) break; if (_sp > XB_SPIN_CAP) { atomicAdd(&(bar)[XB_TMO], 1u); break; } } } } while (0)
struct XcdBarrier { unsigned* bar; unsigned x; volatile LAS unsigned* st; };
__device__ __forceinline__ XcdBarrier xcd_barrier_post(unsigned* bar, volatile LAS unsigned* st) {
    XcdBarrier b; b.bar = bar; b.x = xb_xcc_id(); b.st = st;
    if (threadIdx.x == 0) (void)xb_add(&bar[XB_XCNT(b.x)], 1u);
    return b;
}
__device__ __forceinline__ void xcd_barrier_complete(unsigned* bar, unsigned x, unsigned& nloc, unsigned& nx) {
    const unsigned G = gridDim.x * gridDim.y * gridDim.z;
    unsigned sum, cnt, mine, sp = 0u;
    for (;;) {
        sum = 0u; cnt = 0u; mine = 0u;
#pragma unroll
        for (unsigned j = 0; j < 16; ++j) { const unsigned c = xb_ld(&bar[XB_XCNT(j)]); sum += c; cnt += (c > 0u) ? 1u : 0u; mine = (j == x) ? c : mine; }
        if (sum == G) break;
        __builtin_amdgcn_s_sleep(1);
        if ((++sp & 255u) == 0u) { if (xb_ld(&bar[XB_TMO])) break; if (sp > XB_SPIN_CAP) { atomicAdd(&bar[XB_TMO], 1u); break; } }
    }
    nloc = mine > 0u ? mine : 1u; nx = cnt > 0u ? cnt : 1u;
}
__device__ __forceinline__ void xcd_barrier(const XcdBarrier& b) {
    asm volatile("s_waitcnt vmcnt(0)" ::: "memory");
    __syncthreads();
    if (threadIdx.x == 0) {
        unsigned* bar = b.bar;
        __builtin_amdgcn_s_waitcnt(0);
        unsigned nloc = b.st[0], nx = b.st[1];
        if (nloc == 0u) { xcd_barrier_complete(bar, b.x, nloc, nx); b.st[0] = nloc; b.st[1] = nx; }
        const unsigned old = xb_add(&bar[XB_XSUB(b.x)], 1u);
        const unsigned gen = old / nloc;
        if (old + 1u == (gen + 1u) * nloc) {
            __builtin_amdgcn_fence(__ATOMIC_RELEASE, "agent");
            asm volatile("s_waitcnt vmcnt(0)" ::: "memory");
            const unsigned og = xb_add(&bar[XB_TOP], 1u);
            if (og + 1u != (gen + 1u) * nx) XB_SPIN(xb_ld(&bar[XB_TOP]) < (gen + 1u) * nx, bar);
            __builtin_amdgcn_fence(__ATOMIC_ACQUIRE, "agent");
            asm volatile("s_waitcnt vmcnt(0)" ::: "memory");
        } else {
            XB_SPIN(xb_ld(&bar[XB_TOP]) < (gen + 1u) * nx, bar);
            __builtin_amdgcn_fence(__ATOMIC_ACQUIRE, "agent");
            asm volatile("s_waitcnt vmcnt(0)" ::: "memory");
        }
    }
    __syncthreads();
}

__global__ void __launch_bounds__(2 * NTHR, 2) fwd_megakernel(Params p) {
    __shared__ __attribute__((aligned(16))) char smem_all[2 * SMEM_BYTES];
    const int half = __builtin_amdgcn_readfirstlane((int)(threadIdx.x >> 8)), pb = blockIdx.x;
    const int bid = 16 * (pb >> 3) + 8 * half + (pb & 7), nb = 2 * gridDim.x;
    const int bid2 = 2 * pb + half;
    char* smem = smem_all + half * SMEM_BYTES;
    volatile LAS unsigned* bst = (volatile LAS unsigned*)(smem_all + 2 * SMEM_BYTES - 16);
    if (threadIdx.x == 0) { bst[0] = 0u; bst[1] = 0u; }
    __syncthreads();
    const XcdBarrier xb = xcd_barrier_post(p.bar(), bst);

    ph_mod(p, bid, nb, smem);
    if (threadIdx.x == 0) { asm volatile("s_waitcnt vmcnt(0)" ::: "memory"); (void)xb_add(&p.bar()[XB_MODCNT], 1u); }
    ph_wprep(p, bid2, nb, smem);
    __syncthreads();
    if (threadIdx.x == 0) {
        unsigned* bar = p.bar();
        XB_SPIN(xb_ld(&bar[XB_MODCNT]) < gridDim.x, bar);
        __builtin_amdgcn_fence(__ATOMIC_ACQUIRE, "agent");
        asm volatile("s_waitcnt vmcnt(0)" ::: "memory");
    }
    __syncthreads();
    ph_norm(p, bid, nb, smem);
    xcd_barrier(xb);
    ph_inproj8(p, smem_all, pb);
    xcd_barrier(xb);
    ph_mla_proj(p, bid, nb, smem, smem_all, half);
    xcd_barrier(xb);
    ph_attn(p, bid, nb, smem, smem_all, pb);
    xcd_barrier(xb);
    ph_dn1(p, bid, nb, smem);
    __syncthreads();
    ph_zd8(p, smem_all, pb);
    xcd_barrier(xb);
    ph_dn2(p, smem_all, pb);
    xcd_barrier(xb);
    ph_dn3(p, bid, nb, smem);
    ph_gates(p, smem_all, pb);
    xcd_barrier(xb);
    ph_merge8(p, smem_all, pb);
    xcd_barrier(xb);
    ph_out8(p, smem_all, pb);
}

extern "C" void kernel_launch(void* const* d_in, const int* in_sizes, int n_in,
                              void* d_out, int out_size, void* d_ws, size_t ws_size,
                              hipStream_t stream) {
    static int grid_blocks = 0;
    if (!grid_blocks) {
        int dev = 0, cus = 0, per_cu = 0;
        (void)hipGetDevice(&dev);
        (void)hipDeviceGetAttribute(&cus, hipDeviceAttributeMultiprocessorCount, dev);
        (void)hipOccupancyMaxActiveBlocksPerMultiprocessor(&per_cu, fwd_megakernel, 2 * NTHR, 0);
        if (per_cu > 1) per_cu = 1;
        if (per_cu < 1) per_cu = 1;
        grid_blocks = cus * per_cu;
    }
    if (n_in != 21 || ws_size < (size_t)268435456 || out_size != NL * DM) {
        fprintf(stderr, "kernel_launch: built for 21 inputs, a %d-float output and >= 256 MiB of workspace (got %d inputs, out %d, ws %zu)\n", NL * DM, n_in, out_size, ws_size);
        return;
    }
    Params p{};
    const float** fp = (const float**)&p;
    for (int i = 0; i < 21; ++i) fp[i] = (const float*)d_in[i];
    p.out = (float*)d_out;
    char* ws = (char*)d_ws;
    char* ob = (char*)d_out;
    p.ws = ws;
    (void)ob;
    (void)hipMemsetAsync(ws + 16318464, 0, 110592 + XCD_BAR_WORDS * 4, stream);
    void* args[] = {&p};
    hipError_t err = hipLaunchCooperativeKernel((void*)fwd_megakernel, dim3(grid_blocks), dim3(2 * NTHR), args, 0, stream);
    if (err != hipSuccess) fprintf(stderr, "cooperative launch failed: %s (grid %d)\n", hipGetErrorString(err), grid_blocks);
}
```
